# Optimizing an MI355X kernel written in HIP

```python
import jax, jax.numpy as jnp
from jax import lax
import numpy as np

D_MODEL = 1024
BATCH = 4
SEQ = 4096
DEPTH = 1

MIX_WIDTH = D_MODEL
ATT_HEADS = 8
ATT_HEAD_DIM = 64
IDX_HEADS = 8
IDX_DIM = 64
TOPK_MAX = 256
RET_HEADS = 4
RET_QK_DIM = 128
RET_V_DIM = 128
ROPE_THETA = 10000.0
Q_BLOCK = 128
RET_CHUNK = 128
PEER_HEADS = 8
PEER_NKEYS = 128
PEER_KEY_DIM = 256
PEER_HALF = PEER_KEY_DIM // 2
PEER_TOPK = 16
N_EXPERTS = PEER_NKEYS * PEER_NKEYS
N_MOD = 6
EPS = 1e-6

IN_SPLITS = (ATT_HEADS * ATT_HEAD_DIM, ATT_HEADS * ATT_HEAD_DIM, ATT_HEADS * ATT_HEAD_DIM,
             IDX_HEADS * IDX_DIM, IDX_DIM, IDX_HEADS,
             RET_HEADS * RET_QK_DIM, RET_HEADS * RET_QK_DIM, RET_HEADS * RET_V_DIM, RET_HEADS * RET_V_DIM)
IN_COLS = (3 * ATT_HEADS * ATT_HEAD_DIM + IDX_HEADS * IDX_DIM + IDX_DIM + IDX_HEADS
           + 2 * RET_HEADS * RET_QK_DIM + 2 * RET_HEADS * RET_V_DIM)

kernel_name = "hymba_dsa_retnet_peer_adaln"


def rmsnorm(x, g):
    xf = x.astype(jnp.float32)
    y = xf * lax.rsqrt(jnp.mean(xf * xf, axis=-1, keepdims=True) + EPS)
    return (y * g.astype(jnp.float32)).astype(x.dtype)


def rope_inv_freq(d):
    return 1.0 / (ROPE_THETA ** (jnp.arange(0, d, 2, dtype=jnp.float32) / d))


def retnet_inv_freq(d):
    return 1.0 / (ROPE_THETA ** jnp.linspace(0.0, 1.0, d // 2, dtype=jnp.float32))


def rotate(x, inv_freq):
    s = x.shape[1]
    ang = jnp.arange(s, dtype=jnp.float32)[:, None] * inv_freq[None, :]
    cos = jnp.cos(ang)[None, :, None, :]
    sin = jnp.sin(ang)[None, :, None, :]
    x1, x2 = jnp.split(x.astype(jnp.float32), 2, axis=-1)
    return jnp.concatenate([x1 * cos - x2 * sin, x1 * sin + x2 * cos], axis=-1).astype(x.dtype)


def dsa_attention(q, k, v, qi, ki, wi):
    b, s, h, dh = q.shape
    topk = min(TOPK_MAX, s // 4)
    n_blocks = s // Q_BLOCK
    scale = dh ** -0.5
    idx_scale = IDX_DIM ** -0.5
    spos = jnp.arange(s)

    def block(i):
        t0 = i * Q_BLOCK
        qb = lax.dynamic_slice_in_dim(q, t0, Q_BLOCK, axis=1)
        qib = lax.dynamic_slice_in_dim(qi, t0, Q_BLOCK, axis=1)
        wib = lax.dynamic_slice_in_dim(wi, t0, Q_BLOCK, axis=1)
        tpos = t0 + jnp.arange(Q_BLOCK)
        causal = spos[None, :] <= tpos[:, None]
        sc = jnp.einsum('bqhd,bsd->bqhs', qib, ki, preferred_element_type=jnp.float32) * idx_scale
        iscore = jnp.einsum('bqh,bqhs->bqs', wib.astype(jnp.float32), jax.nn.relu(sc))
        iscore = jnp.where(causal[None], iscore, -jnp.inf)
        _, sel = lax.top_k(iscore, topk)
        valid = sel <= tpos[None, :, None]
        kg = jax.vmap(lambda kb, ib: kb[ib])(k, sel)
        vg = jax.vmap(lambda vb, ib: vb[ib])(v, sel)
        logits = jnp.einsum('bqhd,bqkhd->bhqk', qb, kg, preferred_element_type=jnp.float32) * scale
        logits = jnp.where(valid[:, None], logits, -jnp.inf)
        p = jax.nn.softmax(logits, axis=-1)
        return jnp.einsum('bhqk,bqkhd->bqhd', p.astype(v.dtype), vg)

    out = lax.map(block, jnp.arange(n_blocks))
    return out.transpose(1, 0, 2, 3, 4).reshape(b, s, h * dh)


def retention_group(qr, kr, vr, gr):
    b, s, _ = qr.shape
    hh, dk, dv, cl = RET_HEADS, RET_QK_DIM, RET_V_DIM, RET_CHUNK
    n = s // cl
    f32 = jnp.float32
    inv = retnet_inv_freq(dk)
    q = rotate(qr.reshape(b, s, hh, dk), inv).astype(f32)
    k = rotate(kr.reshape(b, s, hh, dk), inv).astype(f32) * (dk ** -0.5)
    v = vr.reshape(b, s, hh, dv).astype(f32)

    def to_chunks(t):
        return t.reshape(b, n, cl, hh, t.shape[-1]).transpose(1, 0, 3, 2, 4)

    qc, kc, vc = to_chunks(q), to_chunks(k), to_chunks(v)
    log_g = jnp.log(1.0 - 2.0 ** (-5.0 - jnp.arange(hh, dtype=f32)))
    idx = jnp.arange(cl)
    diff = (idx[:, None] - idx[None, :]).astype(f32)
    dmat = jnp.where(diff >= 0, jnp.exp(log_g[:, None, None] * jnp.maximum(diff, 0.0)), 0.0)
    xi = jnp.exp(log_g[:, None] * (idx + 1).astype(f32))[None, :, :, None]
    zeta = jnp.exp(log_g[:, None] * (cl - 1 - idx).astype(f32))[None, :, :, None]
    g_chunk = jnp.exp(log_g * cl)[None, :, None, None]

    def step(state, inp):
        qi, ki, vi = inp
        inner = jnp.einsum('bhid,bhjd->bhij', qi, ki) * dmat[None]
        o = (jnp.einsum('bhij,bhjv->bhiv', inner, vi)
             + jnp.einsum('bhid,bhdv->bhiv', qi, state) * xi)
        state = g_chunk * state + jnp.einsum('bhjd,bhjv->bhdv', ki * zeta, vi)
        return state, o

    state0 = jnp.zeros((b, hh, dk, dv), f32)
    _, o = lax.scan(step, state0, (qc, kc, vc))
    o = o.transpose(1, 0, 3, 2, 4).reshape(b, s, hh, dv)
    mu = jnp.mean(o, axis=-1, keepdims=True)
    var = jnp.mean(jnp.square(o - mu), axis=-1, keepdims=True)
    o = ((o - mu) * lax.rsqrt(var + EPS)).reshape(b, s, hh * dv)
    return (jax.nn.silu(gr.astype(f32)) * o).astype(gr.dtype)


def peer_ffn(h, w_pq, sub_keys, u_emb, v_emb):
    b, s, d = h.shape
    nb = s // Q_BLOCK
    t = b * Q_BLOCK
    kk = PEER_TOPK
    hb = h.reshape(b, nb, Q_BLOCK, d).transpose(1, 0, 2, 3).reshape(nb, t, d)

    def block(xb):
        qry = (xb @ w_pq).reshape(t, PEER_HEADS, 2, PEER_HALF)
        sc = jnp.einsum('thpd,hpnd->thpn', qry, sub_keys, preferred_element_type=jnp.float32)
        v1, i1 = lax.top_k(sc[:, :, 0], kk)
        v2, i2 = lax.top_k(sc[:, :, 1], kk)
        cand = (v1[..., :, None] + v2[..., None, :]).reshape(t, PEER_HEADS, kk * kk)
        cid = (i1[..., :, None] * PEER_NKEYS + i2[..., None, :]).reshape(t, PEER_HEADS, kk * kk)
        top_s, pos = lax.top_k(cand, kk)
        eid = jnp.take_along_axis(cid, pos, axis=-1)
        gate = jax.nn.softmax(top_s, axis=-1)
        u = u_emb[eid]
        act = jax.nn.gelu(jnp.einsum('thkd,td->thk', u, xb, preferred_element_type=jnp.float32),
                          approximate=False)
        vv = v_emb[eid]
        return jnp.einsum('thk,thkd->td', (gate * act).astype(xb.dtype), vv)

    out = lax.map(block, hb)
    return out.reshape(nb, b, Q_BLOCK, d).transpose(1, 0, 2, 3).reshape(b, s, d)


def setup_inputs(seed: int = 0) -> dict:
    key = jax.random.key(seed)
    ks = jax.random.split(key, 13)
    f = jnp.float32
    d = D_MODEL
    nrm = jax.random.normal
    return {
        "x": nrm(ks[0], (BATCH, SEQ, d), f),
        "c": nrm(ks[1], (BATCH, d), f),
        "w_ada": nrm(ks[2], (DEPTH, d, N_MOD * d), f) * (0.5 * d ** -0.5),
        "b_ada": 0.01 * nrm(ks[3], (DEPTH, N_MOD * d), f),
        "norm_mix_g": 1.0 + 0.01 * nrm(ks[4], (DEPTH, d), f),
        "w_in": nrm(ks[5], (DEPTH, d, IN_COLS), f) * d ** -0.5,
        "w_out": nrm(ks[6], (DEPTH, MIX_WIDTH, d), f) * MIX_WIDTH ** -0.5,
        "norm_ffn_g": 1.0 + 0.01 * nrm(ks[7], (DEPTH, d), f),
        "w_pq": nrm(ks[8], (DEPTH, d, PEER_HEADS * PEER_KEY_DIM), f) * d ** -0.5,
        "sub_keys": nrm(ks[9], (DEPTH, PEER_HEADS, 2, PEER_NKEYS, PEER_HALF), f) * PEER_HALF ** -0.5,
        "u_emb": nrm(ks[10], (DEPTH, N_EXPERTS, d), f) * d ** -0.5,
        "v_emb": nrm(ks[11], (DEPTH, N_EXPERTS, d), f) * PEER_HEADS ** -0.5,
        "norm_final_g": 1.0 + 0.01 * nrm(ks[12], (d,), f),
    }


def reference(x, c, w_ada, b_ada, norm_mix_g, w_in, w_out, norm_ffn_g, w_pq, sub_keys, u_emb, v_emb,
              norm_final_g):
    b, s, _ = x.shape
    split_pts = tuple(int(p) for p in np.cumsum(np.array(IN_SPLITS))[:-1])
    rope_att = rope_inv_freq(ATT_HEAD_DIM)
    rope_idx = rope_inv_freq(IDX_DIM)
    for layer in range(DEPTH):
        mod = jax.nn.silu(c) @ w_ada[layer] + b_ada[layer]
        sh_m, sc_m, gt_m, sh_f, sc_f, gt_f = jnp.split(mod[:, None, :], N_MOD, axis=-1)

        h = rmsnorm(x, norm_mix_g[layer]) * (1 + sc_m) + sh_m
        proj = h @ w_in[layer]
        qa, ka, va, qi, ki, wi, qr, kr, vr, gr = jnp.split(proj, split_pts, axis=-1)
        qa = rotate(qa.reshape(b, s, ATT_HEADS, ATT_HEAD_DIM), rope_att)
        ka = rotate(ka.reshape(b, s, ATT_HEADS, ATT_HEAD_DIM), rope_att)
        va = va.reshape(b, s, ATT_HEADS, ATT_HEAD_DIM)
        qi = rotate(qi.reshape(b, s, IDX_HEADS, IDX_DIM), rope_idx)
        ki = rotate(ki.reshape(b, s, 1, IDX_DIM), rope_idx)[:, :, 0]
        wi = wi * (IDX_HEADS ** -0.5)
        att = dsa_attention(qa, ka, va, qi, ki, wi)
        ret = retention_group(qr, kr, vr, gr)
        mixed = jnp.concatenate([att, ret.astype(att.dtype)], axis=-1) @ w_out[layer]
        x = x + gt_m * mixed

        h = rmsnorm(x, norm_ffn_g[layer]) * (1 + sc_f) + sh_f
        x = x + gt_f * peer_ffn(h, w_pq[layer], sub_keys[layer], u_emb[layer], v_emb[layer])
    return rmsnorm(x, norm_final_g)
```

```cpp
#include <hip/hip_runtime.h>
#include <hip/hip_cooperative_groups.h>
#include <cstdio>
#include <cstdint>
namespace cg = cooperative_groups;

#ifndef MK_MULTI
#define MK_MULTI 0
#endif

#define GAS __attribute__((address_space(1)))
#define LAS __attribute__((address_space(3)))
typedef unsigned short bf16_t;
typedef short bf16x8 __attribute__((ext_vector_type(8)));
typedef float f32x4 __attribute__((ext_vector_type(4)));
typedef float f32x16 __attribute__((ext_vector_type(16)));
typedef unsigned u32x4 __attribute__((ext_vector_type(4)));
typedef unsigned u32x2 __attribute__((ext_vector_type(2)));

constexpr int BATCH = 4, SEQ = 4096, DM = 1024, MTOK = BATCH * SEQ;
constexpr int N1 = 4352;
constexpr int NTHREADS = 512;
constexpr float EPS = 1e-6f;
constexpr float C_QK = 0.18033688011112042f;
constexpr float NEG_INF = -__builtin_huge_valf();

__device__ __forceinline__ float ret_log2g(int h) { return h == 0 ? -0.045803689613124791f : h == 1 ? -0.022720076500083530f : h == 2 ? -0.011315313227834147f : -0.0056465631411420624f; }
__device__ __forceinline__ float ret_gamma(int h) { return h == 0 ? 0.96875f : h == 1 ? 0.984375f : h == 2 ? 0.9921875f : 0.99609375f; }
__device__ __forceinline__ float ret_g128(int h) { return h == 0 ? 0.017183023570817902f : h == 1 ? 0.13321516287964842f : h == 2 ? 0.36643771592203725f : 0.60593708822908032f; }
__device__ __forceinline__ float ret_g127(int h) { return h == 0 ? 0.017737314653747512f : h == 1 ? 0.13532968927456347f : h == 2 ? 0.36932305226788007f : 0.60831331210448848f; }

constexpr size_t MiB = 1u << 20;
constexpr size_t WS_CTL = 0, CTL_BYTES = 1 * MiB;
constexpr size_t WS_SUMSQ = 5 * MiB;
constexpr size_t WS_MOD = 1 * MiB;
constexpr size_t WS_BIASF = 1 * MiB + 128 * 1024;
constexpr size_t WS_COSA = 2 * MiB, WS_SINA = 2 * MiB + 512 * 1024;
constexpr size_t WS_COSR = 3 * MiB, WS_SINR = 4 * MiB;
constexpr size_t WS_WIN = 6 * MiB;
constexpr size_t WS_WOUT = 15 * MiB;
constexpr size_t WS_WPQ = 17 * MiB;
constexpr size_t WS_BUFA = 22 * MiB;
constexpr size_t WS_MASK = WS_BUFA, WS_STATE = WS_BUFA + 8 * MiB;
constexpr size_t WS_BUFB = 54 * MiB;
constexpr size_t WS_G1 = 86 * MiB;
constexpr size_t WS_QA = WS_G1, WS_KA = WS_G1 + 16 * MiB, WS_VA = WS_G1 + 32 * MiB, WS_QI = WS_G1 + 48 * MiB, WS_QR = WS_G1 + 64 * MiB,
                 WS_KR = WS_G1 + 80 * MiB, WS_VR = WS_G1 + 96 * MiB, WS_GR = WS_G1 + 112 * MiB, WS_KI = WS_G1 + 128 * MiB, WS_WI = WS_G1 + 130 * MiB;
constexpr size_t WS_SC = WS_G1;
constexpr size_t WS_VBF = 217 * MiB;
constexpr size_t WS_END = 256 * MiB;
static_assert(WS_WI + (size_t)MTOK * 8 * 4 <= WS_VBF && WS_SC + (size_t)MTOK * 2048 * 4 <= WS_VBF && WS_VBF + (size_t)16384 * 1024 * 2 <= WS_END, "ws map");
constexpr int LDS_BYTES = 147456;

__device__ __forceinline__ unsigned f2bf(float f) { unsigned u = __float_as_uint(f); return (u + 0x7fffu + ((u >> 16) & 1u)) >> 16; }
__device__ __forceinline__ unsigned pk2(float lo, float hi) { return f2bf(lo) | (f2bf(hi) << 16); }
__device__ __forceinline__ float bf_lo(unsigned w) { return __uint_as_float(w << 16); }
__device__ __forceinline__ float bf_hi(unsigned w) { return __uint_as_float(w & 0xffff0000u); }
__device__ __forceinline__ float wave_sum(float v) {
#pragma unroll
    for (int o = 1; o < 64; o <<= 1) v += __shfl_xor(v, o);
    return v;
}
__device__ __forceinline__ float fast_exp2(float x) { return __builtin_amdgcn_exp2f(x); }
__device__ __forceinline__ float gelu_exact(float v) {
    const float av = fabsf(v), t = __builtin_amdgcn_rcpf(av * 0.2316418882f + 1.0f);
    float q = t * 0.5307027145f + (-0.7265760135f); q = q * t + 0.7107068705f; q = q * t + (-0.142248368f); q = q * t + 0.127414796f; q = q * t;
    const float e = fast_exp2(v * v * (-0.72134752044f));
    const float m = v * (q * e);
    return v < 0.f ? m : v - m;
}
__device__ __forceinline__ float silu_f(float v) { return v / (1.0f + __expf(-v)); }
__device__ __forceinline__ unsigned sortable32(float f) { const unsigned u = __float_as_uint(f); return (u & 0x80000000u) ? ~u : (u | 0x80000000u); }
__device__ __forceinline__ float unsortable32(unsigned s) { return __uint_as_float((s & 0x80000000u) ? (s ^ 0x80000000u) : ~s); }
__device__ __forceinline__ unsigned sortable16(float x) {
    const _Float16 h = (_Float16)x; const unsigned b = (unsigned)__builtin_bit_cast(unsigned short, h);
    return (b & 0x8000u) ? (~b & 0xFFFFu) : (b | 0x8000u);
}
__device__ __forceinline__ f32x4 mfma16(bf16x8 a, bf16x8 b, f32x4 c) { return __builtin_amdgcn_mfma_f32_16x16x32_bf16(a, b, c, 0, 0, 0); }
__device__ __forceinline__ f32x16 mfma32(bf16x8 a, bf16x8 b, f32x16 c) { return __builtin_amdgcn_mfma_f32_32x32x16_bf16(a, b, c, 0, 0, 0); }

__host__ __device__ __forceinline__ int win_src_col(int p) {
    const int tile = p >> 8, bj = (p >> 7) & 1, q = p & 127;
    if (tile < 4) return 256 * tile + (q >> 5) * 64 + bj * 32 + (q & 31);
    if (tile < 6) return p;
    if (tile < 8) return 256 * tile + (q >> 5) * 64 + bj * 32 + (q & 31);
    if (tile == 8) { if (q < 32) return 2048 + bj * 32 + q; if (bj == 0 && q < 40) return 2112 + (q - 32); return -1; }
    if (tile < 13) { const int base = (tile < 11) ? 2120 + 256 * (tile - 9) : 2632 + 256 * (tile - 11); return base + (q >> 6) * 128 + bj * 64 + (q & 63); }
    if (tile < 15) return 3144 + (p - 13 * 256);
    return 3656 + (p - 15 * 256);
}
namespace pg8 {
#define PG8_LAS __attribute__((address_space(3)))
typedef unsigned short bf16_t;
typedef short bf16x8 __attribute__((ext_vector_type(8)));
typedef float f32x4 __attribute__((ext_vector_type(4)));
typedef unsigned u32x4 __attribute__((ext_vector_type(4)));
constexpr int BM = 256, BK = 64, HALF = 128, HTB = HALF * BK * 2  , STAGE_BYTES = 8 * HTB, NXCD = 8, WGM = 8;

__host__ __device__ __forceinline__ int lds_byte(int r, int c) { const int st = (r >> 4) * 2 + (c >> 5), rr = r & 15, cc = c & 31, ob = rr * 64 + cc * 2; return st * 1024 + (ob ^ (((ob >> 9) & 1) << 5)); }
__host__ __device__ __forceinline__ void stage_rc(int b, int& R, int& C) { const int st = b / 1024, sb = b % 1024, swz = sb ^ (((sb >> 9) & 1) << 5); R = (st >> 1) * 16 + swz / 64; C = (st & 1) * 32 + (swz % 64) / 2; }
__host__ __device__ __forceinline__ int perm32(int rho) { const int n = rho >> 4, i = rho & 15; return 8 * (i >> 2) + 4 * n + (i & 3); }

struct Unit { int pm, pn; };
struct Gemm { const bf16_t* A; const bf16_t* Bt; int M, N, K; };

struct StaticOrder {
    int nM, nN, nwg, G, c;
    __host__ __device__ void init(int M, int N, int G_, int c_) { nM = M / BM; nN = N / BM; nwg = nM * nN; G = G_; c = c_; }
    __host__ __device__ bool next(int i, Unit& u) const {
        const long L = (long)i * G + c; if (L >= nwg) return false;
        int wgid = (int)L; { const int q = nwg / NXCD, r = nwg % NXCD, xcd = wgid % NXCD, off = wgid / NXCD; wgid = (xcd < r ? xcd * (q + 1) : r * (q + 1) + (xcd - r) * q) + off; }
        const int nig = WGM * nN, gid = wgid / nig, fm = gid * WGM, gsz = (nM - fm) < WGM ? (nM - fm) : WGM;
        u.pm = fm + ((wgid % nig) % gsz); u.pn = (wgid % nig) / gsz; return true;
    }
    __device__ __forceinline__ void a_ready(const Unit&) const {}
    __device__ __forceinline__ void done(const Unit&) const {}
};

__device__ __forceinline__ unsigned cvt_pk_bf16(float lo, float hi) { unsigned r; asm volatile("v_cvt_pk_bf16_f32 %0, %1, %2" : "=v"(r) : "v"(lo), "v"(hi)); return r; }
__device__ __forceinline__ u32x4 pack8(const float (&v)[8]) { u32x4 w; w.x = cvt_pk_bf16(v[0], v[1]); w.y = cvt_pk_bf16(v[2], v[3]); w.z = cvt_pk_bf16(v[4], v[5]); w.w = cvt_pk_bf16(v[6], v[7]); return w; }

struct Epi1 {
    static constexpr bool PERM = true, AFTER_DRAIN = false;
    unsigned char* ws;
    __device__ __forceinline__ void operator()(const f32x4 (&acc)[2][2][4][2], const Unit& u, int wr, int wc, int fr, int fq) const {
        const int tile = u.pn;
        const int row0 = u.pm * BM + wr * 64 + fr;
        const float* cosA = (const float*)(ws + WS_COSA); const float* sinA = (const float*)(ws + WS_SINA);
        const float* cosR = (const float*)(ws + WS_COSR); const float* sinR = (const float*)(ws + WS_SINR);
        if (tile < 4 || tile == 6 || tile == 7) {
            bf16_t* dst = (bf16_t*)(ws + (tile < 2 ? WS_QA : tile < 4 ? WS_KA : WS_QI));
            const int tl = tile < 2 ? tile : tile < 4 ? tile - 2 : tile - 6;
            const float scale = tile < 2 ? C_QK : 1.0f;
            const int cb = 256 * tl + 64 * wc, i0 = 8 * fq;
#pragma unroll
            for (int ai = 0; ai < 2; ++ai)
#pragma unroll
                for (int m = 0; m < 4; ++m) {
                    const int row = row0 + ai * HALF + m * 16, pos = row & (SEQ - 1);
                    const f32x4 c0 = *(const f32x4*)(cosA + pos * 32 + i0), c1 = *(const f32x4*)(cosA + pos * 32 + i0 + 4);
                    const f32x4 s0 = *(const f32x4*)(sinA + pos * 32 + i0), s1 = *(const f32x4*)(sinA + pos * 32 + i0 + 4);
                    float y1[8], y2[8];
#pragma unroll
                    for (int n = 0; n < 2; ++n)
#pragma unroll
                        for (int e = 0; e < 4; ++e) {
                            const float x1 = acc[ai][0][m][n][e], x2 = acc[ai][1][m][n][e];
                            const float c = n ? c1[e] : c0[e], s = n ? s1[e] : s0[e];
                            y1[4 * n + e] = (x1 * c - x2 * s) * scale; y2[4 * n + e] = (x1 * s + x2 * c) * scale;
                        }
                    bf16_t* rp = dst + (size_t)row * 512 + cb + i0;
                    *(u32x4*)rp = pack8(y1); *(u32x4*)(rp + 32) = pack8(y2);
                }
        } else if (tile == 4 || tile == 5 || tile >= 13) {
            bf16_t* dst = (bf16_t*)(ws + (tile < 6 ? WS_VA : tile < 15 ? WS_VR : WS_GR));
            const int tl = tile < 6 ? tile - 4 : tile < 15 ? tile - 13 : tile - 15;
            const bool act = tile >= 15;
#pragma unroll
            for (int ai = 0; ai < 2; ++ai)
#pragma unroll
                for (int m = 0; m < 4; ++m) {
                    const int row = row0 + ai * HALF + m * 16;
#pragma unroll
                    for (int bj = 0; bj < 2; ++bj) {
                        float y[8];
#pragma unroll
                        for (int n = 0; n < 2; ++n)
#pragma unroll
                            for (int e = 0; e < 4; ++e) { const float v = acc[ai][bj][m][n][e]; y[4 * n + e] = act ? silu_f(v) : v; }
                        *(u32x4*)(dst + (size_t)row * 512 + 256 * tl + 128 * bj + 32 * wc + 8 * fq) = pack8(y);
                    }
                }
        } else if (tile == 8) {
#pragma unroll
            for (int ai = 0; ai < 2; ++ai)
#pragma unroll
                for (int m = 0; m < 4; ++m) {
                    const int row = row0 + ai * HALF + m * 16, pos = row & (SEQ - 1);
                    if (wc == 0) {
                        const int i0 = 8 * fq;
                        const f32x4 c0 = *(const f32x4*)(cosA + pos * 32 + i0), c1 = *(const f32x4*)(cosA + pos * 32 + i0 + 4);
                        const f32x4 s0 = *(const f32x4*)(sinA + pos * 32 + i0), s1 = *(const f32x4*)(sinA + pos * 32 + i0 + 4);
                        float y1[8], y2[8];
#pragma unroll
                        for (int n = 0; n < 2; ++n)
#pragma unroll
                            for (int e = 0; e < 4; ++e) {
                                const float x1 = acc[ai][0][m][n][e], x2 = acc[ai][1][m][n][e];
                                const float c = n ? c1[e] : c0[e], s = n ? s1[e] : s0[e];
                                y1[4 * n + e] = x1 * c - x2 * s; y2[4 * n + e] = x1 * s + x2 * c;
                            }
                        bf16_t* rp = (bf16_t*)(ws + WS_KI) + (size_t)row * 64 + i0;
                        *(u32x4*)rp = pack8(y1); *(u32x4*)(rp + 32) = pack8(y2);
                    } else if (wc == 1 && fq == 0) {
                        const float sw = 0.35355339059327379f;
                        float* WI = (float*)(ws + WS_WI);
                        *(f32x4*)(WI + (size_t)row * 8) = acc[ai][0][m][0] * sw;
                        *(f32x4*)(WI + (size_t)row * 8 + 4) = acc[ai][0][m][1] * sw;
                    }
                }
        } else {
            const bool isk = tile >= 11;
            bf16_t* dst = (bf16_t*)(ws + (isk ? WS_KR : WS_QR));
            const int tl = isk ? tile - 11 : tile - 9, hl = wc >> 1, h = 2 * tl + hl;
            const int i0 = 32 * (wc & 1) + 8 * fq, cb = 256 * tl + 128 * hl;
            const float lg = isk ? -ret_log2g(h) : ret_log2g(h);
            const float base = isk ? 0.08838834764831845f : 1.0f;
#pragma unroll
            for (int ai = 0; ai < 2; ++ai)
#pragma unroll
                for (int m = 0; m < 4; ++m) {
                    const int row = row0 + ai * HALF + m * 16, pos = row & (SEQ - 1);
                    const float dec = base * fast_exp2(lg * (float)(pos & 127));
                    const f32x4 c0 = *(const f32x4*)(cosR + pos * 64 + i0), c1 = *(const f32x4*)(cosR + pos * 64 + i0 + 4);
                    const f32x4 s0 = *(const f32x4*)(sinR + pos * 64 + i0), s1 = *(const f32x4*)(sinR + pos * 64 + i0 + 4);
                    float y1[8], y2[8];
#pragma unroll
                    for (int n = 0; n < 2; ++n)
#pragma unroll
                        for (int e = 0; e < 4; ++e) {
                            const float x1 = acc[ai][0][m][n][e], x2 = acc[ai][1][m][n][e];
                            const float c = n ? c1[e] : c0[e], s = n ? s1[e] : s0[e];
                            y1[4 * n + e] = (x1 * c - x2 * s) * dec; y2[4 * n + e] = (x1 * s + x2 * c) * dec;
                        }
                    bf16_t* rp = dst + (size_t)row * 512 + cb + i0;
                    *(u32x4*)rp = pack8(y1); *(u32x4*)(rp + 64) = pack8(y2);
                }
        }
    }
};

__device__ __forceinline__ float row_rstd(const float* sumsq, int row) {
    const f32x4* p = (const f32x4*)(sumsq + (size_t)row * 16);
    const f32x4 a = p[0], b = p[1], c = p[2], d = p[3];
    const float s = (((a[0] + a[1]) + (a[2] + a[3])) + ((b[0] + b[1]) + (b[2] + b[3]))) + (((c[0] + c[1]) + (c[2] + c[3])) + ((d[0] + d[1]) + (d[2] + d[3])));
    return 1.0f / sqrtf(s * (1.0f / DM) + EPS);
}
struct Epi2 {
    static constexpr bool PERM = false, AFTER_DRAIN = false;
    const float* x; float* x1; bf16_t* a3; const float* mod; const float* gffn; float* sumsq;
    __device__ __forceinline__ void operator()(const f32x4 (&acc)[2][2][4][2], const Unit& u, int wr, int wc, int fr, int fq) const {
        const int row0 = u.pm * BM + wr * 64 + fr, col0 = u.pn * BM + wc * 32 + 4 * fq;
#pragma unroll
        for (int ai = 0; ai < 2; ++ai)
#pragma unroll
            for (int m = 0; m < 4; ++m) {
                const int row = row0 + ai * HALF + m * 16, b = row >> 12;
                const float* mb = mod + b * 6144;
                float ss = 0.f;
#pragma unroll
                for (int bj = 0; bj < 2; ++bj)
#pragma unroll
                    for (int n = 0; n < 2; ++n) {
                        const int c = col0 + bj * HALF + n * 16;
                        const f32x4 xv = *(const f32x4*)(x + (size_t)row * DM + c), gt = *(const f32x4*)(mb + 2048 + c);
#ifdef DBG_NOMIX
                        const f32x4 v = xv;
#else
                        const f32x4 v = xv + gt * acc[ai][bj][m][n];
#endif
                        *(f32x4*)(x1 + (size_t)row * DM + c) = v;
                        ss += (v[0] * v[0] + v[1] * v[1]) + (v[2] * v[2] + v[3] * v[3]);
                        const f32x4 gs = *(const f32x4*)(gffn + c) * (*(const f32x4*)(mb + 4096 + c) + 1.0f);
                        const f32x4 a = v * gs;
                        u32x2 w; w.x = cvt_pk_bf16(a[0], a[1]); w.y = cvt_pk_bf16(a[2], a[3]);
                        *(u32x2*)(a3 + (size_t)row * DM + c) = w;
                    }
                ss += __shfl_xor(ss, 16); ss += __shfl_xor(ss, 32);
                if (fq == 0) sumsq[(size_t)row * 16 + u.pn * 4 + wc] = ss;
            }
    }
};

struct Epi3 {
    static constexpr bool PERM = false, AFTER_DRAIN = false;
    const float* sumsq; const float* biasf; float* sc;
    __device__ __forceinline__ void operator()(const f32x4 (&acc)[2][2][4][2], const Unit& u, int wr, int wc, int fr, int fq) const {
        const int row0 = u.pm * BM + wr * 64 + fr, col0 = u.pn * BM + wc * 32 + 4 * fq;
#pragma unroll
        for (int ai = 0; ai < 2; ++ai)
#pragma unroll
            for (int m = 0; m < 4; ++m) {
                const int row = row0 + ai * HALF + m * 16, b = row >> 12;
                const float rstd = row_rstd(sumsq, row);
#pragma unroll
                for (int bj = 0; bj < 2; ++bj)
#pragma unroll
                    for (int n = 0; n < 2; ++n) {
                        const int c = col0 + bj * HALF + n * 16;
                        *(f32x4*)(sc + (size_t)row * 2048 + c) = acc[ai][bj][m][n] * rstd + *(const f32x4*)(biasf + b * 2048 + c);
                    }
            }
    }
};

template <class Epi, class Sched, bool ALIGN_EPI = false, bool SP2 = false>
__device__ __forceinline__ void gemm_phase(PG8_LAS unsigned char* lds, const Gemm g, const Sched& S, const Epi& E) {
    const int tid = threadIdx.x, wid = __builtin_amdgcn_readfirstlane(tid >> 6), lane = tid & 63, wr = wid >> 2, wc = wid & 3, fr = lane & 15, fq = lane >> 4;
    const int K = g.K, nt = K / BK;
    unsigned voffA[2], voffB[2];
#pragma unroll
    for (int i = 0; i < 2; ++i) { int R, C; stage_rc(tid * 16 + i * 8192, R, C); const int Rb = Epi::PERM ? ((R & ~31) + perm32(R & 31)) : R;
        voffA[i] = (unsigned)(R * K + C) * 2u; voffB[i] = (unsigned)(Rb * K + C) * 2u; }
    const size_t kstep = (size_t)(BK * 2);
    const size_t hstep = (size_t)HALF * K * 2;
    const size_t tstep = 2 * hstep;
    const unsigned ldsw = (unsigned)wid * 1024u;
    const int aoff = lds_byte(wr * 64 + fr, fq * 8), boff = lds_byte(wc * 32 + fr, fq * 8);
#define PG8_SA(b, h) (((b) * 2 + (h)) * HTB)
#define PG8_SB(b, h) ((4 + (b) * 2 + (h)) * HTB)
#define PG8_STAGE(bufoff, gbase, voff) do { _Pragma("unroll") for (int _i = 0; _i < 2; ++_i) \
        __builtin_amdgcn_global_load_lds((const unsigned*)((const char*)(gbase) + (voff)[_i]), (PG8_LAS unsigned*)(lds + (bufoff) + ldsw + _i * 8192), 16, 0, 0); } while (0)
#define PG8_LDA(dst, b, h) do { _Pragma("unroll") for (int m = 0; m < 4; ++m) _Pragma("unroll") for (int k = 0; k < 2; ++k) dst[m][k] = *(const PG8_LAS bf16x8*)(lds + PG8_SA(b, h) + aoff + m * 2048 + k * 1024); } while (0)
#define PG8_LDB(dst, b, h) do { _Pragma("unroll") for (int n = 0; n < 2; ++n) _Pragma("unroll") for (int k = 0; k < 2; ++k) dst[n][k] = *(const PG8_LAS bf16x8*)(lds + PG8_SB(b, h) + boff + n * 2048 + k * 1024); } while (0)
#define PG8_MMA(ai, bj, At, Bt) do { __builtin_amdgcn_s_setprio(1); _Pragma("unroll") for (int m = 0; m < 4; ++m) _Pragma("unroll") for (int n = 0; n < 2; ++n) _Pragma("unroll") for (int k = 0; k < 2; ++k) \
        acc[ai][bj][m][n] = __builtin_amdgcn_mfma_f32_16x16x32_bf16(Bt[n][k], At[m][k], acc[ai][bj][m][n], 0, 0, 0); __builtin_amdgcn_s_setprio(0); } while (0)
#define PG8_WAIT_V(n) asm volatile("s_waitcnt vmcnt(" #n ")" ::: "memory")
#define PG8_WAIT_L(n) asm volatile("s_waitcnt lgkmcnt(" #n ")" ::: "memory")
#define PG8_BAR __builtin_amdgcn_s_barrier()
#define PG8_SCHED __builtin_amdgcn_sched_barrier(0)
    Unit cur, nxt; int ui = 0;
    if (!S.next(0, cur)) return;
    f32x4 acc[2][2][4][2];
#pragma unroll
    for (int a = 0; a < 2; ++a)
#pragma unroll
        for (int b = 0; b < 2; ++b)
#pragma unroll
            for (int m = 0; m < 4; ++m)
#pragma unroll
                for (int n = 0; n < 2; ++n) acc[a][b][m][n] = (f32x4){0.f, 0.f, 0.f, 0.f};
    bf16x8 At[4][2], B0[2][2], B1[2][2];
    const char* cA = (const char*)g.A + (size_t)cur.pm * tstep; const char* cB = (const char*)g.Bt + (size_t)cur.pn * tstep;
    S.a_ready(cur);
    if constexpr (SP2) {
        PG8_STAGE(PG8_SB(0, 0), cB, voffB); PG8_STAGE(PG8_SB(0, 1), cB + hstep, voffB); PG8_STAGE(PG8_SA(0, 0), cA, voffA); PG8_STAGE(PG8_SA(0, 1), cA + hstep, voffA);
        if (wr == 1) PG8_BAR;
        PG8_WAIT_V(2); PG8_BAR;
        PG8_STAGE(PG8_SB(1, 0), cB + kstep, voffB); PG8_STAGE(PG8_SA(1, 0), cA + kstep, voffA); PG8_STAGE(PG8_SB(1, 1), cB + hstep + kstep, voffB);
        PG8_WAIT_V(6); PG8_BAR;
    } else {
        PG8_STAGE(PG8_SB(0, 0), cB, voffB); PG8_STAGE(PG8_SA(0, 0), cA, voffA); PG8_STAGE(PG8_SB(0, 1), cB + hstep, voffB); PG8_STAGE(PG8_SA(0, 1), cA + hstep, voffA);
        if (wr == 1) PG8_BAR;
        PG8_WAIT_V(4); PG8_BAR;
        PG8_STAGE(PG8_SB(1, 0), cB + kstep, voffB); PG8_STAGE(PG8_SA(1, 0), cA + kstep, voffA); PG8_STAGE(PG8_SB(1, 1), cB + hstep + kstep, voffB);
        PG8_WAIT_V(6); PG8_BAR;
    }
    for (;;) {
        const bool has_next = S.next(ui + 1, nxt);
        const char* nA = has_next ? (const char*)g.A + (size_t)nxt.pm * tstep : cA; const char* nB = has_next ? (const char*)g.Bt + (size_t)nxt.pn * tstep : cB;
        for (int t = 0; t < nt; t += 2) {
            const bool last = (t == nt - 2);
            const char* a1 = cA + (size_t)(t + 1) * kstep;
            const char* a2 = last ? nA : cA + (size_t)(t + 2) * kstep; const char* b2 = last ? nB : cB + (size_t)(t + 2) * kstep;
            const char* a3 = a2 + kstep; const char* b3 = b2 + kstep;
            if (last && has_next) S.a_ready(nxt);
            if constexpr (SP2) {
            PG8_LDB(B0, 0, 0); PG8_LDB(B1, 0, 1); PG8_SCHED; PG8_LDA(At, 0, 0); PG8_STAGE(PG8_SA(1, 1), a1 + hstep, voffA);
            PG8_WAIT_V(8); PG8_WAIT_L(0); PG8_BAR; PG8_MMA(0, 0, At, B0); PG8_MMA(0, 1, At, B1); PG8_BAR; PG8_SCHED;
            PG8_LDA(At, 0, 1); PG8_STAGE(PG8_SB(0, 0), b2, voffB); PG8_STAGE(PG8_SB(0, 1), b2 + hstep, voffB); PG8_STAGE(PG8_SA(0, 0), a2, voffA);
            PG8_WAIT_V(8); PG8_WAIT_L(0); PG8_BAR; PG8_MMA(1, 0, At, B0); PG8_MMA(1, 1, At, B1); PG8_BAR; PG8_SCHED;
            PG8_LDB(B0, 1, 0); PG8_LDB(B1, 1, 1); PG8_SCHED; PG8_LDA(At, 1, 0); PG8_STAGE(PG8_SA(0, 1), a2 + hstep, voffA);
            PG8_WAIT_V(8); PG8_WAIT_L(0); PG8_BAR; PG8_MMA(0, 0, At, B0); PG8_MMA(0, 1, At, B1); PG8_BAR; PG8_SCHED;
            PG8_LDA(At, 1, 1); PG8_STAGE(PG8_SB(1, 0), b3, voffB); PG8_STAGE(PG8_SB(1, 1), b3 + hstep, voffB); PG8_STAGE(PG8_SA(1, 0), a3, voffA);
            PG8_WAIT_V(8); PG8_WAIT_L(0); PG8_BAR; PG8_MMA(1, 0, At, B0); PG8_MMA(1, 1, At, B1); PG8_BAR; PG8_SCHED;
            } else {
            PG8_LDB(B0, 0, 0); PG8_SCHED; PG8_LDA(At, 0, 0); PG8_STAGE(PG8_SA(1, 1), a1 + hstep, voffA);
            PG8_WAIT_L(8); PG8_BAR; PG8_WAIT_L(0); PG8_MMA(0, 0, At, B0); PG8_BAR; PG8_SCHED;
            PG8_LDB(B1, 0, 1); PG8_STAGE(PG8_SB(0, 0), b2, voffB);
            PG8_BAR; PG8_WAIT_L(0); PG8_MMA(0, 1, At, B1); PG8_BAR;
            PG8_LDA(At, 0, 1); PG8_STAGE(PG8_SA(0, 0), a2, voffA);
            PG8_BAR; PG8_WAIT_L(0); PG8_MMA(1, 0, At, B0); PG8_BAR; PG8_SCHED;
            PG8_STAGE(PG8_SB(0, 1), b2 + hstep, voffB);
            PG8_WAIT_V(6); PG8_BAR; PG8_MMA(1, 1, At, B1); PG8_BAR;
            PG8_LDB(B0, 1, 0); PG8_SCHED; PG8_LDA(At, 1, 0); PG8_STAGE(PG8_SA(0, 1), a2 + hstep, voffA);
            PG8_WAIT_L(8); PG8_BAR; PG8_WAIT_L(0); PG8_MMA(0, 0, At, B0); PG8_BAR; PG8_SCHED;
            PG8_LDB(B1, 1, 1); PG8_STAGE(PG8_SB(1, 0), b3, voffB);
            PG8_BAR; PG8_WAIT_L(0); PG8_MMA(0, 1, At, B1); PG8_BAR;
            PG8_LDA(At, 1, 1); PG8_STAGE(PG8_SA(1, 0), a3, voffA);
            PG8_BAR; PG8_WAIT_L(0); PG8_MMA(1, 0, At, B0); PG8_BAR; PG8_SCHED;
            PG8_STAGE(PG8_SB(1, 1), b3 + hstep, voffB);
            PG8_WAIT_V(6); PG8_BAR; PG8_MMA(1, 1, At, B1); PG8_BAR;
            }
        }
        if constexpr (ALIGN_EPI) { if (wr == 0) PG8_BAR; }
        if constexpr (!Epi::AFTER_DRAIN) { E(acc, cur, wr, wc, fr, fq); S.done(cur); }
        if (!has_next) break;
#pragma unroll
        for (int a = 0; a < 2; ++a)
#pragma unroll
            for (int b = 0; b < 2; ++b)
#pragma unroll
                for (int m = 0; m < 4; ++m)
#pragma unroll
                    for (int n = 0; n < 2; ++n) acc[a][b][m][n] = (f32x4){0.f, 0.f, 0.f, 0.f};
        cur = nxt; cA = nA; cB = nB; ++ui;
        if constexpr (ALIGN_EPI) { if (wr == 1) PG8_BAR; }
    }
    PG8_WAIT_V(0);
    if constexpr (!ALIGN_EPI) { if (wr == 0) PG8_BAR; }
    PG8_BAR;
    if constexpr (Epi::AFTER_DRAIN) { E.fused(acc, cur, wr, wc, fr, fq, lds, wid, lane); S.done(cur); }
#undef PG8_SA
#undef PG8_SB
#undef PG8_STAGE
#undef PG8_LDA
#undef PG8_LDB
#undef PG8_MMA
#undef PG8_WAIT_V
#undef PG8_WAIT_L
#undef PG8_BAR
#undef PG8_SCHED
}
}
struct Args { const float* in[13]; float* out; unsigned char* ws; int ph_lo, ph_hi; };

template <bool PERMUTE>
__device__ __forceinline__ void p0_transpose_item(const float* W, int K, int N, int NPOS, bf16_t* WT, LAS float* scr, int item, int lane) {
    const int nblk = NPOS / 32, kb = item / nblk, nb = item % nblk, k0 = 64 * kb, n0 = 32 * nb;
    const int pos = n0 + (lane & 31);
    const int col = PERMUTE ? win_src_col(pos) : pos;
#pragma unroll 8
    for (int i = 0; i < 32; ++i) { const int kk = 2 * i + (lane >> 5); scr[kk * 33 + (lane & 31)] = (col >= 0) ? W[(size_t)(k0 + kk) * N + col] : 0.f; }
    asm volatile("s_waitcnt lgkmcnt(0)" ::: "memory");
    const int c = lane & 7;
#pragma unroll
    for (int j = 0; j < 4; ++j) { const int n = (lane >> 3) + 8 * j; const LAS float* s = scr + (8 * c) * 33 + n;
        u32x4 o; o.x = pk2(s[0 * 33], s[1 * 33]); o.y = pk2(s[2 * 33], s[3 * 33]); o.z = pk2(s[4 * 33], s[5 * 33]); o.w = pk2(s[6 * 33], s[7 * 33]);
        *(u32x4*)(WT + (size_t)(n0 + n) * K + k0 + 8 * c) = o; }
    asm volatile("s_waitcnt lgkmcnt(0)" ::: "memory");
}
__device__ __forceinline__ void row_to_bf16(const float* src, bf16_t* dst, int lane) {
    const f32x4* s = (const f32x4*)src + lane; u32x2* d = (u32x2*)dst + lane;
    f32x4 v[4];
#pragma unroll
    for (int j = 0; j < 4; ++j) v[j] = s[64 * j];
#pragma unroll
    for (int j = 0; j < 4; ++j) { u32x2 w; w.x = pk2(v[j][0], v[j][1]); w.y = pk2(v[j][2], v[j][3]); d[64 * j] = w; }
}
__device__ __forceinline__ void sincos_tab(double x, float& s, float& c) {
    const double k = rint(x * 0.15915494309189535);
    double r = fma(-k, 6.283185307179586, x); r = fma(-k, 2.4492935982947064e-16, r);
    const double r2 = r * r;
    double ps = 1.0, pc = 1.0;
#pragma unroll
    for (int n = 29; n >= 3; n -= 2) ps = 1.0 - ps * r2 * (1.0 / (double)((n - 1) * n));
#pragma unroll
    for (int n = 28; n >= 2; n -= 2) pc = 1.0 - pc * r2 * (1.0 / (double)((n - 1) * n));
    s = (float)(r * ps); c = (float)pc;
}

__device__ __forceinline__ void phase0(const Args& a, unsigned char* lds, int tid, int wave, int lane, int bid, int G) {
    unsigned char* ws = a.ws;
    for (int it = bid; it < 192; it += G) {
        float* s_c = (float*)lds; float* red = (float*)(lds + 16384);
        for (int i = tid; i < 4096; i += NTHREADS) { const float v = a.in[1][i]; s_c[i] = v / (1.0f + expf(-v)); }
        __syncthreads();
        const int g = tid & 7, ks = tid >> 3, n0 = 32 * it;
        f32x4 acc[4];
#pragma unroll
        for (int b = 0; b < 4; ++b) acc[b] = (f32x4){0.f, 0.f, 0.f, 0.f};
#pragma unroll 4
        for (int i = 0; i < 16; ++i) { const int k = ks + 64 * i; const f32x4 w = *(const f32x4*)(a.in[2] + (size_t)k * 6144 + n0 + 4 * g);
#pragma unroll
            for (int b = 0; b < 4; ++b) acc[b] += w * s_c[b * 1024 + k]; }
#pragma unroll
        for (int b = 0; b < 4; ++b) *(f32x4*)(red + (ks * 8 + g) * 16 + 4 * b) = acc[b];
        __syncthreads();
        if (tid < 128) { const int b = tid >> 5, col = tid & 31, gg = col >> 2, e = col & 3; float s = 0.f;
            for (int k2 = 0; k2 < 64; ++k2) s += red[(k2 * 8 + gg) * 16 + 4 * b + e];
            ((float*)(ws + WS_MOD))[b * 6144 + n0 + col] = s + a.in[3][n0 + col]; }
        __syncthreads();
    }
    for (int it = bid; it < 256; it += G) {
        const int hp = it >> 4, k0 = 64 * (it & 15);
        float* skl = (float*)lds; float* wql = skl + 128 * 129;
        for (int i = tid; i < 4096; i += NTHREADS) { const int n = i >> 5, d4 = i & 31; const f32x4 v = *(const f32x4*)(a.in[9] + (size_t)hp * 16384 + n * 128 + 4 * d4);
            float* q = skl + n * 129 + 4 * d4; q[0] = v[0]; q[1] = v[1]; q[2] = v[2]; q[3] = v[3]; }
        for (int i = tid; i < 2048; i += NTHREADS) { const int k = i >> 5, d4 = i & 31; const f32x4 v = *(const f32x4*)(a.in[8] + (size_t)(k0 + k) * 2048 + hp * 128 + 4 * d4);
            float* q = wql + k * 129 + 4 * d4; q[0] = v[0]; q[1] = v[1]; q[2] = v[2]; q[3] = v[3]; }
        __syncthreads();
        const int k = tid & 63, ng = tid >> 6;
        float acc[16];
#pragma unroll
        for (int j = 0; j < 16; ++j) acc[j] = 0.f;
        for (int d = 0; d < 128; ++d) { const float av = wql[k * 129 + d];
#pragma unroll
            for (int j = 0; j < 16; ++j) acc[j] += av * skl[(16 * ng + j) * 129 + d]; }
        bf16_t* wt = (bf16_t*)(ws + WS_WPQ);
#pragma unroll
        for (int j = 0; j < 16; ++j) wt[(size_t)(hp * 128 + 16 * ng + j) * 1024 + k0 + k] = (bf16_t)f2bf(acc[j]);
        __syncthreads();
    }
    const int gw = bid * 8 + wave, NGW = G * 8;
    {
        LAS float* scr = (LAS float*)(lds + wave * 16384);
        constexpr int I_IN = 16 * (N1 / 32), I_OUT = 16 * 32;
        for (int it = gw; it < I_IN + I_OUT; it += NGW) {
            if (it < I_IN) p0_transpose_item<true>(a.in[5], 1024, 4168, N1, (bf16_t*)(ws + WS_WIN), scr, it, lane);
            else p0_transpose_item<false>(a.in[6], 1024, 1024, 1024, (bf16_t*)(ws + WS_WOUT), scr, it - I_IN, lane);
        }
    }
    for (int r = gw; r < 16384; r += NGW) row_to_bf16(a.in[11] + (size_t)r * 1024, (bf16_t*)(ws + WS_VBF) + (size_t)r * 1024, lane);
    for (int i = bid * NTHREADS + tid; i < 4096 * 96; i += G * NTHREADS) {
        int pos, f; double r; float* ct; float* st; int idx;
        if (i < 4096 * 32) { pos = i >> 5; f = i & 31; r = 0.74989420933245582730; ct = (float*)(ws + WS_COSA); st = (float*)(ws + WS_SINA); idx = i; }
        else { const int j = i - 4096 * 32; pos = j >> 6; f = j & 63; r = 0.86398844948396852897; ct = (float*)(ws + WS_COSR); st = (float*)(ws + WS_SINR); idx = j; }
        double v = 1.0; for (int t = 0; t < f; ++t) v *= r;
        const float invf = (float)v; const float ang = (float)pos * invf;
        float s, c; sincos_tab((double)ang, s, c);
        ct[idx] = c; st[idx] = s;
    }
}

__device__ __forceinline__ void phase1(const Args& a, int wave, int lane, int bid, int G) {
    unsigned char* ws = a.ws;
    const float* mod = (const float*)(ws + WS_MOD);
    const int gw = bid * 8 + wave, NGW = G * 8;
    for (int r = gw; r < MTOK; r += NGW) {
        const int b = r >> 12;
        const f32x4* xr = (const f32x4*)(a.in[0] + (size_t)r * DM) + lane;
        f32x4 v[4]; float ss = 0.f;
#pragma unroll
        for (int j = 0; j < 4; ++j) { v[j] = xr[64 * j]; ss += (v[j][0] * v[j][0] + v[j][1] * v[j][1]) + (v[j][2] * v[j][2] + v[j][3] * v[j][3]); }
        const float rstd = 1.0f / sqrtf(wave_sum(ss) * (1.0f / DM) + EPS);
        u32x2* o = (u32x2*)((bf16_t*)(ws + WS_BUFA) + (size_t)r * DM) + lane;
#pragma unroll
        for (int j = 0; j < 4; ++j) { const int c = 256 * j + 4 * lane;
            const f32x4 g = *(const f32x4*)(a.in[4] + c), sc = *(const f32x4*)(mod + b * 6144 + 1024 + c), sh = *(const f32x4*)(mod + b * 6144 + c);
            const f32x4 h = v[j] * rstd * g * (sc + 1.0f) + sh;
            u32x2 w; w.x = pk2(h[0], h[1]); w.y = pk2(h[2], h[3]); o[64 * j] = w; }
    }
    for (int n = gw; n < 2048; n += NGW) {
        const u32x4* wr = (const u32x4*)((const bf16_t*)(ws + WS_WPQ) + (size_t)n * 1024);
        const u32x4 w0 = wr[lane], w1 = wr[64 + lane];
        float wf[16];
#pragma unroll
        for (int i = 0; i < 4; ++i) { wf[2 * i] = bf_lo(w0[i]); wf[2 * i + 1] = bf_hi(w0[i]); wf[8 + 2 * i] = bf_lo(w1[i]); wf[8 + 2 * i + 1] = bf_hi(w1[i]); }
#pragma unroll
        for (int b = 0; b < 4; ++b) { const float* sh = mod + b * 6144 + 3072; float s = 0.f;
#pragma unroll
            for (int i = 0; i < 8; ++i) s += wf[i] * sh[8 * lane + i] + wf[8 + i] * sh[512 + 8 * lane + i];
            s = wave_sum(s);
            if (lane == 0) ((float*)(ws + WS_BIASF))[b * 2048 + n] = s; }
    }
}

constexpr int SCP = 8200;
__device__ __forceinline__ void select_row(int b, int t, const unsigned char* ldsrow, unsigned long long* MASK, int lane) {
    const int nreg = (t >> 6) + 1;
    unsigned key[64];
#pragma unroll
    for (int j = 0; j < 64; ++j) {
        unsigned k = 0;
        if (j < nreg) { k = *(const unsigned short*)(ldsrow + 2 * lane + 128 * j); if (lane > t - 64 * j) k = 0; }
        key[j] = k;
    }
    unsigned mw_lo = 0u, mw_hi = 0u;
    if (t < 256) {
#pragma unroll
        for (int j = 0; j < 4; ++j) { const unsigned long long w = __ballot(key[j] != 0u); asm volatile("s_nop 1\n\tv_writelane_b32 %0, %2, %4\n\tv_writelane_b32 %1, %3, %4\n\ts_nop 0" : "+v"(mw_lo), "+v"(mw_hi) : "s"((unsigned)w), "s"((unsigned)(w >> 32)), "n"(j));     }
    } else {
        unsigned T = 0;
#pragma unroll 1
        for (int bit = 15; bit >= 0; --bit) {
            const unsigned cand = T | (1u << bit);
            int cnt = 0;
#pragma unroll
            for (int jb = 0; jb < 16; ++jb) {
                if (4 * jb < nreg) {
#pragma unroll
                    for (int j = 4 * jb; j < 4 * jb + 4; ++j) cnt += __popcll(__ballot(key[j] >= cand));
                }
                __builtin_amdgcn_sched_barrier(0);
            }
            if (cnt >= 256) T = cand;
        }
        int cgt = 0;
#pragma unroll
        for (int jb = 0; jb < 16; ++jb) {
            if (4 * jb < nreg) {
#pragma unroll
                for (int j = 4 * jb; j < 4 * jb + 4; ++j) cgt += __popcll(__ballot(key[j] > T));
            }
            __builtin_amdgcn_sched_barrier(0);
        }
        int need = 256 - cgt;
#pragma unroll
        for (int jb = 0; jb < 32; ++jb) {
            if (2 * jb < nreg) {
#pragma unroll
                for (int j = 2 * jb; j < 2 * jb + 2; ++j) {
                    const bool gt = key[j] > T, eq = key[j] == T;
                    const unsigned long long em = __ballot(eq);
                    const int c = __popcll(em), take = c < need ? c : need;
                    const int rank = (int)__builtin_amdgcn_mbcnt_hi((unsigned)(em >> 32), __builtin_amdgcn_mbcnt_lo((unsigned)em, 0u));
                    const unsigned long long w = __ballot(gt || (eq && rank < take));
                    need -= take;
                    asm volatile("s_nop 1\n\tv_writelane_b32 %0, %2, %4\n\tv_writelane_b32 %1, %3, %4\n\ts_nop 0" : "+v"(mw_lo), "+v"(mw_hi) : "s"((unsigned)w), "s"((unsigned)(w >> 32)), "n"(j));
                }
            }
            __builtin_amdgcn_sched_barrier(0);
        }
    }
    MASK[((size_t)b * SEQ + t) * 64 + lane] = ((unsigned long long)mw_hi << 32) | mw_lo;
}
__device__ __forceinline__ void idx_unit(int b, int qt, const bf16_t* QI, const bf16_t* KI, const float* WI, unsigned long long* MASK, unsigned char* lds, int wave, int lane) {
    const int t0 = 16 * qt, qn = lane & 15, g = lane >> 4;
    const size_t rowq = (size_t)b * SEQ + t0 + qn;
    bf16x8 qf[8][2]; float wi[8];
#pragma unroll
    for (int h = 0; h < 8; ++h)
#pragma unroll
        for (int ks = 0; ks < 2; ++ks) qf[h][ks] = *(const bf16x8*)(QI + rowq * 512 + h * 64 + ks * 32 + 8 * g);
    { const f32x4 w0 = *(const f32x4*)(WI + rowq * 8), w1 = *(const f32x4*)(WI + rowq * 8 + 4);
#pragma unroll
      for (int e = 0; e < 4; ++e) { wi[e] = w0[e]; wi[4 + e] = w1[e]; } }
    for (int kt = wave; kt <= qt; kt += 8) {
        const int s0 = 16 * kt;
        const bf16_t* kr = KI + ((size_t)b * SEQ + s0 + qn) * 64 + 8 * g;
        const bf16x8 a0 = *(const bf16x8*)kr, a1 = *(const bf16x8*)(kr + 32);
        f32x4 sc = (f32x4){0.f, 0.f, 0.f, 0.f};
#pragma unroll
        for (int h = 0; h < 8; ++h) {
            f32x4 d = mfma16(a0, qf[h][0], (f32x4){0.f, 0.f, 0.f, 0.f}); d = mfma16(a1, qf[h][1], d);
#pragma unroll
            for (int r = 0; r < 4; ++r) sc[r] += wi[h] * fmaxf(d[r], 0.f);
        }
        unsigned k[4];
#pragma unroll
        for (int r = 0; r < 4; ++r) k[r] = (s0 + 4 * g + r <= t0 + qn) ? sortable16(sc[r]) : 0u;
        u32x2 pk; pk.x = k[0] | (k[1] << 16); pk.y = k[2] | (k[3] << 16);
        *(u32x2*)(lds + qn * SCP + 2 * (s0 + 4 * g)) = pk;
    }
    __syncthreads();
#ifndef NO_SEL
#pragma unroll 1
    for (int qq = 2 * wave; qq < 2 * wave + 2; ++qq) select_row(b, t0 + qq, lds + qq * SCP, MASK, lane);
#endif
    __syncthreads();
}

__device__ __forceinline__ void ret_state_unit(int b, int h, int vb, const bf16_t* KR, const bf16_t* VR, bf16_t* STATE, unsigned char* lds, int tid, int wave, int lane) {
    constexpr int PT = 272, KT_BYTES = 128 * PT, BUF = KT_BYTES + 16 * PT;
    const int j = tid & 127, dq = tid >> 7, g = lane >> 4, ln = lane & 15;
    const float g128 = ret_g128(h), g127 = ret_g127(h), gam = ret_gamma(h);
    f32x4 st = (f32x4){0.f, 0.f, 0.f, 0.f};
    u32x4 kreg[4], vreg = (u32x4){0u, 0u, 0u, 0u};
#define RS_LOAD(n) do { const size_t row = (size_t)b * SEQ + (n) * 128 + j; const u32x4* p = (const u32x4*)(KR + row * 512 + h * 128 + 32 * dq); \
        kreg[0] = p[0]; kreg[1] = p[1]; kreg[2] = p[2]; kreg[3] = p[3]; if (tid < 256) vreg = *(const u32x4*)(VR + row * 512 + h * 128 + 16 * vb + 8 * dq); } while (0)
    RS_LOAD(0);
#pragma unroll 1
    for (int n = 0; n < 32; ++n) {
        unsigned char* buf = lds + (n & 1) * BUF;
#pragma unroll
        for (int i = 0; i < 4; ++i)
#pragma unroll
            for (int e = 0; e < 4; ++e) { const unsigned w = kreg[i][e]; const int d = 32 * dq + 8 * i + 2 * e;
                *(unsigned short*)(buf + d * PT + 2 * j) = (unsigned short)(w & 0xffffu); *(unsigned short*)(buf + (d + 1) * PT + 2 * j) = (unsigned short)(w >> 16); }
        if (tid < 256) {
#pragma unroll
            for (int e = 0; e < 4; ++e) { const unsigned w = vreg[e]; const int v = 8 * dq + 2 * e;
                *(unsigned short*)(buf + KT_BYTES + v * PT + 2 * j) = (unsigned short)(w & 0xffffu); *(unsigned short*)(buf + KT_BYTES + (v + 1) * PT + 2 * j) = (unsigned short)(w >> 16); }
        }
        if (n < 31) RS_LOAD(n + 1);
        __syncthreads();
        { bf16_t* sp = STATE + ((((size_t)b * 4 + h) * 32 + n) * 128 + 16 * vb + 4 * g) * 128 + 16 * wave + ln;
#pragma unroll
          for (int r = 0; r < 4; ++r) sp[r * 128] = (bf16_t)f2bf(gam * st[r]); }
        f32x4 c = (f32x4){0.f, 0.f, 0.f, 0.f};
#pragma unroll
        for (int ks = 0; ks < 4; ++ks) {
            const bf16x8 af = *(const bf16x8*)(buf + KT_BYTES + ln * PT + 2 * (32 * ks + 8 * g));
            const bf16x8 bf = *(const bf16x8*)(buf + (16 * wave + ln) * PT + 2 * (32 * ks + 8 * g));
            c = mfma16(af, bf, c);
        }
        st = st * g128 + c * g127;
    }
#undef RS_LOAD
    __syncthreads();
}

__device__ __forceinline__ void attn_unit(int b, int h, int qb, const bf16_t* QA, const bf16_t* KA, const bf16_t* VA, const unsigned long long* MASK, bf16_t* AR,
                                          unsigned char* lds, int tid, int wave, int lane) {
    constexpr int KP = 144, KS_BYTES = 64 * KP, BUF = 2 * KS_BYTES;
    const int q0 = 256 * qb, r32 = lane & 31, hi = lane >> 5;
    const int t = q0 + 32 * wave + r32;
    const size_t qrow = (size_t)b * SEQ + t;
    bf16x8 qf[4];
#pragma unroll
    for (int d0 = 0; d0 < 4; ++d0) qf[d0] = *(const bf16x8*)(QA + qrow * 512 + h * 64 + 16 * d0 + 8 * hi);
    const int NT = (q0 + 256) / 64;
    const int key_l = tid >> 3, c8 = tid & 7;
    f32x16 o0, o1;
#pragma unroll
    for (int r = 0; r < 16; ++r) { o0[r] = 0.f; o1[r] = 0.f; }
    float m_run = NEG_INF, l_run = 0.f;
    u32x4 kreg, vreg; unsigned long long mw;
#define AT_LOAD(kt) do { const size_t kr = (size_t)b * SEQ + 64 * (kt) + key_l; kreg = *(const u32x4*)(KA + kr * 512 + h * 64 + 8 * c8); vreg = *(const u32x4*)(VA + kr * 512 + h * 64 + 8 * c8); \
        mw = MASK[qrow * 64 + (kt)]; } while (0)
    AT_LOAD(0);
#pragma unroll 1
    for (int kt = 0; kt < NT; ++kt) {
        unsigned char* buf = lds + (kt & 1) * BUF;
        *(u32x4*)(buf + key_l * KP + 16 * c8) = kreg;
#pragma unroll
        for (int e = 0; e < 4; ++e) { const unsigned w = vreg[e]; const int d = 8 * c8 + 2 * e;
            *(unsigned short*)(buf + KS_BYTES + d * KP + 2 * key_l) = (unsigned short)(w & 0xffffu); *(unsigned short*)(buf + KS_BYTES + (d + 1) * KP + 2 * key_l) = (unsigned short)(w >> 16); }
#ifdef DBG_CAUSAL
        const int nv_ = t - 64 * kt + 1; const unsigned long long mcur = nv_ >= 64 ? ~0ull : nv_ <= 0 ? 0ull : ((1ull << nv_) - 1ull);
#else
        const unsigned long long mcur = mw;
#endif
        if (kt + 1 < NT) AT_LOAD(kt + 1);
        __syncthreads();
        if (64 * kt <= q0 + 32 * wave + 31) {
            f32x16 p0, p1;
#pragma unroll
            for (int r = 0; r < 16; ++r) { p0[r] = 0.f; p1[r] = 0.f; }
#pragma unroll
            for (int d0 = 0; d0 < 4; ++d0) {
                const bf16x8 a0 = *(const bf16x8*)(buf + r32 * KP + 32 * d0 + 16 * hi);
                const bf16x8 a1 = *(const bf16x8*)(buf + (32 + r32) * KP + 32 * d0 + 16 * hi);
                p0 = mfma32(a0, qf[d0], p0); p1 = mfma32(a1, qf[d0], p1);
            }
            const unsigned wl = (unsigned)mcur >> (4 * hi), wh = (unsigned)(mcur >> 32) >> (4 * hi);
            float mx = NEG_INF;
#pragma unroll
            for (int r = 0; r < 16; ++r) { const int bp = (r & 3) + 8 * (r >> 2);
                p0[r] = ((wl >> bp) & 1u) ? p0[r] : NEG_INF; p1[r] = ((wh >> bp) & 1u) ? p1[r] : NEG_INF;
                mx = fmaxf(mx, fmaxf(p0[r], p1[r])); }
            mx = fmaxf(mx, __shfl_xor(mx, 32));
            const float m_new = fmaxf(m_run, mx);
            const float m_use = (m_new == NEG_INF) ? 0.f : m_new;
            const float alpha = fast_exp2(m_run - m_use);
            m_run = m_new;
            float ps = 0.f;
#pragma unroll
            for (int r = 0; r < 16; ++r) { p0[r] = fast_exp2(p0[r] - m_use); p1[r] = fast_exp2(p1[r] - m_use); ps += p0[r] + p1[r]; }
            l_run = l_run * alpha + ps;
#pragma unroll
            for (int r = 0; r < 16; ++r) { o0[r] *= alpha; o1[r] *= alpha; }
#pragma unroll
            for (int s4 = 0; s4 < 4; ++s4) {
                const int rb = 8 * (s4 & 1);
                u32x4 pw;
                if (s4 < 2) { pw.x = pk2(p0[rb], p0[rb + 1]); pw.y = pk2(p0[rb + 2], p0[rb + 3]); pw.z = pk2(p0[rb + 4], p0[rb + 5]); pw.w = pk2(p0[rb + 6], p0[rb + 7]); }
                else        { pw.x = pk2(p1[rb], p1[rb + 1]); pw.y = pk2(p1[rb + 2], p1[rb + 3]); pw.z = pk2(p1[rb + 4], p1[rb + 5]); pw.w = pk2(p1[rb + 6], p1[rb + 7]); }
                const bf16x8 bfr = __builtin_bit_cast(bf16x8, pw);
                { const unsigned char* vp = buf + KS_BYTES + r32 * KP + 2 * (16 * s4 + 4 * hi);
                  const u32x2 lo = *(const u32x2*)vp, h2 = *(const u32x2*)(vp + 16); const u32x4 av = (u32x4){lo.x, lo.y, h2.x, h2.y};
                  o0 = mfma32(__builtin_bit_cast(bf16x8, av), bfr, o0); }
                { const unsigned char* vp = buf + KS_BYTES + (32 + r32) * KP + 2 * (16 * s4 + 4 * hi);
                  const u32x2 lo = *(const u32x2*)vp, h2 = *(const u32x2*)(vp + 16); const u32x4 av = (u32x4){lo.x, lo.y, h2.x, h2.y};
                  o1 = mfma32(__builtin_bit_cast(bf16x8, av), bfr, o1); }
            }
        }
    }
#undef AT_LOAD
    l_run += __shfl_xor(l_run, 32);
#ifdef DBG_NOATT
    const float inv = 0.f;
#else
    const float inv = 1.0f / l_run;
#endif
    bf16_t* op = AR + qrow * 1024 + h * 64 + 4 * hi;
#pragma unroll
    for (int c = 0; c < 4; ++c) {
        u32x2 w; w.x = pk2(o0[4 * c] * inv, o0[4 * c + 1] * inv); w.y = pk2(o0[4 * c + 2] * inv, o0[4 * c + 3] * inv); *(u32x2*)(op + 8 * c) = w;
        u32x2 v; v.x = pk2(o1[4 * c] * inv, o1[4 * c + 1] * inv); v.y = pk2(o1[4 * c + 2] * inv, o1[4 * c + 3] * inv); *(u32x2*)(op + 32 + 8 * c) = v;
    }
    __syncthreads();
}

__device__ __forceinline__ void ret_out_unit(int b, int h, int n, const bf16_t* QR, const bf16_t* KR, const bf16_t* VR, const bf16_t* GR, const bf16_t* STATE, bf16_t* AR,
                                             unsigned char* lds, int tid, int wave, int lane) {
    constexpr int PT = 272;
    const size_t c0 = (size_t)b * SEQ + 128 * n; const int hc = 128 * h;
    { const int j = tid & 127, vq = tid >> 7; const u32x4* p = (const u32x4*)(VR + (c0 + j) * 512 + hc + 32 * vq);
      u32x4 rr[4]; rr[0] = p[0]; rr[1] = p[1]; rr[2] = p[2]; rr[3] = p[3];
#pragma unroll
      for (int i = 0; i < 4; ++i)
#pragma unroll
          for (int e = 0; e < 4; ++e) { const unsigned w = rr[i][e]; const int v = 32 * vq + 8 * i + 2 * e;
              *(unsigned short*)(lds + v * PT + 2 * j) = (unsigned short)(w & 0xffffu); *(unsigned short*)(lds + (v + 1) * PT + 2 * j) = (unsigned short)(w >> 16); } }
    __syncthreads();
    const int ln = lane & 15, g = lane >> 4;
    const size_t qrow = c0 + 16 * wave + ln;
    bf16x8 qf[4];
#pragma unroll
    for (int ks = 0; ks < 4; ++ks) qf[ks] = *(const bf16x8*)(QR + qrow * 512 + hc + 32 * ks + 8 * g);
    f32x4 sT[8];
#pragma unroll
    for (int jt = 0; jt < 8; ++jt) {
        f32x4 d = (f32x4){0.f, 0.f, 0.f, 0.f};
        if (jt <= wave) {
            const bf16_t* kp = KR + (c0 + 16 * jt + ln) * 512 + hc + 8 * g;
#pragma unroll
            for (int ks = 0; ks < 4; ++ks) d = mfma16(*(const bf16x8*)(kp + 32 * ks), qf[ks], d);
            if (jt == wave) {
#pragma unroll
                for (int r = 0; r < 4; ++r) if (4 * g + r > ln) d[r] = 0.f;
            }
        }
        sT[jt] = d;
    }
    f32x4 oT[8];
    const bf16_t* stp = STATE + (((size_t)b * 4 + h) * 32 + n) * 16384;
#pragma unroll
    for (int vt = 0; vt < 8; ++vt) {
        f32x4 d = (f32x4){0.f, 0.f, 0.f, 0.f};
#pragma unroll
        for (int ks = 0; ks < 4; ++ks) d = mfma16(*(const bf16x8*)(stp + (16 * vt + ln) * 128 + 32 * ks + 8 * g), qf[ks], d);
        oT[vt] = d;
    }
#pragma unroll
    for (int pr = 0; pr < 4; ++pr) if (2 * pr <= wave) {
        u32x4 pw; pw.x = pk2(sT[2 * pr][0], sT[2 * pr][1]); pw.y = pk2(sT[2 * pr][2], sT[2 * pr][3]); pw.z = pk2(sT[2 * pr + 1][0], sT[2 * pr + 1][1]); pw.w = pk2(sT[2 * pr + 1][2], sT[2 * pr + 1][3]);
        const bf16x8 bfr = __builtin_bit_cast(bf16x8, pw);
#pragma unroll
        for (int vt = 0; vt < 8; ++vt) {
            const unsigned char* vp = lds + (16 * vt + ln) * PT + 2 * (32 * pr + 4 * g);
            const u32x2 lo = *(const u32x2*)vp, h2 = *(const u32x2*)(vp + 32); const u32x4 av = (u32x4){lo.x, lo.y, h2.x, h2.y};
            oT[vt] = mfma16(__builtin_bit_cast(bf16x8, av), bfr, oT[vt]);
        }
    }
    float s = 0.f;
#pragma unroll
    for (int vt = 0; vt < 8; ++vt) s += (oT[vt][0] + oT[vt][1]) + (oT[vt][2] + oT[vt][3]);
    s += __shfl_xor(s, 16); s += __shfl_xor(s, 32);
    const float mean = s * (1.0f / 128.0f);
    float q = 0.f;
#pragma unroll
    for (int vt = 0; vt < 8; ++vt)
#pragma unroll
        for (int r = 0; r < 4; ++r) { const float d = oT[vt][r] - mean; q += d * d; }
    q += __shfl_xor(q, 16); q += __shfl_xor(q, 32);
    const float rstd = 1.0f / sqrtf(q * (1.0f / 128.0f) + EPS);
#pragma unroll
    for (int vt = 0; vt < 8; ++vt) {
        const u32x2 gw = *(const u32x2*)(GR + qrow * 512 + hc + 16 * vt + 4 * g);
        const float y0 = (oT[vt][0] - mean) * rstd * bf_lo(gw.x), y1 = (oT[vt][1] - mean) * rstd * bf_hi(gw.x);
        const float y2 = (oT[vt][2] - mean) * rstd * bf_lo(gw.y), y3 = (oT[vt][3] - mean) * rstd * bf_hi(gw.y);
        u32x2 w; w.x = pk2(y0, y1); w.y = pk2(y2, y3);
#ifdef DBG_NORET
        w.x = 0u; w.y = 0u;
#endif
        *(u32x2*)(AR + qrow * 1024 + 512 + hc + 16 * vt + 4 * g) = w;
    }
    __syncthreads();
}

template <int N> __device__ __forceinline__ void bitonic_sort_desc(unsigned (&a)[N]) {
#pragma unroll
    for (int k = 2; k <= N; k <<= 1)
#pragma unroll
        for (int j = k >> 1; j > 0; j >>= 1)
#pragma unroll
            for (int i = 0; i < N; ++i) { const int l = i ^ j;
                if (l > i) { const unsigned x = a[i], y = a[l]; const unsigned mx = x > y ? x : y, mn = x > y ? y : x;
                    if ((i & k) == 0) { a[i] = mx; a[l] = mn; } else { a[i] = mn; a[l] = mx; } } }
}
template <int N> __device__ __forceinline__ void bitonic_merge_desc(unsigned (&a)[N]) {
#pragma unroll
    for (int j = N >> 1; j > 0; j >>= 1)
#pragma unroll
        for (int i = 0; i < N; ++i) { const int l = i ^ j;
            if (l > i) { const unsigned x = a[i], y = a[l]; a[i] = x > y ? x : y; a[l] = x > y ? y : x; } }
}
__device__ __forceinline__ void top16_merge(unsigned (&best)[16], const unsigned (&grp)[16]) {
#pragma unroll
    for (int i = 0; i < 16; ++i) { const unsigned x = best[i], y = grp[15 - i]; best[i] = x > y ? x : y; }
    bitonic_merge_desc<16>(best);
}
struct CandTab { int a[64], b[64], n; constexpr CandTab() : a{}, b{}, n(0) { for (int x = 0; x < 16; ++x) for (int y = 0; y < 16; ++y) if ((x + 1) * (y + 1) <= 16) { a[n] = x; b[n] = y; ++n; } } };
constexpr CandTab kCand{};
static_assert(kCand.n == 50, "staircase candidates");

constexpr int PL_EID = 0, PL_GATE = 16384, PL_IDX = 32768;
__device__ __forceinline__ void peer_unit(int unit, unsigned char* ws, float* outp, const float* gffn, const float* gfin, unsigned char* lds, int tid, int wave, int lane) {
    const float* SC = (const float*)(ws + WS_SC);
    const float* mod = (const float*)(ws + WS_MOD);
#ifndef DBG_NOPEER
    {
        const int tl = tid >> 4, h = (tid >> 1) & 7, p = tid & 1;
        const size_t row = (size_t)32 * unit + tl;
        const f32x4* sp = (const f32x4*)(SC + row * 2048 + h * 256 + p * 128);
        unsigned best[16];
#pragma unroll
        for (int grp = 0; grp < 8; ++grp) {
            unsigned k[16];
#pragma unroll
            for (int q4 = 0; q4 < 4; ++q4) { const f32x4 v = sp[4 * grp + q4];
#pragma unroll
                for (int e = 0; e < 4; ++e) k[4 * q4 + e] = (sortable32(v[e]) & ~127u) | (unsigned)(127 - (16 * grp + 4 * q4 + e)); }
            bitonic_sort_desc<16>(k);
            if (grp == 0) {
#pragma unroll
                for (int i = 0; i < 16; ++i) best[i] = k[i];
            } else top16_merge(best, k);
        }
        unsigned char* il = lds + PL_IDX + (tl * 8 + h) * 32;
#pragma unroll
        for (int i = 0; i < 4; ++i) { unsigned w = 0;
#pragma unroll
            for (int e = 0; e < 4; ++e) w |= (127u - (best[4 * i + e] & 127u)) << (8 * e);
            *(unsigned*)(il + p * 16 + 4 * i) = w; }
        float v1[16], v2[16];
#pragma unroll
        for (int i = 0; i < 16; ++i) { const unsigned o = __shfl_xor(best[i], 1); const float mine = unsortable32(best[i] & ~127u), oth = unsortable32(o & ~127u);
            v1[i] = p ? oth : mine; v2[i] = p ? mine : oth; }
        unsigned top[16];
#pragma unroll
        for (int grp = 0; grp < 4; ++grp) {
            unsigned k[16];
#pragma unroll
            for (int i = 0; i < 16; ++i) { const int c = 16 * grp + i;
                k[i] = (c < kCand.n) ? ((sortable32(v1[kCand.a[c < kCand.n ? c : 0]] + v2[kCand.b[c < kCand.n ? c : 0]]) & ~255u) | (unsigned)(255 - (16 * kCand.a[c < kCand.n ? c : 0] + kCand.b[c < kCand.n ? c : 0]))) : 0u; }
            bitonic_sort_desc<16>(k);
            if (grp == 0) {
#pragma unroll
                for (int i = 0; i < 16; ++i) top[i] = k[i];
            } else top16_merge(top, k);
        }
        float ts[16], es[16], sum = 0.f;
#pragma unroll
        for (int i = 0; i < 16; ++i) ts[i] = unsortable32(top[i] & ~255u);
#pragma unroll
        for (int i = 0; i < 16; ++i) { es[i] = __expf(ts[i] - ts[0]); sum += es[i]; }
        const float rs = 1.0f / sum;
        __builtin_amdgcn_wave_barrier(); asm volatile("s_waitcnt lgkmcnt(0)" ::: "memory");
        unsigned* eo = (unsigned*)(lds + PL_EID) + tl * 128 + h * 16;
        float* go = (float*)(lds + PL_GATE) + tl * 128 + h * 16;
#pragma unroll
        for (int i = 0; i < 16; ++i) {
            const unsigned flat = 255u - (top[i] & 255u);
            const unsigned i1 = il[flat >> 4], i2 = il[16 + (flat & 15u)];
            eo[i] = i1 * 128u + i2; go[i] = es[i] * rs;
        }
    }
#endif
    __syncthreads();
    const bf16_t* UBF = (const bf16_t*)(ws + WS_BUFB); const bf16_t* VBF = (const bf16_t*)(ws + WS_VBF);
#pragma unroll 1
    for (int ti = 0; ti < 4; ++ti) {
        const int tl = wave + 8 * ti; const size_t row = (size_t)32 * unit + tl; const int b = (int)(row >> 12);
        const float* mb = mod + b * 6144;
        float x1v[16], hv[16], acc[16];
        const float rstd = pg8::row_rstd((const float*)(ws + WS_SUMSQ), (int)row);
#pragma unroll
        for (int half = 0; half < 2; ++half)
#pragma unroll
            for (int q4 = 0; q4 < 2; ++q4) { const int c = 512 * half + 8 * lane + 4 * q4;
                const f32x4 xv = *(const f32x4*)(outp + row * DM + c), g = *(const f32x4*)(gffn + c), sc = *(const f32x4*)(mb + 4096 + c), sh = *(const f32x4*)(mb + 3072 + c);
#pragma unroll
                for (int e = 0; e < 4; ++e) { const int i = 8 * half + 4 * q4 + e; x1v[i] = xv[e]; hv[i] = xv[e] * rstd * g[e] * (1.0f + sc[e]) + sh[e]; acc[i] = 0.f; } }
        const unsigned* el = (const unsigned*)(lds + PL_EID) + tl * 128; const float* gl = (const float*)(lds + PL_GATE) + tl * 128;
#ifdef DBG_NOPEER
        for (int e0 = 0; e0 < 0; e0 += 4) {
#else
#pragma unroll 1
        for (int e0 = 0; e0 < 128; e0 += 4) {
#endif
            u32x4 uu[4][2], vv[4][2]; float gt[4];
#pragma unroll
            for (int k = 0; k < 4; ++k) { const unsigned eid = el[e0 + k]; gt[k] = gl[e0 + k];
                const u32x4* up = (const u32x4*)(UBF + (size_t)eid * 1024); const u32x4* vp = (const u32x4*)(VBF + (size_t)eid * 1024);
                uu[k][0] = up[lane]; uu[k][1] = up[64 + lane]; vv[k][0] = vp[lane]; vv[k][1] = vp[64 + lane]; }
#pragma unroll
            for (int k = 0; k < 4; ++k) {
                float d = 0.f;
#pragma unroll
                for (int half = 0; half < 2; ++half)
#pragma unroll
                    for (int i = 0; i < 4; ++i) { const unsigned w = uu[k][half][i]; d += hv[8 * half + 2 * i] * bf_lo(w) + hv[8 * half + 2 * i + 1] * bf_hi(w); }
                d = wave_sum(d);
                const float cf = gt[k] * gelu_exact(d);
#pragma unroll
                for (int half = 0; half < 2; ++half)
#pragma unroll
                    for (int i = 0; i < 4; ++i) { const unsigned w = vv[k][half][i]; acc[8 * half + 2 * i] += cf * bf_lo(w); acc[8 * half + 2 * i + 1] += cf * bf_hi(w); }
            }
        }
        float ss = 0.f;
#pragma unroll
        for (int half = 0; half < 2; ++half)
#pragma unroll
            for (int q4 = 0; q4 < 2; ++q4) { const int c = 512 * half + 8 * lane + 4 * q4; const f32x4 gf = *(const f32x4*)(mb + 5120 + c);
#pragma unroll
                for (int e = 0; e < 4; ++e) { const int i = 8 * half + 4 * q4 + e; x1v[i] = x1v[i] + gf[e] * acc[i]; ss += x1v[i] * x1v[i]; } }
        const float r2 = 1.0f / sqrtf(wave_sum(ss) * (1.0f / DM) + EPS);
#pragma unroll
        for (int half = 0; half < 2; ++half)
#pragma unroll
            for (int q4 = 0; q4 < 2; ++q4) { const int c = 512 * half + 8 * lane + 4 * q4; const f32x4 gn = *(const f32x4*)(gfin + c);
                f32x4 o;
#pragma unroll
                for (int e = 0; e < 4; ++e) o[e] = x1v[8 * half + 4 * q4 + e] * r2 * gn[e];
                *(f32x4*)(outp + row * DM + c) = o; }
    }
    __syncthreads();
}

constexpr int N_PHASES = 8;
__global__ void __launch_bounds__(NTHREADS, 2) mega(Args a) {
    extern __shared__ __attribute__((aligned(16))) unsigned char lds[];
    const int tid = threadIdx.x, lane = tid & 63, wave = __builtin_amdgcn_readfirstlane(tid >> 6);
    const int bid = blockIdx.x, G = gridDim.x;
    unsigned char* ws = a.ws;
    const int lo = a.ph_lo, hi = a.ph_hi;
#ifndef PH_MASK
#define PH_MASK 0xFF
#endif
#define IN(k) (((PH_MASK >> (k)) & 1) && lo <= (k) && (k) < hi)
#define SEAM(k) do { if (IN(k) && IN((k) + 1)) { cg::this_grid().sync(); } } while (0)

    if (IN(0)) phase0(a, lds, tid, wave, lane, bid, G);
    SEAM(0);
    if (IN(1)) phase1(a, wave, lane, bid, G);
    SEAM(1);
    if (IN(2)) {
        pg8::Gemm g{(const bf16_t*)(ws + WS_BUFA), (const bf16_t*)(ws + WS_WIN), MTOK, N1, DM}; pg8::StaticOrder S; S.init(MTOK, N1, G, bid);
        pg8::Epi1 E{ws};
        pg8::gemm_phase<pg8::Epi1, pg8::StaticOrder, true, true>((LAS unsigned char*)lds, g, S, E);
    }
    SEAM(2);
    if (IN(3)) {
#ifndef NO_RS
        for (int u = bid; u < 128; u += G)
            ret_state_unit(u >> 5, (u >> 3) & 3, u & 7, (const bf16_t*)(ws + WS_KR), (const bf16_t*)(ws + WS_VR), (bf16_t*)(ws + WS_STATE), lds, tid, wave, lane);
#endif
        for (int k = bid; k < 256; k += G)
#pragma unroll 1
            for (int i = 0; i < 4; ++i) {
                const int b = i, qt = (i < 2) ? k : 255 - k;
                idx_unit(b, qt, (const bf16_t*)(ws + WS_QI), (const bf16_t*)(ws + WS_KI), (const float*)(ws + WS_WI), (unsigned long long*)(ws + WS_MASK), lds, wave, lane);
            }
    }
    SEAM(3);
    if (IN(4)) {
        for (int k = bid; k < 256; k += G) {
            const int bh = k >> 3, s = k & 7;
#pragma unroll 1
            for (int i = 0; i < 2; ++i)
                attn_unit(bh >> 3, bh & 7, i ? 15 - s : s, (const bf16_t*)(ws + WS_QA), (const bf16_t*)(ws + WS_KA), (const bf16_t*)(ws + WS_VA), (const unsigned long long*)(ws + WS_MASK),
                          (bf16_t*)(ws + WS_BUFB), lds, tid, wave, lane);
        }
        for (int u = bid; u < 512; u += G)
            ret_out_unit(u >> 7, (u >> 5) & 3, u & 31, (const bf16_t*)(ws + WS_QR), (const bf16_t*)(ws + WS_KR), (const bf16_t*)(ws + WS_VR), (const bf16_t*)(ws + WS_GR),
                         (const bf16_t*)(ws + WS_STATE), (bf16_t*)(ws + WS_BUFB), lds, tid, wave, lane);
    }
    SEAM(4);
    if (IN(5)) {
        pg8::Gemm g{(const bf16_t*)(ws + WS_BUFB), (const bf16_t*)(ws + WS_WOUT), MTOK, DM, DM}; pg8::StaticOrder S; S.init(MTOK, DM, G, bid);
        pg8::Epi2 E{a.in[0], a.out, (bf16_t*)(ws + WS_BUFA), (const float*)(ws + WS_MOD), a.in[7], (float*)(ws + WS_SUMSQ)};
        pg8::gemm_phase<pg8::Epi2, pg8::StaticOrder, true, true>((LAS unsigned char*)lds, g, S, E);
    }
    SEAM(5);
    if (IN(6)) {
        const int gw = bid * 8 + wave, NGW = G * 8;
        for (int r = gw; r < 16384; r += NGW) row_to_bf16(a.in[10] + (size_t)r * 1024, (bf16_t*)(ws + WS_BUFB) + (size_t)r * 1024, lane);
        __syncthreads();
        pg8::Gemm g{(const bf16_t*)(ws + WS_BUFA), (const bf16_t*)(ws + WS_WPQ), MTOK, 2048, DM}; pg8::StaticOrder S; S.init(MTOK, 2048, G, bid);
        pg8::Epi3 E{(const float*)(ws + WS_SUMSQ), (const float*)(ws + WS_BIASF), (float*)(ws + WS_SC)};
        pg8::gemm_phase<pg8::Epi3, pg8::StaticOrder, true, true>((LAS unsigned char*)lds, g, S, E);
    }
    SEAM(6);
    if (IN(7)) {
        for (int u = bid; u < 512; u += G) peer_unit(u, ws, a.out, a.in[7], a.in[12], lds, tid, wave, lane);
    }
#undef IN
#undef SEAM
}

extern "C" void kernel_launch(void* const* d_in, const int* in_sizes, int n_in, void* d_out, int out_size, void* d_ws, size_t ws_size, hipStream_t stream) {
    static int grid = 0;
    if (grid == 0) {
        if (n_in != 13 || out_size != MTOK * DM || ws_size < WS_END) { fprintf(stderr, "kernel_launch: unexpected shapes (n_in %d, out %d, ws %zu); nothing launched\n", n_in, out_size, ws_size); grid = -1; return; }
        int dev = 0, cus = 0, per_cu = 0;
        if (hipGetDevice(&dev) != hipSuccess || hipDeviceGetAttribute(&cus, hipDeviceAttributeMultiprocessorCount, dev) != hipSuccess) { grid = -1; return; }
        if (hipFuncSetAttribute((const void*)mega, hipFuncAttributeMaxDynamicSharedMemorySize, LDS_BYTES) != hipSuccess) { fprintf(stderr, "kernel_launch: hipFuncSetAttribute failed\n"); grid = -1; return; }
        if (hipOccupancyMaxActiveBlocksPerMultiprocessor(&per_cu, (const void*)mega, NTHREADS, LDS_BYTES) != hipSuccess || per_cu < 1) { fprintf(stderr, "kernel_launch: occupancy query gave %d\n", per_cu); per_cu = 1; }
        (void)hipGetLastError();
        grid = cus;
    }
    if (grid < 0) return;
    Args a{};
    for (int i = 0; i < 13; ++i) a.in[i] = (const float*)d_in[i];
    a.out = (float*)d_out; a.ws = (unsigned char*)d_ws;
#if MK_MULTI
    for (int p = 0; p < N_PHASES; ++p) { a.ph_lo = p; a.ph_hi = p + 1; hipLaunchKernelGGL(mega, dim3(grid), dim3(NTHREADS), LDS_BYTES, stream, a); }
#else
    a.ph_lo = 0; a.ph_hi = N_PHASES;
    void* args[] = {&a};
    const hipError_t e = hipLaunchCooperativeKernel((const void*)mega, dim3(grid), dim3(NTHREADS), args, LDS_BYTES, stream);
    if (e != hipSuccess) fprintf(stderr, "kernel_launch: cooperative launch failed: %s (grid %d)\n", hipGetErrorString(e), grid);
#endif
}
```

```cpp
#include <hip/hip_runtime.h>
#include <cstdio>
#include <cstdint>

#ifndef MK_MULTI
#define MK_MULTI 0
#endif

#define GAS __attribute__((address_space(1)))
#define LAS __attribute__((address_space(3)))
typedef unsigned short bf16_t;
typedef short bf16x8 __attribute__((ext_vector_type(8)));
typedef float f32x4 __attribute__((ext_vector_type(4)));
typedef float f32x16 __attribute__((ext_vector_type(16)));
typedef unsigned u32x4 __attribute__((ext_vector_type(4)));
typedef unsigned u32x2 __attribute__((ext_vector_type(2)));

constexpr int BATCH = 4, SEQ = 4096, DM = 1024, MTOK = BATCH * SEQ;
constexpr int N1 = 4352;
constexpr int NTHREADS = 512;
constexpr float EPS = 1e-6f;
constexpr float C_QK = 0.18033688011112042f;
constexpr float NEG_INF = -__builtin_huge_valf();

__device__ __forceinline__ float ret_log2g(int h) { return h == 0 ? -0.045803689613124791f : h == 1 ? -0.022720076500083530f : h == 2 ? -0.011315313227834147f : -0.0056465631411420624f; }
__device__ __forceinline__ float ret_gamma(int h) { return h == 0 ? 0.96875f : h == 1 ? 0.984375f : h == 2 ? 0.9921875f : 0.99609375f; }
__device__ __forceinline__ float ret_g128(int h) { return h == 0 ? 0.017183023570817902f : h == 1 ? 0.13321516287964842f : h == 2 ? 0.36643771592203725f : 0.60593708822908032f; }
__device__ __forceinline__ float ret_g127(int h) { return h == 0 ? 0.017737314653747512f : h == 1 ? 0.13532968927456347f : h == 2 ? 0.36932305226788007f : 0.60831331210448848f; }

constexpr size_t MiB = 1u << 20;
constexpr size_t WS_CTL = 0, CTL_BYTES = 1 * MiB;
constexpr size_t WS_SUMSQ = 5 * MiB;
constexpr size_t WS_MOD = 1 * MiB;
constexpr size_t WS_BIASF = 1 * MiB + 128 * 1024;
constexpr size_t WS_COSA = 2 * MiB, WS_SINA = 2 * MiB + 512 * 1024;
constexpr size_t WS_COSR = 3 * MiB, WS_SINR = 4 * MiB;
constexpr size_t WS_WIN = 6 * MiB;
constexpr size_t WS_WOUT = 15 * MiB;
constexpr size_t WS_WPQ = 17 * MiB;
constexpr size_t WS_BUFA = 22 * MiB;
constexpr size_t WS_MASK = WS_BUFA, WS_STATE = WS_BUFA + 8 * MiB;
constexpr size_t WS_BUFB = 54 * MiB;
constexpr size_t WS_G1 = 86 * MiB;
constexpr size_t WS_QA = WS_G1, WS_KA = WS_G1 + 16 * MiB, WS_VA = WS_G1 + 32 * MiB, WS_QI = WS_G1 + 48 * MiB, WS_QR = WS_G1 + 64 * MiB,
                 WS_KR = WS_G1 + 80 * MiB, WS_VR = WS_G1 + 96 * MiB, WS_GR = WS_G1 + 112 * MiB, WS_KI = WS_G1 + 128 * MiB, WS_WI = WS_G1 + 130 * MiB;
constexpr size_t WS_SC = WS_G1;
constexpr size_t WS_VBF = 217 * MiB;
constexpr size_t WS_END = 256 * MiB;
static_assert(WS_WI + (size_t)MTOK * 8 * 4 <= WS_VBF && WS_SC + (size_t)MTOK * 2048 * 4 <= WS_VBF && WS_VBF + (size_t)16384 * 1024 * 2 <= WS_END, "ws map");
constexpr int LDS_BYTES = 147456;
constexpr int MISC_OFF = LDS_BYTES - 64;
constexpr int CW_BAR = 4096;

__device__ __forceinline__ unsigned f2bf(float f) { unsigned u = __float_as_uint(f); return (u + 0x7fffu + ((u >> 16) & 1u)) >> 16; }
__device__ __forceinline__ unsigned pk2(float lo, float hi) { return f2bf(lo) | (f2bf(hi) << 16); }
__device__ __forceinline__ float bf_lo(unsigned w) { return __uint_as_float(w << 16); }
__device__ __forceinline__ float bf_hi(unsigned w) { return __uint_as_float(w & 0xffff0000u); }
__device__ __forceinline__ float wave_sum(float v) {
#pragma unroll
    for (int o = 1; o < 64; o <<= 1) v += __shfl_xor(v, o);
    return v;
}
__device__ __forceinline__ float fast_exp2(float x) { return __builtin_amdgcn_exp2f(x); }
__device__ __forceinline__ float gelu_exact(float v) {
    const float av = fabsf(v), t = __builtin_amdgcn_rcpf(av * 0.2316418882f + 1.0f);
    float q = t * 0.5307027145f + (-0.7265760135f); q = q * t + 0.7107068705f; q = q * t + (-0.142248368f); q = q * t + 0.127414796f; q = q * t;
    const float e = fast_exp2(v * v * (-0.72134752044f));
    const float m = v * (q * e);
    return v < 0.f ? m : v - m;
}
__device__ __forceinline__ float silu_f(float v) { return v / (1.0f + __expf(-v)); }
__device__ __forceinline__ unsigned sortable32(float f) { const unsigned u = __float_as_uint(f); return (u & 0x80000000u) ? ~u : (u | 0x80000000u); }
__device__ __forceinline__ float unsortable32(unsigned s) { return __uint_as_float((s & 0x80000000u) ? (s ^ 0x80000000u) : ~s); }
__device__ __forceinline__ unsigned sortable16(float x) {
    const _Float16 h = (_Float16)x; const unsigned b = (unsigned)__builtin_bit_cast(unsigned short, h);
    return (b & 0x8000u) ? (~b & 0xFFFFu) : (b | 0x8000u);
}
__device__ __forceinline__ f32x4 mfma16(bf16x8 a, bf16x8 b, f32x4 c) { return __builtin_amdgcn_mfma_f32_16x16x32_bf16(a, b, c, 0, 0, 0); }
__device__ __forceinline__ f32x16 mfma32(bf16x8 a, bf16x8 b, f32x16 c) { return __builtin_amdgcn_mfma_f32_32x32x16_bf16(a, b, c, 0, 0, 0); }

__host__ __device__ __forceinline__ int win_src_col(int p) {
    const int tile = p >> 8, bj = (p >> 7) & 1, q = p & 127;
    if (tile < 4) return 256 * tile + (q >> 5) * 64 + bj * 32 + (q & 31);
    if (tile < 6) return p;
    if (tile < 8) return 256 * tile + (q >> 5) * 64 + bj * 32 + (q & 31);
    if (tile == 8) { if (q < 32) return 2048 + bj * 32 + q; if (bj == 0 && q < 40) return 2112 + (q - 32); return -1; }
    if (tile < 13) { const int base = (tile < 11) ? 2120 + 256 * (tile - 9) : 2632 + 256 * (tile - 11); return base + (q >> 6) * 128 + bj * 64 + (q & 63); }
    if (tile < 15) return 3144 + (p - 13 * 256);
    return 3656 + (p - 15 * 256);
}
namespace pg8 {
#define PG8_LAS __attribute__((address_space(3)))
typedef unsigned short bf16_t;
typedef short bf16x8 __attribute__((ext_vector_type(8)));
typedef float f32x4 __attribute__((ext_vector_type(4)));
typedef unsigned u32x4 __attribute__((ext_vector_type(4)));
constexpr int BM = 256, BK = 64, HALF = 128, HTB = HALF * BK * 2  , STAGE_BYTES = 8 * HTB, NXCD = 8, WGM = 8;

__host__ __device__ __forceinline__ int lds_byte(int r, int c) { const int st = (r >> 4) * 2 + (c >> 5), rr = r & 15, cc = c & 31, ob = rr * 64 + cc * 2; return st * 1024 + (ob ^ (((ob >> 9) & 1) << 5)); }
__host__ __device__ __forceinline__ void stage_rc(int b, int& R, int& C) { const int st = b / 1024, sb = b % 1024, swz = sb ^ (((sb >> 9) & 1) << 5); R = (st >> 1) * 16 + swz / 64; C = (st & 1) * 32 + (swz % 64) / 2; }
__host__ __device__ __forceinline__ int perm32(int rho) { const int n = rho >> 4, i = rho & 15; return 8 * (i >> 2) + 4 * n + (i & 3); }

struct Unit { int pm, pn; };
struct Gemm { const bf16_t* A; const bf16_t* Bt; int M, N, K; };

struct StaticOrder {
    int nM, nN, nwg, G, c;
    __host__ __device__ void init(int M, int N, int G_, int c_) { nM = M / BM; nN = N / BM; nwg = nM * nN; G = G_; c = c_; }
    __host__ __device__ bool next(int i, Unit& u) const {
        const long L = (long)i * G + c; if (L >= nwg) return false;
        int wgid = (int)L; { const int q = nwg / NXCD, r = nwg % NXCD, xcd = wgid % NXCD, off = wgid / NXCD; wgid = (xcd < r ? xcd * (q + 1) : r * (q + 1) + (xcd - r) * q) + off; }
        const int nig = WGM * nN, gid = wgid / nig, fm = gid * WGM, gsz = (nM - fm) < WGM ? (nM - fm) : WGM;
        u.pm = fm + ((wgid % nig) % gsz); u.pn = (wgid % nig) / gsz; return true;
    }
    __device__ __forceinline__ void a_ready(const Unit&) const {}
    __device__ __forceinline__ void done(const Unit&) const {}
};

__device__ __forceinline__ unsigned cvt_pk_bf16(float lo, float hi) { unsigned r; asm volatile("v_cvt_pk_bf16_f32 %0, %1, %2" : "=v"(r) : "v"(lo), "v"(hi)); return r; }
__device__ __forceinline__ u32x4 pack8(const float (&v)[8]) { u32x4 w; w.x = cvt_pk_bf16(v[0], v[1]); w.y = cvt_pk_bf16(v[2], v[3]); w.z = cvt_pk_bf16(v[4], v[5]); w.w = cvt_pk_bf16(v[6], v[7]); return w; }

struct Epi1 {
    static constexpr bool PERM = true, AFTER_DRAIN = false;
    unsigned char* ws;
    __device__ __forceinline__ void operator()(const f32x4 (&acc)[2][2][4][2], const Unit& u, int wr, int wc, int fr, int fq) const {
        const int tile = u.pn;
        const int row0 = u.pm * BM + wr * 64 + fr;
        const float* cosA = (const float*)(ws + WS_COSA); const float* sinA = (const float*)(ws + WS_SINA);
        const float* cosR = (const float*)(ws + WS_COSR); const float* sinR = (const float*)(ws + WS_SINR);
        if (tile < 4 || tile == 6 || tile == 7) {
            bf16_t* dst = (bf16_t*)(ws + (tile < 2 ? WS_QA : tile < 4 ? WS_KA : WS_QI));
            const int tl = tile < 2 ? tile : tile < 4 ? tile - 2 : tile - 6;
            const float scale = tile < 2 ? C_QK : 1.0f;
            const int cb = 256 * tl + 64 * wc, i0 = 8 * fq;
#pragma unroll
            for (int ai = 0; ai < 2; ++ai)
#pragma unroll
                for (int m = 0; m < 4; ++m) {
                    const int row = row0 + ai * HALF + m * 16, pos = row & (SEQ - 1);
                    const f32x4 c0 = *(const f32x4*)(cosA + pos * 32 + i0), c1 = *(const f32x4*)(cosA + pos * 32 + i0 + 4);
                    const f32x4 s0 = *(const f32x4*)(sinA + pos * 32 + i0), s1 = *(const f32x4*)(sinA + pos * 32 + i0 + 4);
                    float y1[8], y2[8];
#pragma unroll
                    for (int n = 0; n < 2; ++n)
#pragma unroll
                        for (int e = 0; e < 4; ++e) {
                            const float x1 = acc[ai][0][m][n][e], x2 = acc[ai][1][m][n][e];
                            const float c = n ? c1[e] : c0[e], s = n ? s1[e] : s0[e];
                            y1[4 * n + e] = (x1 * c - x2 * s) * scale; y2[4 * n + e] = (x1 * s + x2 * c) * scale;
                        }
                    bf16_t* rp = dst + (size_t)row * 512 + cb + i0;
                    *(u32x4*)rp = pack8(y1); *(u32x4*)(rp + 32) = pack8(y2);
                }
        } else if (tile == 4 || tile == 5 || tile >= 13) {
            bf16_t* dst = (bf16_t*)(ws + (tile < 6 ? WS_VA : tile < 15 ? WS_VR : WS_GR));
            const int tl = tile < 6 ? tile - 4 : tile < 15 ? tile - 13 : tile - 15;
            const bool act = tile >= 15;
#pragma unroll
            for (int ai = 0; ai < 2; ++ai)
#pragma unroll
                for (int m = 0; m < 4; ++m) {
                    const int row = row0 + ai * HALF + m * 16;
#pragma unroll
                    for (int bj = 0; bj < 2; ++bj) {
                        float y[8];
#pragma unroll
                        for (int n = 0; n < 2; ++n)
#pragma unroll
                            for (int e = 0; e < 4; ++e) { const float v = acc[ai][bj][m][n][e]; y[4 * n + e] = act ? silu_f(v) : v; }
                        *(u32x4*)(dst + (size_t)row * 512 + 256 * tl + 128 * bj + 32 * wc + 8 * fq) = pack8(y);
                    }
                }
        } else if (tile == 8) {
#pragma unroll
            for (int ai = 0; ai < 2; ++ai)
#pragma unroll
                for (int m = 0; m < 4; ++m) {
                    const int row = row0 + ai * HALF + m * 16, pos = row & (SEQ - 1);
                    if (wc == 0) {
                        const int i0 = 8 * fq;
                        const f32x4 c0 = *(const f32x4*)(cosA + pos * 32 + i0), c1 = *(const f32x4*)(cosA + pos * 32 + i0 + 4);
                        const f32x4 s0 = *(const f32x4*)(sinA + pos * 32 + i0), s1 = *(const f32x4*)(sinA + pos * 32 + i0 + 4);
                        float y1[8], y2[8];
#pragma unroll
                        for (int n = 0; n < 2; ++n)
#pragma unroll
                            for (int e = 0; e < 4; ++e) {
                                const float x1 = acc[ai][0][m][n][e], x2 = acc[ai][1][m][n][e];
                                const float c = n ? c1[e] : c0[e], s = n ? s1[e] : s0[e];
                                y1[4 * n + e] = x1 * c - x2 * s; y2[4 * n + e] = x1 * s + x2 * c;
                            }
                        bf16_t* rp = (bf16_t*)(ws + WS_KI) + (size_t)row * 64 + i0;
                        *(u32x4*)rp = pack8(y1); *(u32x4*)(rp + 32) = pack8(y2);
                    } else if (wc == 1 && fq == 0) {
                        const float sw = 0.35355339059327379f;
                        float* WI = (float*)(ws + WS_WI);
                        *(f32x4*)(WI + (size_t)row * 8) = acc[ai][0][m][0] * sw;
                        *(f32x4*)(WI + (size_t)row * 8 + 4) = acc[ai][0][m][1] * sw;
                    }
                }
        } else {
            const bool isk = tile >= 11;
            bf16_t* dst = (bf16_t*)(ws + (isk ? WS_KR : WS_QR));
            const int tl = isk ? tile - 11 : tile - 9, hl = wc >> 1, h = 2 * tl + hl;
            const int i0 = 32 * (wc & 1) + 8 * fq, cb = 256 * tl + 128 * hl;
            const float lg = isk ? -ret_log2g(h) : ret_log2g(h);
            const float base = isk ? 0.08838834764831845f : 1.0f;
#pragma unroll
            for (int ai = 0; ai < 2; ++ai)
#pragma unroll
                for (int m = 0; m < 4; ++m) {
                    const int row = row0 + ai * HALF + m * 16, pos = row & (SEQ - 1);
                    const float dec = base * fast_exp2(lg * (float)(pos & 127));
                    const f32x4 c0 = *(const f32x4*)(cosR + pos * 64 + i0), c1 = *(const f32x4*)(cosR + pos * 64 + i0 + 4);
                    const f32x4 s0 = *(const f32x4*)(sinR + pos * 64 + i0), s1 = *(const f32x4*)(sinR + pos * 64 + i0 + 4);
                    float y1[8], y2[8];
#pragma unroll
                    for (int n = 0; n < 2; ++n)
#pragma unroll
                        for (int e = 0; e < 4; ++e) {
                            const float x1 = acc[ai][0][m][n][e], x2 = acc[ai][1][m][n][e];
                            const float c = n ? c1[e] : c0[e], s = n ? s1[e] : s0[e];
                            y1[4 * n + e] = (x1 * c - x2 * s) * dec; y2[4 * n + e] = (x1 * s + x2 * c) * dec;
                        }
                    bf16_t* rp = dst + (size_t)row * 512 + cb + i0;
                    *(u32x4*)rp = pack8(y1); *(u32x4*)(rp + 64) = pack8(y2);
                }
        }
    }
};

__device__ __forceinline__ float row_rstd(const float* sumsq, int row) {
    const f32x4* p = (const f32x4*)(sumsq + (size_t)row * 16);
    const f32x4 a = p[0], b = p[1], c = p[2], d = p[3];
    const float s = (((a[0] + a[1]) + (a[2] + a[3])) + ((b[0] + b[1]) + (b[2] + b[3]))) + (((c[0] + c[1]) + (c[2] + c[3])) + ((d[0] + d[1]) + (d[2] + d[3])));
    return 1.0f / sqrtf(s * (1.0f / DM) + EPS);
}
struct Epi2 {
    static constexpr bool PERM = false, AFTER_DRAIN = false;
    const float* x; float* x1; bf16_t* a3; const float* mod; const float* gffn; float* sumsq;
    __device__ __forceinline__ void operator()(const f32x4 (&acc)[2][2][4][2], const Unit& u, int wr, int wc, int fr, int fq) const {
        const int row0 = u.pm * BM + wr * 64 + fr, col0 = u.pn * BM + wc * 32 + 4 * fq;
#pragma unroll
        for (int ai = 0; ai < 2; ++ai)
#pragma unroll
            for (int m = 0; m < 4; ++m) {
                const int row = row0 + ai * HALF + m * 16, b = row >> 12;
                const float* mb = mod + b * 6144;
                float ss = 0.f;
#pragma unroll
                for (int bj = 0; bj < 2; ++bj)
#pragma unroll
                    for (int n = 0; n < 2; ++n) {
                        const int c = col0 + bj * HALF + n * 16;
                        const f32x4 xv = *(const f32x4*)(x + (size_t)row * DM + c), gt = *(const f32x4*)(mb + 2048 + c);
#ifdef DBG_NOMIX
                        const f32x4 v = xv;
#else
                        const f32x4 v = xv + gt * acc[ai][bj][m][n];
#endif
                        *(f32x4*)(x1 + (size_t)row * DM + c) = v;
                        ss += (v[0] * v[0] + v[1] * v[1]) + (v[2] * v[2] + v[3] * v[3]);
                        const f32x4 gs = *(const f32x4*)(gffn + c) * (*(const f32x4*)(mb + 4096 + c) + 1.0f);
                        const f32x4 a = v * gs;
                        u32x2 w; w.x = cvt_pk_bf16(a[0], a[1]); w.y = cvt_pk_bf16(a[2], a[3]);
                        *(u32x2*)(a3 + (size_t)row * DM + c) = w;
                    }
                ss += __shfl_xor(ss, 16); ss += __shfl_xor(ss, 32);
                if (fq == 0) sumsq[(size_t)row * 16 + u.pn * 4 + wc] = ss;
            }
    }
};

struct Epi3 {
    static constexpr bool PERM = false, AFTER_DRAIN = false;
    const float* sumsq; const float* biasf; float* sc;
    __device__ __forceinline__ void operator()(const f32x4 (&acc)[2][2][4][2], const Unit& u, int wr, int wc, int fr, int fq) const {
        const int row0 = u.pm * BM + wr * 64 + fr, col0 = u.pn * BM + wc * 32 + 4 * fq;
#pragma unroll
        for (int ai = 0; ai < 2; ++ai)
#pragma unroll
            for (int m = 0; m < 4; ++m) {
                const int row = row0 + ai * HALF + m * 16, b = row >> 12;
                const float rstd = row_rstd(sumsq, row);
#pragma unroll
                for (int bj = 0; bj < 2; ++bj)
#pragma unroll
                    for (int n = 0; n < 2; ++n) {
                        const int c = col0 + bj * HALF + n * 16;
                        *(f32x4*)(sc + (size_t)row * 2048 + c) = acc[ai][bj][m][n] * rstd + *(const f32x4*)(biasf + b * 2048 + c);
                    }
            }
    }
};

template <class Epi, class Sched, bool ALIGN_EPI = false, bool SP2 = false>
__device__ __forceinline__ void gemm_phase(PG8_LAS unsigned char* lds, const Gemm g, const Sched& S, const Epi& E) {
    const int tid = threadIdx.x, wid = __builtin_amdgcn_readfirstlane(tid >> 6), lane = tid & 63, wr = wid >> 2, wc = wid & 3, fr = lane & 15, fq = lane >> 4;
    const int K = g.K, nt = K / BK;
    unsigned voffA[2], voffB[2];
#pragma unroll
    for (int i = 0; i < 2; ++i) { int R, C; stage_rc(tid * 16 + i * 8192, R, C); const int Rb = Epi::PERM ? ((R & ~31) + perm32(R & 31)) : R;
        voffA[i] = (unsigned)(R * K + C) * 2u; voffB[i] = (unsigned)(Rb * K + C) * 2u; }
    const size_t kstep = (size_t)(BK * 2);
    const size_t hstep = (size_t)HALF * K * 2;
    const size_t tstep = 2 * hstep;
    const unsigned ldsw = (unsigned)wid * 1024u;
    const int aoff = lds_byte(wr * 64 + fr, fq * 8), boff = lds_byte(wc * 32 + fr, fq * 8);
#define PG8_SA(b, h) (((b) * 2 + (h)) * HTB)
#define PG8_SB(b, h) ((4 + (b) * 2 + (h)) * HTB)
#define PG8_STAGE(bufoff, gbase, voff) do { _Pragma("unroll") for (int _i = 0; _i < 2; ++_i) \
        __builtin_amdgcn_global_load_lds((const unsigned*)((const char*)(gbase) + (voff)[_i]), (PG8_LAS unsigned*)(lds + (bufoff) + ldsw + _i * 8192), 16, 0, 0); } while (0)
#define PG8_LDA(dst, b, h) do { _Pragma("unroll") for (int m = 0; m < 4; ++m) _Pragma("unroll") for (int k = 0; k < 2; ++k) dst[m][k] = *(const PG8_LAS bf16x8*)(lds + PG8_SA(b, h) + aoff + m * 2048 + k * 1024); } while (0)
#define PG8_LDB(dst, b, h) do { _Pragma("unroll") for (int n = 0; n < 2; ++n) _Pragma("unroll") for (int k = 0; k < 2; ++k) dst[n][k] = *(const PG8_LAS bf16x8*)(lds + PG8_SB(b, h) + boff + n * 2048 + k * 1024); } while (0)
#define PG8_MMA(ai, bj, At, Bt) do { __builtin_amdgcn_s_setprio(1); _Pragma("unroll") for (int m = 0; m < 4; ++m) _Pragma("unroll") for (int n = 0; n < 2; ++n) _Pragma("unroll") for (int k = 0; k < 2; ++k) \
        acc[ai][bj][m][n] = __builtin_amdgcn_mfma_f32_16x16x32_bf16(Bt[n][k], At[m][k], acc[ai][bj][m][n], 0, 0, 0); __builtin_amdgcn_s_setprio(0); } while (0)
#define PG8_WAIT_V(n) asm volatile("s_waitcnt vmcnt(" #n ")" ::: "memory")
#define PG8_WAIT_L(n) asm volatile("s_waitcnt lgkmcnt(" #n ")" ::: "memory")
#define PG8_BAR __builtin_amdgcn_s_barrier()
#define PG8_SCHED __builtin_amdgcn_sched_barrier(0)
    Unit cur, nxt; int ui = 0;
    if (!S.next(0, cur)) return;
    f32x4 acc[2][2][4][2];
#pragma unroll
    for (int a = 0; a < 2; ++a)
#pragma unroll
        for (int b = 0; b < 2; ++b)
#pragma unroll
            for (int m = 0; m < 4; ++m)
#pragma unroll
                for (int n = 0; n < 2; ++n) acc[a][b][m][n] = (f32x4){0.f, 0.f, 0.f, 0.f};
    bf16x8 At[4][2], B0[2][2], B1[2][2];
    const char* cA = (const char*)g.A + (size_t)cur.pm * tstep; const char* cB = (const char*)g.Bt + (size_t)cur.pn * tstep;
    S.a_ready(cur);
    if constexpr (SP2) {
        PG8_STAGE(PG8_SB(0, 0), cB, voffB); PG8_STAGE(PG8_SB(0, 1), cB + hstep, voffB); PG8_STAGE(PG8_SA(0, 0), cA, voffA); PG8_STAGE(PG8_SA(0, 1), cA + hstep, voffA);
        if (wr == 1) PG8_BAR;
        PG8_WAIT_V(2); PG8_BAR;
        PG8_STAGE(PG8_SB(1, 0), cB + kstep, voffB); PG8_STAGE(PG8_SA(1, 0), cA + kstep, voffA); PG8_STAGE(PG8_SB(1, 1), cB + hstep + kstep, voffB);
        PG8_WAIT_V(6); PG8_BAR;
    } else {
        PG8_STAGE(PG8_SB(0, 0), cB, voffB); PG8_STAGE(PG8_SA(0, 0), cA, voffA); PG8_STAGE(PG8_SB(0, 1), cB + hstep, voffB); PG8_STAGE(PG8_SA(0, 1), cA + hstep, voffA);
        if (wr == 1) PG8_BAR;
        PG8_WAIT_V(4); PG8_BAR;
        PG8_STAGE(PG8_SB(1, 0), cB + kstep, voffB); PG8_STAGE(PG8_SA(1, 0), cA + kstep, voffA); PG8_STAGE(PG8_SB(1, 1), cB + hstep + kstep, voffB);
        PG8_WAIT_V(6); PG8_BAR;
    }
    for (;;) {
        const bool has_next = S.next(ui + 1, nxt);
        const char* nA = has_next ? (const char*)g.A + (size_t)nxt.pm * tstep : cA; const char* nB = has_next ? (const char*)g.Bt + (size_t)nxt.pn * tstep : cB;
        for (int t = 0; t < nt; t += 2) {
            const bool last = (t == nt - 2);
            const char* a1 = cA + (size_t)(t + 1) * kstep;
            const char* a2 = last ? nA : cA + (size_t)(t + 2) * kstep; const char* b2 = last ? nB : cB + (size_t)(t + 2) * kstep;
            const char* a3 = a2 + kstep; const char* b3 = b2 + kstep;
            if (last && has_next) S.a_ready(nxt);
            if constexpr (SP2) {
            PG8_LDB(B0, 0, 0); PG8_LDB(B1, 0, 1); PG8_SCHED; PG8_LDA(At, 0, 0); PG8_STAGE(PG8_SA(1, 1), a1 + hstep, voffA);
            PG8_WAIT_V(8); PG8_WAIT_L(0); PG8_BAR; PG8_MMA(0, 0, At, B0); PG8_MMA(0, 1, At, B1); PG8_BAR; PG8_SCHED;
            PG8_LDA(At, 0, 1); PG8_STAGE(PG8_SB(0, 0), b2, voffB); PG8_STAGE(PG8_SB(0, 1), b2 + hstep, voffB); PG8_STAGE(PG8_SA(0, 0), a2, voffA);
            PG8_WAIT_V(8); PG8_WAIT_L(0); PG8_BAR; PG8_MMA(1, 0, At, B0); PG8_MMA(1, 1, At, B1); PG8_BAR; PG8_SCHED;
            PG8_LDB(B0, 1, 0); PG8_LDB(B1, 1, 1); PG8_SCHED; PG8_LDA(At, 1, 0); PG8_STAGE(PG8_SA(0, 1), a2 + hstep, voffA);
            PG8_WAIT_V(8); PG8_WAIT_L(0); PG8_BAR; PG8_MMA(0, 0, At, B0); PG8_MMA(0, 1, At, B1); PG8_BAR; PG8_SCHED;
            PG8_LDA(At, 1, 1); PG8_STAGE(PG8_SB(1, 0), b3, voffB); PG8_STAGE(PG8_SB(1, 1), b3 + hstep, voffB); PG8_STAGE(PG8_SA(1, 0), a3, voffA);
            PG8_WAIT_V(8); PG8_WAIT_L(0); PG8_BAR; PG8_MMA(1, 0, At, B0); PG8_MMA(1, 1, At, B1); PG8_BAR; PG8_SCHED;
            } else {
            PG8_LDB(B0, 0, 0); PG8_SCHED; PG8_LDA(At, 0, 0); PG8_STAGE(PG8_SA(1, 1), a1 + hstep, voffA);
            PG8_WAIT_L(8); PG8_BAR; PG8_WAIT_L(0); PG8_MMA(0, 0, At, B0); PG8_BAR; PG8_SCHED;
            PG8_LDB(B1, 0, 1); PG8_STAGE(PG8_SB(0, 0), b2, voffB);
            PG8_BAR; PG8_WAIT_L(0); PG8_MMA(0, 1, At, B1); PG8_BAR;
            PG8_LDA(At, 0, 1); PG8_STAGE(PG8_SA(0, 0), a2, voffA);
            PG8_BAR; PG8_WAIT_L(0); PG8_MMA(1, 0, At, B0); PG8_BAR; PG8_SCHED;
            PG8_STAGE(PG8_SB(0, 1), b2 + hstep, voffB);
            PG8_WAIT_V(6); PG8_BAR; PG8_MMA(1, 1, At, B1); PG8_BAR;
            PG8_LDB(B0, 1, 0); PG8_SCHED; PG8_LDA(At, 1, 0); PG8_STAGE(PG8_SA(0, 1), a2 + hstep, voffA);
            PG8_WAIT_L(8); PG8_BAR; PG8_WAIT_L(0); PG8_MMA(0, 0, At, B0); PG8_BAR; PG8_SCHED;
            PG8_LDB(B1, 1, 1); PG8_STAGE(PG8_SB(1, 0), b3, voffB);
            PG8_BAR; PG8_WAIT_L(0); PG8_MMA(0, 1, At, B1); PG8_BAR;
            PG8_LDA(At, 1, 1); PG8_STAGE(PG8_SA(1, 0), a3, voffA);
            PG8_BAR; PG8_WAIT_L(0); PG8_MMA(1, 0, At, B0); PG8_BAR; PG8_SCHED;
            PG8_STAGE(PG8_SB(1, 1), b3 + hstep, voffB);
            PG8_WAIT_V(6); PG8_BAR; PG8_MMA(1, 1, At, B1); PG8_BAR;
            }
        }
        if constexpr (ALIGN_EPI) { if (wr == 0) PG8_BAR; }
        if constexpr (!Epi::AFTER_DRAIN) { E(acc, cur, wr, wc, fr, fq); S.done(cur); }
        if (!has_next) break;
#pragma unroll
        for (int a = 0; a < 2; ++a)
#pragma unroll
            for (int b = 0; b < 2; ++b)
#pragma unroll
                for (int m = 0; m < 4; ++m)
#pragma unroll
                    for (int n = 0; n < 2; ++n) acc[a][b][m][n] = (f32x4){0.f, 0.f, 0.f, 0.f};
        cur = nxt; cA = nA; cB = nB; ++ui;
        if constexpr (ALIGN_EPI) { if (wr == 1) PG8_BAR; }
    }
    PG8_WAIT_V(0);
    if constexpr (!ALIGN_EPI) { if (wr == 0) PG8_BAR; }
    PG8_BAR;
    if constexpr (Epi::AFTER_DRAIN) { E.fused(acc, cur, wr, wc, fr, fq, lds, wid, lane); S.done(cur); }
#undef PG8_SA
#undef PG8_SB
#undef PG8_STAGE
#undef PG8_LDA
#undef PG8_LDB
#undef PG8_MMA
#undef PG8_WAIT_V
#undef PG8_WAIT_L
#undef PG8_BAR
#undef PG8_SCHED
}
}
struct Args { const float* in[13]; float* out; unsigned char* ws; int ph_lo, ph_hi; };

template <bool PERMUTE>
__device__ __forceinline__ void p0_transpose_item(const float* W, int K, int N, int NPOS, bf16_t* WT, LAS float* scr, int item, int lane) {
    const int nblk = NPOS / 32, kb = item / nblk, nb = item % nblk, k0 = 64 * kb, n0 = 32 * nb;
    const int pos = n0 + (lane & 31);
    const int col = PERMUTE ? win_src_col(pos) : pos;
#pragma unroll 8
    for (int i = 0; i < 32; ++i) { const int kk = 2 * i + (lane >> 5); scr[kk * 33 + (lane & 31)] = (col >= 0) ? W[(size_t)(k0 + kk) * N + col] : 0.f; }
    asm volatile("s_waitcnt lgkmcnt(0)" ::: "memory");
    const int c = lane & 7;
#pragma unroll
    for (int j = 0; j < 4; ++j) { const int n = (lane >> 3) + 8 * j; const LAS float* s = scr + (8 * c) * 33 + n;
        u32x4 o; o.x = pk2(s[0 * 33], s[1 * 33]); o.y = pk2(s[2 * 33], s[3 * 33]); o.z = pk2(s[4 * 33], s[5 * 33]); o.w = pk2(s[6 * 33], s[7 * 33]);
        *(u32x4*)(WT + (size_t)(n0 + n) * K + k0 + 8 * c) = o; }
    asm volatile("s_waitcnt lgkmcnt(0)" ::: "memory");
}
__device__ __forceinline__ void row_to_bf16(const float* src, bf16_t* dst, int lane) {
    const f32x4* s = (const f32x4*)src + lane; u32x2* d = (u32x2*)dst + lane;
    f32x4 v[4];
#pragma unroll
    for (int j = 0; j < 4; ++j) v[j] = s[64 * j];
#pragma unroll
    for (int j = 0; j < 4; ++j) { u32x2 w; w.x = pk2(v[j][0], v[j][1]); w.y = pk2(v[j][2], v[j][3]); d[64 * j] = w; }
}
__device__ __forceinline__ void sincos_tab(double x, float& s, float& c) {
    const double k = rint(x * 0.15915494309189535);
    double r = fma(-k, 6.283185307179586, x); r = fma(-k, 2.4492935982947064e-16, r);
    const double r2 = r * r;
    double ps = 1.0, pc = 1.0;
#pragma unroll
    for (int n = 29; n >= 3; n -= 2) ps = 1.0 - ps * r2 * (1.0 / (double)((n - 1) * n));
#pragma unroll
    for (int n = 28; n >= 2; n -= 2) pc = 1.0 - pc * r2 * (1.0 / (double)((n - 1) * n));
    s = (float)(r * ps); c = (float)pc;
}

__device__ __forceinline__ void phase0(const Args& a, unsigned char* lds, int tid, int wave, int lane, int bid, int G) {
    unsigned char* ws = a.ws;
    for (int it = bid; it < 192; it += G) {
        float* s_c = (float*)lds; float* red = (float*)(lds + 16384);
        for (int i = tid; i < 4096; i += NTHREADS) { const float v = a.in[1][i]; s_c[i] = v / (1.0f + expf(-v)); }
        __syncthreads();
        const int g = tid & 7, ks = tid >> 3, n0 = 32 * it;
        f32x4 acc[4];
#pragma unroll
        for (int b = 0; b < 4; ++b) acc[b] = (f32x4){0.f, 0.f, 0.f, 0.f};
#pragma unroll 4
        for (int i = 0; i < 16; ++i) { const int k = ks + 64 * i; const f32x4 w = *(const f32x4*)(a.in[2] + (size_t)k * 6144 + n0 + 4 * g);
#pragma unroll
            for (int b = 0; b < 4; ++b) acc[b] += w * s_c[b * 1024 + k]; }
#pragma unroll
        for (int b = 0; b < 4; ++b) *(f32x4*)(red + (ks * 8 + g) * 16 + 4 * b) = acc[b];
        __syncthreads();
        if (tid < 128) { const int b = tid >> 5, col = tid & 31, gg = col >> 2, e = col & 3; float s = 0.f;
            for (int k2 = 0; k2 < 64; ++k2) s += red[(k2 * 8 + gg) * 16 + 4 * b + e];
            ((float*)(ws + WS_MOD))[b * 6144 + n0 + col] = s + a.in[3][n0 + col]; }
        __syncthreads();
    }
    for (int it = bid; it < 256; it += G) {
        const int hp = it >> 4, k0 = 64 * (it & 15);
        float* skl = (float*)lds; float* wql = skl + 128 * 129;
        for (int i = tid; i < 4096; i += NTHREADS) { const int n = i >> 5, d4 = i & 31; const f32x4 v = *(const f32x4*)(a.in[9] + (size_t)hp * 16384 + n * 128 + 4 * d4);
            float* q = skl + n * 129 + 4 * d4; q[0] = v[0]; q[1] = v[1]; q[2] = v[2]; q[3] = v[3]; }
        for (int i = tid; i < 2048; i += NTHREADS) { const int k = i >> 5, d4 = i & 31; const f32x4 v = *(const f32x4*)(a.in[8] + (size_t)(k0 + k) * 2048 + hp * 128 + 4 * d4);
            float* q = wql + k * 129 + 4 * d4; q[0] = v[0]; q[1] = v[1]; q[2] = v[2]; q[3] = v[3]; }
        __syncthreads();
        const int k = tid & 63, ng = tid >> 6;
        float acc[16];
#pragma unroll
        for (int j = 0; j < 16; ++j) acc[j] = 0.f;
        for (int d = 0; d < 128; ++d) { const float av = wql[k * 129 + d];
#pragma unroll
            for (int j = 0; j < 16; ++j) acc[j] += av * skl[(16 * ng + j) * 129 + d]; }
        bf16_t* wt = (bf16_t*)(ws + WS_WPQ);
#pragma unroll
        for (int j = 0; j < 16; ++j) wt[(size_t)(hp * 128 + 16 * ng + j) * 1024 + k0 + k] = (bf16_t)f2bf(acc[j]);
        __syncthreads();
    }
    const int gw = bid * 8 + wave, NGW = G * 8;
    {
        LAS float* scr = (LAS float*)(lds + wave * 16384);
        constexpr int I_IN = 16 * (N1 / 32), I_OUT = 16 * 32;
        for (int it = gw; it < I_IN + I_OUT; it += NGW) {
            if (it < I_IN) p0_transpose_item<true>(a.in[5], 1024, 4168, N1, (bf16_t*)(ws + WS_WIN), scr, it, lane);
            else p0_transpose_item<false>(a.in[6], 1024, 1024, 1024, (bf16_t*)(ws + WS_WOUT), scr, it - I_IN, lane);
        }
    }
    for (int r = gw; r < 16384; r += NGW) row_to_bf16(a.in[11] + (size_t)r * 1024, (bf16_t*)(ws + WS_VBF) + (size_t)r * 1024, lane);
    for (int i = bid * NTHREADS + tid; i < 4096 * 96; i += G * NTHREADS) {
        int pos, f; double r; float* ct; float* st; int idx;
        if (i < 4096 * 32) { pos = i >> 5; f = i & 31; r = 0.74989420933245582730; ct = (float*)(ws + WS_COSA); st = (float*)(ws + WS_SINA); idx = i; }
        else { const int j = i - 4096 * 32; pos = j >> 6; f = j & 63; r = 0.86398844948396852897; ct = (float*)(ws + WS_COSR); st = (float*)(ws + WS_SINR); idx = j; }
        double v = 1.0; for (int t = 0; t < f; ++t) v *= r;
        const float invf = (float)v; const float ang = (float)pos * invf;
        float s, c; sincos_tab((double)ang, s, c);
        ct[idx] = c; st[idx] = s;
    }
}

__device__ __forceinline__ void phase1(const Args& a, int wave, int lane, int bid, int G) {
    unsigned char* ws = a.ws;
    const float* mod = (const float*)(ws + WS_MOD);
    const int gw = bid * 8 + wave, NGW = G * 8;
    for (int r = gw; r < MTOK; r += NGW) {
        const int b = r >> 12;
        const f32x4* xr = (const f32x4*)(a.in[0] + (size_t)r * DM) + lane;
        f32x4 v[4]; float ss = 0.f;
#pragma unroll
        for (int j = 0; j < 4; ++j) { v[j] = xr[64 * j]; ss += (v[j][0] * v[j][0] + v[j][1] * v[j][1]) + (v[j][2] * v[j][2] + v[j][3] * v[j][3]); }
        const float rstd = 1.0f / sqrtf(wave_sum(ss) * (1.0f / DM) + EPS);
        u32x2* o = (u32x2*)((bf16_t*)(ws + WS_BUFA) + (size_t)r * DM) + lane;
#pragma unroll
        for (int j = 0; j < 4; ++j) { const int c = 256 * j + 4 * lane;
            const f32x4 g = *(const f32x4*)(a.in[4] + c), sc = *(const f32x4*)(mod + b * 6144 + 1024 + c), sh = *(const f32x4*)(mod + b * 6144 + c);
            const f32x4 h = v[j] * rstd * g * (sc + 1.0f) + sh;
            u32x2 w; w.x = pk2(h[0], h[1]); w.y = pk2(h[2], h[3]); o[64 * j] = w; }
    }
    for (int n = gw; n < 2048; n += NGW) {
        const u32x4* wr = (const u32x4*)((const bf16_t*)(ws + WS_WPQ) + (size_t)n * 1024);
        const u32x4 w0 = wr[lane], w1 = wr[64 + lane];
        float wf[16];
#pragma unroll
        for (int i = 0; i < 4; ++i) { wf[2 * i] = bf_lo(w0[i]); wf[2 * i + 1] = bf_hi(w0[i]); wf[8 + 2 * i] = bf_lo(w1[i]); wf[8 + 2 * i + 1] = bf_hi(w1[i]); }
#pragma unroll
        for (int b = 0; b < 4; ++b) { const float* sh = mod + b * 6144 + 3072; float s = 0.f;
#pragma unroll
            for (int i = 0; i < 8; ++i) s += wf[i] * sh[8 * lane + i] + wf[8 + i] * sh[512 + 8 * lane + i];
            s = wave_sum(s);
            if (lane == 0) ((float*)(ws + WS_BIASF))[b * 2048 + n] = s; }
    }
}

constexpr int SCP = 8200;
__device__ __forceinline__ void select_row(int b, int t, const unsigned char* ldsrow, unsigned long long* MASK, int lane) {
    const int nreg = (t >> 6) + 1;
    unsigned key[64];
#pragma unroll
    for (int j = 0; j < 64; ++j) {
        unsigned k = 0;
        if (j < nreg) { k = *(const unsigned short*)(ldsrow + 2 * lane + 128 * j); if (lane > t - 64 * j) k = 0; }
        key[j] = k;
    }
    unsigned mw_lo = 0u, mw_hi = 0u;
    if (t < 256) {
#pragma unroll
        for (int j = 0; j < 4; ++j) { const unsigned long long w = __ballot(key[j] != 0u); asm volatile("s_nop 1\n\tv_writelane_b32 %0, %2, %4\n\tv_writelane_b32 %1, %3, %4\n\ts_nop 0" : "+v"(mw_lo), "+v"(mw_hi) : "s"((unsigned)w), "s"((unsigned)(w >> 32)), "n"(j));     }
    } else {
        unsigned T = 0;
#pragma unroll 1
        for (int bit = 15; bit >= 0; --bit) {
            const unsigned cand = T | (1u << bit);
            int cnt = 0;
#pragma unroll
            for (int jb = 0; jb < 16; ++jb) {
                if (4 * jb < nreg) {
#pragma unroll
                    for (int j = 4 * jb; j < 4 * jb + 4; ++j) cnt += __popcll(__ballot(key[j] >= cand));
                }
                __builtin_amdgcn_sched_barrier(0);
            }
            if (cnt >= 256) T = cand;
        }
        int cgt = 0;
#pragma unroll
        for (int jb = 0; jb < 16; ++jb) {
            if (4 * jb < nreg) {
#pragma unroll
                for (int j = 4 * jb; j < 4 * jb + 4; ++j) cgt += __popcll(__ballot(key[j] > T));
            }
            __builtin_amdgcn_sched_barrier(0);
        }
        int need = 256 - cgt;
#pragma unroll
        for (int jb = 0; jb < 32; ++jb) {
            if (2 * jb < nreg) {
#pragma unroll
                for (int j = 2 * jb; j < 2 * jb + 2; ++j) {
                    const bool gt = key[j] > T, eq = key[j] == T;
                    const unsigned long long em = __ballot(eq);
                    const int c = __popcll(em), take = c < need ? c : need;
                    const int rank = (int)__builtin_amdgcn_mbcnt_hi((unsigned)(em >> 32), __builtin_amdgcn_mbcnt_lo((unsigned)em, 0u));
                    const unsigned long long w = __ballot(gt || (eq && rank < take));
                    need -= take;
                    asm volatile("s_nop 1\n\tv_writelane_b32 %0, %2, %4\n\tv_writelane_b32 %1, %3, %4\n\ts_nop 0" : "+v"(mw_lo), "+v"(mw_hi) : "s"((unsigned)w), "s"((unsigned)(w >> 32)), "n"(j));
                }
            }
            __builtin_amdgcn_sched_barrier(0);
        }
    }
    MASK[((size_t)b * SEQ + t) * 64 + lane] = ((unsigned long long)mw_hi << 32) | mw_lo;
}
__device__ __forceinline__ void idx_unit(int b, int qt, const bf16_t* QI, const bf16_t* KI, const float* WI, unsigned long long* MASK, unsigned char* lds, int wave, int lane) {
    const int t0 = 16 * qt, qn = lane & 15, g = lane >> 4;
    const size_t rowq = (size_t)b * SEQ + t0 + qn;
    bf16x8 qf[8][2]; float wi[8];
#pragma unroll
    for (int h = 0; h < 8; ++h)
#pragma unroll
        for (int ks = 0; ks < 2; ++ks) qf[h][ks] = *(const bf16x8*)(QI + rowq * 512 + h * 64 + ks * 32 + 8 * g);
    { const f32x4 w0 = *(const f32x4*)(WI + rowq * 8), w1 = *(const f32x4*)(WI + rowq * 8 + 4);
#pragma unroll
      for (int e = 0; e < 4; ++e) { wi[e] = w0[e]; wi[4 + e] = w1[e]; } }
    for (int kt = wave; kt <= qt; kt += 8) {
        const int s0 = 16 * kt;
        const bf16_t* kr = KI + ((size_t)b * SEQ + s0 + qn) * 64 + 8 * g;
        const bf16x8 a0 = *(const bf16x8*)kr, a1 = *(const bf16x8*)(kr + 32);
        f32x4 sc = (f32x4){0.f, 0.f, 0.f, 0.f};
#pragma unroll
        for (int h = 0; h < 8; ++h) {
            f32x4 d = mfma16(a0, qf[h][0], (f32x4){0.f, 0.f, 0.f, 0.f}); d = mfma16(a1, qf[h][1], d);
#pragma unroll
            for (int r = 0; r < 4; ++r) sc[r] += wi[h] * fmaxf(d[r], 0.f);
        }
        unsigned k[4];
#pragma unroll
        for (int r = 0; r < 4; ++r) k[r] = (s0 + 4 * g + r <= t0 + qn) ? sortable16(sc[r]) : 0u;
        u32x2 pk; pk.x = k[0] | (k[1] << 16); pk.y = k[2] | (k[3] << 16);
        *(u32x2*)(lds + qn * SCP + 2 * (s0 + 4 * g)) = pk;
    }
    __syncthreads();
#ifndef NO_SEL
#pragma unroll 1
    for (int qq = 2 * wave; qq < 2 * wave + 2; ++qq) select_row(b, t0 + qq, lds + qq * SCP, MASK, lane);
#endif
    __syncthreads();
}

__device__ __forceinline__ void ret_state_unit(int b, int h, int vb, const bf16_t* KR, const bf16_t* VR, bf16_t* STATE, unsigned char* lds, int tid, int wave, int lane) {
    constexpr int PT = 272, KT_BYTES = 128 * PT, BUF = KT_BYTES + 16 * PT;
    const int j = tid & 127, dq = tid >> 7, g = lane >> 4, ln = lane & 15;
    const float g128 = ret_g128(h), g127 = ret_g127(h), gam = ret_gamma(h);
    f32x4 st = (f32x4){0.f, 0.f, 0.f, 0.f};
    u32x4 kreg[4], vreg = (u32x4){0u, 0u, 0u, 0u};
#define RS_LOAD(n) do { const size_t row = (size_t)b * SEQ + (n) * 128 + j; const u32x4* p = (const u32x4*)(KR + row * 512 + h * 128 + 32 * dq); \
        kreg[0] = p[0]; kreg[1] = p[1]; kreg[2] = p[2]; kreg[3] = p[3]; if (tid < 256) vreg = *(const u32x4*)(VR + row * 512 + h * 128 + 16 * vb + 8 * dq); } while (0)
    RS_LOAD(0);
#pragma unroll 1
    for (int n = 0; n < 32; ++n) {
        unsigned char* buf = lds + (n & 1) * BUF;
#pragma unroll
        for (int i = 0; i < 4; ++i)
#pragma unroll
            for (int e = 0; e < 4; ++e) { const unsigned w = kreg[i][e]; const int d = 32 * dq + 8 * i + 2 * e;
                *(unsigned short*)(buf + d * PT + 2 * j) = (unsigned short)(w & 0xffffu); *(unsigned short*)(buf + (d + 1) * PT + 2 * j) = (unsigned short)(w >> 16); }
        if (tid < 256) {
#pragma unroll
            for (int e = 0; e < 4; ++e) { const unsigned w = vreg[e]; const int v = 8 * dq + 2 * e;
                *(unsigned short*)(buf + KT_BYTES + v * PT + 2 * j) = (unsigned short)(w & 0xffffu); *(unsigned short*)(buf + KT_BYTES + (v + 1) * PT + 2 * j) = (unsigned short)(w >> 16); }
        }
        if (n < 31) RS_LOAD(n + 1);
        __syncthreads();
        { bf16_t* sp = STATE + ((((size_t)b * 4 + h) * 32 + n) * 128 + 16 * vb + 4 * g) * 128 + 16 * wave + ln;
#pragma unroll
          for (int r = 0; r < 4; ++r) sp[r * 128] = (bf16_t)f2bf(gam * st[r]); }
        f32x4 c = (f32x4){0.f, 0.f, 0.f, 0.f};
#pragma unroll
        for (int ks = 0; ks < 4; ++ks) {
            const bf16x8 af = *(const bf16x8*)(buf + KT_BYTES + ln * PT + 2 * (32 * ks + 8 * g));
            const bf16x8 bf = *(const bf16x8*)(buf + (16 * wave + ln) * PT + 2 * (32 * ks + 8 * g));
            c = mfma16(af, bf, c);
        }
        st = st * g128 + c * g127;
    }
#undef RS_LOAD
    __syncthreads();
}

__device__ __forceinline__ void attn_unit(int b, int h, int qb, const bf16_t* QA, const bf16_t* KA, const bf16_t* VA, const unsigned long long* MASK, bf16_t* AR,
                                          unsigned char* lds, int tid, int wave, int lane) {
    constexpr int KP = 144, KS_BYTES = 64 * KP, BUF = 2 * KS_BYTES;
    const int q0 = 256 * qb, r32 = lane & 31, hi = lane >> 5;
    const int t = q0 + 32 * wave + r32;
    const size_t qrow = (size_t)b * SEQ + t;
    bf16x8 qf[4];
#pragma unroll
    for (int d0 = 0; d0 < 4; ++d0) qf[d0] = *(const bf16x8*)(QA + qrow * 512 + h * 64 + 16 * d0 + 8 * hi);
    const int NT = (q0 + 256) / 64;
    const int key_l = tid >> 3, c8 = tid & 7;
    f32x16 o0, o1;
#pragma unroll
    for (int r = 0; r < 16; ++r) { o0[r] = 0.f; o1[r] = 0.f; }
    float m_run = NEG_INF, l_run = 0.f;
    u32x4 kreg, vreg; unsigned long long mw;
#define AT_LOAD(kt) do { const size_t kr = (size_t)b * SEQ + 64 * (kt) + key_l; kreg = *(const u32x4*)(KA + kr * 512 + h * 64 + 8 * c8); vreg = *(const u32x4*)(VA + kr * 512 + h * 64 + 8 * c8); \
        mw = MASK[qrow * 64 + (kt)]; } while (0)
    AT_LOAD(0);
#pragma unroll 1
    for (int kt = 0; kt < NT; ++kt) {
        unsigned char* buf = lds + (kt & 1) * BUF;
        *(u32x4*)(buf + key_l * KP + 16 * c8) = kreg;
#pragma unroll
        for (int e = 0; e < 4; ++e) { const unsigned w = vreg[e]; const int d = 8 * c8 + 2 * e;
            *(unsigned short*)(buf + KS_BYTES + d * KP + 2 * key_l) = (unsigned short)(w & 0xffffu); *(unsigned short*)(buf + KS_BYTES + (d + 1) * KP + 2 * key_l) = (unsigned short)(w >> 16); }
#ifdef DBG_CAUSAL
        const int nv_ = t - 64 * kt + 1; const unsigned long long mcur = nv_ >= 64 ? ~0ull : nv_ <= 0 ? 0ull : ((1ull << nv_) - 1ull);
#else
        const unsigned long long mcur = mw;
#endif
        if (kt + 1 < NT) AT_LOAD(kt + 1);
        __syncthreads();
        if (64 * kt <= q0 + 32 * wave + 31) {
            f32x16 p0, p1;
#pragma unroll
            for (int r = 0; r < 16; ++r) { p0[r] = 0.f; p1[r] = 0.f; }
#pragma unroll
            for (int d0 = 0; d0 < 4; ++d0) {
                const bf16x8 a0 = *(const bf16x8*)(buf + r32 * KP + 32 * d0 + 16 * hi);
                const bf16x8 a1 = *(const bf16x8*)(buf + (32 + r32) * KP + 32 * d0 + 16 * hi);
                p0 = mfma32(a0, qf[d0], p0); p1 = mfma32(a1, qf[d0], p1);
            }
            const unsigned wl = (unsigned)mcur >> (4 * hi), wh = (unsigned)(mcur >> 32) >> (4 * hi);
            float mx = NEG_INF;
#pragma unroll
            for (int r = 0; r < 16; ++r) { const int bp = (r & 3) + 8 * (r >> 2);
                p0[r] = ((wl >> bp) & 1u) ? p0[r] : NEG_INF; p1[r] = ((wh >> bp) & 1u) ? p1[r] : NEG_INF;
                mx = fmaxf(mx, fmaxf(p0[r], p1[r])); }
            mx = fmaxf(mx, __shfl_xor(mx, 32));
            const float m_new = fmaxf(m_run, mx);
            const float m_use = (m_new == NEG_INF) ? 0.f : m_new;
            const float alpha = fast_exp2(m_run - m_use);
            m_run = m_new;
            float ps = 0.f;
#pragma unroll
            for (int r = 0; r < 16; ++r) { p0[r] = fast_exp2(p0[r] - m_use); p1[r] = fast_exp2(p1[r] - m_use); ps += p0[r] + p1[r]; }
            l_run = l_run * alpha + ps;
#pragma unroll
            for (int r = 0; r < 16; ++r) { o0[r] *= alpha; o1[r] *= alpha; }
#pragma unroll
            for (int s4 = 0; s4 < 4; ++s4) {
                const int rb = 8 * (s4 & 1);
                u32x4 pw;
                if (s4 < 2) { pw.x = pk2(p0[rb], p0[rb + 1]); pw.y = pk2(p0[rb + 2], p0[rb + 3]); pw.z = pk2(p0[rb + 4], p0[rb + 5]); pw.w = pk2(p0[rb + 6], p0[rb + 7]); }
                else        { pw.x = pk2(p1[rb], p1[rb + 1]); pw.y = pk2(p1[rb + 2], p1[rb + 3]); pw.z = pk2(p1[rb + 4], p1[rb + 5]); pw.w = pk2(p1[rb + 6], p1[rb + 7]); }
                const bf16x8 bfr = __builtin_bit_cast(bf16x8, pw);
                { const unsigned char* vp = buf + KS_BYTES + r32 * KP + 2 * (16 * s4 + 4 * hi);
                  const u32x2 lo = *(const u32x2*)vp, h2 = *(const u32x2*)(vp + 16); const u32x4 av = (u32x4){lo.x, lo.y, h2.x, h2.y};
                  o0 = mfma32(__builtin_bit_cast(bf16x8, av), bfr, o0); }
                { const unsigned char* vp = buf + KS_BYTES + (32 + r32) * KP + 2 * (16 * s4 + 4 * hi);
                  const u32x2 lo = *(const u32x2*)vp, h2 = *(const u32x2*)(vp + 16); const u32x4 av = (u32x4){lo.x, lo.y, h2.x, h2.y};
                  o1 = mfma32(__builtin_bit_cast(bf16x8, av), bfr, o1); }
            }
        }
    }
#undef AT_LOAD
    l_run += __shfl_xor(l_run, 32);
#ifdef DBG_NOATT
    const float inv = 0.f;
#else
    const float inv = 1.0f / l_run;
#endif
    bf16_t* op = AR + qrow * 1024 + h * 64 + 4 * hi;
#pragma unroll
    for (int c = 0; c < 4; ++c) {
        u32x2 w; w.x = pk2(o0[4 * c] * inv, o0[4 * c + 1] * inv); w.y = pk2(o0[4 * c + 2] * inv, o0[4 * c + 3] * inv); *(u32x2*)(op + 8 * c) = w;
        u32x2 v; v.x = pk2(o1[4 * c] * inv, o1[4 * c + 1] * inv); v.y = pk2(o1[4 * c + 2] * inv, o1[4 * c + 3] * inv); *(u32x2*)(op + 32 + 8 * c) = v;
    }
    __syncthreads();
}

__device__ __forceinline__ void ret_out_unit(int b, int h, int n, const bf16_t* QR, const bf16_t* KR, const bf16_t* VR, const bf16_t* GR, const bf16_t* STATE, bf16_t* AR,
                                             unsigned char* lds, int tid, int wave, int lane) {
    constexpr int PT = 272;
    const size_t c0 = (size_t)b * SEQ + 128 * n; const int hc = 128 * h;
    { const int j = tid & 127, vq = tid >> 7; const u32x4* p = (const u32x4*)(VR + (c0 + j) * 512 + hc + 32 * vq);
      u32x4 rr[4]; rr[0] = p[0]; rr[1] = p[1]; rr[2] = p[2]; rr[3] = p[3];
#pragma unroll
      for (int i = 0; i < 4; ++i)
#pragma unroll
          for (int e = 0; e < 4; ++e) { const unsigned w = rr[i][e]; const int v = 32 * vq + 8 * i + 2 * e;
              *(unsigned short*)(lds + v * PT + 2 * j) = (unsigned short)(w & 0xffffu); *(unsigned short*)(lds + (v + 1) * PT + 2 * j) = (unsigned short)(w >> 16); } }
    __syncthreads();
    const int ln = lane & 15, g = lane >> 4;
    const size_t qrow = c0 + 16 * wave + ln;
    bf16x8 qf[4];
#pragma unroll
    for (int ks = 0; ks < 4; ++ks) qf[ks] = *(const bf16x8*)(QR + qrow * 512 + hc + 32 * ks + 8 * g);
    f32x4 sT[8];
#pragma unroll
    for (int jt = 0; jt < 8; ++jt) {
        f32x4 d = (f32x4){0.f, 0.f, 0.f, 0.f};
        if (jt <= wave) {
            const bf16_t* kp = KR + (c0 + 16 * jt + ln) * 512 + hc + 8 * g;
#pragma unroll
            for (int ks = 0; ks < 4; ++ks) d = mfma16(*(const bf16x8*)(kp + 32 * ks), qf[ks], d);
            if (jt == wave) {
#pragma unroll
                for (int r = 0; r < 4; ++r) if (4 * g + r > ln) d[r] = 0.f;
            }
        }
        sT[jt] = d;
    }
    f32x4 oT[8];
    const bf16_t* stp = STATE + (((size_t)b * 4 + h) * 32 + n) * 16384;
#pragma unroll
    for (int vt = 0; vt < 8; ++vt) {
        f32x4 d = (f32x4){0.f, 0.f, 0.f, 0.f};
#pragma unroll
        for (int ks = 0; ks < 4; ++ks) d = mfma16(*(const bf16x8*)(stp + (16 * vt + ln) * 128 + 32 * ks + 8 * g), qf[ks], d);
        oT[vt] = d;
    }
#pragma unroll
    for (int pr = 0; pr < 4; ++pr) if (2 * pr <= wave) {
        u32x4 pw; pw.x = pk2(sT[2 * pr][0], sT[2 * pr][1]); pw.y = pk2(sT[2 * pr][2], sT[2 * pr][3]); pw.z = pk2(sT[2 * pr + 1][0], sT[2 * pr + 1][1]); pw.w = pk2(sT[2 * pr + 1][2], sT[2 * pr + 1][3]);
        const bf16x8 bfr = __builtin_bit_cast(bf16x8, pw);
#pragma unroll
        for (int vt = 0; vt < 8; ++vt) {
            const unsigned char* vp = lds + (16 * vt + ln) * PT + 2 * (32 * pr + 4 * g);
            const u32x2 lo = *(const u32x2*)vp, h2 = *(const u32x2*)(vp + 32); const u32x4 av = (u32x4){lo.x, lo.y, h2.x, h2.y};
            oT[vt] = mfma16(__builtin_bit_cast(bf16x8, av), bfr, oT[vt]);
        }
    }
    float s = 0.f;
#pragma unroll
    for (int vt = 0; vt < 8; ++vt) s += (oT[vt][0] + oT[vt][1]) + (oT[vt][2] + oT[vt][3]);
    s += __shfl_xor(s, 16); s += __shfl_xor(s, 32);
    const float mean = s * (1.0f / 128.0f);
    float q = 0.f;
#pragma unroll
    for (int vt = 0; vt < 8; ++vt)
#pragma unroll
        for (int r = 0; r < 4; ++r) { const float d = oT[vt][r] - mean; q += d * d; }
    q += __shfl_xor(q, 16); q += __shfl_xor(q, 32);
    const float rstd = 1.0f / sqrtf(q * (1.0f / 128.0f) + EPS);
#pragma unroll
    for (int vt = 0; vt < 8; ++vt) {
        const u32x2 gw = *(const u32x2*)(GR + qrow * 512 + hc + 16 * vt + 4 * g);
        const float y0 = (oT[vt][0] - mean) * rstd * bf_lo(gw.x), y1 = (oT[vt][1] - mean) * rstd * bf_hi(gw.x);
        const float y2 = (oT[vt][2] - mean) * rstd * bf_lo(gw.y), y3 = (oT[vt][3] - mean) * rstd * bf_hi(gw.y);
        u32x2 w; w.x = pk2(y0, y1); w.y = pk2(y2, y3);
#ifdef DBG_NORET
        w.x = 0u; w.y = 0u;
#endif
        *(u32x2*)(AR + qrow * 1024 + 512 + hc + 16 * vt + 4 * g) = w;
    }
    __syncthreads();
}

template <int N> __device__ __forceinline__ void bitonic_sort_desc(unsigned (&a)[N]) {
#pragma unroll
    for (int k = 2; k <= N; k <<= 1)
#pragma unroll
        for (int j = k >> 1; j > 0; j >>= 1)
#pragma unroll
            for (int i = 0; i < N; ++i) { const int l = i ^ j;
                if (l > i) { const unsigned x = a[i], y = a[l]; const unsigned mx = x > y ? x : y, mn = x > y ? y : x;
                    if ((i & k) == 0) { a[i] = mx; a[l] = mn; } else { a[i] = mn; a[l] = mx; } } }
}
template <int N> __device__ __forceinline__ void bitonic_merge_desc(unsigned (&a)[N]) {
#pragma unroll
    for (int j = N >> 1; j > 0; j >>= 1)
#pragma unroll
        for (int i = 0; i < N; ++i) { const int l = i ^ j;
            if (l > i) { const unsigned x = a[i], y = a[l]; a[i] = x > y ? x : y; a[l] = x > y ? y : x; } }
}
__device__ __forceinline__ void top16_merge(unsigned (&best)[16], const unsigned (&grp)[16]) {
#pragma unroll
    for (int i = 0; i < 16; ++i) { const unsigned x = best[i], y = grp[15 - i]; best[i] = x > y ? x : y; }
    bitonic_merge_desc<16>(best);
}
struct CandTab { int a[64], b[64], n; constexpr CandTab() : a{}, b{}, n(0) { for (int x = 0; x < 16; ++x) for (int y = 0; y < 16; ++y) if ((x + 1) * (y + 1) <= 16) { a[n] = x; b[n] = y; ++n; } } };
constexpr CandTab kCand{};
static_assert(kCand.n == 50, "staircase candidates");

constexpr int PL_EID = 0, PL_GATE = 16384, PL_IDX = 32768;
__device__ __forceinline__ void peer_unit(int unit, unsigned char* ws, float* outp, const float* gffn, const float* gfin, unsigned char* lds, int tid, int wave, int lane) {
    const float* SC = (const float*)(ws + WS_SC);
    const float* mod = (const float*)(ws + WS_MOD);
#ifndef DBG_NOPEER
    {
        const int tl = tid >> 4, h = (tid >> 1) & 7, p = tid & 1;
        const size_t row = (size_t)32 * unit + tl;
        const f32x4* sp = (const f32x4*)(SC + row * 2048 + h * 256 + p * 128);
        unsigned best[16];
#pragma unroll
        for (int grp = 0; grp < 8; ++grp) {
            unsigned k[16];
#pragma unroll
            for (int q4 = 0; q4 < 4; ++q4) { const f32x4 v = sp[4 * grp + q4];
#pragma unroll
                for (int e = 0; e < 4; ++e) k[4 * q4 + e] = (sortable32(v[e]) & ~127u) | (unsigned)(127 - (16 * grp + 4 * q4 + e)); }
            bitonic_sort_desc<16>(k);
            if (grp == 0) {
#pragma unroll
                for (int i = 0; i < 16; ++i) best[i] = k[i];
            } else top16_merge(best, k);
        }
        unsigned char* il = lds + PL_IDX + (tl * 8 + h) * 32;
#pragma unroll
        for (int i = 0; i < 4; ++i) { unsigned w = 0;
#pragma unroll
            for (int e = 0; e < 4; ++e) w |= (127u - (best[4 * i + e] & 127u)) << (8 * e);
            *(unsigned*)(il + p * 16 + 4 * i) = w; }
        float v1[16], v2[16];
#pragma unroll
        for (int i = 0; i < 16; ++i) { const unsigned o = __shfl_xor(best[i], 1); const float mine = unsortable32(best[i] & ~127u), oth = unsortable32(o & ~127u);
            v1[i] = p ? oth : mine; v2[i] = p ? mine : oth; }
        unsigned top[16];
#pragma unroll
        for (int grp = 0; grp < 4; ++grp) {
            unsigned k[16];
#pragma unroll
            for (int i = 0; i < 16; ++i) { const int c = 16 * grp + i;
                k[i] = (c < kCand.n) ? ((sortable32(v1[kCand.a[c < kCand.n ? c : 0]] + v2[kCand.b[c < kCand.n ? c : 0]]) & ~255u) | (unsigned)(255 - (16 * kCand.a[c < kCand.n ? c : 0] + kCand.b[c < kCand.n ? c : 0]))) : 0u; }
            bitonic_sort_desc<16>(k);
            if (grp == 0) {
#pragma unroll
                for (int i = 0; i < 16; ++i) top[i] = k[i];
            } else top16_merge(top, k);
        }
        float ts[16], es[16], sum = 0.f;
#pragma unroll
        for (int i = 0; i < 16; ++i) ts[i] = unsortable32(top[i] & ~255u);
#pragma unroll
        for (int i = 0; i < 16; ++i) { es[i] = __expf(ts[i] - ts[0]); sum += es[i]; }
        const float rs = 1.0f / sum;
        __builtin_amdgcn_wave_barrier(); asm volatile("s_waitcnt lgkmcnt(0)" ::: "memory");
        unsigned* eo = (unsigned*)(lds + PL_EID) + tl * 128 + h * 16;
        float* go = (float*)(lds + PL_GATE) + tl * 128 + h * 16;
#pragma unroll
        for (int i = 0; i < 16; ++i) {
            const unsigned flat = 255u - (top[i] & 255u);
            const unsigned i1 = il[flat >> 4], i2 = il[16 + (flat & 15u)];
            eo[i] = i1 * 128u + i2; go[i] = es[i] * rs;
        }
    }
#endif
    __syncthreads();
    const bf16_t* UBF = (const bf16_t*)(ws + WS_BUFB); const bf16_t* VBF = (const bf16_t*)(ws + WS_VBF);
#pragma unroll 1
    for (int ti = 0; ti < 4; ++ti) {
        const int tl = wave + 8 * ti; const size_t row = (size_t)32 * unit + tl; const int b = (int)(row >> 12);
        const float* mb = mod + b * 6144;
        float x1v[16], hv[16], acc[16];
        const float rstd = pg8::row_rstd((const float*)(ws + WS_SUMSQ), (int)row);
#pragma unroll
        for (int half = 0; half < 2; ++half)
#pragma unroll
            for (int q4 = 0; q4 < 2; ++q4) { const int c = 512 * half + 8 * lane + 4 * q4;
                const f32x4 xv = *(const f32x4*)(outp + row * DM + c), g = *(const f32x4*)(gffn + c), sc = *(const f32x4*)(mb + 4096 + c), sh = *(const f32x4*)(mb + 3072 + c);
#pragma unroll
                for (int e = 0; e < 4; ++e) { const int i = 8 * half + 4 * q4 + e; x1v[i] = xv[e]; hv[i] = xv[e] * rstd * g[e] * (1.0f + sc[e]) + sh[e]; acc[i] = 0.f; } }
        const unsigned* el = (const unsigned*)(lds + PL_EID) + tl * 128; const float* gl = (const float*)(lds + PL_GATE) + tl * 128;
#ifdef DBG_NOPEER
        for (int e0 = 0; e0 < 0; e0 += 4) {
#else
#pragma unroll 1
        for (int e0 = 0; e0 < 128; e0 += 4) {
#endif
            u32x4 uu[4][2], vv[4][2]; float gt[4];
#pragma unroll
            for (int k = 0; k < 4; ++k) { const unsigned eid = el[e0 + k]; gt[k] = gl[e0 + k];
                const u32x4* up = (const u32x4*)(UBF + (size_t)eid * 1024); const u32x4* vp = (const u32x4*)(VBF + (size_t)eid * 1024);
                uu[k][0] = up[lane]; uu[k][1] = up[64 + lane]; vv[k][0] = vp[lane]; vv[k][1] = vp[64 + lane]; }
#pragma unroll
            for (int k = 0; k < 4; ++k) {
                float d = 0.f;
#pragma unroll
                for (int half = 0; half < 2; ++half)
#pragma unroll
                    for (int i = 0; i < 4; ++i) { const unsigned w = uu[k][half][i]; d += hv[8 * half + 2 * i] * bf_lo(w) + hv[8 * half + 2 * i + 1] * bf_hi(w); }
                d = wave_sum(d);
                const float cf = gt[k] * gelu_exact(d);
#pragma unroll
                for (int half = 0; half < 2; ++half)
#pragma unroll
                    for (int i = 0; i < 4; ++i) { const unsigned w = vv[k][half][i]; acc[8 * half + 2 * i] += cf * bf_lo(w); acc[8 * half + 2 * i + 1] += cf * bf_hi(w); }
            }
        }
        float ss = 0.f;
#pragma unroll
        for (int half = 0; half < 2; ++half)
#pragma unroll
            for (int q4 = 0; q4 < 2; ++q4) { const int c = 512 * half + 8 * lane + 4 * q4; const f32x4 gf = *(const f32x4*)(mb + 5120 + c);
#pragma unroll
                for (int e = 0; e < 4; ++e) { const int i = 8 * half + 4 * q4 + e; x1v[i] = x1v[i] + gf[e] * acc[i]; ss += x1v[i] * x1v[i]; } }
        const float r2 = 1.0f / sqrtf(wave_sum(ss) * (1.0f / DM) + EPS);
#pragma unroll
        for (int half = 0; half < 2; ++half)
#pragma unroll
            for (int q4 = 0; q4 < 2; ++q4) { const int c = 512 * half + 8 * lane + 4 * q4; const f32x4 gn = *(const f32x4*)(gfin + c);
                f32x4 o;
#pragma unroll
                for (int e = 0; e < 4; ++e) o[e] = x1v[8 * half + 4 * q4 + e] * r2 * gn[e];
                *(f32x4*)(outp + row * DM + c) = o; }
    }
    __syncthreads();
}

#define XB_TMO      128
#define XB_XCNT(j)  (256  + 64 * (j))
#define XB_XSUB(j)  (1280 + 64 * (j))
#define XB_XGEN(j)  (2304 + 64 * (j))
#define XB_TOP      3328
#define XB_TOPGEN   3392
#define XCD_BAR_WORDS 3456
#define XB_SPIN_CAP (1u << 18)

__device__ __forceinline__ unsigned xb_ld(unsigned* p)              { return __hip_atomic_load(p, __ATOMIC_RELAXED, __HIP_MEMORY_SCOPE_AGENT); }
__device__ __forceinline__ unsigned xb_add(unsigned* p, unsigned v) { return __hip_atomic_fetch_add(p, v, __ATOMIC_RELAXED, __HIP_MEMORY_SCOPE_AGENT); }
__device__ __forceinline__ unsigned xb_xcc_id() { return (unsigned)__builtin_amdgcn_s_getreg((3 << 11) | 20) & 0xFu; }
#define XB_SPIN(cond, bar) do { unsigned _sp = 0; while (cond) { __builtin_amdgcn_s_sleep(1); \
    if ((++_sp & 255u) == 0u) { if (xb_ld(&(bar)[XB_TMO])) break; if (_sp > XB_SPIN_CAP) { atomicAdd(&(bar)[XB_TMO], 1u); break; } } } } while (0)

struct XcdBarrier {
    unsigned* bar; unsigned x;
    volatile LAS unsigned* st;
};

__device__ __forceinline__ XcdBarrier xcd_barrier_post(unsigned* bar, volatile LAS unsigned* st) {
    XcdBarrier b; b.bar = bar; b.x = xb_xcc_id(); b.st = st;
    if (threadIdx.x == 0) (void)xb_add(&bar[XB_XCNT(b.x)], 1u);
    return b;
}
__device__ __forceinline__ void xcd_barrier_complete(unsigned* bar, unsigned x, unsigned& nloc, unsigned& nx) {
    const unsigned G = gridDim.x * gridDim.y * gridDim.z;
    unsigned sum, cnt, mine, sp = 0u;
    for (;;) {
        sum = 0u; cnt = 0u; mine = 0u;
#pragma unroll
        for (unsigned j = 0; j < 16; ++j) { const unsigned c = xb_ld(&bar[XB_XCNT(j)]); sum += c; cnt += (c > 0u) ? 1u : 0u; mine = (j == x) ? c : mine; }
        if (sum == G) break;
        __builtin_amdgcn_s_sleep(1);
        if ((++sp & 255u) == 0u) { if (xb_ld(&bar[XB_TMO])) break; if (sp > XB_SPIN_CAP) { atomicAdd(&bar[XB_TMO], 1u); break; } }
    }
    nloc = mine > 0u ? mine : 1u; nx = cnt > 0u ? cnt : 1u;
}

__device__ __forceinline__ void xcd_barrier(const XcdBarrier& b) {
    asm volatile("s_waitcnt vmcnt(0)" ::: "memory");
    __syncthreads();
    if (threadIdx.x == 0) {
        unsigned* bar = b.bar;
        __builtin_amdgcn_s_waitcnt(0);
        unsigned nloc = b.st[0], nx = b.st[1];
        if (nloc == 0u) { xcd_barrier_complete(bar, b.x, nloc, nx); b.st[0] = nloc; b.st[1] = nx; }
        const unsigned old = xb_add(&bar[XB_XSUB(b.x)], 1u);
        const unsigned gen = old / nloc;
        if (old + 1u == (gen + 1u) * nloc) {
            __builtin_amdgcn_fence(__ATOMIC_RELEASE, "agent");
            asm volatile("s_waitcnt vmcnt(0)" ::: "memory");
            const unsigned og = xb_add(&bar[XB_TOP], 1u);
            const unsigned tg = og / nx;
            if (og + 1u == (tg + 1u) * nx) xb_add(&bar[XB_TOPGEN], 1u);
            else XB_SPIN(xb_ld(&bar[XB_TOPGEN]) == tg, bar);
            __builtin_amdgcn_fence(__ATOMIC_ACQUIRE, "agent");
            xb_add(&bar[XB_XGEN(b.x)], 1u);
            asm volatile("s_waitcnt vmcnt(0)" ::: "memory");
        } else {
            XB_SPIN(xb_ld(&bar[XB_XGEN(b.x)]) == gen, bar);
            __builtin_amdgcn_fence(__ATOMIC_ACQUIRE, "agent");
            asm volatile("s_waitcnt vmcnt(0)" ::: "memory");
        }
    }
    __syncthreads();
}

constexpr int N_PHASES = 8;
__global__ void __launch_bounds__(NTHREADS, 2) mega(Args a) {
    extern __shared__ __attribute__((aligned(16))) unsigned char lds[];
    const int tid = threadIdx.x, lane = tid & 63, wave = __builtin_amdgcn_readfirstlane(tid >> 6);
    const int bid = blockIdx.x, G = gridDim.x;
    unsigned char* ws = a.ws;
    const int lo = a.ph_lo, hi = a.ph_hi;
    volatile LAS unsigned* MISC = (volatile LAS unsigned*)((LAS unsigned char*)lds + MISC_OFF);
    if (tid < 16) MISC[tid] = 0u;
    __syncthreads();
    XcdBarrier bar; bar.bar = (unsigned*)(ws + WS_CTL) + CW_BAR; bar.x = 0; bar.st = nullptr;
    if (hi - lo > 1) bar = xcd_barrier_post((unsigned*)(ws + WS_CTL) + CW_BAR, MISC + 8);
#ifndef PH_MASK
#define PH_MASK 0xFF
#endif
#define IN(k) (((PH_MASK >> (k)) & 1) && lo <= (k) && (k) < hi)
#define SEAM(k) do { if (IN(k) && IN((k) + 1)) { xcd_barrier(bar); } } while (0)
#ifndef REP_PH
#define REP_PH -1
#endif
#ifndef REP_N
#define REP_N 1
#endif
#define REPS(k) for (int rep_ = 0; rep_ < ((k) == REP_PH ? 1 + REP_N : 1); ++rep_, ((k) == REP_PH && rep_ <= REP_N ? (xcd_barrier(bar), 0) : 0))

    REPS(0) if (IN(0)) phase0(a, lds, tid, wave, lane, bid, G);
    SEAM(0);
    REPS(1) if (IN(1)) phase1(a, wave, lane, bid, G);
    SEAM(1);
    REPS(2) if (IN(2)) {
        pg8::Gemm g{(const bf16_t*)(ws + WS_BUFA), (const bf16_t*)(ws + WS_WIN), MTOK, N1, DM}; pg8::StaticOrder S; S.init(MTOK, N1, G, bid);
        pg8::Epi1 E{ws};
        pg8::gemm_phase<pg8::Epi1, pg8::StaticOrder, true, true>((LAS unsigned char*)lds, g, S, E);
    }
    SEAM(2);
    REPS(3) if (IN(3)) {
#ifndef NO_RS
        for (int u = bid; u < 128; u += G)
            ret_state_unit(u >> 5, (u >> 3) & 3, u & 7, (const bf16_t*)(ws + WS_KR), (const bf16_t*)(ws + WS_VR), (bf16_t*)(ws + WS_STATE), lds, tid, wave, lane);
#endif
        for (int k = bid; k < 256; k += G)
#pragma unroll 1
            for (int i = 0; i < 4; ++i) {
                const int b = i, qt = (i < 2) ? k : 255 - k;
                idx_unit(b, qt, (const bf16_t*)(ws + WS_QI), (const bf16_t*)(ws + WS_KI), (const float*)(ws + WS_WI), (unsigned long long*)(ws + WS_MASK), lds, wave, lane);
            }
    }
    SEAM(3);
    REPS(4) if (IN(4)) {
        for (int k = bid; k < 256; k += G) {
            const int bh = k >> 3, s = k & 7;
#pragma unroll 1
            for (int i = 0; i < 2; ++i)
                attn_unit(bh >> 3, bh & 7, i ? 15 - s : s, (const bf16_t*)(ws + WS_QA), (const bf16_t*)(ws + WS_KA), (const bf16_t*)(ws + WS_VA), (const unsigned long long*)(ws + WS_MASK),
                          (bf16_t*)(ws + WS_BUFB), lds, tid, wave, lane);
        }
        for (int u = bid; u < 512; u += G)
            ret_out_unit(u >> 7, (u >> 5) & 3, u & 31, (const bf16_t*)(ws + WS_QR), (const bf16_t*)(ws + WS_KR), (const bf16_t*)(ws + WS_VR), (const bf16_t*)(ws + WS_GR),
                         (const bf16_t*)(ws + WS_STATE), (bf16_t*)(ws + WS_BUFB), lds, tid, wave, lane);
    }
    SEAM(4);
    REPS(5) if (IN(5)) {
        pg8::Gemm g{(const bf16_t*)(ws + WS_BUFB), (const bf16_t*)(ws + WS_WOUT), MTOK, DM, DM}; pg8::StaticOrder S; S.init(MTOK, DM, G, bid);
        pg8::Epi2 E{a.in[0], a.out, (bf16_t*)(ws + WS_BUFA), (const float*)(ws + WS_MOD), a.in[7], (float*)(ws + WS_SUMSQ)};
        pg8::gemm_phase<pg8::Epi2, pg8::StaticOrder, true, true>((LAS unsigned char*)lds, g, S, E);
    }
    SEAM(5);
    REPS(6) if (IN(6)) {
        const int gw = bid * 8 + wave, NGW = G * 8;
        for (int r = gw; r < 16384; r += NGW) row_to_bf16(a.in[10] + (size_t)r * 1024, (bf16_t*)(ws + WS_BUFB) + (size_t)r * 1024, lane);
        __syncthreads();
        pg8::Gemm g{(const bf16_t*)(ws + WS_BUFA), (const bf16_t*)(ws + WS_WPQ), MTOK, 2048, DM}; pg8::StaticOrder S; S.init(MTOK, 2048, G, bid);
        pg8::Epi3 E{(const float*)(ws + WS_SUMSQ), (const float*)(ws + WS_BIASF), (float*)(ws + WS_SC)};
        pg8::gemm_phase<pg8::Epi3, pg8::StaticOrder, true, true>((LAS unsigned char*)lds, g, S, E);
    }
    SEAM(6);
    if (IN(7)) {
        for (int u = bid; u < 512; u += G) peer_unit(u, ws, a.out, a.in[7], a.in[12], lds, tid, wave, lane);
    }
#undef IN
#undef SEAM
}

extern "C" void kernel_launch(void* const* d_in, const int* in_sizes, int n_in, void* d_out, int out_size, void* d_ws, size_t ws_size, hipStream_t stream) {
    static int grid = 0;
    if (grid == 0) {
        if (n_in != 13 || out_size != MTOK * DM || ws_size < WS_END) { fprintf(stderr, "kernel_launch: unexpected shapes (n_in %d, out %d, ws %zu); nothing launched\n", n_in, out_size, ws_size); grid = -1; return; }
        int dev = 0, cus = 0, per_cu = 0;
        if (hipGetDevice(&dev) != hipSuccess || hipDeviceGetAttribute(&cus, hipDeviceAttributeMultiprocessorCount, dev) != hipSuccess) { grid = -1; return; }
        if (hipFuncSetAttribute((const void*)mega, hipFuncAttributeMaxDynamicSharedMemorySize, LDS_BYTES) != hipSuccess) { fprintf(stderr, "kernel_launch: hipFuncSetAttribute failed\n"); grid = -1; return; }
        if (hipOccupancyMaxActiveBlocksPerMultiprocessor(&per_cu, (const void*)mega, NTHREADS, LDS_BYTES) != hipSuccess || per_cu < 1) { fprintf(stderr, "kernel_launch: occupancy query gave %d\n", per_cu); per_cu = 1; }
        (void)hipGetLastError();
        grid = cus;
    }
    if (grid < 0) return;
    if (hipMemsetAsync((char*)d_ws + WS_CTL, 0, CTL_BYTES, stream) != hipSuccess) { fprintf(stderr, "kernel_launch: memset failed\n"); return; }
    Args a{};
    for (int i = 0; i < 13; ++i) a.in[i] = (const float*)d_in[i];
    a.out = (float*)d_out; a.ws = (unsigned char*)d_ws;
#if MK_MULTI
    for (int p = 0; p < N_PHASES; ++p) { a.ph_lo = p; a.ph_hi = p + 1; hipLaunchKernelGGL(mega, dim3(grid), dim3(NTHREADS), LDS_BYTES, stream, a); }
#else
    a.ph_lo = 0; a.ph_hi = N_PHASES;
    hipLaunchKernelGGL(mega, dim3(grid), dim3(NTHREADS), LDS_BYTES, stream, a);
#endif
}
```

```cpp
#include <hip/hip_runtime.h>
#include <cstdio>
#include <cstdint>

#ifndef MK_MULTI
#define MK_MULTI 0
#endif

#define GAS __attribute__((address_space(1)))
#define LAS __attribute__((address_space(3)))
typedef unsigned short bf16_t;
typedef short bf16x8 __attribute__((ext_vector_type(8)));
typedef float f32x4 __attribute__((ext_vector_type(4)));
typedef float f32x16 __attribute__((ext_vector_type(16)));
typedef unsigned u32x4 __attribute__((ext_vector_type(4)));
typedef unsigned u32x2 __attribute__((ext_vector_type(2)));

constexpr int BATCH = 4, SEQ = 4096, DM = 1024, MTOK = BATCH * SEQ;
constexpr int N1 = 4352;
constexpr int NTHREADS = 512;
constexpr float EPS = 1e-6f;
constexpr float C_QK = 0.18033688011112042f;
constexpr float NEG_INF = -__builtin_huge_valf();

__device__ __forceinline__ float ret_log2g(int h) { return h == 0 ? -0.045803689613124791f : h == 1 ? -0.022720076500083530f : h == 2 ? -0.011315313227834147f : -0.0056465631411420624f; }
__device__ __forceinline__ float ret_gamma(int h) { return h == 0 ? 0.96875f : h == 1 ? 0.984375f : h == 2 ? 0.9921875f : 0.99609375f; }
__device__ __forceinline__ float ret_g128(int h) { return h == 0 ? 0.017183023570817902f : h == 1 ? 0.13321516287964842f : h == 2 ? 0.36643771592203725f : 0.60593708822908032f; }
__device__ __forceinline__ float ret_g127(int h) { return h == 0 ? 0.017737314653747512f : h == 1 ? 0.13532968927456347f : h == 2 ? 0.36932305226788007f : 0.60831331210448848f; }

constexpr size_t MiB = 1u << 20;
constexpr size_t WS_CTL = 0, CTL_BYTES = 1 * MiB;
constexpr size_t WS_SUMSQ = 5 * MiB;
constexpr size_t WS_MOD = 1 * MiB;
constexpr size_t WS_BIASF = 1 * MiB + 128 * 1024;
constexpr size_t WS_COSA = 2 * MiB, WS_SINA = 2 * MiB + 512 * 1024;
constexpr size_t WS_COSR = 3 * MiB, WS_SINR = 4 * MiB;
constexpr size_t WS_WIN = 6 * MiB;
constexpr size_t WS_WOUT = 15 * MiB;
constexpr size_t WS_WPQ = 17 * MiB;
constexpr size_t WS_BUFA = 22 * MiB;
constexpr size_t WS_MASK = WS_BUFA, WS_STATE = WS_BUFA + 8 * MiB;
constexpr size_t WS_BUFB = 54 * MiB;
constexpr size_t WS_G1 = 86 * MiB;
constexpr size_t WS_QA = WS_G1, WS_KA = WS_G1 + 16 * MiB, WS_VA = WS_G1 + 32 * MiB, WS_QI = WS_G1 + 48 * MiB, WS_QR = WS_G1 + 64 * MiB,
                 WS_KR = WS_G1 + 80 * MiB, WS_VR = WS_G1 + 96 * MiB, WS_GR = WS_G1 + 112 * MiB, WS_KI = WS_G1 + 128 * MiB, WS_WI = WS_G1 + 130 * MiB;
constexpr size_t WS_SC = WS_G1;
constexpr size_t WS_U8 = 217 * MiB, WS_V8 = 233 * MiB;
constexpr size_t WS_USC = 249 * MiB, WS_VSC = 249 * MiB + 65536;
constexpr size_t WS_END = 256 * MiB;
static_assert(WS_WI + (size_t)MTOK * 8 * 4 <= WS_U8 && WS_SC + (size_t)MTOK * 2048 * 4 <= WS_U8 && WS_VSC + 65536 <= WS_END, "ws map");
constexpr int LDS_BYTES = 147456;
constexpr int MISC_OFF = LDS_BYTES - 64;
constexpr int CW_BAR = 4096;

__device__ __forceinline__ unsigned f2bf(float f) { unsigned u = __float_as_uint(f); return (u + 0x7fffu + ((u >> 16) & 1u)) >> 16; }
__device__ __forceinline__ unsigned pk2(float lo, float hi) { return f2bf(lo) | (f2bf(hi) << 16); }
__device__ __forceinline__ float bf_lo(unsigned w) { return __uint_as_float(w << 16); }
__device__ __forceinline__ float bf_hi(unsigned w) { return __uint_as_float(w & 0xffff0000u); }
__device__ __forceinline__ float wave_sum(float v) {
#pragma unroll
    for (int o = 1; o < 64; o <<= 1) v += __shfl_xor(v, o);
    return v;
}
__device__ __forceinline__ float fast_exp2(float x) { return __builtin_amdgcn_exp2f(x); }
__device__ __forceinline__ float gelu_exact(float v) {
    const float av = fabsf(v), t = __builtin_amdgcn_rcpf(av * 0.2316418882f + 1.0f);
    float q = t * 0.5307027145f + (-0.7265760135f); q = q * t + 0.7107068705f; q = q * t + (-0.142248368f); q = q * t + 0.127414796f; q = q * t;
    const float e = fast_exp2(v * v * (-0.72134752044f));
    const float m = v * (q * e);
    return v < 0.f ? m : v - m;
}
__device__ __forceinline__ float silu_f(float v) { return v / (1.0f + __expf(-v)); }
__device__ __forceinline__ unsigned sortable32(float f) { const unsigned u = __float_as_uint(f); return (u & 0x80000000u) ? ~u : (u | 0x80000000u); }
__device__ __forceinline__ float unsortable32(unsigned s) { return __uint_as_float((s & 0x80000000u) ? (s ^ 0x80000000u) : ~s); }
__device__ __forceinline__ unsigned sortable16(float x) {
    const _Float16 h = (_Float16)x; const unsigned b = (unsigned)__builtin_bit_cast(unsigned short, h);
    return (b & 0x8000u) ? (~b & 0xFFFFu) : (b | 0x8000u);
}
__device__ __forceinline__ f32x4 mfma16(bf16x8 a, bf16x8 b, f32x4 c) { return __builtin_amdgcn_mfma_f32_16x16x32_bf16(a, b, c, 0, 0, 0); }
__device__ __forceinline__ f32x16 mfma32(bf16x8 a, bf16x8 b, f32x16 c) { return __builtin_amdgcn_mfma_f32_32x32x16_bf16(a, b, c, 0, 0, 0); }

__host__ __device__ __forceinline__ int win_src_col(int p) {
    const int tile = p >> 8, bj = (p >> 7) & 1, q = p & 127;
    if (tile < 4) return 256 * tile + (q >> 5) * 64 + bj * 32 + (q & 31);
    if (tile < 6) return p;
    if (tile < 8) return 256 * tile + (q >> 5) * 64 + bj * 32 + (q & 31);
    if (tile == 8) { if (q < 32) return 2048 + bj * 32 + q; if (bj == 0 && q < 40) return 2112 + (q - 32); return -1; }
    if (tile < 13) { const int base = (tile < 11) ? 2120 + 256 * (tile - 9) : 2632 + 256 * (tile - 11); return base + (q >> 6) * 128 + bj * 64 + (q & 63); }
    if (tile < 15) return 3144 + (p - 13 * 256);
    return 3656 + (p - 15 * 256);
}
namespace pg8 {
#define PG8_LAS __attribute__((address_space(3)))
typedef unsigned short bf16_t;
typedef short bf16x8 __attribute__((ext_vector_type(8)));
typedef float f32x4 __attribute__((ext_vector_type(4)));
typedef unsigned u32x4 __attribute__((ext_vector_type(4)));
constexpr int BM = 256, BK = 64, HALF = 128, HTB = HALF * BK * 2  , STAGE_BYTES = 8 * HTB, NXCD = 8, WGM = 8;

__host__ __device__ __forceinline__ int lds_byte(int r, int c) { const int st = (r >> 4) * 2 + (c >> 5), rr = r & 15, cc = c & 31, ob = rr * 64 + cc * 2; return st * 1024 + (ob ^ (((ob >> 9) & 1) << 5)); }
__host__ __device__ __forceinline__ void stage_rc(int b, int& R, int& C) { const int st = b / 1024, sb = b % 1024, swz = sb ^ (((sb >> 9) & 1) << 5); R = (st >> 1) * 16 + swz / 64; C = (st & 1) * 32 + (swz % 64) / 2; }
__host__ __device__ __forceinline__ int perm32(int rho) { const int n = rho >> 4, i = rho & 15; return 8 * (i >> 2) + 4 * n + (i & 3); }

struct Unit { int pm, pn; };
struct Gemm { const bf16_t* A; const bf16_t* Bt; int M, N, K; };

struct StaticOrder {
    int nM, nN, nwg, G, c;
    __host__ __device__ void init(int M, int N, int G_, int c_) { nM = M / BM; nN = N / BM; nwg = nM * nN; G = G_; c = c_; }
    __host__ __device__ bool next(int i, Unit& u) const {
        const long L = (long)i * G + c; if (L >= nwg) return false;
        int wgid = (int)L; { const int q = nwg / NXCD, r = nwg % NXCD, xcd = wgid % NXCD, off = wgid / NXCD; wgid = (xcd < r ? xcd * (q + 1) : r * (q + 1) + (xcd - r) * q) + off; }
        const int nig = WGM * nN, gid = wgid / nig, fm = gid * WGM, gsz = (nM - fm) < WGM ? (nM - fm) : WGM;
        u.pm = fm + ((wgid % nig) % gsz); u.pn = (wgid % nig) / gsz; return true;
    }
    __device__ __forceinline__ void a_ready(const Unit&) const {}
    __device__ __forceinline__ void done(const Unit&) const {}
};

__device__ __forceinline__ unsigned cvt_pk_bf16(float lo, float hi) { unsigned r; asm volatile("v_cvt_pk_bf16_f32 %0, %1, %2" : "=v"(r) : "v"(lo), "v"(hi)); return r; }
__device__ __forceinline__ u32x4 pack8(const float (&v)[8]) { u32x4 w; w.x = cvt_pk_bf16(v[0], v[1]); w.y = cvt_pk_bf16(v[2], v[3]); w.z = cvt_pk_bf16(v[4], v[5]); w.w = cvt_pk_bf16(v[6], v[7]); return w; }

struct Epi1 {
    static constexpr bool PERM = true, AFTER_DRAIN = false;
    unsigned char* ws;
    __device__ __forceinline__ void operator()(const f32x4 (&acc)[2][2][4][2], const Unit& u, int wr, int wc, int fr, int fq) const {
        const int tile = u.pn;
        const int row0 = u.pm * BM + wr * 64 + fr;
        const float* cosA = (const float*)(ws + WS_COSA); const float* sinA = (const float*)(ws + WS_SINA);
        const float* cosR = (const float*)(ws + WS_COSR); const float* sinR = (const float*)(ws + WS_SINR);
        if (tile < 4 || tile == 6 || tile == 7) {
            bf16_t* dst = (bf16_t*)(ws + (tile < 2 ? WS_QA : tile < 4 ? WS_KA : WS_QI));
            const int tl = tile < 2 ? tile : tile < 4 ? tile - 2 : tile - 6;
            const float scale = tile < 2 ? C_QK : 1.0f;
            const int cb = 256 * tl + 64 * wc, i0 = 8 * fq;
#pragma unroll
            for (int ai = 0; ai < 2; ++ai)
#pragma unroll
                for (int m = 0; m < 4; ++m) {
                    const int row = row0 + ai * HALF + m * 16, pos = row & (SEQ - 1);
                    const f32x4 c0 = *(const f32x4*)(cosA + pos * 32 + i0), c1 = *(const f32x4*)(cosA + pos * 32 + i0 + 4);
                    const f32x4 s0 = *(const f32x4*)(sinA + pos * 32 + i0), s1 = *(const f32x4*)(sinA + pos * 32 + i0 + 4);
                    float y1[8], y2[8];
#pragma unroll
                    for (int n = 0; n < 2; ++n)
#pragma unroll
                        for (int e = 0; e < 4; ++e) {
                            const float x1 = acc[ai][0][m][n][e], x2 = acc[ai][1][m][n][e];
                            const float c = n ? c1[e] : c0[e], s = n ? s1[e] : s0[e];
                            y1[4 * n + e] = (x1 * c - x2 * s) * scale; y2[4 * n + e] = (x1 * s + x2 * c) * scale;
                        }
                    bf16_t* rp = dst + (size_t)row * 512 + cb + i0;
                    *(u32x4*)rp = pack8(y1); *(u32x4*)(rp + 32) = pack8(y2);
                }
        } else if (tile == 4 || tile == 5 || tile >= 13) {
            bf16_t* dst = (bf16_t*)(ws + (tile < 6 ? WS_VA : tile < 15 ? WS_VR : WS_GR));
            const int tl = tile < 6 ? tile - 4 : tile < 15 ? tile - 13 : tile - 15;
            const bool act = tile >= 15;
#pragma unroll
            for (int ai = 0; ai < 2; ++ai)
#pragma unroll
                for (int m = 0; m < 4; ++m) {
                    const int row = row0 + ai * HALF + m * 16;
#pragma unroll
                    for (int bj = 0; bj < 2; ++bj) {
                        float y[8];
#pragma unroll
                        for (int n = 0; n < 2; ++n)
#pragma unroll
                            for (int e = 0; e < 4; ++e) { const float v = acc[ai][bj][m][n][e]; y[4 * n + e] = act ? silu_f(v) : v; }
                        *(u32x4*)(dst + (size_t)row * 512 + 256 * tl + 128 * bj + 32 * wc + 8 * fq) = pack8(y);
                    }
                }
        } else if (tile == 8) {
#pragma unroll
            for (int ai = 0; ai < 2; ++ai)
#pragma unroll
                for (int m = 0; m < 4; ++m) {
                    const int row = row0 + ai * HALF + m * 16, pos = row & (SEQ - 1);
                    if (wc == 0) {
                        const int i0 = 8 * fq;
                        const f32x4 c0 = *(const f32x4*)(cosA + pos * 32 + i0), c1 = *(const f32x4*)(cosA + pos * 32 + i0 + 4);
                        const f32x4 s0 = *(const f32x4*)(sinA + pos * 32 + i0), s1 = *(const f32x4*)(sinA + pos * 32 + i0 + 4);
                        float y1[8], y2[8];
#pragma unroll
                        for (int n = 0; n < 2; ++n)
#pragma unroll
                            for (int e = 0; e < 4; ++e) {
                                const float x1 = acc[ai][0][m][n][e], x2 = acc[ai][1][m][n][e];
                                const float c = n ? c1[e] : c0[e], s = n ? s1[e] : s0[e];
                                y1[4 * n + e] = x1 * c - x2 * s; y2[4 * n + e] = x1 * s + x2 * c;
                            }
                        bf16_t* rp = (bf16_t*)(ws + WS_KI) + (size_t)row * 64 + i0;
                        *(u32x4*)rp = pack8(y1); *(u32x4*)(rp + 32) = pack8(y2);
                    } else if (wc == 1 && fq == 0) {
                        const float sw = 0.35355339059327379f;
                        float* WI = (float*)(ws + WS_WI);
                        *(f32x4*)(WI + (size_t)row * 8) = acc[ai][0][m][0] * sw;
                        *(f32x4*)(WI + (size_t)row * 8 + 4) = acc[ai][0][m][1] * sw;
                    }
                }
        } else {
            const bool isk = tile >= 11;
            bf16_t* dst = (bf16_t*)(ws + (isk ? WS_KR : WS_QR));
            const int tl = isk ? tile - 11 : tile - 9, hl = wc >> 1, h = 2 * tl + hl;
            const int i0 = 32 * (wc & 1) + 8 * fq, cb = 256 * tl + 128 * hl;
            const float lg = isk ? -ret_log2g(h) : ret_log2g(h);
            const float base = isk ? 0.08838834764831845f : 1.0f;
#pragma unroll
            for (int ai = 0; ai < 2; ++ai)
#pragma unroll
                for (int m = 0; m < 4; ++m) {
                    const int row = row0 + ai * HALF + m * 16, pos = row & (SEQ - 1);
                    const float dec = base * fast_exp2(lg * (float)(pos & 127));
                    const f32x4 c0 = *(const f32x4*)(cosR + pos * 64 + i0), c1 = *(const f32x4*)(cosR + pos * 64 + i0 + 4);
                    const f32x4 s0 = *(const f32x4*)(sinR + pos * 64 + i0), s1 = *(const f32x4*)(sinR + pos * 64 + i0 + 4);
                    float y1[8], y2[8];
#pragma unroll
                    for (int n = 0; n < 2; ++n)
#pragma unroll
                        for (int e = 0; e < 4; ++e) {
                            const float x1 = acc[ai][0][m][n][e], x2 = acc[ai][1][m][n][e];
                            const float c = n ? c1[e] : c0[e], s = n ? s1[e] : s0[e];
                            y1[4 * n + e] = (x1 * c - x2 * s) * dec; y2[4 * n + e] = (x1 * s + x2 * c) * dec;
                        }
                    bf16_t* rp = dst + (size_t)row * 512 + cb + i0;
                    *(u32x4*)rp = pack8(y1); *(u32x4*)(rp + 64) = pack8(y2);
                }
        }
    }
};

__device__ __forceinline__ float row_rstd(const float* sumsq, int row) {
    const f32x4* p = (const f32x4*)(sumsq + (size_t)row * 16);
    const f32x4 a = p[0], b = p[1], c = p[2], d = p[3];
    const float s = (((a[0] + a[1]) + (a[2] + a[3])) + ((b[0] + b[1]) + (b[2] + b[3]))) + (((c[0] + c[1]) + (c[2] + c[3])) + ((d[0] + d[1]) + (d[2] + d[3])));
    return 1.0f / sqrtf(s * (1.0f / DM) + EPS);
}
struct Epi2 {
    static constexpr bool PERM = false, AFTER_DRAIN = false;
    const float* x; float* x1; bf16_t* a3; const float* mod; const float* gffn; float* sumsq;
    __device__ __forceinline__ void operator()(const f32x4 (&acc)[2][2][4][2], const Unit& u, int wr, int wc, int fr, int fq) const {
        const int row0 = u.pm * BM + wr * 64 + fr, col0 = u.pn * BM + wc * 32 + 4 * fq;
#pragma unroll
        for (int ai = 0; ai < 2; ++ai)
#pragma unroll
            for (int m = 0; m < 4; ++m) {
                const int row = row0 + ai * HALF + m * 16, b = row >> 12;
                const float* mb = mod + b * 6144;
                float ss = 0.f;
#pragma unroll
                for (int bj = 0; bj < 2; ++bj)
#pragma unroll
                    for (int n = 0; n < 2; ++n) {
                        const int c = col0 + bj * HALF + n * 16;
                        const f32x4 xv = *(const f32x4*)(x + (size_t)row * DM + c), gt = *(const f32x4*)(mb + 2048 + c);
#ifdef DBG_NOMIX
                        const f32x4 v = xv;
#else
                        const f32x4 v = xv + gt * acc[ai][bj][m][n];
#endif
                        *(f32x4*)(x1 + (size_t)row * DM + c) = v;
                        ss += (v[0] * v[0] + v[1] * v[1]) + (v[2] * v[2] + v[3] * v[3]);
                        const f32x4 gs = *(const f32x4*)(gffn + c) * (*(const f32x4*)(mb + 4096 + c) + 1.0f);
                        const f32x4 a = v * gs;
                        u32x2 w; w.x = cvt_pk_bf16(a[0], a[1]); w.y = cvt_pk_bf16(a[2], a[3]);
                        *(u32x2*)(a3 + (size_t)row * DM + c) = w;
                    }
                ss += __shfl_xor(ss, 16); ss += __shfl_xor(ss, 32);
                if (fq == 0) sumsq[(size_t)row * 16 + u.pn * 4 + wc] = ss;
            }
    }
};

struct Epi3 {
    static constexpr bool PERM = false, AFTER_DRAIN = false;
    const float* sumsq; const float* biasf; float* sc;
    __device__ __forceinline__ void operator()(const f32x4 (&acc)[2][2][4][2], const Unit& u, int wr, int wc, int fr, int fq) const {
        const int row0 = u.pm * BM + wr * 64 + fr, col0 = u.pn * BM + wc * 32 + 4 * fq;
#pragma unroll
        for (int ai = 0; ai < 2; ++ai)
#pragma unroll
            for (int m = 0; m < 4; ++m) {
                const int row = row0 + ai * HALF + m * 16, b = row >> 12;
                const float rstd = row_rstd(sumsq, row);
#pragma unroll
                for (int bj = 0; bj < 2; ++bj)
#pragma unroll
                    for (int n = 0; n < 2; ++n) {
                        const int c = col0 + bj * HALF + n * 16;
                        *(f32x4*)(sc + (size_t)row * 2048 + c) = acc[ai][bj][m][n] * rstd + *(const f32x4*)(biasf + b * 2048 + c);
                    }
            }
    }
};

template <class Epi, class Sched, bool ALIGN_EPI = false, bool SP2 = false>
__device__ __forceinline__ void gemm_phase(PG8_LAS unsigned char* lds, const Gemm g, const Sched& S, const Epi& E) {
    const int tid = threadIdx.x, wid = __builtin_amdgcn_readfirstlane(tid >> 6), lane = tid & 63, wr = wid >> 2, wc = wid & 3, fr = lane & 15, fq = lane >> 4;
    const int K = g.K, nt = K / BK;
    unsigned voffA[2], voffB[2];
#pragma unroll
    for (int i = 0; i < 2; ++i) { int R, C; stage_rc(tid * 16 + i * 8192, R, C); const int Rb = Epi::PERM ? ((R & ~31) + perm32(R & 31)) : R;
        voffA[i] = (unsigned)(R * K + C) * 2u; voffB[i] = (unsigned)(Rb * K + C) * 2u; }
    const size_t kstep = (size_t)(BK * 2);
    const size_t hstep = (size_t)HALF * K * 2;
    const size_t tstep = 2 * hstep;
    const unsigned ldsw = (unsigned)wid * 1024u;
    const int aoff = lds_byte(wr * 64 + fr, fq * 8), boff = lds_byte(wc * 32 + fr, fq * 8);
#define PG8_SA(b, h) (((b) * 2 + (h)) * HTB)
#define PG8_SB(b, h) ((4 + (b) * 2 + (h)) * HTB)
#define PG8_STAGE(bufoff, gbase, voff) do { _Pragma("unroll") for (int _i = 0; _i < 2; ++_i) \
        __builtin_amdgcn_global_load_lds((const unsigned*)((const char*)(gbase) + (voff)[_i]), (PG8_LAS unsigned*)(lds + (bufoff) + ldsw + _i * 8192), 16, 0, 0); } while (0)
#define PG8_LDA(dst, b, h) do { _Pragma("unroll") for (int m = 0; m < 4; ++m) _Pragma("unroll") for (int k = 0; k < 2; ++k) dst[m][k] = *(const PG8_LAS bf16x8*)(lds + PG8_SA(b, h) + aoff + m * 2048 + k * 1024); } while (0)
#define PG8_LDB(dst, b, h) do { _Pragma("unroll") for (int n = 0; n < 2; ++n) _Pragma("unroll") for (int k = 0; k < 2; ++k) dst[n][k] = *(const PG8_LAS bf16x8*)(lds + PG8_SB(b, h) + boff + n * 2048 + k * 1024); } while (0)
#define PG8_MMA(ai, bj, At, Bt) do { __builtin_amdgcn_s_setprio(1); _Pragma("unroll") for (int m = 0; m < 4; ++m) _Pragma("unroll") for (int n = 0; n < 2; ++n) _Pragma("unroll") for (int k = 0; k < 2; ++k) \
        acc[ai][bj][m][n] = __builtin_amdgcn_mfma_f32_16x16x32_bf16(Bt[n][k], At[m][k], acc[ai][bj][m][n], 0, 0, 0); __builtin_amdgcn_s_setprio(0); } while (0)
#define PG8_WAIT_V(n) asm volatile("s_waitcnt vmcnt(" #n ")" ::: "memory")
#define PG8_WAIT_L(n) asm volatile("s_waitcnt lgkmcnt(" #n ")" ::: "memory")
#define PG8_BAR __builtin_amdgcn_s_barrier()
#define PG8_SCHED __builtin_amdgcn_sched_barrier(0)
    Unit cur, nxt; int ui = 0;
    if (!S.next(0, cur)) return;
    f32x4 acc[2][2][4][2];
#pragma unroll
    for (int a = 0; a < 2; ++a)
#pragma unroll
        for (int b = 0; b < 2; ++b)
#pragma unroll
            for (int m = 0; m < 4; ++m)
#pragma unroll
                for (int n = 0; n < 2; ++n) acc[a][b][m][n] = (f32x4){0.f, 0.f, 0.f, 0.f};
    bf16x8 At[4][2], B0[2][2], B1[2][2];
    const char* cA = (const char*)g.A + (size_t)cur.pm * tstep; const char* cB = (const char*)g.Bt + (size_t)cur.pn * tstep;
    S.a_ready(cur);
    if constexpr (SP2) {
        PG8_STAGE(PG8_SB(0, 0), cB, voffB); PG8_STAGE(PG8_SB(0, 1), cB + hstep, voffB); PG8_STAGE(PG8_SA(0, 0), cA, voffA); PG8_STAGE(PG8_SA(0, 1), cA + hstep, voffA);
        if (wr == 1) PG8_BAR;
        PG8_WAIT_V(2); PG8_BAR;
        PG8_STAGE(PG8_SB(1, 0), cB + kstep, voffB); PG8_STAGE(PG8_SA(1, 0), cA + kstep, voffA); PG8_STAGE(PG8_SB(1, 1), cB + hstep + kstep, voffB);
        PG8_WAIT_V(6); PG8_BAR;
    } else {
        PG8_STAGE(PG8_SB(0, 0), cB, voffB); PG8_STAGE(PG8_SA(0, 0), cA, voffA); PG8_STAGE(PG8_SB(0, 1), cB + hstep, voffB); PG8_STAGE(PG8_SA(0, 1), cA + hstep, voffA);
        if (wr == 1) PG8_BAR;
        PG8_WAIT_V(4); PG8_BAR;
        PG8_STAGE(PG8_SB(1, 0), cB + kstep, voffB); PG8_STAGE(PG8_SA(1, 0), cA + kstep, voffA); PG8_STAGE(PG8_SB(1, 1), cB + hstep + kstep, voffB);
        PG8_WAIT_V(6); PG8_BAR;
    }
    for (;;) {
        const bool has_next = S.next(ui + 1, nxt);
        const char* nA = has_next ? (const char*)g.A + (size_t)nxt.pm * tstep : cA; const char* nB = has_next ? (const char*)g.Bt + (size_t)nxt.pn * tstep : cB;
        for (int t = 0; t < nt; t += 2) {
            const bool last = (t == nt - 2);
            const char* a1 = cA + (size_t)(t + 1) * kstep;
            const char* a2 = last ? nA : cA + (size_t)(t + 2) * kstep; const char* b2 = last ? nB : cB + (size_t)(t + 2) * kstep;
            const char* a3 = a2 + kstep; const char* b3 = b2 + kstep;
            if (last && has_next) S.a_ready(nxt);
            if constexpr (SP2) {
            PG8_LDB(B0, 0, 0); PG8_LDB(B1, 0, 1); PG8_SCHED; PG8_LDA(At, 0, 0); PG8_STAGE(PG8_SA(1, 1), a1 + hstep, voffA);
            PG8_WAIT_V(8); PG8_WAIT_L(0); PG8_BAR; PG8_MMA(0, 0, At, B0); PG8_MMA(0, 1, At, B1); PG8_BAR; PG8_SCHED;
            PG8_LDA(At, 0, 1); PG8_STAGE(PG8_SB(0, 0), b2, voffB); PG8_STAGE(PG8_SB(0, 1), b2 + hstep, voffB); PG8_STAGE(PG8_SA(0, 0), a2, voffA);
            PG8_WAIT_V(8); PG8_WAIT_L(0); PG8_BAR; PG8_MMA(1, 0, At, B0); PG8_MMA(1, 1, At, B1); PG8_BAR; PG8_SCHED;
            PG8_LDB(B0, 1, 0); PG8_LDB(B1, 1, 1); PG8_SCHED; PG8_LDA(At, 1, 0); PG8_STAGE(PG8_SA(0, 1), a2 + hstep, voffA);
            PG8_WAIT_V(8); PG8_WAIT_L(0); PG8_BAR; PG8_MMA(0, 0, At, B0); PG8_MMA(0, 1, At, B1); PG8_BAR; PG8_SCHED;
            PG8_LDA(At, 1, 1); PG8_STAGE(PG8_SB(1, 0), b3, voffB); PG8_STAGE(PG8_SB(1, 1), b3 + hstep, voffB); PG8_STAGE(PG8_SA(1, 0), a3, voffA);
            PG8_WAIT_V(8); PG8_WAIT_L(0); PG8_BAR; PG8_MMA(1, 0, At, B0); PG8_MMA(1, 1, At, B1); PG8_BAR; PG8_SCHED;
            } else {
            PG8_LDB(B0, 0, 0); PG8_SCHED; PG8_LDA(At, 0, 0); PG8_STAGE(PG8_SA(1, 1), a1 + hstep, voffA);
            PG8_WAIT_L(8); PG8_BAR; PG8_WAIT_L(0); PG8_MMA(0, 0, At, B0); PG8_BAR; PG8_SCHED;
            PG8_LDB(B1, 0, 1); PG8_STAGE(PG8_SB(0, 0), b2, voffB);
            PG8_BAR; PG8_WAIT_L(0); PG8_MMA(0, 1, At, B1); PG8_BAR;
            PG8_LDA(At, 0, 1); PG8_STAGE(PG8_SA(0, 0), a2, voffA);
            PG8_BAR; PG8_WAIT_L(0); PG8_MMA(1, 0, At, B0); PG8_BAR; PG8_SCHED;
            PG8_STAGE(PG8_SB(0, 1), b2 + hstep, voffB);
            PG8_WAIT_V(6); PG8_BAR; PG8_MMA(1, 1, At, B1); PG8_BAR;
            PG8_LDB(B0, 1, 0); PG8_SCHED; PG8_LDA(At, 1, 0); PG8_STAGE(PG8_SA(0, 1), a2 + hstep, voffA);
            PG8_WAIT_L(8); PG8_BAR; PG8_WAIT_L(0); PG8_MMA(0, 0, At, B0); PG8_BAR; PG8_SCHED;
            PG8_LDB(B1, 1, 1); PG8_STAGE(PG8_SB(1, 0), b3, voffB);
            PG8_BAR; PG8_WAIT_L(0); PG8_MMA(0, 1, At, B1); PG8_BAR;
            PG8_LDA(At, 1, 1); PG8_STAGE(PG8_SA(1, 0), a3, voffA);
            PG8_BAR; PG8_WAIT_L(0); PG8_MMA(1, 0, At, B0); PG8_BAR; PG8_SCHED;
            PG8_STAGE(PG8_SB(1, 1), b3 + hstep, voffB);
            PG8_WAIT_V(6); PG8_BAR; PG8_MMA(1, 1, At, B1); PG8_BAR;
            }
        }
        if constexpr (ALIGN_EPI) { if (wr == 0) PG8_BAR; }
        if constexpr (!Epi::AFTER_DRAIN) { E(acc, cur, wr, wc, fr, fq); S.done(cur); }
        if (!has_next) break;
#pragma unroll
        for (int a = 0; a < 2; ++a)
#pragma unroll
            for (int b = 0; b < 2; ++b)
#pragma unroll
                for (int m = 0; m < 4; ++m)
#pragma unroll
                    for (int n = 0; n < 2; ++n) acc[a][b][m][n] = (f32x4){0.f, 0.f, 0.f, 0.f};
        cur = nxt; cA = nA; cB = nB; ++ui;
        if constexpr (ALIGN_EPI) { if (wr == 1) PG8_BAR; }
    }
    PG8_WAIT_V(0);
    if constexpr (!ALIGN_EPI) { if (wr == 0) PG8_BAR; }
    PG8_BAR;
    if constexpr (Epi::AFTER_DRAIN) { E.fused(acc, cur, wr, wc, fr, fq, lds, wid, lane); S.done(cur); }
#undef PG8_SA
#undef PG8_SB
#undef PG8_STAGE
#undef PG8_LDA
#undef PG8_LDB
#undef PG8_MMA
#undef PG8_WAIT_V
#undef PG8_WAIT_L
#undef PG8_BAR
#undef PG8_SCHED
}
}
struct Args { const float* in[13]; float* out; unsigned char* ws; int ph_lo, ph_hi; };

template <bool PERMUTE>
__device__ __forceinline__ void p0_transpose_item(const float* W, int K, int N, int NPOS, bf16_t* WT, LAS float* scr, int item, int lane) {
    const int nblk = NPOS / 32, kb = item / nblk, nb = item % nblk, k0 = 64 * kb, n0 = 32 * nb;
    const int pos = n0 + (lane & 31);
    const int col = PERMUTE ? win_src_col(pos) : pos;
#pragma unroll 8
    for (int i = 0; i < 32; ++i) { const int kk = 2 * i + (lane >> 5); scr[kk * 33 + (lane & 31)] = (col >= 0) ? W[(size_t)(k0 + kk) * N + col] : 0.f; }
    asm volatile("s_waitcnt lgkmcnt(0)" ::: "memory");
    const int c = lane & 7;
#pragma unroll
    for (int j = 0; j < 4; ++j) { const int n = (lane >> 3) + 8 * j; const LAS float* s = scr + (8 * c) * 33 + n;
        u32x4 o; o.x = pk2(s[0 * 33], s[1 * 33]); o.y = pk2(s[2 * 33], s[3 * 33]); o.z = pk2(s[4 * 33], s[5 * 33]); o.w = pk2(s[6 * 33], s[7 * 33]);
        *(u32x4*)(WT + (size_t)(n0 + n) * K + k0 + 8 * c) = o; }
    asm volatile("s_waitcnt lgkmcnt(0)" ::: "memory");
}
__device__ __forceinline__ void row_to_bf16(const float* src, bf16_t* dst, int lane) {
    const f32x4* s = (const f32x4*)src + lane; u32x2* d = (u32x2*)dst + lane;
    f32x4 v[4];
#pragma unroll
    for (int j = 0; j < 4; ++j) v[j] = s[64 * j];
#pragma unroll
    for (int j = 0; j < 4; ++j) { u32x2 w; w.x = pk2(v[j][0], v[j][1]); w.y = pk2(v[j][2], v[j][3]); d[64 * j] = w; }
}
typedef float f32x2 __attribute__((ext_vector_type(2)));
__device__ __forceinline__ void row_to_fp8(const float* src, unsigned char* dst, float* scale_out, int lane) {
    const f32x4* s = (const f32x4*)src + 4 * lane;
    f32x4 v[4]; float am = 0.f;
#pragma unroll
    for (int j = 0; j < 4; ++j) { v[j] = s[j]; am = fmaxf(am, fmaxf(fmaxf(fabsf(v[j][0]), fabsf(v[j][1])), fmaxf(fabsf(v[j][2]), fabsf(v[j][3])))); }
#pragma unroll
    for (int o = 1; o < 64; o <<= 1) am = fmaxf(am, __shfl_xor(am, o));
    const float sc = am > 0.f ? am * (1.0f / 440.0f) : 1.0f, inv = 1.0f / sc;
    u32x4 w;
#pragma unroll
    for (int j = 0; j < 4; ++j) { unsigned t = 0u; t = __builtin_amdgcn_cvt_pk_fp8_f32(v[j][0] * inv, v[j][1] * inv, t, false); t = __builtin_amdgcn_cvt_pk_fp8_f32(v[j][2] * inv, v[j][3] * inv, t, true); w[j] = t; }
    *((u32x4*)dst + lane) = w;
    if (lane == 0) *scale_out = sc;
}
__device__ __forceinline__ void sincos_tab(double x, float& s, float& c) {
    const double k = rint(x * 0.15915494309189535);
    double r = fma(-k, 6.283185307179586, x); r = fma(-k, 2.4492935982947064e-16, r);
    const double r2 = r * r;
    double ps = 1.0, pc = 1.0;
#pragma unroll
    for (int n = 29; n >= 3; n -= 2) ps = 1.0 - ps * r2 * (1.0 / (double)((n - 1) * n));
#pragma unroll
    for (int n = 28; n >= 2; n -= 2) pc = 1.0 - pc * r2 * (1.0 / (double)((n - 1) * n));
    s = (float)(r * ps); c = (float)pc;
}

__device__ __forceinline__ void phase0(const Args& a, unsigned char* lds, int tid, int wave, int lane, int bid, int G) {
    unsigned char* ws = a.ws;
    for (int it = bid; it < 192; it += G) {
        float* s_c = (float*)lds; float* red = (float*)(lds + 16384);
        for (int i = tid; i < 4096; i += NTHREADS) { const float v = a.in[1][i]; s_c[i] = v / (1.0f + expf(-v)); }
        __syncthreads();
        const int g = tid & 7, ks = tid >> 3, n0 = 32 * it;
        f32x4 acc[4];
#pragma unroll
        for (int b = 0; b < 4; ++b) acc[b] = (f32x4){0.f, 0.f, 0.f, 0.f};
#pragma unroll 4
        for (int i = 0; i < 16; ++i) { const int k = ks + 64 * i; const f32x4 w = *(const f32x4*)(a.in[2] + (size_t)k * 6144 + n0 + 4 * g);
#pragma unroll
            for (int b = 0; b < 4; ++b) acc[b] += w * s_c[b * 1024 + k]; }
#pragma unroll
        for (int b = 0; b < 4; ++b) *(f32x4*)(red + (ks * 8 + g) * 16 + 4 * b) = acc[b];
        __syncthreads();
        if (tid < 128) { const int b = tid >> 5, col = tid & 31, gg = col >> 2, e = col & 3; float s = 0.f;
            for (int k2 = 0; k2 < 64; ++k2) s += red[(k2 * 8 + gg) * 16 + 4 * b + e];
            ((float*)(ws + WS_MOD))[b * 6144 + n0 + col] = s + a.in[3][n0 + col]; }
        __syncthreads();
    }
    for (int it = bid; it < 256; it += G) {
        const int hp = it >> 4, k0 = 64 * (it & 15);
        float* skl = (float*)lds; float* wql = skl + 128 * 129;
        for (int i = tid; i < 4096; i += NTHREADS) { const int n = i >> 5, d4 = i & 31; const f32x4 v = *(const f32x4*)(a.in[9] + (size_t)hp * 16384 + n * 128 + 4 * d4);
            float* q = skl + n * 129 + 4 * d4; q[0] = v[0]; q[1] = v[1]; q[2] = v[2]; q[3] = v[3]; }
        for (int i = tid; i < 2048; i += NTHREADS) { const int k = i >> 5, d4 = i & 31; const f32x4 v = *(const f32x4*)(a.in[8] + (size_t)(k0 + k) * 2048 + hp * 128 + 4 * d4);
            float* q = wql + k * 129 + 4 * d4; q[0] = v[0]; q[1] = v[1]; q[2] = v[2]; q[3] = v[3]; }
        __syncthreads();
        const int k = tid & 63, ng = tid >> 6;
        float acc[16];
#pragma unroll
        for (int j = 0; j < 16; ++j) acc[j] = 0.f;
        for (int d = 0; d < 128; ++d) { const float av = wql[k * 129 + d];
#pragma unroll
            for (int j = 0; j < 16; ++j) acc[j] += av * skl[(16 * ng + j) * 129 + d]; }
        bf16_t* wt = (bf16_t*)(ws + WS_WPQ);
#pragma unroll
        for (int j = 0; j < 16; ++j) wt[(size_t)(hp * 128 + 16 * ng + j) * 1024 + k0 + k] = (bf16_t)f2bf(acc[j]);
        __syncthreads();
    }
    const int gw = bid * 8 + wave, NGW = G * 8;
    {
        LAS float* scr = (LAS float*)(lds + wave * 16384);
        constexpr int I_IN = 16 * (N1 / 32), I_OUT = 16 * 32;
        for (int it = gw; it < I_IN + I_OUT; it += NGW) {
            if (it < I_IN) p0_transpose_item<true>(a.in[5], 1024, 4168, N1, (bf16_t*)(ws + WS_WIN), scr, it, lane);
            else p0_transpose_item<false>(a.in[6], 1024, 1024, 1024, (bf16_t*)(ws + WS_WOUT), scr, it - I_IN, lane);
        }
    }
    for (int r = gw; r < 16384; r += NGW) {
        row_to_fp8(a.in[10] + (size_t)r * 1024, ws + WS_U8 + (size_t)r * 1024, (float*)(ws + WS_USC) + r, lane);
        row_to_fp8(a.in[11] + (size_t)r * 1024, ws + WS_V8 + (size_t)r * 1024, (float*)(ws + WS_VSC) + r, lane);
    }
    for (int i = bid * NTHREADS + tid; i < 4096 * 96; i += G * NTHREADS) {
        int pos, f; double r; float* ct; float* st; int idx;
        if (i < 4096 * 32) { pos = i >> 5; f = i & 31; r = 0.74989420933245582730; ct = (float*)(ws + WS_COSA); st = (float*)(ws + WS_SINA); idx = i; }
        else { const int j = i - 4096 * 32; pos = j >> 6; f = j & 63; r = 0.86398844948396852897; ct = (float*)(ws + WS_COSR); st = (float*)(ws + WS_SINR); idx = j; }
        double v = 1.0; for (int t = 0; t < f; ++t) v *= r;
        const float invf = (float)v; const float ang = (float)pos * invf;
        float s, c; sincos_tab((double)ang, s, c);
        ct[idx] = c; st[idx] = s;
    }
}

__device__ __forceinline__ void phase1(const Args& a, int wave, int lane, int bid, int G) {
    unsigned char* ws = a.ws;
    const float* mod = (const float*)(ws + WS_MOD);
    const int gw = bid * 8 + wave, NGW = G * 8;
    for (int r = gw; r < MTOK; r += NGW) {
        const int b = r >> 12;
        const f32x4* xr = (const f32x4*)(a.in[0] + (size_t)r * DM) + lane;
        f32x4 v[4]; float ss = 0.f;
#pragma unroll
        for (int j = 0; j < 4; ++j) { v[j] = xr[64 * j]; ss += (v[j][0] * v[j][0] + v[j][1] * v[j][1]) + (v[j][2] * v[j][2] + v[j][3] * v[j][3]); }
        const float rstd = 1.0f / sqrtf(wave_sum(ss) * (1.0f / DM) + EPS);
        u32x2* o = (u32x2*)((bf16_t*)(ws + WS_BUFA) + (size_t)r * DM) + lane;
#pragma unroll
        for (int j = 0; j < 4; ++j) { const int c = 256 * j + 4 * lane;
            const f32x4 g = *(const f32x4*)(a.in[4] + c), sc = *(const f32x4*)(mod + b * 6144 + 1024 + c), sh = *(const f32x4*)(mod + b * 6144 + c);
            const f32x4 h = v[j] * rstd * g * (sc + 1.0f) + sh;
            u32x2 w; w.x = pk2(h[0], h[1]); w.y = pk2(h[2], h[3]); o[64 * j] = w; }
    }
    for (int n = gw; n < 2048; n += NGW) {
        const u32x4* wr = (const u32x4*)((const bf16_t*)(ws + WS_WPQ) + (size_t)n * 1024);
        const u32x4 w0 = wr[lane], w1 = wr[64 + lane];
        float wf[16];
#pragma unroll
        for (int i = 0; i < 4; ++i) { wf[2 * i] = bf_lo(w0[i]); wf[2 * i + 1] = bf_hi(w0[i]); wf[8 + 2 * i] = bf_lo(w1[i]); wf[8 + 2 * i + 1] = bf_hi(w1[i]); }
#pragma unroll
        for (int b = 0; b < 4; ++b) { const float* sh = mod + b * 6144 + 3072; float s = 0.f;
#pragma unroll
            for (int i = 0; i < 8; ++i) s += wf[i] * sh[8 * lane + i] + wf[8 + i] * sh[512 + 8 * lane + i];
            s = wave_sum(s);
            if (lane == 0) ((float*)(ws + WS_BIASF))[b * 2048 + n] = s; }
    }
}

constexpr int SCP = 8200;
__device__ __forceinline__ void select_row(int b, int t, const unsigned char* ldsrow, unsigned long long* MASK, int lane) {
    const int nreg = (t >> 6) + 1;
    unsigned key[64];
#pragma unroll
    for (int j = 0; j < 64; ++j) {
        unsigned k = 0;
        if (j < nreg) { k = *(const unsigned short*)(ldsrow + 2 * lane + 128 * j); if (lane > t - 64 * j) k = 0; }
        key[j] = k;
    }
    unsigned mw_lo = 0u, mw_hi = 0u;
    if (t < 256) {
#pragma unroll
        for (int j = 0; j < 4; ++j) { const unsigned long long w = __ballot(key[j] != 0u); asm volatile("s_nop 1\n\tv_writelane_b32 %0, %2, %4\n\tv_writelane_b32 %1, %3, %4\n\ts_nop 0" : "+v"(mw_lo), "+v"(mw_hi) : "s"((unsigned)w), "s"((unsigned)(w >> 32)), "n"(j));     }
    } else {
        unsigned T = 0;
#pragma unroll 1
        for (int bit = 15; bit >= 0; --bit) {
            const unsigned cand = T | (1u << bit);
            int cnt = 0;
#pragma unroll
            for (int jb = 0; jb < 16; ++jb) {
                if (4 * jb < nreg) {
#pragma unroll
                    for (int j = 4 * jb; j < 4 * jb + 4; ++j) cnt += __popcll(__ballot(key[j] >= cand));
                }
                __builtin_amdgcn_sched_barrier(0);
            }
            if (cnt >= 256) T = cand;
        }
        int cgt = 0;
#pragma unroll
        for (int jb = 0; jb < 16; ++jb) {
            if (4 * jb < nreg) {
#pragma unroll
                for (int j = 4 * jb; j < 4 * jb + 4; ++j) cgt += __popcll(__ballot(key[j] > T));
            }
            __builtin_amdgcn_sched_barrier(0);
        }
        int need = 256 - cgt;
#pragma unroll
        for (int jb = 0; jb < 32; ++jb) {
            if (2 * jb < nreg) {
#pragma unroll
                for (int j = 2 * jb; j < 2 * jb + 2; ++j) {
                    const bool gt = key[j] > T, eq = key[j] == T;
                    const unsigned long long em = __ballot(eq);
                    const int c = __popcll(em), take = c < need ? c : need;
                    const int rank = (int)__builtin_amdgcn_mbcnt_hi((unsigned)(em >> 32), __builtin_amdgcn_mbcnt_lo((unsigned)em, 0u));
                    const unsigned long long w = __ballot(gt || (eq && rank < take));
                    need -= take;
                    asm volatile("s_nop 1\n\tv_writelane_b32 %0, %2, %4\n\tv_writelane_b32 %1, %3, %4\n\ts_nop 0" : "+v"(mw_lo), "+v"(mw_hi) : "s"((unsigned)w), "s"((unsigned)(w >> 32)), "n"(j));
                }
            }
            __builtin_amdgcn_sched_barrier(0);
        }
    }
    MASK[((size_t)b * SEQ + t) * 64 + lane] = ((unsigned long long)mw_hi << 32) | mw_lo;
}
__device__ __forceinline__ void idx_unit(int b, int qt, const bf16_t* QI, const bf16_t* KI, const float* WI, unsigned long long* MASK, unsigned char* lds, int wave, int lane) {
    const int t0 = 16 * qt, qn = lane & 15, g = lane >> 4;
    const size_t rowq = (size_t)b * SEQ + t0 + qn;
    bf16x8 qf[8][2]; float wi[8];
#pragma unroll
    for (int h = 0; h < 8; ++h)
#pragma unroll
        for (int ks = 0; ks < 2; ++ks) qf[h][ks] = *(const bf16x8*)(QI + rowq * 512 + h * 64 + ks * 32 + 8 * g);
    { const f32x4 w0 = *(const f32x4*)(WI + rowq * 8), w1 = *(const f32x4*)(WI + rowq * 8 + 4);
#pragma unroll
      for (int e = 0; e < 4; ++e) { wi[e] = w0[e]; wi[4 + e] = w1[e]; } }
    for (int kt = wave; kt <= qt; kt += 8) {
        const int s0 = 16 * kt;
        const bf16_t* kr = KI + ((size_t)b * SEQ + s0 + qn) * 64 + 8 * g;
        const bf16x8 a0 = *(const bf16x8*)kr, a1 = *(const bf16x8*)(kr + 32);
        f32x4 sc = (f32x4){0.f, 0.f, 0.f, 0.f};
#pragma unroll
        for (int h = 0; h < 8; ++h) {
            f32x4 d = mfma16(a0, qf[h][0], (f32x4){0.f, 0.f, 0.f, 0.f}); d = mfma16(a1, qf[h][1], d);
#pragma unroll
            for (int r = 0; r < 4; ++r) sc[r] += wi[h] * fmaxf(d[r], 0.f);
        }
        unsigned k[4];
#pragma unroll
        for (int r = 0; r < 4; ++r) k[r] = (s0 + 4 * g + r <= t0 + qn) ? sortable16(sc[r]) : 0u;
        u32x2 pk; pk.x = k[0] | (k[1] << 16); pk.y = k[2] | (k[3] << 16);
        *(u32x2*)(lds + qn * SCP + 2 * (s0 + 4 * g)) = pk;
    }
    __syncthreads();
#ifndef NO_SEL
#pragma unroll 1
    for (int qq = 2 * wave; qq < 2 * wave + 2; ++qq) select_row(b, t0 + qq, lds + qq * SCP, MASK, lane);
#endif
    __syncthreads();
}

__device__ __forceinline__ void ret_state_unit(int b, int h, int vb, const bf16_t* KR, const bf16_t* VR, bf16_t* STATE, unsigned char* lds, int tid, int wave, int lane) {
    constexpr int PT = 272, KT_BYTES = 128 * PT, BUF = KT_BYTES + 16 * PT;
    const int j = tid & 127, dq = tid >> 7, g = lane >> 4, ln = lane & 15;
    const float g128 = ret_g128(h), g127 = ret_g127(h), gam = ret_gamma(h);
    f32x4 st = (f32x4){0.f, 0.f, 0.f, 0.f};
    u32x4 kreg[4], vreg = (u32x4){0u, 0u, 0u, 0u};
#define RS_LOAD(n) do { const size_t row = (size_t)b * SEQ + (n) * 128 + j; const u32x4* p = (const u32x4*)(KR + row * 512 + h * 128 + 32 * dq); \
        kreg[0] = p[0]; kreg[1] = p[1]; kreg[2] = p[2]; kreg[3] = p[3]; if (tid < 256) vreg = *(const u32x4*)(VR + row * 512 + h * 128 + 16 * vb + 8 * dq); } while (0)
    RS_LOAD(0);
#pragma unroll 1
    for (int n = 0; n < 32; ++n) {
        unsigned char* buf = lds + (n & 1) * BUF;
#pragma unroll
        for (int i = 0; i < 4; ++i)
#pragma unroll
            for (int e = 0; e < 4; ++e) { const unsigned w = kreg[i][e]; const int d = 32 * dq + 8 * i + 2 * e;
                *(unsigned short*)(buf + d * PT + 2 * j) = (unsigned short)(w & 0xffffu); *(unsigned short*)(buf + (d + 1) * PT + 2 * j) = (unsigned short)(w >> 16); }
        if (tid < 256) {
#pragma unroll
            for (int e = 0; e < 4; ++e) { const unsigned w = vreg[e]; const int v = 8 * dq + 2 * e;
                *(unsigned short*)(buf + KT_BYTES + v * PT + 2 * j) = (unsigned short)(w & 0xffffu); *(unsigned short*)(buf + KT_BYTES + (v + 1) * PT + 2 * j) = (unsigned short)(w >> 16); }
        }
        if (n < 31) RS_LOAD(n + 1);
        __syncthreads();
        { bf16_t* sp = STATE + ((((size_t)b * 4 + h) * 32 + n) * 128 + 16 * vb + 4 * g) * 128 + 16 * wave + ln;
#pragma unroll
          for (int r = 0; r < 4; ++r) sp[r * 128] = (bf16_t)f2bf(gam * st[r]); }
        f32x4 c = (f32x4){0.f, 0.f, 0.f, 0.f};
#pragma unroll
        for (int ks = 0; ks < 4; ++ks) {
            const bf16x8 af = *(const bf16x8*)(buf + KT_BYTES + ln * PT + 2 * (32 * ks + 8 * g));
            const bf16x8 bf = *(const bf16x8*)(buf + (16 * wave + ln) * PT + 2 * (32 * ks + 8 * g));
            c = mfma16(af, bf, c);
        }
        st = st * g128 + c * g127;
    }
#undef RS_LOAD
    __syncthreads();
}

__device__ __forceinline__ void attn_unit(int b, int h, int qb, const bf16_t* QA, const bf16_t* KA, const bf16_t* VA, const unsigned long long* MASK, bf16_t* AR,
                                          unsigned char* lds, int tid, int wave, int lane) {
    constexpr int KP = 144, KS_BYTES = 64 * KP, BUF = 2 * KS_BYTES;
    const int q0 = 256 * qb, r32 = lane & 31, hi = lane >> 5;
    const int t = q0 + 32 * wave + r32;
    const size_t qrow = (size_t)b * SEQ + t;
    bf16x8 qf[4];
#pragma unroll
    for (int d0 = 0; d0 < 4; ++d0) qf[d0] = *(const bf16x8*)(QA + qrow * 512 + h * 64 + 16 * d0 + 8 * hi);
    const int NT = (q0 + 256) / 64;
    const int key_l = tid >> 3, c8 = tid & 7;
    f32x16 o0, o1;
#pragma unroll
    for (int r = 0; r < 16; ++r) { o0[r] = 0.f; o1[r] = 0.f; }
    float m_run = NEG_INF, l_run = 0.f;
    u32x4 kreg, vreg; unsigned long long mw;
#define AT_LOAD(kt) do { const size_t kr = (size_t)b * SEQ + 64 * (kt) + key_l; kreg = *(const u32x4*)(KA + kr * 512 + h * 64 + 8 * c8); vreg = *(const u32x4*)(VA + kr * 512 + h * 64 + 8 * c8); \
        mw = MASK[qrow * 64 + (kt)]; } while (0)
    AT_LOAD(0);
#pragma unroll 1
    for (int kt = 0; kt < NT; ++kt) {
        unsigned char* buf = lds + (kt & 1) * BUF;
        *(u32x4*)(buf + key_l * KP + 16 * c8) = kreg;
#pragma unroll
        for (int e = 0; e < 4; ++e) { const unsigned w = vreg[e]; const int d = 8 * c8 + 2 * e;
            *(unsigned short*)(buf + KS_BYTES + d * KP + 2 * key_l) = (unsigned short)(w & 0xffffu); *(unsigned short*)(buf + KS_BYTES + (d + 1) * KP + 2 * key_l) = (unsigned short)(w >> 16); }
#ifdef DBG_CAUSAL
        const int nv_ = t - 64 * kt + 1; const unsigned long long mcur = nv_ >= 64 ? ~0ull : nv_ <= 0 ? 0ull : ((1ull << nv_) - 1ull);
#else
        const unsigned long long mcur = mw;
#endif
        if (kt + 1 < NT) AT_LOAD(kt + 1);
        __syncthreads();
        if (64 * kt <= q0 + 32 * wave + 31) {
            f32x16 p0, p1;
#pragma unroll
            for (int r = 0; r < 16; ++r) { p0[r] = 0.f; p1[r] = 0.f; }
#pragma unroll
            for (int d0 = 0; d0 < 4; ++d0) {
                const bf16x8 a0 = *(const bf16x8*)(buf + r32 * KP + 32 * d0 + 16 * hi);
                const bf16x8 a1 = *(const bf16x8*)(buf + (32 + r32) * KP + 32 * d0 + 16 * hi);
                p0 = mfma32(a0, qf[d0], p0); p1 = mfma32(a1, qf[d0], p1);
            }
            const unsigned wl = (unsigned)mcur >> (4 * hi), wh = (unsigned)(mcur >> 32) >> (4 * hi);
            float mx = NEG_INF;
#pragma unroll
            for (int r = 0; r < 16; ++r) { const int bp = (r & 3) + 8 * (r >> 2);
                p0[r] = ((wl >> bp) & 1u) ? p0[r] : NEG_INF; p1[r] = ((wh >> bp) & 1u) ? p1[r] : NEG_INF;
                mx = fmaxf(mx, fmaxf(p0[r], p1[r])); }
            mx = fmaxf(mx, __shfl_xor(mx, 32));
            const float m_new = fmaxf(m_run, mx);
            const float m_use = (m_new == NEG_INF) ? 0.f : m_new;
            const float alpha = fast_exp2(m_run - m_use);
            m_run = m_new;
            float ps = 0.f;
#pragma unroll
            for (int r = 0; r < 16; ++r) { p0[r] = fast_exp2(p0[r] - m_use); p1[r] = fast_exp2(p1[r] - m_use); ps += p0[r] + p1[r]; }
            l_run = l_run * alpha + ps;
#pragma unroll
            for (int r = 0; r < 16; ++r) { o0[r] *= alpha; o1[r] *= alpha; }
#pragma unroll
            for (int s4 = 0; s4 < 4; ++s4) {
                const int rb = 8 * (s4 & 1);
                u32x4 pw;
                if (s4 < 2) { pw.x = pk2(p0[rb], p0[rb + 1]); pw.y = pk2(p0[rb + 2], p0[rb + 3]); pw.z = pk2(p0[rb + 4], p0[rb + 5]); pw.w = pk2(p0[rb + 6], p0[rb + 7]); }
                else        { pw.x = pk2(p1[rb], p1[rb + 1]); pw.y = pk2(p1[rb + 2], p1[rb + 3]); pw.z = pk2(p1[rb + 4], p1[rb + 5]); pw.w = pk2(p1[rb + 6], p1[rb + 7]); }
                const bf16x8 bfr = __builtin_bit_cast(bf16x8, pw);
                { const unsigned char* vp = buf + KS_BYTES + r32 * KP + 2 * (16 * s4 + 4 * hi);
                  const u32x2 lo = *(const u32x2*)vp, h2 = *(const u32x2*)(vp + 16); const u32x4 av = (u32x4){lo.x, lo.y, h2.x, h2.y};
                  o0 = mfma32(__builtin_bit_cast(bf16x8, av), bfr, o0); }
                { const unsigned char* vp = buf + KS_BYTES + (32 + r32) * KP + 2 * (16 * s4 + 4 * hi);
                  const u32x2 lo = *(const u32x2*)vp, h2 = *(const u32x2*)(vp + 16); const u32x4 av = (u32x4){lo.x, lo.y, h2.x, h2.y};
                  o1 = mfma32(__builtin_bit_cast(bf16x8, av), bfr, o1); }
            }
        }
    }
#undef AT_LOAD
    l_run += __shfl_xor(l_run, 32);
#ifdef DBG_NOATT
    const float inv = 0.f;
#else
    const float inv = 1.0f / l_run;
#endif
    bf16_t* op = AR + qrow * 1024 + h * 64 + 4 * hi;
#pragma unroll
    for (int c = 0; c < 4; ++c) {
        u32x2 w; w.x = pk2(o0[4 * c] * inv, o0[4 * c + 1] * inv); w.y = pk2(o0[4 * c + 2] * inv, o0[4 * c + 3] * inv); *(u32x2*)(op + 8 * c) = w;
        u32x2 v; v.x = pk2(o1[4 * c] * inv, o1[4 * c + 1] * inv); v.y = pk2(o1[4 * c + 2] * inv, o1[4 * c + 3] * inv); *(u32x2*)(op + 32 + 8 * c) = v;
    }
    __syncthreads();
}

__device__ __forceinline__ void ret_out_unit(int b, int h, int n, const bf16_t* QR, const bf16_t* KR, const bf16_t* VR, const bf16_t* GR, const bf16_t* STATE, bf16_t* AR,
                                             unsigned char* lds, int tid, int wave, int lane) {
    constexpr int PT = 272;
    const size_t c0 = (size_t)b * SEQ + 128 * n; const int hc = 128 * h;
    { const int j = tid & 127, vq = tid >> 7; const u32x4* p = (const u32x4*)(VR + (c0 + j) * 512 + hc + 32 * vq);
      u32x4 rr[4]; rr[0] = p[0]; rr[1] = p[1]; rr[2] = p[2]; rr[3] = p[3];
#pragma unroll
      for (int i = 0; i < 4; ++i)
#pragma unroll
          for (int e = 0; e < 4; ++e) { const unsigned w = rr[i][e]; const int v = 32 * vq + 8 * i + 2 * e;
              *(unsigned short*)(lds + v * PT + 2 * j) = (unsigned short)(w & 0xffffu); *(unsigned short*)(lds + (v + 1) * PT + 2 * j) = (unsigned short)(w >> 16); } }
    __syncthreads();
    const int ln = lane & 15, g = lane >> 4;
    const size_t qrow = c0 + 16 * wave + ln;
    bf16x8 qf[4];
#pragma unroll
    for (int ks = 0; ks < 4; ++ks) qf[ks] = *(const bf16x8*)(QR + qrow * 512 + hc + 32 * ks + 8 * g);
    f32x4 sT[8];
#pragma unroll
    for (int jt = 0; jt < 8; ++jt) {
        f32x4 d = (f32x4){0.f, 0.f, 0.f, 0.f};
        if (jt <= wave) {
            const bf16_t* kp = KR + (c0 + 16 * jt + ln) * 512 + hc + 8 * g;
#pragma unroll
            for (int ks = 0; ks < 4; ++ks) d = mfma16(*(const bf16x8*)(kp + 32 * ks), qf[ks], d);
            if (jt == wave) {
#pragma unroll
                for (int r = 0; r < 4; ++r) if (4 * g + r > ln) d[r] = 0.f;
            }
        }
        sT[jt] = d;
    }
    f32x4 oT[8];
    const bf16_t* stp = STATE + (((size_t)b * 4 + h) * 32 + n) * 16384;
#pragma unroll
    for (int vt = 0; vt < 8; ++vt) {
        f32x4 d = (f32x4){0.f, 0.f, 0.f, 0.f};
#pragma unroll
        for (int ks = 0; ks < 4; ++ks) d = mfma16(*(const bf16x8*)(stp + (16 * vt + ln) * 128 + 32 * ks + 8 * g), qf[ks], d);
        oT[vt] = d;
    }
#pragma unroll
    for (int pr = 0; pr < 4; ++pr) if (2 * pr <= wave) {
        u32x4 pw; pw.x = pk2(sT[2 * pr][0], sT[2 * pr][1]); pw.y = pk2(sT[2 * pr][2], sT[2 * pr][3]); pw.z = pk2(sT[2 * pr + 1][0], sT[2 * pr + 1][1]); pw.w = pk2(sT[2 * pr + 1][2], sT[2 * pr + 1][3]);
        const bf16x8 bfr = __builtin_bit_cast(bf16x8, pw);
#pragma unroll
        for (int vt = 0; vt < 8; ++vt) {
            const unsigned char* vp = lds + (16 * vt + ln) * PT + 2 * (32 * pr + 4 * g);
            const u32x2 lo = *(const u32x2*)vp, h2 = *(const u32x2*)(vp + 32); const u32x4 av = (u32x4){lo.x, lo.y, h2.x, h2.y};
            oT[vt] = mfma16(__builtin_bit_cast(bf16x8, av), bfr, oT[vt]);
        }
    }
    float s = 0.f;
#pragma unroll
    for (int vt = 0; vt < 8; ++vt) s += (oT[vt][0] + oT[vt][1]) + (oT[vt][2] + oT[vt][3]);
    s += __shfl_xor(s, 16); s += __shfl_xor(s, 32);
    const float mean = s * (1.0f / 128.0f);
    float q = 0.f;
#pragma unroll
    for (int vt = 0; vt < 8; ++vt)
#pragma unroll
        for (int r = 0; r < 4; ++r) { const float d = oT[vt][r] - mean; q += d * d; }
    q += __shfl_xor(q, 16); q += __shfl_xor(q, 32);
    const float rstd = 1.0f / sqrtf(q * (1.0f / 128.0f) + EPS);
#pragma unroll
    for (int vt = 0; vt < 8; ++vt) {
        const u32x2 gw = *(const u32x2*)(GR + qrow * 512 + hc + 16 * vt + 4 * g);
        const float y0 = (oT[vt][0] - mean) * rstd * bf_lo(gw.x), y1 = (oT[vt][1] - mean) * rstd * bf_hi(gw.x);
        const float y2 = (oT[vt][2] - mean) * rstd * bf_lo(gw.y), y3 = (oT[vt][3] - mean) * rstd * bf_hi(gw.y);
        u32x2 w; w.x = pk2(y0, y1); w.y = pk2(y2, y3);
#ifdef DBG_NORET
        w.x = 0u; w.y = 0u;
#endif
        *(u32x2*)(AR + qrow * 1024 + 512 + hc + 16 * vt + 4 * g) = w;
    }
    __syncthreads();
}

template <int N> __device__ __forceinline__ void bitonic_sort_desc(unsigned (&a)[N]) {
#pragma unroll
    for (int k = 2; k <= N; k <<= 1)
#pragma unroll
        for (int j = k >> 1; j > 0; j >>= 1)
#pragma unroll
            for (int i = 0; i < N; ++i) { const int l = i ^ j;
                if (l > i) { const unsigned x = a[i], y = a[l]; const unsigned mx = x > y ? x : y, mn = x > y ? y : x;
                    if ((i & k) == 0) { a[i] = mx; a[l] = mn; } else { a[i] = mn; a[l] = mx; } } }
}
template <int N> __device__ __forceinline__ void bitonic_merge_desc(unsigned (&a)[N]) {
#pragma unroll
    for (int j = N >> 1; j > 0; j >>= 1)
#pragma unroll
        for (int i = 0; i < N; ++i) { const int l = i ^ j;
            if (l > i) { const unsigned x = a[i], y = a[l]; a[i] = x > y ? x : y; a[l] = x > y ? y : x; } }
}
__device__ __forceinline__ void top16_merge(unsigned (&best)[16], const unsigned (&grp)[16]) {
#pragma unroll
    for (int i = 0; i < 16; ++i) { const unsigned x = best[i], y = grp[15 - i]; best[i] = x > y ? x : y; }
    bitonic_merge_desc<16>(best);
}
struct CandTab { int a[64], b[64], n; constexpr CandTab() : a{}, b{}, n(0) { for (int x = 0; x < 16; ++x) for (int y = 0; y < 16; ++y) if ((x + 1) * (y + 1) <= 16) { a[n] = x; b[n] = y; ++n; } } };
constexpr CandTab kCand{};
static_assert(kCand.n == 50, "staircase candidates");

constexpr int PL_EID = 0, PL_GATE = 16384, PL_IDX = 32768;
__device__ __forceinline__ void peer_unit(int unit, unsigned char* ws, float* outp, const float* gffn, const float* gfin, unsigned char* lds, int tid, int wave, int lane) {
    const float* SC = (const float*)(ws + WS_SC);
    const float* mod = (const float*)(ws + WS_MOD);
#ifndef DBG_NOPEER
    {
        const int tl = tid >> 4, h = (tid >> 1) & 7, p = tid & 1;
        const size_t row = (size_t)32 * unit + tl;
        const f32x4* sp = (const f32x4*)(SC + row * 2048 + h * 256 + p * 128);
        unsigned best[16];
#pragma unroll
        for (int grp = 0; grp < 8; ++grp) {
            unsigned k[16];
#pragma unroll
            for (int q4 = 0; q4 < 4; ++q4) { const f32x4 v = sp[4 * grp + q4];
#pragma unroll
                for (int e = 0; e < 4; ++e) k[4 * q4 + e] = (sortable32(v[e]) & ~127u) | (unsigned)(127 - (16 * grp + 4 * q4 + e)); }
            bitonic_sort_desc<16>(k);
            if (grp == 0) {
#pragma unroll
                for (int i = 0; i < 16; ++i) best[i] = k[i];
            } else top16_merge(best, k);
        }
        unsigned char* il = lds + PL_IDX + (tl * 8 + h) * 32;
#pragma unroll
        for (int i = 0; i < 4; ++i) { unsigned w = 0;
#pragma unroll
            for (int e = 0; e < 4; ++e) w |= (127u - (best[4 * i + e] & 127u)) << (8 * e);
            *(unsigned*)(il + p * 16 + 4 * i) = w; }
        float v1[16], v2[16];
#pragma unroll
        for (int i = 0; i < 16; ++i) { const unsigned o = __shfl_xor(best[i], 1); const float mine = unsortable32(best[i] & ~127u), oth = unsortable32(o & ~127u);
            v1[i] = p ? oth : mine; v2[i] = p ? mine : oth; }
        unsigned top[16];
#pragma unroll
        for (int grp = 0; grp < 4; ++grp) {
            unsigned k[16];
#pragma unroll
            for (int i = 0; i < 16; ++i) { const int c = 16 * grp + i;
                k[i] = (c < kCand.n) ? ((sortable32(v1[kCand.a[c < kCand.n ? c : 0]] + v2[kCand.b[c < kCand.n ? c : 0]]) & ~255u) | (unsigned)(255 - (16 * kCand.a[c < kCand.n ? c : 0] + kCand.b[c < kCand.n ? c : 0]))) : 0u; }
            bitonic_sort_desc<16>(k);
            if (grp == 0) {
#pragma unroll
                for (int i = 0; i < 16; ++i) top[i] = k[i];
            } else top16_merge(top, k);
        }
        float ts[16], es[16], sum = 0.f;
#pragma unroll
        for (int i = 0; i < 16; ++i) ts[i] = unsortable32(top[i] & ~255u);
#pragma unroll
        for (int i = 0; i < 16; ++i) { es[i] = __expf(ts[i] - ts[0]); sum += es[i]; }
        const float rs = 1.0f / sum;
        __builtin_amdgcn_wave_barrier(); asm volatile("s_waitcnt lgkmcnt(0)" ::: "memory");
        unsigned* eo = (unsigned*)(lds + PL_EID) + tl * 128 + h * 16;
        float* go = (float*)(lds + PL_GATE) + tl * 128 + h * 16;
#pragma unroll
        for (int i = 0; i < 16; ++i) {
            const unsigned flat = 255u - (top[i] & 255u);
            const unsigned i1 = il[flat >> 4], i2 = il[16 + (flat & 15u)];
            eo[i] = i1 * 128u + i2; go[i] = es[i] * rs;
        }
    }
#endif
    __syncthreads();
    const unsigned char* U8 = ws + WS_U8; const unsigned char* V8 = ws + WS_V8;
    const float* USC = (const float*)(ws + WS_USC); const float* VSC = (const float*)(ws + WS_VSC);
    const int me = ((lane >> 5) & 1) * 4 + ((lane >> 4) & 1) * 2 + ((lane >> 3) & 1);
#pragma unroll 1
    for (int ti = 0; ti < 4; ++ti) {
        const int tl = wave + 8 * ti; const size_t row = (size_t)32 * unit + tl; const int b = (int)(row >> 12);
        const float* mb = mod + b * 6144;
        float x1v[16], hv[16], acc[16];
        const float rstd = pg8::row_rstd((const float*)(ws + WS_SUMSQ), (int)row);
#pragma unroll
        for (int q4 = 0; q4 < 4; ++q4) { const int c = 16 * lane + 4 * q4;
            const f32x4 xv = *(const f32x4*)(outp + row * DM + c), g = *(const f32x4*)(gffn + c), sc = *(const f32x4*)(mb + 4096 + c), sh = *(const f32x4*)(mb + 3072 + c);
#pragma unroll
            for (int e = 0; e < 4; ++e) { const int i = 4 * q4 + e; x1v[i] = xv[e]; hv[i] = xv[e] * rstd * g[e] * (1.0f + sc[e]) + sh[e]; acc[i] = 0.f; } }
        const unsigned* el = (const unsigned*)(lds + PL_EID) + tl * 128; const float* gl = (const float*)(lds + PL_GATE) + tl * 128;
        u32x4 uA[8], vA[8]; float guA, gvA;
#define PEER_LOAD(U_, V_, GU_, GV_, e0_) do { _Pragma("unroll") for (int k = 0; k < 8; ++k) { const unsigned eid = el[(e0_) + k]; \
            U_[k] = *((const u32x4*)(U8 + (size_t)eid * 1024) + lane); V_[k] = *((const u32x4*)(V8 + (size_t)eid * 1024) + lane); } \
        { const unsigned em = el[(e0_) + me]; GU_ = USC[em]; GV_ = VSC[em] * gl[(e0_) + me]; } } while (0)
#define PEER_COMP(U_, V_, GU_, GV_) do { float pd[8]; \
        _Pragma("unroll") for (int k = 0; k < 8; ++k) { float d = 0.f; \
            _Pragma("unroll") for (int i = 0; i < 4; ++i) { const f32x2 lo = __builtin_amdgcn_cvt_pk_f32_fp8(U_[k][i], false), hi2 = __builtin_amdgcn_cvt_pk_f32_fp8(U_[k][i], true); \
                d += hv[4 * i] * lo.x; d += hv[4 * i + 1] * lo.y; d += hv[4 * i + 2] * hi2.x; d += hv[4 * i + 3] * hi2.y; } \
            pd[k] = d; } \
        float q4_[4], r2_[2], s_; \
        _Pragma("unroll") for (int k = 0; k < 4; ++k) { const float keep = (lane & 32) ? pd[k + 4] : pd[k], send = (lane & 32) ? pd[k] : pd[k + 4]; q4_[k] = keep + __shfl_xor(send, 32); } \
        _Pragma("unroll") for (int k = 0; k < 2; ++k) { const float keep = (lane & 16) ? q4_[k + 2] : q4_[k], send = (lane & 16) ? q4_[k] : q4_[k + 2]; r2_[k] = keep + __shfl_xor(send, 16); } \
        { const float keep = (lane & 8) ? r2_[1] : r2_[0], send = (lane & 8) ? r2_[0] : r2_[1]; s_ = keep + __shfl_xor(send, 8); } \
        s_ += __shfl_xor(s_, 4); s_ += __shfl_xor(s_, 2); s_ += __shfl_xor(s_, 1); \
        const float cf_ = GV_ * gelu_exact(s_ * GU_); \
        _Pragma("unroll") for (int k = 0; k < 8; ++k) { const float c = __uint_as_float((unsigned)__builtin_amdgcn_readlane((int)__float_as_uint(cf_), 32 * (k >> 2) + 16 * ((k >> 1) & 1) + 8 * (k & 1))); \
            _Pragma("unroll") for (int i = 0; i < 4; ++i) { const f32x2 lo = __builtin_amdgcn_cvt_pk_f32_fp8(V_[k][i], false), hi2 = __builtin_amdgcn_cvt_pk_f32_fp8(V_[k][i], true); \
                acc[4 * i] += c * lo.x; acc[4 * i + 1] += c * lo.y; acc[4 * i + 2] += c * hi2.x; acc[4 * i + 3] += c * hi2.y; } } } while (0)
#pragma unroll 1
        for (int e0 = 0; e0 < 128; e0 += 8) {
            PEER_LOAD(uA, vA, guA, gvA, e0);
            PEER_COMP(uA, vA, guA, gvA);
        }
#undef PEER_LOAD
#undef PEER_COMP
        float ss = 0.f;
#pragma unroll
        for (int q4 = 0; q4 < 4; ++q4) { const int c = 16 * lane + 4 * q4; const f32x4 gf = *(const f32x4*)(mb + 5120 + c);
#pragma unroll
            for (int e = 0; e < 4; ++e) { const int i = 4 * q4 + e; x1v[i] = x1v[i] + gf[e] * acc[i]; ss += x1v[i] * x1v[i]; } }
        const float r2 = 1.0f / sqrtf(wave_sum(ss) * (1.0f / DM) + EPS);
#pragma unroll
        for (int q4 = 0; q4 < 4; ++q4) { const int c = 16 * lane + 4 * q4; const f32x4 gn = *(const f32x4*)(gfin + c);
            f32x4 o;
#pragma unroll
            for (int e = 0; e < 4; ++e) o[e] = x1v[4 * q4 + e] * r2 * gn[e];
            *(f32x4*)(outp + row * DM + c) = o; }
    }
    __syncthreads();
}

#define XB_TMO      128
#define XB_XCNT(j)  (256  + 64 * (j))
#define XB_XSUB(j)  (1280 + 64 * (j))
#define XB_XGEN(j)  (2304 + 64 * (j))
#define XB_TOP      3328
#define XB_TOPGEN   3392
#define XCD_BAR_WORDS 3456
#define XB_SPIN_CAP (1u << 18)

__device__ __forceinline__ unsigned xb_ld(unsigned* p)              { return __hip_atomic_load(p, __ATOMIC_RELAXED, __HIP_MEMORY_SCOPE_AGENT); }
__device__ __forceinline__ unsigned xb_add(unsigned* p, unsigned v) { return __hip_atomic_fetch_add(p, v, __ATOMIC_RELAXED, __HIP_MEMORY_SCOPE_AGENT); }
__device__ __forceinline__ unsigned xb_xcc_id() { return (unsigned)__builtin_amdgcn_s_getreg((3 << 11) | 20) & 0xFu; }
#define XB_SPIN(cond, bar) do { unsigned _sp = 0; while (cond) { __builtin_amdgcn_s_sleep(1); \
    if ((++_sp & 255u) == 0u) { if (xb_ld(&(bar)[XB_TMO])) break; if (_sp > XB_SPIN_CAP) { atomicAdd(&(bar)[XB_TMO], 1u); break; } } } } while (0)

struct XcdBarrier {
    unsigned* bar; unsigned x;
    volatile LAS unsigned* st;
};

__device__ __forceinline__ XcdBarrier xcd_barrier_post(unsigned* bar, volatile LAS unsigned* st) {
    XcdBarrier b; b.bar = bar; b.x = xb_xcc_id(); b.st = st;
    if (threadIdx.x == 0) (void)xb_add(&bar[XB_XCNT(b.x)], 1u);
    return b;
}
__device__ __forceinline__ void xcd_barrier_complete(unsigned* bar, unsigned x, unsigned& nloc, unsigned& nx) {
    const unsigned G = gridDim.x * gridDim.y * gridDim.z;
    unsigned sum, cnt, mine, sp = 0u;
    for (;;) {
        sum = 0u; cnt = 0u; mine = 0u;
#pragma unroll
        for (unsigned j = 0; j < 16; ++j) { const unsigned c = xb_ld(&bar[XB_XCNT(j)]); sum += c; cnt += (c > 0u) ? 1u : 0u; mine = (j == x) ? c : mine; }
        if (sum == G) break;
        __builtin_amdgcn_s_sleep(1);
        if ((++sp & 255u) == 0u) { if (xb_ld(&bar[XB_TMO])) break; if (sp > XB_SPIN_CAP) { atomicAdd(&bar[XB_TMO], 1u); break; } }
    }
    nloc = mine > 0u ? mine : 1u; nx = cnt > 0u ? cnt : 1u;
}

__device__ __forceinline__ void xcd_barrier(const XcdBarrier& b) {
    asm volatile("s_waitcnt vmcnt(0)" ::: "memory");
    __syncthreads();
    if (threadIdx.x == 0) {
        unsigned* bar = b.bar;
        __builtin_amdgcn_s_waitcnt(0);
        unsigned nloc = b.st[0], nx = b.st[1];
        if (nloc == 0u) { xcd_barrier_complete(bar, b.x, nloc, nx); b.st[0] = nloc; b.st[1] = nx; }
        const unsigned old = xb_add(&bar[XB_XSUB(b.x)], 1u);
        const unsigned gen = old / nloc;
        if (old + 1u == (gen + 1u) * nloc) {
            __builtin_amdgcn_fence(__ATOMIC_RELEASE, "agent");
            asm volatile("s_waitcnt vmcnt(0)" ::: "memory");
            const unsigned og = xb_add(&bar[XB_TOP], 1u);
            const unsigned tg = og / nx;
            if (og + 1u == (tg + 1u) * nx) xb_add(&bar[XB_TOPGEN], 1u);
            else XB_SPIN(xb_ld(&bar[XB_TOPGEN]) == tg, bar);
            __builtin_amdgcn_fence(__ATOMIC_ACQUIRE, "agent");
            xb_add(&bar[XB_XGEN(b.x)], 1u);
            asm volatile("s_waitcnt vmcnt(0)" ::: "memory");
        } else {
            XB_SPIN(xb_ld(&bar[XB_XGEN(b.x)]) == gen, bar);
            __builtin_amdgcn_fence(__ATOMIC_ACQUIRE, "agent");
            asm volatile("s_waitcnt vmcnt(0)" ::: "memory");
        }
    }
    __syncthreads();
}

constexpr int N_PHASES = 8;
__global__ void __launch_bounds__(NTHREADS, 2) mega(Args a) {
    extern __shared__ __attribute__((aligned(16))) unsigned char lds[];
    const int tid = threadIdx.x, lane = tid & 63, wave = __builtin_amdgcn_readfirstlane(tid >> 6);
    const int bid = blockIdx.x, G = gridDim.x;
    unsigned char* ws = a.ws;
    const int lo = a.ph_lo, hi = a.ph_hi;
    volatile LAS unsigned* MISC = (volatile LAS unsigned*)((LAS unsigned char*)lds + MISC_OFF);
    if (tid < 16) MISC[tid] = 0u;
    __syncthreads();
    XcdBarrier bar; bar.bar = (unsigned*)(ws + WS_CTL) + CW_BAR; bar.x = 0; bar.st = nullptr;
    if (hi - lo > 1) bar = xcd_barrier_post((unsigned*)(ws + WS_CTL) + CW_BAR, MISC + 8);
#ifndef PH_MASK
#define PH_MASK 0xFF
#endif
#define IN(k) (((PH_MASK >> (k)) & 1) && lo <= (k) && (k) < hi)
#define SEAM(k) do { if (IN(k) && IN((k) + 1)) { xcd_barrier(bar); } } while (0)
#ifdef REP_PH
#ifndef REP_N
#define REP_N 1
#endif
#define REPS(k) for (int rep_ = 0; rep_ < ((k) == REP_PH ? 1 + REP_N : 1); ++rep_, ((k) == REP_PH && rep_ <= REP_N ? (xcd_barrier(bar), 0) : 0))
#else
#define REPS(k)
#endif

    REPS(0) if (IN(0)) phase0(a, lds, tid, wave, lane, bid, G);
    SEAM(0);
    REPS(1) if (IN(1)) phase1(a, wave, lane, bid, G);
    SEAM(1);
    REPS(2) if (IN(2)) {
        pg8::Gemm g{(const bf16_t*)(ws + WS_BUFA), (const bf16_t*)(ws + WS_WIN), MTOK, N1, DM}; pg8::StaticOrder S; S.init(MTOK, N1, G, bid);
        pg8::Epi1 E{ws};
        pg8::gemm_phase<pg8::Epi1, pg8::StaticOrder, true, true>((LAS unsigned char*)lds, g, S, E);
    }
    SEAM(2);
    REPS(3) if (IN(3)) {
#ifndef NO_RS
        for (int u = bid; u < 128; u += G)
            ret_state_unit(u >> 5, (u >> 3) & 3, u & 7, (const bf16_t*)(ws + WS_KR), (const bf16_t*)(ws + WS_VR), (bf16_t*)(ws + WS_STATE), lds, tid, wave, lane);
#endif
        for (int k = bid; k < 256; k += G)
#pragma unroll 1
            for (int i = 0; i < 4; ++i) {
                const int b = i, qt = (i < 2) ? k : 255 - k;
                idx_unit(b, qt, (const bf16_t*)(ws + WS_QI), (const bf16_t*)(ws + WS_KI), (const float*)(ws + WS_WI), (unsigned long long*)(ws + WS_MASK), lds, wave, lane);
            }
    }
    SEAM(3);
    REPS(4) if (IN(4)) {
        for (int k = bid; k < 256; k += G) {
            const int bh = k >> 3, s = k & 7;
#pragma unroll 1
            for (int i = 0; i < 2; ++i)
                attn_unit(bh >> 3, bh & 7, i ? 15 - s : s, (const bf16_t*)(ws + WS_QA), (const bf16_t*)(ws + WS_KA), (const bf16_t*)(ws + WS_VA), (const unsigned long long*)(ws + WS_MASK),
                          (bf16_t*)(ws + WS_BUFB), lds, tid, wave, lane);
        }
        for (int u = bid; u < 512; u += G)
            ret_out_unit(u >> 7, (u >> 5) & 3, u & 31, (const bf16_t*)(ws + WS_QR), (const bf16_t*)(ws + WS_KR), (const bf16_t*)(ws + WS_VR), (const bf16_t*)(ws + WS_GR),
                         (const bf16_t*)(ws + WS_STATE), (bf16_t*)(ws + WS_BUFB), lds, tid, wave, lane);
    }
    SEAM(4);
    REPS(5) if (IN(5)) {
        pg8::Gemm g{(const bf16_t*)(ws + WS_BUFB), (const bf16_t*)(ws + WS_WOUT), MTOK, DM, DM}; pg8::StaticOrder S; S.init(MTOK, DM, G, bid);
        pg8::Epi2 E{a.in[0], a.out, (bf16_t*)(ws + WS_BUFA), (const float*)(ws + WS_MOD), a.in[7], (float*)(ws + WS_SUMSQ)};
        pg8::gemm_phase<pg8::Epi2, pg8::StaticOrder, true, true>((LAS unsigned char*)lds, g, S, E);
    }
    SEAM(5);
    REPS(6) if (IN(6)) {
        pg8::Gemm g{(const bf16_t*)(ws + WS_BUFA), (const bf16_t*)(ws + WS_WPQ), MTOK, 2048, DM}; pg8::StaticOrder S; S.init(MTOK, 2048, G, bid);
        pg8::Epi3 E{(const float*)(ws + WS_SUMSQ), (const float*)(ws + WS_BIASF), (float*)(ws + WS_SC)};
        pg8::gemm_phase<pg8::Epi3, pg8::StaticOrder, true, true>((LAS unsigned char*)lds, g, S, E);
    }
    SEAM(6);
    if (IN(7)) {
        for (int u = bid; u < 512; u += G) peer_unit(u, ws, a.out, a.in[7], a.in[12], lds, tid, wave, lane);
    }
#undef IN
#undef SEAM
}

extern "C" void kernel_launch(void* const* d_in, const int* in_sizes, int n_in, void* d_out, int out_size, void* d_ws, size_t ws_size, hipStream_t stream) {
    static int grid = 0;
    if (grid == 0) {
        if (n_in != 13 || out_size != MTOK * DM || ws_size < WS_END) { fprintf(stderr, "kernel_launch: unexpected shapes (n_in %d, out %d, ws %zu); nothing launched\n", n_in, out_size, ws_size); grid = -1; return; }
        int dev = 0, cus = 0, per_cu = 0;
        if (hipGetDevice(&dev) != hipSuccess || hipDeviceGetAttribute(&cus, hipDeviceAttributeMultiprocessorCount, dev) != hipSuccess) { grid = -1; return; }
        if (hipFuncSetAttribute((const void*)mega, hipFuncAttributeMaxDynamicSharedMemorySize, LDS_BYTES) != hipSuccess) { fprintf(stderr, "kernel_launch: hipFuncSetAttribute failed\n"); grid = -1; return; }
        if (hipOccupancyMaxActiveBlocksPerMultiprocessor(&per_cu, (const void*)mega, NTHREADS, LDS_BYTES) != hipSuccess || per_cu < 1) { fprintf(stderr, "kernel_launch: occupancy query gave %d\n", per_cu); per_cu = 1; }
        (void)hipGetLastError();
        grid = cus;
    }
    if (grid < 0) return;
    if (hipMemsetAsync((char*)d_ws + WS_CTL, 0, CTL_BYTES, stream) != hipSuccess) { fprintf(stderr, "kernel_launch: memset failed\n"); return; }
    Args a{};
    for (int i = 0; i < 13; ++i) a.in[i] = (const float*)d_in[i];
    a.out = (float*)d_out; a.ws = (unsigned char*)d_ws;
#if MK_MULTI
    for (int p = 0; p < N_PHASES; ++p) { a.ph_lo = p; a.ph_hi = p + 1; hipLaunchKernelGGL(mega, dim3(grid), dim3(NTHREADS), LDS_BYTES, stream, a); }
#else
    a.ph_lo = 0; a.ph_hi = N_PHASES;
    hipLaunchKernelGGL(mega, dim3(grid), dim3(NTHREADS), LDS_BYTES, stream, a);
#endif
}
```

```cpp
#include <hip/hip_runtime.h>
#include <cstdio>
#include <cstdint>

#ifndef MK_MULTI
#define MK_MULTI 0
#endif

#define GAS __attribute__((address_space(1)))
#define LAS __attribute__((address_space(3)))
typedef unsigned short bf16_t;
typedef short bf16x8 __attribute__((ext_vector_type(8)));
typedef float f32x4 __attribute__((ext_vector_type(4)));
typedef float f32x16 __attribute__((ext_vector_type(16)));
typedef unsigned u32x4 __attribute__((ext_vector_type(4)));
typedef unsigned u32x2 __attribute__((ext_vector_type(2)));

constexpr int BATCH = 4, SEQ = 4096, DM = 1024, MTOK = BATCH * SEQ;
constexpr int N1 = 4352;
constexpr int NTHREADS = 512;
constexpr float EPS = 1e-6f;
constexpr float C_QK = 0.18033688011112042f;
constexpr float NEG_INF = -__builtin_huge_valf();

__device__ __forceinline__ float ret_log2g(int h) { return h == 0 ? -0.045803689613124791f : h == 1 ? -0.022720076500083530f : h == 2 ? -0.011315313227834147f : -0.0056465631411420624f; }
__device__ __forceinline__ float ret_gamma(int h) { return h == 0 ? 0.96875f : h == 1 ? 0.984375f : h == 2 ? 0.9921875f : 0.99609375f; }
__device__ __forceinline__ float ret_g128(int h) { return h == 0 ? 0.017183023570817902f : h == 1 ? 0.13321516287964842f : h == 2 ? 0.36643771592203725f : 0.60593708822908032f; }
__device__ __forceinline__ float ret_g127(int h) { return h == 0 ? 0.017737314653747512f : h == 1 ? 0.13532968927456347f : h == 2 ? 0.36932305226788007f : 0.60831331210448848f; }

constexpr size_t MiB = 1u << 20;
constexpr size_t WS_CTL = 0, CTL_BYTES = 1 * MiB;
constexpr size_t WS_SUMSQ = 5 * MiB;
constexpr size_t WS_MOD = 1 * MiB;
constexpr size_t WS_BIASF = 1 * MiB + 128 * 1024;
constexpr size_t WS_COSA = 2 * MiB, WS_SINA = 2 * MiB + 512 * 1024;
constexpr size_t WS_COSR = 3 * MiB, WS_SINR = 4 * MiB;
constexpr size_t WS_WIN = 6 * MiB;
constexpr size_t WS_WOUT = 15 * MiB;
constexpr size_t WS_WPQ = 17 * MiB;
constexpr size_t WS_BUFA = 22 * MiB;
constexpr size_t WS_MASK = WS_BUFA, WS_STATE = WS_BUFA + 8 * MiB;
constexpr size_t WS_BUFB = 54 * MiB;
constexpr size_t WS_G1 = 86 * MiB;
constexpr size_t WS_QA = WS_G1, WS_KA = WS_G1 + 16 * MiB, WS_VA = WS_G1 + 32 * MiB, WS_QI = WS_G1 + 48 * MiB, WS_QR = WS_G1 + 64 * MiB,
                 WS_KR = WS_G1 + 80 * MiB, WS_VR = WS_G1 + 96 * MiB, WS_GR = WS_G1 + 112 * MiB, WS_KI = WS_G1 + 128 * MiB, WS_WI = WS_G1 + 130 * MiB;
constexpr size_t WS_SC = WS_G1;
constexpr size_t WS_U8 = 217 * MiB, WS_V8 = 233 * MiB;
constexpr size_t WS_USC = 249 * MiB, WS_VSC = 249 * MiB + 65536;
constexpr size_t WS_END = 256 * MiB;
static_assert(WS_WI + (size_t)MTOK * 8 * 4 <= WS_U8 && WS_SC + (size_t)MTOK * 2048 * 4 <= WS_U8 && WS_VSC + 65536 <= WS_END, "ws map");
constexpr int LDS_BYTES = 147456;
constexpr int MISC_OFF = LDS_BYTES - 64;
constexpr int CW_BAR = 4096;

__device__ __forceinline__ unsigned f2bf(float f) { unsigned u = __float_as_uint(f); return (u + 0x7fffu + ((u >> 16) & 1u)) >> 16; }
typedef float f32x2_t __attribute__((ext_vector_type(2))); typedef __bf16 bf16x2_t __attribute__((ext_vector_type(2)));
__device__ __forceinline__ unsigned pk2(float lo, float hi) { const f32x2_t v = {lo, hi}; const bf16x2_t b = __builtin_convertvector(v, bf16x2_t); return __builtin_bit_cast(unsigned, b); }
__device__ __forceinline__ float bf_lo(unsigned w) { return __uint_as_float(w << 16); }
__device__ __forceinline__ float bf_hi(unsigned w) { return __uint_as_float(w & 0xffff0000u); }
__device__ __forceinline__ float wave_sum(float v) {
#pragma unroll
    for (int o = 1; o < 64; o <<= 1) v += __shfl_xor(v, o);
    return v;
}
__device__ __forceinline__ float fast_exp2(float x) { return __builtin_amdgcn_exp2f(x); }
__device__ __forceinline__ float gelu_exact(float v) {
    const float av = fabsf(v), t = __builtin_amdgcn_rcpf(av * 0.2316418882f + 1.0f);
    float q = t * 0.5307027145f + (-0.7265760135f); q = q * t + 0.7107068705f; q = q * t + (-0.142248368f); q = q * t + 0.127414796f; q = q * t;
    const float e = fast_exp2(v * v * (-0.72134752044f));
    const float m = v * (q * e);
    return v < 0.f ? m : v - m;
}
__device__ __forceinline__ float silu_f(float v) { return v / (1.0f + __expf(-v)); }
__device__ __forceinline__ unsigned sortable32(float f) { const unsigned u = __float_as_uint(f); return (u & 0x80000000u) ? ~u : (u | 0x80000000u); }
__device__ __forceinline__ float unsortable32(unsigned s) { return __uint_as_float((s & 0x80000000u) ? (s ^ 0x80000000u) : ~s); }
__device__ __forceinline__ unsigned sortable16(float x) {
    const _Float16 h = (_Float16)x; const unsigned b = (unsigned)__builtin_bit_cast(unsigned short, h);
    return (b & 0x8000u) ? (~b & 0xFFFFu) : (b | 0x8000u);
}
__device__ __forceinline__ f32x4 mfma16(bf16x8 a, bf16x8 b, f32x4 c) { return __builtin_amdgcn_mfma_f32_16x16x32_bf16(a, b, c, 0, 0, 0); }
__device__ __forceinline__ f32x16 mfma32(bf16x8 a, bf16x8 b, f32x16 c) { return __builtin_amdgcn_mfma_f32_32x32x16_bf16(a, b, c, 0, 0, 0); }

__host__ __device__ __forceinline__ int win_src_col(int p) {
    const int tile = p >> 8, bj = (p >> 7) & 1, q = p & 127;
    if (tile < 4) return 256 * tile + (q >> 5) * 64 + bj * 32 + (q & 31);
    if (tile < 6) return p;
    if (tile < 8) return 256 * tile + (q >> 5) * 64 + bj * 32 + (q & 31);
    if (tile == 8) { if (q < 32) return 2048 + bj * 32 + q; if (bj == 0 && q < 40) return 2112 + (q - 32); return -1; }
    if (tile < 13) { const int base = (tile < 11) ? 2120 + 256 * (tile - 9) : 2632 + 256 * (tile - 11); return base + (q >> 6) * 128 + bj * 64 + (q & 63); }
    if (tile < 15) return 3144 + (p - 13 * 256);
    return 3656 + (p - 15 * 256);
}
namespace pg8 {
#define PG8_LAS __attribute__((address_space(3)))
typedef unsigned short bf16_t;
typedef short bf16x8 __attribute__((ext_vector_type(8)));
typedef float f32x4 __attribute__((ext_vector_type(4)));
typedef unsigned u32x4 __attribute__((ext_vector_type(4)));
constexpr int BM = 256, BK = 64, HALF = 128, HTB = HALF * BK * 2  , STAGE_BYTES = 8 * HTB, NXCD = 8, WGM = 8;

__host__ __device__ __forceinline__ int lds_byte(int r, int c) { const int st = (r >> 4) * 2 + (c >> 5), rr = r & 15, cc = c & 31, ob = rr * 64 + cc * 2; return st * 1024 + (ob ^ (((ob >> 9) & 1) << 5)); }
__host__ __device__ __forceinline__ void stage_rc(int b, int& R, int& C) { const int st = b / 1024, sb = b % 1024, swz = sb ^ (((sb >> 9) & 1) << 5); R = (st >> 1) * 16 + swz / 64; C = (st & 1) * 32 + (swz % 64) / 2; }
__host__ __device__ __forceinline__ int perm32(int rho) { const int n = rho >> 4, i = rho & 15; return 8 * (i >> 2) + 4 * n + (i & 3); }

struct Unit { int pm, pn; };
struct Gemm { const bf16_t* A; const bf16_t* Bt; int M, N, K; };

struct StaticOrder {
    int nM, nN, nwg, G, c;
    __host__ __device__ void init(int M, int N, int G_, int c_) { nM = M / BM; nN = N / BM; nwg = nM * nN; G = G_; c = c_; }
    __host__ __device__ bool next(int i, Unit& u) const {
        const long L = (long)i * G + c; if (L >= nwg) return false;
        int wgid = (int)L; { const int q = nwg / NXCD, r = nwg % NXCD, xcd = wgid % NXCD, off = wgid / NXCD; wgid = (xcd < r ? xcd * (q + 1) : r * (q + 1) + (xcd - r) * q) + off; }
        const int nig = WGM * nN, gid = wgid / nig, fm = gid * WGM, gsz = (nM - fm) < WGM ? (nM - fm) : WGM;
        u.pm = fm + ((wgid % nig) % gsz); u.pn = (wgid % nig) / gsz; return true;
    }
    __device__ __forceinline__ void a_ready(const Unit&) const {}
    __device__ __forceinline__ void done(const Unit&) const {}
};

__device__ __forceinline__ unsigned cvt_pk_bf16(float lo, float hi) { unsigned r; asm volatile("v_cvt_pk_bf16_f32 %0, %1, %2" : "=v"(r) : "v"(lo), "v"(hi)); return r; }
__device__ __forceinline__ u32x4 pack8(const float (&v)[8]) { u32x4 w; w.x = cvt_pk_bf16(v[0], v[1]); w.y = cvt_pk_bf16(v[2], v[3]); w.z = cvt_pk_bf16(v[4], v[5]); w.w = cvt_pk_bf16(v[6], v[7]); return w; }

struct Epi1 {
    static constexpr bool PERM = true, AFTER_DRAIN = false;
    unsigned char* ws;
    __device__ __forceinline__ void operator()(const f32x4 (&acc)[2][2][4][2], const Unit& u, int wr, int wc, int fr, int fq) const {
        const int tile = u.pn;
        const int row0 = u.pm * BM + wr * 64 + fr;
        const float* cosA = (const float*)(ws + WS_COSA); const float* sinA = (const float*)(ws + WS_SINA);
        const float* cosR = (const float*)(ws + WS_COSR); const float* sinR = (const float*)(ws + WS_SINR);
        if (tile < 4 || tile == 6 || tile == 7) {
            bf16_t* dst = (bf16_t*)(ws + (tile < 2 ? WS_QA : tile < 4 ? WS_KA : WS_QI));
            const int tl = tile < 2 ? tile : tile < 4 ? tile - 2 : tile - 6;
            const float scale = tile < 2 ? C_QK : 1.0f;
            const int cb = 256 * tl + 64 * wc, i0 = 8 * fq;
#pragma unroll
            for (int ai = 0; ai < 2; ++ai)
#pragma unroll
                for (int m = 0; m < 4; ++m) {
                    const int row = row0 + ai * HALF + m * 16, pos = row & (SEQ - 1);
                    const f32x4 c0 = *(const f32x4*)(cosA + pos * 32 + i0), c1 = *(const f32x4*)(cosA + pos * 32 + i0 + 4);
                    const f32x4 s0 = *(const f32x4*)(sinA + pos * 32 + i0), s1 = *(const f32x4*)(sinA + pos * 32 + i0 + 4);
                    float y1[8], y2[8];
#pragma unroll
                    for (int n = 0; n < 2; ++n)
#pragma unroll
                        for (int e = 0; e < 4; ++e) {
                            const float x1 = acc[ai][0][m][n][e], x2 = acc[ai][1][m][n][e];
                            const float c = n ? c1[e] : c0[e], s = n ? s1[e] : s0[e];
                            y1[4 * n + e] = (x1 * c - x2 * s) * scale; y2[4 * n + e] = (x1 * s + x2 * c) * scale;
                        }
                    bf16_t* rp = dst + (size_t)row * 512 + cb + i0;
                    *(u32x4*)rp = pack8(y1); *(u32x4*)(rp + 32) = pack8(y2);
                }
        } else if (tile == 4 || tile == 5 || tile >= 13) {
            bf16_t* dst = (bf16_t*)(ws + (tile < 6 ? WS_VA : tile < 15 ? WS_VR : WS_GR));
            const int tl = tile < 6 ? tile - 4 : tile < 15 ? tile - 13 : tile - 15;
            const bool act = tile >= 15;
#pragma unroll
            for (int ai = 0; ai < 2; ++ai)
#pragma unroll
                for (int m = 0; m < 4; ++m) {
                    const int row = row0 + ai * HALF + m * 16;
#pragma unroll
                    for (int bj = 0; bj < 2; ++bj) {
                        float y[8];
#pragma unroll
                        for (int n = 0; n < 2; ++n)
#pragma unroll
                            for (int e = 0; e < 4; ++e) { const float v = acc[ai][bj][m][n][e]; y[4 * n + e] = act ? silu_f(v) : v; }
                        *(u32x4*)(dst + (size_t)row * 512 + 256 * tl + 128 * bj + 32 * wc + 8 * fq) = pack8(y);
                    }
                }
        } else if (tile == 8) {
#pragma unroll
            for (int ai = 0; ai < 2; ++ai)
#pragma unroll
                for (int m = 0; m < 4; ++m) {
                    const int row = row0 + ai * HALF + m * 16, pos = row & (SEQ - 1);
                    if (wc == 0) {
                        const int i0 = 8 * fq;
                        const f32x4 c0 = *(const f32x4*)(cosA + pos * 32 + i0), c1 = *(const f32x4*)(cosA + pos * 32 + i0 + 4);
                        const f32x4 s0 = *(const f32x4*)(sinA + pos * 32 + i0), s1 = *(const f32x4*)(sinA + pos * 32 + i0 + 4);
                        float y1[8], y2[8];
#pragma unroll
                        for (int n = 0; n < 2; ++n)
#pragma unroll
                            for (int e = 0; e < 4; ++e) {
                                const float x1 = acc[ai][0][m][n][e], x2 = acc[ai][1][m][n][e];
                                const float c = n ? c1[e] : c0[e], s = n ? s1[e] : s0[e];
                                y1[4 * n + e] = x1 * c - x2 * s; y2[4 * n + e] = x1 * s + x2 * c;
                            }
                        bf16_t* rp = (bf16_t*)(ws + WS_KI) + (size_t)row * 64 + i0;
                        *(u32x4*)rp = pack8(y1); *(u32x4*)(rp + 32) = pack8(y2);
                    } else if (wc == 1 && fq == 0) {
                        const float sw = 0.35355339059327379f;
                        float* WI = (float*)(ws + WS_WI);
                        *(f32x4*)(WI + (size_t)row * 8) = acc[ai][0][m][0] * sw;
                        *(f32x4*)(WI + (size_t)row * 8 + 4) = acc[ai][0][m][1] * sw;
                    }
                }
        } else {
            const bool isk = tile >= 11;
            bf16_t* dst = (bf16_t*)(ws + (isk ? WS_KR : WS_QR));
            const int tl = isk ? tile - 11 : tile - 9, hl = wc >> 1, h = 2 * tl + hl;
            const int i0 = 32 * (wc & 1) + 8 * fq, cb = 256 * tl + 128 * hl;
            const float lg = isk ? -ret_log2g(h) : ret_log2g(h);
            const float base = isk ? 0.08838834764831845f : 1.0f;
#pragma unroll
            for (int ai = 0; ai < 2; ++ai)
#pragma unroll
                for (int m = 0; m < 4; ++m) {
                    const int row = row0 + ai * HALF + m * 16, pos = row & (SEQ - 1);
                    const float dec = base * fast_exp2(lg * (float)(pos & 127));
                    const f32x4 c0 = *(const f32x4*)(cosR + pos * 64 + i0), c1 = *(const f32x4*)(cosR + pos * 64 + i0 + 4);
                    const f32x4 s0 = *(const f32x4*)(sinR + pos * 64 + i0), s1 = *(const f32x4*)(sinR + pos * 64 + i0 + 4);
                    float y1[8], y2[8];
#pragma unroll
                    for (int n = 0; n < 2; ++n)
#pragma unroll
                        for (int e = 0; e < 4; ++e) {
                            const float x1 = acc[ai][0][m][n][e], x2 = acc[ai][1][m][n][e];
                            const float c = n ? c1[e] : c0[e], s = n ? s1[e] : s0[e];
                            y1[4 * n + e] = (x1 * c - x2 * s) * dec; y2[4 * n + e] = (x1 * s + x2 * c) * dec;
                        }
                    bf16_t* rp = dst + (size_t)row * 512 + cb + i0;
                    *(u32x4*)rp = pack8(y1); *(u32x4*)(rp + 64) = pack8(y2);
                }
        }
    }
};

__device__ __forceinline__ float row_rstd(const float* sumsq, int row) {
    const f32x4* p = (const f32x4*)(sumsq + (size_t)row * 16);
    const f32x4 a = p[0], b = p[1], c = p[2], d = p[3];
    const float s = (((a[0] + a[1]) + (a[2] + a[3])) + ((b[0] + b[1]) + (b[2] + b[3]))) + (((c[0] + c[1]) + (c[2] + c[3])) + ((d[0] + d[1]) + (d[2] + d[3])));
    return 1.0f / sqrtf(s * (1.0f / DM) + EPS);
}
struct Epi2 {
    static constexpr bool PERM = false, AFTER_DRAIN = false;
    const float* x; float* x1; bf16_t* a3; const float* mod; const float* gffn; float* sumsq;
    __device__ __forceinline__ void operator()(const f32x4 (&acc)[2][2][4][2], const Unit& u, int wr, int wc, int fr, int fq) const {
        const int row0 = u.pm * BM + wr * 64 + fr, col0 = u.pn * BM + wc * 32 + 4 * fq;
#pragma unroll
        for (int ai = 0; ai < 2; ++ai)
#pragma unroll
            for (int m = 0; m < 4; ++m) {
                const int row = row0 + ai * HALF + m * 16, b = row >> 12;
                const float* mb = mod + b * 6144;
                float ss = 0.f;
#pragma unroll
                for (int bj = 0; bj < 2; ++bj)
#pragma unroll
                    for (int n = 0; n < 2; ++n) {
                        const int c = col0 + bj * HALF + n * 16;
                        const f32x4 xv = *(const f32x4*)(x + (size_t)row * DM + c), gt = *(const f32x4*)(mb + 2048 + c);
#ifdef DBG_NOMIX
                        const f32x4 v = xv;
#else
                        const f32x4 v = xv + gt * acc[ai][bj][m][n];
#endif
                        *(f32x4*)(x1 + (size_t)row * DM + c) = v;
                        ss += (v[0] * v[0] + v[1] * v[1]) + (v[2] * v[2] + v[3] * v[3]);
                        const f32x4 gs = *(const f32x4*)(gffn + c) * (*(const f32x4*)(mb + 4096 + c) + 1.0f);
                        const f32x4 a = v * gs;
                        u32x2 w; w.x = cvt_pk_bf16(a[0], a[1]); w.y = cvt_pk_bf16(a[2], a[3]);
                        *(u32x2*)(a3 + (size_t)row * DM + c) = w;
                    }
                ss += __shfl_xor(ss, 16); ss += __shfl_xor(ss, 32);
                if (fq == 0) sumsq[(size_t)row * 16 + u.pn * 4 + wc] = ss;
            }
    }
};

struct Epi3 {
    static constexpr bool PERM = false, AFTER_DRAIN = false;
    const float* sumsq; const float* biasf; float* sc;
    __device__ __forceinline__ void operator()(const f32x4 (&acc)[2][2][4][2], const Unit& u, int wr, int wc, int fr, int fq) const {
        const int row0 = u.pm * BM + wr * 64 + fr, col0 = u.pn * BM + wc * 32 + 4 * fq;
#pragma unroll
        for (int ai = 0; ai < 2; ++ai)
#pragma unroll
            for (int m = 0; m < 4; ++m) {
                const int row = row0 + ai * HALF + m * 16, b = row >> 12;
                const float rstd = row_rstd(sumsq, row);
#pragma unroll
                for (int bj = 0; bj < 2; ++bj)
#pragma unroll
                    for (int n = 0; n < 2; ++n) {
                        const int c = col0 + bj * HALF + n * 16;
                        *(f32x4*)(sc + (size_t)row * 2048 + c) = acc[ai][bj][m][n] * rstd + *(const f32x4*)(biasf + b * 2048 + c);
                    }
            }
    }
};

template <class Epi, class Sched, bool ALIGN_EPI = false, bool SP2 = false>
__device__ __forceinline__ void gemm_phase(PG8_LAS unsigned char* lds, const Gemm g, const Sched& S, const Epi& E) {
    const int tid = threadIdx.x, wid = __builtin_amdgcn_readfirstlane(tid >> 6), lane = tid & 63, wr = wid >> 2, wc = wid & 3, fr = lane & 15, fq = lane >> 4;
    const int K = g.K, nt = K / BK;
    unsigned voffA[2], voffB[2];
#pragma unroll
    for (int i = 0; i < 2; ++i) { int R, C; stage_rc(tid * 16 + i * 8192, R, C); const int Rb = Epi::PERM ? ((R & ~31) + perm32(R & 31)) : R;
        voffA[i] = (unsigned)(R * K + C) * 2u; voffB[i] = (unsigned)(Rb * K + C) * 2u; }
    const size_t kstep = (size_t)(BK * 2);
    const size_t hstep = (size_t)HALF * K * 2;
    const size_t tstep = 2 * hstep;
    const unsigned ldsw = (unsigned)wid * 1024u;
    const int aoff = lds_byte(wr * 64 + fr, fq * 8), boff = lds_byte(wc * 32 + fr, fq * 8);
#define PG8_SA(b, h) (((b) * 2 + (h)) * HTB)
#define PG8_SB(b, h) ((4 + (b) * 2 + (h)) * HTB)
#define PG8_STAGE(bufoff, gbase, voff) do { _Pragma("unroll") for (int _i = 0; _i < 2; ++_i) \
        __builtin_amdgcn_global_load_lds((const unsigned*)((const char*)(gbase) + (voff)[_i]), (PG8_LAS unsigned*)(lds + (bufoff) + ldsw + _i * 8192), 16, 0, 0); } while (0)
#define PG8_LDA(dst, b, h) do { _Pragma("unroll") for (int m = 0; m < 4; ++m) _Pragma("unroll") for (int k = 0; k < 2; ++k) dst[m][k] = *(const PG8_LAS bf16x8*)(lds + PG8_SA(b, h) + aoff + m * 2048 + k * 1024); } while (0)
#define PG8_LDB(dst, b, h) do { _Pragma("unroll") for (int n = 0; n < 2; ++n) _Pragma("unroll") for (int k = 0; k < 2; ++k) dst[n][k] = *(const PG8_LAS bf16x8*)(lds + PG8_SB(b, h) + boff + n * 2048 + k * 1024); } while (0)
#define PG8_MMA(ai, bj, At, Bt) do { __builtin_amdgcn_s_setprio(1); _Pragma("unroll") for (int m = 0; m < 4; ++m) _Pragma("unroll") for (int n = 0; n < 2; ++n) _Pragma("unroll") for (int k = 0; k < 2; ++k) \
        acc[ai][bj][m][n] = __builtin_amdgcn_mfma_f32_16x16x32_bf16(Bt[n][k], At[m][k], acc[ai][bj][m][n], 0, 0, 0); __builtin_amdgcn_s_setprio(0); } while (0)
#define PG8_WAIT_V(n) asm volatile("s_waitcnt vmcnt(" #n ")" ::: "memory")
#define PG8_WAIT_L(n) asm volatile("s_waitcnt lgkmcnt(" #n ")" ::: "memory")
#define PG8_BAR __builtin_amdgcn_s_barrier()
#define PG8_SCHED __builtin_amdgcn_sched_barrier(0)
    Unit cur, nxt; int ui = 0;
    if (!S.next(0, cur)) return;
    f32x4 acc[2][2][4][2];
#pragma unroll
    for (int a = 0; a < 2; ++a)
#pragma unroll
        for (int b = 0; b < 2; ++b)
#pragma unroll
            for (int m = 0; m < 4; ++m)
#pragma unroll
                for (int n = 0; n < 2; ++n) acc[a][b][m][n] = (f32x4){0.f, 0.f, 0.f, 0.f};
    bf16x8 At[4][2], B0[2][2], B1[2][2];
    const char* cA = (const char*)g.A + (size_t)cur.pm * tstep; const char* cB = (const char*)g.Bt + (size_t)cur.pn * tstep;
    S.a_ready(cur);
    if constexpr (SP2) {
        PG8_STAGE(PG8_SB(0, 0), cB, voffB); PG8_STAGE(PG8_SB(0, 1), cB + hstep, voffB); PG8_STAGE(PG8_SA(0, 0), cA, voffA); PG8_STAGE(PG8_SA(0, 1), cA + hstep, voffA);
        if (wr == 1) PG8_BAR;
        PG8_WAIT_V(2); PG8_BAR;
        PG8_STAGE(PG8_SB(1, 0), cB + kstep, voffB); PG8_STAGE(PG8_SA(1, 0), cA + kstep, voffA); PG8_STAGE(PG8_SB(1, 1), cB + hstep + kstep, voffB);
        PG8_WAIT_V(6); PG8_BAR;
    } else {
        PG8_STAGE(PG8_SB(0, 0), cB, voffB); PG8_STAGE(PG8_SA(0, 0), cA, voffA); PG8_STAGE(PG8_SB(0, 1), cB + hstep, voffB); PG8_STAGE(PG8_SA(0, 1), cA + hstep, voffA);
        if (wr == 1) PG8_BAR;
        PG8_WAIT_V(4); PG8_BAR;
        PG8_STAGE(PG8_SB(1, 0), cB + kstep, voffB); PG8_STAGE(PG8_SA(1, 0), cA + kstep, voffA); PG8_STAGE(PG8_SB(1, 1), cB + hstep + kstep, voffB);
        PG8_WAIT_V(6); PG8_BAR;
    }
    for (;;) {
        const bool has_next = S.next(ui + 1, nxt);
        const char* nA = has_next ? (const char*)g.A + (size_t)nxt.pm * tstep : cA; const char* nB = has_next ? (const char*)g.Bt + (size_t)nxt.pn * tstep : cB;
        for (int t = 0; t < nt; t += 2) {
            const bool last = (t == nt - 2);
            const char* a1 = cA + (size_t)(t + 1) * kstep;
            const char* a2 = last ? nA : cA + (size_t)(t + 2) * kstep; const char* b2 = last ? nB : cB + (size_t)(t + 2) * kstep;
            const char* a3 = a2 + kstep; const char* b3 = b2 + kstep;
            if (last && has_next) S.a_ready(nxt);
            if constexpr (SP2) {
            PG8_LDB(B0, 0, 0); PG8_LDB(B1, 0, 1); PG8_SCHED; PG8_LDA(At, 0, 0); PG8_STAGE(PG8_SA(1, 1), a1 + hstep, voffA);
            PG8_WAIT_V(8); PG8_WAIT_L(0); PG8_BAR; PG8_MMA(0, 0, At, B0); PG8_MMA(0, 1, At, B1); PG8_BAR; PG8_SCHED;
            PG8_LDA(At, 0, 1); PG8_STAGE(PG8_SB(0, 0), b2, voffB); PG8_STAGE(PG8_SB(0, 1), b2 + hstep, voffB); PG8_STAGE(PG8_SA(0, 0), a2, voffA);
            PG8_WAIT_V(8); PG8_WAIT_L(0); PG8_BAR; PG8_MMA(1, 0, At, B0); PG8_MMA(1, 1, At, B1); PG8_BAR; PG8_SCHED;
            PG8_LDB(B0, 1, 0); PG8_LDB(B1, 1, 1); PG8_SCHED; PG8_LDA(At, 1, 0); PG8_STAGE(PG8_SA(0, 1), a2 + hstep, voffA);
            PG8_WAIT_V(8); PG8_WAIT_L(0); PG8_BAR; PG8_MMA(0, 0, At, B0); PG8_MMA(0, 1, At, B1); PG8_BAR; PG8_SCHED;
            PG8_LDA(At, 1, 1); PG8_STAGE(PG8_SB(1, 0), b3, voffB); PG8_STAGE(PG8_SB(1, 1), b3 + hstep, voffB); PG8_STAGE(PG8_SA(1, 0), a3, voffA);
            PG8_WAIT_V(8); PG8_WAIT_L(0); PG8_BAR; PG8_MMA(1, 0, At, B0); PG8_MMA(1, 1, At, B1); PG8_BAR; PG8_SCHED;
            } else {
            PG8_LDB(B0, 0, 0); PG8_SCHED; PG8_LDA(At, 0, 0); PG8_STAGE(PG8_SA(1, 1), a1 + hstep, voffA);
            PG8_WAIT_L(8); PG8_BAR; PG8_WAIT_L(0); PG8_MMA(0, 0, At, B0); PG8_BAR; PG8_SCHED;
            PG8_LDB(B1, 0, 1); PG8_STAGE(PG8_SB(0, 0), b2, voffB);
            PG8_BAR; PG8_WAIT_L(0); PG8_MMA(0, 1, At, B1); PG8_BAR;
            PG8_LDA(At, 0, 1); PG8_STAGE(PG8_SA(0, 0), a2, voffA);
            PG8_BAR; PG8_WAIT_L(0); PG8_MMA(1, 0, At, B0); PG8_BAR; PG8_SCHED;
            PG8_STAGE(PG8_SB(0, 1), b2 + hstep, voffB);
            PG8_WAIT_V(6); PG8_BAR; PG8_MMA(1, 1, At, B1); PG8_BAR;
            PG8_LDB(B0, 1, 0); PG8_SCHED; PG8_LDA(At, 1, 0); PG8_STAGE(PG8_SA(0, 1), a2 + hstep, voffA);
            PG8_WAIT_L(8); PG8_BAR; PG8_WAIT_L(0); PG8_MMA(0, 0, At, B0); PG8_BAR; PG8_SCHED;
            PG8_LDB(B1, 1, 1); PG8_STAGE(PG8_SB(1, 0), b3, voffB);
            PG8_BAR; PG8_WAIT_L(0); PG8_MMA(0, 1, At, B1); PG8_BAR;
            PG8_LDA(At, 1, 1); PG8_STAGE(PG8_SA(1, 0), a3, voffA);
            PG8_BAR; PG8_WAIT_L(0); PG8_MMA(1, 0, At, B0); PG8_BAR; PG8_SCHED;
            PG8_STAGE(PG8_SB(1, 1), b3 + hstep, voffB);
            PG8_WAIT_V(6); PG8_BAR; PG8_MMA(1, 1, At, B1); PG8_BAR;
            }
        }
        if constexpr (ALIGN_EPI) { if (wr == 0) PG8_BAR; }
        if constexpr (!Epi::AFTER_DRAIN) { E(acc, cur, wr, wc, fr, fq); S.done(cur); }
        if (!has_next) break;
#pragma unroll
        for (int a = 0; a < 2; ++a)
#pragma unroll
            for (int b = 0; b < 2; ++b)
#pragma unroll
                for (int m = 0; m < 4; ++m)
#pragma unroll
                    for (int n = 0; n < 2; ++n) acc[a][b][m][n] = (f32x4){0.f, 0.f, 0.f, 0.f};
        cur = nxt; cA = nA; cB = nB; ++ui;
        if constexpr (ALIGN_EPI) { if (wr == 1) PG8_BAR; }
    }
    PG8_WAIT_V(0);
    if constexpr (!ALIGN_EPI) { if (wr == 0) PG8_BAR; }
    PG8_BAR;
    if constexpr (Epi::AFTER_DRAIN) { E.fused(acc, cur, wr, wc, fr, fq, lds, wid, lane); S.done(cur); }
#undef PG8_SA
#undef PG8_SB
#undef PG8_STAGE
#undef PG8_LDA
#undef PG8_LDB
#undef PG8_MMA
#undef PG8_WAIT_V
#undef PG8_WAIT_L
#undef PG8_BAR
#undef PG8_SCHED
}
}
struct Args { const float* in[13]; float* out; unsigned char* ws; int ph_lo, ph_hi; };

#ifndef TPROBE_I
#define TPROBE_I 3
#endif
#ifndef TPROBE_B
#define TPROBE_B 0
#endif
#ifdef TIME_PH
#ifndef TIME_AMP
#define TIME_AMP 4
#endif
#define TSTAMP(k, slot) do { if ((k) == TIME_PH && bid == TPROBE_B && tid == 0) { const unsigned long long t_ = __builtin_amdgcn_s_memrealtime(); MISC[slot] = (unsigned)t_; MISC[(slot) + 1] = (unsigned)(t_ >> 32); } } while (0)
#else
#define TSTAMP(k, slot) do { } while (0)
#endif
template <bool PERMUTE>
__device__ __forceinline__ void p0_transpose_item(const float* W, int K, int N, int NPOS, bf16_t* WT, LAS float* scr, int item, int lane) {
    const int nblk = NPOS / 32, kb = item / nblk, nb = item % nblk, k0 = 64 * kb, n0 = 32 * nb;
    const int pos = n0 + 4 * (lane & 7);
    const int col = PERMUTE ? win_src_col(pos) : pos;
    f32x4 v[8];
#pragma unroll
    for (int i = 0; i < 8; ++i) { const int kk = 8 * i + (lane >> 3); v[i] = (col >= 0) ? *(const f32x4*)(W + (size_t)(k0 + kk) * N + col) : (f32x4){0.f, 0.f, 0.f, 0.f}; }
#pragma unroll
    for (int i = 0; i < 8; ++i) { const int kk = 8 * i + (lane >> 3); LAS float* q = scr + kk * 33 + 4 * (lane & 7); q[0] = v[i][0]; q[1] = v[i][1]; q[2] = v[i][2]; q[3] = v[i][3]; }
    asm volatile("s_waitcnt lgkmcnt(0)" ::: "memory");
    const int c = lane & 7;
#pragma unroll
    for (int j = 0; j < 4; ++j) { const int n = (lane >> 3) + 8 * j; const LAS float* s = scr + (8 * c) * 33 + n;
        u32x4 o; o.x = pk2(s[0 * 33], s[1 * 33]); o.y = pk2(s[2 * 33], s[3 * 33]); o.z = pk2(s[4 * 33], s[5 * 33]); o.w = pk2(s[6 * 33], s[7 * 33]);
        *(u32x4*)(WT + (size_t)(n0 + n) * K + k0 + 8 * c) = o; }
    asm volatile("s_waitcnt lgkmcnt(0)" ::: "memory");
}
__device__ __forceinline__ void row_to_bf16(const float* src, bf16_t* dst, int lane) {
    const f32x4* s = (const f32x4*)src + lane; u32x2* d = (u32x2*)dst + lane;
    f32x4 v[4];
#pragma unroll
    for (int j = 0; j < 4; ++j) v[j] = s[64 * j];
#pragma unroll
    for (int j = 0; j < 4; ++j) { u32x2 w; w.x = pk2(v[j][0], v[j][1]); w.y = pk2(v[j][2], v[j][3]); d[64 * j] = w; }
}
typedef float f32x2 __attribute__((ext_vector_type(2)));
template <int NB>
__device__ __forceinline__ void rows_to_fp8(const float* src, unsigned char* dst, float* scale_out, int lane) {
    f32x4 v[NB][4];
#pragma unroll
    for (int i = 0; i < NB; ++i) { const f32x4* s = (const f32x4*)(src + (size_t)i * 1024) + 4 * lane;
#pragma unroll
        for (int j = 0; j < 4; ++j) v[i][j] = __builtin_nontemporal_load(s + j); }
#pragma unroll
    for (int i = 0; i < NB; ++i) {
        float am = 0.f;
#pragma unroll
        for (int j = 0; j < 4; ++j) am = fmaxf(am, fmaxf(fmaxf(fabsf(v[i][j][0]), fabsf(v[i][j][1])), fmaxf(fabsf(v[i][j][2]), fabsf(v[i][j][3]))));
#pragma unroll
        for (int o = 1; o < 64; o <<= 1) am = fmaxf(am, __shfl_xor(am, o));
        const float sc = am > 0.f ? am * (1.0f / 440.0f) : 1.0f, inv = 1.0f / sc;
        u32x4 w;
#pragma unroll
        for (int j = 0; j < 4; ++j) { unsigned t = 0u; t = __builtin_amdgcn_cvt_pk_fp8_f32(v[i][j][0] * inv, v[i][j][1] * inv, t, false); t = __builtin_amdgcn_cvt_pk_fp8_f32(v[i][j][2] * inv, v[i][j][3] * inv, t, true); w[j] = t; }
        *((u32x4*)(dst + (size_t)i * 1024) + lane) = w;
        if (lane == 0) scale_out[i] = sc;
    }
}
__device__ __forceinline__ void sincos_tab(double x, float& s, float& c) {
    const double k = rint(x * 0.15915494309189535);
    double r = fma(-k, 6.283185307179586, x); r = fma(-k, 2.4492935982947064e-16, r);
    const double r2 = r * r;
    double ps = 1.0, pc = 1.0;
#pragma unroll
    for (int n = 29; n >= 3; n -= 2) ps = 1.0 - ps * r2 * (1.0 / (double)((n - 1) * n));
#pragma unroll
    for (int n = 28; n >= 2; n -= 2) pc = 1.0 - pc * r2 * (1.0 / (double)((n - 1) * n));
    s = (float)(r * ps); c = (float)pc;
}

__device__ __forceinline__ void phase0(const Args& a, unsigned char* lds, int tid, int wave, int lane, int bid, int G) {
    unsigned char* ws = a.ws;
    volatile LAS unsigned* MISC = (volatile LAS unsigned*)((LAS unsigned char*)lds + MISC_OFF);
    TSTAMP(90, 0);
    for (int it = bid; it < 192; it += G) {
        float* s_c = (float*)lds; float* red = (float*)(lds + 16384);
        for (int i = tid; i < 4096; i += NTHREADS) { const float v = a.in[1][i]; s_c[i] = v / (1.0f + expf(-v)); }
        __syncthreads();
        const int g = tid & 7, ks = tid >> 3, n0 = 32 * it;
        f32x4 acc[4];
#pragma unroll
        for (int b = 0; b < 4; ++b) acc[b] = (f32x4){0.f, 0.f, 0.f, 0.f};
#pragma unroll 4
        for (int i = 0; i < 16; ++i) { const int k = ks + 64 * i; const f32x4 w = *(const f32x4*)(a.in[2] + (size_t)k * 6144 + n0 + 4 * g);
#pragma unroll
            for (int b = 0; b < 4; ++b) acc[b] += w * s_c[b * 1024 + k]; }
#pragma unroll
        for (int b = 0; b < 4; ++b) *(f32x4*)(red + (ks * 8 + g) * 16 + 4 * b) = acc[b];
        __syncthreads();
        if (tid < 128) { const int b = tid >> 5, col = tid & 31, gg = col >> 2, e = col & 3; float s = 0.f;
            for (int k2 = 0; k2 < 64; ++k2) s += red[(k2 * 8 + gg) * 16 + 4 * b + e];
            ((float*)(ws + WS_MOD))[b * 6144 + n0 + col] = s + a.in[3][n0 + col]; }
        __syncthreads();
    }
    TSTAMP(90, 2); TSTAMP(91, 0);
    for (int it = bid; it < 256; it += G) {
        const int hp = it >> 4, k0 = 64 * (it & 15);
        constexpr int WP = 132;
        float* skl = (float*)lds; float* wql = skl + 128 * WP;
        for (int i = tid; i < 4096; i += NTHREADS) { const int n = i >> 5, d4 = i & 31; *(f32x4*)(skl + n * WP + 4 * d4) = *(const f32x4*)(a.in[9] + (size_t)hp * 16384 + n * 128 + 4 * d4); }
        for (int i = tid; i < 2048; i += NTHREADS) { const int k = i >> 5, d4 = i & 31; *(f32x4*)(wql + k * WP + 4 * d4) = *(const f32x4*)(a.in[8] + (size_t)(k0 + k) * 2048 + hp * 128 + 4 * d4); }
        __syncthreads();
        const int kg = tid & 15, ng = tid >> 4;
        float acc[4][4];
#pragma unroll
        for (int i = 0; i < 4; ++i)
#pragma unroll
            for (int j = 0; j < 4; ++j) acc[i][j] = 0.f;
#pragma unroll 2
        for (int d4 = 0; d4 < 32; ++d4) {
            f32x4 wv[4], sv[4];
#pragma unroll
            for (int i = 0; i < 4; ++i) { wv[i] = *(const f32x4*)(wql + (kg + 16 * i) * WP + 4 * d4); sv[i] = *(const f32x4*)(skl + (ng + 32 * i) * WP + 4 * d4); }
#pragma unroll
            for (int i = 0; i < 4; ++i)
#pragma unroll
                for (int j = 0; j < 4; ++j) acc[i][j] += (wv[i][0] * sv[j][0] + wv[i][1] * sv[j][1]) + (wv[i][2] * sv[j][2] + wv[i][3] * sv[j][3]);
        }
        bf16_t* wt = (bf16_t*)(ws + WS_WPQ);
#pragma unroll
        for (int j = 0; j < 4; ++j)
#pragma unroll
            for (int i = 0; i < 4; ++i) wt[(size_t)(hp * 128 + ng + 32 * j) * 1024 + k0 + kg + 16 * i] = (bf16_t)f2bf(acc[i][j]);
        __syncthreads();
    }
    TSTAMP(91, 2); TSTAMP(92, 0);
    const int gw = bid * 8 + wave, NGW = G * 8;
    {
        LAS float* scr = (LAS float*)(lds + wave * 16384);
        constexpr int I_IN = 16 * (N1 / 32), I_OUT = 16 * 32;
        for (int it = gw; it < I_IN + I_OUT; it += NGW) {
            if (it < I_IN) p0_transpose_item<true>(a.in[5], 1024, 4168, N1, (bf16_t*)(ws + WS_WIN), scr, it, lane);
            else p0_transpose_item<false>(a.in[6], 1024, 1024, 1024, (bf16_t*)(ws + WS_WOUT), scr, it - I_IN, lane);
        }
    }
    __syncthreads(); TSTAMP(92, 2); TSTAMP(93, 0);
    for (int it = gw; it < 8192; it += NGW) {
        const int tb = it >> 12, r = 4 * (it & 4095);
        rows_to_fp8<4>(a.in[10 + tb] + (size_t)r * 1024, ws + (tb ? WS_V8 : WS_U8) + (size_t)r * 1024, (float*)(ws + (tb ? WS_VSC : WS_USC)) + r, lane);
    }
    __syncthreads(); TSTAMP(93, 2); TSTAMP(94, 0);
    for (int i = bid * NTHREADS + tid; i < 4096 * 96; i += G * NTHREADS) {
        int pos, f; double r; float* ct; float* st; int idx;
        if (i < 4096 * 32) { pos = i >> 5; f = i & 31; r = 0.74989420933245582730; ct = (float*)(ws + WS_COSA); st = (float*)(ws + WS_SINA); idx = i; }
        else { const int j = i - 4096 * 32; pos = j >> 6; f = j & 63; r = 0.86398844948396852897; ct = (float*)(ws + WS_COSR); st = (float*)(ws + WS_SINR); idx = j; }
        double v = 1.0; for (int t = 0; t < f; ++t) v *= r;
        const float invf = (float)v; const float ang = (float)pos * invf;
        float s, c; sincos_tab((double)ang, s, c);
        ct[idx] = c; st[idx] = s;
    }
    __syncthreads(); TSTAMP(94, 2);
}

__device__ __forceinline__ void phase1(const Args& a, int wave, int lane, int bid, int G) {
    unsigned char* ws = a.ws;
    const float* mod = (const float*)(ws + WS_MOD);
    const int gw = bid * 8 + wave, NGW = G * 8;
    for (int r = gw; r < MTOK; r += NGW) {
        const int b = r >> 12;
        const f32x4* xr = (const f32x4*)(a.in[0] + (size_t)r * DM) + lane;
        f32x4 v[4]; float ss = 0.f;
#pragma unroll
        for (int j = 0; j < 4; ++j) { v[j] = xr[64 * j]; ss += (v[j][0] * v[j][0] + v[j][1] * v[j][1]) + (v[j][2] * v[j][2] + v[j][3] * v[j][3]); }
        const float rstd = 1.0f / sqrtf(wave_sum(ss) * (1.0f / DM) + EPS);
        u32x2* o = (u32x2*)((bf16_t*)(ws + WS_BUFA) + (size_t)r * DM) + lane;
#pragma unroll
        for (int j = 0; j < 4; ++j) { const int c = 256 * j + 4 * lane;
            const f32x4 g = *(const f32x4*)(a.in[4] + c), sc = *(const f32x4*)(mod + b * 6144 + 1024 + c), sh = *(const f32x4*)(mod + b * 6144 + c);
            const f32x4 h = v[j] * rstd * g * (sc + 1.0f) + sh;
            u32x2 w; w.x = pk2(h[0], h[1]); w.y = pk2(h[2], h[3]); o[64 * j] = w; }
    }
    for (int n = gw; n < 2048; n += NGW) {
        const u32x4* wr = (const u32x4*)((const bf16_t*)(ws + WS_WPQ) + (size_t)n * 1024);
        const u32x4 w0 = wr[lane], w1 = wr[64 + lane];
        float wf[16];
#pragma unroll
        for (int i = 0; i < 4; ++i) { wf[2 * i] = bf_lo(w0[i]); wf[2 * i + 1] = bf_hi(w0[i]); wf[8 + 2 * i] = bf_lo(w1[i]); wf[8 + 2 * i + 1] = bf_hi(w1[i]); }
#pragma unroll
        for (int b = 0; b < 4; ++b) { const float* sh = mod + b * 6144 + 3072; float s = 0.f;
#pragma unroll
            for (int i = 0; i < 8; ++i) s += wf[i] * sh[8 * lane + i] + wf[8 + i] * sh[512 + 8 * lane + i];
            s = wave_sum(s);
            if (lane == 0) ((float*)(ws + WS_BIASF))[b * 2048 + n] = s; }
    }
}

constexpr int SCP = 8200;
__device__ __forceinline__ int wave_total(int v) {
    v += __builtin_amdgcn_update_dpp(0, v, 0xB1, 0xF, 0xF, true);
    v += __builtin_amdgcn_update_dpp(0, v, 0x4E, 0xF, 0xF, true);
    v += __builtin_amdgcn_update_dpp(0, v, 0x141, 0xF, 0xF, true);
    v += __builtin_amdgcn_update_dpp(0, v, 0x140, 0xF, 0xF, true);
    return __builtin_amdgcn_readlane(v, 0) + __builtin_amdgcn_readlane(v, 16) + __builtin_amdgcn_readlane(v, 32) + __builtin_amdgcn_readlane(v, 48);
}
template <int NR>
__device__ __forceinline__ void select_row_t(int b, int t, const unsigned char* ldsrow, unsigned long long* MASK, int lane) {
    {
        unsigned* row32 = (unsigned*)ldsrow;
        for (int i = 8 * ((t >> 4) + 1) + lane; i < 32 * NR; i += 64) row32[i] = 0u;
    }
    unsigned key[NR];
#pragma unroll
    for (int j = 0; j < NR; ++j) key[j] = *(const unsigned short*)(ldsrow + 2 * lane + 128 * j);
    unsigned mw_lo = 0u, mw_hi = 0u;
    if (t < 256) {
#pragma unroll
        for (int j = 0; j < 4; ++j) { const unsigned long long w = __ballot(key[j] != 0u);
            asm volatile("s_nop 1\n\tv_writelane_b32 %0, %2, %4\n\tv_writelane_b32 %1, %3, %4\n\ts_nop 0" : "+v"(mw_lo), "+v"(mw_hi) : "s"((unsigned)w), "s"((unsigned)(w >> 32)), "n"(j)); }
    } else {
        unsigned T = 0;
#pragma unroll 1
        for (int bit = 15; bit >= 0; --bit) {
            const unsigned cand = T | (1u << bit);
            int c0 = 0, c1 = 0, c2 = 0, c3 = 0;
#pragma unroll
            for (int j = 0; j < NR; j += 4) { c0 += (key[j] >= cand) ? 1 : 0; c1 += (key[j + 1] >= cand) ? 1 : 0; c2 += (key[j + 2] >= cand) ? 1 : 0; c3 += (key[j + 3] >= cand) ? 1 : 0; }
            if (wave_total((c0 + c1) + (c2 + c3)) >= 256) T = cand;
        }
        int g0 = 0, g1 = 0;
#pragma unroll
        for (int j = 0; j < NR; j += 2) { g0 += (key[j] > T) ? 1 : 0; g1 += (key[j + 1] > T) ? 1 : 0; }
        int e0 = 0, e1 = 0;
#pragma unroll
        for (int j = 0; j < NR; j += 2) { e0 += (key[j] == T) ? 1 : 0; e1 += (key[j + 1] == T) ? 1 : 0; }
        int need = 256 - wave_total(g0 + g1);
        if (wave_total(e0 + e1) == need) {
#pragma unroll
            for (int j = 0; j < NR; ++j) { const unsigned long long w = __ballot(key[j] >= T);
                asm volatile("s_nop 1\n\tv_writelane_b32 %0, %2, %4\n\tv_writelane_b32 %1, %3, %4\n\ts_nop 0" : "+v"(mw_lo), "+v"(mw_hi) : "s"((unsigned)w), "s"((unsigned)(w >> 32)), "n"(j));
                if ((j & 3) == 3) __builtin_amdgcn_sched_barrier(0); }
        } else {
#pragma unroll
        for (int j = 0; j < NR; ++j) {
            const bool gt = key[j] > T, eq = key[j] == T;
            const unsigned long long em = __ballot(eq);
            const int cc = __popcll(em), take = cc < need ? cc : need;
            const int rank = (int)__builtin_amdgcn_mbcnt_hi((unsigned)(em >> 32), __builtin_amdgcn_mbcnt_lo((unsigned)em, 0u));
            const unsigned long long w = __ballot(gt || (eq && rank < take));
            need -= take;
            asm volatile("s_nop 1\n\tv_writelane_b32 %0, %2, %4\n\tv_writelane_b32 %1, %3, %4\n\ts_nop 0" : "+v"(mw_lo), "+v"(mw_hi) : "s"((unsigned)w), "s"((unsigned)(w >> 32)), "n"(j));
            if ((j & 1) == 1) __builtin_amdgcn_sched_barrier(0);
        }
        }
    }
    MASK[((size_t)b * SEQ + t) * 64 + lane] = ((unsigned long long)mw_hi << 32) | mw_lo;
}
__device__ __forceinline__ void select_row(int b, int t, const unsigned char* ldsrow, unsigned long long* MASK, int lane) {
    switch (t >> 10) {
        case 0: select_row_t<16>(b, t, ldsrow, MASK, lane); break;
        case 1: select_row_t<32>(b, t, ldsrow, MASK, lane); break;
        case 2: select_row_t<48>(b, t, ldsrow, MASK, lane); break;
        default: select_row_t<64>(b, t, ldsrow, MASK, lane); break;
    }
}
__device__ __forceinline__ void idx_unit(int b, int qt, const bf16_t* QI, const bf16_t* KI, const float* WI, unsigned long long* MASK, unsigned char* lds, int wave, int lane, bool tprobe) {
    volatile LAS unsigned* MISC = (volatile LAS unsigned*)((LAS unsigned char*)lds + MISC_OFF); const int bid = tprobe ? TPROBE_B : -1; const int tid = (int)threadIdx.x;
    TSTAMP(32, 0);
    const int t0 = 16 * qt, qn = lane & 15, g = lane >> 4;
    const size_t rowq = (size_t)b * SEQ + t0 + qn;
    bf16x8 qf[8][2]; float wi[8];
#pragma unroll
    for (int h = 0; h < 8; ++h)
#pragma unroll
        for (int ks = 0; ks < 2; ++ks) qf[h][ks] = *(const bf16x8*)(QI + rowq * 512 + h * 64 + ks * 32 + 8 * g);
    { const f32x4 w0 = *(const f32x4*)(WI + rowq * 8), w1 = *(const f32x4*)(WI + rowq * 8 + 4);
#pragma unroll
      for (int e = 0; e < 4; ++e) { wi[e] = w0[e]; wi[4 + e] = w1[e]; } }
    const bf16_t* kbase = KI + ((size_t)b * SEQ + qn) * 64 + 8 * g;
    bf16x8 ra0[8], ra1[8];
#pragma unroll
    for (int i = 0; i < 8; ++i) if (wave + 8 * i <= qt) { const bf16_t* kr = kbase + (size_t)(wave + 8 * i) * 1024; ra0[i] = *(const bf16x8*)kr; ra1[i] = *(const bf16x8*)(kr + 32); }
#pragma unroll 1
    for (int base = wave; base <= qt; base += 64) {
#pragma unroll
        for (int i = 0; i < 8; ++i) {
            const int kt = base + 8 * i;
            if (kt <= qt) {
                const bf16x8 a0 = ra0[i], a1 = ra1[i];
                if (kt + 64 <= qt) { const bf16_t* kr = kbase + (size_t)(kt + 64) * 1024; ra0[i] = *(const bf16x8*)kr; ra1[i] = *(const bf16x8*)(kr + 32); }
                const int s0 = 16 * kt;
                f32x4 sc = (f32x4){0.f, 0.f, 0.f, 0.f};
#pragma unroll
                for (int h = 0; h < 8; ++h) {
                    f32x4 d = mfma16(a0, qf[h][0], (f32x4){0.f, 0.f, 0.f, 0.f}); d = mfma16(a1, qf[h][1], d);
#pragma unroll
                    for (int r = 0; r < 4; ++r) { const int di = (int)__float_as_uint(d[r]); sc[r] += wi[h] * __uint_as_float((unsigned)(di > 0 ? di : 0)); }
                }
                unsigned k[4];
#pragma unroll
                for (int r = 0; r < 4; ++r) { const unsigned kk = sortable16(sc[r]); k[r] = (s0 + 4 * g + r <= t0 + qn) ? kk : 0u; }
                u32x2 pk; pk.x = k[0] | (k[1] << 16); pk.y = k[2] | (k[3] << 16);
                *(u32x2*)(lds + qn * SCP + 2 * (s0 + 4 * g)) = pk;
            }
        }
    }
    __syncthreads();
    TSTAMP(32, 2); TSTAMP(33, 0);
#ifndef NO_SEL
#pragma unroll 1
    for (int qq = 2 * wave; qq < 2 * wave + 2; ++qq) select_row(b, t0 + qq, lds + qq * SCP, MASK, lane);
#endif
    __syncthreads();
    TSTAMP(33, 2);
}

__device__ __forceinline__ void ret_state_unit(int b, int h, int vb, int dh, const bf16_t* KR, const bf16_t* VR, bf16_t* STATE, unsigned char* lds, int tid, int wave, int lane) {
    constexpr int PT = 272, KT_BYTES = 64 * PT, BUF = KT_BYTES + 16 * PT;
    const int j = tid & 127, dq = tid >> 7, g = lane >> 4, ln = lane & 15;
    const float g128 = ret_g128(h), g127 = ret_g127(h), gam = ret_gamma(h);
    f32x4 st = (f32x4){0.f, 0.f, 0.f, 0.f};
    u32x4 kA[2], kB[2], vA = (u32x4){0u, 0u, 0u, 0u}, vB = (u32x4){0u, 0u, 0u, 0u};
#define RS_LOAD(K_, V_, n) do { const size_t row = (size_t)b * SEQ + (n) * 128 + j; const u32x4* p = (const u32x4*)(KR + row * 512 + h * 128 + 64 * dh + 16 * dq); \
        K_[0] = p[0]; K_[1] = p[1]; if (tid < 256) V_ = *(const u32x4*)(VR + row * 512 + h * 128 + 16 * vb + 8 * dq); } while (0)
#define RS_WRITE(K_, V_, buf) do { _Pragma("unroll") for (int i = 0; i < 2; ++i) _Pragma("unroll") for (int e = 0; e < 4; ++e) { const unsigned w = K_[i][e]; const int d = 16 * dq + 8 * i + 2 * e; \
            *(unsigned short*)((buf) + d * PT + 2 * j) = (unsigned short)(w & 0xffffu); *(unsigned short*)((buf) + (d + 1) * PT + 2 * j) = (unsigned short)(w >> 16); } \
        if (tid < 256) { _Pragma("unroll") for (int e = 0; e < 4; ++e) { const unsigned w = V_[e]; const int v = 8 * dq + 2 * e; \
            *(unsigned short*)((buf) + KT_BYTES + v * PT + 2 * j) = (unsigned short)(w & 0xffffu); *(unsigned short*)((buf) + KT_BYTES + (v + 1) * PT + 2 * j) = (unsigned short)(w >> 16); } } } while (0)
#define RS_COMP(buf, n) do { if (wave < 4) { \
        bf16_t* sp = STATE + ((((size_t)b * 4 + h) * 32 + (n)) * 128 + 16 * vb + 4 * g) * 128 + 64 * dh + 16 * wave + ln; \
        _Pragma("unroll") for (int r = 0; r < 4; ++r) sp[r * 128] = (bf16_t)f2bf(gam * st[r]); \
        f32x4 c = (f32x4){0.f, 0.f, 0.f, 0.f}; \
        _Pragma("unroll") for (int ks = 0; ks < 4; ++ks) { \
            const bf16x8 af = *(const bf16x8*)((buf) + KT_BYTES + ln * PT + 2 * (32 * ks + 8 * g)); \
            const bf16x8 bf = *(const bf16x8*)((buf) + (16 * wave + ln) * PT + 2 * (32 * ks + 8 * g)); \
            c = mfma16(af, bf, c); } \
        st = st * g128 + c * g127; } } while (0)
    RS_LOAD(kA, vA, 0); RS_LOAD(kB, vB, 1);
#pragma unroll 1
    for (int n = 0; n < 32; n += 2) {
        RS_WRITE(kA, vA, lds);
        if (n + 2 < 32) RS_LOAD(kA, vA, n + 2);
        __syncthreads();
        RS_COMP(lds, n);
        RS_WRITE(kB, vB, lds + BUF);
        if (n + 3 < 32) RS_LOAD(kB, vB, n + 3);
        __syncthreads();
        RS_COMP(lds + BUF, n + 1);
    }
#undef RS_LOAD
#undef RS_WRITE
#undef RS_COMP
    __syncthreads();
}

__device__ __forceinline__ float amax3(float a, float b, float c) { float r; asm("v_max3_f32 %0, %1, %2, %3" : "=v"(r) : "v"(a), "v"(b), "v"(c)); return r; }
__device__ __forceinline__ void attn_unit(int b, int h, int qb, const bf16_t* QA, const bf16_t* KA, const bf16_t* VA, const unsigned long long* MASK, bf16_t* AR,
                                          unsigned char* lds, int tid, int wave, int lane) {
    constexpr int KP = 144, KS_BYTES = 64 * KP, BUF = 2 * KS_BYTES;
    const int q0 = 256 * qb, r32 = lane & 31, hi = lane >> 5;
    const int t = q0 + 32 * wave + r32;
    const size_t qrow = (size_t)b * SEQ + t;
    bf16x8 qf[4];
#pragma unroll
    for (int d0 = 0; d0 < 4; ++d0) qf[d0] = *(const bf16x8*)(QA + qrow * 512 + h * 64 + 16 * d0 + 8 * hi);
    const int NT = (q0 + 256) / 64;
    const int key_l = tid >> 3, c8 = tid & 7;
    f32x16 o0, o1;
#pragma unroll
    for (int r = 0; r < 16; ++r) { o0[r] = 0.f; o1[r] = 0.f; }
    float m_run = NEG_INF, l_run = 0.f;
    u32x4 kreg[4], vreg[4]; unsigned long long mw[4];
#define AT_LOAD(i, kt) do { const size_t kr = (size_t)b * SEQ + 64 * (kt) + key_l; kreg[i] = *(const u32x4*)(KA + kr * 512 + h * 64 + 8 * c8); vreg[i] = *(const u32x4*)(VA + kr * 512 + h * 64 + 8 * c8); \
        mw[i] = MASK[qrow * 64 + (kt)]; } while (0)
#pragma unroll
    for (int i = 0; i < 4; ++i) AT_LOAD(i, i);
#pragma unroll 1
    for (int kt4 = 0; kt4 < NT; kt4 += 4) {
#pragma unroll
      for (int i = 0; i < 4; ++i) {
        const int kt = kt4 + i;
        unsigned char* buf = lds + (i & 1) * BUF;
        *(u32x4*)(buf + key_l * KP + 16 * c8) = kreg[i];
#pragma unroll
        for (int e = 0; e < 4; ++e) { const unsigned w = vreg[i][e]; const int d = 8 * c8 + 2 * e;
            *(unsigned short*)(buf + KS_BYTES + d * KP + 2 * key_l) = (unsigned short)(w & 0xffffu); *(unsigned short*)(buf + KS_BYTES + (d + 1) * KP + 2 * key_l) = (unsigned short)(w >> 16); }
        const unsigned long long mcur = mw[i];
        if (kt + 4 < NT) AT_LOAD(i, kt + 4);
        __syncthreads();
        if (64 * kt <= q0 + 32 * wave + 31) {
            f32x16 p0, p1;
#pragma unroll
            for (int r = 0; r < 16; ++r) { p0[r] = 0.f; p1[r] = 0.f; }
#pragma unroll
            for (int d0 = 0; d0 < 4; ++d0) {
                const bf16x8 a0 = *(const bf16x8*)(buf + r32 * KP + 32 * d0 + 16 * hi);
                const bf16x8 a1 = *(const bf16x8*)(buf + (32 + r32) * KP + 32 * d0 + 16 * hi);
                p0 = mfma32(a0, qf[d0], p0); p1 = mfma32(a1, qf[d0], p1);
            }
            const unsigned wl = (unsigned)mcur >> (4 * hi), wh = (unsigned)(mcur >> 32) >> (4 * hi);
#pragma unroll
            for (int r = 0; r < 16; ++r) { const int bp = (r & 3) + 8 * (r >> 2);
                const unsigned m0 = (unsigned)((int)(wl << (31 - bp)) >> 31), m1 = (unsigned)((int)(wh << (31 - bp)) >> 31);
                p0[r] = __uint_as_float((__float_as_uint(p0[r]) & m0) | (0xff800000u & ~m0)); p1[r] = __uint_as_float((__float_as_uint(p1[r]) & m1) | (0xff800000u & ~m1)); }
            float mx;
            { float a = amax3(p0[0], p0[1], p1[0]), bq = amax3(p0[2], p0[3], p1[1]); a = amax3(a, p1[2], p1[3]);
#pragma unroll
              for (int r = 4; r < 16; r += 4) { a = amax3(a, p0[r], p0[r + 1]); bq = amax3(bq, p0[r + 2], p0[r + 3]); a = amax3(a, p1[r], p1[r + 1]); bq = amax3(bq, p1[r + 2], p1[r + 3]); }
              mx = amax3(a, bq, bq); }
            mx = amax3(mx, __shfl_xor(mx, 32), mx);
            const float m_new = amax3(m_run, mx, mx);
            const float m_use = (m_new == NEG_INF) ? 0.f : m_new;
            const float alpha = fast_exp2(m_run - m_use);
            m_run = m_new;
            float ps = 0.f;
#pragma unroll
            for (int r = 0; r < 16; ++r) { p0[r] = fast_exp2(p0[r] - m_use); p1[r] = fast_exp2(p1[r] - m_use); ps += p0[r] + p1[r]; }
            l_run = l_run * alpha + ps;
            if (__any(alpha != 1.0f)) {
#pragma unroll
                for (int r = 0; r < 16; ++r) { o0[r] *= alpha; o1[r] *= alpha; }
            }
#pragma unroll
            for (int s4 = 0; s4 < 4; ++s4) {
                const int rb = 8 * (s4 & 1);
                u32x4 pw;
                if (s4 < 2) { pw.x = pk2(p0[rb], p0[rb + 1]); pw.y = pk2(p0[rb + 2], p0[rb + 3]); pw.z = pk2(p0[rb + 4], p0[rb + 5]); pw.w = pk2(p0[rb + 6], p0[rb + 7]); }
                else        { pw.x = pk2(p1[rb], p1[rb + 1]); pw.y = pk2(p1[rb + 2], p1[rb + 3]); pw.z = pk2(p1[rb + 4], p1[rb + 5]); pw.w = pk2(p1[rb + 6], p1[rb + 7]); }
                const bf16x8 bfr = __builtin_bit_cast(bf16x8, pw);
                { const unsigned char* vp = buf + KS_BYTES + r32 * KP + 2 * (16 * s4 + 4 * hi);
                  const u32x2 lo = *(const u32x2*)vp, h2 = *(const u32x2*)(vp + 16); const u32x4 av = (u32x4){lo.x, lo.y, h2.x, h2.y};
                  o0 = mfma32(__builtin_bit_cast(bf16x8, av), bfr, o0); }
                { const unsigned char* vp = buf + KS_BYTES + (32 + r32) * KP + 2 * (16 * s4 + 4 * hi);
                  const u32x2 lo = *(const u32x2*)vp, h2 = *(const u32x2*)(vp + 16); const u32x4 av = (u32x4){lo.x, lo.y, h2.x, h2.y};
                  o1 = mfma32(__builtin_bit_cast(bf16x8, av), bfr, o1); }
            }
        }
      }
    }
#undef AT_LOAD
    l_run += __shfl_xor(l_run, 32);
#ifdef DBG_NOATT
    const float inv = 0.f;
#else
    const float inv = 1.0f / l_run;
#endif
    bf16_t* op = AR + qrow * 1024 + h * 64 + 4 * hi;
#pragma unroll
    for (int c = 0; c < 4; ++c) {
        u32x2 w; w.x = pk2(o0[4 * c] * inv, o0[4 * c + 1] * inv); w.y = pk2(o0[4 * c + 2] * inv, o0[4 * c + 3] * inv); *(u32x2*)(op + 8 * c) = w;
        u32x2 v; v.x = pk2(o1[4 * c] * inv, o1[4 * c + 1] * inv); v.y = pk2(o1[4 * c + 2] * inv, o1[4 * c + 3] * inv); *(u32x2*)(op + 32 + 8 * c) = v;
    }
    __syncthreads();
}

__device__ __forceinline__ void ret_out_unit(int b, int h, int n, const bf16_t* QR, const bf16_t* KR, const bf16_t* VR, const bf16_t* GR, const bf16_t* STATE, bf16_t* AR,
                                             unsigned char* lds, int tid, int wave, int lane) {
    constexpr int PT = 272;
    const size_t c0 = (size_t)b * SEQ + 128 * n; const int hc = 128 * h;
    { const int j = tid & 127, vq = tid >> 7; const u32x4* p = (const u32x4*)(VR + (c0 + j) * 512 + hc + 32 * vq);
      u32x4 rr[4]; rr[0] = p[0]; rr[1] = p[1]; rr[2] = p[2]; rr[3] = p[3];
#pragma unroll
      for (int i = 0; i < 4; ++i)
#pragma unroll
          for (int e = 0; e < 4; ++e) { const unsigned w = rr[i][e]; const int v = 32 * vq + 8 * i + 2 * e;
              *(unsigned short*)(lds + v * PT + 2 * j) = (unsigned short)(w & 0xffffu); *(unsigned short*)(lds + (v + 1) * PT + 2 * j) = (unsigned short)(w >> 16); } }
    __syncthreads();
    const int ln = lane & 15, g = lane >> 4;
    const size_t qrow = c0 + 16 * wave + ln;
    bf16x8 qf[4];
#pragma unroll
    for (int ks = 0; ks < 4; ++ks) qf[ks] = *(const bf16x8*)(QR + qrow * 512 + hc + 32 * ks + 8 * g);
    f32x4 sT[8];
#pragma unroll
    for (int jt = 0; jt < 8; ++jt) {
        f32x4 d = (f32x4){0.f, 0.f, 0.f, 0.f};
        if (jt <= wave) {
            const bf16_t* kp = KR + (c0 + 16 * jt + ln) * 512 + hc + 8 * g;
#pragma unroll
            for (int ks = 0; ks < 4; ++ks) d = mfma16(*(const bf16x8*)(kp + 32 * ks), qf[ks], d);
            if (jt == wave) {
#pragma unroll
                for (int r = 0; r < 4; ++r) if (4 * g + r > ln) d[r] = 0.f;
            }
        }
        sT[jt] = d;
    }
    f32x4 oT[8];
    const bf16_t* stp = STATE + (((size_t)b * 4 + h) * 32 + n) * 16384;
#pragma unroll
    for (int vt = 0; vt < 8; ++vt) {
        f32x4 d = (f32x4){0.f, 0.f, 0.f, 0.f};
#pragma unroll
        for (int ks = 0; ks < 4; ++ks) d = mfma16(*(const bf16x8*)(stp + (16 * vt + ln) * 128 + 32 * ks + 8 * g), qf[ks], d);
        oT[vt] = d;
    }
#pragma unroll
    for (int pr = 0; pr < 4; ++pr) if (2 * pr <= wave) {
        u32x4 pw; pw.x = pk2(sT[2 * pr][0], sT[2 * pr][1]); pw.y = pk2(sT[2 * pr][2], sT[2 * pr][3]); pw.z = pk2(sT[2 * pr + 1][0], sT[2 * pr + 1][1]); pw.w = pk2(sT[2 * pr + 1][2], sT[2 * pr + 1][3]);
        const bf16x8 bfr = __builtin_bit_cast(bf16x8, pw);
#pragma unroll
        for (int vt = 0; vt < 8; ++vt) {
            const unsigned char* vp = lds + (16 * vt + ln) * PT + 2 * (32 * pr + 4 * g);
            const u32x2 lo = *(const u32x2*)vp, h2 = *(const u32x2*)(vp + 32); const u32x4 av = (u32x4){lo.x, lo.y, h2.x, h2.y};
            oT[vt] = mfma16(__builtin_bit_cast(bf16x8, av), bfr, oT[vt]);
        }
    }
    float s = 0.f;
#pragma unroll
    for (int vt = 0; vt < 8; ++vt) s += (oT[vt][0] + oT[vt][1]) + (oT[vt][2] + oT[vt][3]);
    s += __shfl_xor(s, 16); s += __shfl_xor(s, 32);
    const float mean = s * (1.0f / 128.0f);
    float q = 0.f;
#pragma unroll
    for (int vt = 0; vt < 8; ++vt)
#pragma unroll
        for (int r = 0; r < 4; ++r) { const float d = oT[vt][r] - mean; q += d * d; }
    q += __shfl_xor(q, 16); q += __shfl_xor(q, 32);
    const float rstd = 1.0f / sqrtf(q * (1.0f / 128.0f) + EPS);
#pragma unroll
    for (int vt = 0; vt < 8; ++vt) {
        const u32x2 gw = *(const u32x2*)(GR + qrow * 512 + hc + 16 * vt + 4 * g);
        const float y0 = (oT[vt][0] - mean) * rstd * bf_lo(gw.x), y1 = (oT[vt][1] - mean) * rstd * bf_hi(gw.x);
        const float y2 = (oT[vt][2] - mean) * rstd * bf_lo(gw.y), y3 = (oT[vt][3] - mean) * rstd * bf_hi(gw.y);
        u32x2 w; w.x = pk2(y0, y1); w.y = pk2(y2, y3);
#ifdef DBG_NORET
        w.x = 0u; w.y = 0u;
#endif
        *(u32x2*)(AR + qrow * 1024 + 512 + hc + 16 * vt + 4 * g) = w;
    }
    __syncthreads();
}

template <int N> __device__ __forceinline__ void bitonic_sort_desc(unsigned (&a)[N]) {
#pragma unroll
    for (int k = 2; k <= N; k <<= 1)
#pragma unroll
        for (int j = k >> 1; j > 0; j >>= 1)
#pragma unroll
            for (int i = 0; i < N; ++i) { const int l = i ^ j;
                if (l > i) { const unsigned x = a[i], y = a[l]; const unsigned mx = x > y ? x : y, mn = x > y ? y : x;
                    if ((i & k) == 0) { a[i] = mx; a[l] = mn; } else { a[i] = mn; a[l] = mx; } } }
}
template <int N> __device__ __forceinline__ void bitonic_merge_desc(unsigned (&a)[N]) {
#pragma unroll
    for (int j = N >> 1; j > 0; j >>= 1)
#pragma unroll
        for (int i = 0; i < N; ++i) { const int l = i ^ j;
            if (l > i) { const unsigned x = a[i], y = a[l]; a[i] = x > y ? x : y; a[l] = x > y ? y : x; } }
}
__device__ __forceinline__ void top16_merge(unsigned (&best)[16], const unsigned (&grp)[16]) {
#pragma unroll
    for (int i = 0; i < 16; ++i) { const unsigned x = best[i], y = grp[15 - i]; best[i] = x > y ? x : y; }
    bitonic_merge_desc<16>(best);
}
struct CandTab { int a[64], b[64], n; constexpr CandTab() : a{}, b{}, n(0) { for (int x = 0; x < 16; ++x) for (int y = 0; y < 16; ++y) if ((x + 1) * (y + 1) <= 16) { a[n] = x; b[n] = y; ++n; } } };
constexpr CandTab kCand{};
static_assert(kCand.n == 50, "staircase candidates");

constexpr int PL_EID = 0, PL_GATE = 16384, PL_IDX = 32768;
__device__ __forceinline__ void peer_unit(int unit, unsigned char* ws, float* outp, const float* gffn, const float* gfin, unsigned char* lds, int tid, int wave, int lane) {
    volatile LAS unsigned* MISC = (volatile LAS unsigned*)((LAS unsigned char*)lds + MISC_OFF); const int bid = unit;
    TSTAMP(70, 0);
    const float* SC = (const float*)(ws + WS_SC);
    const float* mod = (const float*)(ws + WS_MOD);
#ifndef DBG_NOPEER
    {
        const int tl = tid >> 4, h = (tid >> 1) & 7, p = tid & 1;
        const size_t row = (size_t)32 * unit + tl;
        const f32x4* sp = (const f32x4*)(SC + row * 2048 + h * 256 + p * 128);
        unsigned best[16];
#pragma unroll
        for (int grp = 0; grp < 8; ++grp) {
            unsigned k[16];
#pragma unroll
            for (int q4 = 0; q4 < 4; ++q4) { const f32x4 v = sp[4 * grp + q4];
#pragma unroll
                for (int e = 0; e < 4; ++e) k[4 * q4 + e] = (sortable32(v[e]) & ~127u) | (unsigned)(127 - (16 * grp + 4 * q4 + e)); }
            bitonic_sort_desc<16>(k);
            if (grp == 0) {
#pragma unroll
                for (int i = 0; i < 16; ++i) best[i] = k[i];
            } else top16_merge(best, k);
        }
        unsigned char* il = lds + PL_IDX + (tl * 8 + h) * 32;
#pragma unroll
        for (int i = 0; i < 4; ++i) { unsigned w = 0;
#pragma unroll
            for (int e = 0; e < 4; ++e) w |= (127u - (best[4 * i + e] & 127u)) << (8 * e);
            *(unsigned*)(il + p * 16 + 4 * i) = w; }
        float v1[16], v2[16];
#pragma unroll
        for (int i = 0; i < 16; ++i) { const unsigned o = __shfl_xor(best[i], 1); const float mine = unsortable32(best[i] & ~127u), oth = unsortable32(o & ~127u);
            v1[i] = p ? oth : mine; v2[i] = p ? mine : oth; }
        unsigned top[16];
#pragma unroll
        for (int grp = 0; grp < 4; ++grp) {
            unsigned k[16];
#pragma unroll
            for (int i = 0; i < 16; ++i) { const int c = 16 * grp + i;
                k[i] = (c < kCand.n) ? ((sortable32(v1[kCand.a[c < kCand.n ? c : 0]] + v2[kCand.b[c < kCand.n ? c : 0]]) & ~255u) | (unsigned)(255 - (16 * kCand.a[c < kCand.n ? c : 0] + kCand.b[c < kCand.n ? c : 0]))) : 0u; }
            bitonic_sort_desc<16>(k);
            if (grp == 0) {
#pragma unroll
                for (int i = 0; i < 16; ++i) top[i] = k[i];
            } else top16_merge(top, k);
        }
        float ts[16], es[16], sum = 0.f;
#pragma unroll
        for (int i = 0; i < 16; ++i) ts[i] = unsortable32(top[i] & ~255u);
#pragma unroll
        for (int i = 0; i < 16; ++i) { es[i] = __expf(ts[i] - ts[0]); sum += es[i]; }
        const float rs = 1.0f / sum;
        __builtin_amdgcn_wave_barrier(); asm volatile("s_waitcnt lgkmcnt(0)" ::: "memory");
        unsigned* eo = (unsigned*)(lds + PL_EID) + tl * 128 + h * 16;
        float* go = (float*)(lds + PL_GATE) + tl * 128 + h * 16;
#pragma unroll
        for (int i = 0; i < 16; ++i) {
            const unsigned flat = 255u - (top[i] & 255u);
            const unsigned i1 = il[flat >> 4], i2 = il[16 + (flat & 15u)];
            eo[i] = i1 * 128u + i2; go[i] = es[i] * rs;
        }
    }
#endif
    __syncthreads();
    TSTAMP(70, 2); TSTAMP(71, 0);
    const unsigned char* U8 = ws + WS_U8; const unsigned char* V8 = ws + WS_V8;
    const float* USC = (const float*)(ws + WS_USC); const float* VSC = (const float*)(ws + WS_VSC);
    const int me = ((lane >> 5) & 1) * 4 + ((lane >> 4) & 1) * 2 + ((lane >> 3) & 1);
#pragma unroll 1
    for (int ti = 0; ti < 4; ++ti) {
        const int tl = wave + 8 * ti; const size_t row = (size_t)32 * unit + tl; const int b = (int)(row >> 12);
        const float* mb = mod + b * 6144;
        float x1v[16], hv[16], acc[16];
        const float rstd = pg8::row_rstd((const float*)(ws + WS_SUMSQ), (int)row);
#pragma unroll
        for (int q4 = 0; q4 < 4; ++q4) { const int c = 16 * lane + 4 * q4;
            const f32x4 xv = *(const f32x4*)(outp + row * DM + c), g = *(const f32x4*)(gffn + c), sc = *(const f32x4*)(mb + 4096 + c), sh = *(const f32x4*)(mb + 3072 + c);
#pragma unroll
            for (int e = 0; e < 4; ++e) { const int i = 4 * q4 + e; x1v[i] = xv[e]; hv[i] = xv[e] * rstd * g[e] * (1.0f + sc[e]) + sh[e]; acc[i] = 0.f; } }
        const unsigned* el = (const unsigned*)(lds + PL_EID) + tl * 128; const float* gl = (const float*)(lds + PL_GATE) + tl * 128;
        u32x4 uA[8], vA[8]; float guA, gvA;
#define PEER_LOAD(U_, V_, GU_, GV_, e0_) do { _Pragma("unroll") for (int k = 0; k < 8; ++k) { const unsigned eid = el[(e0_) + k]; \
            U_[k] = *((const u32x4*)(U8 + (size_t)eid * 1024) + lane); V_[k] = *((const u32x4*)(V8 + (size_t)eid * 1024) + lane); } \
        { const unsigned em = el[(e0_) + me]; GU_ = USC[em]; GV_ = VSC[em] * gl[(e0_) + me]; } } while (0)
#define PEER_COMP(U_, V_, GU_, GV_) do { float pd[8]; \
        _Pragma("unroll") for (int k = 0; k < 8; ++k) { float d = 0.f; \
            _Pragma("unroll") for (int i = 0; i < 4; ++i) { const f32x2 lo = __builtin_amdgcn_cvt_pk_f32_fp8(U_[k][i], false), hi2 = __builtin_amdgcn_cvt_pk_f32_fp8(U_[k][i], true); \
                d += hv[4 * i] * lo.x; d += hv[4 * i + 1] * lo.y; d += hv[4 * i + 2] * hi2.x; d += hv[4 * i + 3] * hi2.y; } \
            pd[k] = d; } \
        float q4_[4], r2_[2], s_; \
        _Pragma("unroll") for (int k = 0; k < 4; ++k) { const float keep = (lane & 32) ? pd[k + 4] : pd[k], send = (lane & 32) ? pd[k] : pd[k + 4]; q4_[k] = keep + __shfl_xor(send, 32); } \
        _Pragma("unroll") for (int k = 0; k < 2; ++k) { const float keep = (lane & 16) ? q4_[k + 2] : q4_[k], send = (lane & 16) ? q4_[k] : q4_[k + 2]; r2_[k] = keep + __shfl_xor(send, 16); } \
        { const float keep = (lane & 8) ? r2_[1] : r2_[0], send = (lane & 8) ? r2_[0] : r2_[1]; s_ = keep + __shfl_xor(send, 8); } \
        s_ += __shfl_xor(s_, 4); s_ += __shfl_xor(s_, 2); s_ += __shfl_xor(s_, 1); \
        const float cf_ = GV_ * gelu_exact(s_ * GU_); \
        _Pragma("unroll") for (int k = 0; k < 8; ++k) { const float c = __uint_as_float((unsigned)__builtin_amdgcn_readlane((int)__float_as_uint(cf_), 32 * (k >> 2) + 16 * ((k >> 1) & 1) + 8 * (k & 1))); \
            _Pragma("unroll") for (int i = 0; i < 4; ++i) { const f32x2 lo = __builtin_amdgcn_cvt_pk_f32_fp8(V_[k][i], false), hi2 = __builtin_amdgcn_cvt_pk_f32_fp8(V_[k][i], true); \
                acc[4 * i] += c * lo.x; acc[4 * i + 1] += c * lo.y; acc[4 * i + 2] += c * hi2.x; acc[4 * i + 3] += c * hi2.y; } } } while (0)
#pragma unroll 1
        for (int e0 = 0; e0 < 128; e0 += 8) {
            PEER_LOAD(uA, vA, guA, gvA, e0);
            PEER_COMP(uA, vA, guA, gvA);
        }
#undef PEER_LOAD
#undef PEER_COMP
        float ss = 0.f;
#pragma unroll
        for (int q4 = 0; q4 < 4; ++q4) { const int c = 16 * lane + 4 * q4; const f32x4 gf = *(const f32x4*)(mb + 5120 + c);
#pragma unroll
            for (int e = 0; e < 4; ++e) { const int i = 4 * q4 + e; x1v[i] = x1v[i] + gf[e] * acc[i]; ss += x1v[i] * x1v[i]; } }
        const float r2 = 1.0f / sqrtf(wave_sum(ss) * (1.0f / DM) + EPS);
#pragma unroll
        for (int q4 = 0; q4 < 4; ++q4) { const int c = 16 * lane + 4 * q4; const f32x4 gn = *(const f32x4*)(gfin + c);
            f32x4 o;
#pragma unroll
            for (int e = 0; e < 4; ++e) o[e] = x1v[4 * q4 + e] * r2 * gn[e];
            *(f32x4*)(outp + row * DM + c) = o; }
    }
    __syncthreads();
    TSTAMP(71, 2);
}

#define XB_TMO      128
#define XB_XCNT(j)  (256  + 64 * (j))
#define XB_XSUB(j)  (1280 + 64 * (j))
#define XB_XGEN(j)  (2304 + 64 * (j))
#define XB_TOP      3328
#define XB_TOPGEN   3392
#define XCD_BAR_WORDS 3456
#define XB_SPIN_CAP (1u << 18)

__device__ __forceinline__ unsigned xb_ld(unsigned* p)              { return __hip_atomic_load(p, __ATOMIC_RELAXED, __HIP_MEMORY_SCOPE_AGENT); }
__device__ __forceinline__ unsigned xb_add(unsigned* p, unsigned v) { return __hip_atomic_fetch_add(p, v, __ATOMIC_RELAXED, __HIP_MEMORY_SCOPE_AGENT); }
__device__ __forceinline__ unsigned xb_xcc_id() { return (unsigned)__builtin_amdgcn_s_getreg((3 << 11) | 20) & 0xFu; }
#define XB_SPIN(cond, bar) do { unsigned _sp = 0; while (cond) { __builtin_amdgcn_s_sleep(1); \
    if ((++_sp & 255u) == 0u) { if (xb_ld(&(bar)[XB_TMO])) break; if (_sp > XB_SPIN_CAP) { atomicAdd(&(bar)[XB_TMO], 1u); break; } } } } while (0)

struct XcdBarrier {
    unsigned* bar; unsigned x;
    volatile LAS unsigned* st;
};

__device__ __forceinline__ XcdBarrier xcd_barrier_post(unsigned* bar, volatile LAS unsigned* st) {
    XcdBarrier b; b.bar = bar; b.x = xb_xcc_id(); b.st = st;
    if (threadIdx.x == 0) (void)xb_add(&bar[XB_XCNT(b.x)], 1u);
    return b;
}
__device__ __forceinline__ void xcd_barrier_complete(unsigned* bar, unsigned x, unsigned& nloc, unsigned& nx) {
    const unsigned G = gridDim.x * gridDim.y * gridDim.z;
    unsigned sum, cnt, mine, sp = 0u;
    for (;;) {
        sum = 0u; cnt = 0u; mine = 0u;
#pragma unroll
        for (unsigned j = 0; j < 16; ++j) { const unsigned c = xb_ld(&bar[XB_XCNT(j)]); sum += c; cnt += (c > 0u) ? 1u : 0u; mine = (j == x) ? c : mine; }
        if (sum == G) break;
        __builtin_amdgcn_s_sleep(1);
        if ((++sp & 255u) == 0u) { if (xb_ld(&bar[XB_TMO])) break; if (sp > XB_SPIN_CAP) { atomicAdd(&bar[XB_TMO], 1u); break; } }
    }
    nloc = mine > 0u ? mine : 1u; nx = cnt > 0u ? cnt : 1u;
}

__device__ __forceinline__ void xcd_barrier(const XcdBarrier& b) {
    asm volatile("s_waitcnt vmcnt(0)" ::: "memory");
    __syncthreads();
    if (threadIdx.x == 0) {
        unsigned* bar = b.bar;
        __builtin_amdgcn_s_waitcnt(0);
        unsigned nloc = b.st[0], nx = b.st[1];
        if (nloc == 0u) { xcd_barrier_complete(bar, b.x, nloc, nx); b.st[0] = nloc; b.st[1] = nx; }
        const unsigned old = xb_add(&bar[XB_XSUB(b.x)], 1u);
        const unsigned gen = old / nloc;
        if (old + 1u == (gen + 1u) * nloc) {
            __builtin_amdgcn_fence(__ATOMIC_RELEASE, "agent");
            asm volatile("s_waitcnt vmcnt(0)" ::: "memory");
            const unsigned og = xb_add(&bar[XB_TOP], 1u);
            const unsigned tg = og / nx;
            if (og + 1u == (tg + 1u) * nx) xb_add(&bar[XB_TOPGEN], 1u);
            else XB_SPIN(xb_ld(&bar[XB_TOPGEN]) == tg, bar);
            __builtin_amdgcn_fence(__ATOMIC_ACQUIRE, "agent");
            xb_add(&bar[XB_XGEN(b.x)], 1u);
            asm volatile("s_waitcnt vmcnt(0)" ::: "memory");
        } else {
            XB_SPIN(xb_ld(&bar[XB_XGEN(b.x)]) == gen, bar);
            __builtin_amdgcn_fence(__ATOMIC_ACQUIRE, "agent");
            asm volatile("s_waitcnt vmcnt(0)" ::: "memory");
        }
    }
    __syncthreads();
}

constexpr int N_PHASES = 8;
__global__ void __launch_bounds__(NTHREADS, 2) mega(Args a) {
    extern __shared__ __attribute__((aligned(16))) unsigned char lds[];
    const int tid = threadIdx.x, lane = tid & 63, wave = __builtin_amdgcn_readfirstlane(tid >> 6);
    const int bid = blockIdx.x, G = gridDim.x;
    unsigned char* ws = a.ws;
    const int lo = a.ph_lo, hi = a.ph_hi;
    volatile LAS unsigned* MISC = (volatile LAS unsigned*)((LAS unsigned char*)lds + MISC_OFF);
    if (tid < 16) MISC[tid] = 0u;
    __syncthreads();
    XcdBarrier bar; bar.bar = (unsigned*)(ws + WS_CTL) + CW_BAR; bar.x = 0; bar.st = nullptr;
    if (hi - lo > 1) bar = xcd_barrier_post((unsigned*)(ws + WS_CTL) + CW_BAR, MISC + 8);
#ifndef PH_MASK
#define PH_MASK 0xFF
#endif
#define IN(k) (((PH_MASK >> (k)) & 1) && lo <= (k) && (k) < hi)
#define SEAM(k) do { if (IN(k) && IN((k) + 1)) { xcd_barrier(bar); } } while (0)
#ifdef REP_PH
#ifndef REP_N
#define REP_N 1
#endif
#define REPS(k) for (int rep_ = 0; rep_ < ((k) == REP_PH ? 1 + REP_N : 1); ++rep_, ((k) == REP_PH && rep_ <= REP_N ? (xcd_barrier(bar), 0) : 0))
#else
#define REPS(k)
#endif

    TSTAMP(0, 0);
    REPS(0) if (IN(0)) phase0(a, lds, tid, wave, lane, bid, G);
    SEAM(0);
    TSTAMP(0, 2);
    TSTAMP(1, 0);
    REPS(1) if (IN(1)) phase1(a, wave, lane, bid, G);
    SEAM(1);
    TSTAMP(1, 2);
    TSTAMP(2, 0);
    REPS(2) if (IN(2)) {
        pg8::Gemm g{(const bf16_t*)(ws + WS_BUFA), (const bf16_t*)(ws + WS_WIN), MTOK, N1, DM}; pg8::StaticOrder S; S.init(MTOK, N1, G, bid);
        pg8::Epi1 E{ws};
        pg8::gemm_phase<pg8::Epi1, pg8::StaticOrder, true, true>((LAS unsigned char*)lds, g, S, E);
    }
    SEAM(2);
    TSTAMP(2, 2);
    TSTAMP(3, 0);
    REPS(3) if (IN(3)) {
        TSTAMP(30, 0);
        for (int u = bid; u < 256; u += G)
            ret_state_unit(u >> 6, (u >> 4) & 3, (u >> 1) & 7, u & 1, (const bf16_t*)(ws + WS_KR), (const bf16_t*)(ws + WS_VR), (bf16_t*)(ws + WS_STATE), lds, tid, wave, lane);
        TSTAMP(30, 2); TSTAMP(31, 0);
        for (int k = bid; k < 256; k += G)
#pragma unroll 1
            for (int i = 0; i < 4; ++i) {
                const int b = i, qt = (i < 2) ? k : 255 - k;
                idx_unit(b, qt, (const bf16_t*)(ws + WS_QI), (const bf16_t*)(ws + WS_KI), (const float*)(ws + WS_WI), (unsigned long long*)(ws + WS_MASK), lds, wave, lane, bid == TPROBE_B && i == TPROBE_I);
            }
        TSTAMP(31, 2);
    }
    SEAM(3);
    TSTAMP(3, 2);
    TSTAMP(4, 0);
    REPS(4) if (IN(4)) {
        TSTAMP(40, 0);
        for (int k = bid; k < 256; k += G) {
            const int bh = k >> 3, s = k & 7;
#pragma unroll 1
            for (int i = 0; i < 2; ++i)
                attn_unit(bh >> 3, bh & 7, i ? 15 - s : s, (const bf16_t*)(ws + WS_QA), (const bf16_t*)(ws + WS_KA), (const bf16_t*)(ws + WS_VA), (const unsigned long long*)(ws + WS_MASK),
                          (bf16_t*)(ws + WS_BUFB), lds, tid, wave, lane);
        }
        TSTAMP(40, 2); TSTAMP(41, 0);
        for (int u = bid; u < 512; u += G)
            ret_out_unit(u >> 7, (u >> 5) & 3, u & 31, (const bf16_t*)(ws + WS_QR), (const bf16_t*)(ws + WS_KR), (const bf16_t*)(ws + WS_VR), (const bf16_t*)(ws + WS_GR),
                         (const bf16_t*)(ws + WS_STATE), (bf16_t*)(ws + WS_BUFB), lds, tid, wave, lane);
        TSTAMP(41, 2);
    }
    SEAM(4);
    TSTAMP(4, 2);
    TSTAMP(5, 0);
    REPS(5) if (IN(5)) {
        pg8::Gemm g{(const bf16_t*)(ws + WS_BUFB), (const bf16_t*)(ws + WS_WOUT), MTOK, DM, DM}; pg8::StaticOrder S; S.init(MTOK, DM, G, bid);
        pg8::Epi2 E{a.in[0], a.out, (bf16_t*)(ws + WS_BUFA), (const float*)(ws + WS_MOD), a.in[7], (float*)(ws + WS_SUMSQ)};
        pg8::gemm_phase<pg8::Epi2, pg8::StaticOrder, true, true>((LAS unsigned char*)lds, g, S, E);
    }
    SEAM(5);
    TSTAMP(5, 2);
    TSTAMP(6, 0);
    REPS(6) if (IN(6)) {
        pg8::Gemm g{(const bf16_t*)(ws + WS_BUFA), (const bf16_t*)(ws + WS_WPQ), MTOK, 2048, DM}; pg8::StaticOrder S; S.init(MTOK, 2048, G, bid);
        pg8::Epi3 E{(const float*)(ws + WS_SUMSQ), (const float*)(ws + WS_BIASF), (float*)(ws + WS_SC)};
        pg8::gemm_phase<pg8::Epi3, pg8::StaticOrder, true, true>((LAS unsigned char*)lds, g, S, E);
    }
    SEAM(6);
    TSTAMP(6, 2);
    TSTAMP(7, 0);
    if (IN(7)) {
        for (int u = bid; u < 512; u += G) peer_unit(u, ws, a.out, a.in[7], a.in[12], lds, tid, wave, lane);
    }
    TSTAMP(7, 2);
#ifdef TIME_PH
    if (bid == TPROBE_B && tid == 0) {
        const unsigned long long t0_ = ((unsigned long long)MISC[1] << 32) | MISC[0], t1_ = ((unsigned long long)MISC[3] << 32) | MISC[2];
        const unsigned long long until_ = __builtin_amdgcn_s_memrealtime() + (unsigned long long)TIME_AMP * (t1_ - t0_);
        while (__builtin_amdgcn_s_memrealtime() < until_) __builtin_amdgcn_s_sleep(8);
    }
#endif
#undef IN
#undef SEAM
}

extern "C" void kernel_launch(void* const* d_in, const int* in_sizes, int n_in, void* d_out, int out_size, void* d_ws, size_t ws_size, hipStream_t stream) {
    static int grid = 0;
    if (grid == 0) {
        if (n_in != 13 || out_size != MTOK * DM || ws_size < WS_END) { fprintf(stderr, "kernel_launch: unexpected shapes (n_in %d, out %d, ws %zu); nothing launched\n", n_in, out_size, ws_size); grid = -1; return; }
        int dev = 0, cus = 0, per_cu = 0;
        if (hipGetDevice(&dev) != hipSuccess || hipDeviceGetAttribute(&cus, hipDeviceAttributeMultiprocessorCount, dev) != hipSuccess) { grid = -1; return; }
        if (hipFuncSetAttribute((const void*)mega, hipFuncAttributeMaxDynamicSharedMemorySize, LDS_BYTES) != hipSuccess) { fprintf(stderr, "kernel_launch: hipFuncSetAttribute failed\n"); grid = -1; return; }
        if (hipOccupancyMaxActiveBlocksPerMultiprocessor(&per_cu, (const void*)mega, NTHREADS, LDS_BYTES) != hipSuccess || per_cu < 1) { fprintf(stderr, "kernel_launch: occupancy query gave %d\n", per_cu); per_cu = 1; }
        (void)hipGetLastError();
        grid = cus;
    }
    if (grid < 0) return;
    if (hipMemsetAsync((char*)d_ws + WS_CTL, 0, CTL_BYTES, stream) != hipSuccess) { fprintf(stderr, "kernel_launch: memset failed\n"); return; }
    Args a{};
    for (int i = 0; i < 13; ++i) a.in[i] = (const float*)d_in[i];
    a.out = (float*)d_out; a.ws = (unsigned char*)d_ws;
#if MK_MULTI
    for (int p = 0; p < N_PHASES; ++p) { a.ph_lo = p; a.ph_hi = p + 1; hipLaunchKernelGGL(mega, dim3(grid), dim3(NTHREADS), LDS_BYTES, stream, a); }
#else
    a.ph_lo = 0; a.ph_hi = N_PHASES;
    hipLaunchKernelGGL(mega, dim3(grid), dim3(NTHREADS), LDS_BYTES, stream, a);
#endif
}
```

```cpp
#include <hip/hip_runtime.h>
#include <cstdio>
#include <cstdint>

#ifndef MK_MULTI
#define MK_MULTI 0
#endif

#define GAS __attribute__((address_space(1)))
#define LAS __attribute__((address_space(3)))
typedef unsigned short bf16_t;
typedef short bf16x8 __attribute__((ext_vector_type(8)));
typedef float f32x4 __attribute__((ext_vector_type(4)));
typedef float f32x16 __attribute__((ext_vector_type(16)));
typedef unsigned u32x4 __attribute__((ext_vector_type(4)));
typedef unsigned u32x2 __attribute__((ext_vector_type(2)));

constexpr int BATCH = 4, SEQ = 4096, DM = 1024, MTOK = BATCH * SEQ;
constexpr int N1 = 4352;
constexpr int NTHREADS = 512;
constexpr float EPS = 1e-6f;
constexpr float C_QK = 0.18033688011112042f;
constexpr float NEG_INF = -__builtin_huge_valf();

__device__ __forceinline__ float ret_log2g(int h) { return h == 0 ? -0.045803689613124791f : h == 1 ? -0.022720076500083530f : h == 2 ? -0.011315313227834147f : -0.0056465631411420624f; }
__device__ __forceinline__ float ret_gamma(int h) { return h == 0 ? 0.96875f : h == 1 ? 0.984375f : h == 2 ? 0.9921875f : 0.99609375f; }
__device__ __forceinline__ float ret_g128(int h) { return h == 0 ? 0.017183023570817902f : h == 1 ? 0.13321516287964842f : h == 2 ? 0.36643771592203725f : 0.60593708822908032f; }
__device__ __forceinline__ float ret_g127(int h) { return h == 0 ? 0.017737314653747512f : h == 1 ? 0.13532968927456347f : h == 2 ? 0.36932305226788007f : 0.60831331210448848f; }

constexpr size_t MiB = 1u << 20;
constexpr size_t WS_CTL = 0, CTL_BYTES = 1 * MiB;
constexpr size_t WS_SUMSQ = 5 * MiB;
constexpr size_t WS_MOD = 1 * MiB;
constexpr size_t WS_BIASF = 1 * MiB + 128 * 1024;
constexpr size_t WS_COSA = 2 * MiB, WS_SINA = 2 * MiB + 512 * 1024;
constexpr size_t WS_COSR = 3 * MiB, WS_SINR = 4 * MiB;
constexpr size_t WS_WIN = 6 * MiB;
constexpr size_t WS_WOUT = 15 * MiB;
constexpr size_t WS_WPQ = 17 * MiB;
constexpr size_t WS_BUFA = 22 * MiB;
constexpr size_t WS_MASK = WS_BUFA, WS_STATE = WS_BUFA + 8 * MiB;
constexpr size_t WS_BUFB = 54 * MiB;
constexpr size_t WS_G1 = 86 * MiB;
constexpr size_t WS_QA = WS_G1, WS_KA = WS_G1 + 16 * MiB, WS_VA = WS_G1 + 32 * MiB, WS_QI = WS_G1 + 48 * MiB, WS_QR = WS_G1 + 64 * MiB,
                 WS_KR = WS_G1 + 80 * MiB, WS_VR = WS_G1 + 96 * MiB, WS_GR = WS_G1 + 112 * MiB, WS_KI = WS_G1 + 128 * MiB, WS_WI = WS_G1 + 130 * MiB;
constexpr size_t WS_SC = WS_G1;
constexpr size_t WS_U8 = 217 * MiB, WS_V8 = 233 * MiB;
constexpr size_t WS_USC = 249 * MiB, WS_VSC = 249 * MiB + 65536;
constexpr size_t WS_END = 256 * MiB;
static_assert(WS_WI + (size_t)MTOK * 8 * 4 <= WS_U8 && WS_SC + (size_t)MTOK * 2048 * 4 <= WS_U8 && WS_VSC + 65536 <= WS_END, "ws map");
constexpr int LDS_BYTES = 147456;
constexpr int MISC_OFF = LDS_BYTES - 64;
constexpr int CW_BAR = 4096;

__device__ __forceinline__ unsigned f2bf(float f) { unsigned u = __float_as_uint(f); return (u + 0x7fffu + ((u >> 16) & 1u)) >> 16; }
typedef float f32x2_t __attribute__((ext_vector_type(2))); typedef __bf16 bf16x2_t __attribute__((ext_vector_type(2)));
__device__ __forceinline__ unsigned pk2(float lo, float hi) { const f32x2_t v = {lo, hi}; const bf16x2_t b = __builtin_convertvector(v, bf16x2_t); return __builtin_bit_cast(unsigned, b); }
__device__ __forceinline__ float bf_lo(unsigned w) { return __uint_as_float(w << 16); }
__device__ __forceinline__ float bf_hi(unsigned w) { return __uint_as_float(w & 0xffff0000u); }
__device__ __forceinline__ float wave_sum(float v) {
#pragma unroll
    for (int o = 1; o < 64; o <<= 1) v += __shfl_xor(v, o);
    return v;
}
__device__ __forceinline__ float fast_exp2(float x) { return __builtin_amdgcn_exp2f(x); }
__device__ __forceinline__ float gelu_exact(float v) {
    const float av = fabsf(v), t = __builtin_amdgcn_rcpf(av * 0.2316418882f + 1.0f);
    float q = t * 0.5307027145f + (-0.7265760135f); q = q * t + 0.7107068705f; q = q * t + (-0.142248368f); q = q * t + 0.127414796f; q = q * t;
    const float e = fast_exp2(v * v * (-0.72134752044f));
    const float m = v * (q * e);
    return v < 0.f ? m : v - m;
}
__device__ __forceinline__ float silu_f(float v) { return v / (1.0f + __expf(-v)); }
__device__ __forceinline__ unsigned sortable32(float f) { const unsigned u = __float_as_uint(f); return (u & 0x80000000u) ? ~u : (u | 0x80000000u); }
__device__ __forceinline__ float unsortable32(unsigned s) { return __uint_as_float((s & 0x80000000u) ? (s ^ 0x80000000u) : ~s); }
__device__ __forceinline__ unsigned sortable16(float x) {
    const _Float16 h = (_Float16)x; const unsigned b = (unsigned)__builtin_bit_cast(unsigned short, h);
    return (b & 0x8000u) ? (~b & 0xFFFFu) : (b | 0x8000u);
}
__device__ __forceinline__ f32x4 mfma16(bf16x8 a, bf16x8 b, f32x4 c) { return __builtin_amdgcn_mfma_f32_16x16x32_bf16(a, b, c, 0, 0, 0); }
__device__ __forceinline__ f32x16 mfma32(bf16x8 a, bf16x8 b, f32x16 c) { return __builtin_amdgcn_mfma_f32_32x32x16_bf16(a, b, c, 0, 0, 0); }

__host__ __device__ __forceinline__ int win_src_col(int p) {
    const int tile = p >> 8, bj = (p >> 7) & 1, q = p & 127;
    if (tile < 4) return 256 * tile + (q >> 5) * 64 + bj * 32 + (q & 31);
    if (tile < 6) return p;
    if (tile < 8) return 256 * tile + (q >> 5) * 64 + bj * 32 + (q & 31);
    if (tile == 8) { if (q < 32) return 2048 + bj * 32 + q; if (bj == 0 && q < 40) return 2112 + (q - 32); return -1; }
    if (tile < 13) { const int base = (tile < 11) ? 2120 + 256 * (tile - 9) : 2632 + 256 * (tile - 11); return base + (q >> 6) * 128 + bj * 64 + (q & 63); }
    if (tile < 15) return 3144 + (p - 13 * 256);
    return 3656 + (p - 15 * 256);
}
namespace pg8 {
#define PG8_LAS __attribute__((address_space(3)))
typedef unsigned short bf16_t;
typedef short bf16x8 __attribute__((ext_vector_type(8)));
typedef float f32x4 __attribute__((ext_vector_type(4)));
typedef unsigned u32x4 __attribute__((ext_vector_type(4)));
constexpr int BM = 256, BK = 64, HALF = 128, HTB = HALF * BK * 2  , STAGE_BYTES = 8 * HTB, NXCD = 8, WGM = 8;

__host__ __device__ __forceinline__ int lds_byte(int r, int c) { const int st = (r >> 4) * 2 + (c >> 5), rr = r & 15, cc = c & 31, ob = rr * 64 + cc * 2; return st * 1024 + (ob ^ (((ob >> 9) & 1) << 5)); }
__host__ __device__ __forceinline__ void stage_rc(int b, int& R, int& C) { const int st = b / 1024, sb = b % 1024, swz = sb ^ (((sb >> 9) & 1) << 5); R = (st >> 1) * 16 + swz / 64; C = (st & 1) * 32 + (swz % 64) / 2; }
__host__ __device__ __forceinline__ int perm32(int rho) { const int n = rho >> 4, i = rho & 15; return 8 * (i >> 2) + 4 * n + (i & 3); }

struct Unit { int pm, pn; };
struct Gemm { const bf16_t* A; const bf16_t* Bt; int M, N, K; };

struct StaticOrder {
    int nM, nN, nwg, G, c;
    __host__ __device__ void init(int M, int N, int G_, int c_) { nM = M / BM; nN = N / BM; nwg = nM * nN; G = G_; c = c_; }
    __host__ __device__ bool next(int i, Unit& u) const {
        const long L = (long)i * G + c; if (L >= nwg) return false;
        int wgid = (int)L; { const int q = nwg / NXCD, r = nwg % NXCD, xcd = wgid % NXCD, off = wgid / NXCD; wgid = (xcd < r ? xcd * (q + 1) : r * (q + 1) + (xcd - r) * q) + off; }
        const int nig = WGM * nN, gid = wgid / nig, fm = gid * WGM, gsz = (nM - fm) < WGM ? (nM - fm) : WGM;
        u.pm = fm + ((wgid % nig) % gsz); u.pn = (wgid % nig) / gsz; return true;
    }
    __device__ __forceinline__ void a_ready(const Unit&) const {}
    __device__ __forceinline__ void done(const Unit&) const {}
};

__device__ __forceinline__ unsigned cvt_pk_bf16(float lo, float hi) { unsigned r; asm volatile("v_cvt_pk_bf16_f32 %0, %1, %2" : "=v"(r) : "v"(lo), "v"(hi)); return r; }
__device__ __forceinline__ u32x4 pack8(const float (&v)[8]) { u32x4 w; w.x = cvt_pk_bf16(v[0], v[1]); w.y = cvt_pk_bf16(v[2], v[3]); w.z = cvt_pk_bf16(v[4], v[5]); w.w = cvt_pk_bf16(v[6], v[7]); return w; }

struct Epi1 {
    static constexpr bool PERM = true, AFTER_DRAIN = false;
    unsigned char* ws;
    __device__ __forceinline__ void operator()(const f32x4 (&acc)[2][2][4][2], const Unit& u, int wr, int wc, int fr, int fq) const {
        const int tile = u.pn;
        const int row0 = u.pm * BM + wr * 64 + fr;
        const float* cosA = (const float*)(ws + WS_COSA); const float* sinA = (const float*)(ws + WS_SINA);
        const float* cosR = (const float*)(ws + WS_COSR); const float* sinR = (const float*)(ws + WS_SINR);
        if (tile < 4 || tile == 6 || tile == 7) {
            bf16_t* dst = (bf16_t*)(ws + (tile < 2 ? WS_QA : tile < 4 ? WS_KA : WS_QI));
            const int tl = tile < 2 ? tile : tile < 4 ? tile - 2 : tile - 6;
            const float scale = tile < 2 ? C_QK : 1.0f;
            const int cb = 256 * tl + 64 * wc, i0 = 8 * fq;
#pragma unroll
            for (int ai = 0; ai < 2; ++ai)
#pragma unroll
                for (int m = 0; m < 4; ++m) {
                    const int row = row0 + ai * HALF + m * 16, pos = row & (SEQ - 1);
                    const f32x4 c0 = *(const f32x4*)(cosA + pos * 32 + i0), c1 = *(const f32x4*)(cosA + pos * 32 + i0 + 4);
                    const f32x4 s0 = *(const f32x4*)(sinA + pos * 32 + i0), s1 = *(const f32x4*)(sinA + pos * 32 + i0 + 4);
                    float y1[8], y2[8];
#pragma unroll
                    for (int n = 0; n < 2; ++n)
#pragma unroll
                        for (int e = 0; e < 4; ++e) {
                            const float x1 = acc[ai][0][m][n][e], x2 = acc[ai][1][m][n][e];
                            const float c = n ? c1[e] : c0[e], s = n ? s1[e] : s0[e];
                            y1[4 * n + e] = (x1 * c - x2 * s) * scale; y2[4 * n + e] = (x1 * s + x2 * c) * scale;
                        }
                    bf16_t* rp = dst + (size_t)row * 512 + cb + i0;
                    *(u32x4*)rp = pack8(y1); *(u32x4*)(rp + 32) = pack8(y2);
                }
        } else if (tile == 4 || tile == 5 || tile >= 13) {
            bf16_t* dst = (bf16_t*)(ws + (tile < 6 ? WS_VA : tile < 15 ? WS_VR : WS_GR));
            const int tl = tile < 6 ? tile - 4 : tile < 15 ? tile - 13 : tile - 15;
            const bool act = tile >= 15;
#pragma unroll
            for (int ai = 0; ai < 2; ++ai)
#pragma unroll
                for (int m = 0; m < 4; ++m) {
                    const int row = row0 + ai * HALF + m * 16;
#pragma unroll
                    for (int bj = 0; bj < 2; ++bj) {
                        float y[8];
#pragma unroll
                        for (int n = 0; n < 2; ++n)
#pragma unroll
                            for (int e = 0; e < 4; ++e) { const float v = acc[ai][bj][m][n][e]; y[4 * n + e] = act ? silu_f(v) : v; }
                        *(u32x4*)(dst + (size_t)row * 512 + 256 * tl + 128 * bj + 32 * wc + 8 * fq) = pack8(y);
                    }
                }
        } else if (tile == 8) {
#pragma unroll
            for (int ai = 0; ai < 2; ++ai)
#pragma unroll
                for (int m = 0; m < 4; ++m) {
                    const int row = row0 + ai * HALF + m * 16, pos = row & (SEQ - 1);
                    if (wc == 0) {
                        const int i0 = 8 * fq;
                        const f32x4 c0 = *(const f32x4*)(cosA + pos * 32 + i0), c1 = *(const f32x4*)(cosA + pos * 32 + i0 + 4);
                        const f32x4 s0 = *(const f32x4*)(sinA + pos * 32 + i0), s1 = *(const f32x4*)(sinA + pos * 32 + i0 + 4);
                        float y1[8], y2[8];
#pragma unroll
                        for (int n = 0; n < 2; ++n)
#pragma unroll
                            for (int e = 0; e < 4; ++e) {
                                const float x1 = acc[ai][0][m][n][e], x2 = acc[ai][1][m][n][e];
                                const float c = n ? c1[e] : c0[e], s = n ? s1[e] : s0[e];
                                y1[4 * n + e] = x1 * c - x2 * s; y2[4 * n + e] = x1 * s + x2 * c;
                            }
                        bf16_t* rp = (bf16_t*)(ws + WS_KI) + (size_t)row * 64 + i0;
                        *(u32x4*)rp = pack8(y1); *(u32x4*)(rp + 32) = pack8(y2);
                    } else if (wc == 1 && fq == 0) {
                        const float sw = 0.35355339059327379f;
                        float* WI = (float*)(ws + WS_WI);
                        *(f32x4*)(WI + (size_t)row * 8) = acc[ai][0][m][0] * sw;
                        *(f32x4*)(WI + (size_t)row * 8 + 4) = acc[ai][0][m][1] * sw;
                    }
                }
        } else {
            const bool isk = tile >= 11;
            bf16_t* dst = (bf16_t*)(ws + (isk ? WS_KR : WS_QR));
            const int tl = isk ? tile - 11 : tile - 9, hl = wc >> 1, h = 2 * tl + hl;
            const int i0 = 32 * (wc & 1) + 8 * fq, cb = 256 * tl + 128 * hl;
            const float lg = isk ? -ret_log2g(h) : ret_log2g(h);
            const float base = isk ? 0.08838834764831845f : 1.0f;
#pragma unroll
            for (int ai = 0; ai < 2; ++ai)
#pragma unroll
                for (int m = 0; m < 4; ++m) {
                    const int row = row0 + ai * HALF + m * 16, pos = row & (SEQ - 1);
                    const float dec = base * fast_exp2(lg * (float)(pos & 127));
                    const f32x4 c0 = *(const f32x4*)(cosR + pos * 64 + i0), c1 = *(const f32x4*)(cosR + pos * 64 + i0 + 4);
                    const f32x4 s0 = *(const f32x4*)(sinR + pos * 64 + i0), s1 = *(const f32x4*)(sinR + pos * 64 + i0 + 4);
                    float y1[8], y2[8];
#pragma unroll
                    for (int n = 0; n < 2; ++n)
#pragma unroll
                        for (int e = 0; e < 4; ++e) {
                            const float x1 = acc[ai][0][m][n][e], x2 = acc[ai][1][m][n][e];
                            const float c = n ? c1[e] : c0[e], s = n ? s1[e] : s0[e];
                            y1[4 * n + e] = (x1 * c - x2 * s) * dec; y2[4 * n + e] = (x1 * s + x2 * c) * dec;
                        }
                    bf16_t* rp = dst + (size_t)row * 512 + cb + i0;
                    *(u32x4*)rp = pack8(y1); *(u32x4*)(rp + 64) = pack8(y2);
                }
        }
    }
};

__device__ __forceinline__ float row_rstd(const float* sumsq, int row) {
    const f32x4* p = (const f32x4*)(sumsq + (size_t)row * 16);
    const f32x4 a = p[0], b = p[1], c = p[2], d = p[3];
    const float s = (((a[0] + a[1]) + (a[2] + a[3])) + ((b[0] + b[1]) + (b[2] + b[3]))) + (((c[0] + c[1]) + (c[2] + c[3])) + ((d[0] + d[1]) + (d[2] + d[3])));
    return 1.0f / sqrtf(s * (1.0f / DM) + EPS);
}
struct Epi2 {
    static constexpr bool PERM = false, AFTER_DRAIN = false;
    const float* x; float* x1; bf16_t* a3; const float* mod; const float* gffn; float* sumsq;
    __device__ __forceinline__ void operator()(const f32x4 (&acc)[2][2][4][2], const Unit& u, int wr, int wc, int fr, int fq) const {
        const int row0 = u.pm * BM + wr * 64 + fr, col0 = u.pn * BM + wc * 32 + 4 * fq;
#pragma unroll
        for (int ai = 0; ai < 2; ++ai)
#pragma unroll
            for (int m = 0; m < 4; ++m) {
                const int row = row0 + ai * HALF + m * 16, b = row >> 12;
                const float* mb = mod + b * 6144;
                float ss = 0.f;
#pragma unroll
                for (int bj = 0; bj < 2; ++bj)
#pragma unroll
                    for (int n = 0; n < 2; ++n) {
                        const int c = col0 + bj * HALF + n * 16;
                        const f32x4 xv = *(const f32x4*)(x + (size_t)row * DM + c), gt = *(const f32x4*)(mb + 2048 + c);
#ifdef DBG_NOMIX
                        const f32x4 v = xv;
#else
                        const f32x4 v = xv + gt * acc[ai][bj][m][n];
#endif
                        *(f32x4*)(x1 + (size_t)row * DM + c) = v;
                        ss += (v[0] * v[0] + v[1] * v[1]) + (v[2] * v[2] + v[3] * v[3]);
                        const f32x4 gs = *(const f32x4*)(gffn + c) * (*(const f32x4*)(mb + 4096 + c) + 1.0f);
                        const f32x4 a = v * gs;
                        u32x2 w; w.x = cvt_pk_bf16(a[0], a[1]); w.y = cvt_pk_bf16(a[2], a[3]);
                        *(u32x2*)(a3 + (size_t)row * DM + c) = w;
                    }
                ss += __shfl_xor(ss, 16); ss += __shfl_xor(ss, 32);
                if (fq == 0) sumsq[(size_t)row * 16 + u.pn * 4 + wc] = ss;
            }
    }
};

struct Epi3 {
    static constexpr bool PERM = false, AFTER_DRAIN = false;
    const float* sumsq; const float* biasf; float* sc;
    __device__ __forceinline__ void operator()(const f32x4 (&acc)[2][2][4][2], const Unit& u, int wr, int wc, int fr, int fq) const {
        const int row0 = u.pm * BM + wr * 64 + fr, col0 = u.pn * BM + wc * 32 + 4 * fq;
#pragma unroll
        for (int ai = 0; ai < 2; ++ai)
#pragma unroll
            for (int m = 0; m < 4; ++m) {
                const int row = row0 + ai * HALF + m * 16, b = row >> 12;
                const float rstd = row_rstd(sumsq, row);
#pragma unroll
                for (int bj = 0; bj < 2; ++bj)
#pragma unroll
                    for (int n = 0; n < 2; ++n) {
                        const int c = col0 + bj * HALF + n * 16;
                        *(f32x4*)(sc + (size_t)row * 2048 + c) = acc[ai][bj][m][n] * rstd + *(const f32x4*)(biasf + b * 2048 + c);
                    }
            }
    }
};

template <class Epi, class Sched, bool ALIGN_EPI = false, bool SP2 = false>
__device__ __forceinline__ void gemm_phase(PG8_LAS unsigned char* lds, const Gemm g, const Sched& S, const Epi& E) {
    const int tid = threadIdx.x, wid = __builtin_amdgcn_readfirstlane(tid >> 6), lane = tid & 63, wr = wid >> 2, wc = wid & 3, fr = lane & 15, fq = lane >> 4;
    const int K = g.K, nt = K / BK;
    unsigned voffA[2], voffB[2];
#pragma unroll
    for (int i = 0; i < 2; ++i) { int R, C; stage_rc(tid * 16 + i * 8192, R, C); const int Rb = Epi::PERM ? ((R & ~31) + perm32(R & 31)) : R;
        voffA[i] = (unsigned)(R * K + C) * 2u; voffB[i] = (unsigned)(Rb * K + C) * 2u; }
    const size_t kstep = (size_t)(BK * 2);
    const size_t hstep = (size_t)HALF * K * 2;
    const size_t tstep = 2 * hstep;
    const unsigned ldsw = (unsigned)wid * 1024u;
    const int aoff = lds_byte(wr * 64 + fr, fq * 8), boff = lds_byte(wc * 32 + fr, fq * 8);
#define PG8_SA(b, h) (((b) * 2 + (h)) * HTB)
#define PG8_SB(b, h) ((4 + (b) * 2 + (h)) * HTB)
#define PG8_STAGE(bufoff, gbase, voff) do { _Pragma("unroll") for (int _i = 0; _i < 2; ++_i) \
        __builtin_amdgcn_global_load_lds((const unsigned*)((const char*)(gbase) + (voff)[_i]), (PG8_LAS unsigned*)(lds + (bufoff) + ldsw + _i * 8192), 16, 0, 0); } while (0)
#define PG8_LDA(dst, b, h) do { _Pragma("unroll") for (int m = 0; m < 4; ++m) _Pragma("unroll") for (int k = 0; k < 2; ++k) dst[m][k] = *(const PG8_LAS bf16x8*)(lds + PG8_SA(b, h) + aoff + m * 2048 + k * 1024); } while (0)
#define PG8_LDB(dst, b, h) do { _Pragma("unroll") for (int n = 0; n < 2; ++n) _Pragma("unroll") for (int k = 0; k < 2; ++k) dst[n][k] = *(const PG8_LAS bf16x8*)(lds + PG8_SB(b, h) + boff + n * 2048 + k * 1024); } while (0)
#define PG8_MMA(ai, bj, At, Bt) do { __builtin_amdgcn_s_setprio(1); _Pragma("unroll") for (int m = 0; m < 4; ++m) _Pragma("unroll") for (int n = 0; n < 2; ++n) _Pragma("unroll") for (int k = 0; k < 2; ++k) \
        acc[ai][bj][m][n] = __builtin_amdgcn_mfma_f32_16x16x32_bf16(Bt[n][k], At[m][k], acc[ai][bj][m][n], 0, 0, 0); __builtin_amdgcn_s_setprio(0); } while (0)
#define PG8_WAIT_V(n) asm volatile("s_waitcnt vmcnt(" #n ")" ::: "memory")
#define PG8_WAIT_L(n) asm volatile("s_waitcnt lgkmcnt(" #n ")" ::: "memory")
#define PG8_BAR __builtin_amdgcn_s_barrier()
#define PG8_SCHED __builtin_amdgcn_sched_barrier(0)
    Unit cur, nxt; int ui = 0;
    if (!S.next(0, cur)) return;
    f32x4 acc[2][2][4][2];
#pragma unroll
    for (int a = 0; a < 2; ++a)
#pragma unroll
        for (int b = 0; b < 2; ++b)
#pragma unroll
            for (int m = 0; m < 4; ++m)
#pragma unroll
                for (int n = 0; n < 2; ++n) acc[a][b][m][n] = (f32x4){0.f, 0.f, 0.f, 0.f};
    bf16x8 At[4][2], B0[2][2], B1[2][2];
    const char* cA = (const char*)g.A + (size_t)cur.pm * tstep; const char* cB = (const char*)g.Bt + (size_t)cur.pn * tstep;
    S.a_ready(cur);
    if constexpr (SP2) {
        PG8_STAGE(PG8_SB(0, 0), cB, voffB); PG8_STAGE(PG8_SB(0, 1), cB + hstep, voffB); PG8_STAGE(PG8_SA(0, 0), cA, voffA); PG8_STAGE(PG8_SA(0, 1), cA + hstep, voffA);
        if (wr == 1) PG8_BAR;
        PG8_WAIT_V(2); PG8_BAR;
        PG8_STAGE(PG8_SB(1, 0), cB + kstep, voffB); PG8_STAGE(PG8_SA(1, 0), cA + kstep, voffA); PG8_STAGE(PG8_SB(1, 1), cB + hstep + kstep, voffB);
        PG8_WAIT_V(6); PG8_BAR;
    } else {
        PG8_STAGE(PG8_SB(0, 0), cB, voffB); PG8_STAGE(PG8_SA(0, 0), cA, voffA); PG8_STAGE(PG8_SB(0, 1), cB + hstep, voffB); PG8_STAGE(PG8_SA(0, 1), cA + hstep, voffA);
        if (wr == 1) PG8_BAR;
        PG8_WAIT_V(4); PG8_BAR;
        PG8_STAGE(PG8_SB(1, 0), cB + kstep, voffB); PG8_STAGE(PG8_SA(1, 0), cA + kstep, voffA); PG8_STAGE(PG8_SB(1, 1), cB + hstep + kstep, voffB);
        PG8_WAIT_V(6); PG8_BAR;
    }
    for (;;) {
        const bool has_next = S.next(ui + 1, nxt);
        const char* nA = has_next ? (const char*)g.A + (size_t)nxt.pm * tstep : cA; const char* nB = has_next ? (const char*)g.Bt + (size_t)nxt.pn * tstep : cB;
        for (int t = 0; t < nt; t += 2) {
            const bool last = (t == nt - 2);
            const char* a1 = cA + (size_t)(t + 1) * kstep;
            const char* a2 = last ? nA : cA + (size_t)(t + 2) * kstep; const char* b2 = last ? nB : cB + (size_t)(t + 2) * kstep;
            const char* a3 = a2 + kstep; const char* b3 = b2 + kstep;
            if (last && has_next) S.a_ready(nxt);
            if constexpr (SP2) {
            PG8_LDB(B0, 0, 0); PG8_LDB(B1, 0, 1); PG8_SCHED; PG8_LDA(At, 0, 0); PG8_STAGE(PG8_SA(1, 1), a1 + hstep, voffA);
            PG8_WAIT_V(8); PG8_WAIT_L(0); PG8_BAR; PG8_MMA(0, 0, At, B0); PG8_MMA(0, 1, At, B1); PG8_BAR; PG8_SCHED;
            PG8_LDA(At, 0, 1); PG8_STAGE(PG8_SB(0, 0), b2, voffB); PG8_STAGE(PG8_SB(0, 1), b2 + hstep, voffB); PG8_STAGE(PG8_SA(0, 0), a2, voffA);
            PG8_WAIT_V(8); PG8_WAIT_L(0); PG8_BAR; PG8_MMA(1, 0, At, B0); PG8_MMA(1, 1, At, B1); PG8_BAR; PG8_SCHED;
            PG8_LDB(B0, 1, 0); PG8_LDB(B1, 1, 1); PG8_SCHED; PG8_LDA(At, 1, 0); PG8_STAGE(PG8_SA(0, 1), a2 + hstep, voffA);
            PG8_WAIT_V(8); PG8_WAIT_L(0); PG8_BAR; PG8_MMA(0, 0, At, B0); PG8_MMA(0, 1, At, B1); PG8_BAR; PG8_SCHED;
            PG8_LDA(At, 1, 1); PG8_STAGE(PG8_SB(1, 0), b3, voffB); PG8_STAGE(PG8_SB(1, 1), b3 + hstep, voffB); PG8_STAGE(PG8_SA(1, 0), a3, voffA);
            PG8_WAIT_V(8); PG8_WAIT_L(0); PG8_BAR; PG8_MMA(1, 0, At, B0); PG8_MMA(1, 1, At, B1); PG8_BAR; PG8_SCHED;
            } else {
            PG8_LDB(B0, 0, 0); PG8_SCHED; PG8_LDA(At, 0, 0); PG8_STAGE(PG8_SA(1, 1), a1 + hstep, voffA);
            PG8_WAIT_L(8); PG8_BAR; PG8_WAIT_L(0); PG8_MMA(0, 0, At, B0); PG8_BAR; PG8_SCHED;
            PG8_LDB(B1, 0, 1); PG8_STAGE(PG8_SB(0, 0), b2, voffB);
            PG8_BAR; PG8_WAIT_L(0); PG8_MMA(0, 1, At, B1); PG8_BAR;
            PG8_LDA(At, 0, 1); PG8_STAGE(PG8_SA(0, 0), a2, voffA);
            PG8_BAR; PG8_WAIT_L(0); PG8_MMA(1, 0, At, B0); PG8_BAR; PG8_SCHED;
            PG8_STAGE(PG8_SB(0, 1), b2 + hstep, voffB);
            PG8_WAIT_V(6); PG8_BAR; PG8_MMA(1, 1, At, B1); PG8_BAR;
            PG8_LDB(B0, 1, 0); PG8_SCHED; PG8_LDA(At, 1, 0); PG8_STAGE(PG8_SA(0, 1), a2 + hstep, voffA);
            PG8_WAIT_L(8); PG8_BAR; PG8_WAIT_L(0); PG8_MMA(0, 0, At, B0); PG8_BAR; PG8_SCHED;
            PG8_LDB(B1, 1, 1); PG8_STAGE(PG8_SB(1, 0), b3, voffB);
            PG8_BAR; PG8_WAIT_L(0); PG8_MMA(0, 1, At, B1); PG8_BAR;
            PG8_LDA(At, 1, 1); PG8_STAGE(PG8_SA(1, 0), a3, voffA);
            PG8_BAR; PG8_WAIT_L(0); PG8_MMA(1, 0, At, B0); PG8_BAR; PG8_SCHED;
            PG8_STAGE(PG8_SB(1, 1), b3 + hstep, voffB);
            PG8_WAIT_V(6); PG8_BAR; PG8_MMA(1, 1, At, B1); PG8_BAR;
            }
        }
        if constexpr (ALIGN_EPI) { if (wr == 0) PG8_BAR; }
        if constexpr (!Epi::AFTER_DRAIN) { E(acc, cur, wr, wc, fr, fq); S.done(cur); }
        if (!has_next) break;
#pragma unroll
        for (int a = 0; a < 2; ++a)
#pragma unroll
            for (int b = 0; b < 2; ++b)
#pragma unroll
                for (int m = 0; m < 4; ++m)
#pragma unroll
                    for (int n = 0; n < 2; ++n) acc[a][b][m][n] = (f32x4){0.f, 0.f, 0.f, 0.f};
        cur = nxt; cA = nA; cB = nB; ++ui;
        if constexpr (ALIGN_EPI) { if (wr == 1) PG8_BAR; }
    }
    PG8_WAIT_V(0);
    if constexpr (!ALIGN_EPI) { if (wr == 0) PG8_BAR; }
    PG8_BAR;
    if constexpr (Epi::AFTER_DRAIN) { E.fused(acc, cur, wr, wc, fr, fq, lds, wid, lane); S.done(cur); }
#undef PG8_SA
#undef PG8_SB
#undef PG8_STAGE
#undef PG8_LDA
#undef PG8_LDB
#undef PG8_MMA
#undef PG8_WAIT_V
#undef PG8_WAIT_L
#undef PG8_BAR
#undef PG8_SCHED
}
}
struct Args { const float* in[13]; float* out; unsigned char* ws; int ph_lo, ph_hi; };

#ifndef TPROBE_I
#define TPROBE_I 3
#endif
#ifndef TPROBE_B
#define TPROBE_B 0
#endif
#ifdef TIME_PH
#ifndef TIME_AMP
#define TIME_AMP 4
#endif
#define TSTAMP(k, slot) do { if ((k) == TIME_PH && bid == TPROBE_B && tid == 0) { const unsigned long long t_ = __builtin_amdgcn_s_memrealtime(); MISC[slot] = (unsigned)t_; MISC[(slot) + 1] = (unsigned)(t_ >> 32); } } while (0)
#else
#define TSTAMP(k, slot) do { } while (0)
#endif
template <bool PERMUTE>
__device__ __forceinline__ void p0_transpose_item(const float* W, int K, int N, int NPOS, bf16_t* WT, LAS float* scr, int item, int lane) {
    const int nblk = NPOS / 32, kb = item / nblk, nb = item % nblk, k0 = 64 * kb, n0 = 32 * nb;
    const int pos = n0 + 4 * (lane & 7);
    const int col = PERMUTE ? win_src_col(pos) : pos;
    f32x4 v[8];
#pragma unroll
    for (int i = 0; i < 8; ++i) { const int kk = 8 * i + (lane >> 3); v[i] = (col >= 0) ? *(const f32x4*)(W + (size_t)(k0 + kk) * N + col) : (f32x4){0.f, 0.f, 0.f, 0.f}; }
#pragma unroll
    for (int i = 0; i < 8; ++i) { const int kk = 8 * i + (lane >> 3); LAS float* q = scr + kk * 33 + 4 * (lane & 7); q[0] = v[i][0]; q[1] = v[i][1]; q[2] = v[i][2]; q[3] = v[i][3]; }
    asm volatile("s_waitcnt lgkmcnt(0)" ::: "memory");
    const int c = lane & 7;
#pragma unroll
    for (int j = 0; j < 4; ++j) { const int n = (lane >> 3) + 8 * j; const LAS float* s = scr + (8 * c) * 33 + n;
        u32x4 o; o.x = pk2(s[0 * 33], s[1 * 33]); o.y = pk2(s[2 * 33], s[3 * 33]); o.z = pk2(s[4 * 33], s[5 * 33]); o.w = pk2(s[6 * 33], s[7 * 33]);
        *(u32x4*)(WT + (size_t)(n0 + n) * K + k0 + 8 * c) = o; }
    asm volatile("s_waitcnt lgkmcnt(0)" ::: "memory");
}
__device__ __forceinline__ void row_to_bf16(const float* src, bf16_t* dst, int lane) {
    const f32x4* s = (const f32x4*)src + lane; u32x2* d = (u32x2*)dst + lane;
    f32x4 v[4];
#pragma unroll
    for (int j = 0; j < 4; ++j) v[j] = s[64 * j];
#pragma unroll
    for (int j = 0; j < 4; ++j) { u32x2 w; w.x = pk2(v[j][0], v[j][1]); w.y = pk2(v[j][2], v[j][3]); d[64 * j] = w; }
}
typedef float f32x2 __attribute__((ext_vector_type(2)));
template <int NB>
__device__ __forceinline__ void rows_to_fp8(const float* src, unsigned char* dst, float* scale_out, int lane) {
    f32x4 v[NB][4];
#pragma unroll
    for (int i = 0; i < NB; ++i) { const f32x4* s = (const f32x4*)(src + (size_t)i * 1024) + 4 * lane;
#pragma unroll
        for (int j = 0; j < 4; ++j) v[i][j] = __builtin_nontemporal_load(s + j); }
#pragma unroll
    for (int i = 0; i < NB; ++i) {
        float am = 0.f;
#pragma unroll
        for (int j = 0; j < 4; ++j) am = fmaxf(am, fmaxf(fmaxf(fabsf(v[i][j][0]), fabsf(v[i][j][1])), fmaxf(fabsf(v[i][j][2]), fabsf(v[i][j][3]))));
#pragma unroll
        for (int o = 1; o < 64; o <<= 1) am = fmaxf(am, __shfl_xor(am, o));
        const float sc = am > 0.f ? am * (1.0f / 440.0f) : 1.0f, inv = 1.0f / sc;
        u32x4 w;
#pragma unroll
        for (int j = 0; j < 4; ++j) { unsigned t = 0u; t = __builtin_amdgcn_cvt_pk_fp8_f32(v[i][j][0] * inv, v[i][j][1] * inv, t, false); t = __builtin_amdgcn_cvt_pk_fp8_f32(v[i][j][2] * inv, v[i][j][3] * inv, t, true); w[j] = t; }
        *((u32x4*)(dst + (size_t)i * 1024) + lane) = w;
        if (lane == 0) scale_out[i] = sc;
    }
}
__device__ __forceinline__ void sincos_tab(double x, float& s, float& c) {
    const double k = rint(x * 0.15915494309189535);
    double r = fma(-k, 6.283185307179586, x); r = fma(-k, 2.4492935982947064e-16, r);
    const double r2 = r * r;
    double ps = 1.0, pc = 1.0;
#pragma unroll
    for (int n = 29; n >= 3; n -= 2) ps = 1.0 - ps * r2 * (1.0 / (double)((n - 1) * n));
#pragma unroll
    for (int n = 28; n >= 2; n -= 2) pc = 1.0 - pc * r2 * (1.0 / (double)((n - 1) * n));
    s = (float)(r * ps); c = (float)pc;
}

__device__ __forceinline__ void phase0(const Args& a, unsigned char* lds, int tid, int wave, int lane, int bid, int G) {
    unsigned char* ws = a.ws;
    volatile LAS unsigned* MISC = (volatile LAS unsigned*)((LAS unsigned char*)lds + MISC_OFF);
    TSTAMP(90, 0);
    for (int it = bid; it < 192; it += G) {
        float* s_c = (float*)lds; float* red = (float*)(lds + 16384);
        for (int i = tid; i < 4096; i += NTHREADS) { const float v = a.in[1][i]; s_c[i] = v / (1.0f + expf(-v)); }
        __syncthreads();
        const int g = tid & 7, ks = tid >> 3, n0 = 32 * it;
        f32x4 acc[4];
#pragma unroll
        for (int b = 0; b < 4; ++b) acc[b] = (f32x4){0.f, 0.f, 0.f, 0.f};
#pragma unroll 4
        for (int i = 0; i < 16; ++i) { const int k = ks + 64 * i; const f32x4 w = *(const f32x4*)(a.in[2] + (size_t)k * 6144 + n0 + 4 * g);
#pragma unroll
            for (int b = 0; b < 4; ++b) acc[b] += w * s_c[b * 1024 + k]; }
#pragma unroll
        for (int b = 0; b < 4; ++b) *(f32x4*)(red + (ks * 8 + g) * 16 + 4 * b) = acc[b];
        __syncthreads();
        if (tid < 128) { const int b = tid >> 5, col = tid & 31, gg = col >> 2, e = col & 3; float s = 0.f;
            for (int k2 = 0; k2 < 64; ++k2) s += red[(k2 * 8 + gg) * 16 + 4 * b + e];
            ((float*)(ws + WS_MOD))[b * 6144 + n0 + col] = s + a.in[3][n0 + col]; }
        __syncthreads();
    }
    TSTAMP(90, 2); TSTAMP(91, 0);
    for (int it = bid; it < 256; it += G) {
        const int hp = it >> 4, k0 = 64 * (it & 15);
        constexpr int WP = 132;
        float* skl = (float*)lds; float* wql = skl + 128 * WP;
        for (int i = tid; i < 4096; i += NTHREADS) { const int n = i >> 5, d4 = i & 31; *(f32x4*)(skl + n * WP + 4 * d4) = *(const f32x4*)(a.in[9] + (size_t)hp * 16384 + n * 128 + 4 * d4); }
        for (int i = tid; i < 2048; i += NTHREADS) { const int k = i >> 5, d4 = i & 31; *(f32x4*)(wql + k * WP + 4 * d4) = *(const f32x4*)(a.in[8] + (size_t)(k0 + k) * 2048 + hp * 128 + 4 * d4); }
        __syncthreads();
        const int kg = tid & 15, ng = tid >> 4;
        float acc[4][4];
#pragma unroll
        for (int i = 0; i < 4; ++i)
#pragma unroll
            for (int j = 0; j < 4; ++j) acc[i][j] = 0.f;
#pragma unroll 2
        for (int d4 = 0; d4 < 32; ++d4) {
            f32x4 wv[4], sv[4];
#pragma unroll
            for (int i = 0; i < 4; ++i) { wv[i] = *(const f32x4*)(wql + (kg + 16 * i) * WP + 4 * d4); sv[i] = *(const f32x4*)(skl + (ng + 32 * i) * WP + 4 * d4); }
#pragma unroll
            for (int i = 0; i < 4; ++i)
#pragma unroll
                for (int j = 0; j < 4; ++j) acc[i][j] += (wv[i][0] * sv[j][0] + wv[i][1] * sv[j][1]) + (wv[i][2] * sv[j][2] + wv[i][3] * sv[j][3]);
        }
        bf16_t* wt = (bf16_t*)(ws + WS_WPQ);
#pragma unroll
        for (int j = 0; j < 4; ++j)
#pragma unroll
            for (int i = 0; i < 4; ++i) wt[(size_t)(hp * 128 + ng + 32 * j) * 1024 + k0 + kg + 16 * i] = (bf16_t)f2bf(acc[i][j]);
        __syncthreads();
    }
    TSTAMP(91, 2); TSTAMP(92, 0);
    const int gw = bid * 8 + wave, NGW = G * 8;
    {
        LAS float* scr = (LAS float*)(lds + wave * 16384);
        constexpr int I_IN = 16 * (N1 / 32), I_OUT = 16 * 32;
        for (int it = gw; it < I_IN + I_OUT; it += NGW) {
            if (it < I_IN) p0_transpose_item<true>(a.in[5], 1024, 4168, N1, (bf16_t*)(ws + WS_WIN), scr, it, lane);
            else p0_transpose_item<false>(a.in[6], 1024, 1024, 1024, (bf16_t*)(ws + WS_WOUT), scr, it - I_IN, lane);
        }
    }
    for (int it = gw; it < 4096; it += NGW) { const int r = 4 * it;
        rows_to_fp8<4>(a.in[10] + (size_t)r * 1024, ws + WS_U8 + (size_t)r * 1024, (float*)(ws + WS_USC) + r, lane); }
    for (int i = bid * NTHREADS + tid; i < 4096 * 96; i += G * NTHREADS) {
        int pos, f; double r; float* ct; float* st; int idx;
        if (i < 4096 * 32) { pos = i >> 5; f = i & 31; r = 0.74989420933245582730; ct = (float*)(ws + WS_COSA); st = (float*)(ws + WS_SINA); idx = i; }
        else { const int j = i - 4096 * 32; pos = j >> 6; f = j & 63; r = 0.86398844948396852897; ct = (float*)(ws + WS_COSR); st = (float*)(ws + WS_SINR); idx = j; }
        double v = 1.0; for (int t = 0; t < f; ++t) v *= r;
        const float invf = (float)v; const float ang = (float)pos * invf;
        float s, c; sincos_tab((double)ang, s, c);
        ct[idx] = c; st[idx] = s;
    }
}

__device__ __forceinline__ void phase1(const Args& a, int wave, int lane, int bid, int G) {
    unsigned char* ws = a.ws;
    const float* mod = (const float*)(ws + WS_MOD);
    const int gw = bid * 8 + wave, NGW = G * 8;
    for (int r = gw; r < MTOK; r += NGW) {
        const int b = r >> 12;
        const f32x4* xr = (const f32x4*)(a.in[0] + (size_t)r * DM) + lane;
        f32x4 v[4]; float ss = 0.f;
#pragma unroll
        for (int j = 0; j < 4; ++j) { v[j] = xr[64 * j]; ss += (v[j][0] * v[j][0] + v[j][1] * v[j][1]) + (v[j][2] * v[j][2] + v[j][3] * v[j][3]); }
        const float rstd = 1.0f / sqrtf(wave_sum(ss) * (1.0f / DM) + EPS);
        u32x2* o = (u32x2*)((bf16_t*)(ws + WS_BUFA) + (size_t)r * DM) + lane;
#pragma unroll
        for (int j = 0; j < 4; ++j) { const int c = 256 * j + 4 * lane;
            const f32x4 g = *(const f32x4*)(a.in[4] + c), sc = *(const f32x4*)(mod + b * 6144 + 1024 + c), sh = *(const f32x4*)(mod + b * 6144 + c);
            const f32x4 h = v[j] * rstd * g * (sc + 1.0f) + sh;
            u32x2 w; w.x = pk2(h[0], h[1]); w.y = pk2(h[2], h[3]); o[64 * j] = w; }
    }
    for (int n = gw; n < 2048; n += NGW) {
        const u32x4* wr = (const u32x4*)((const bf16_t*)(ws + WS_WPQ) + (size_t)n * 1024);
        const u32x4 w0 = wr[lane], w1 = wr[64 + lane];
        float wf[16];
#pragma unroll
        for (int i = 0; i < 4; ++i) { wf[2 * i] = bf_lo(w0[i]); wf[2 * i + 1] = bf_hi(w0[i]); wf[8 + 2 * i] = bf_lo(w1[i]); wf[8 + 2 * i + 1] = bf_hi(w1[i]); }
#pragma unroll
        for (int b = 0; b < 4; ++b) { const float* sh = mod + b * 6144 + 3072; float s = 0.f;
#pragma unroll
            for (int i = 0; i < 8; ++i) s += wf[i] * sh[8 * lane + i] + wf[8 + i] * sh[512 + 8 * lane + i];
            s = wave_sum(s);
            if (lane == 0) ((float*)(ws + WS_BIASF))[b * 2048 + n] = s; }
    }
}

constexpr int SCP = 8200;
__device__ __forceinline__ int wave_total(int v) {
    v += __builtin_amdgcn_update_dpp(0, v, 0xB1, 0xF, 0xF, true);
    v += __builtin_amdgcn_update_dpp(0, v, 0x4E, 0xF, 0xF, true);
    v += __builtin_amdgcn_update_dpp(0, v, 0x141, 0xF, 0xF, true);
    v += __builtin_amdgcn_update_dpp(0, v, 0x140, 0xF, 0xF, true);
    return __builtin_amdgcn_readlane(v, 0) + __builtin_amdgcn_readlane(v, 16) + __builtin_amdgcn_readlane(v, 32) + __builtin_amdgcn_readlane(v, 48);
}
template <int NR>
__device__ __forceinline__ void select_row_t(int b, int t, const unsigned char* ldsrow, unsigned long long* MASK, int lane) {
    {
        unsigned* row32 = (unsigned*)ldsrow;
        for (int i = 8 * ((t >> 4) + 1) + lane; i < 32 * NR; i += 64) row32[i] = 0u;
    }
    unsigned key[NR];
#pragma unroll
    for (int j = 0; j < NR; ++j) key[j] = *(const unsigned short*)(ldsrow + 2 * lane + 128 * j);
    unsigned mw_lo = 0u, mw_hi = 0u;
    if (t < 256) {
#pragma unroll
        for (int j = 0; j < 4; ++j) { const unsigned long long w = __ballot(key[j] != 0u);
            asm volatile("s_nop 1\n\tv_writelane_b32 %0, %2, %4\n\tv_writelane_b32 %1, %3, %4\n\ts_nop 0" : "+v"(mw_lo), "+v"(mw_hi) : "s"((unsigned)w), "s"((unsigned)(w >> 32)), "n"(j)); }
    } else {
        unsigned T = 0;
#pragma unroll 1
        for (int bit = 15; bit >= 0; --bit) {
            const unsigned cand = T | (1u << bit);
            int c0 = 0, c1 = 0, c2 = 0, c3 = 0;
#pragma unroll
            for (int j = 0; j < NR; j += 4) { c0 += (key[j] >= cand) ? 1 : 0; c1 += (key[j + 1] >= cand) ? 1 : 0; c2 += (key[j + 2] >= cand) ? 1 : 0; c3 += (key[j + 3] >= cand) ? 1 : 0; }
            if (wave_total((c0 + c1) + (c2 + c3)) >= 256) T = cand;
        }
        int g0 = 0, g1 = 0;
#pragma unroll
        for (int j = 0; j < NR; j += 2) { g0 += (key[j] > T) ? 1 : 0; g1 += (key[j + 1] > T) ? 1 : 0; }
        int e0 = 0, e1 = 0;
#pragma unroll
        for (int j = 0; j < NR; j += 2) { e0 += (key[j] == T) ? 1 : 0; e1 += (key[j + 1] == T) ? 1 : 0; }
        int need = 256 - wave_total(g0 + g1);
        if (wave_total(e0 + e1) == need) {
#pragma unroll
            for (int j = 0; j < NR; ++j) { const unsigned long long w = __ballot(key[j] >= T);
                asm volatile("s_nop 1\n\tv_writelane_b32 %0, %2, %4\n\tv_writelane_b32 %1, %3, %4\n\ts_nop 0" : "+v"(mw_lo), "+v"(mw_hi) : "s"((unsigned)w), "s"((unsigned)(w >> 32)), "n"(j));
                if ((j & 3) == 3) __builtin_amdgcn_sched_barrier(0); }
        } else {
#pragma unroll
        for (int j = 0; j < NR; ++j) {
            const bool gt = key[j] > T, eq = key[j] == T;
            const unsigned long long em = __ballot(eq);
            const int cc = __popcll(em), take = cc < need ? cc : need;
            const int rank = (int)__builtin_amdgcn_mbcnt_hi((unsigned)(em >> 32), __builtin_amdgcn_mbcnt_lo((unsigned)em, 0u));
            const unsigned long long w = __ballot(gt || (eq && rank < take));
            need -= take;
            asm volatile("s_nop 1\n\tv_writelane_b32 %0, %2, %4\n\tv_writelane_b32 %1, %3, %4\n\ts_nop 0" : "+v"(mw_lo), "+v"(mw_hi) : "s"((unsigned)w), "s"((unsigned)(w >> 32)), "n"(j));
            if ((j & 1) == 1) __builtin_amdgcn_sched_barrier(0);
        }
        }
    }
    MASK[((size_t)b * SEQ + t) * 64 + lane] = ((unsigned long long)mw_hi << 32) | mw_lo;
}
__device__ __forceinline__ void select_row(int b, int t, const unsigned char* ldsrow, unsigned long long* MASK, int lane) {
    switch (t >> 10) {
        case 0: select_row_t<16>(b, t, ldsrow, MASK, lane); break;
        case 1: select_row_t<32>(b, t, ldsrow, MASK, lane); break;
        case 2: select_row_t<48>(b, t, ldsrow, MASK, lane); break;
        default: select_row_t<64>(b, t, ldsrow, MASK, lane); break;
    }
}
__device__ __forceinline__ void idx_unit(int b, int qt, const bf16_t* QI, const bf16_t* KI, const float* WI, unsigned long long* MASK, unsigned char* lds, int wave, int lane, bool tprobe) {
    volatile LAS unsigned* MISC = (volatile LAS unsigned*)((LAS unsigned char*)lds + MISC_OFF); const int bid = tprobe ? TPROBE_B : -1; const int tid = (int)threadIdx.x;
    TSTAMP(32, 0);
    const int t0 = 16 * qt, qn = lane & 15, g = lane >> 4;
    const size_t rowq = (size_t)b * SEQ + t0 + qn;
    bf16x8 qf[8][2]; float wi[8];
#pragma unroll
    for (int h = 0; h < 8; ++h)
#pragma unroll
        for (int ks = 0; ks < 2; ++ks) qf[h][ks] = *(const bf16x8*)(QI + rowq * 512 + h * 64 + ks * 32 + 8 * g);
    { const f32x4 w0 = *(const f32x4*)(WI + rowq * 8), w1 = *(const f32x4*)(WI + rowq * 8 + 4);
#pragma unroll
      for (int e = 0; e < 4; ++e) { wi[e] = w0[e]; wi[4 + e] = w1[e]; } }
    const bf16_t* kbase = KI + ((size_t)b * SEQ + qn) * 64 + 8 * g;
    bf16x8 ra0[8], ra1[8];
#pragma unroll
    for (int i = 0; i < 8; ++i) if (wave + 8 * i <= qt) { const bf16_t* kr = kbase + (size_t)(wave + 8 * i) * 1024; ra0[i] = *(const bf16x8*)kr; ra1[i] = *(const bf16x8*)(kr + 32); }
#pragma unroll 1
    for (int base = wave; base <= qt; base += 64) {
#pragma unroll
        for (int i = 0; i < 8; ++i) {
            const int kt = base + 8 * i;
            if (kt <= qt) {
                const bf16x8 a0 = ra0[i], a1 = ra1[i];
                if (kt + 64 <= qt) { const bf16_t* kr = kbase + (size_t)(kt + 64) * 1024; ra0[i] = *(const bf16x8*)kr; ra1[i] = *(const bf16x8*)(kr + 32); }
                const int s0 = 16 * kt;
                f32x4 sc = (f32x4){0.f, 0.f, 0.f, 0.f};
#pragma unroll
                for (int h = 0; h < 8; ++h) {
                    f32x4 d = mfma16(a0, qf[h][0], (f32x4){0.f, 0.f, 0.f, 0.f}); d = mfma16(a1, qf[h][1], d);
#pragma unroll
                    for (int r = 0; r < 4; ++r) { const int di = (int)__float_as_uint(d[r]); sc[r] += wi[h] * __uint_as_float((unsigned)(di > 0 ? di : 0)); }
                }
                unsigned k[4];
#pragma unroll
                for (int r = 0; r < 4; ++r) { const unsigned kk = sortable16(sc[r]); k[r] = (s0 + 4 * g + r <= t0 + qn) ? kk : 0u; }
                u32x2 pk; pk.x = k[0] | (k[1] << 16); pk.y = k[2] | (k[3] << 16);
                *(u32x2*)(lds + qn * SCP + 2 * (s0 + 4 * g)) = pk;
            }
        }
    }
    __syncthreads();
    TSTAMP(32, 2); TSTAMP(33, 0);
#ifndef NO_SEL
#pragma unroll 1
    for (int qq = 2 * wave; qq < 2 * wave + 2; ++qq) select_row(b, t0 + qq, lds + qq * SCP, MASK, lane);
#endif
    __syncthreads();
    TSTAMP(33, 2);
}

__device__ __forceinline__ void ret_state_unit(int b, int h, int vb, int dh, const bf16_t* KR, const bf16_t* VR, bf16_t* STATE, unsigned char* lds, int tid, int wave, int lane) {
    constexpr int PT = 272, KT_BYTES = 64 * PT, BUF = KT_BYTES + 16 * PT;
    const int j = tid & 127, dq = tid >> 7, g = lane >> 4, ln = lane & 15;
    const float g128 = ret_g128(h), g127 = ret_g127(h), gam = ret_gamma(h);
    f32x4 st = (f32x4){0.f, 0.f, 0.f, 0.f};
    u32x4 kA[2], kB[2], vA = (u32x4){0u, 0u, 0u, 0u}, vB = (u32x4){0u, 0u, 0u, 0u};
#define RS_LOAD(K_, V_, n) do { const size_t row = (size_t)b * SEQ + (n) * 128 + j; const u32x4* p = (const u32x4*)(KR + row * 512 + h * 128 + 64 * dh + 16 * dq); \
        K_[0] = p[0]; K_[1] = p[1]; if (tid < 256) V_ = *(const u32x4*)(VR + row * 512 + h * 128 + 16 * vb + 8 * dq); } while (0)
#define RS_WRITE(K_, V_, buf) do { _Pragma("unroll") for (int i = 0; i < 2; ++i) _Pragma("unroll") for (int e = 0; e < 4; ++e) { const unsigned w = K_[i][e]; const int d = 16 * dq + 8 * i + 2 * e; \
            *(unsigned short*)((buf) + d * PT + 2 * j) = (unsigned short)(w & 0xffffu); *(unsigned short*)((buf) + (d + 1) * PT + 2 * j) = (unsigned short)(w >> 16); } \
        if (tid < 256) { _Pragma("unroll") for (int e = 0; e < 4; ++e) { const unsigned w = V_[e]; const int v = 8 * dq + 2 * e; \
            *(unsigned short*)((buf) + KT_BYTES + v * PT + 2 * j) = (unsigned short)(w & 0xffffu); *(unsigned short*)((buf) + KT_BYTES + (v + 1) * PT + 2 * j) = (unsigned short)(w >> 16); } } } while (0)
#define RS_COMP(buf, n) do { if (wave < 4) { \
        bf16_t* sp = STATE + ((((size_t)b * 4 + h) * 32 + (n)) * 128 + 16 * vb + 4 * g) * 128 + 64 * dh + 16 * wave + ln; \
        _Pragma("unroll") for (int r = 0; r < 4; ++r) sp[r * 128] = (bf16_t)f2bf(gam * st[r]); \
        f32x4 c = (f32x4){0.f, 0.f, 0.f, 0.f}; \
        _Pragma("unroll") for (int ks = 0; ks < 4; ++ks) { \
            const bf16x8 af = *(const bf16x8*)((buf) + KT_BYTES + ln * PT + 2 * (32 * ks + 8 * g)); \
            const bf16x8 bf = *(const bf16x8*)((buf) + (16 * wave + ln) * PT + 2 * (32 * ks + 8 * g)); \
            c = mfma16(af, bf, c); } \
        st = st * g128 + c * g127; } } while (0)
    RS_LOAD(kA, vA, 0); RS_LOAD(kB, vB, 1);
#pragma unroll 1
    for (int n = 0; n < 32; n += 2) {
        RS_WRITE(kA, vA, lds);
        if (n + 2 < 32) RS_LOAD(kA, vA, n + 2);
        __syncthreads();
        RS_COMP(lds, n);
        RS_WRITE(kB, vB, lds + BUF);
        if (n + 3 < 32) RS_LOAD(kB, vB, n + 3);
        __syncthreads();
        RS_COMP(lds + BUF, n + 1);
    }
#undef RS_LOAD
#undef RS_WRITE
#undef RS_COMP
    __syncthreads();
}

__device__ __forceinline__ float amax3(float a, float b, float c) { float r; asm("v_max3_f32 %0, %1, %2, %3" : "=v"(r) : "v"(a), "v"(b), "v"(c)); return r; }
__device__ __forceinline__ void attn_unit(int b, int h, int qb, const bf16_t* QA, const bf16_t* KA, const bf16_t* VA, const unsigned long long* MASK, bf16_t* AR,
                                          unsigned char* lds, int tid, int wave, int lane) {
    constexpr int KP = 144, KS_BYTES = 64 * KP, BUF = 2 * KS_BYTES;
    const int q0 = 256 * qb, r32 = lane & 31, hi = lane >> 5;
    const int t = q0 + 32 * wave + r32;
    const size_t qrow = (size_t)b * SEQ + t;
    bf16x8 qf[4];
#pragma unroll
    for (int d0 = 0; d0 < 4; ++d0) qf[d0] = *(const bf16x8*)(QA + qrow * 512 + h * 64 + 16 * d0 + 8 * hi);
    const int NT = (q0 + 256) / 64;
    const int key_l = tid >> 3, c8 = tid & 7;
    f32x16 o0, o1;
#pragma unroll
    for (int r = 0; r < 16; ++r) { o0[r] = 0.f; o1[r] = 0.f; }
    float m_run = NEG_INF, l_run = 0.f;
    u32x4 kreg[4], vreg[4]; unsigned long long mw[4];
#define AT_LOAD(i, kt) do { const size_t kr = (size_t)b * SEQ + 64 * (kt) + key_l; kreg[i] = *(const u32x4*)(KA + kr * 512 + h * 64 + 8 * c8); vreg[i] = *(const u32x4*)(VA + kr * 512 + h * 64 + 8 * c8); \
        mw[i] = MASK[qrow * 64 + (kt)]; } while (0)
#pragma unroll
    for (int i = 0; i < 4; ++i) AT_LOAD(i, i);
#pragma unroll 1
    for (int kt4 = 0; kt4 < NT; kt4 += 4) {
#pragma unroll
      for (int i = 0; i < 4; ++i) {
        const int kt = kt4 + i;
        unsigned char* buf = lds + (i & 1) * BUF;
        *(u32x4*)(buf + key_l * KP + 16 * c8) = kreg[i];
#pragma unroll
        for (int e = 0; e < 4; ++e) { const unsigned w = vreg[i][e]; const int d = 8 * c8 + 2 * e;
            *(unsigned short*)(buf + KS_BYTES + d * KP + 2 * key_l) = (unsigned short)(w & 0xffffu); *(unsigned short*)(buf + KS_BYTES + (d + 1) * KP + 2 * key_l) = (unsigned short)(w >> 16); }
        const unsigned long long mcur = mw[i];
        if (kt + 4 < NT) AT_LOAD(i, kt + 4);
        __syncthreads();
        if (64 * kt <= q0 + 32 * wave + 31) {
            f32x16 p0, p1;
#pragma unroll
            for (int r = 0; r < 16; ++r) { p0[r] = 0.f; p1[r] = 0.f; }
#pragma unroll
            for (int d0 = 0; d0 < 4; ++d0) {
                const bf16x8 a0 = *(const bf16x8*)(buf + r32 * KP + 32 * d0 + 16 * hi);
                const bf16x8 a1 = *(const bf16x8*)(buf + (32 + r32) * KP + 32 * d0 + 16 * hi);
                p0 = mfma32(a0, qf[d0], p0); p1 = mfma32(a1, qf[d0], p1);
            }
            const unsigned wl = (unsigned)mcur >> (4 * hi), wh = (unsigned)(mcur >> 32) >> (4 * hi);
#pragma unroll
            for (int r = 0; r < 16; ++r) { const int bp = (r & 3) + 8 * (r >> 2);
                const unsigned m0 = (unsigned)((int)(wl << (31 - bp)) >> 31), m1 = (unsigned)((int)(wh << (31 - bp)) >> 31);
                p0[r] = __uint_as_float((__float_as_uint(p0[r]) & m0) | (0xff800000u & ~m0)); p1[r] = __uint_as_float((__float_as_uint(p1[r]) & m1) | (0xff800000u & ~m1)); }
            float mx;
            { float a = amax3(p0[0], p0[1], p1[0]), bq = amax3(p0[2], p0[3], p1[1]); a = amax3(a, p1[2], p1[3]);
#pragma unroll
              for (int r = 4; r < 16; r += 4) { a = amax3(a, p0[r], p0[r + 1]); bq = amax3(bq, p0[r + 2], p0[r + 3]); a = amax3(a, p1[r], p1[r + 1]); bq = amax3(bq, p1[r + 2], p1[r + 3]); }
              mx = amax3(a, bq, bq); }
            mx = amax3(mx, __shfl_xor(mx, 32), mx);
            const float m_new = amax3(m_run, mx, mx);
            const float m_use = (m_new == NEG_INF) ? 0.f : m_new;
            const float alpha = fast_exp2(m_run - m_use);
            m_run = m_new;
            float ps = 0.f;
#pragma unroll
            for (int r = 0; r < 16; ++r) { p0[r] = fast_exp2(p0[r] - m_use); p1[r] = fast_exp2(p1[r] - m_use); ps += p0[r] + p1[r]; }
            l_run = l_run * alpha + ps;
            if (__any(alpha != 1.0f)) {
#pragma unroll
                for (int r = 0; r < 16; ++r) { o0[r] *= alpha; o1[r] *= alpha; }
            }
#pragma unroll
            for (int s4 = 0; s4 < 4; ++s4) {
                const int rb = 8 * (s4 & 1);
                u32x4 pw;
                if (s4 < 2) { pw.x = pk2(p0[rb], p0[rb + 1]); pw.y = pk2(p0[rb + 2], p0[rb + 3]); pw.z = pk2(p0[rb + 4], p0[rb + 5]); pw.w = pk2(p0[rb + 6], p0[rb + 7]); }
                else        { pw.x = pk2(p1[rb], p1[rb + 1]); pw.y = pk2(p1[rb + 2], p1[rb + 3]); pw.z = pk2(p1[rb + 4], p1[rb + 5]); pw.w = pk2(p1[rb + 6], p1[rb + 7]); }
                const bf16x8 bfr = __builtin_bit_cast(bf16x8, pw);
                { const unsigned char* vp = buf + KS_BYTES + r32 * KP + 2 * (16 * s4 + 4 * hi);
                  const u32x2 lo = *(const u32x2*)vp, h2 = *(const u32x2*)(vp + 16); const u32x4 av = (u32x4){lo.x, lo.y, h2.x, h2.y};
                  o0 = mfma32(__builtin_bit_cast(bf16x8, av), bfr, o0); }
                { const unsigned char* vp = buf + KS_BYTES + (32 + r32) * KP + 2 * (16 * s4 + 4 * hi);
                  const u32x2 lo = *(const u32x2*)vp, h2 = *(const u32x2*)(vp + 16); const u32x4 av = (u32x4){lo.x, lo.y, h2.x, h2.y};
                  o1 = mfma32(__builtin_bit_cast(bf16x8, av), bfr, o1); }
            }
        }
      }
    }
#undef AT_LOAD
    l_run += __shfl_xor(l_run, 32);
#ifdef DBG_NOATT
    const float inv = 0.f;
#else
    const float inv = 1.0f / l_run;
#endif
    bf16_t* op = AR + qrow * 1024 + h * 64 + 4 * hi;
#pragma unroll
    for (int c = 0; c < 4; ++c) {
        u32x2 w; w.x = pk2(o0[4 * c] * inv, o0[4 * c + 1] * inv); w.y = pk2(o0[4 * c + 2] * inv, o0[4 * c + 3] * inv); *(u32x2*)(op + 8 * c) = w;
        u32x2 v; v.x = pk2(o1[4 * c] * inv, o1[4 * c + 1] * inv); v.y = pk2(o1[4 * c + 2] * inv, o1[4 * c + 3] * inv); *(u32x2*)(op + 32 + 8 * c) = v;
    }
    __syncthreads();
}

__device__ __forceinline__ void ret_out_unit(int b, int h, int n, const bf16_t* QR, const bf16_t* KR, const bf16_t* VR, const bf16_t* GR, const bf16_t* STATE, bf16_t* AR,
                                             unsigned char* lds, int tid, int wave, int lane) {
    constexpr int PT = 272;
    const size_t c0 = (size_t)b * SEQ + 128 * n; const int hc = 128 * h;
    const int ln = lane & 15, g = lane >> 4;
    const size_t qrow = c0 + 16 * wave + ln;
    u32x4 rr[4];
    { const int j = tid & 127, vq = tid >> 7; const u32x4* p = (const u32x4*)(VR + (c0 + j) * 512 + hc + 32 * vq); rr[0] = p[0]; rr[1] = p[1]; rr[2] = p[2]; rr[3] = p[3]; }
    bf16x8 qf[4];
#pragma unroll
    for (int ks = 0; ks < 4; ++ks) qf[ks] = *(const bf16x8*)(QR + qrow * 512 + hc + 32 * ks + 8 * g);
    bf16x8 kf[8][4];
#pragma unroll
    for (int jt = 0; jt < 8; ++jt) if (jt <= wave) { const bf16_t* kp = KR + (c0 + 16 * jt + ln) * 512 + hc + 8 * g;
#pragma unroll
        for (int ks = 0; ks < 4; ++ks) kf[jt][ks] = *(const bf16x8*)(kp + 32 * ks); }
    u32x2 gw[8];
#pragma unroll
    for (int vt = 0; vt < 8; ++vt) gw[vt] = *(const u32x2*)(GR + qrow * 512 + hc + 16 * vt + 4 * g);
    { const int j = tid & 127, vq = tid >> 7;
#pragma unroll
      for (int i = 0; i < 4; ++i)
#pragma unroll
          for (int e = 0; e < 4; ++e) { const unsigned w = rr[i][e]; const int v = 32 * vq + 8 * i + 2 * e;
              *(unsigned short*)(lds + v * PT + 2 * j) = (unsigned short)(w & 0xffffu); *(unsigned short*)(lds + (v + 1) * PT + 2 * j) = (unsigned short)(w >> 16); } }
    __syncthreads();
    f32x4 sT[8];
#pragma unroll
    for (int jt = 0; jt < 8; ++jt) {
        f32x4 d = (f32x4){0.f, 0.f, 0.f, 0.f};
        if (jt <= wave) {
#pragma unroll
            for (int ks = 0; ks < 4; ++ks) d = mfma16(kf[jt][ks], qf[ks], d);
            if (jt == wave) {
#pragma unroll
                for (int r = 0; r < 4; ++r) if (4 * g + r > ln) d[r] = 0.f;
            }
        }
        sT[jt] = d;
    }
    f32x4 oT[8];
    const bf16_t* stp = STATE + (((size_t)b * 4 + h) * 32 + n) * 16384;
#pragma unroll
    for (int vt = 0; vt < 8; ++vt) {
        f32x4 d = (f32x4){0.f, 0.f, 0.f, 0.f};
#pragma unroll
        for (int ks = 0; ks < 4; ++ks) d = mfma16(*(const bf16x8*)(stp + (16 * vt + ln) * 128 + 32 * ks + 8 * g), qf[ks], d);
        oT[vt] = d;
    }
#pragma unroll
    for (int pr = 0; pr < 4; ++pr) if (2 * pr <= wave) {
        u32x4 pw; pw.x = pk2(sT[2 * pr][0], sT[2 * pr][1]); pw.y = pk2(sT[2 * pr][2], sT[2 * pr][3]); pw.z = pk2(sT[2 * pr + 1][0], sT[2 * pr + 1][1]); pw.w = pk2(sT[2 * pr + 1][2], sT[2 * pr + 1][3]);
        const bf16x8 bfr = __builtin_bit_cast(bf16x8, pw);
#pragma unroll
        for (int vt = 0; vt < 8; ++vt) {
            const unsigned char* vp = lds + (16 * vt + ln) * PT + 2 * (32 * pr + 4 * g);
            const u32x2 lo = *(const u32x2*)vp, h2 = *(const u32x2*)(vp + 32); const u32x4 av = (u32x4){lo.x, lo.y, h2.x, h2.y};
            oT[vt] = mfma16(__builtin_bit_cast(bf16x8, av), bfr, oT[vt]);
        }
    }
    float s = 0.f;
#pragma unroll
    for (int vt = 0; vt < 8; ++vt) s += (oT[vt][0] + oT[vt][1]) + (oT[vt][2] + oT[vt][3]);
    s += __shfl_xor(s, 16); s += __shfl_xor(s, 32);
    const float mean = s * (1.0f / 128.0f);
    float q = 0.f;
#pragma unroll
    for (int vt = 0; vt < 8; ++vt)
#pragma unroll
        for (int r = 0; r < 4; ++r) { const float d = oT[vt][r] - mean; q += d * d; }
    q += __shfl_xor(q, 16); q += __shfl_xor(q, 32);
    const float rstd = 1.0f / sqrtf(q * (1.0f / 128.0f) + EPS);
#pragma unroll
    for (int vt = 0; vt < 8; ++vt) {
        const float y0 = (oT[vt][0] - mean) * rstd * bf_lo(gw[vt].x), y1 = (oT[vt][1] - mean) * rstd * bf_hi(gw[vt].x);
        const float y2 = (oT[vt][2] - mean) * rstd * bf_lo(gw[vt].y), y3 = (oT[vt][3] - mean) * rstd * bf_hi(gw[vt].y);
        u32x2 w; w.x = pk2(y0, y1); w.y = pk2(y2, y3);
        *(u32x2*)(AR + qrow * 1024 + 512 + hc + 16 * vt + 4 * g) = w;
    }
    __syncthreads();
}

template <int N> __device__ __forceinline__ void bitonic_sort_desc(unsigned (&a)[N]) {
#pragma unroll
    for (int k = 2; k <= N; k <<= 1)
#pragma unroll
        for (int j = k >> 1; j > 0; j >>= 1)
#pragma unroll
            for (int i = 0; i < N; ++i) { const int l = i ^ j;
                if (l > i) { const unsigned x = a[i], y = a[l]; const unsigned mx = x > y ? x : y, mn = x > y ? y : x;
                    if ((i & k) == 0) { a[i] = mx; a[l] = mn; } else { a[i] = mn; a[l] = mx; } } }
}
template <int N> __device__ __forceinline__ void bitonic_merge_desc(unsigned (&a)[N]) {
#pragma unroll
    for (int j = N >> 1; j > 0; j >>= 1)
#pragma unroll
        for (int i = 0; i < N; ++i) { const int l = i ^ j;
            if (l > i) { const unsigned x = a[i], y = a[l]; a[i] = x > y ? x : y; a[l] = x > y ? y : x; } }
}
__device__ __forceinline__ void top16_merge(unsigned (&best)[16], const unsigned (&grp)[16]) {
#pragma unroll
    for (int i = 0; i < 16; ++i) { const unsigned x = best[i], y = grp[15 - i]; best[i] = x > y ? x : y; }
    bitonic_merge_desc<16>(best);
}
struct CandTab { int a[64], b[64], n; constexpr CandTab() : a{}, b{}, n(0) { for (int x = 0; x < 16; ++x) for (int y = 0; y < 16; ++y) if ((x + 1) * (y + 1) <= 16) { a[n] = x; b[n] = y; ++n; } } };
constexpr CandTab kCand{};
static_assert(kCand.n == 50, "staircase candidates");

constexpr int PL_EID = 0, PL_GATE = 16384, PL_IDX = 32768;
__device__ __forceinline__ void peer_unit(int unit, unsigned char* ws, float* outp, const float* gffn, const float* gfin, unsigned char* lds, int tid, int wave, int lane) {
    volatile LAS unsigned* MISC = (volatile LAS unsigned*)((LAS unsigned char*)lds + MISC_OFF); const int bid = unit;
    TSTAMP(70, 0);
    const float* SC = (const float*)(ws + WS_SC);
    const float* mod = (const float*)(ws + WS_MOD);
#ifndef DBG_NOPEER
    {
        const int tl = tid >> 4, h = (tid >> 1) & 7, p = tid & 1;
        const size_t row = (size_t)32 * unit + tl;
        const f32x4* sp = (const f32x4*)(SC + row * 2048 + h * 256 + p * 128);
        unsigned best[16];
#pragma unroll
        for (int grp = 0; grp < 8; ++grp) {
            unsigned k[16];
#pragma unroll
            for (int q4 = 0; q4 < 4; ++q4) { const f32x4 v = sp[4 * grp + q4];
#pragma unroll
                for (int e = 0; e < 4; ++e) k[4 * q4 + e] = (sortable32(v[e]) & ~127u) | (unsigned)(127 - (16 * grp + 4 * q4 + e)); }
            bitonic_sort_desc<16>(k);
            if (grp == 0) {
#pragma unroll
                for (int i = 0; i < 16; ++i) best[i] = k[i];
            } else top16_merge(best, k);
        }
        unsigned char* il = lds + PL_IDX + (tl * 8 + h) * 32;
#pragma unroll
        for (int i = 0; i < 4; ++i) { unsigned w = 0;
#pragma unroll
            for (int e = 0; e < 4; ++e) w |= (127u - (best[4 * i + e] & 127u)) << (8 * e);
            *(unsigned*)(il + p * 16 + 4 * i) = w; }
        float v1[16], v2[16];
#pragma unroll
        for (int i = 0; i < 16; ++i) { const unsigned o = __shfl_xor(best[i], 1); const float mine = unsortable32(best[i] & ~127u), oth = unsortable32(o & ~127u);
            v1[i] = p ? oth : mine; v2[i] = p ? mine : oth; }
        unsigned top[16];
#pragma unroll
        for (int grp = 0; grp < 4; ++grp) {
            unsigned k[16];
#pragma unroll
            for (int i = 0; i < 16; ++i) { const int c = 16 * grp + i;
                k[i] = (c < kCand.n) ? ((sortable32(v1[kCand.a[c < kCand.n ? c : 0]] + v2[kCand.b[c < kCand.n ? c : 0]]) & ~255u) | (unsigned)(255 - (16 * kCand.a[c < kCand.n ? c : 0] + kCand.b[c < kCand.n ? c : 0]))) : 0u; }
            bitonic_sort_desc<16>(k);
            if (grp == 0) {
#pragma unroll
                for (int i = 0; i < 16; ++i) top[i] = k[i];
            } else top16_merge(top, k);
        }
        float ts[16], es[16], sum = 0.f;
#pragma unroll
        for (int i = 0; i < 16; ++i) ts[i] = unsortable32(top[i] & ~255u);
#pragma unroll
        for (int i = 0; i < 16; ++i) { es[i] = __expf(ts[i] - ts[0]); sum += es[i]; }
        const float rs = 1.0f / sum;
        __builtin_amdgcn_wave_barrier(); asm volatile("s_waitcnt lgkmcnt(0)" ::: "memory");
        unsigned* eo = (unsigned*)(lds + PL_EID) + tl * 128 + h * 16;
        float* go = (float*)(lds + PL_GATE) + tl * 128 + h * 16;
#pragma unroll
        for (int i = 0; i < 16; ++i) {
            const unsigned flat = 255u - (top[i] & 255u);
            const unsigned i1 = il[flat >> 4], i2 = il[16 + (flat & 15u)];
            eo[i] = i1 * 128u + i2; go[i] = es[i] * rs;
        }
    }
#endif
    __syncthreads();
    TSTAMP(70, 2); TSTAMP(71, 0);
    const unsigned char* U8 = ws + WS_U8; const unsigned char* V8 = ws + WS_V8;
    const float* USC = (const float*)(ws + WS_USC); const float* VSC = (const float*)(ws + WS_VSC);
    const int me = ((lane >> 5) & 1) * 4 + ((lane >> 4) & 1) * 2 + ((lane >> 3) & 1);
#pragma unroll 1
    for (int ti = 0; ti < 4; ++ti) {
        const int tl = wave + 8 * ti; const size_t row = (size_t)32 * unit + tl; const int b = (int)(row >> 12);
        const float* mb = mod + b * 6144;
        float x1v[16], hv[16], acc[16];
        const float rstd = pg8::row_rstd((const float*)(ws + WS_SUMSQ), (int)row);
#pragma unroll
        for (int q4 = 0; q4 < 4; ++q4) { const int c = 16 * lane + 4 * q4;
            const f32x4 xv = *(const f32x4*)(outp + row * DM + c), g = *(const f32x4*)(gffn + c), sc = *(const f32x4*)(mb + 4096 + c), sh = *(const f32x4*)(mb + 3072 + c);
#pragma unroll
            for (int e = 0; e < 4; ++e) { const int i = 4 * q4 + e; x1v[i] = xv[e]; hv[i] = xv[e] * rstd * g[e] * (1.0f + sc[e]) + sh[e]; acc[i] = 0.f; } }
        const unsigned* el = (const unsigned*)(lds + PL_EID) + tl * 128; const float* gl = (const float*)(lds + PL_GATE) + tl * 128;
        u32x4 uA[8], vA[8]; float guA, gvA;
#define PEER_LOAD(U_, V_, GU_, GV_, e0_) do { _Pragma("unroll") for (int k = 0; k < 8; ++k) { const unsigned eid = el[(e0_) + k]; \
            U_[k] = *((const u32x4*)(U8 + (size_t)eid * 1024) + lane); V_[k] = *((const u32x4*)(V8 + (size_t)eid * 1024) + lane); } \
        { const unsigned em = el[(e0_) + me]; GU_ = USC[em]; GV_ = VSC[em] * gl[(e0_) + me]; } } while (0)
#define PEER_COMP(U_, V_, GU_, GV_) do { float pd[8]; \
        _Pragma("unroll") for (int k = 0; k < 8; ++k) { float d = 0.f; \
            _Pragma("unroll") for (int i = 0; i < 4; ++i) { const f32x2 lo = __builtin_amdgcn_cvt_pk_f32_fp8(U_[k][i], false), hi2 = __builtin_amdgcn_cvt_pk_f32_fp8(U_[k][i], true); \
                d += hv[4 * i] * lo.x; d += hv[4 * i + 1] * lo.y; d += hv[4 * i + 2] * hi2.x; d += hv[4 * i + 3] * hi2.y; } \
            pd[k] = d; } \
        float q4_[4], r2_[2], s_; \
        _Pragma("unroll") for (int k = 0; k < 4; ++k) { const float keep = (lane & 32) ? pd[k + 4] : pd[k], send = (lane & 32) ? pd[k] : pd[k + 4]; q4_[k] = keep + __shfl_xor(send, 32); } \
        _Pragma("unroll") for (int k = 0; k < 2; ++k) { const float keep = (lane & 16) ? q4_[k + 2] : q4_[k], send = (lane & 16) ? q4_[k] : q4_[k + 2]; r2_[k] = keep + __shfl_xor(send, 16); } \
        { const float keep = (lane & 8) ? r2_[1] : r2_[0], send = (lane & 8) ? r2_[0] : r2_[1]; s_ = keep + __shfl_xor(send, 8); } \
        s_ += __shfl_xor(s_, 4); s_ += __shfl_xor(s_, 2); s_ += __shfl_xor(s_, 1); \
        const float cf_ = GV_ * gelu_exact(s_ * GU_); \
        _Pragma("unroll") for (int k = 0; k < 8; ++k) { const float c = __uint_as_float((unsigned)__builtin_amdgcn_readlane((int)__float_as_uint(cf_), 32 * (k >> 2) + 16 * ((k >> 1) & 1) + 8 * (k & 1))); \
            _Pragma("unroll") for (int i = 0; i < 4; ++i) { const f32x2 lo = __builtin_amdgcn_cvt_pk_f32_fp8(V_[k][i], false), hi2 = __builtin_amdgcn_cvt_pk_f32_fp8(V_[k][i], true); \
                acc[4 * i] += c * lo.x; acc[4 * i + 1] += c * lo.y; acc[4 * i + 2] += c * hi2.x; acc[4 * i + 3] += c * hi2.y; } } } while (0)
#pragma unroll 1
        for (int e0 = 0; e0 < 128; e0 += 8) {
            PEER_LOAD(uA, vA, guA, gvA, e0);
            PEER_COMP(uA, vA, guA, gvA);
        }
#undef PEER_LOAD
#undef PEER_COMP
        float ss = 0.f;
#pragma unroll
        for (int q4 = 0; q4 < 4; ++q4) { const int c = 16 * lane + 4 * q4; const f32x4 gf = *(const f32x4*)(mb + 5120 + c);
#pragma unroll
            for (int e = 0; e < 4; ++e) { const int i = 4 * q4 + e; x1v[i] = x1v[i] + gf[e] * acc[i]; ss += x1v[i] * x1v[i]; } }
        const float r2 = 1.0f / sqrtf(wave_sum(ss) * (1.0f / DM) + EPS);
#pragma unroll
        for (int q4 = 0; q4 < 4; ++q4) { const int c = 16 * lane + 4 * q4; const f32x4 gn = *(const f32x4*)(gfin + c);
            f32x4 o;
#pragma unroll
            for (int e = 0; e < 4; ++e) o[e] = x1v[4 * q4 + e] * r2 * gn[e];
            *(f32x4*)(outp + row * DM + c) = o; }
    }
    __syncthreads();
    TSTAMP(71, 2);
}

#define XB_TMO      128
#define XB_XCNT(j)  (256  + 64 * (j))
#define XB_XSUB(j)  (1280 + 64 * (j))
#define XB_XGEN(j)  (2304 + 64 * (j))
#define XB_TOP      3328
#define XB_TOPGEN   3392
#define XCD_BAR_WORDS 3456
#define XB_SPIN_CAP (1u << 18)

__device__ __forceinline__ unsigned xb_ld(unsigned* p)              { return __hip_atomic_load(p, __ATOMIC_RELAXED, __HIP_MEMORY_SCOPE_AGENT); }
__device__ __forceinline__ unsigned xb_add(unsigned* p, unsigned v) { return __hip_atomic_fetch_add(p, v, __ATOMIC_RELAXED, __HIP_MEMORY_SCOPE_AGENT); }
__device__ __forceinline__ unsigned xb_xcc_id() { return (unsigned)__builtin_amdgcn_s_getreg((3 << 11) | 20) & 0xFu; }
#define XB_SPIN(cond, bar) do { unsigned _sp = 0; while (cond) { __builtin_amdgcn_s_sleep(1); \
    if ((++_sp & 255u) == 0u) { if (xb_ld(&(bar)[XB_TMO])) break; if (_sp > XB_SPIN_CAP) { atomicAdd(&(bar)[XB_TMO], 1u); break; } } } } while (0)

struct XcdBarrier {
    unsigned* bar; unsigned x;
    volatile LAS unsigned* st;
};

__device__ __forceinline__ XcdBarrier xcd_barrier_post(unsigned* bar, volatile LAS unsigned* st) {
    XcdBarrier b; b.bar = bar; b.x = xb_xcc_id(); b.st = st;
    if (threadIdx.x == 0) (void)xb_add(&bar[XB_XCNT(b.x)], 1u);
    return b;
}
__device__ __forceinline__ void xcd_barrier_complete(unsigned* bar, unsigned x, unsigned& nloc, unsigned& nx) {
    const unsigned G = gridDim.x * gridDim.y * gridDim.z;
    unsigned sum, cnt, mine, sp = 0u;
    for (;;) {
        sum = 0u; cnt = 0u; mine = 0u;
#pragma unroll
        for (unsigned j = 0; j < 16; ++j) { const unsigned c = xb_ld(&bar[XB_XCNT(j)]); sum += c; cnt += (c > 0u) ? 1u : 0u; mine = (j == x) ? c : mine; }
        if (sum == G) break;
        __builtin_amdgcn_s_sleep(1);
        if ((++sp & 255u) == 0u) { if (xb_ld(&bar[XB_TMO])) break; if (sp > XB_SPIN_CAP) { atomicAdd(&bar[XB_TMO], 1u); break; } }
    }
    nloc = mine > 0u ? mine : 1u; nx = cnt > 0u ? cnt : 1u;
}

__device__ __forceinline__ void xcd_barrier(const XcdBarrier& b) {
    asm volatile("s_waitcnt vmcnt(0)" ::: "memory");
    __syncthreads();
    if (threadIdx.x == 0) {
        unsigned* bar = b.bar;
        __builtin_amdgcn_s_waitcnt(0);
        unsigned nloc = b.st[0], nx = b.st[1];
        if (nloc == 0u) { xcd_barrier_complete(bar, b.x, nloc, nx); b.st[0] = nloc; b.st[1] = nx; }
        const unsigned old = xb_add(&bar[XB_XSUB(b.x)], 1u);
        const unsigned gen = old / nloc;
        if (old + 1u == (gen + 1u) * nloc) {
            __builtin_amdgcn_fence(__ATOMIC_RELEASE, "agent");
            asm volatile("s_waitcnt vmcnt(0)" ::: "memory");
            const unsigned og = xb_add(&bar[XB_TOP], 1u);
            const unsigned tg = og / nx;
            if (og + 1u == (tg + 1u) * nx) xb_add(&bar[XB_TOPGEN], 1u);
            else XB_SPIN(xb_ld(&bar[XB_TOPGEN]) == tg, bar);
            __builtin_amdgcn_fence(__ATOMIC_ACQUIRE, "agent");
            xb_add(&bar[XB_XGEN(b.x)], 1u);
            asm volatile("s_waitcnt vmcnt(0)" ::: "memory");
        } else {
            XB_SPIN(xb_ld(&bar[XB_XGEN(b.x)]) == gen, bar);
            __builtin_amdgcn_fence(__ATOMIC_ACQUIRE, "agent");
            asm volatile("s_waitcnt vmcnt(0)" ::: "memory");
        }
    }
    __syncthreads();
}

constexpr int N_PHASES = 8;
__global__ void __launch_bounds__(NTHREADS, 2) mega(Args a) {
    extern __shared__ __attribute__((aligned(16))) unsigned char lds[];
    const int tid = threadIdx.x, lane = tid & 63, wave = __builtin_amdgcn_readfirstlane(tid >> 6);
    const int bid = blockIdx.x, G = gridDim.x;
    unsigned char* ws = a.ws;
    const int lo = a.ph_lo, hi = a.ph_hi;
    volatile LAS unsigned* MISC = (volatile LAS unsigned*)((LAS unsigned char*)lds + MISC_OFF);
    if (tid < 16) MISC[tid] = 0u;
    __syncthreads();
    XcdBarrier bar; bar.bar = (unsigned*)(ws + WS_CTL) + CW_BAR; bar.x = 0; bar.st = nullptr;
    if (hi - lo > 1) bar = xcd_barrier_post((unsigned*)(ws + WS_CTL) + CW_BAR, MISC + 8);
#ifndef PH_MASK
#define PH_MASK 0xFF
#endif
#define IN(k) (((PH_MASK >> (k)) & 1) && lo <= (k) && (k) < hi)
#define SEAM(k) do { if (IN(k) && IN((k) + 1)) { xcd_barrier(bar); } } while (0)
#ifdef REP_PH
#ifndef REP_N
#define REP_N 1
#endif
#define REPS(k) for (int rep_ = 0; rep_ < ((k) == REP_PH ? 1 + REP_N : 1); ++rep_, ((k) == REP_PH && rep_ <= REP_N ? (xcd_barrier(bar), 0) : 0))
#else
#define REPS(k)
#endif

    TSTAMP(100, 0);
    TSTAMP(0, 0);
    REPS(0) if (IN(0)) phase0(a, lds, tid, wave, lane, bid, G);
    SEAM(0);
    TSTAMP(0, 2);
    TSTAMP(1, 0);
    REPS(1) if (IN(1)) phase1(a, wave, lane, bid, G);
    SEAM(1);
    TSTAMP(1, 2);
    TSTAMP(2, 0);
    REPS(2) if (IN(2)) {
        pg8::Gemm g{(const bf16_t*)(ws + WS_BUFA), (const bf16_t*)(ws + WS_WIN), MTOK, N1, DM}; pg8::StaticOrder S; S.init(MTOK, N1, G, bid);
        pg8::Epi1 E{ws};
        pg8::gemm_phase<pg8::Epi1, pg8::StaticOrder, true, true>((LAS unsigned char*)lds, g, S, E);
        const int nfull = (MTOK / 256) * (N1 / 256) - 4 * G;
        { const bool tail = nfull > 0 && nfull < G; const int cw = tail ? (bid - nfull) * 8 + wave : bid * 8 + wave, NCW = tail ? (G - nfull) * 8 : G * 8;
          if (!tail || bid >= nfull)
              for (int it = cw; it < 4096; it += NCW) { const int r = 4 * it;
                  rows_to_fp8<4>(a.in[11] + (size_t)r * 1024, ws + WS_V8 + (size_t)r * 1024, (float*)(ws + WS_VSC) + r, lane); } }
    }
    SEAM(2);
    TSTAMP(2, 2);
    TSTAMP(3, 0);
    REPS(3) if (IN(3)) {
        TSTAMP(30, 0);
        for (int u = bid; u < 256; u += G)
            ret_state_unit(u >> 6, (u >> 4) & 3, (u >> 1) & 7, u & 1, (const bf16_t*)(ws + WS_KR), (const bf16_t*)(ws + WS_VR), (bf16_t*)(ws + WS_STATE), lds, tid, wave, lane);
        TSTAMP(30, 2); TSTAMP(31, 0);
        for (int k = bid; k < 256; k += G)
#pragma unroll 1
            for (int i = 0; i < 4; ++i) {
                const int b = i, qt = (i < 2) ? k : 255 - k;
                idx_unit(b, qt, (const bf16_t*)(ws + WS_QI), (const bf16_t*)(ws + WS_KI), (const float*)(ws + WS_WI), (unsigned long long*)(ws + WS_MASK), lds, wave, lane, bid == TPROBE_B && i == TPROBE_I);
            }
        TSTAMP(31, 2);
    }
    SEAM(3);
    TSTAMP(3, 2);
    TSTAMP(4, 0);
    REPS(4) if (IN(4)) {
        TSTAMP(40, 0);
        for (int k = bid; k < 256; k += G) {
            const int bh = k >> 3, s = k & 7;
#pragma unroll 1
            for (int i = 0; i < 2; ++i)
                attn_unit(bh >> 3, bh & 7, i ? 15 - s : s, (const bf16_t*)(ws + WS_QA), (const bf16_t*)(ws + WS_KA), (const bf16_t*)(ws + WS_VA), (const unsigned long long*)(ws + WS_MASK),
                          (bf16_t*)(ws + WS_BUFB), lds, tid, wave, lane);
        }
        TSTAMP(40, 2); TSTAMP(41, 0);
        for (int u = bid; u < 512; u += G)
            ret_out_unit(u >> 7, (u >> 5) & 3, u & 31, (const bf16_t*)(ws + WS_QR), (const bf16_t*)(ws + WS_KR), (const bf16_t*)(ws + WS_VR), (const bf16_t*)(ws + WS_GR),
                         (const bf16_t*)(ws + WS_STATE), (bf16_t*)(ws + WS_BUFB), lds, tid, wave, lane);
        TSTAMP(41, 2);
    }
    SEAM(4);
    TSTAMP(4, 2);
    TSTAMP(5, 0);
    REPS(5) if (IN(5)) {
        pg8::Gemm g{(const bf16_t*)(ws + WS_BUFB), (const bf16_t*)(ws + WS_WOUT), MTOK, DM, DM}; pg8::StaticOrder S; S.init(MTOK, DM, G, bid);
        pg8::Epi2 E{a.in[0], a.out, (bf16_t*)(ws + WS_BUFA), (const float*)(ws + WS_MOD), a.in[7], (float*)(ws + WS_SUMSQ)};
        pg8::gemm_phase<pg8::Epi2, pg8::StaticOrder, true, true>((LAS unsigned char*)lds, g, S, E);
    }
    SEAM(5);
    TSTAMP(5, 2);
    TSTAMP(6, 0);
    REPS(6) if (IN(6)) {
        pg8::Gemm g{(const bf16_t*)(ws + WS_BUFA), (const bf16_t*)(ws + WS_WPQ), MTOK, 2048, DM}; pg8::StaticOrder S; S.init(MTOK, 2048, G, bid);
        pg8::Epi3 E{(const float*)(ws + WS_SUMSQ), (const float*)(ws + WS_BIASF), (float*)(ws + WS_SC)};
        pg8::gemm_phase<pg8::Epi3, pg8::StaticOrder, true, true>((LAS unsigned char*)lds, g, S, E);
    }
    SEAM(6);
    TSTAMP(6, 2);
    TSTAMP(7, 0);
    if (IN(7)) {
        for (int u = bid; u < 512; u += G) peer_unit(u, ws, a.out, a.in[7], a.in[12], lds, tid, wave, lane);
    }
    TSTAMP(7, 2);
    TSTAMP(100, 2);
#ifdef TIME_PH
    if (bid == TPROBE_B && tid == 0) {
        const unsigned long long t0_ = ((unsigned long long)MISC[1] << 32) | MISC[0], t1_ = ((unsigned long long)MISC[3] << 32) | MISC[2];
        const unsigned long long until_ = __builtin_amdgcn_s_memrealtime() + (unsigned long long)TIME_AMP * (t1_ - t0_);
        while (__builtin_amdgcn_s_memrealtime() < until_) __builtin_amdgcn_s_sleep(8);
    }
#endif
#undef IN
#undef SEAM
}

extern "C" void kernel_launch(void* const* d_in, const int* in_sizes, int n_in, void* d_out, int out_size, void* d_ws, size_t ws_size, hipStream_t stream) {
    static int grid = 0;
    if (grid == 0) {
        if (n_in != 13 || out_size != MTOK * DM || ws_size < WS_END) { fprintf(stderr, "kernel_launch: unexpected shapes (n_in %d, out %d, ws %zu); nothing launched\n", n_in, out_size, ws_size); grid = -1; return; }
        int dev = 0, cus = 0, per_cu = 0;
        if (hipGetDevice(&dev) != hipSuccess || hipDeviceGetAttribute(&cus, hipDeviceAttributeMultiprocessorCount, dev) != hipSuccess) { grid = -1; return; }
        if (hipFuncSetAttribute((const void*)mega, hipFuncAttributeMaxDynamicSharedMemorySize, LDS_BYTES) != hipSuccess) { fprintf(stderr, "kernel_launch: hipFuncSetAttribute failed\n"); grid = -1; return; }
        if (hipOccupancyMaxActiveBlocksPerMultiprocessor(&per_cu, (const void*)mega, NTHREADS, LDS_BYTES) != hipSuccess || per_cu < 1) { fprintf(stderr, "kernel_launch: occupancy query gave %d\n", per_cu); per_cu = 1; }
        (void)hipGetLastError();
        grid = cus;
    }
    if (grid < 0) return;
    if (hipMemsetAsync((char*)d_ws + WS_CTL, 0, CTL_BYTES, stream) != hipSuccess) { fprintf(stderr, "kernel_launch: memset failed\n"); return; }
    Args a{};
    for (int i = 0; i < 13; ++i) a.in[i] = (const float*)d_in[i];
    a.out = (float*)d_out; a.ws = (unsigned char*)d_ws;
#if MK_MULTI
    for (int p = 0; p < N_PHASES; ++p) { a.ph_lo = p; a.ph_hi = p + 1; hipLaunchKernelGGL(mega, dim3(grid), dim3(NTHREADS), LDS_BYTES, stream, a); }
#else
    a.ph_lo = 0; a.ph_hi = N_PHASES;
    hipLaunchKernelGGL(mega, dim3(grid), dim3(NTHREADS), LDS_BYTES, stream, a);
#endif
}
```

```cpp
#include <hip/hip_runtime.h>
#include <cstdio>
#include <cstdint>

#ifndef MK_MULTI
#define MK_MULTI 0
#endif

#define GAS __attribute__((address_space(1)))
#define LAS __attribute__((address_space(3)))
typedef unsigned short bf16_t;
typedef short bf16x8 __attribute__((ext_vector_type(8)));
typedef float f32x4 __attribute__((ext_vector_type(4)));
typedef float f32x16 __attribute__((ext_vector_type(16)));
typedef unsigned u32x4 __attribute__((ext_vector_type(4)));
typedef unsigned u32x2 __attribute__((ext_vector_type(2)));

constexpr int BATCH = 4, SEQ = 4096, DM = 1024, MTOK = BATCH * SEQ;
constexpr int N1 = 4352;
constexpr int NTHREADS = 512;
constexpr float EPS = 1e-6f;
constexpr float C_QK = 0.18033688011112042f;
constexpr float NEG_INF = -__builtin_huge_valf();

__device__ __forceinline__ float ret_log2g(int h) { return h == 0 ? -0.045803689613124791f : h == 1 ? -0.022720076500083530f : h == 2 ? -0.011315313227834147f : -0.0056465631411420624f; }
__device__ __forceinline__ float ret_gamma(int h) { return h == 0 ? 0.96875f : h == 1 ? 0.984375f : h == 2 ? 0.9921875f : 0.99609375f; }
__device__ __forceinline__ float ret_g128(int h) { return h == 0 ? 0.017183023570817902f : h == 1 ? 0.13321516287964842f : h == 2 ? 0.36643771592203725f : 0.60593708822908032f; }
__device__ __forceinline__ float ret_g127(int h) { return h == 0 ? 0.017737314653747512f : h == 1 ? 0.13532968927456347f : h == 2 ? 0.36932305226788007f : 0.60831331210448848f; }

constexpr size_t MiB = 1u << 20;
constexpr size_t WS_CTL = 0, CTL_BYTES = 1 * MiB;
constexpr size_t WS_SUMSQ = 5 * MiB;
constexpr size_t WS_MOD = 1 * MiB;
constexpr size_t WS_BIASF = 1 * MiB + 128 * 1024;
constexpr size_t WS_COSA = 2 * MiB, WS_SINA = 2 * MiB + 512 * 1024;
constexpr size_t WS_COSR = 3 * MiB, WS_SINR = 4 * MiB;
constexpr size_t WS_WIN = 6 * MiB;
constexpr size_t WS_WOUT = 15 * MiB;
constexpr size_t WS_WPQ = 17 * MiB;
constexpr size_t WS_BUFA = 22 * MiB;
constexpr size_t WS_MASK = WS_BUFA, WS_STATE = WS_BUFA + 8 * MiB;
constexpr size_t WS_BUFB = 54 * MiB;
constexpr size_t WS_G1 = 86 * MiB;
constexpr size_t WS_QA = WS_G1, WS_KA = WS_G1 + 16 * MiB, WS_VA = WS_G1 + 32 * MiB, WS_QI = WS_G1 + 48 * MiB, WS_QR = WS_G1 + 64 * MiB,
                 WS_KR = WS_G1 + 80 * MiB, WS_VR = WS_G1 + 96 * MiB, WS_GR = WS_G1 + 112 * MiB, WS_KI = WS_G1 + 128 * MiB, WS_WI = WS_G1 + 130 * MiB;
constexpr size_t WS_SC = WS_G1;
constexpr size_t WS_U8 = 217 * MiB, WS_V8 = 233 * MiB;
constexpr size_t WS_USC = 249 * MiB, WS_VSC = 249 * MiB + 65536;
constexpr size_t WS_END = 256 * MiB;
static_assert(WS_WI + (size_t)MTOK * 8 * 4 <= WS_U8 && WS_SC + (size_t)MTOK * 2048 * 4 <= WS_U8 && WS_VSC + 65536 <= WS_END, "ws map");
constexpr int LDS_BYTES = 147456;
constexpr int MISC_OFF = LDS_BYTES - 64;
constexpr int CW_BAR = 4096;

__device__ __forceinline__ unsigned f2bf(float f) { unsigned u = __float_as_uint(f); return (u + 0x7fffu + ((u >> 16) & 1u)) >> 16; }
typedef float f32x2_t __attribute__((ext_vector_type(2))); typedef __bf16 bf16x2_t __attribute__((ext_vector_type(2)));
__device__ __forceinline__ unsigned pk2(float lo, float hi) { const f32x2_t v = {lo, hi}; const bf16x2_t b = __builtin_convertvector(v, bf16x2_t); return __builtin_bit_cast(unsigned, b); }
__device__ __forceinline__ float bf_lo(unsigned w) { return __uint_as_float(w << 16); }
__device__ __forceinline__ float bf_hi(unsigned w) { return __uint_as_float(w & 0xffff0000u); }
__device__ __forceinline__ float wave_sum(float v) {
#pragma unroll
    for (int o = 1; o < 64; o <<= 1) v += __shfl_xor(v, o);
    return v;
}
__device__ __forceinline__ float fast_exp2(float x) { return __builtin_amdgcn_exp2f(x); }
__device__ __forceinline__ float gelu_exact(float v) {
    const float av = fabsf(v), t = __builtin_amdgcn_rcpf(av * 0.2316418882f + 1.0f);
    float q = t * 0.5307027145f + (-0.7265760135f); q = q * t + 0.7107068705f; q = q * t + (-0.142248368f); q = q * t + 0.127414796f; q = q * t;
    const float e = fast_exp2(v * v * (-0.72134752044f));
    const float m = v * (q * e);
    return v < 0.f ? m : v - m;
}
__device__ __forceinline__ float silu_f(float v) { return v / (1.0f + __expf(-v)); }
__device__ __forceinline__ unsigned sortable32(float f) { const unsigned u = __float_as_uint(f); return (u & 0x80000000u) ? ~u : (u | 0x80000000u); }
__device__ __forceinline__ float unsortable32(unsigned s) { return __uint_as_float((s & 0x80000000u) ? (s ^ 0x80000000u) : ~s); }
__device__ __forceinline__ unsigned sortable16(float x) {
    const _Float16 h = (_Float16)x; const unsigned b = (unsigned)__builtin_bit_cast(unsigned short, h);
    return (b & 0x8000u) ? (~b & 0xFFFFu) : (b | 0x8000u);
}
__device__ __forceinline__ f32x4 mfma16(bf16x8 a, bf16x8 b, f32x4 c) { return __builtin_amdgcn_mfma_f32_16x16x32_bf16(a, b, c, 0, 0, 0); }
__device__ __forceinline__ f32x16 mfma32(bf16x8 a, bf16x8 b, f32x16 c) { return __builtin_amdgcn_mfma_f32_32x32x16_bf16(a, b, c, 0, 0, 0); }

__host__ __device__ __forceinline__ int win_src_col(int p) {
    const int tile = p >> 8, bj = (p >> 7) & 1, q = p & 127;
    if (tile < 4) return 256 * tile + (q >> 5) * 64 + bj * 32 + (q & 31);
    if (tile < 6) return p;
    if (tile < 8) return 256 * tile + (q >> 5) * 64 + bj * 32 + (q & 31);
    if (tile == 8) { if (q < 32) return 2048 + bj * 32 + q; if (bj == 0 && q < 40) return 2112 + (q - 32); return -1; }
    if (tile < 13) { const int base = (tile < 11) ? 2120 + 256 * (tile - 9) : 2632 + 256 * (tile - 11); return base + (q >> 6) * 128 + bj * 64 + (q & 63); }
    if (tile < 15) return 3144 + (p - 13 * 256);
    return 3656 + (p - 15 * 256);
}
namespace pg8 {
#define PG8_LAS __attribute__((address_space(3)))
typedef unsigned short bf16_t;
typedef short bf16x8 __attribute__((ext_vector_type(8)));
typedef float f32x4 __attribute__((ext_vector_type(4)));
typedef unsigned u32x4 __attribute__((ext_vector_type(4)));
constexpr int BM = 256, BK = 64, HALF = 128, HTB = HALF * BK * 2  , STAGE_BYTES = 8 * HTB, NXCD = 8, WGM = 8;

__host__ __device__ __forceinline__ int lds_byte(int r, int c) { const int st = (r >> 4) * 2 + (c >> 5), rr = r & 15, cc = c & 31, ob = rr * 64 + cc * 2; return st * 1024 + (ob ^ (((ob >> 9) & 1) << 5)); }
__host__ __device__ __forceinline__ void stage_rc(int b, int& R, int& C) { const int st = b / 1024, sb = b % 1024, swz = sb ^ (((sb >> 9) & 1) << 5); R = (st >> 1) * 16 + swz / 64; C = (st & 1) * 32 + (swz % 64) / 2; }
__host__ __device__ __forceinline__ int perm32(int rho) { const int n = rho >> 4, i = rho & 15; return 8 * (i >> 2) + 4 * n + (i & 3); }

struct Unit { int pm, pn; };
struct Gemm { const bf16_t* A; const bf16_t* Bt; int M, N, K; };

struct StaticOrder {
    int nM, nN, nwg, G, c;
    __host__ __device__ void init(int M, int N, int G_, int c_) { nM = M / BM; nN = N / BM; nwg = nM * nN; G = G_; c = c_; }
    __host__ __device__ bool next(int i, Unit& u) const {
        const long L = (long)i * G + c; if (L >= nwg) return false;
        int wgid = (int)L; { const int q = nwg / NXCD, r = nwg % NXCD, xcd = wgid % NXCD, off = wgid / NXCD; wgid = (xcd < r ? xcd * (q + 1) : r * (q + 1) + (xcd - r) * q) + off; }
        const int nig = WGM * nN, gid = wgid / nig, fm = gid * WGM, gsz = (nM - fm) < WGM ? (nM - fm) : WGM;
        u.pm = fm + ((wgid % nig) % gsz); u.pn = (wgid % nig) / gsz; return true;
    }
    __device__ __forceinline__ void a_ready(const Unit&) const {}
    __device__ __forceinline__ void done(const Unit&) const {}
};

__device__ __forceinline__ unsigned cvt_pk_bf16(float lo, float hi) { unsigned r; asm volatile("v_cvt_pk_bf16_f32 %0, %1, %2" : "=v"(r) : "v"(lo), "v"(hi)); return r; }
__device__ __forceinline__ u32x4 pack8(const float (&v)[8]) { u32x4 w; w.x = cvt_pk_bf16(v[0], v[1]); w.y = cvt_pk_bf16(v[2], v[3]); w.z = cvt_pk_bf16(v[4], v[5]); w.w = cvt_pk_bf16(v[6], v[7]); return w; }

struct Epi1 {
    static constexpr bool PERM = true, AFTER_DRAIN = false;
    unsigned char* ws;
    __device__ __forceinline__ void operator()(const f32x4 (&acc)[2][2][4][2], const Unit& u, int wr, int wc, int fr, int fq) const {
        const int tile = u.pn;
        const int row0 = u.pm * BM + wr * 64 + fr;
        const float* cosA = (const float*)(ws + WS_COSA); const float* sinA = (const float*)(ws + WS_SINA);
        const float* cosR = (const float*)(ws + WS_COSR); const float* sinR = (const float*)(ws + WS_SINR);
        if (tile < 4 || tile == 6 || tile == 7) {
            bf16_t* dst = (bf16_t*)(ws + (tile < 2 ? WS_QA : tile < 4 ? WS_KA : WS_QI));
            const int tl = tile < 2 ? tile : tile < 4 ? tile - 2 : tile - 6;
            const float scale = tile < 2 ? C_QK : 1.0f;
            const int cb = 256 * tl + 64 * wc, i0 = 8 * fq;
#pragma unroll
            for (int ai = 0; ai < 2; ++ai)
#pragma unroll
                for (int m = 0; m < 4; ++m) {
                    const int row = row0 + ai * HALF + m * 16, pos = row & (SEQ - 1);
                    const f32x4 c0 = *(const f32x4*)(cosA + pos * 32 + i0), c1 = *(const f32x4*)(cosA + pos * 32 + i0 + 4);
                    const f32x4 s0 = *(const f32x4*)(sinA + pos * 32 + i0), s1 = *(const f32x4*)(sinA + pos * 32 + i0 + 4);
                    float y1[8], y2[8];
#pragma unroll
                    for (int n = 0; n < 2; ++n)
#pragma unroll
                        for (int e = 0; e < 4; ++e) {
                            const float x1 = acc[ai][0][m][n][e], x2 = acc[ai][1][m][n][e];
                            const float c = n ? c1[e] : c0[e], s = n ? s1[e] : s0[e];
                            y1[4 * n + e] = (x1 * c - x2 * s) * scale; y2[4 * n + e] = (x1 * s + x2 * c) * scale;
                        }
                    bf16_t* rp = dst + (size_t)row * 512 + cb + i0;
                    *(u32x4*)rp = pack8(y1); *(u32x4*)(rp + 32) = pack8(y2);
                }
        } else if (tile == 4 || tile == 5 || tile >= 13) {
            bf16_t* dst = (bf16_t*)(ws + (tile < 6 ? WS_VA : tile < 15 ? WS_VR : WS_GR));
            const int tl = tile < 6 ? tile - 4 : tile < 15 ? tile - 13 : tile - 15;
            const bool act = tile >= 15;
#pragma unroll
            for (int ai = 0; ai < 2; ++ai)
#pragma unroll
                for (int m = 0; m < 4; ++m) {
                    const int row = row0 + ai * HALF + m * 16;
#pragma unroll
                    for (int bj = 0; bj < 2; ++bj) {
                        float y[8];
#pragma unroll
                        for (int n = 0; n < 2; ++n)
#pragma unroll
                            for (int e = 0; e < 4; ++e) { const float v = acc[ai][bj][m][n][e]; y[4 * n + e] = act ? silu_f(v) : v; }
                        *(u32x4*)(dst + (size_t)row * 512 + 256 * tl + 128 * bj + 32 * wc + 8 * fq) = pack8(y);
                    }
                }
        } else if (tile == 8) {
#pragma unroll
            for (int ai = 0; ai < 2; ++ai)
#pragma unroll
                for (int m = 0; m < 4; ++m) {
                    const int row = row0 + ai * HALF + m * 16, pos = row & (SEQ - 1);
                    if (wc == 0) {
                        const int i0 = 8 * fq;
                        const f32x4 c0 = *(const f32x4*)(cosA + pos * 32 + i0), c1 = *(const f32x4*)(cosA + pos * 32 + i0 + 4);
                        const f32x4 s0 = *(const f32x4*)(sinA + pos * 32 + i0), s1 = *(const f32x4*)(sinA + pos * 32 + i0 + 4);
                        float y1[8], y2[8];
#pragma unroll
                        for (int n = 0; n < 2; ++n)
#pragma unroll
                            for (int e = 0; e < 4; ++e) {
                                const float x1 = acc[ai][0][m][n][e], x2 = acc[ai][1][m][n][e];
                                const float c = n ? c1[e] : c0[e], s = n ? s1[e] : s0[e];
                                y1[4 * n + e] = x1 * c - x2 * s; y2[4 * n + e] = x1 * s + x2 * c;
                            }
                        bf16_t* rp = (bf16_t*)(ws + WS_KI) + (size_t)row * 64 + i0;
                        *(u32x4*)rp = pack8(y1); *(u32x4*)(rp + 32) = pack8(y2);
                    } else if (wc == 1 && fq == 0) {
                        const float sw = 0.35355339059327379f;
                        float* WI = (float*)(ws + WS_WI);
                        *(f32x4*)(WI + (size_t)row * 8) = acc[ai][0][m][0] * sw;
                        *(f32x4*)(WI + (size_t)row * 8 + 4) = acc[ai][0][m][1] * sw;
                    }
                }
        } else {
            const bool isk = tile >= 11;
            bf16_t* dst = (bf16_t*)(ws + (isk ? WS_KR : WS_QR));
            const int tl = isk ? tile - 11 : tile - 9, hl = wc >> 1, h = 2 * tl + hl;
            const int i0 = 32 * (wc & 1) + 8 * fq, cb = 256 * tl + 128 * hl;
            const float lg = isk ? -ret_log2g(h) : ret_log2g(h);
            const float base = isk ? 0.08838834764831845f : 1.0f;
#pragma unroll
            for (int ai = 0; ai < 2; ++ai)
#pragma unroll
                for (int m = 0; m < 4; ++m) {
                    const int row = row0 + ai * HALF + m * 16, pos = row & (SEQ - 1);
                    const float dec = base * fast_exp2(lg * (float)(pos & 127));
                    const f32x4 c0 = *(const f32x4*)(cosR + pos * 64 + i0), c1 = *(const f32x4*)(cosR + pos * 64 + i0 + 4);
                    const f32x4 s0 = *(const f32x4*)(sinR + pos * 64 + i0), s1 = *(const f32x4*)(sinR + pos * 64 + i0 + 4);
                    float y1[8], y2[8];
#pragma unroll
                    for (int n = 0; n < 2; ++n)
#pragma unroll
                        for (int e = 0; e < 4; ++e) {
                            const float x1 = acc[ai][0][m][n][e], x2 = acc[ai][1][m][n][e];
                            const float c = n ? c1[e] : c0[e], s = n ? s1[e] : s0[e];
                            y1[4 * n + e] = (x1 * c - x2 * s) * dec; y2[4 * n + e] = (x1 * s + x2 * c) * dec;
                        }
                    bf16_t* rp = dst + (size_t)row * 512 + cb + i0;
                    *(u32x4*)rp = pack8(y1); *(u32x4*)(rp + 64) = pack8(y2);
                }
        }
    }
};

__device__ __forceinline__ float row_rstd(const float* sumsq, int row) {
    const f32x4* p = (const f32x4*)(sumsq + (size_t)row * 16);
    const f32x4 a = p[0], b = p[1], c = p[2], d = p[3];
    const float s = (((a[0] + a[1]) + (a[2] + a[3])) + ((b[0] + b[1]) + (b[2] + b[3]))) + (((c[0] + c[1]) + (c[2] + c[3])) + ((d[0] + d[1]) + (d[2] + d[3])));
    return 1.0f / sqrtf(s * (1.0f / DM) + EPS);
}
struct Epi2 {
    static constexpr bool PERM = false, AFTER_DRAIN = false;
    const float* x; float* x1; bf16_t* a3; const float* mod; const float* gffn; float* sumsq;
    __device__ __forceinline__ void operator()(const f32x4 (&acc)[2][2][4][2], const Unit& u, int wr, int wc, int fr, int fq) const {
        const int row0 = u.pm * BM + wr * 64 + fr, col0 = u.pn * BM + wc * 32 + 4 * fq;
#pragma unroll
        for (int ai = 0; ai < 2; ++ai)
#pragma unroll
            for (int m = 0; m < 4; ++m) {
                const int row = row0 + ai * HALF + m * 16, b = row >> 12;
                const float* mb = mod + b * 6144;
                float ss = 0.f;
#pragma unroll
                for (int bj = 0; bj < 2; ++bj)
#pragma unroll
                    for (int n = 0; n < 2; ++n) {
                        const int c = col0 + bj * HALF + n * 16;
                        const f32x4 xv = *(const f32x4*)(x + (size_t)row * DM + c), gt = *(const f32x4*)(mb + 2048 + c);
#ifdef DBG_NOMIX
                        const f32x4 v = xv;
#else
                        const f32x4 v = xv + gt * acc[ai][bj][m][n];
#endif
                        *(f32x4*)(x1 + (size_t)row * DM + c) = v;
                        ss += (v[0] * v[0] + v[1] * v[1]) + (v[2] * v[2] + v[3] * v[3]);
                        const f32x4 gs = *(const f32x4*)(gffn + c) * (*(const f32x4*)(mb + 4096 + c) + 1.0f);
                        const f32x4 a = v * gs;
                        u32x2 w; w.x = cvt_pk_bf16(a[0], a[1]); w.y = cvt_pk_bf16(a[2], a[3]);
                        *(u32x2*)(a3 + (size_t)row * DM + c) = w;
                    }
                ss += __shfl_xor(ss, 16); ss += __shfl_xor(ss, 32);
                if (fq == 0) sumsq[(size_t)row * 16 + u.pn * 4 + wc] = ss;
            }
    }
};

struct Epi3 {
    static constexpr bool PERM = true, AFTER_DRAIN = false;
    const float* sumsq; const float* biasf; bf16_t* sc;
    __device__ __forceinline__ void operator()(const f32x4 (&acc)[2][2][4][2], const Unit& u, int wr, int wc, int fr, int fq) const {
        const int row0 = u.pm * BM + wr * 64 + fr, col0 = u.pn * BM + wc * 32 + 8 * fq;
#pragma unroll
        for (int ai = 0; ai < 2; ++ai)
#pragma unroll
            for (int m = 0; m < 4; ++m) {
                const int row = row0 + ai * HALF + m * 16, b = row >> 12;
                const float rstd = row_rstd(sumsq, row);
#pragma unroll
                for (int bj = 0; bj < 2; ++bj) {
                    const int c = col0 + bj * HALF;
                    const f32x4 b0 = *(const f32x4*)(biasf + b * 2048 + c), b1 = *(const f32x4*)(biasf + b * 2048 + c + 4);
                    const f32x4 v0 = acc[ai][bj][m][0] * rstd + b0, v1 = acc[ai][bj][m][1] * rstd + b1;
                    u32x4 w; w.x = cvt_pk_bf16(v0[0], v0[1]); w.y = cvt_pk_bf16(v0[2], v0[3]); w.z = cvt_pk_bf16(v1[0], v1[1]); w.w = cvt_pk_bf16(v1[2], v1[3]);
                    *(u32x4*)(sc + (size_t)row * 2048 + c) = w;
                }
            }
    }
};

template <class Epi, class Sched, bool ALIGN_EPI = false, bool SP2 = false>
__device__ __forceinline__ void gemm_phase(PG8_LAS unsigned char* lds, const Gemm g, const Sched& S, const Epi& E) {
    const int tid = threadIdx.x, wid = __builtin_amdgcn_readfirstlane(tid >> 6), lane = tid & 63, wr = wid >> 2, wc = wid & 3, fr = lane & 15, fq = lane >> 4;
    const int K = g.K, nt = K / BK;
    unsigned voffA[2], voffB[2];
#pragma unroll
    for (int i = 0; i < 2; ++i) { int R, C; stage_rc(tid * 16 + i * 8192, R, C); const int Rb = Epi::PERM ? ((R & ~31) + perm32(R & 31)) : R;
        voffA[i] = (unsigned)(R * K + C) * 2u; voffB[i] = (unsigned)(Rb * K + C) * 2u; }
    const size_t kstep = (size_t)(BK * 2);
    const size_t hstep = (size_t)HALF * K * 2;
    const size_t tstep = 2 * hstep;
    const unsigned ldsw = (unsigned)wid * 1024u;
    const int aoff = lds_byte(wr * 64 + fr, fq * 8), boff = lds_byte(wc * 32 + fr, fq * 8);
#define PG8_SA(b, h) (((b) * 2 + (h)) * HTB)
#define PG8_SB(b, h) ((4 + (b) * 2 + (h)) * HTB)
#define PG8_STAGE(bufoff, gbase, voff) do { _Pragma("unroll") for (int _i = 0; _i < 2; ++_i) \
        __builtin_amdgcn_global_load_lds((const unsigned*)((const char*)(gbase) + (voff)[_i]), (PG8_LAS unsigned*)(lds + (bufoff) + ldsw + _i * 8192), 16, 0, 0); } while (0)
#define PG8_LDA(dst, b, h) do { _Pragma("unroll") for (int m = 0; m < 4; ++m) _Pragma("unroll") for (int k = 0; k < 2; ++k) dst[m][k] = *(const PG8_LAS bf16x8*)(lds + PG8_SA(b, h) + aoff + m * 2048 + k * 1024); } while (0)
#define PG8_LDB(dst, b, h) do { _Pragma("unroll") for (int n = 0; n < 2; ++n) _Pragma("unroll") for (int k = 0; k < 2; ++k) dst[n][k] = *(const PG8_LAS bf16x8*)(lds + PG8_SB(b, h) + boff + n * 2048 + k * 1024); } while (0)
#define PG8_MMA(ai, bj, At, Bt) do { __builtin_amdgcn_s_setprio(1); _Pragma("unroll") for (int m = 0; m < 4; ++m) _Pragma("unroll") for (int n = 0; n < 2; ++n) _Pragma("unroll") for (int k = 0; k < 2; ++k) \
        acc[ai][bj][m][n] = __builtin_amdgcn_mfma_f32_16x16x32_bf16(Bt[n][k], At[m][k], acc[ai][bj][m][n], 0, 0, 0); __builtin_amdgcn_s_setprio(0); } while (0)
#define PG8_WAIT_V(n) asm volatile("s_waitcnt vmcnt(" #n ")" ::: "memory")
#define PG8_WAIT_L(n) asm volatile("s_waitcnt lgkmcnt(" #n ")" ::: "memory")
#define PG8_BAR __builtin_amdgcn_s_barrier()
#define PG8_SCHED __builtin_amdgcn_sched_barrier(0)
    Unit cur, nxt; int ui = 0;
    if (!S.next(0, cur)) return;
    f32x4 acc[2][2][4][2];
#pragma unroll
    for (int a = 0; a < 2; ++a)
#pragma unroll
        for (int b = 0; b < 2; ++b)
#pragma unroll
            for (int m = 0; m < 4; ++m)
#pragma unroll
                for (int n = 0; n < 2; ++n) acc[a][b][m][n] = (f32x4){0.f, 0.f, 0.f, 0.f};
    bf16x8 At[4][2], B0[2][2], B1[2][2];
    const char* cA = (const char*)g.A + (size_t)cur.pm * tstep; const char* cB = (const char*)g.Bt + (size_t)cur.pn * tstep;
    S.a_ready(cur);
    if constexpr (SP2) {
        PG8_STAGE(PG8_SB(0, 0), cB, voffB); PG8_STAGE(PG8_SB(0, 1), cB + hstep, voffB); PG8_STAGE(PG8_SA(0, 0), cA, voffA); PG8_STAGE(PG8_SA(0, 1), cA + hstep, voffA);
        if (wr == 1) PG8_BAR;
        PG8_WAIT_V(2); PG8_BAR;
        PG8_STAGE(PG8_SB(1, 0), cB + kstep, voffB); PG8_STAGE(PG8_SA(1, 0), cA + kstep, voffA); PG8_STAGE(PG8_SB(1, 1), cB + hstep + kstep, voffB);
        PG8_WAIT_V(6); PG8_BAR;
    } else {
        PG8_STAGE(PG8_SB(0, 0), cB, voffB); PG8_STAGE(PG8_SA(0, 0), cA, voffA); PG8_STAGE(PG8_SB(0, 1), cB + hstep, voffB); PG8_STAGE(PG8_SA(0, 1), cA + hstep, voffA);
        if (wr == 1) PG8_BAR;
        PG8_WAIT_V(4); PG8_BAR;
        PG8_STAGE(PG8_SB(1, 0), cB + kstep, voffB); PG8_STAGE(PG8_SA(1, 0), cA + kstep, voffA); PG8_STAGE(PG8_SB(1, 1), cB + hstep + kstep, voffB);
        PG8_WAIT_V(6); PG8_BAR;
    }
    for (;;) {
        const bool has_next = S.next(ui + 1, nxt);
        const char* nA = has_next ? (const char*)g.A + (size_t)nxt.pm * tstep : cA; const char* nB = has_next ? (const char*)g.Bt + (size_t)nxt.pn * tstep : cB;
        for (int t = 0; t < nt; t += 2) {
            const bool last = (t == nt - 2);
            const char* a1 = cA + (size_t)(t + 1) * kstep;
            const char* a2 = last ? nA : cA + (size_t)(t + 2) * kstep; const char* b2 = last ? nB : cB + (size_t)(t + 2) * kstep;
            const char* a3 = a2 + kstep; const char* b3 = b2 + kstep;
            if (last && has_next) S.a_ready(nxt);
            if constexpr (SP2) {
            PG8_LDB(B0, 0, 0); PG8_LDB(B1, 0, 1); PG8_SCHED; PG8_LDA(At, 0, 0); PG8_STAGE(PG8_SA(1, 1), a1 + hstep, voffA);
            PG8_WAIT_V(8); PG8_WAIT_L(0); PG8_BAR; PG8_MMA(0, 0, At, B0); PG8_MMA(0, 1, At, B1); PG8_BAR; PG8_SCHED;
            PG8_LDA(At, 0, 1); PG8_STAGE(PG8_SB(0, 0), b2, voffB); PG8_STAGE(PG8_SB(0, 1), b2 + hstep, voffB); PG8_STAGE(PG8_SA(0, 0), a2, voffA);
            PG8_WAIT_V(8); PG8_WAIT_L(0); PG8_BAR; PG8_MMA(1, 0, At, B0); PG8_MMA(1, 1, At, B1); PG8_BAR; PG8_SCHED;
            PG8_LDB(B0, 1, 0); PG8_LDB(B1, 1, 1); PG8_SCHED; PG8_LDA(At, 1, 0); PG8_STAGE(PG8_SA(0, 1), a2 + hstep, voffA);
            PG8_WAIT_V(8); PG8_WAIT_L(0); PG8_BAR; PG8_MMA(0, 0, At, B0); PG8_MMA(0, 1, At, B1); PG8_BAR; PG8_SCHED;
            PG8_LDA(At, 1, 1); PG8_STAGE(PG8_SB(1, 0), b3, voffB); PG8_STAGE(PG8_SB(1, 1), b3 + hstep, voffB); PG8_STAGE(PG8_SA(1, 0), a3, voffA);
            PG8_WAIT_V(8); PG8_WAIT_L(0); PG8_BAR; PG8_MMA(1, 0, At, B0); PG8_MMA(1, 1, At, B1); PG8_BAR; PG8_SCHED;
            } else {
            PG8_LDB(B0, 0, 0); PG8_SCHED; PG8_LDA(At, 0, 0); PG8_STAGE(PG8_SA(1, 1), a1 + hstep, voffA);
            PG8_WAIT_L(8); PG8_BAR; PG8_WAIT_L(0); PG8_MMA(0, 0, At, B0); PG8_BAR; PG8_SCHED;
            PG8_LDB(B1, 0, 1); PG8_STAGE(PG8_SB(0, 0), b2, voffB);
            PG8_BAR; PG8_WAIT_L(0); PG8_MMA(0, 1, At, B1); PG8_BAR;
            PG8_LDA(At, 0, 1); PG8_STAGE(PG8_SA(0, 0), a2, voffA);
            PG8_BAR; PG8_WAIT_L(0); PG8_MMA(1, 0, At, B0); PG8_BAR; PG8_SCHED;
            PG8_STAGE(PG8_SB(0, 1), b2 + hstep, voffB);
            PG8_WAIT_V(6); PG8_BAR; PG8_MMA(1, 1, At, B1); PG8_BAR;
            PG8_LDB(B0, 1, 0); PG8_SCHED; PG8_LDA(At, 1, 0); PG8_STAGE(PG8_SA(0, 1), a2 + hstep, voffA);
            PG8_WAIT_L(8); PG8_BAR; PG8_WAIT_L(0); PG8_MMA(0, 0, At, B0); PG8_BAR; PG8_SCHED;
            PG8_LDB(B1, 1, 1); PG8_STAGE(PG8_SB(1, 0), b3, voffB);
            PG8_BAR; PG8_WAIT_L(0); PG8_MMA(0, 1, At, B1); PG8_BAR;
            PG8_LDA(At, 1, 1); PG8_STAGE(PG8_SA(1, 0), a3, voffA);
            PG8_BAR; PG8_WAIT_L(0); PG8_MMA(1, 0, At, B0); PG8_BAR; PG8_SCHED;
            PG8_STAGE(PG8_SB(1, 1), b3 + hstep, voffB);
            PG8_WAIT_V(6); PG8_BAR; PG8_MMA(1, 1, At, B1); PG8_BAR;
            }
        }
        if constexpr (ALIGN_EPI) { if (wr == 0) PG8_BAR; }
        if constexpr (!Epi::AFTER_DRAIN) { E(acc, cur, wr, wc, fr, fq); S.done(cur); }
        if (!has_next) break;
#pragma unroll
        for (int a = 0; a < 2; ++a)
#pragma unroll
            for (int b = 0; b < 2; ++b)
#pragma unroll
                for (int m = 0; m < 4; ++m)
#pragma unroll
                    for (int n = 0; n < 2; ++n) acc[a][b][m][n] = (f32x4){0.f, 0.f, 0.f, 0.f};
        cur = nxt; cA = nA; cB = nB; ++ui;
        if constexpr (ALIGN_EPI) { if (wr == 1) PG8_BAR; }
    }
    PG8_WAIT_V(0);
    if constexpr (!ALIGN_EPI) { if (wr == 0) PG8_BAR; }
    PG8_BAR;
    if constexpr (Epi::AFTER_DRAIN) { E.fused(acc, cur, wr, wc, fr, fq, lds, wid, lane); S.done(cur); }
#undef PG8_SA
#undef PG8_SB
#undef PG8_STAGE
#undef PG8_LDA
#undef PG8_LDB
#undef PG8_MMA
#undef PG8_WAIT_V
#undef PG8_WAIT_L
#undef PG8_BAR
#undef PG8_SCHED
}
}
struct Args { const float* in[13]; float* out; unsigned char* ws; int ph_lo, ph_hi; };

#ifndef TPROBE_I
#define TPROBE_I 3
#endif
#ifndef TPROBE_B
#define TPROBE_B 0
#endif
#ifdef TIME_PH
#ifndef TIME_AMP
#define TIME_AMP 4
#endif
#define TSTAMP(k, slot) do { if ((k) == TIME_PH && bid == TPROBE_B && tid == 0) { const unsigned long long t_ = __builtin_amdgcn_s_memrealtime(); MISC[slot] = (unsigned)t_; MISC[(slot) + 1] = (unsigned)(t_ >> 32); } } while (0)
#else
#define TSTAMP(k, slot) do { } while (0)
#endif
template <bool PERMUTE>
__device__ __forceinline__ void p0_transpose_item(const float* W, int K, int N, int NPOS, bf16_t* WT, LAS float* scr, int item, int lane) {
    const int nblk = NPOS / 32, kb = item / nblk, nb = item % nblk, k0 = 64 * kb, n0 = 32 * nb;
    const int pos = n0 + 4 * (lane & 7);
    const int col = PERMUTE ? win_src_col(pos) : pos;
    f32x4 v[8];
#pragma unroll
    for (int i = 0; i < 8; ++i) { const int kk = 8 * i + (lane >> 3); v[i] = (col >= 0) ? *(const f32x4*)(W + (size_t)(k0 + kk) * N + col) : (f32x4){0.f, 0.f, 0.f, 0.f}; }
#pragma unroll
    for (int i = 0; i < 8; ++i) { const int kk = 8 * i + (lane >> 3); LAS float* q = scr + kk * 33 + 4 * (lane & 7); q[0] = v[i][0]; q[1] = v[i][1]; q[2] = v[i][2]; q[3] = v[i][3]; }
    asm volatile("s_waitcnt lgkmcnt(0)" ::: "memory");
    const int c = lane & 7;
#pragma unroll
    for (int j = 0; j < 4; ++j) { const int n = (lane >> 3) + 8 * j; const LAS float* s = scr + (8 * c) * 33 + n;
        u32x4 o; o.x = pk2(s[0 * 33], s[1 * 33]); o.y = pk2(s[2 * 33], s[3 * 33]); o.z = pk2(s[4 * 33], s[5 * 33]); o.w = pk2(s[6 * 33], s[7 * 33]);
        *(u32x4*)(WT + (size_t)(n0 + n) * K + k0 + 8 * c) = o; }
    asm volatile("s_waitcnt lgkmcnt(0)" ::: "memory");
}
__device__ __forceinline__ void row_to_bf16(const float* src, bf16_t* dst, int lane) {
    const f32x4* s = (const f32x4*)src + lane; u32x2* d = (u32x2*)dst + lane;
    f32x4 v[4];
#pragma unroll
    for (int j = 0; j < 4; ++j) v[j] = s[64 * j];
#pragma unroll
    for (int j = 0; j < 4; ++j) { u32x2 w; w.x = pk2(v[j][0], v[j][1]); w.y = pk2(v[j][2], v[j][3]); d[64 * j] = w; }
}
typedef float f32x2 __attribute__((ext_vector_type(2)));
template <int NB>
__device__ __forceinline__ void rows_to_fp8(const float* src, unsigned char* dst, float* scale_out, int lane) {
    f32x4 v[NB][4];
#pragma unroll
    for (int i = 0; i < NB; ++i) { const f32x4* s = (const f32x4*)(src + (size_t)i * 1024) + 4 * lane;
#pragma unroll
        for (int j = 0; j < 4; ++j) v[i][j] = __builtin_nontemporal_load(s + j); }
#pragma unroll
    for (int i = 0; i < NB; ++i) {
        float am = 0.f;
#pragma unroll
        for (int j = 0; j < 4; ++j) am = fmaxf(am, fmaxf(fmaxf(fabsf(v[i][j][0]), fabsf(v[i][j][1])), fmaxf(fabsf(v[i][j][2]), fabsf(v[i][j][3]))));
#pragma unroll
        for (int o = 1; o < 64; o <<= 1) am = fmaxf(am, __shfl_xor(am, o));
        const float sc = am > 0.f ? am * (1.0f / 440.0f) : 1.0f, inv = 1.0f / sc;
        u32x4 w;
#pragma unroll
        for (int j = 0; j < 4; ++j) { unsigned t = 0u; t = __builtin_amdgcn_cvt_pk_fp8_f32(v[i][j][0] * inv, v[i][j][1] * inv, t, false); t = __builtin_amdgcn_cvt_pk_fp8_f32(v[i][j][2] * inv, v[i][j][3] * inv, t, true); w[j] = t; }
        *((u32x4*)(dst + (size_t)i * 1024) + lane) = w;
        if (lane == 0) scale_out[i] = sc;
    }
}
__device__ __forceinline__ void sincos_tab(double x, float& s, float& c) {
    const double k = rint(x * 0.15915494309189535);
    double r = fma(-k, 6.283185307179586, x); r = fma(-k, 2.4492935982947064e-16, r);
    const double r2 = r * r;
    double ps = 1.0, pc = 1.0;
#pragma unroll
    for (int n = 29; n >= 3; n -= 2) ps = 1.0 - ps * r2 * (1.0 / (double)((n - 1) * n));
#pragma unroll
    for (int n = 28; n >= 2; n -= 2) pc = 1.0 - pc * r2 * (1.0 / (double)((n - 1) * n));
    s = (float)(r * ps); c = (float)pc;
}

__device__ __forceinline__ void phase0(const Args& a, unsigned char* lds, int tid, int wave, int lane, int bid, int G) {
    unsigned char* ws = a.ws;
    volatile LAS unsigned* MISC = (volatile LAS unsigned*)((LAS unsigned char*)lds + MISC_OFF);
    TSTAMP(90, 0);
    for (int it = bid; it < 192; it += G) {
        float* s_c = (float*)lds; float* red = (float*)(lds + 16384);
        for (int i = tid; i < 4096; i += NTHREADS) { const float v = a.in[1][i]; s_c[i] = v / (1.0f + expf(-v)); }
        __syncthreads();
        const int g = tid & 7, ks = tid >> 3, n0 = 32 * it;
        f32x4 acc[4];
#pragma unroll
        for (int b = 0; b < 4; ++b) acc[b] = (f32x4){0.f, 0.f, 0.f, 0.f};
#pragma unroll 4
        for (int i = 0; i < 16; ++i) { const int k = ks + 64 * i; const f32x4 w = *(const f32x4*)(a.in[2] + (size_t)k * 6144 + n0 + 4 * g);
#pragma unroll
            for (int b = 0; b < 4; ++b) acc[b] += w * s_c[b * 1024 + k]; }
#pragma unroll
        for (int b = 0; b < 4; ++b) *(f32x4*)(red + (ks * 8 + g) * 16 + 4 * b) = acc[b];
        __syncthreads();
        if (tid < 128) { const int b = tid >> 5, col = tid & 31, gg = col >> 2, e = col & 3; float s = 0.f;
            for (int k2 = 0; k2 < 64; ++k2) s += red[(k2 * 8 + gg) * 16 + 4 * b + e];
            ((float*)(ws + WS_MOD))[b * 6144 + n0 + col] = s + a.in[3][n0 + col]; }
        __syncthreads();
    }
    TSTAMP(90, 2); TSTAMP(91, 0);
    for (int it = bid; it < 256; it += G) {
        const int hp = it >> 4, k0 = 64 * (it & 15);
        constexpr int WP = 132;
        float* skl = (float*)lds; float* wql = skl + 128 * WP;
        for (int i = tid; i < 4096; i += NTHREADS) { const int n = i >> 5, d4 = i & 31; *(f32x4*)(skl + n * WP + 4 * d4) = *(const f32x4*)(a.in[9] + (size_t)hp * 16384 + n * 128 + 4 * d4); }
        for (int i = tid; i < 2048; i += NTHREADS) { const int k = i >> 5, d4 = i & 31; *(f32x4*)(wql + k * WP + 4 * d4) = *(const f32x4*)(a.in[8] + (size_t)(k0 + k) * 2048 + hp * 128 + 4 * d4); }
        __syncthreads();
        const int kg = tid & 15, ng = tid >> 4;
        float acc[4][4];
#pragma unroll
        for (int i = 0; i < 4; ++i)
#pragma unroll
            for (int j = 0; j < 4; ++j) acc[i][j] = 0.f;
#pragma unroll 2
        for (int d4 = 0; d4 < 32; ++d4) {
            f32x4 wv[4], sv[4];
#pragma unroll
            for (int i = 0; i < 4; ++i) { wv[i] = *(const f32x4*)(wql + (kg + 16 * i) * WP + 4 * d4); sv[i] = *(const f32x4*)(skl + (ng + 32 * i) * WP + 4 * d4); }
#pragma unroll
            for (int i = 0; i < 4; ++i)
#pragma unroll
                for (int j = 0; j < 4; ++j) acc[i][j] += (wv[i][0] * sv[j][0] + wv[i][1] * sv[j][1]) + (wv[i][2] * sv[j][2] + wv[i][3] * sv[j][3]);
        }
        bf16_t* wt = (bf16_t*)(ws + WS_WPQ);
#pragma unroll
        for (int j = 0; j < 4; ++j)
#pragma unroll
            for (int i = 0; i < 4; ++i) wt[(size_t)(hp * 128 + ng + 32 * j) * 1024 + k0 + kg + 16 * i] = (bf16_t)f2bf(acc[i][j]);
        __syncthreads();
    }
    TSTAMP(91, 2); TSTAMP(92, 0);
    const int gw = bid * 8 + wave, NGW = G * 8;
    {
        LAS float* scr = (LAS float*)(lds + wave * 16384);
        constexpr int I_IN = 16 * (N1 / 32), I_OUT = 16 * 32;
        for (int it = gw; it < I_IN + I_OUT; it += NGW) {
            if (it < I_IN) p0_transpose_item<true>(a.in[5], 1024, 4168, N1, (bf16_t*)(ws + WS_WIN), scr, it, lane);
            else p0_transpose_item<false>(a.in[6], 1024, 1024, 1024, (bf16_t*)(ws + WS_WOUT), scr, it - I_IN, lane);
        }
    }
    for (int it = gw; it < 4096; it += NGW) { const int r = 4 * it;
        rows_to_fp8<4>(a.in[10] + (size_t)r * 1024, ws + WS_U8 + (size_t)r * 1024, (float*)(ws + WS_USC) + r, lane); }
    for (int i = bid * NTHREADS + tid; i < 4096 * 96; i += G * NTHREADS) {
        int pos, f; double r; float* ct; float* st; int idx;
        if (i < 4096 * 32) { pos = i >> 5; f = i & 31; r = 0.74989420933245582730; ct = (float*)(ws + WS_COSA); st = (float*)(ws + WS_SINA); idx = i; }
        else { const int j = i - 4096 * 32; pos = j >> 6; f = j & 63; r = 0.86398844948396852897; ct = (float*)(ws + WS_COSR); st = (float*)(ws + WS_SINR); idx = j; }
        double v = 1.0; for (int t = 0; t < f; ++t) v *= r;
        const float invf = (float)v; const float ang = (float)pos * invf;
        float s, c; sincos_tab((double)ang, s, c);
        ct[idx] = c; st[idx] = s;
    }
}

__device__ __forceinline__ void phase1(const Args& a, int wave, int lane, int bid, int G) {
    unsigned char* ws = a.ws;
    const float* mod = (const float*)(ws + WS_MOD);
    const int gw = bid * 8 + wave, NGW = G * 8;
    for (int r0 = gw; r0 < MTOK; r0 += 2 * NGW) {
        const int r1 = r0 + NGW; const bool has1 = r1 < MTOK;
        const f32x4* xa = (const f32x4*)(a.in[0] + (size_t)r0 * DM) + lane; const f32x4* xb = (const f32x4*)(a.in[0] + (size_t)(has1 ? r1 : r0) * DM) + lane;
        f32x4 va[4], vb[4]; float sa = 0.f, sb = 0.f;
#pragma unroll
        for (int j = 0; j < 4; ++j) { va[j] = xa[64 * j]; vb[j] = xb[64 * j]; }
#pragma unroll
        for (int j = 0; j < 4; ++j) { sa += (va[j][0] * va[j][0] + va[j][1] * va[j][1]) + (va[j][2] * va[j][2] + va[j][3] * va[j][3]); sb += (vb[j][0] * vb[j][0] + vb[j][1] * vb[j][1]) + (vb[j][2] * vb[j][2] + vb[j][3] * vb[j][3]); }
#pragma unroll
        for (int o = 1; o < 64; o <<= 1) { sa += __shfl_xor(sa, o); sb += __shfl_xor(sb, o); }
        const float ra = 1.0f / sqrtf(sa * (1.0f / DM) + EPS), rb = 1.0f / sqrtf(sb * (1.0f / DM) + EPS);
        const int ba = r0 >> 12, bb = (has1 ? r1 : r0) >> 12;
        u32x2* oa = (u32x2*)((bf16_t*)(ws + WS_BUFA) + (size_t)r0 * DM) + lane; u32x2* ob = (u32x2*)((bf16_t*)(ws + WS_BUFA) + (size_t)(has1 ? r1 : r0) * DM) + lane;
#pragma unroll
        for (int j = 0; j < 4; ++j) { const int c = 256 * j + 4 * lane;
            const f32x4 g = *(const f32x4*)(a.in[4] + c);
            { const f32x4 sc = *(const f32x4*)(mod + ba * 6144 + 1024 + c), sh = *(const f32x4*)(mod + ba * 6144 + c);
              const f32x4 h = va[j] * ra * g * (sc + 1.0f) + sh; u32x2 w; w.x = pk2(h[0], h[1]); w.y = pk2(h[2], h[3]); oa[64 * j] = w; }
            if (has1) { const f32x4 sc = *(const f32x4*)(mod + bb * 6144 + 1024 + c), sh = *(const f32x4*)(mod + bb * 6144 + c);
              const f32x4 h = vb[j] * rb * g * (sc + 1.0f) + sh; u32x2 w; w.x = pk2(h[0], h[1]); w.y = pk2(h[2], h[3]); ob[64 * j] = w; }
        }
    }
    for (int n = gw; n < 2048; n += NGW) {
        const u32x4* wr = (const u32x4*)((const bf16_t*)(ws + WS_WPQ) + (size_t)n * 1024);
        const u32x4 w0 = wr[lane], w1 = wr[64 + lane];
        float wf[16];
#pragma unroll
        for (int i = 0; i < 4; ++i) { wf[2 * i] = bf_lo(w0[i]); wf[2 * i + 1] = bf_hi(w0[i]); wf[8 + 2 * i] = bf_lo(w1[i]); wf[8 + 2 * i + 1] = bf_hi(w1[i]); }
#pragma unroll
        for (int b = 0; b < 4; ++b) { const float* sh = mod + b * 6144 + 3072; float s = 0.f;
#pragma unroll
            for (int i = 0; i < 8; ++i) s += wf[i] * sh[8 * lane + i] + wf[8 + i] * sh[512 + 8 * lane + i];
            s = wave_sum(s);
            if (lane == 0) ((float*)(ws + WS_BIASF))[b * 2048 + n] = s; }
    }
}

constexpr int SCP = 8200;
__device__ __forceinline__ int wave_total(int v) {
    v += __builtin_amdgcn_update_dpp(0, v, 0xB1, 0xF, 0xF, true);
    v += __builtin_amdgcn_update_dpp(0, v, 0x4E, 0xF, 0xF, true);
    v += __builtin_amdgcn_update_dpp(0, v, 0x141, 0xF, 0xF, true);
    v += __builtin_amdgcn_update_dpp(0, v, 0x140, 0xF, 0xF, true);
    return __builtin_amdgcn_readlane(v, 0) + __builtin_amdgcn_readlane(v, 16) + __builtin_amdgcn_readlane(v, 32) + __builtin_amdgcn_readlane(v, 48);
}
__device__ __forceinline__ int wave_suffix_sum(int v, int lane) {
#pragma unroll
    for (int d = 1; d < 64; d <<= 1) { const int o = __shfl_down(v, d); if (lane + d < 64) v += o; }
    return v;
}
__device__ __forceinline__ void hist_find(const unsigned* hist, int want, int lane, int& bin, int& above, int& inbin) {
    const u32x4 h = *(const u32x4*)(hist + 4 * lane);
    const int s = (int)(h.x + h.y) + (int)(h.z + h.w);
    const int incl = wave_suffix_sum(s, lane), excl = incl - s;
    const bool mine = excl < want && want <= incl;
    int c = excl, bsel = 4 * lane + 3, cin = (int)h.w;
    if (c + (int)h.w < want) { c += (int)h.w; bsel = 4 * lane + 2; cin = (int)h.z;
        if (c + (int)h.z < want) { c += (int)h.z; bsel = 4 * lane + 1; cin = (int)h.y;
            if (c + (int)h.y < want) { c += (int)h.y; bsel = 4 * lane; cin = (int)h.x; } } }
    const int src = (int)__builtin_ctzll(__ballot(mine));
    bin = __builtin_amdgcn_readlane(bsel, src); above = __builtin_amdgcn_readlane(c, src); inbin = __builtin_amdgcn_readlane(cin, src);
}
template <int NR>
__device__ __forceinline__ void select_row_t(int b, int t, unsigned char* ldsrow, unsigned* hist, unsigned long long* MASK, int lane) {
    {
        unsigned* row32 = (unsigned*)ldsrow;
        for (int i = 8 * ((t >> 4) + 1) + lane; i < 32 * NR; i += 64) row32[i] = 0u;
    }
    unsigned key[NR];
#pragma unroll
    for (int j = 0; j < NR; ++j) key[j] = *(const unsigned short*)(ldsrow + 2 * lane + 128 * j);
    unsigned mw_lo = 0u, mw_hi = 0u;
    if (t < 256) {
#pragma unroll
        for (int j = 0; j < 4; ++j) { const unsigned long long w = __ballot(key[j] != 0u);
            asm volatile("s_nop 1\n\tv_writelane_b32 %0, %2, %4\n\tv_writelane_b32 %1, %3, %4\n\ts_nop 0" : "+v"(mw_lo), "+v"(mw_hi) : "s"((unsigned)w), "s"((unsigned)(w >> 32)), "n"(j)); }
    } else {
        *(u32x4*)(hist + 4 * lane) = (u32x4){0u, 0u, 0u, 0u};
#pragma unroll
        for (int j = 0; j < NR; ++j) __hip_atomic_fetch_add(hist + (key[j] >> 8), 1u, __ATOMIC_RELAXED, __HIP_MEMORY_SCOPE_WORKGROUP);
        int B, above, inB;
        hist_find(hist, 256, lane, B, above, inB);
        *(u32x4*)(hist + 4 * lane) = (u32x4){0u, 0u, 0u, 0u};
#pragma unroll
        for (int j = 0; j < NR; ++j) if ((int)(key[j] >> 8) == B) __hip_atomic_fetch_add(hist + (key[j] & 255u), 1u, __ATOMIC_RELAXED, __HIP_MEMORY_SCOPE_WORKGROUP);
        int b2, above2, ties;
        hist_find(hist, 256 - above, lane, b2, above2, ties);
        const unsigned T = ((unsigned)B << 8) | (unsigned)b2;
        int need = 256 - above - above2;
        if (ties == need) {
#pragma unroll
            for (int j = 0; j < NR; ++j) { const unsigned long long w = __ballot(key[j] >= T);
                asm volatile("s_nop 1\n\tv_writelane_b32 %0, %2, %4\n\tv_writelane_b32 %1, %3, %4\n\ts_nop 0" : "+v"(mw_lo), "+v"(mw_hi) : "s"((unsigned)w), "s"((unsigned)(w >> 32)), "n"(j));
                if ((j & 3) == 3) __builtin_amdgcn_sched_barrier(0); }
        } else {
#pragma unroll
            for (int j = 0; j < NR; ++j) {
                const bool gt = key[j] > T, eq = key[j] == T;
                const unsigned long long em = __ballot(eq);
                const int cc = __popcll(em), take = cc < need ? cc : need;
                const int rank = (int)__builtin_amdgcn_mbcnt_hi((unsigned)(em >> 32), __builtin_amdgcn_mbcnt_lo((unsigned)em, 0u));
                const unsigned long long w = __ballot(gt || (eq && rank < take));
                need -= take;
                asm volatile("s_nop 1\n\tv_writelane_b32 %0, %2, %4\n\tv_writelane_b32 %1, %3, %4\n\ts_nop 0" : "+v"(mw_lo), "+v"(mw_hi) : "s"((unsigned)w), "s"((unsigned)(w >> 32)), "n"(j));
                if ((j & 1) == 1) __builtin_amdgcn_sched_barrier(0);
            }
        }
    }
    MASK[((size_t)b * SEQ + t) * 64 + lane] = ((unsigned long long)mw_hi << 32) | mw_lo;
}
__device__ __forceinline__ void select_row(int b, int t, unsigned char* ldsrow, unsigned* hist, unsigned long long* MASK, int lane) {
    switch (t >> 10) {
        case 0: select_row_t<16>(b, t, ldsrow, hist, MASK, lane); break;
        case 1: select_row_t<32>(b, t, ldsrow, hist, MASK, lane); break;
        case 2: select_row_t<48>(b, t, ldsrow, hist, MASK, lane); break;
        default: select_row_t<64>(b, t, ldsrow, hist, MASK, lane); break;
    }
}
__device__ __forceinline__ void idx_unit(int b, int qt, const bf16_t* QI, const bf16_t* KI, const float* WI, unsigned long long* MASK, unsigned char* lds, int wave, int lane, bool tprobe) {
    volatile LAS unsigned* MISC = (volatile LAS unsigned*)((LAS unsigned char*)lds + MISC_OFF); const int bid = tprobe ? TPROBE_B : -1; const int tid = (int)threadIdx.x;
    TSTAMP(32, 0);
    const int t0 = 16 * qt, qn = lane & 15, g = lane >> 4;
    const size_t rowq = (size_t)b * SEQ + t0 + qn;
    bf16x8 qf[8][2]; float wi[8];
#pragma unroll
    for (int h = 0; h < 8; ++h)
#pragma unroll
        for (int ks = 0; ks < 2; ++ks) qf[h][ks] = *(const bf16x8*)(QI + rowq * 512 + h * 64 + ks * 32 + 8 * g);
    { const f32x4 w0 = *(const f32x4*)(WI + rowq * 8), w1 = *(const f32x4*)(WI + rowq * 8 + 4);
#pragma unroll
      for (int e = 0; e < 4; ++e) { wi[e] = w0[e]; wi[4 + e] = w1[e]; } }
    const bf16_t* kbase = KI + ((size_t)b * SEQ + qn) * 64 + 8 * g;
    bf16x8 ra0[8], ra1[8];
#pragma unroll
    for (int i = 0; i < 8; ++i) if (wave + 8 * i <= qt) { const bf16_t* kr = kbase + (size_t)(wave + 8 * i) * 1024; ra0[i] = *(const bf16x8*)kr; ra1[i] = *(const bf16x8*)(kr + 32); }
#pragma unroll 1
    for (int base = wave; base <= qt; base += 64) {
#pragma unroll
        for (int i = 0; i < 8; ++i) {
            const int kt = base + 8 * i;
            if (kt <= qt) {
                const bf16x8 a0 = ra0[i], a1 = ra1[i];
                if (kt + 64 <= qt) { const bf16_t* kr = kbase + (size_t)(kt + 64) * 1024; ra0[i] = *(const bf16x8*)kr; ra1[i] = *(const bf16x8*)(kr + 32); }
                const int s0 = 16 * kt;
                f32x4 sc = (f32x4){0.f, 0.f, 0.f, 0.f};
#pragma unroll
                for (int h = 0; h < 8; ++h) {
                    f32x4 d = mfma16(a0, qf[h][0], (f32x4){0.f, 0.f, 0.f, 0.f}); d = mfma16(a1, qf[h][1], d);
#pragma unroll
                    for (int r = 0; r < 4; ++r) { const int di = (int)__float_as_uint(d[r]); sc[r] += wi[h] * __uint_as_float((unsigned)(di > 0 ? di : 0)); }
                }
                unsigned k[4];
#pragma unroll
                for (int r = 0; r < 4; ++r) { const unsigned kk = sortable16(sc[r]); k[r] = (s0 + 4 * g + r <= t0 + qn) ? kk : 0u; }
                u32x2 pk; pk.x = k[0] | (k[1] << 16); pk.y = k[2] | (k[3] << 16);
                *(u32x2*)(lds + qn * SCP + 2 * (s0 + 4 * g)) = pk;
            }
        }
    }
    __syncthreads();
    TSTAMP(32, 2); TSTAMP(33, 0);
#ifndef NO_SEL
#pragma unroll 1
    for (int qq = 2 * wave; qq < 2 * wave + 2; ++qq) select_row(b, t0 + qq, lds + qq * SCP, (unsigned*)(lds + 16 * SCP) + 256 * wave, MASK, lane);
#endif
    __syncthreads();
    TSTAMP(33, 2);
}

__device__ __forceinline__ void ret_state_unit(int b, int h, int vb, int dh, const bf16_t* KR, const bf16_t* VR, bf16_t* STATE, unsigned char* lds, int tid, int wave, int lane) {
    constexpr int PT = 272, KT_BYTES = 64 * PT, BUF = KT_BYTES + 16 * PT;
    const int j = tid & 127, dq = tid >> 7, g = lane >> 4, ln = lane & 15;
    const float g128 = ret_g128(h), g127 = ret_g127(h), gam = ret_gamma(h);
    f32x4 st = (f32x4){0.f, 0.f, 0.f, 0.f};
    u32x4 kA[2], kB[2], vA = (u32x4){0u, 0u, 0u, 0u}, vB = (u32x4){0u, 0u, 0u, 0u};
#define RS_LOAD(K_, V_, n) do { const size_t row = (size_t)b * SEQ + (n) * 128 + j; const u32x4* p = (const u32x4*)(KR + row * 512 + h * 128 + 64 * dh + 16 * dq); \
        K_[0] = p[0]; K_[1] = p[1]; if (tid < 256) V_ = *(const u32x4*)(VR + row * 512 + h * 128 + 16 * vb + 8 * dq); } while (0)
#define RS_WRITE(K_, V_, buf) do { _Pragma("unroll") for (int i = 0; i < 2; ++i) _Pragma("unroll") for (int e = 0; e < 4; ++e) { const unsigned w = K_[i][e]; const int d = 16 * dq + 8 * i + 2 * e; \
            *(unsigned short*)((buf) + d * PT + 2 * j) = (unsigned short)(w & 0xffffu); *(unsigned short*)((buf) + (d + 1) * PT + 2 * j) = (unsigned short)(w >> 16); } \
        if (tid < 256) { _Pragma("unroll") for (int e = 0; e < 4; ++e) { const unsigned w = V_[e]; const int v = 8 * dq + 2 * e; \
            *(unsigned short*)((buf) + KT_BYTES + v * PT + 2 * j) = (unsigned short)(w & 0xffffu); *(unsigned short*)((buf) + KT_BYTES + (v + 1) * PT + 2 * j) = (unsigned short)(w >> 16); } } } while (0)
#define RS_COMP(buf, n) do { if (wave < 4) { \
        bf16_t* sp = STATE + ((((size_t)b * 4 + h) * 32 + (n)) * 128 + 16 * vb + 4 * g) * 128 + 64 * dh + 16 * wave + ln; \
        _Pragma("unroll") for (int r = 0; r < 4; ++r) sp[r * 128] = (bf16_t)f2bf(gam * st[r]); \
        f32x4 c = (f32x4){0.f, 0.f, 0.f, 0.f}; \
        _Pragma("unroll") for (int ks = 0; ks < 4; ++ks) { \
            const bf16x8 af = *(const bf16x8*)((buf) + KT_BYTES + ln * PT + 2 * (32 * ks + 8 * g)); \
            const bf16x8 bf = *(const bf16x8*)((buf) + (16 * wave + ln) * PT + 2 * (32 * ks + 8 * g)); \
            c = mfma16(af, bf, c); } \
        st = st * g128 + c * g127; } } while (0)
    RS_LOAD(kA, vA, 0); RS_LOAD(kB, vB, 1);
#pragma unroll 1
    for (int n = 0; n < 32; n += 2) {
        RS_WRITE(kA, vA, lds);
        if (n + 2 < 32) RS_LOAD(kA, vA, n + 2);
        __syncthreads();
        RS_COMP(lds, n);
        RS_WRITE(kB, vB, lds + BUF);
        if (n + 3 < 32) RS_LOAD(kB, vB, n + 3);
        __syncthreads();
        RS_COMP(lds + BUF, n + 1);
    }
#undef RS_LOAD
#undef RS_WRITE
#undef RS_COMP
    __syncthreads();
}

__device__ __forceinline__ float amax3(float a, float b, float c) { float r; asm("v_max3_f32 %0, %1, %2, %3" : "=v"(r) : "v"(a), "v"(b), "v"(c)); return r; }
__device__ __forceinline__ void attn_unit(int b, int h, int qb, const bf16_t* QA, const bf16_t* KA, const bf16_t* VA, const unsigned long long* MASK, bf16_t* AR,
                                          unsigned char* lds, int tid, int wave, int lane) {
    constexpr int KP = 144, KS_BYTES = 64 * KP, BUF = 2 * KS_BYTES;
    const int q0 = 256 * qb, r32 = lane & 31, hi = lane >> 5;
    const int t = q0 + 32 * wave + r32;
    const size_t qrow = (size_t)b * SEQ + t;
    bf16x8 qf[4];
#pragma unroll
    for (int d0 = 0; d0 < 4; ++d0) qf[d0] = *(const bf16x8*)(QA + qrow * 512 + h * 64 + 16 * d0 + 8 * hi);
    const int NT = (q0 + 256) / 64;
    const int key_l = tid >> 3, c8 = tid & 7;
    f32x16 o0, o1;
#pragma unroll
    for (int r = 0; r < 16; ++r) { o0[r] = 0.f; o1[r] = 0.f; }
    float m_run = NEG_INF, l_run = 0.f;
    u32x4 kreg[4], vreg[4]; unsigned long long mw[4];
#define AT_LOAD(i, kt) do { const size_t kr = (size_t)b * SEQ + 64 * (kt) + key_l; kreg[i] = *(const u32x4*)(KA + kr * 512 + h * 64 + 8 * c8); vreg[i] = *(const u32x4*)(VA + kr * 512 + h * 64 + 8 * c8); \
        mw[i] = MASK[qrow * 64 + (kt)]; } while (0)
#pragma unroll
    for (int i = 0; i < 4; ++i) AT_LOAD(i, i);
#pragma unroll 1
    for (int kt4 = 0; kt4 < NT; kt4 += 4) {
#pragma unroll
      for (int i = 0; i < 4; ++i) {
        const int kt = kt4 + i;
        unsigned char* buf = lds + (i & 1) * BUF;
        *(u32x4*)(buf + key_l * KP + 16 * c8) = kreg[i];
#pragma unroll
        for (int e = 0; e < 4; ++e) { const unsigned w = vreg[i][e]; const int d = 8 * c8 + 2 * e;
            *(unsigned short*)(buf + KS_BYTES + d * KP + 2 * key_l) = (unsigned short)(w & 0xffffu); *(unsigned short*)(buf + KS_BYTES + (d + 1) * KP + 2 * key_l) = (unsigned short)(w >> 16); }
        const unsigned long long mcur = mw[i];
        if (kt + 4 < NT) AT_LOAD(i, kt + 4);
        __syncthreads();
        if (64 * kt <= q0 + 32 * wave + 31) {
            f32x16 p0, p1;
#pragma unroll
            for (int r = 0; r < 16; ++r) { p0[r] = 0.f; p1[r] = 0.f; }
#pragma unroll
            for (int d0 = 0; d0 < 4; ++d0) {
                const bf16x8 a0 = *(const bf16x8*)(buf + r32 * KP + 32 * d0 + 16 * hi);
                const bf16x8 a1 = *(const bf16x8*)(buf + (32 + r32) * KP + 32 * d0 + 16 * hi);
                p0 = mfma32(a0, qf[d0], p0); p1 = mfma32(a1, qf[d0], p1);
            }
            const unsigned wl = (unsigned)mcur >> (4 * hi), wh = (unsigned)(mcur >> 32) >> (4 * hi);
#pragma unroll
            for (int r = 0; r < 16; ++r) { const int bp = (r & 3) + 8 * (r >> 2);
                const unsigned m0 = (unsigned)((int)(wl << (31 - bp)) >> 31), m1 = (unsigned)((int)(wh << (31 - bp)) >> 31);
                p0[r] = __uint_as_float((__float_as_uint(p0[r]) & m0) | (0xff800000u & ~m0)); p1[r] = __uint_as_float((__float_as_uint(p1[r]) & m1) | (0xff800000u & ~m1)); }
            float mx;
            { float a = amax3(p0[0], p0[1], p1[0]), bq = amax3(p0[2], p0[3], p1[1]); a = amax3(a, p1[2], p1[3]);
#pragma unroll
              for (int r = 4; r < 16; r += 4) { a = amax3(a, p0[r], p0[r + 1]); bq = amax3(bq, p0[r + 2], p0[r + 3]); a = amax3(a, p1[r], p1[r + 1]); bq = amax3(bq, p1[r + 2], p1[r + 3]); }
              mx = amax3(a, bq, bq); }
            mx = amax3(mx, __shfl_xor(mx, 32), mx);
            const float m_new = amax3(m_run, mx, mx);
            const float m_use = (m_new == NEG_INF) ? 0.f : m_new;
            const float alpha = fast_exp2(m_run - m_use);
            m_run = m_new;
            float ps = 0.f;
#pragma unroll
            for (int r = 0; r < 16; ++r) { p0[r] = fast_exp2(p0[r] - m_use); p1[r] = fast_exp2(p1[r] - m_use); ps += p0[r] + p1[r]; }
            l_run = l_run * alpha + ps;
            if (__any(alpha != 1.0f)) {
#pragma unroll
                for (int r = 0; r < 16; ++r) { o0[r] *= alpha; o1[r] *= alpha; }
            }
#pragma unroll
            for (int s4 = 0; s4 < 4; ++s4) {
                const int rb = 8 * (s4 & 1);
                u32x4 pw;
                if (s4 < 2) { pw.x = pk2(p0[rb], p0[rb + 1]); pw.y = pk2(p0[rb + 2], p0[rb + 3]); pw.z = pk2(p0[rb + 4], p0[rb + 5]); pw.w = pk2(p0[rb + 6], p0[rb + 7]); }
                else        { pw.x = pk2(p1[rb], p1[rb + 1]); pw.y = pk2(p1[rb + 2], p1[rb + 3]); pw.z = pk2(p1[rb + 4], p1[rb + 5]); pw.w = pk2(p1[rb + 6], p1[rb + 7]); }
                const bf16x8 bfr = __builtin_bit_cast(bf16x8, pw);
                { const unsigned char* vp = buf + KS_BYTES + r32 * KP + 2 * (16 * s4 + 4 * hi);
                  const u32x2 lo = *(const u32x2*)vp, h2 = *(const u32x2*)(vp + 16); const u32x4 av = (u32x4){lo.x, lo.y, h2.x, h2.y};
                  o0 = mfma32(__builtin_bit_cast(bf16x8, av), bfr, o0); }
                { const unsigned char* vp = buf + KS_BYTES + (32 + r32) * KP + 2 * (16 * s4 + 4 * hi);
                  const u32x2 lo = *(const u32x2*)vp, h2 = *(const u32x2*)(vp + 16); const u32x4 av = (u32x4){lo.x, lo.y, h2.x, h2.y};
                  o1 = mfma32(__builtin_bit_cast(bf16x8, av), bfr, o1); }
            }
        }
      }
    }
#undef AT_LOAD
    l_run += __shfl_xor(l_run, 32);
#ifdef DBG_NOATT
    const float inv = 0.f;
#else
    const float inv = 1.0f / l_run;
#endif
    bf16_t* op = AR + qrow * 1024 + h * 64 + 4 * hi;
#pragma unroll
    for (int c = 0; c < 4; ++c) {
        u32x2 w; w.x = pk2(o0[4 * c] * inv, o0[4 * c + 1] * inv); w.y = pk2(o0[4 * c + 2] * inv, o0[4 * c + 3] * inv); *(u32x2*)(op + 8 * c) = w;
        u32x2 v; v.x = pk2(o1[4 * c] * inv, o1[4 * c + 1] * inv); v.y = pk2(o1[4 * c + 2] * inv, o1[4 * c + 3] * inv); *(u32x2*)(op + 32 + 8 * c) = v;
    }
    __syncthreads();
}

__device__ __forceinline__ void ret_out_unit(int b, int h, int n, const bf16_t* QR, const bf16_t* KR, const bf16_t* VR, const bf16_t* GR, const bf16_t* STATE, bf16_t* AR,
                                             unsigned char* lds, int tid, int wave, int lane) {
    constexpr int PT = 272;
    const size_t c0 = (size_t)b * SEQ + 128 * n; const int hc = 128 * h;
    const int ln = lane & 15, g = lane >> 4;
    const size_t qrow = c0 + 16 * wave + ln;
    u32x4 rr[4];
    { const int j = tid & 127, vq = tid >> 7; const u32x4* p = (const u32x4*)(VR + (c0 + j) * 512 + hc + 32 * vq); rr[0] = p[0]; rr[1] = p[1]; rr[2] = p[2]; rr[3] = p[3]; }
    bf16x8 qf[4];
#pragma unroll
    for (int ks = 0; ks < 4; ++ks) qf[ks] = *(const bf16x8*)(QR + qrow * 512 + hc + 32 * ks + 8 * g);
    bf16x8 kf[8][4];
#pragma unroll
    for (int jt = 0; jt < 8; ++jt) if (jt <= wave) { const bf16_t* kp = KR + (c0 + 16 * jt + ln) * 512 + hc + 8 * g;
#pragma unroll
        for (int ks = 0; ks < 4; ++ks) kf[jt][ks] = *(const bf16x8*)(kp + 32 * ks); }
    u32x2 gw[8];
#pragma unroll
    for (int vt = 0; vt < 8; ++vt) gw[vt] = *(const u32x2*)(GR + qrow * 512 + hc + 16 * vt + 4 * g);
    { const int j = tid & 127, vq = tid >> 7;
#pragma unroll
      for (int i = 0; i < 4; ++i)
#pragma unroll
          for (int e = 0; e < 4; ++e) { const unsigned w = rr[i][e]; const int v = 32 * vq + 8 * i + 2 * e;
              *(unsigned short*)(lds + v * PT + 2 * j) = (unsigned short)(w & 0xffffu); *(unsigned short*)(lds + (v + 1) * PT + 2 * j) = (unsigned short)(w >> 16); } }
    __syncthreads();
    f32x4 sT[8];
#pragma unroll
    for (int jt = 0; jt < 8; ++jt) {
        f32x4 d = (f32x4){0.f, 0.f, 0.f, 0.f};
        if (jt <= wave) {
#pragma unroll
            for (int ks = 0; ks < 4; ++ks) d = mfma16(kf[jt][ks], qf[ks], d);
            if (jt == wave) {
#pragma unroll
                for (int r = 0; r < 4; ++r) if (4 * g + r > ln) d[r] = 0.f;
            }
        }
        sT[jt] = d;
    }
    f32x4 oT[8];
    const bf16_t* stp = STATE + (((size_t)b * 4 + h) * 32 + n) * 16384;
#pragma unroll
    for (int vt = 0; vt < 8; ++vt) {
        f32x4 d = (f32x4){0.f, 0.f, 0.f, 0.f};
#pragma unroll
        for (int ks = 0; ks < 4; ++ks) d = mfma16(*(const bf16x8*)(stp + (16 * vt + ln) * 128 + 32 * ks + 8 * g), qf[ks], d);
        oT[vt] = d;
    }
#pragma unroll
    for (int pr = 0; pr < 4; ++pr) if (2 * pr <= wave) {
        u32x4 pw; pw.x = pk2(sT[2 * pr][0], sT[2 * pr][1]); pw.y = pk2(sT[2 * pr][2], sT[2 * pr][3]); pw.z = pk2(sT[2 * pr + 1][0], sT[2 * pr + 1][1]); pw.w = pk2(sT[2 * pr + 1][2], sT[2 * pr + 1][3]);
        const bf16x8 bfr = __builtin_bit_cast(bf16x8, pw);
#pragma unroll
        for (int vt = 0; vt < 8; ++vt) {
            const unsigned char* vp = lds + (16 * vt + ln) * PT + 2 * (32 * pr + 4 * g);
            const u32x2 lo = *(const u32x2*)vp, h2 = *(const u32x2*)(vp + 32); const u32x4 av = (u32x4){lo.x, lo.y, h2.x, h2.y};
            oT[vt] = mfma16(__builtin_bit_cast(bf16x8, av), bfr, oT[vt]);
        }
    }
    float s = 0.f;
#pragma unroll
    for (int vt = 0; vt < 8; ++vt) s += (oT[vt][0] + oT[vt][1]) + (oT[vt][2] + oT[vt][3]);
    s += __shfl_xor(s, 16); s += __shfl_xor(s, 32);
    const float mean = s * (1.0f / 128.0f);
    float q = 0.f;
#pragma unroll
    for (int vt = 0; vt < 8; ++vt)
#pragma unroll
        for (int r = 0; r < 4; ++r) { const float d = oT[vt][r] - mean; q += d * d; }
    q += __shfl_xor(q, 16); q += __shfl_xor(q, 32);
    const float rstd = 1.0f / sqrtf(q * (1.0f / 128.0f) + EPS);
#pragma unroll
    for (int vt = 0; vt < 8; ++vt) {
        const float y0 = (oT[vt][0] - mean) * rstd * bf_lo(gw[vt].x), y1 = (oT[vt][1] - mean) * rstd * bf_hi(gw[vt].x);
        const float y2 = (oT[vt][2] - mean) * rstd * bf_lo(gw[vt].y), y3 = (oT[vt][3] - mean) * rstd * bf_hi(gw[vt].y);
        u32x2 w; w.x = pk2(y0, y1); w.y = pk2(y2, y3);
        *(u32x2*)(AR + qrow * 1024 + 512 + hc + 16 * vt + 4 * g) = w;
    }
    __syncthreads();
}

template <int N> __device__ __forceinline__ void bitonic_sort_desc(unsigned (&a)[N]) {
#pragma unroll
    for (int k = 2; k <= N; k <<= 1)
#pragma unroll
        for (int j = k >> 1; j > 0; j >>= 1)
#pragma unroll
            for (int i = 0; i < N; ++i) { const int l = i ^ j;
                if (l > i) { const unsigned x = a[i], y = a[l]; const unsigned mx = x > y ? x : y, mn = x > y ? y : x;
                    if ((i & k) == 0) { a[i] = mx; a[l] = mn; } else { a[i] = mn; a[l] = mx; } } }
}
template <int N> __device__ __forceinline__ void bitonic_merge_desc(unsigned (&a)[N]) {
#pragma unroll
    for (int j = N >> 1; j > 0; j >>= 1)
#pragma unroll
        for (int i = 0; i < N; ++i) { const int l = i ^ j;
            if (l > i) { const unsigned x = a[i], y = a[l]; a[i] = x > y ? x : y; a[l] = x > y ? y : x; } }
}
__device__ __forceinline__ void top16_merge(unsigned (&best)[16], const unsigned (&grp)[16]) {
#pragma unroll
    for (int i = 0; i < 16; ++i) { const unsigned x = best[i], y = grp[15 - i]; best[i] = x > y ? x : y; }
    bitonic_merge_desc<16>(best);
}
struct CandTab { int a[64], b[64], n; constexpr CandTab() : a{}, b{}, n(0) { for (int x = 0; x < 16; ++x) for (int y = 0; y < 16; ++y) if ((x + 1) * (y + 1) <= 16) { a[n] = x; b[n] = y; ++n; } } };
constexpr CandTab kCand{};
static_assert(kCand.n == 50, "staircase candidates");

constexpr int PL_EID = 0, PL_GATE = 16384, PL_IDX = 32768;
__device__ __forceinline__ void peer_unit(int unit, unsigned char* ws, float* outp, const float* gffn, const float* gfin, unsigned char* lds, int tid, int wave, int lane) {
    volatile LAS unsigned* MISC = (volatile LAS unsigned*)((LAS unsigned char*)lds + MISC_OFF); const int bid = unit;
    TSTAMP(70, 0);
    const bf16_t* SC = (const bf16_t*)(ws + WS_SC);
    const float* mod = (const float*)(ws + WS_MOD);
#ifndef DBG_NOPEER
    {
        const int tl = tid >> 4, h = (tid >> 1) & 7, p = tid & 1;
        const size_t row = (size_t)32 * unit + tl;
        const u32x4* sp = (const u32x4*)(SC + row * 2048 + h * 256 + p * 128);
        unsigned best[16];
#pragma unroll
        for (int grp = 0; grp < 8; ++grp) {
            unsigned k[16];
#pragma unroll
            for (int q4 = 0; q4 < 2; ++q4) { const u32x4 v = sp[2 * grp + q4];
#pragma unroll
                for (int e = 0; e < 4; ++e) { const int n0 = 16 * grp + 8 * q4 + 2 * e;
                    k[8 * q4 + 2 * e] = (sortable32(bf_lo(v[e])) & ~127u) | (unsigned)(127 - n0);
                    k[8 * q4 + 2 * e + 1] = (sortable32(bf_hi(v[e])) & ~127u) | (unsigned)(127 - (n0 + 1)); } }
            bitonic_sort_desc<16>(k);
            if (grp == 0) {
#pragma unroll
                for (int i = 0; i < 16; ++i) best[i] = k[i];
            } else top16_merge(best, k);
        }
        unsigned char* il = lds + PL_IDX + (tl * 8 + h) * 32;
#pragma unroll
        for (int i = 0; i < 4; ++i) { unsigned w = 0;
#pragma unroll
            for (int e = 0; e < 4; ++e) w |= (127u - (best[4 * i + e] & 127u)) << (8 * e);
            *(unsigned*)(il + p * 16 + 4 * i) = w; }
        float v1[16], v2[16];
#pragma unroll
        for (int i = 0; i < 16; ++i) { const unsigned o = __shfl_xor(best[i], 1); const float mine = unsortable32(best[i] & ~127u), oth = unsortable32(o & ~127u);
            v1[i] = p ? oth : mine; v2[i] = p ? mine : oth; }
        unsigned top[16];
#pragma unroll
        for (int grp = 0; grp < 4; ++grp) {
            unsigned k[16];
#pragma unroll
            for (int i = 0; i < 16; ++i) { const int c = 16 * grp + i;
                k[i] = (c < kCand.n) ? ((sortable32(v1[kCand.a[c < kCand.n ? c : 0]] + v2[kCand.b[c < kCand.n ? c : 0]]) & ~255u) | (unsigned)(255 - (16 * kCand.a[c < kCand.n ? c : 0] + kCand.b[c < kCand.n ? c : 0]))) : 0u; }
            bitonic_sort_desc<16>(k);
            if (grp == 0) {
#pragma unroll
                for (int i = 0; i < 16; ++i) top[i] = k[i];
            } else top16_merge(top, k);
        }
        float ts[16], es[16], sum = 0.f;
#pragma unroll
        for (int i = 0; i < 16; ++i) ts[i] = unsortable32(top[i] & ~255u);
#pragma unroll
        for (int i = 0; i < 16; ++i) { es[i] = __expf(ts[i] - ts[0]); sum += es[i]; }
        const float rs = 1.0f / sum;
        __builtin_amdgcn_wave_barrier(); asm volatile("s_waitcnt lgkmcnt(0)" ::: "memory");
        unsigned* eo = (unsigned*)(lds + PL_EID) + tl * 128 + h * 16;
        float* go = (float*)(lds + PL_GATE) + tl * 128 + h * 16;
#pragma unroll
        for (int i = 0; i < 16; ++i) {
            const unsigned flat = 255u - (top[i] & 255u);
            const unsigned i1 = il[flat >> 4], i2 = il[16 + (flat & 15u)];
            eo[i] = i1 * 128u + i2; go[i] = es[i] * rs;
        }
    }
#endif
    __syncthreads();
    TSTAMP(70, 2); TSTAMP(71, 0);
    const unsigned char* U8 = ws + WS_U8; const unsigned char* V8 = ws + WS_V8;
    const float* USC = (const float*)(ws + WS_USC); const float* VSC = (const float*)(ws + WS_VSC);
    const int me = ((lane >> 5) & 1) * 4 + ((lane >> 4) & 1) * 2 + ((lane >> 3) & 1);
#pragma unroll 1
    for (int ti = 0; ti < 4; ++ti) {
        const int tl = wave + 8 * ti; const size_t row = (size_t)32 * unit + tl; const int b = (int)(row >> 12);
        const float* mb = mod + b * 6144;
        float x1v[16], hv[16], acc[16];
        const float rstd = pg8::row_rstd((const float*)(ws + WS_SUMSQ), (int)row);
#pragma unroll
        for (int q4 = 0; q4 < 4; ++q4) { const int c = 16 * lane + 4 * q4;
            const f32x4 xv = *(const f32x4*)(outp + row * DM + c), g = *(const f32x4*)(gffn + c), sc = *(const f32x4*)(mb + 4096 + c), sh = *(const f32x4*)(mb + 3072 + c);
#pragma unroll
            for (int e = 0; e < 4; ++e) { const int i = 4 * q4 + e; x1v[i] = xv[e]; hv[i] = xv[e] * rstd * g[e] * (1.0f + sc[e]) + sh[e]; acc[i] = 0.f; } }
        const unsigned* el = (const unsigned*)(lds + PL_EID) + tl * 128; const float* gl = (const float*)(lds + PL_GATE) + tl * 128;
        u32x4 uA[8], vA[8]; float guA, gvA;
#define PEER_LOAD(U_, V_, GU_, GV_, e0_) do { _Pragma("unroll") for (int k = 0; k < 8; ++k) { const unsigned eid = el[(e0_) + k]; \
            U_[k] = *((const u32x4*)(U8 + (size_t)eid * 1024) + lane); V_[k] = *((const u32x4*)(V8 + (size_t)eid * 1024) + lane); } \
        { const unsigned em = el[(e0_) + me]; GU_ = USC[em]; GV_ = VSC[em] * gl[(e0_) + me]; } } while (0)
#define PEER_COMP(U_, V_, GU_, GV_) do { float pd[8]; \
        _Pragma("unroll") for (int k = 0; k < 8; ++k) { float d = 0.f; \
            _Pragma("unroll") for (int i = 0; i < 4; ++i) { const f32x2 lo = __builtin_amdgcn_cvt_pk_f32_fp8(U_[k][i], false), hi2 = __builtin_amdgcn_cvt_pk_f32_fp8(U_[k][i], true); \
                d += hv[4 * i] * lo.x; d += hv[4 * i + 1] * lo.y; d += hv[4 * i + 2] * hi2.x; d += hv[4 * i + 3] * hi2.y; } \
            pd[k] = d; } \
        float q4_[4], r2_[2], s_; \
        _Pragma("unroll") for (int k = 0; k < 4; ++k) { const float keep = (lane & 32) ? pd[k + 4] : pd[k], send = (lane & 32) ? pd[k] : pd[k + 4]; q4_[k] = keep + __shfl_xor(send, 32); } \
        _Pragma("unroll") for (int k = 0; k < 2; ++k) { const float keep = (lane & 16) ? q4_[k + 2] : q4_[k], send = (lane & 16) ? q4_[k] : q4_[k + 2]; r2_[k] = keep + __shfl_xor(send, 16); } \
        { const float keep = (lane & 8) ? r2_[1] : r2_[0], send = (lane & 8) ? r2_[0] : r2_[1]; s_ = keep + __shfl_xor(send, 8); } \
        s_ += __shfl_xor(s_, 4); s_ += __shfl_xor(s_, 2); s_ += __shfl_xor(s_, 1); \
        const float cf_ = GV_ * gelu_exact(s_ * GU_); \
        _Pragma("unroll") for (int k = 0; k < 8; ++k) { const float c = __uint_as_float((unsigned)__builtin_amdgcn_readlane((int)__float_as_uint(cf_), 32 * (k >> 2) + 16 * ((k >> 1) & 1) + 8 * (k & 1))); \
            _Pragma("unroll") for (int i = 0; i < 4; ++i) { const f32x2 lo = __builtin_amdgcn_cvt_pk_f32_fp8(V_[k][i], false), hi2 = __builtin_amdgcn_cvt_pk_f32_fp8(V_[k][i], true); \
                acc[4 * i] += c * lo.x; acc[4 * i + 1] += c * lo.y; acc[4 * i + 2] += c * hi2.x; acc[4 * i + 3] += c * hi2.y; } } } while (0)
#pragma unroll 1
        for (int e0 = 0; e0 < 128; e0 += 8) {
            PEER_LOAD(uA, vA, guA, gvA, e0);
            PEER_COMP(uA, vA, guA, gvA);
        }
#undef PEER_LOAD
#undef PEER_COMP
        float ss = 0.f;
#pragma unroll
        for (int q4 = 0; q4 < 4; ++q4) { const int c = 16 * lane + 4 * q4; const f32x4 gf = *(const f32x4*)(mb + 5120 + c);
#pragma unroll
            for (int e = 0; e < 4; ++e) { const int i = 4 * q4 + e; x1v[i] = x1v[i] + gf[e] * acc[i]; ss += x1v[i] * x1v[i]; } }
        const float r2 = 1.0f / sqrtf(wave_sum(ss) * (1.0f / DM) + EPS);
#pragma unroll
        for (int q4 = 0; q4 < 4; ++q4) { const int c = 16 * lane + 4 * q4; const f32x4 gn = *(const f32x4*)(gfin + c);
            f32x4 o;
#pragma unroll
            for (int e = 0; e < 4; ++e) o[e] = x1v[4 * q4 + e] * r2 * gn[e];
            *(f32x4*)(outp + row * DM + c) = o; }
    }
    __syncthreads();
    TSTAMP(71, 2);
}

#define XB_TMO      128
#define XB_XCNT(j)  (256  + 64 * (j))
#define XB_XSUB(j)  (1280 + 64 * (j))
#define XB_XGEN(j)  (2304 + 64 * (j))
#define XB_TOP      3328
#define XB_TOPGEN   3392
#define XCD_BAR_WORDS 3456
#define XB_SPIN_CAP (1u << 18)

__device__ __forceinline__ unsigned xb_ld(unsigned* p)              { return __hip_atomic_load(p, __ATOMIC_RELAXED, __HIP_MEMORY_SCOPE_AGENT); }
__device__ __forceinline__ unsigned xb_add(unsigned* p, unsigned v) { return __hip_atomic_fetch_add(p, v, __ATOMIC_RELAXED, __HIP_MEMORY_SCOPE_AGENT); }
__device__ __forceinline__ unsigned xb_xcc_id() { return (unsigned)__builtin_amdgcn_s_getreg((3 << 11) | 20) & 0xFu; }
#define XB_SPIN(cond, bar) do { unsigned _sp = 0; while (cond) { __builtin_amdgcn_s_sleep(1); \
    if ((++_sp & 255u) == 0u) { if (xb_ld(&(bar)[XB_TMO])) break; if (_sp > XB_SPIN_CAP) { atomicAdd(&(bar)[XB_TMO], 1u); break; } } } } while (0)

struct XcdBarrier {
    unsigned* bar; unsigned x;
    volatile LAS unsigned* st;
};

__device__ __forceinline__ XcdBarrier xcd_barrier_post(unsigned* bar, volatile LAS unsigned* st) {
    XcdBarrier b; b.bar = bar; b.x = xb_xcc_id(); b.st = st;
    if (threadIdx.x == 0) (void)xb_add(&bar[XB_XCNT(b.x)], 1u);
    return b;
}
__device__ __forceinline__ void xcd_barrier_complete(unsigned* bar, unsigned x, unsigned& nloc, unsigned& nx) {
    const unsigned G = gridDim.x * gridDim.y * gridDim.z;
    unsigned sum, cnt, mine, sp = 0u;
    for (;;) {
        sum = 0u; cnt = 0u; mine = 0u;
#pragma unroll
        for (unsigned j = 0; j < 16; ++j) { const unsigned c = xb_ld(&bar[XB_XCNT(j)]); sum += c; cnt += (c > 0u) ? 1u : 0u; mine = (j == x) ? c : mine; }
        if (sum == G) break;
        __builtin_amdgcn_s_sleep(1);
        if ((++sp & 255u) == 0u) { if (xb_ld(&bar[XB_TMO])) break; if (sp > XB_SPIN_CAP) { atomicAdd(&bar[XB_TMO], 1u); break; } }
    }
    nloc = mine > 0u ? mine : 1u; nx = cnt > 0u ? cnt : 1u;
}

__device__ __forceinline__ void xcd_barrier(const XcdBarrier& b) {
    asm volatile("s_waitcnt vmcnt(0)" ::: "memory");
    __syncthreads();
    if (threadIdx.x == 0) {
        unsigned* bar = b.bar;
        __builtin_amdgcn_s_waitcnt(0);
        unsigned nloc = b.st[0], nx = b.st[1];
        if (nloc == 0u) { xcd_barrier_complete(bar, b.x, nloc, nx); b.st[0] = nloc; b.st[1] = nx; }
        const unsigned old = xb_add(&bar[XB_XSUB(b.x)], 1u);
        const unsigned gen = old / nloc;
        if (old + 1u == (gen + 1u) * nloc) {
            __builtin_amdgcn_fence(__ATOMIC_RELEASE, "agent");
            asm volatile("s_waitcnt vmcnt(0)" ::: "memory");
            const unsigned og = xb_add(&bar[XB_TOP], 1u);
            const unsigned tg = og / nx;
            if (og + 1u == (tg + 1u) * nx) xb_add(&bar[XB_TOPGEN], 1u);
            else XB_SPIN(xb_ld(&bar[XB_TOPGEN]) == tg, bar);
            __builtin_amdgcn_fence(__ATOMIC_ACQUIRE, "agent");
            xb_add(&bar[XB_XGEN(b.x)], 1u);
            asm volatile("s_waitcnt vmcnt(0)" ::: "memory");
        } else {
            XB_SPIN(xb_ld(&bar[XB_XGEN(b.x)]) == gen, bar);
            __builtin_amdgcn_fence(__ATOMIC_ACQUIRE, "agent");
            asm volatile("s_waitcnt vmcnt(0)" ::: "memory");
        }
    }
    __syncthreads();
}

constexpr int N_PHASES = 8;
__global__ void __launch_bounds__(NTHREADS, 2) mega(Args a) {
    extern __shared__ __attribute__((aligned(16))) unsigned char lds[];
    const int tid = threadIdx.x, lane = tid & 63, wave = __builtin_amdgcn_readfirstlane(tid >> 6);
    const int bid = blockIdx.x, G = gridDim.x;
    unsigned char* ws = a.ws;
    const int lo = a.ph_lo, hi = a.ph_hi;
    volatile LAS unsigned* MISC = (volatile LAS unsigned*)((LAS unsigned char*)lds + MISC_OFF);
    if (tid < 16) MISC[tid] = 0u;
    __syncthreads();
    XcdBarrier bar; bar.bar = (unsigned*)(ws + WS_CTL) + CW_BAR; bar.x = 0; bar.st = nullptr;
    if (hi - lo > 1) bar = xcd_barrier_post((unsigned*)(ws + WS_CTL) + CW_BAR, MISC + 8);
#ifndef PH_MASK
#define PH_MASK 0xFF
#endif
#define IN(k) (((PH_MASK >> (k)) & 1) && lo <= (k) && (k) < hi)
#define SEAM(k) do { if (IN(k) && IN((k) + 1)) { xcd_barrier(bar); } } while (0)
#ifdef REP_PH
#ifndef REP_N
#define REP_N 1
#endif
#define REPS(k) for (int rep_ = 0; rep_ < ((k) == REP_PH ? 1 + REP_N : 1); ++rep_, ((k) == REP_PH && rep_ <= REP_N ? (xcd_barrier(bar), 0) : 0))
#else
#define REPS(k)
#endif

    TSTAMP(100, 0);
    TSTAMP(0, 0);
    REPS(0) if (IN(0)) phase0(a, lds, tid, wave, lane, bid, G);
    SEAM(0);
    TSTAMP(0, 2);
    TSTAMP(1, 0);
    REPS(1) if (IN(1)) phase1(a, wave, lane, bid, G);
    SEAM(1);
    TSTAMP(1, 2);
    TSTAMP(2, 0);
    REPS(2) if (IN(2)) {
        pg8::Gemm g{(const bf16_t*)(ws + WS_BUFA), (const bf16_t*)(ws + WS_WIN), MTOK, N1, DM}; pg8::StaticOrder S; S.init(MTOK, N1, G, bid);
        pg8::Epi1 E{ws};
        pg8::gemm_phase<pg8::Epi1, pg8::StaticOrder, true, true>((LAS unsigned char*)lds, g, S, E);
        const int nfull = (MTOK / 256) * (N1 / 256) - 4 * G;
        { const bool tail = nfull > 0 && nfull < G; const int cw = tail ? (bid - nfull) * 8 + wave : bid * 8 + wave, NCW = tail ? (G - nfull) * 8 : G * 8;
          if (!tail || bid >= nfull)
              for (int it = cw; it < 4096; it += NCW) { const int r = 4 * it;
                  rows_to_fp8<4>(a.in[11] + (size_t)r * 1024, ws + WS_V8 + (size_t)r * 1024, (float*)(ws + WS_VSC) + r, lane); } }
    }
    SEAM(2);
    TSTAMP(2, 2);
    TSTAMP(3, 0);
    REPS(3) if (IN(3)) {
        TSTAMP(30, 0);
        for (int u = bid; u < 256; u += G)
            ret_state_unit(u >> 6, (u >> 4) & 3, (u >> 1) & 7, u & 1, (const bf16_t*)(ws + WS_KR), (const bf16_t*)(ws + WS_VR), (bf16_t*)(ws + WS_STATE), lds, tid, wave, lane);
        TSTAMP(30, 2); TSTAMP(31, 0);
        for (int k = bid; k < 256; k += G)
#pragma unroll 1
            for (int i = 0; i < 4; ++i) {
                const int b = i, qt = (i < 2) ? k : 255 - k;
                idx_unit(b, qt, (const bf16_t*)(ws + WS_QI), (const bf16_t*)(ws + WS_KI), (const float*)(ws + WS_WI), (unsigned long long*)(ws + WS_MASK), lds, wave, lane, bid == TPROBE_B && i == TPROBE_I);
            }
        TSTAMP(31, 2);
    }
    SEAM(3);
    TSTAMP(3, 2);
    TSTAMP(4, 0);
    REPS(4) if (IN(4)) {
        TSTAMP(40, 0);
        for (int k = bid; k < 256; k += G) {
            const int bh = k >> 3, s = k & 7;
#pragma unroll 1
            for (int i = 0; i < 2; ++i)
                attn_unit(bh >> 3, bh & 7, i ? 15 - s : s, (const bf16_t*)(ws + WS_QA), (const bf16_t*)(ws + WS_KA), (const bf16_t*)(ws + WS_VA), (const unsigned long long*)(ws + WS_MASK),
                          (bf16_t*)(ws + WS_BUFB), lds, tid, wave, lane);
        }
        TSTAMP(40, 2); TSTAMP(41, 0);
        for (int u = bid; u < 512; u += G)
            ret_out_unit(u >> 7, (u >> 5) & 3, u & 31, (const bf16_t*)(ws + WS_QR), (const bf16_t*)(ws + WS_KR), (const bf16_t*)(ws + WS_VR), (const bf16_t*)(ws + WS_GR),
                         (const bf16_t*)(ws + WS_STATE), (bf16_t*)(ws + WS_BUFB), lds, tid, wave, lane);
        TSTAMP(41, 2);
    }
    SEAM(4);
    TSTAMP(4, 2);
    TSTAMP(5, 0);
    REPS(5) if (IN(5)) {
        pg8::Gemm g{(const bf16_t*)(ws + WS_BUFB), (const bf16_t*)(ws + WS_WOUT), MTOK, DM, DM}; pg8::StaticOrder S; S.init(MTOK, DM, G, bid);
        pg8::Epi2 E{a.in[0], a.out, (bf16_t*)(ws + WS_BUFA), (const float*)(ws + WS_MOD), a.in[7], (float*)(ws + WS_SUMSQ)};
        pg8::gemm_phase<pg8::Epi2, pg8::StaticOrder, true, true>((LAS unsigned char*)lds, g, S, E);
    }
    SEAM(5);
    TSTAMP(5, 2);
    TSTAMP(6, 0);
    REPS(6) if (IN(6)) {
        pg8::Gemm g{(const bf16_t*)(ws + WS_BUFA), (const bf16_t*)(ws + WS_WPQ), MTOK, 2048, DM}; pg8::StaticOrder S; S.init(MTOK, 2048, G, bid);
        pg8::Epi3 E{(const float*)(ws + WS_SUMSQ), (const float*)(ws + WS_BIASF), (bf16_t*)(ws + WS_SC)};
        pg8::gemm_phase<pg8::Epi3, pg8::StaticOrder, true, true>((LAS unsigned char*)lds, g, S, E);
    }
    SEAM(6);
    TSTAMP(6, 2);
    TSTAMP(7, 0);
    if (IN(7)) {
        for (int u = bid; u < 512; u += G) peer_unit(u, ws, a.out, a.in[7], a.in[12], lds, tid, wave, lane);
    }
    TSTAMP(7, 2);
    TSTAMP(100, 2);
#ifdef TIME_PH
    if (bid == TPROBE_B && tid == 0) {
        const unsigned long long t0_ = ((unsigned long long)MISC[1] << 32) | MISC[0], t1_ = ((unsigned long long)MISC[3] << 32) | MISC[2];
        const unsigned long long until_ = __builtin_amdgcn_s_memrealtime() + (unsigned long long)TIME_AMP * (t1_ - t0_);
        while (__builtin_amdgcn_s_memrealtime() < until_) __builtin_amdgcn_s_sleep(8);
    }
#endif
#undef IN
#undef SEAM
}

extern "C" void kernel_launch(void* const* d_in, const int* in_sizes, int n_in, void* d_out, int out_size, void* d_ws, size_t ws_size, hipStream_t stream) {
    static int grid = 0;
    if (grid == 0) {
        if (n_in != 13 || out_size != MTOK * DM || ws_size < WS_END) { fprintf(stderr, "kernel_launch: unexpected shapes (n_in %d, out %d, ws %zu); nothing launched\n", n_in, out_size, ws_size); grid = -1; return; }
        int dev = 0, cus = 0, per_cu = 0;
        if (hipGetDevice(&dev) != hipSuccess || hipDeviceGetAttribute(&cus, hipDeviceAttributeMultiprocessorCount, dev) != hipSuccess) { grid = -1; return; }
        if (hipFuncSetAttribute((const void*)mega, hipFuncAttributeMaxDynamicSharedMemorySize, LDS_BYTES) != hipSuccess) { fprintf(stderr, "kernel_launch: hipFuncSetAttribute failed\n"); grid = -1; return; }
        if (hipOccupancyMaxActiveBlocksPerMultiprocessor(&per_cu, (const void*)mega, NTHREADS, LDS_BYTES) != hipSuccess || per_cu < 1) { fprintf(stderr, "kernel_launch: occupancy query gave %d\n", per_cu); per_cu = 1; }
        (void)hipGetLastError();
        grid = cus;
    }
    if (grid < 0) return;
    if (hipMemsetAsync((char*)d_ws + WS_CTL, 0, CTL_BYTES, stream) != hipSuccess) { fprintf(stderr, "kernel_launch: memset failed\n"); return; }
    Args a{};
    for (int i = 0; i < 13; ++i) a.in[i] = (const float*)d_in[i];
    a.out = (float*)d_out; a.ws = (unsigned char*)d_ws;
#if MK_MULTI
    for (int p = 0; p < N_PHASES; ++p) { a.ph_lo = p; a.ph_hi = p + 1; hipLaunchKernelGGL(mega, dim3(grid), dim3(NTHREADS), LDS_BYTES, stream, a); }
#else
    a.ph_lo = 0; a.ph_hi = N_PHASES;
    hipLaunchKernelGGL(mega, dim3(grid), dim3(NTHREADS), LDS_BYTES, stream, a);
#endif
}
```

```cpp
#include <hip/hip_runtime.h>
#include <cstdio>
#include <cstdint>

#ifndef MK_MULTI
#define MK_MULTI 0
#endif

#define GAS __attribute__((address_space(1)))
#define LAS __attribute__((address_space(3)))
typedef unsigned short bf16_t;
typedef short bf16x8 __attribute__((ext_vector_type(8)));
typedef float f32x4 __attribute__((ext_vector_type(4)));
typedef float f32x16 __attribute__((ext_vector_type(16)));
typedef unsigned u32x4 __attribute__((ext_vector_type(4)));
typedef unsigned u32x2 __attribute__((ext_vector_type(2)));

constexpr int BATCH = 4, SEQ = 4096, DM = 1024, MTOK = BATCH * SEQ;
constexpr int N1 = 4352;
constexpr int NTHREADS = 512;
constexpr float EPS = 1e-6f;
constexpr float C_QK = 0.18033688011112042f;
constexpr float NEG_INF = -__builtin_huge_valf();

__device__ __forceinline__ float ret_log2g(int h) { return h == 0 ? -0.045803689613124791f : h == 1 ? -0.022720076500083530f : h == 2 ? -0.011315313227834147f : -0.0056465631411420624f; }
__device__ __forceinline__ float ret_gamma(int h) { return h == 0 ? 0.96875f : h == 1 ? 0.984375f : h == 2 ? 0.9921875f : 0.99609375f; }
__device__ __forceinline__ float ret_g128(int h) { return h == 0 ? 0.017183023570817902f : h == 1 ? 0.13321516287964842f : h == 2 ? 0.36643771592203725f : 0.60593708822908032f; }
__device__ __forceinline__ float ret_g127(int h) { return h == 0 ? 0.017737314653747512f : h == 1 ? 0.13532968927456347f : h == 2 ? 0.36932305226788007f : 0.60831331210448848f; }

constexpr size_t MiB = 1u << 20;
constexpr size_t WS_CTL = 0, CTL_BYTES = 1 * MiB;
constexpr size_t WS_SUMSQ = 5 * MiB;
constexpr size_t WS_MOD = 1 * MiB;
constexpr size_t WS_BIASF = 1 * MiB + 128 * 1024;
constexpr size_t WS_COSA = 2 * MiB, WS_SINA = 2 * MiB + 512 * 1024;
constexpr size_t WS_COSR = 3 * MiB, WS_SINR = 4 * MiB;
constexpr size_t WS_WIN = 6 * MiB;
constexpr size_t WS_WOUT = 15 * MiB;
constexpr size_t WS_WPQ = 17 * MiB;
constexpr size_t WS_BUFA = 22 * MiB;
constexpr size_t WS_MASK = WS_BUFA, WS_STATE = WS_BUFA + 8 * MiB;
constexpr size_t WS_BUFB = 54 * MiB;
constexpr size_t WS_G1 = 86 * MiB;
constexpr size_t WS_QA = WS_G1, WS_KA = WS_G1 + 16 * MiB, WS_VA = WS_G1 + 32 * MiB, WS_QI = WS_G1 + 48 * MiB, WS_QR = WS_G1 + 64 * MiB,
                 WS_KR = WS_G1 + 80 * MiB, WS_VR = WS_G1 + 96 * MiB, WS_GR = WS_G1 + 112 * MiB, WS_KI = WS_G1 + 128 * MiB, WS_WI = WS_G1 + 130 * MiB;
constexpr size_t WS_SC = WS_G1;
constexpr size_t WS_U8 = 217 * MiB, WS_V8 = 233 * MiB;
constexpr size_t WS_USC = 249 * MiB, WS_VSC = 249 * MiB + 65536;
constexpr size_t WS_END = 256 * MiB;
static_assert(WS_WI + (size_t)MTOK * 8 * 4 <= WS_U8 && WS_SC + (size_t)MTOK * 2048 * 4 <= WS_U8 && WS_VSC + 65536 <= WS_END, "ws map");
constexpr int LDS_BYTES = 147456;
constexpr int MISC_OFF = LDS_BYTES - 64;
constexpr int CW_BAR = 4096;

__device__ __forceinline__ unsigned f2bf(float f) { unsigned u = __float_as_uint(f); return (u + 0x7fffu + ((u >> 16) & 1u)) >> 16; }
typedef float f32x2_t __attribute__((ext_vector_type(2))); typedef __bf16 bf16x2_t __attribute__((ext_vector_type(2)));
__device__ __forceinline__ unsigned pk2(float lo, float hi) { const f32x2_t v = {lo, hi}; const bf16x2_t b = __builtin_convertvector(v, bf16x2_t); return __builtin_bit_cast(unsigned, b); }
__device__ __forceinline__ float bf_lo(unsigned w) { return __uint_as_float(w << 16); }
__device__ __forceinline__ float bf_hi(unsigned w) { return __uint_as_float(w & 0xffff0000u); }
__device__ __forceinline__ float wave_sum(float v) {
#pragma unroll
    for (int o = 1; o < 64; o <<= 1) v += __shfl_xor(v, o);
    return v;
}
__device__ __forceinline__ float fast_exp2(float x) { return __builtin_amdgcn_exp2f(x); }
__device__ __forceinline__ float gelu_exact(float v) {
    const float av = fabsf(v), t = __builtin_amdgcn_rcpf(av * 0.2316418882f + 1.0f);
    float q = t * 0.5307027145f + (-0.7265760135f); q = q * t + 0.7107068705f; q = q * t + (-0.142248368f); q = q * t + 0.127414796f; q = q * t;
    const float e = fast_exp2(v * v * (-0.72134752044f));
    const float m = v * (q * e);
    return v < 0.f ? m : v - m;
}
__device__ __forceinline__ float silu_f(float v) { return v / (1.0f + __expf(-v)); }
__device__ __forceinline__ unsigned sortable32(float f) { const unsigned u = __float_as_uint(f); return (u & 0x80000000u) ? ~u : (u | 0x80000000u); }
__device__ __forceinline__ float unsortable32(unsigned s) { return __uint_as_float((s & 0x80000000u) ? (s ^ 0x80000000u) : ~s); }
__device__ __forceinline__ unsigned sortable16(float x) {
    const _Float16 h = (_Float16)x; const unsigned b = (unsigned)__builtin_bit_cast(unsigned short, h);
    return (b & 0x8000u) ? (~b & 0xFFFFu) : (b | 0x8000u);
}
__device__ __forceinline__ f32x4 mfma16(bf16x8 a, bf16x8 b, f32x4 c) { return __builtin_amdgcn_mfma_f32_16x16x32_bf16(a, b, c, 0, 0, 0); }
__device__ __forceinline__ f32x16 mfma32(bf16x8 a, bf16x8 b, f32x16 c) { return __builtin_amdgcn_mfma_f32_32x32x16_bf16(a, b, c, 0, 0, 0); }

__host__ __device__ __forceinline__ int win_src_col(int p) {
    const int tile = p >> 8, bj = (p >> 7) & 1, q = p & 127;
    if (tile < 4) return 256 * tile + (q >> 5) * 64 + bj * 32 + (q & 31);
    if (tile < 6) return p;
    if (tile < 8) return 256 * tile + (q >> 5) * 64 + bj * 32 + (q & 31);
    if (tile == 8) { if (q < 32) return 2048 + bj * 32 + q; if (bj == 0 && q < 40) return 2112 + (q - 32); return -1; }
    if (tile < 13) { const int base = (tile < 11) ? 2120 + 256 * (tile - 9) : 2632 + 256 * (tile - 11); return base + (q >> 6) * 128 + bj * 64 + (q & 63); }
    if (tile < 15) return 3144 + (p - 13 * 256);
    return 3656 + (p - 15 * 256);
}
namespace pg8 {
#define PG8_LAS __attribute__((address_space(3)))
typedef unsigned short bf16_t;
typedef short bf16x8 __attribute__((ext_vector_type(8)));
typedef float f32x4 __attribute__((ext_vector_type(4)));
typedef unsigned u32x4 __attribute__((ext_vector_type(4)));
constexpr int BM = 256, BK = 64, HALF = 128, HTB = HALF * BK * 2  , STAGE_BYTES = 8 * HTB, NXCD = 8, WGM = 8;

__host__ __device__ __forceinline__ int lds_byte(int r, int c) { const int st = (r >> 4) * 2 + (c >> 5), rr = r & 15, cc = c & 31, ob = rr * 64 + cc * 2; return st * 1024 + (ob ^ (((ob >> 9) & 1) << 5)); }
__host__ __device__ __forceinline__ void stage_rc(int b, int& R, int& C) { const int st = b / 1024, sb = b % 1024, swz = sb ^ (((sb >> 9) & 1) << 5); R = (st >> 1) * 16 + swz / 64; C = (st & 1) * 32 + (swz % 64) / 2; }
__host__ __device__ __forceinline__ int perm32(int rho) { const int n = rho >> 4, i = rho & 15; return 8 * (i >> 2) + 4 * n + (i & 3); }

struct Unit { int pm, pn; };
struct Gemm { const bf16_t* A; const bf16_t* Bt; int M, N, K; };

struct StaticOrder {
    int nM, nN, nwg, G, c;
    __host__ __device__ void init(int M, int N, int G_, int c_) { nM = M / BM; nN = N / BM; nwg = nM * nN; G = G_; c = c_; }
    __host__ __device__ bool next(int i, Unit& u) const {
        const long L = (long)i * G + c; if (L >= nwg) return false;
        int wgid = (int)L; { const int q = nwg / NXCD, r = nwg % NXCD, xcd = wgid % NXCD, off = wgid / NXCD; wgid = (xcd < r ? xcd * (q + 1) : r * (q + 1) + (xcd - r) * q) + off; }
        const int nig = WGM * nN, gid = wgid / nig, fm = gid * WGM, gsz = (nM - fm) < WGM ? (nM - fm) : WGM;
        u.pm = fm + ((wgid % nig) % gsz); u.pn = (wgid % nig) / gsz; return true;
    }
    __device__ __forceinline__ void a_ready(const Unit&) const {}
    __device__ __forceinline__ void done(const Unit&) const {}
};

__device__ __forceinline__ unsigned cvt_pk_bf16(float lo, float hi) { unsigned r; asm volatile("v_cvt_pk_bf16_f32 %0, %1, %2" : "=v"(r) : "v"(lo), "v"(hi)); return r; }
__device__ __forceinline__ u32x4 pack8(const float (&v)[8]) { u32x4 w; w.x = cvt_pk_bf16(v[0], v[1]); w.y = cvt_pk_bf16(v[2], v[3]); w.z = cvt_pk_bf16(v[4], v[5]); w.w = cvt_pk_bf16(v[6], v[7]); return w; }

struct Epi1 {
    static constexpr bool PERM = true, AFTER_DRAIN = false;
    unsigned char* ws;
    __device__ __forceinline__ void operator()(const f32x4 (&acc)[2][2][4][2], const Unit& u, int wr, int wc, int fr, int fq) const {
        const int tile = u.pn;
        const int row0 = u.pm * BM + wr * 64 + fr;
        const float* cosA = (const float*)(ws + WS_COSA); const float* sinA = (const float*)(ws + WS_SINA);
        const float* cosR = (const float*)(ws + WS_COSR); const float* sinR = (const float*)(ws + WS_SINR);
        if (tile < 4 || tile == 6 || tile == 7) {
            bf16_t* dst = (bf16_t*)(ws + (tile < 2 ? WS_QA : tile < 4 ? WS_KA : WS_QI));
            const int tl = tile < 2 ? tile : tile < 4 ? tile - 2 : tile - 6;
            const float scale = tile < 2 ? C_QK : 1.0f;
            const int cb = 256 * tl + 64 * wc, i0 = 8 * fq;
#pragma unroll
            for (int ai = 0; ai < 2; ++ai)
#pragma unroll
                for (int m = 0; m < 4; ++m) {
                    const int row = row0 + ai * HALF + m * 16, pos = row & (SEQ - 1);
                    const f32x4 c0 = *(const f32x4*)(cosA + pos * 32 + i0), c1 = *(const f32x4*)(cosA + pos * 32 + i0 + 4);
                    const f32x4 s0 = *(const f32x4*)(sinA + pos * 32 + i0), s1 = *(const f32x4*)(sinA + pos * 32 + i0 + 4);
                    float y1[8], y2[8];
#pragma unroll
                    for (int n = 0; n < 2; ++n)
#pragma unroll
                        for (int e = 0; e < 4; ++e) {
                            const float x1 = acc[ai][0][m][n][e], x2 = acc[ai][1][m][n][e];
                            const float c = n ? c1[e] : c0[e], s = n ? s1[e] : s0[e];
                            y1[4 * n + e] = (x1 * c - x2 * s) * scale; y2[4 * n + e] = (x1 * s + x2 * c) * scale;
                        }
                    bf16_t* rp = dst + (size_t)row * 512 + cb + i0;
                    *(u32x4*)rp = pack8(y1); *(u32x4*)(rp + 32) = pack8(y2);
                }
        } else if (tile == 4 || tile == 5 || tile >= 13) {
            bf16_t* dst = (bf16_t*)(ws + (tile < 6 ? WS_VA : tile < 15 ? WS_VR : WS_GR));
            const int tl = tile < 6 ? tile - 4 : tile < 15 ? tile - 13 : tile - 15;
            const bool act = tile >= 15;
#pragma unroll
            for (int ai = 0; ai < 2; ++ai)
#pragma unroll
                for (int m = 0; m < 4; ++m) {
                    const int row = row0 + ai * HALF + m * 16;
#pragma unroll
                    for (int bj = 0; bj < 2; ++bj) {
                        float y[8];
#pragma unroll
                        for (int n = 0; n < 2; ++n)
#pragma unroll
                            for (int e = 0; e < 4; ++e) { const float v = acc[ai][bj][m][n][e]; y[4 * n + e] = act ? silu_f(v) : v; }
                        *(u32x4*)(dst + (size_t)row * 512 + 256 * tl + 128 * bj + 32 * wc + 8 * fq) = pack8(y);
                    }
                }
        } else if (tile == 8) {
#pragma unroll
            for (int ai = 0; ai < 2; ++ai)
#pragma unroll
                for (int m = 0; m < 4; ++m) {
                    const int row = row0 + ai * HALF + m * 16, pos = row & (SEQ - 1);
                    if (wc == 0) {
                        const int i0 = 8 * fq;
                        const f32x4 c0 = *(const f32x4*)(cosA + pos * 32 + i0), c1 = *(const f32x4*)(cosA + pos * 32 + i0 + 4);
                        const f32x4 s0 = *(const f32x4*)(sinA + pos * 32 + i0), s1 = *(const f32x4*)(sinA + pos * 32 + i0 + 4);
                        float y1[8], y2[8];
#pragma unroll
                        for (int n = 0; n < 2; ++n)
#pragma unroll
                            for (int e = 0; e < 4; ++e) {
                                const float x1 = acc[ai][0][m][n][e], x2 = acc[ai][1][m][n][e];
                                const float c = n ? c1[e] : c0[e], s = n ? s1[e] : s0[e];
                                y1[4 * n + e] = x1 * c - x2 * s; y2[4 * n + e] = x1 * s + x2 * c;
                            }
                        bf16_t* rp = (bf16_t*)(ws + WS_KI) + (size_t)row * 64 + i0;
                        *(u32x4*)rp = pack8(y1); *(u32x4*)(rp + 32) = pack8(y2);
                    } else if (wc == 1 && fq == 0) {
                        const float sw = 0.35355339059327379f;
                        float* WI = (float*)(ws + WS_WI);
                        *(f32x4*)(WI + (size_t)row * 8) = acc[ai][0][m][0] * sw;
                        *(f32x4*)(WI + (size_t)row * 8 + 4) = acc[ai][0][m][1] * sw;
                    }
                }
        } else {
            const bool isk = tile >= 11;
            bf16_t* dst = (bf16_t*)(ws + (isk ? WS_KR : WS_QR));
            const int tl = isk ? tile - 11 : tile - 9, hl = wc >> 1, h = 2 * tl + hl;
            const int i0 = 32 * (wc & 1) + 8 * fq, cb = 256 * tl + 128 * hl;
            const float lg = isk ? -ret_log2g(h) : ret_log2g(h);
            const float base = isk ? 0.08838834764831845f : 1.0f;
#pragma unroll
            for (int ai = 0; ai < 2; ++ai)
#pragma unroll
                for (int m = 0; m < 4; ++m) {
                    const int row = row0 + ai * HALF + m * 16, pos = row & (SEQ - 1);
                    const float dec = base * fast_exp2(lg * (float)(pos & 127));
                    const f32x4 c0 = *(const f32x4*)(cosR + pos * 64 + i0), c1 = *(const f32x4*)(cosR + pos * 64 + i0 + 4);
                    const f32x4 s0 = *(const f32x4*)(sinR + pos * 64 + i0), s1 = *(const f32x4*)(sinR + pos * 64 + i0 + 4);
                    float y1[8], y2[8];
#pragma unroll
                    for (int n = 0; n < 2; ++n)
#pragma unroll
                        for (int e = 0; e < 4; ++e) {
                            const float x1 = acc[ai][0][m][n][e], x2 = acc[ai][1][m][n][e];
                            const float c = n ? c1[e] : c0[e], s = n ? s1[e] : s0[e];
                            y1[4 * n + e] = (x1 * c - x2 * s) * dec; y2[4 * n + e] = (x1 * s + x2 * c) * dec;
                        }
                    bf16_t* rp = dst + (size_t)row * 512 + cb + i0;
                    *(u32x4*)rp = pack8(y1); *(u32x4*)(rp + 64) = pack8(y2);
                }
        }
    }
};

__device__ __forceinline__ float row_rstd(const float* sumsq, int row) {
    const f32x4* p = (const f32x4*)(sumsq + (size_t)row * 16);
    const f32x4 a = p[0], b = p[1], c = p[2], d = p[3];
    const float s = (((a[0] + a[1]) + (a[2] + a[3])) + ((b[0] + b[1]) + (b[2] + b[3]))) + (((c[0] + c[1]) + (c[2] + c[3])) + ((d[0] + d[1]) + (d[2] + d[3])));
    return 1.0f / sqrtf(s * (1.0f / DM) + EPS);
}
struct Epi2 {
    static constexpr bool PERM = false, AFTER_DRAIN = false;
    const float* x; float* x1; bf16_t* a3; const float* mod; const float* gffn; float* sumsq;
    __device__ __forceinline__ void operator()(const f32x4 (&acc)[2][2][4][2], const Unit& u, int wr, int wc, int fr, int fq) const {
        const int row0 = u.pm * BM + wr * 64 + fr, col0 = u.pn * BM + wc * 32 + 4 * fq;
#pragma unroll
        for (int ai = 0; ai < 2; ++ai)
#pragma unroll
            for (int m = 0; m < 4; ++m) {
                const int row = row0 + ai * HALF + m * 16, b = row >> 12;
                const float* mb = mod + b * 6144;
                float ss = 0.f;
#pragma unroll
                for (int bj = 0; bj < 2; ++bj)
#pragma unroll
                    for (int n = 0; n < 2; ++n) {
                        const int c = col0 + bj * HALF + n * 16;
                        const f32x4 xv = *(const f32x4*)(x + (size_t)row * DM + c), gt = *(const f32x4*)(mb + 2048 + c);
#ifdef DBG_NOMIX
                        const f32x4 v = xv;
#else
                        const f32x4 v = xv + gt * acc[ai][bj][m][n];
#endif
                        *(f32x4*)(x1 + (size_t)row * DM + c) = v;
                        ss += (v[0] * v[0] + v[1] * v[1]) + (v[2] * v[2] + v[3] * v[3]);
                        const f32x4 gs = *(const f32x4*)(gffn + c) * (*(const f32x4*)(mb + 4096 + c) + 1.0f);
                        const f32x4 a = v * gs;
                        u32x2 w; w.x = cvt_pk_bf16(a[0], a[1]); w.y = cvt_pk_bf16(a[2], a[3]);
                        *(u32x2*)(a3 + (size_t)row * DM + c) = w;
                    }
                ss += __shfl_xor(ss, 16); ss += __shfl_xor(ss, 32);
                if (fq == 0) sumsq[(size_t)row * 16 + u.pn * 4 + wc] = ss;
            }
    }
};

struct Epi3 {
    static constexpr bool PERM = true, AFTER_DRAIN = false;
    const float* sumsq; const float* biasf; bf16_t* sc;
    __device__ __forceinline__ void operator()(const f32x4 (&acc)[2][2][4][2], const Unit& u, int wr, int wc, int fr, int fq) const {
        const int row0 = u.pm * BM + wr * 64 + fr, col0 = u.pn * BM + wc * 32 + 8 * fq;
#pragma unroll
        for (int ai = 0; ai < 2; ++ai)
#pragma unroll
            for (int m = 0; m < 4; ++m) {
                const int row = row0 + ai * HALF + m * 16, b = row >> 12;
                const float rstd = row_rstd(sumsq, row);
#pragma unroll
                for (int bj = 0; bj < 2; ++bj) {
                    const int c = col0 + bj * HALF;
                    const f32x4 b0 = *(const f32x4*)(biasf + b * 2048 + c), b1 = *(const f32x4*)(biasf + b * 2048 + c + 4);
                    const f32x4 v0 = acc[ai][bj][m][0] * rstd + b0, v1 = acc[ai][bj][m][1] * rstd + b1;
                    u32x4 w; w.x = cvt_pk_bf16(v0[0], v0[1]); w.y = cvt_pk_bf16(v0[2], v0[3]); w.z = cvt_pk_bf16(v1[0], v1[1]); w.w = cvt_pk_bf16(v1[2], v1[3]);
                    *(u32x4*)(sc + (size_t)row * 2048 + c) = w;
                }
            }
    }
};

template <class Epi, class Sched, bool ALIGN_EPI = false, bool SP2 = false>
__device__ __forceinline__ void gemm_phase(PG8_LAS unsigned char* lds, const Gemm g, const Sched& S, const Epi& E) {
    const int tid = threadIdx.x, wid = __builtin_amdgcn_readfirstlane(tid >> 6), lane = tid & 63, wr = wid >> 2, wc = wid & 3, fr = lane & 15, fq = lane >> 4;
    const int K = g.K, nt = K / BK;
    unsigned voffA[2], voffB[2];
#pragma unroll
    for (int i = 0; i < 2; ++i) { int R, C; stage_rc(tid * 16 + i * 8192, R, C); const int Rb = Epi::PERM ? ((R & ~31) + perm32(R & 31)) : R;
        voffA[i] = (unsigned)(R * K + C) * 2u; voffB[i] = (unsigned)(Rb * K + C) * 2u; }
    const size_t kstep = (size_t)(BK * 2);
    const size_t hstep = (size_t)HALF * K * 2;
    const size_t tstep = 2 * hstep;
    const unsigned ldsw = (unsigned)wid * 1024u;
    const int aoff = lds_byte(wr * 64 + fr, fq * 8), boff = lds_byte(wc * 32 + fr, fq * 8);
#define PG8_SA(b, h) (((b) * 2 + (h)) * HTB)
#define PG8_SB(b, h) ((4 + (b) * 2 + (h)) * HTB)
#define PG8_STAGE(bufoff, gbase, voff) do { _Pragma("unroll") for (int _i = 0; _i < 2; ++_i) \
        __builtin_amdgcn_global_load_lds((const unsigned*)((const char*)(gbase) + (voff)[_i]), (PG8_LAS unsigned*)(lds + (bufoff) + ldsw + _i * 8192), 16, 0, 0); } while (0)
#define PG8_LDA(dst, b, h) do { _Pragma("unroll") for (int m = 0; m < 4; ++m) _Pragma("unroll") for (int k = 0; k < 2; ++k) dst[m][k] = *(const PG8_LAS bf16x8*)(lds + PG8_SA(b, h) + aoff + m * 2048 + k * 1024); } while (0)
#define PG8_LDB(dst, b, h) do { _Pragma("unroll") for (int n = 0; n < 2; ++n) _Pragma("unroll") for (int k = 0; k < 2; ++k) dst[n][k] = *(const PG8_LAS bf16x8*)(lds + PG8_SB(b, h) + boff + n * 2048 + k * 1024); } while (0)
#define PG8_MMA(ai, bj, At, Bt) do { __builtin_amdgcn_s_setprio(1); _Pragma("unroll") for (int m = 0; m < 4; ++m) _Pragma("unroll") for (int n = 0; n < 2; ++n) _Pragma("unroll") for (int k = 0; k < 2; ++k) \
        acc[ai][bj][m][n] = __builtin_amdgcn_mfma_f32_16x16x32_bf16(Bt[n][k], At[m][k], acc[ai][bj][m][n], 0, 0, 0); __builtin_amdgcn_s_setprio(0); } while (0)
#define PG8_WAIT_V(n) asm volatile("s_waitcnt vmcnt(" #n ")" ::: "memory")
#define PG8_WAIT_L(n) asm volatile("s_waitcnt lgkmcnt(" #n ")" ::: "memory")
#define PG8_BAR __builtin_amdgcn_s_barrier()
#define PG8_SCHED __builtin_amdgcn_sched_barrier(0)
    Unit cur, nxt; int ui = 0;
    if (!S.next(0, cur)) return;
    f32x4 acc[2][2][4][2];
#pragma unroll
    for (int a = 0; a < 2; ++a)
#pragma unroll
        for (int b = 0; b < 2; ++b)
#pragma unroll
            for (int m = 0; m < 4; ++m)
#pragma unroll
                for (int n = 0; n < 2; ++n) acc[a][b][m][n] = (f32x4){0.f, 0.f, 0.f, 0.f};
    bf16x8 At[4][2], B0[2][2], B1[2][2];
    const char* cA = (const char*)g.A + (size_t)cur.pm * tstep; const char* cB = (const char*)g.Bt + (size_t)cur.pn * tstep;
    S.a_ready(cur);
    if constexpr (SP2) {
        PG8_STAGE(PG8_SB(0, 0), cB, voffB); PG8_STAGE(PG8_SB(0, 1), cB + hstep, voffB); PG8_STAGE(PG8_SA(0, 0), cA, voffA); PG8_STAGE(PG8_SA(0, 1), cA + hstep, voffA);
        if (wr == 1) PG8_BAR;
        PG8_WAIT_V(2); PG8_BAR;
        PG8_STAGE(PG8_SB(1, 0), cB + kstep, voffB); PG8_STAGE(PG8_SA(1, 0), cA + kstep, voffA); PG8_STAGE(PG8_SB(1, 1), cB + hstep + kstep, voffB);
        PG8_WAIT_V(6); PG8_BAR;
    } else {
        PG8_STAGE(PG8_SB(0, 0), cB, voffB); PG8_STAGE(PG8_SA(0, 0), cA, voffA); PG8_STAGE(PG8_SB(0, 1), cB + hstep, voffB); PG8_STAGE(PG8_SA(0, 1), cA + hstep, voffA);
        if (wr == 1) PG8_BAR;
        PG8_WAIT_V(4); PG8_BAR;
        PG8_STAGE(PG8_SB(1, 0), cB + kstep, voffB); PG8_STAGE(PG8_SA(1, 0), cA + kstep, voffA); PG8_STAGE(PG8_SB(1, 1), cB + hstep + kstep, voffB);
        PG8_WAIT_V(6); PG8_BAR;
    }
    for (;;) {
        const bool has_next = S.next(ui + 1, nxt);
        const char* nA = has_next ? (const char*)g.A + (size_t)nxt.pm * tstep : cA; const char* nB = has_next ? (const char*)g.Bt + (size_t)nxt.pn * tstep : cB;
        for (int t = 0; t < nt; t += 2) {
            const bool last = (t == nt - 2);
            const char* a1 = cA + (size_t)(t + 1) * kstep;
            const char* a2 = last ? nA : cA + (size_t)(t + 2) * kstep; const char* b2 = last ? nB : cB + (size_t)(t + 2) * kstep;
            const char* a3 = a2 + kstep; const char* b3 = b2 + kstep;
            if (last && has_next) S.a_ready(nxt);
            if constexpr (SP2) {
            PG8_LDB(B0, 0, 0); PG8_LDB(B1, 0, 1); PG8_SCHED; PG8_LDA(At, 0, 0); PG8_STAGE(PG8_SA(1, 1), a1 + hstep, voffA);
            PG8_WAIT_V(8); PG8_WAIT_L(0); PG8_BAR; PG8_MMA(0, 0, At, B0); PG8_MMA(0, 1, At, B1); PG8_BAR; PG8_SCHED;
            PG8_LDA(At, 0, 1); PG8_STAGE(PG8_SB(0, 0), b2, voffB); PG8_STAGE(PG8_SB(0, 1), b2 + hstep, voffB); PG8_STAGE(PG8_SA(0, 0), a2, voffA);
            PG8_WAIT_V(8); PG8_WAIT_L(0); PG8_BAR; PG8_MMA(1, 0, At, B0); PG8_MMA(1, 1, At, B1); PG8_BAR; PG8_SCHED;
            PG8_LDB(B0, 1, 0); PG8_LDB(B1, 1, 1); PG8_SCHED; PG8_LDA(At, 1, 0); PG8_STAGE(PG8_SA(0, 1), a2 + hstep, voffA);
            PG8_WAIT_V(8); PG8_WAIT_L(0); PG8_BAR; PG8_MMA(0, 0, At, B0); PG8_MMA(0, 1, At, B1); PG8_BAR; PG8_SCHED;
            PG8_LDA(At, 1, 1); PG8_STAGE(PG8_SB(1, 0), b3, voffB); PG8_STAGE(PG8_SB(1, 1), b3 + hstep, voffB); PG8_STAGE(PG8_SA(1, 0), a3, voffA);
            PG8_WAIT_V(8); PG8_WAIT_L(0); PG8_BAR; PG8_MMA(1, 0, At, B0); PG8_MMA(1, 1, At, B1); PG8_BAR; PG8_SCHED;
            } else {
            PG8_LDB(B0, 0, 0); PG8_SCHED; PG8_LDA(At, 0, 0); PG8_STAGE(PG8_SA(1, 1), a1 + hstep, voffA);
            PG8_WAIT_L(8); PG8_BAR; PG8_WAIT_L(0); PG8_MMA(0, 0, At, B0); PG8_BAR; PG8_SCHED;
            PG8_LDB(B1, 0, 1); PG8_STAGE(PG8_SB(0, 0), b2, voffB);
            PG8_BAR; PG8_WAIT_L(0); PG8_MMA(0, 1, At, B1); PG8_BAR;
            PG8_LDA(At, 0, 1); PG8_STAGE(PG8_SA(0, 0), a2, voffA);
            PG8_BAR; PG8_WAIT_L(0); PG8_MMA(1, 0, At, B0); PG8_BAR; PG8_SCHED;
            PG8_STAGE(PG8_SB(0, 1), b2 + hstep, voffB);
            PG8_WAIT_V(6); PG8_BAR; PG8_MMA(1, 1, At, B1); PG8_BAR;
            PG8_LDB(B0, 1, 0); PG8_SCHED; PG8_LDA(At, 1, 0); PG8_STAGE(PG8_SA(0, 1), a2 + hstep, voffA);
            PG8_WAIT_L(8); PG8_BAR; PG8_WAIT_L(0); PG8_MMA(0, 0, At, B0); PG8_BAR; PG8_SCHED;
            PG8_LDB(B1, 1, 1); PG8_STAGE(PG8_SB(1, 0), b3, voffB);
            PG8_BAR; PG8_WAIT_L(0); PG8_MMA(0, 1, At, B1); PG8_BAR;
            PG8_LDA(At, 1, 1); PG8_STAGE(PG8_SA(1, 0), a3, voffA);
            PG8_BAR; PG8_WAIT_L(0); PG8_MMA(1, 0, At, B0); PG8_BAR; PG8_SCHED;
            PG8_STAGE(PG8_SB(1, 1), b3 + hstep, voffB);
            PG8_WAIT_V(6); PG8_BAR; PG8_MMA(1, 1, At, B1); PG8_BAR;
            }
        }
        if constexpr (ALIGN_EPI) { if (wr == 0) PG8_BAR; }
        if constexpr (!Epi::AFTER_DRAIN) { E(acc, cur, wr, wc, fr, fq); S.done(cur); }
        if (!has_next) break;
#pragma unroll
        for (int a = 0; a < 2; ++a)
#pragma unroll
            for (int b = 0; b < 2; ++b)
#pragma unroll
                for (int m = 0; m < 4; ++m)
#pragma unroll
                    for (int n = 0; n < 2; ++n) acc[a][b][m][n] = (f32x4){0.f, 0.f, 0.f, 0.f};
        cur = nxt; cA = nA; cB = nB; ++ui;
        if constexpr (ALIGN_EPI) { if (wr == 1) PG8_BAR; }
    }
    PG8_WAIT_V(0);
    if constexpr (!ALIGN_EPI) { if (wr == 0) PG8_BAR; }
    PG8_BAR;
    if constexpr (Epi::AFTER_DRAIN) { E.fused(acc, cur, wr, wc, fr, fq, lds, wid, lane); S.done(cur); }
#undef PG8_SA
#undef PG8_SB
#undef PG8_STAGE
#undef PG8_LDA
#undef PG8_LDB
#undef PG8_MMA
#undef PG8_WAIT_V
#undef PG8_WAIT_L
#undef PG8_BAR
#undef PG8_SCHED
}
}
struct Args { const float* in[13]; float* out; unsigned char* ws; int ph_lo, ph_hi; };

#ifndef TPROBE_I
#define TPROBE_I 3
#endif
#ifndef TPROBE_B
#define TPROBE_B 0
#endif
#ifdef TIME_PH
#ifndef TIME_AMP
#define TIME_AMP 4
#endif
#define TSTAMP(k, slot) do { if ((k) == TIME_PH && bid == TPROBE_B && tid == 0) { const unsigned long long t_ = __builtin_amdgcn_s_memrealtime(); MISC[slot] = (unsigned)t_; MISC[(slot) + 1] = (unsigned)(t_ >> 32); } } while (0)
#else
#define TSTAMP(k, slot) do { } while (0)
#endif
template <bool PERMUTE>
__device__ __forceinline__ void p0_transpose_item(const float* W, int K, int N, int NPOS, bf16_t* WT, LAS float* scr, int item, int lane) {
    const int nblk = NPOS / 32, kb = item / nblk, nb = item % nblk, k0 = 64 * kb, n0 = 32 * nb;
    const int pos = n0 + 4 * (lane & 7);
    const int col = PERMUTE ? win_src_col(pos) : pos;
    f32x4 v[8];
#pragma unroll
    for (int i = 0; i < 8; ++i) { const int kk = 8 * i + (lane >> 3); v[i] = (col >= 0) ? *(const f32x4*)(W + (size_t)(k0 + kk) * N + col) : (f32x4){0.f, 0.f, 0.f, 0.f}; }
#pragma unroll
    for (int i = 0; i < 8; ++i) { const int kk = 8 * i + (lane >> 3); LAS float* q = scr + kk * 33 + 4 * (lane & 7); q[0] = v[i][0]; q[1] = v[i][1]; q[2] = v[i][2]; q[3] = v[i][3]; }
    asm volatile("s_waitcnt lgkmcnt(0)" ::: "memory");
    const int c = lane & 7;
#pragma unroll
    for (int j = 0; j < 4; ++j) { const int n = (lane >> 3) + 8 * j; const LAS float* s = scr + (8 * c) * 33 + n;
        u32x4 o; o.x = pk2(s[0 * 33], s[1 * 33]); o.y = pk2(s[2 * 33], s[3 * 33]); o.z = pk2(s[4 * 33], s[5 * 33]); o.w = pk2(s[6 * 33], s[7 * 33]);
        *(u32x4*)(WT + (size_t)(n0 + n) * K + k0 + 8 * c) = o; }
    asm volatile("s_waitcnt lgkmcnt(0)" ::: "memory");
}
__device__ __forceinline__ void row_to_bf16(const float* src, bf16_t* dst, int lane) {
    const f32x4* s = (const f32x4*)src + lane; u32x2* d = (u32x2*)dst + lane;
    f32x4 v[4];
#pragma unroll
    for (int j = 0; j < 4; ++j) v[j] = s[64 * j];
#pragma unroll
    for (int j = 0; j < 4; ++j) { u32x2 w; w.x = pk2(v[j][0], v[j][1]); w.y = pk2(v[j][2], v[j][3]); d[64 * j] = w; }
}
typedef float f32x2 __attribute__((ext_vector_type(2)));
template <int NB>
__device__ __forceinline__ void rows_to_fp8(const float* src, unsigned char* dst, float* scale_out, int lane) {
    f32x4 v[NB][4];
#pragma unroll
    for (int i = 0; i < NB; ++i) { const f32x4* s = (const f32x4*)(src + (size_t)i * 1024) + 4 * lane;
#pragma unroll
        for (int j = 0; j < 4; ++j) v[i][j] = __builtin_nontemporal_load(s + j); }
#pragma unroll
    for (int i = 0; i < NB; ++i) {
        float am = 0.f;
#pragma unroll
        for (int j = 0; j < 4; ++j) am = fmaxf(am, fmaxf(fmaxf(fabsf(v[i][j][0]), fabsf(v[i][j][1])), fmaxf(fabsf(v[i][j][2]), fabsf(v[i][j][3]))));
#pragma unroll
        for (int o = 1; o < 64; o <<= 1) am = fmaxf(am, __shfl_xor(am, o));
        const float sc = am > 0.f ? am * (1.0f / 440.0f) : 1.0f, inv = 1.0f / sc;
        u32x4 w;
#pragma unroll
        for (int j = 0; j < 4; ++j) { unsigned t = 0u; t = __builtin_amdgcn_cvt_pk_fp8_f32(v[i][j][0] * inv, v[i][j][1] * inv, t, false); t = __builtin_amdgcn_cvt_pk_fp8_f32(v[i][j][2] * inv, v[i][j][3] * inv, t, true); w[j] = t; }
        *((u32x4*)(dst + (size_t)i * 1024) + lane) = w;
        if (lane == 0) scale_out[i] = sc;
    }
}
__device__ __forceinline__ void sincos_tab(double x, float& s, float& c) {
    const double k = rint(x * 0.15915494309189535);
    double r = fma(-k, 6.283185307179586, x); r = fma(-k, 2.4492935982947064e-16, r);
    const double r2 = r * r;
    double ps = 1.0, pc = 1.0;
#pragma unroll
    for (int n = 29; n >= 3; n -= 2) ps = 1.0 - ps * r2 * (1.0 / (double)((n - 1) * n));
#pragma unroll
    for (int n = 28; n >= 2; n -= 2) pc = 1.0 - pc * r2 * (1.0 / (double)((n - 1) * n));
    s = (float)(r * ps); c = (float)pc;
}

__device__ __forceinline__ void phase0(const Args& a, unsigned char* lds, int tid, int wave, int lane, int bid, int G) {
    unsigned char* ws = a.ws;
    volatile LAS unsigned* MISC = (volatile LAS unsigned*)((LAS unsigned char*)lds + MISC_OFF);
    TSTAMP(90, 0);
    if (bid & 1) { const int gw0 = bid * 8 + wave, NGW0 = G * 8;
        for (int it = gw0; it < 4096; it += NGW0) { const int r = 4 * it;
            rows_to_fp8<4>(a.in[10] + (size_t)r * 1024, ws + WS_U8 + (size_t)r * 1024, (float*)(ws + WS_USC) + r, lane); }
        __syncthreads(); }
    for (int it = bid; it < 192; it += G) {
        float* s_c = (float*)lds; float* red = (float*)(lds + 16384);
        for (int i = tid; i < 4096; i += NTHREADS) { const float v = a.in[1][i]; s_c[i] = v / (1.0f + expf(-v)); }
        __syncthreads();
        const int g = tid & 7, ks = tid >> 3, n0 = 32 * it;
        f32x4 acc[4];
#pragma unroll
        for (int b = 0; b < 4; ++b) acc[b] = (f32x4){0.f, 0.f, 0.f, 0.f};
#pragma unroll 4
        for (int i = 0; i < 16; ++i) { const int k = ks + 64 * i; const f32x4 w = *(const f32x4*)(a.in[2] + (size_t)k * 6144 + n0 + 4 * g);
#pragma unroll
            for (int b = 0; b < 4; ++b) acc[b] += w * s_c[b * 1024 + k]; }
#pragma unroll
        for (int b = 0; b < 4; ++b) *(f32x4*)(red + (ks * 8 + g) * 16 + 4 * b) = acc[b];
        __syncthreads();
        if (tid < 128) { const int b = tid >> 5, col = tid & 31, gg = col >> 2, e = col & 3; float s = 0.f;
            for (int k2 = 0; k2 < 64; ++k2) s += red[(k2 * 8 + gg) * 16 + 4 * b + e];
            ((float*)(ws + WS_MOD))[b * 6144 + n0 + col] = s + a.in[3][n0 + col]; }
        __syncthreads();
    }
    TSTAMP(90, 2); TSTAMP(91, 0);
    for (int it = bid; it < 256; it += G) {
        const int hp = it >> 4, k0 = 64 * (it & 15);
        constexpr int WP = 132;
        float* skl = (float*)lds; float* wql = skl + 128 * WP;
        for (int i = tid; i < 4096; i += NTHREADS) { const int n = i >> 5, d4 = i & 31; *(f32x4*)(skl + n * WP + 4 * d4) = *(const f32x4*)(a.in[9] + (size_t)hp * 16384 + n * 128 + 4 * d4); }
        for (int i = tid; i < 2048; i += NTHREADS) { const int k = i >> 5, d4 = i & 31; *(f32x4*)(wql + k * WP + 4 * d4) = *(const f32x4*)(a.in[8] + (size_t)(k0 + k) * 2048 + hp * 128 + 4 * d4); }
        __syncthreads();
        const int kg = tid & 15, ng = tid >> 4;
        float acc[4][4];
#pragma unroll
        for (int i = 0; i < 4; ++i)
#pragma unroll
            for (int j = 0; j < 4; ++j) acc[i][j] = 0.f;
#pragma unroll 2
        for (int d4 = 0; d4 < 32; ++d4) {
            f32x4 wv[4], sv[4];
#pragma unroll
            for (int i = 0; i < 4; ++i) { wv[i] = *(const f32x4*)(wql + (kg + 16 * i) * WP + 4 * d4); sv[i] = *(const f32x4*)(skl + (ng + 32 * i) * WP + 4 * d4); }
#pragma unroll
            for (int i = 0; i < 4; ++i)
#pragma unroll
                for (int j = 0; j < 4; ++j) acc[i][j] += (wv[i][0] * sv[j][0] + wv[i][1] * sv[j][1]) + (wv[i][2] * sv[j][2] + wv[i][3] * sv[j][3]);
        }
        bf16_t* wt = (bf16_t*)(ws + WS_WPQ);
#pragma unroll
        for (int j = 0; j < 4; ++j)
#pragma unroll
            for (int i = 0; i < 4; ++i) wt[(size_t)(hp * 128 + ng + 32 * j) * 1024 + k0 + kg + 16 * i] = (bf16_t)f2bf(acc[i][j]);
        __syncthreads();
    }
    TSTAMP(91, 2); TSTAMP(92, 0);
    const int gw = bid * 8 + wave, NGW = G * 8;
    {
        LAS float* scr = (LAS float*)(lds + wave * 16384);
        constexpr int I_IN = 16 * (N1 / 32), I_OUT = 16 * 32;
        for (int it = gw; it < I_IN + I_OUT; it += NGW) {
            if (it < I_IN) p0_transpose_item<true>(a.in[5], 1024, 4168, N1, (bf16_t*)(ws + WS_WIN), scr, it, lane);
            else p0_transpose_item<false>(a.in[6], 1024, 1024, 1024, (bf16_t*)(ws + WS_WOUT), scr, it - I_IN, lane);
        }
    }
    if (!(bid & 1)) {
        for (int it = gw; it < 4096; it += NGW) { const int r = 4 * it;
            rows_to_fp8<4>(a.in[10] + (size_t)r * 1024, ws + WS_U8 + (size_t)r * 1024, (float*)(ws + WS_USC) + r, lane); }
    }
    for (int i = bid * NTHREADS + tid; i < 4096 * 96; i += G * NTHREADS) {
        int pos, f; double r; float* ct; float* st; int idx;
        if (i < 4096 * 32) { pos = i >> 5; f = i & 31; r = 0.74989420933245582730; ct = (float*)(ws + WS_COSA); st = (float*)(ws + WS_SINA); idx = i; }
        else { const int j = i - 4096 * 32; pos = j >> 6; f = j & 63; r = 0.86398844948396852897; ct = (float*)(ws + WS_COSR); st = (float*)(ws + WS_SINR); idx = j; }
        double v = 1.0; for (int t = 0; t < f; ++t) v *= r;
        const float invf = (float)v; const float ang = (float)pos * invf;
        float s, c; sincos_tab((double)ang, s, c);
        ct[idx] = c; st[idx] = s;
    }
}

__device__ __forceinline__ void phase1(const Args& a, int wave, int lane, int bid, int G) {
    unsigned char* ws = a.ws;
    const float* mod = (const float*)(ws + WS_MOD);
    const int gw = bid * 8 + wave, NGW = G * 8;
    for (int r0 = gw; r0 < MTOK; r0 += 2 * NGW) {
        const int r1 = r0 + NGW; const bool has1 = r1 < MTOK;
        const f32x4* xa = (const f32x4*)(a.in[0] + (size_t)r0 * DM) + lane; const f32x4* xb = (const f32x4*)(a.in[0] + (size_t)(has1 ? r1 : r0) * DM) + lane;
        f32x4 va[4], vb[4]; float sa = 0.f, sb = 0.f;
#pragma unroll
        for (int j = 0; j < 4; ++j) { va[j] = xa[64 * j]; vb[j] = xb[64 * j]; }
#pragma unroll
        for (int j = 0; j < 4; ++j) { sa += (va[j][0] * va[j][0] + va[j][1] * va[j][1]) + (va[j][2] * va[j][2] + va[j][3] * va[j][3]); sb += (vb[j][0] * vb[j][0] + vb[j][1] * vb[j][1]) + (vb[j][2] * vb[j][2] + vb[j][3] * vb[j][3]); }
#pragma unroll
        for (int o = 1; o < 64; o <<= 1) { sa += __shfl_xor(sa, o); sb += __shfl_xor(sb, o); }
        const float ra = 1.0f / sqrtf(sa * (1.0f / DM) + EPS), rb = 1.0f / sqrtf(sb * (1.0f / DM) + EPS);
        const int ba = r0 >> 12, bb = (has1 ? r1 : r0) >> 12;
        u32x2* oa = (u32x2*)((bf16_t*)(ws + WS_BUFA) + (size_t)r0 * DM) + lane; u32x2* ob = (u32x2*)((bf16_t*)(ws + WS_BUFA) + (size_t)(has1 ? r1 : r0) * DM) + lane;
#pragma unroll
        for (int j = 0; j < 4; ++j) { const int c = 256 * j + 4 * lane;
            const f32x4 g = *(const f32x4*)(a.in[4] + c);
            { const f32x4 sc = *(const f32x4*)(mod + ba * 6144 + 1024 + c), sh = *(const f32x4*)(mod + ba * 6144 + c);
              const f32x4 h = va[j] * ra * g * (sc + 1.0f) + sh; u32x2 w; w.x = pk2(h[0], h[1]); w.y = pk2(h[2], h[3]); oa[64 * j] = w; }
            if (has1) { const f32x4 sc = *(const f32x4*)(mod + bb * 6144 + 1024 + c), sh = *(const f32x4*)(mod + bb * 6144 + c);
              const f32x4 h = vb[j] * rb * g * (sc + 1.0f) + sh; u32x2 w; w.x = pk2(h[0], h[1]); w.y = pk2(h[2], h[3]); ob[64 * j] = w; }
        }
    }
    for (int n = gw; n < 2048; n += NGW) {
        const u32x4* wr = (const u32x4*)((const bf16_t*)(ws + WS_WPQ) + (size_t)n * 1024);
        const u32x4 w0 = wr[lane], w1 = wr[64 + lane];
        float wf[16];
#pragma unroll
        for (int i = 0; i < 4; ++i) { wf[2 * i] = bf_lo(w0[i]); wf[2 * i + 1] = bf_hi(w0[i]); wf[8 + 2 * i] = bf_lo(w1[i]); wf[8 + 2 * i + 1] = bf_hi(w1[i]); }
#pragma unroll
        for (int b = 0; b < 4; ++b) { const float* sh = mod + b * 6144 + 3072; float s = 0.f;
#pragma unroll
            for (int i = 0; i < 8; ++i) s += wf[i] * sh[8 * lane + i] + wf[8 + i] * sh[512 + 8 * lane + i];
            s = wave_sum(s);
            if (lane == 0) ((float*)(ws + WS_BIASF))[b * 2048 + n] = s; }
    }
}

constexpr int SCP = 8200;
__device__ __forceinline__ int wave_total(int v) {
    v += __builtin_amdgcn_update_dpp(0, v, 0xB1, 0xF, 0xF, true);
    v += __builtin_amdgcn_update_dpp(0, v, 0x4E, 0xF, 0xF, true);
    v += __builtin_amdgcn_update_dpp(0, v, 0x141, 0xF, 0xF, true);
    v += __builtin_amdgcn_update_dpp(0, v, 0x140, 0xF, 0xF, true);
    return __builtin_amdgcn_readlane(v, 0) + __builtin_amdgcn_readlane(v, 16) + __builtin_amdgcn_readlane(v, 32) + __builtin_amdgcn_readlane(v, 48);
}
__device__ __forceinline__ int wave_suffix_sum(int v, int lane) {
#pragma unroll
    for (int d = 1; d < 64; d <<= 1) { const int o = __shfl_down(v, d); if (lane + d < 64) v += o; }
    return v;
}
__device__ __forceinline__ void hist_find(const unsigned* hist, int want, int lane, int& bin, int& above, int& inbin) {
    const u32x4 h = *(const u32x4*)(hist + 4 * lane);
    const int s = (int)(h.x + h.y) + (int)(h.z + h.w);
    const int incl = wave_suffix_sum(s, lane), excl = incl - s;
    const bool mine = excl < want && want <= incl;
    int c = excl, bsel = 4 * lane + 3, cin = (int)h.w;
    if (c + (int)h.w < want) { c += (int)h.w; bsel = 4 * lane + 2; cin = (int)h.z;
        if (c + (int)h.z < want) { c += (int)h.z; bsel = 4 * lane + 1; cin = (int)h.y;
            if (c + (int)h.y < want) { c += (int)h.y; bsel = 4 * lane; cin = (int)h.x; } } }
    const int src = (int)__builtin_ctzll(__ballot(mine));
    bin = __builtin_amdgcn_readlane(bsel, src); above = __builtin_amdgcn_readlane(c, src); inbin = __builtin_amdgcn_readlane(cin, src);
}
template <int NR>
__device__ __forceinline__ void select_row_t(int b, int t, unsigned char* ldsrow, unsigned* hist, unsigned long long* MASK, int lane) {
    {
        unsigned* row32 = (unsigned*)ldsrow;
        for (int i = 8 * ((t >> 4) + 1) + lane; i < 32 * NR; i += 64) row32[i] = 0u;
    }
    unsigned key[NR];
#pragma unroll
    for (int j = 0; j < NR; ++j) key[j] = *(const unsigned short*)(ldsrow + 2 * lane + 128 * j);
    unsigned mw_lo = 0u, mw_hi = 0u;
    if (t < 256) {
#pragma unroll
        for (int j = 0; j < 4; ++j) { const unsigned long long w = __ballot(key[j] != 0u);
            asm volatile("s_nop 1\n\tv_writelane_b32 %0, %2, %4\n\tv_writelane_b32 %1, %3, %4\n\ts_nop 0" : "+v"(mw_lo), "+v"(mw_hi) : "s"((unsigned)w), "s"((unsigned)(w >> 32)), "n"(j)); }
    } else {
        *(u32x4*)(hist + 4 * lane) = (u32x4){0u, 0u, 0u, 0u};
#pragma unroll
        for (int j = 0; j < NR; ++j) __hip_atomic_fetch_add(hist + (key[j] >> 8), 1u, __ATOMIC_RELAXED, __HIP_MEMORY_SCOPE_WORKGROUP);
        int B, above, inB;
        hist_find(hist, 256, lane, B, above, inB);
        *(u32x4*)(hist + 4 * lane) = (u32x4){0u, 0u, 0u, 0u};
#pragma unroll
        for (int j = 0; j < NR; ++j) if ((int)(key[j] >> 8) == B) __hip_atomic_fetch_add(hist + (key[j] & 255u), 1u, __ATOMIC_RELAXED, __HIP_MEMORY_SCOPE_WORKGROUP);
        int b2, above2, ties;
        hist_find(hist, 256 - above, lane, b2, above2, ties);
        const unsigned T = ((unsigned)B << 8) | (unsigned)b2;
        int need = 256 - above - above2;
        if (ties == need) {
#pragma unroll
            for (int j = 0; j < NR; ++j) { const unsigned long long w = __ballot(key[j] >= T);
                asm volatile("s_nop 1\n\tv_writelane_b32 %0, %2, %4\n\tv_writelane_b32 %1, %3, %4\n\ts_nop 0" : "+v"(mw_lo), "+v"(mw_hi) : "s"((unsigned)w), "s"((unsigned)(w >> 32)), "n"(j));
                if ((j & 3) == 3) __builtin_amdgcn_sched_barrier(0); }
        } else {
#pragma unroll
            for (int j = 0; j < NR; ++j) {
                const bool gt = key[j] > T, eq = key[j] == T;
                const unsigned long long em = __ballot(eq);
                const int cc = __popcll(em), take = cc < need ? cc : need;
                const int rank = (int)__builtin_amdgcn_mbcnt_hi((unsigned)(em >> 32), __builtin_amdgcn_mbcnt_lo((unsigned)em, 0u));
                const unsigned long long w = __ballot(gt || (eq && rank < take));
                need -= take;
                asm volatile("s_nop 1\n\tv_writelane_b32 %0, %2, %4\n\tv_writelane_b32 %1, %3, %4\n\ts_nop 0" : "+v"(mw_lo), "+v"(mw_hi) : "s"((unsigned)w), "s"((unsigned)(w >> 32)), "n"(j));
                if ((j & 1) == 1) __builtin_amdgcn_sched_barrier(0);
            }
        }
    }
    MASK[((size_t)b * SEQ + t) * 64 + lane] = ((unsigned long long)mw_hi << 32) | mw_lo;
}
__device__ __forceinline__ void select_row(int b, int t, unsigned char* ldsrow, unsigned* hist, unsigned long long* MASK, int lane) {
    switch (t >> 10) {
        case 0: select_row_t<16>(b, t, ldsrow, hist, MASK, lane); break;
        case 1: select_row_t<32>(b, t, ldsrow, hist, MASK, lane); break;
        case 2: select_row_t<48>(b, t, ldsrow, hist, MASK, lane); break;
        default: select_row_t<64>(b, t, ldsrow, hist, MASK, lane); break;
    }
}
__device__ __forceinline__ void idx_unit(int b, int qt, const bf16_t* QI, const bf16_t* KI, const float* WI, unsigned long long* MASK, unsigned char* lds, int wave, int lane, bool tprobe) {
    volatile LAS unsigned* MISC = (volatile LAS unsigned*)((LAS unsigned char*)lds + MISC_OFF); const int bid = tprobe ? TPROBE_B : -1; const int tid = (int)threadIdx.x;
    TSTAMP(32, 0);
    const int t0 = 16 * qt, qn = lane & 15, g = lane >> 4;
    const size_t rowq = (size_t)b * SEQ + t0 + qn;
    bf16x8 qf[8][2]; float wi[8];
#pragma unroll
    for (int h = 0; h < 8; ++h)
#pragma unroll
        for (int ks = 0; ks < 2; ++ks) qf[h][ks] = *(const bf16x8*)(QI + rowq * 512 + h * 64 + ks * 32 + 8 * g);
    { const f32x4 w0 = *(const f32x4*)(WI + rowq * 8), w1 = *(const f32x4*)(WI + rowq * 8 + 4);
#pragma unroll
      for (int e = 0; e < 4; ++e) { wi[e] = w0[e]; wi[4 + e] = w1[e]; } }
    const bf16_t* kbase = KI + ((size_t)b * SEQ + qn) * 64 + 8 * g;
    bf16x8 ra0[8], ra1[8];
#pragma unroll
    for (int i = 0; i < 8; ++i) if (wave + 8 * i <= qt) { const bf16_t* kr = kbase + (size_t)(wave + 8 * i) * 1024; ra0[i] = *(const bf16x8*)kr; ra1[i] = *(const bf16x8*)(kr + 32); }
#pragma unroll 1
    for (int base = wave; base <= qt; base += 64) {
#pragma unroll
        for (int i = 0; i < 8; ++i) {
            const int kt = base + 8 * i;
            if (kt <= qt) {
                const bf16x8 a0 = ra0[i], a1 = ra1[i];
                if (kt + 64 <= qt) { const bf16_t* kr = kbase + (size_t)(kt + 64) * 1024; ra0[i] = *(const bf16x8*)kr; ra1[i] = *(const bf16x8*)(kr + 32); }
                const int s0 = 16 * kt;
                f32x4 sc = (f32x4){0.f, 0.f, 0.f, 0.f};
#pragma unroll
                for (int h = 0; h < 8; ++h) {
                    f32x4 d = mfma16(a0, qf[h][0], (f32x4){0.f, 0.f, 0.f, 0.f}); d = mfma16(a1, qf[h][1], d);
#pragma unroll
                    for (int r = 0; r < 4; ++r) { const int di = (int)__float_as_uint(d[r]); sc[r] += wi[h] * __uint_as_float((unsigned)(di > 0 ? di : 0)); }
                }
                unsigned k[4];
#pragma unroll
                for (int r = 0; r < 4; ++r) { const unsigned kk = sortable16(sc[r]); k[r] = (s0 + 4 * g + r <= t0 + qn) ? kk : 0u; }
                u32x2 pk; pk.x = k[0] | (k[1] << 16); pk.y = k[2] | (k[3] << 16);
                *(u32x2*)(lds + qn * SCP + 2 * (s0 + 4 * g)) = pk;
            }
        }
    }
    __syncthreads();
    TSTAMP(32, 2); TSTAMP(33, 0);
#ifndef NO_SEL
#pragma unroll 1
    for (int qq = 2 * wave; qq < 2 * wave + 2; ++qq) select_row(b, t0 + qq, lds + qq * SCP, (unsigned*)(lds + 16 * SCP) + 256 * wave, MASK, lane);
#endif
    __syncthreads();
    TSTAMP(33, 2);
}

__device__ __forceinline__ void ret_state_unit(int b, int h, int vb, int dh, const bf16_t* KR, const bf16_t* VR, bf16_t* STATE, unsigned char* lds, int tid, int wave, int lane) {
    constexpr int PT = 272, KT_BYTES = 64 * PT, BUF = KT_BYTES + 16 * PT;
    const int j = tid & 127, dq = tid >> 7, g = lane >> 4, ln = lane & 15;
    const float g128 = ret_g128(h), g127 = ret_g127(h), gam = ret_gamma(h);
    f32x4 st = (f32x4){0.f, 0.f, 0.f, 0.f};
    u32x4 kA[2], kB[2], vA = (u32x4){0u, 0u, 0u, 0u}, vB = (u32x4){0u, 0u, 0u, 0u};
#define RS_LOAD(K_, V_, n) do { const size_t row = (size_t)b * SEQ + (n) * 128 + j; const u32x4* p = (const u32x4*)(KR + row * 512 + h * 128 + 64 * dh + 16 * dq); \
        K_[0] = p[0]; K_[1] = p[1]; if (tid < 256) V_ = *(const u32x4*)(VR + row * 512 + h * 128 + 16 * vb + 8 * dq); } while (0)
#define RS_WRITE(K_, V_, buf) do { _Pragma("unroll") for (int i = 0; i < 2; ++i) _Pragma("unroll") for (int e = 0; e < 4; ++e) { const unsigned w = K_[i][e]; const int d = 16 * dq + 8 * i + 2 * e; \
            *(unsigned short*)((buf) + d * PT + 2 * j) = (unsigned short)(w & 0xffffu); *(unsigned short*)((buf) + (d + 1) * PT + 2 * j) = (unsigned short)(w >> 16); } \
        if (tid < 256) { _Pragma("unroll") for (int e = 0; e < 4; ++e) { const unsigned w = V_[e]; const int v = 8 * dq + 2 * e; \
            *(unsigned short*)((buf) + KT_BYTES + v * PT + 2 * j) = (unsigned short)(w & 0xffffu); *(unsigned short*)((buf) + KT_BYTES + (v + 1) * PT + 2 * j) = (unsigned short)(w >> 16); } } } while (0)
#define RS_COMP(buf, n) do { if (wave < 4) { \
        bf16_t* sp = STATE + ((((size_t)b * 4 + h) * 32 + (n)) * 128 + 16 * vb + 4 * g) * 128 + 64 * dh + 16 * wave + ln; \
        _Pragma("unroll") for (int r = 0; r < 4; ++r) sp[r * 128] = (bf16_t)f2bf(gam * st[r]); \
        f32x4 c = (f32x4){0.f, 0.f, 0.f, 0.f}; \
        _Pragma("unroll") for (int ks = 0; ks < 4; ++ks) { \
            const bf16x8 af = *(const bf16x8*)((buf) + KT_BYTES + ln * PT + 2 * (32 * ks + 8 * g)); \
            const bf16x8 bf = *(const bf16x8*)((buf) + (16 * wave + ln) * PT + 2 * (32 * ks + 8 * g)); \
            c = mfma16(af, bf, c); } \
        st = st * g128 + c * g127; } } while (0)
    RS_LOAD(kA, vA, 0); RS_LOAD(kB, vB, 1);
#pragma unroll 1
    for (int n = 0; n < 32; n += 2) {
        RS_WRITE(kA, vA, lds);
        if (n + 2 < 32) RS_LOAD(kA, vA, n + 2);
        __syncthreads();
        RS_COMP(lds, n);
        RS_WRITE(kB, vB, lds + BUF);
        if (n + 3 < 32) RS_LOAD(kB, vB, n + 3);
        __syncthreads();
        RS_COMP(lds + BUF, n + 1);
    }
#undef RS_LOAD
#undef RS_WRITE
#undef RS_COMP
    __syncthreads();
}

__device__ __forceinline__ float amax3(float a, float b, float c) { float r; asm("v_max3_f32 %0, %1, %2, %3" : "=v"(r) : "v"(a), "v"(b), "v"(c)); return r; }
__device__ __forceinline__ void attn_unit(int b, int h, int qb, const bf16_t* QA, const bf16_t* KA, const bf16_t* VA, const unsigned long long* MASK, bf16_t* AR,
                                          unsigned char* lds, int tid, int wave, int lane) {
    constexpr int KP = 144, KS_BYTES = 64 * KP, BUF = 2 * KS_BYTES;
    const int q0 = 256 * qb, r32 = lane & 31, hi = lane >> 5;
    const int t = q0 + 32 * wave + r32;
    const size_t qrow = (size_t)b * SEQ + t;
    bf16x8 qf[4];
#pragma unroll
    for (int d0 = 0; d0 < 4; ++d0) qf[d0] = *(const bf16x8*)(QA + qrow * 512 + h * 64 + 16 * d0 + 8 * hi);
    const int NT = (q0 + 256) / 64;
    const int key_l = tid >> 3, c8 = tid & 7;
    f32x16 o0, o1;
#pragma unroll
    for (int r = 0; r < 16; ++r) { o0[r] = 0.f; o1[r] = 0.f; }
    float m_run = NEG_INF, l_run = 0.f;
    u32x4 kreg[4], vreg[4]; unsigned long long mw[4];
#define AT_LOAD(i, kt) do { const size_t kr = (size_t)b * SEQ + 64 * (kt) + key_l; kreg[i] = *(const u32x4*)(KA + kr * 512 + h * 64 + 8 * c8); vreg[i] = *(const u32x4*)(VA + kr * 512 + h * 64 + 8 * c8); \
        mw[i] = MASK[qrow * 64 + (kt)]; } while (0)
#pragma unroll
    for (int i = 0; i < 4; ++i) AT_LOAD(i, i);
#pragma unroll 1
    for (int kt4 = 0; kt4 < NT; kt4 += 4) {
#pragma unroll
      for (int i = 0; i < 4; ++i) {
        const int kt = kt4 + i;
        unsigned char* buf = lds + (i & 1) * BUF;
        *(u32x4*)(buf + key_l * KP + 16 * c8) = kreg[i];
#pragma unroll
        for (int e = 0; e < 4; ++e) { const unsigned w = vreg[i][e]; const int d = 8 * c8 + 2 * e;
            *(unsigned short*)(buf + KS_BYTES + d * KP + 2 * key_l) = (unsigned short)(w & 0xffffu); *(unsigned short*)(buf + KS_BYTES + (d + 1) * KP + 2 * key_l) = (unsigned short)(w >> 16); }
        const unsigned long long mcur = mw[i];
        if (kt + 4 < NT) AT_LOAD(i, kt + 4);
        __syncthreads();
        if (64 * kt <= q0 + 32 * wave + 31) {
            f32x16 p0, p1;
#pragma unroll
            for (int r = 0; r < 16; ++r) { p0[r] = 0.f; p1[r] = 0.f; }
#pragma unroll
            for (int d0 = 0; d0 < 4; ++d0) {
                const bf16x8 a0 = *(const bf16x8*)(buf + r32 * KP + 32 * d0 + 16 * hi);
                const bf16x8 a1 = *(const bf16x8*)(buf + (32 + r32) * KP + 32 * d0 + 16 * hi);
                p0 = mfma32(a0, qf[d0], p0); p1 = mfma32(a1, qf[d0], p1);
            }
            const unsigned wl = (unsigned)mcur >> (4 * hi), wh = (unsigned)(mcur >> 32) >> (4 * hi);
#pragma unroll
            for (int r = 0; r < 16; ++r) { const int bp = (r & 3) + 8 * (r >> 2);
                const unsigned m0 = (unsigned)((int)(wl << (31 - bp)) >> 31), m1 = (unsigned)((int)(wh << (31 - bp)) >> 31);
                p0[r] = __uint_as_float((__float_as_uint(p0[r]) & m0) | (0xff800000u & ~m0)); p1[r] = __uint_as_float((__float_as_uint(p1[r]) & m1) | (0xff800000u & ~m1)); }
            float mx;
            { float a = amax3(p0[0], p0[1], p1[0]), bq = amax3(p0[2], p0[3], p1[1]); a = amax3(a, p1[2], p1[3]);
#pragma unroll
              for (int r = 4; r < 16; r += 4) { a = amax3(a, p0[r], p0[r + 1]); bq = amax3(bq, p0[r + 2], p0[r + 3]); a = amax3(a, p1[r], p1[r + 1]); bq = amax3(bq, p1[r + 2], p1[r + 3]); }
              mx = amax3(a, bq, bq); }
            mx = amax3(mx, __shfl_xor(mx, 32), mx);
            const float m_new = amax3(m_run, mx, mx);
            const float m_use = (m_new == NEG_INF) ? 0.f : m_new;
            const float alpha = fast_exp2(m_run - m_use);
            m_run = m_new;
            float ps = 0.f;
#pragma unroll
            for (int r = 0; r < 16; ++r) { p0[r] = fast_exp2(p0[r] - m_use); p1[r] = fast_exp2(p1[r] - m_use); ps += p0[r] + p1[r]; }
            l_run = l_run * alpha + ps;
            if (__any(alpha != 1.0f)) {
#pragma unroll
                for (int r = 0; r < 16; ++r) { o0[r] *= alpha; o1[r] *= alpha; }
            }
#pragma unroll
            for (int s4 = 0; s4 < 4; ++s4) {
                const int rb = 8 * (s4 & 1);
                u32x4 pw;
                if (s4 < 2) { pw.x = pk2(p0[rb], p0[rb + 1]); pw.y = pk2(p0[rb + 2], p0[rb + 3]); pw.z = pk2(p0[rb + 4], p0[rb + 5]); pw.w = pk2(p0[rb + 6], p0[rb + 7]); }
                else        { pw.x = pk2(p1[rb], p1[rb + 1]); pw.y = pk2(p1[rb + 2], p1[rb + 3]); pw.z = pk2(p1[rb + 4], p1[rb + 5]); pw.w = pk2(p1[rb + 6], p1[rb + 7]); }
                const bf16x8 bfr = __builtin_bit_cast(bf16x8, pw);
                { const unsigned char* vp = buf + KS_BYTES + r32 * KP + 2 * (16 * s4 + 4 * hi);
                  const u32x2 lo = *(const u32x2*)vp, h2 = *(const u32x2*)(vp + 16); const u32x4 av = (u32x4){lo.x, lo.y, h2.x, h2.y};
                  o0 = mfma32(__builtin_bit_cast(bf16x8, av), bfr, o0); }
                { const unsigned char* vp = buf + KS_BYTES + (32 + r32) * KP + 2 * (16 * s4 + 4 * hi);
                  const u32x2 lo = *(const u32x2*)vp, h2 = *(const u32x2*)(vp + 16); const u32x4 av = (u32x4){lo.x, lo.y, h2.x, h2.y};
                  o1 = mfma32(__builtin_bit_cast(bf16x8, av), bfr, o1); }
            }
        }
      }
    }
#undef AT_LOAD
    l_run += __shfl_xor(l_run, 32);
#ifdef DBG_NOATT
    const float inv = 0.f;
#else
    const float inv = 1.0f / l_run;
#endif
    bf16_t* op = AR + qrow * 1024 + h * 64 + 4 * hi;
#pragma unroll
    for (int c = 0; c < 4; ++c) {
        u32x2 w; w.x = pk2(o0[4 * c] * inv, o0[4 * c + 1] * inv); w.y = pk2(o0[4 * c + 2] * inv, o0[4 * c + 3] * inv); *(u32x2*)(op + 8 * c) = w;
        u32x2 v; v.x = pk2(o1[4 * c] * inv, o1[4 * c + 1] * inv); v.y = pk2(o1[4 * c + 2] * inv, o1[4 * c + 3] * inv); *(u32x2*)(op + 32 + 8 * c) = v;
    }
    __syncthreads();
}

__device__ __forceinline__ void ret_out_unit(int b, int h, int n, const bf16_t* QR, const bf16_t* KR, const bf16_t* VR, const bf16_t* GR, const bf16_t* STATE, bf16_t* AR,
                                             unsigned char* lds, int tid, int wave, int lane) {
    constexpr int PT = 272;
    const size_t c0 = (size_t)b * SEQ + 128 * n; const int hc = 128 * h;
    const int ln = lane & 15, g = lane >> 4;
    const size_t qrow = c0 + 16 * wave + ln;
    u32x4 rr[4];
    { const int j = tid & 127, vq = tid >> 7; const u32x4* p = (const u32x4*)(VR + (c0 + j) * 512 + hc + 32 * vq); rr[0] = p[0]; rr[1] = p[1]; rr[2] = p[2]; rr[3] = p[3]; }
    bf16x8 qf[4];
#pragma unroll
    for (int ks = 0; ks < 4; ++ks) qf[ks] = *(const bf16x8*)(QR + qrow * 512 + hc + 32 * ks + 8 * g);
    bf16x8 kf[8][4];
#pragma unroll
    for (int jt = 0; jt < 8; ++jt) if (jt <= wave) { const bf16_t* kp = KR + (c0 + 16 * jt + ln) * 512 + hc + 8 * g;
#pragma unroll
        for (int ks = 0; ks < 4; ++ks) kf[jt][ks] = *(const bf16x8*)(kp + 32 * ks); }
    u32x2 gw[8];
#pragma unroll
    for (int vt = 0; vt < 8; ++vt) gw[vt] = *(const u32x2*)(GR + qrow * 512 + hc + 16 * vt + 4 * g);
    { const int j = tid & 127, vq = tid >> 7;
#pragma unroll
      for (int i = 0; i < 4; ++i)
#pragma unroll
          for (int e = 0; e < 4; ++e) { const unsigned w = rr[i][e]; const int v = 32 * vq + 8 * i + 2 * e;
              *(unsigned short*)(lds + v * PT + 2 * j) = (unsigned short)(w & 0xffffu); *(unsigned short*)(lds + (v + 1) * PT + 2 * j) = (unsigned short)(w >> 16); } }
    __syncthreads();
    f32x4 sT[8];
#pragma unroll
    for (int jt = 0; jt < 8; ++jt) {
        f32x4 d = (f32x4){0.f, 0.f, 0.f, 0.f};
        if (jt <= wave) {
#pragma unroll
            for (int ks = 0; ks < 4; ++ks) d = mfma16(kf[jt][ks], qf[ks], d);
            if (jt == wave) {
#pragma unroll
                for (int r = 0; r < 4; ++r) if (4 * g + r > ln) d[r] = 0.f;
            }
        }
        sT[jt] = d;
    }
    f32x4 oT[8];
    const bf16_t* stp = STATE + (((size_t)b * 4 + h) * 32 + n) * 16384;
#pragma unroll
    for (int vt = 0; vt < 8; ++vt) {
        f32x4 d = (f32x4){0.f, 0.f, 0.f, 0.f};
#pragma unroll
        for (int ks = 0; ks < 4; ++ks) d = mfma16(*(const bf16x8*)(stp + (16 * vt + ln) * 128 + 32 * ks + 8 * g), qf[ks], d);
        oT[vt] = d;
    }
#pragma unroll
    for (int pr = 0; pr < 4; ++pr) if (2 * pr <= wave) {
        u32x4 pw; pw.x = pk2(sT[2 * pr][0], sT[2 * pr][1]); pw.y = pk2(sT[2 * pr][2], sT[2 * pr][3]); pw.z = pk2(sT[2 * pr + 1][0], sT[2 * pr + 1][1]); pw.w = pk2(sT[2 * pr + 1][2], sT[2 * pr + 1][3]);
        const bf16x8 bfr = __builtin_bit_cast(bf16x8, pw);
#pragma unroll
        for (int vt = 0; vt < 8; ++vt) {
            const unsigned char* vp = lds + (16 * vt + ln) * PT + 2 * (32 * pr + 4 * g);
            const u32x2 lo = *(const u32x2*)vp, h2 = *(const u32x2*)(vp + 32); const u32x4 av = (u32x4){lo.x, lo.y, h2.x, h2.y};
            oT[vt] = mfma16(__builtin_bit_cast(bf16x8, av), bfr, oT[vt]);
        }
    }
    float s = 0.f;
#pragma unroll
    for (int vt = 0; vt < 8; ++vt) s += (oT[vt][0] + oT[vt][1]) + (oT[vt][2] + oT[vt][3]);
    s += __shfl_xor(s, 16); s += __shfl_xor(s, 32);
    const float mean = s * (1.0f / 128.0f);
    float q = 0.f;
#pragma unroll
    for (int vt = 0; vt < 8; ++vt)
#pragma unroll
        for (int r = 0; r < 4; ++r) { const float d = oT[vt][r] - mean; q += d * d; }
    q += __shfl_xor(q, 16); q += __shfl_xor(q, 32);
    const float rstd = 1.0f / sqrtf(q * (1.0f / 128.0f) + EPS);
#pragma unroll
    for (int vt = 0; vt < 8; ++vt) {
        const float y0 = (oT[vt][0] - mean) * rstd * bf_lo(gw[vt].x), y1 = (oT[vt][1] - mean) * rstd * bf_hi(gw[vt].x);
        const float y2 = (oT[vt][2] - mean) * rstd * bf_lo(gw[vt].y), y3 = (oT[vt][3] - mean) * rstd * bf_hi(gw[vt].y);
        u32x2 w; w.x = pk2(y0, y1); w.y = pk2(y2, y3);
        *(u32x2*)(AR + qrow * 1024 + 512 + hc + 16 * vt + 4 * g) = w;
    }
    __syncthreads();
}

template <int N> __device__ __forceinline__ void bitonic_sort_desc(unsigned (&a)[N]) {
#pragma unroll
    for (int k = 2; k <= N; k <<= 1)
#pragma unroll
        for (int j = k >> 1; j > 0; j >>= 1)
#pragma unroll
            for (int i = 0; i < N; ++i) { const int l = i ^ j;
                if (l > i) { const unsigned x = a[i], y = a[l]; const unsigned mx = x > y ? x : y, mn = x > y ? y : x;
                    if ((i & k) == 0) { a[i] = mx; a[l] = mn; } else { a[i] = mn; a[l] = mx; } } }
}
template <int N> __device__ __forceinline__ void bitonic_merge_desc(unsigned (&a)[N]) {
#pragma unroll
    for (int j = N >> 1; j > 0; j >>= 1)
#pragma unroll
        for (int i = 0; i < N; ++i) { const int l = i ^ j;
            if (l > i) { const unsigned x = a[i], y = a[l]; a[i] = x > y ? x : y; a[l] = x > y ? y : x; } }
}
__device__ __forceinline__ void top16_merge(unsigned (&best)[16], const unsigned (&grp)[16]) {
#pragma unroll
    for (int i = 0; i < 16; ++i) { const unsigned x = best[i], y = grp[15 - i]; best[i] = x > y ? x : y; }
    bitonic_merge_desc<16>(best);
}
struct CandTab { int a[64], b[64], n; constexpr CandTab() : a{}, b{}, n(0) { for (int x = 0; x < 16; ++x) for (int y = 0; y < 16; ++y) if ((x + 1) * (y + 1) <= 16) { a[n] = x; b[n] = y; ++n; } } };
constexpr CandTab kCand{};
static_assert(kCand.n == 50, "staircase candidates");

constexpr int PL_EID = 0, PL_GATE = 16384, PL_IDX = 32768;
__device__ __forceinline__ void peer_unit(int unit, unsigned char* ws, float* outp, const float* gffn, const float* gfin, unsigned char* lds, int tid, int wave, int lane) {
    volatile LAS unsigned* MISC = (volatile LAS unsigned*)((LAS unsigned char*)lds + MISC_OFF); const int bid = unit;
    TSTAMP(70, 0);
    const bf16_t* SC = (const bf16_t*)(ws + WS_SC);
    const float* mod = (const float*)(ws + WS_MOD);
#ifndef DBG_NOPEER
    {
        const int tl = tid >> 4, h = (tid >> 1) & 7, p = tid & 1;
        const size_t row = (size_t)32 * unit + tl;
        const u32x4* sp = (const u32x4*)(SC + row * 2048 + h * 256 + p * 128);
        unsigned best[16];
#pragma unroll
        for (int grp = 0; grp < 8; ++grp) {
            unsigned k[16];
#pragma unroll
            for (int q4 = 0; q4 < 2; ++q4) { const u32x4 v = sp[2 * grp + q4];
#pragma unroll
                for (int e = 0; e < 4; ++e) { const int n0 = 16 * grp + 8 * q4 + 2 * e;
                    k[8 * q4 + 2 * e] = (sortable32(bf_lo(v[e])) & ~127u) | (unsigned)(127 - n0);
                    k[8 * q4 + 2 * e + 1] = (sortable32(bf_hi(v[e])) & ~127u) | (unsigned)(127 - (n0 + 1)); } }
            bitonic_sort_desc<16>(k);
            if (grp == 0) {
#pragma unroll
                for (int i = 0; i < 16; ++i) best[i] = k[i];
            } else top16_merge(best, k);
        }
        unsigned char* il = lds + PL_IDX + (tl * 8 + h) * 32;
#pragma unroll
        for (int i = 0; i < 4; ++i) { unsigned w = 0;
#pragma unroll
            for (int e = 0; e < 4; ++e) w |= (127u - (best[4 * i + e] & 127u)) << (8 * e);
            *(unsigned*)(il + p * 16 + 4 * i) = w; }
        float v1[16], v2[16];
#pragma unroll
        for (int i = 0; i < 16; ++i) { const unsigned o = __shfl_xor(best[i], 1); const float mine = unsortable32(best[i] & ~127u), oth = unsortable32(o & ~127u);
            v1[i] = p ? oth : mine; v2[i] = p ? mine : oth; }
        unsigned top[16];
#pragma unroll
        for (int grp = 0; grp < 4; ++grp) {
            unsigned k[16];
#pragma unroll
            for (int i = 0; i < 16; ++i) { const int c = 16 * grp + i;
                k[i] = (c < kCand.n) ? ((sortable32(v1[kCand.a[c < kCand.n ? c : 0]] + v2[kCand.b[c < kCand.n ? c : 0]]) & ~255u) | (unsigned)(255 - (16 * kCand.a[c < kCand.n ? c : 0] + kCand.b[c < kCand.n ? c : 0]))) : 0u; }
            bitonic_sort_desc<16>(k);
            if (grp == 0) {
#pragma unroll
                for (int i = 0; i < 16; ++i) top[i] = k[i];
            } else top16_merge(top, k);
        }
        float ts[16], es[16], sum = 0.f;
#pragma unroll
        for (int i = 0; i < 16; ++i) ts[i] = unsortable32(top[i] & ~255u);
#pragma unroll
        for (int i = 0; i < 16; ++i) { es[i] = __expf(ts[i] - ts[0]); sum += es[i]; }
        const float rs = 1.0f / sum;
        __builtin_amdgcn_wave_barrier(); asm volatile("s_waitcnt lgkmcnt(0)" ::: "memory");
        unsigned* eo = (unsigned*)(lds + PL_EID) + tl * 128 + h * 16;
        float* go = (float*)(lds + PL_GATE) + tl * 128 + h * 16;
#pragma unroll
        for (int i = 0; i < 16; ++i) {
            const unsigned flat = 255u - (top[i] & 255u);
            const unsigned i1 = il[flat >> 4], i2 = il[16 + (flat & 15u)];
            eo[i] = i1 * 128u + i2; go[i] = es[i] * rs;
        }
    }
#endif
    __syncthreads();
    TSTAMP(70, 2); TSTAMP(71, 0);
    const unsigned char* U8 = ws + WS_U8; const unsigned char* V8 = ws + WS_V8;
    const float* USC = (const float*)(ws + WS_USC); const float* VSC = (const float*)(ws + WS_VSC);
    const int me = ((lane >> 5) & 1) * 4 + ((lane >> 4) & 1) * 2 + ((lane >> 3) & 1);
#pragma unroll 1
    for (int ti = 0; ti < 4; ++ti) {
        const int tl = wave + 8 * ti; const size_t row = (size_t)32 * unit + tl; const int b = (int)(row >> 12);
        const float* mb = mod + b * 6144;
        float x1v[16], hv[16], acc[16];
        const float rstd = pg8::row_rstd((const float*)(ws + WS_SUMSQ), (int)row);
#pragma unroll
        for (int q4 = 0; q4 < 4; ++q4) { const int c = 16 * lane + 4 * q4;
            const f32x4 xv = *(const f32x4*)(outp + row * DM + c), g = *(const f32x4*)(gffn + c), sc = *(const f32x4*)(mb + 4096 + c), sh = *(const f32x4*)(mb + 3072 + c);
#pragma unroll
            for (int e = 0; e < 4; ++e) { const int i = 4 * q4 + e; x1v[i] = xv[e]; hv[i] = xv[e] * rstd * g[e] * (1.0f + sc[e]) + sh[e]; acc[i] = 0.f; } }
        const unsigned* el = (const unsigned*)(lds + PL_EID) + tl * 128; const float* gl = (const float*)(lds + PL_GATE) + tl * 128;
        u32x4 uA[8], vA[8]; float guA, gvA;
#define PEER_LOAD(U_, V_, GU_, GV_, e0_) do { _Pragma("unroll") for (int k = 0; k < 8; ++k) { const unsigned eid = el[(e0_) + k]; \
            U_[k] = *((const u32x4*)(U8 + (size_t)eid * 1024) + lane); V_[k] = *((const u32x4*)(V8 + (size_t)eid * 1024) + lane); } \
        { const unsigned em = el[(e0_) + me]; GU_ = USC[em]; GV_ = VSC[em] * gl[(e0_) + me]; } } while (0)
#define PEER_COMP(U_, V_, GU_, GV_) do { float pd[8]; \
        _Pragma("unroll") for (int k = 0; k < 8; ++k) { float d = 0.f; \
            _Pragma("unroll") for (int i = 0; i < 4; ++i) { const f32x2 lo = __builtin_amdgcn_cvt_pk_f32_fp8(U_[k][i], false), hi2 = __builtin_amdgcn_cvt_pk_f32_fp8(U_[k][i], true); \
                d += hv[4 * i] * lo.x; d += hv[4 * i + 1] * lo.y; d += hv[4 * i + 2] * hi2.x; d += hv[4 * i + 3] * hi2.y; } \
            pd[k] = d; } \
        float q4_[4], r2_[2], s_; \
        _Pragma("unroll") for (int k = 0; k < 4; ++k) { const float keep = (lane & 32) ? pd[k + 4] : pd[k], send = (lane & 32) ? pd[k] : pd[k + 4]; q4_[k] = keep + __shfl_xor(send, 32); } \
        _Pragma("unroll") for (int k = 0; k < 2; ++k) { const float keep = (lane & 16) ? q4_[k + 2] : q4_[k], send = (lane & 16) ? q4_[k] : q4_[k + 2]; r2_[k] = keep + __shfl_xor(send, 16); } \
        { const float keep = (lane & 8) ? r2_[1] : r2_[0], send = (lane & 8) ? r2_[0] : r2_[1]; s_ = keep + __shfl_xor(send, 8); } \
        s_ += __shfl_xor(s_, 4); s_ += __shfl_xor(s_, 2); s_ += __shfl_xor(s_, 1); \
        const float cf_ = GV_ * gelu_exact(s_ * GU_); \
        _Pragma("unroll") for (int k = 0; k < 8; ++k) { const float c = __uint_as_float((unsigned)__builtin_amdgcn_readlane((int)__float_as_uint(cf_), 32 * (k >> 2) + 16 * ((k >> 1) & 1) + 8 * (k & 1))); \
            _Pragma("unroll") for (int i = 0; i < 4; ++i) { const f32x2 lo = __builtin_amdgcn_cvt_pk_f32_fp8(V_[k][i], false), hi2 = __builtin_amdgcn_cvt_pk_f32_fp8(V_[k][i], true); \
                acc[4 * i] += c * lo.x; acc[4 * i + 1] += c * lo.y; acc[4 * i + 2] += c * hi2.x; acc[4 * i + 3] += c * hi2.y; } } } while (0)
#pragma unroll 1
        for (int e0 = 0; e0 < 128; e0 += 8) {
            PEER_LOAD(uA, vA, guA, gvA, e0);
            PEER_COMP(uA, vA, guA, gvA);
        }
#undef PEER_LOAD
#undef PEER_COMP
        float ss = 0.f;
#pragma unroll
        for (int q4 = 0; q4 < 4; ++q4) { const int c = 16 * lane + 4 * q4; const f32x4 gf = *(const f32x4*)(mb + 5120 + c);
#pragma unroll
            for (int e = 0; e < 4; ++e) { const int i = 4 * q4 + e; x1v[i] = x1v[i] + gf[e] * acc[i]; ss += x1v[i] * x1v[i]; } }
        const float r2 = 1.0f / sqrtf(wave_sum(ss) * (1.0f / DM) + EPS);
#pragma unroll
        for (int q4 = 0; q4 < 4; ++q4) { const int c = 16 * lane + 4 * q4; const f32x4 gn = *(const f32x4*)(gfin + c);
            f32x4 o;
#pragma unroll
            for (int e = 0; e < 4; ++e) o[e] = x1v[4 * q4 + e] * r2 * gn[e];
            *(f32x4*)(outp + row * DM + c) = o; }
    }
    __syncthreads();
    TSTAMP(71, 2);
}

#define XB_TMO      128
#define XB_XCNT(j)  (256  + 64 * (j))
#define XB_XSUB(j)  (1280 + 64 * (j))
#define XB_XGEN(j)  (2304 + 64 * (j))
#define XB_TOP      3328
#define XB_TOPGEN   3392
#define XCD_BAR_WORDS 3456
#define XB_SPIN_CAP (1u << 18)

__device__ __forceinline__ unsigned xb_ld(unsigned* p)              { return __hip_atomic_load(p, __ATOMIC_RELAXED, __HIP_MEMORY_SCOPE_AGENT); }
__device__ __forceinline__ unsigned xb_add(unsigned* p, unsigned v) { return __hip_atomic_fetch_add(p, v, __ATOMIC_RELAXED, __HIP_MEMORY_SCOPE_AGENT); }
__device__ __forceinline__ unsigned xb_xcc_id() { return (unsigned)__builtin_amdgcn_s_getreg((3 << 11) | 20) & 0xFu; }
#define XB_SPIN(cond, bar) do { unsigned _sp = 0; while (cond) { __builtin_amdgcn_s_sleep(1); \
    if ((++_sp & 255u) == 0u) { if (xb_ld(&(bar)[XB_TMO])) break; if (_sp > XB_SPIN_CAP) { atomicAdd(&(bar)[XB_TMO], 1u); break; } } } } while (0)

struct XcdBarrier {
    unsigned* bar; unsigned x;
    volatile LAS unsigned* st;
};

__device__ __forceinline__ XcdBarrier xcd_barrier_post(unsigned* bar, volatile LAS unsigned* st) {
    XcdBarrier b; b.bar = bar; b.x = xb_xcc_id(); b.st = st;
    if (threadIdx.x == 0) (void)xb_add(&bar[XB_XCNT(b.x)], 1u);
    return b;
}
__device__ __forceinline__ void xcd_barrier_complete(unsigned* bar, unsigned x, unsigned& nloc, unsigned& nx) {
    const unsigned G = gridDim.x * gridDim.y * gridDim.z;
    unsigned sum, cnt, mine, sp = 0u;
    for (;;) {
        sum = 0u; cnt = 0u; mine = 0u;
#pragma unroll
        for (unsigned j = 0; j < 16; ++j) { const unsigned c = xb_ld(&bar[XB_XCNT(j)]); sum += c; cnt += (c > 0u) ? 1u : 0u; mine = (j == x) ? c : mine; }
        if (sum == G) break;
        __builtin_amdgcn_s_sleep(1);
        if ((++sp & 255u) == 0u) { if (xb_ld(&bar[XB_TMO])) break; if (sp > XB_SPIN_CAP) { atomicAdd(&bar[XB_TMO], 1u); break; } }
    }
    nloc = mine > 0u ? mine : 1u; nx = cnt > 0u ? cnt : 1u;
}

__device__ __forceinline__ void xcd_barrier(const XcdBarrier& b) {
    asm volatile("s_waitcnt vmcnt(0)" ::: "memory");
    __syncthreads();
    if (threadIdx.x == 0) {
        unsigned* bar = b.bar;
        __builtin_amdgcn_s_waitcnt(0);
        unsigned nloc = b.st[0], nx = b.st[1];
        if (nloc == 0u) { xcd_barrier_complete(bar, b.x, nloc, nx); b.st[0] = nloc; b.st[1] = nx; }
        const unsigned old = xb_add(&bar[XB_XSUB(b.x)], 1u);
        const unsigned gen = old / nloc;
        if (old + 1u == (gen + 1u) * nloc) {
            __builtin_amdgcn_fence(__ATOMIC_RELEASE, "agent");
            asm volatile("s_waitcnt vmcnt(0)" ::: "memory");
            const unsigned og = xb_add(&bar[XB_TOP], 1u);
            const unsigned tg = og / nx;
            if (og + 1u == (tg + 1u) * nx) xb_add(&bar[XB_TOPGEN], 1u);
            else XB_SPIN(xb_ld(&bar[XB_TOPGEN]) == tg, bar);
            __builtin_amdgcn_fence(__ATOMIC_ACQUIRE, "agent");
            xb_add(&bar[XB_XGEN(b.x)], 1u);
            asm volatile("s_waitcnt vmcnt(0)" ::: "memory");
        } else {
            XB_SPIN(xb_ld(&bar[XB_XGEN(b.x)]) == gen, bar);
            __builtin_amdgcn_fence(__ATOMIC_ACQUIRE, "agent");
            asm volatile("s_waitcnt vmcnt(0)" ::: "memory");
        }
    }
    __syncthreads();
}

constexpr int N_PHASES = 8;
__global__ void __launch_bounds__(NTHREADS, 2) mega(Args a) {
    extern __shared__ __attribute__((aligned(16))) unsigned char lds[];
    const int tid = threadIdx.x, lane = tid & 63, wave = __builtin_amdgcn_readfirstlane(tid >> 6);
    const int bid = blockIdx.x, G = gridDim.x;
    unsigned char* ws = a.ws;
    const int lo = a.ph_lo, hi = a.ph_hi;
    volatile LAS unsigned* MISC = (volatile LAS unsigned*)((LAS unsigned char*)lds + MISC_OFF);
    if (tid < 16) MISC[tid] = 0u;
    __syncthreads();
    XcdBarrier bar; bar.bar = (unsigned*)(ws + WS_CTL) + CW_BAR; bar.x = 0; bar.st = nullptr;
    if (hi - lo > 1) bar = xcd_barrier_post((unsigned*)(ws + WS_CTL) + CW_BAR, MISC + 8);
#ifndef PH_MASK
#define PH_MASK 0xFF
#endif
#define IN(k) (((PH_MASK >> (k)) & 1) && lo <= (k) && (k) < hi)
#define SEAM(k) do { if (IN(k) && IN((k) + 1)) { xcd_barrier(bar); } } while (0)
#ifdef REP_PH
#ifndef REP_N
#define REP_N 1
#endif
#define REPS(k) for (int rep_ = 0; rep_ < ((k) == REP_PH ? 1 + REP_N : 1); ++rep_, ((k) == REP_PH && rep_ <= REP_N ? (xcd_barrier(bar), 0) : 0))
#else
#define REPS(k)
#endif

    TSTAMP(100, 0);
    TSTAMP(0, 0);
    REPS(0) if (IN(0)) phase0(a, lds, tid, wave, lane, bid, G);
    SEAM(0);
    TSTAMP(0, 2);
    TSTAMP(1, 0);
    REPS(1) if (IN(1)) phase1(a, wave, lane, bid, G);
    SEAM(1);
    TSTAMP(1, 2);
    TSTAMP(2, 0);
    REPS(2) if (IN(2)) {
        pg8::Gemm g{(const bf16_t*)(ws + WS_BUFA), (const bf16_t*)(ws + WS_WIN), MTOK, N1, DM}; pg8::StaticOrder S; S.init(MTOK, N1, G, bid);
        pg8::Epi1 E{ws};
        pg8::gemm_phase<pg8::Epi1, pg8::StaticOrder, true, true>((LAS unsigned char*)lds, g, S, E);
        const int nfull = (MTOK / 256) * (N1 / 256) - 4 * G;
        { const bool tail = nfull > 0 && nfull < G; const int cw = tail ? (bid - nfull) * 8 + wave : bid * 8 + wave, NCW = tail ? (G - nfull) * 8 : G * 8;
          if (!tail || bid >= nfull)
              for (int it = cw; it < 4096; it += NCW) { const int r = 4 * it;
                  rows_to_fp8<4>(a.in[11] + (size_t)r * 1024, ws + WS_V8 + (size_t)r * 1024, (float*)(ws + WS_VSC) + r, lane); } }
    }
    SEAM(2);
    TSTAMP(2, 2);
    TSTAMP(3, 0);
    REPS(3) if (IN(3)) {
        TSTAMP(30, 0);
        for (int u = bid; u < 256; u += G)
            ret_state_unit(u >> 6, (u >> 4) & 3, (u >> 1) & 7, u & 1, (const bf16_t*)(ws + WS_KR), (const bf16_t*)(ws + WS_VR), (bf16_t*)(ws + WS_STATE), lds, tid, wave, lane);
        TSTAMP(30, 2); TSTAMP(31, 0);
        for (int k = bid; k < 256; k += G)
#pragma unroll 1
            for (int i = 0; i < 4; ++i) {
                const int b = i, qt = (i < 2) ? k : 255 - k;
                idx_unit(b, qt, (const bf16_t*)(ws + WS_QI), (const bf16_t*)(ws + WS_KI), (const float*)(ws + WS_WI), (unsigned long long*)(ws + WS_MASK), lds, wave, lane, bid == TPROBE_B && i == TPROBE_I);
            }
        TSTAMP(31, 2);
    }
    SEAM(3);
    TSTAMP(3, 2);
    TSTAMP(4, 0);
    REPS(4) if (IN(4)) {
        TSTAMP(40, 0);
        for (int k = bid; k < 256; k += G) {
            const int bh = k >> 3, s = k & 7;
#pragma unroll 1
            for (int i = 0; i < 2; ++i)
                attn_unit(bh >> 3, bh & 7, i ? 15 - s : s, (const bf16_t*)(ws + WS_QA), (const bf16_t*)(ws + WS_KA), (const bf16_t*)(ws + WS_VA), (const unsigned long long*)(ws + WS_MASK),
                          (bf16_t*)(ws + WS_BUFB), lds, tid, wave, lane);
        }
        TSTAMP(40, 2); TSTAMP(41, 0);
        for (int u = bid; u < 512; u += G)
            ret_out_unit(u >> 7, (u >> 5) & 3, u & 31, (const bf16_t*)(ws + WS_QR), (const bf16_t*)(ws + WS_KR), (const bf16_t*)(ws + WS_VR), (const bf16_t*)(ws + WS_GR),
                         (const bf16_t*)(ws + WS_STATE), (bf16_t*)(ws + WS_BUFB), lds, tid, wave, lane);
        TSTAMP(41, 2);
    }
    SEAM(4);
    TSTAMP(4, 2);
    TSTAMP(5, 0);
    REPS(5) if (IN(5)) {
        pg8::Gemm g{(const bf16_t*)(ws + WS_BUFB), (const bf16_t*)(ws + WS_WOUT), MTOK, DM, DM}; pg8::StaticOrder S; S.init(MTOK, DM, G, bid);
        pg8::Epi2 E{a.in[0], a.out, (bf16_t*)(ws + WS_BUFA), (const float*)(ws + WS_MOD), a.in[7], (float*)(ws + WS_SUMSQ)};
        pg8::gemm_phase<pg8::Epi2, pg8::StaticOrder, true, true>((LAS unsigned char*)lds, g, S, E);
    }
    SEAM(5);
    TSTAMP(5, 2);
    TSTAMP(6, 0);
    REPS(6) if (IN(6)) {
        pg8::Gemm g{(const bf16_t*)(ws + WS_BUFA), (const bf16_t*)(ws + WS_WPQ), MTOK, 2048, DM}; pg8::StaticOrder S; S.init(MTOK, 2048, G, bid);
        pg8::Epi3 E{(const float*)(ws + WS_SUMSQ), (const float*)(ws + WS_BIASF), (bf16_t*)(ws + WS_SC)};
        pg8::gemm_phase<pg8::Epi3, pg8::StaticOrder, true, true>((LAS unsigned char*)lds, g, S, E);
    }
    SEAM(6);
    TSTAMP(6, 2);
    TSTAMP(7, 0);
    if (IN(7)) {
        for (int u = bid; u < 512; u += G) peer_unit(u, ws, a.out, a.in[7], a.in[12], lds, tid, wave, lane);
    }
    TSTAMP(7, 2);
    TSTAMP(100, 2);
#ifdef TIME_PH
    if (bid == TPROBE_B && tid == 0) {
        const unsigned long long t0_ = ((unsigned long long)MISC[1] << 32) | MISC[0], t1_ = ((unsigned long long)MISC[3] << 32) | MISC[2];
        const unsigned long long until_ = __builtin_amdgcn_s_memrealtime() + (unsigned long long)TIME_AMP * (t1_ - t0_);
        while (__builtin_amdgcn_s_memrealtime() < until_) __builtin_amdgcn_s_sleep(8);
    }
#endif
#undef IN
#undef SEAM
}

extern "C" void kernel_launch(void* const* d_in, const int* in_sizes, int n_in, void* d_out, int out_size, void* d_ws, size_t ws_size, hipStream_t stream) {
    static int grid = 0;
    if (grid == 0) {
        if (n_in != 13 || out_size != MTOK * DM || ws_size < WS_END) { fprintf(stderr, "kernel_launch: unexpected shapes (n_in %d, out %d, ws %zu); nothing launched\n", n_in, out_size, ws_size); grid = -1; return; }
        int dev = 0, cus = 0, per_cu = 0;
        if (hipGetDevice(&dev) != hipSuccess || hipDeviceGetAttribute(&cus, hipDeviceAttributeMultiprocessorCount, dev) != hipSuccess) { grid = -1; return; }
        if (hipFuncSetAttribute((const void*)mega, hipFuncAttributeMaxDynamicSharedMemorySize, LDS_BYTES) != hipSuccess) { fprintf(stderr, "kernel_launch: hipFuncSetAttribute failed\n"); grid = -1; return; }
        if (hipOccupancyMaxActiveBlocksPerMultiprocessor(&per_cu, (const void*)mega, NTHREADS, LDS_BYTES) != hipSuccess || per_cu < 1) { fprintf(stderr, "kernel_launch: occupancy query gave %d\n", per_cu); per_cu = 1; }
        (void)hipGetLastError();
        grid = cus;
    }
    if (grid < 0) return;
    if (hipMemsetAsync((char*)d_ws + WS_CTL + (size_t)CW_BAR * 4, 0, (size_t)XCD_BAR_WORDS * 4, stream) != hipSuccess) { fprintf(stderr, "kernel_launch: memset failed\n"); return; }
    Args a{};
    for (int i = 0; i < 13; ++i) a.in[i] = (const float*)d_in[i];
    a.out = (float*)d_out; a.ws = (unsigned char*)d_ws;
#if MK_MULTI
    for (int p = 0; p < N_PHASES; ++p) { a.ph_lo = p; a.ph_hi = p + 1; hipLaunchKernelGGL(mega, dim3(grid), dim3(NTHREADS), LDS_BYTES, stream, a); }
#else
    a.ph_lo = 0; a.ph_hi = N_PHASES;
    hipLaunchKernelGGL(mega, dim3(grid), dim3(NTHREADS), LDS_BYTES, stream, a);
#endif
}
```

```cpp
#include <hip/hip_runtime.h>
#include <cstdio>
#include <cstdint>

#ifndef MK_MULTI
#define MK_MULTI 0
#endif

#define GAS __attribute__((address_space(1)))
#define LAS __attribute__((address_space(3)))
typedef unsigned short bf16_t;
typedef short bf16x8 __attribute__((ext_vector_type(8)));
typedef float f32x4 __attribute__((ext_vector_type(4)));
typedef float f32x16 __attribute__((ext_vector_type(16)));
typedef unsigned u32x4 __attribute__((ext_vector_type(4)));
typedef unsigned u32x2 __attribute__((ext_vector_type(2)));

constexpr int BATCH = 4, SEQ = 4096, DM = 1024, MTOK = BATCH * SEQ;
constexpr int N1 = 4352;
constexpr int NTHREADS = 512;
constexpr float EPS = 1e-6f;
constexpr float C_QK = 0.18033688011112042f;
constexpr float NEG_INF = -__builtin_huge_valf();

__device__ __forceinline__ float ret_log2g(int h) { return h == 0 ? -0.045803689613124791f : h == 1 ? -0.022720076500083530f : h == 2 ? -0.011315313227834147f : -0.0056465631411420624f; }
__device__ __forceinline__ float ret_gamma(int h) { return h == 0 ? 0.96875f : h == 1 ? 0.984375f : h == 2 ? 0.9921875f : 0.99609375f; }
__device__ __forceinline__ float ret_g128(int h) { return h == 0 ? 0.017183023570817902f : h == 1 ? 0.13321516287964842f : h == 2 ? 0.36643771592203725f : 0.60593708822908032f; }
__device__ __forceinline__ float ret_g127(int h) { return h == 0 ? 0.017737314653747512f : h == 1 ? 0.13532968927456347f : h == 2 ? 0.36932305226788007f : 0.60831331210448848f; }

constexpr size_t MiB = 1u << 20;
constexpr size_t WS_CTL = 0, CTL_BYTES = 1 * MiB;
constexpr size_t WS_SUMSQ = 5 * MiB;
constexpr size_t WS_MOD = 1 * MiB;
constexpr size_t WS_BIASF = 1 * MiB + 128 * 1024;
constexpr size_t WS_COSA = 2 * MiB, WS_SINA = 2 * MiB + 512 * 1024;
constexpr size_t WS_COSR = 3 * MiB, WS_SINR = 4 * MiB;
constexpr size_t WS_WIN = 6 * MiB;
constexpr size_t WS_WOUT = 15 * MiB;
constexpr size_t WS_WPQ = 17 * MiB;
constexpr size_t WS_BUFA = 22 * MiB;
constexpr size_t WS_MASK = WS_BUFA, WS_STATE = WS_BUFA + 8 * MiB;
constexpr size_t WS_BUFB = 54 * MiB;
constexpr size_t WS_G1 = 86 * MiB;
constexpr size_t WS_QA = WS_G1, WS_KA = WS_G1 + 16 * MiB, WS_VA = WS_G1 + 32 * MiB, WS_QI = WS_G1 + 48 * MiB, WS_QR = WS_G1 + 64 * MiB,
                 WS_KR = WS_G1 + 80 * MiB, WS_VR = WS_G1 + 96 * MiB, WS_GR = WS_G1 + 112 * MiB, WS_KI = WS_G1 + 128 * MiB, WS_WI = WS_G1 + 130 * MiB;
constexpr size_t WS_SC = WS_G1;
constexpr size_t WS_U8 = 217 * MiB, WS_V8 = 233 * MiB;
constexpr size_t WS_USC = 249 * MiB, WS_VSC = 249 * MiB + 65536;
constexpr size_t WS_END = 256 * MiB;
static_assert(WS_WI + (size_t)MTOK * 8 * 4 <= WS_U8 && WS_SC + (size_t)MTOK * 2048 * 4 <= WS_U8 && WS_VSC + 65536 <= WS_END, "ws map");
constexpr int LDS_BYTES = 147456;
constexpr int MISC_OFF = LDS_BYTES - 64;
constexpr int CW_BAR = 4096;

__device__ __forceinline__ unsigned f2bf(float f) { unsigned u = __float_as_uint(f); return (u + 0x7fffu + ((u >> 16) & 1u)) >> 16; }
typedef float f32x2_t __attribute__((ext_vector_type(2))); typedef __bf16 bf16x2_t __attribute__((ext_vector_type(2)));
__device__ __forceinline__ unsigned pk2(float lo, float hi) { const f32x2_t v = {lo, hi}; const bf16x2_t b = __builtin_convertvector(v, bf16x2_t); return __builtin_bit_cast(unsigned, b); }
__device__ __forceinline__ float bf_lo(unsigned w) { return __uint_as_float(w << 16); }
__device__ __forceinline__ float bf_hi(unsigned w) { return __uint_as_float(w & 0xffff0000u); }
__device__ __forceinline__ float wave_sum(float v) {
#pragma unroll
    for (int o = 1; o < 64; o <<= 1) v += __shfl_xor(v, o);
    return v;
}
__device__ __forceinline__ float fast_exp2(float x) { return __builtin_amdgcn_exp2f(x); }
__device__ __forceinline__ float gelu_exact(float v) {
    const float av = fabsf(v), t = __builtin_amdgcn_rcpf(av * 0.2316418882f + 1.0f);
    float q = t * 0.5307027145f + (-0.7265760135f); q = q * t + 0.7107068705f; q = q * t + (-0.142248368f); q = q * t + 0.127414796f; q = q * t;
    const float e = fast_exp2(v * v * (-0.72134752044f));
    const float m = v * (q * e);
    return v < 0.f ? m : v - m;
}
__device__ __forceinline__ float silu_f(float v) { return v / (1.0f + __expf(-v)); }
__device__ __forceinline__ unsigned sortable32(float f) { const unsigned u = __float_as_uint(f); return (u & 0x80000000u) ? ~u : (u | 0x80000000u); }
__device__ __forceinline__ float unsortable32(unsigned s) { return __uint_as_float((s & 0x80000000u) ? (s ^ 0x80000000u) : ~s); }
__device__ __forceinline__ unsigned sortable16(float x) {
    const _Float16 h = (_Float16)x; const unsigned b = (unsigned)__builtin_bit_cast(unsigned short, h);
    return (b & 0x8000u) ? (~b & 0xFFFFu) : (b | 0x8000u);
}
__device__ __forceinline__ f32x4 mfma16(bf16x8 a, bf16x8 b, f32x4 c) { return __builtin_amdgcn_mfma_f32_16x16x32_bf16(a, b, c, 0, 0, 0); }
__device__ __forceinline__ f32x16 mfma32(bf16x8 a, bf16x8 b, f32x16 c) { return __builtin_amdgcn_mfma_f32_32x32x16_bf16(a, b, c, 0, 0, 0); }

__host__ __device__ __forceinline__ int win_src_col(int p) {
    const int tile = p >> 8, bj = (p >> 7) & 1, q = p & 127;
    if (tile < 4) return 256 * tile + (q >> 5) * 64 + bj * 32 + (q & 31);
    if (tile < 6) return p;
    if (tile < 8) return 256 * tile + (q >> 5) * 64 + bj * 32 + (q & 31);
    if (tile == 8) { if (q < 32) return 2048 + bj * 32 + q; if (bj == 0 && q < 40) return 2112 + (q - 32); return -1; }
    if (tile < 13) { const int base = (tile < 11) ? 2120 + 256 * (tile - 9) : 2632 + 256 * (tile - 11); return base + (q >> 6) * 128 + bj * 64 + (q & 63); }
    if (tile < 15) return 3144 + (p - 13 * 256);
    return 3656 + (p - 15 * 256);
}
namespace pg8 {
#define PG8_LAS __attribute__((address_space(3)))
typedef unsigned short bf16_t;
typedef short bf16x8 __attribute__((ext_vector_type(8)));
typedef float f32x4 __attribute__((ext_vector_type(4)));
typedef unsigned u32x4 __attribute__((ext_vector_type(4)));
constexpr int BM = 256, BK = 64, HALF = 128, HTB = HALF * BK * 2  , STAGE_BYTES = 8 * HTB, NXCD = 8, WGM = 8;

__host__ __device__ __forceinline__ int lds_byte(int r, int c) { const int st = (r >> 4) * 2 + (c >> 5), rr = r & 15, cc = c & 31, ob = rr * 64 + cc * 2; return st * 1024 + (ob ^ (((ob >> 9) & 1) << 5)); }
__host__ __device__ __forceinline__ void stage_rc(int b, int& R, int& C) { const int st = b / 1024, sb = b % 1024, swz = sb ^ (((sb >> 9) & 1) << 5); R = (st >> 1) * 16 + swz / 64; C = (st & 1) * 32 + (swz % 64) / 2; }
__host__ __device__ __forceinline__ int perm32(int rho) { const int n = rho >> 4, i = rho & 15; return 8 * (i >> 2) + 4 * n + (i & 3); }

struct Unit { int pm, pn; };
struct Gemm { const bf16_t* A; const bf16_t* Bt; int M, N, K; };

struct StaticOrder {
    int nM, nN, nwg, G, c;
    __host__ __device__ void init(int M, int N, int G_, int c_) { nM = M / BM; nN = N / BM; nwg = nM * nN; G = G_; c = c_; }
    __host__ __device__ bool next(int i, Unit& u) const {
        const long L = (long)i * G + c; if (L >= nwg) return false;
        int wgid = (int)L; { const int q = nwg / NXCD, r = nwg % NXCD, xcd = wgid % NXCD, off = wgid / NXCD; wgid = (xcd < r ? xcd * (q + 1) : r * (q + 1) + (xcd - r) * q) + off; }
        const int nig = WGM * nN, gid = wgid / nig, fm = gid * WGM, gsz = (nM - fm) < WGM ? (nM - fm) : WGM;
        u.pm = fm + ((wgid % nig) % gsz); u.pn = (wgid % nig) / gsz; return true;
    }
    __device__ __forceinline__ void a_ready(const Unit&) const {}
    __device__ __forceinline__ void done(const Unit&) const {}
};

__device__ __forceinline__ unsigned cvt_pk_bf16(float lo, float hi) { unsigned r; asm volatile("v_cvt_pk_bf16_f32 %0, %1, %2" : "=v"(r) : "v"(lo), "v"(hi)); return r; }
__device__ __forceinline__ u32x4 pack8(const float (&v)[8]) { u32x4 w; w.x = cvt_pk_bf16(v[0], v[1]); w.y = cvt_pk_bf16(v[2], v[3]); w.z = cvt_pk_bf16(v[4], v[5]); w.w = cvt_pk_bf16(v[6], v[7]); return w; }

struct Epi1 {
    static constexpr bool PERM = true, AFTER_DRAIN = false;
    unsigned char* ws;
    __device__ __forceinline__ void operator()(const f32x4 (&acc)[2][2][4][2], const Unit& u, int wr, int wc, int fr, int fq) const {
        const int tile = u.pn;
        const int row0 = u.pm * BM + wr * 64 + fr;
        const float* cosA = (const float*)(ws + WS_COSA); const float* sinA = (const float*)(ws + WS_SINA);
        const float* cosR = (const float*)(ws + WS_COSR); const float* sinR = (const float*)(ws + WS_SINR);
        if (tile < 4 || tile == 6 || tile == 7) {
            bf16_t* dst = (bf16_t*)(ws + (tile < 2 ? WS_QA : tile < 4 ? WS_KA : WS_QI));
            const int tl = tile < 2 ? tile : tile < 4 ? tile - 2 : tile - 6;
            const float scale = tile < 2 ? C_QK : 1.0f;
            const int cb = 256 * tl + 64 * wc, i0 = 8 * fq;
#pragma unroll
            for (int ai = 0; ai < 2; ++ai)
#pragma unroll
                for (int m = 0; m < 4; ++m) {
                    const int row = row0 + ai * HALF + m * 16, pos = row & (SEQ - 1);
                    const f32x4 c0 = *(const f32x4*)(cosA + pos * 32 + i0), c1 = *(const f32x4*)(cosA + pos * 32 + i0 + 4);
                    const f32x4 s0 = *(const f32x4*)(sinA + pos * 32 + i0), s1 = *(const f32x4*)(sinA + pos * 32 + i0 + 4);
                    float y1[8], y2[8];
#pragma unroll
                    for (int n = 0; n < 2; ++n)
#pragma unroll
                        for (int e = 0; e < 4; ++e) {
                            const float x1 = acc[ai][0][m][n][e], x2 = acc[ai][1][m][n][e];
                            const float c = n ? c1[e] : c0[e], s = n ? s1[e] : s0[e];
                            y1[4 * n + e] = (x1 * c - x2 * s) * scale; y2[4 * n + e] = (x1 * s + x2 * c) * scale;
                        }
                    bf16_t* rp = dst + (size_t)row * 512 + cb + i0;
                    *(u32x4*)rp = pack8(y1); *(u32x4*)(rp + 32) = pack8(y2);
                }
        } else if (tile == 4 || tile == 5 || tile >= 13) {
            bf16_t* dst = (bf16_t*)(ws + (tile < 6 ? WS_VA : tile < 15 ? WS_VR : WS_GR));
            const int tl = tile < 6 ? tile - 4 : tile < 15 ? tile - 13 : tile - 15;
            const bool act = tile >= 15;
#pragma unroll
            for (int ai = 0; ai < 2; ++ai)
#pragma unroll
                for (int m = 0; m < 4; ++m) {
                    const int row = row0 + ai * HALF + m * 16;
#pragma unroll
                    for (int bj = 0; bj < 2; ++bj) {
                        float y[8];
#pragma unroll
                        for (int n = 0; n < 2; ++n)
#pragma unroll
                            for (int e = 0; e < 4; ++e) { const float v = acc[ai][bj][m][n][e]; y[4 * n + e] = act ? silu_f(v) : v; }
                        *(u32x4*)(dst + (size_t)row * 512 + 256 * tl + 128 * bj + 32 * wc + 8 * fq) = pack8(y);
                    }
                }
        } else if (tile == 8) {
#pragma unroll
            for (int ai = 0; ai < 2; ++ai)
#pragma unroll
                for (int m = 0; m < 4; ++m) {
                    const int row = row0 + ai * HALF + m * 16, pos = row & (SEQ - 1);
                    if (wc == 0) {
                        const int i0 = 8 * fq;
                        const f32x4 c0 = *(const f32x4*)(cosA + pos * 32 + i0), c1 = *(const f32x4*)(cosA + pos * 32 + i0 + 4);
                        const f32x4 s0 = *(const f32x4*)(sinA + pos * 32 + i0), s1 = *(const f32x4*)(sinA + pos * 32 + i0 + 4);
                        float y1[8], y2[8];
#pragma unroll
                        for (int n = 0; n < 2; ++n)
#pragma unroll
                            for (int e = 0; e < 4; ++e) {
                                const float x1 = acc[ai][0][m][n][e], x2 = acc[ai][1][m][n][e];
                                const float c = n ? c1[e] : c0[e], s = n ? s1[e] : s0[e];
                                y1[4 * n + e] = x1 * c - x2 * s; y2[4 * n + e] = x1 * s + x2 * c;
                            }
                        bf16_t* rp = (bf16_t*)(ws + WS_KI) + (size_t)row * 64 + i0;
                        *(u32x4*)rp = pack8(y1); *(u32x4*)(rp + 32) = pack8(y2);
                    } else if (wc == 1 && fq == 0) {
                        const float sw = 0.35355339059327379f;
                        float* WI = (float*)(ws + WS_WI);
                        *(f32x4*)(WI + (size_t)row * 8) = acc[ai][0][m][0] * sw;
                        *(f32x4*)(WI + (size_t)row * 8 + 4) = acc[ai][0][m][1] * sw;
                    }
                }
        } else {
            const bool isk = tile >= 11;
            bf16_t* dst = (bf16_t*)(ws + (isk ? WS_KR : WS_QR));
            const int tl = isk ? tile - 11 : tile - 9, hl = wc >> 1, h = 2 * tl + hl;
            const int i0 = 32 * (wc & 1) + 8 * fq, cb = 256 * tl + 128 * hl;
            const float lg = isk ? -ret_log2g(h) : ret_log2g(h);
            const float base = isk ? 0.08838834764831845f : 1.0f;
#pragma unroll
            for (int ai = 0; ai < 2; ++ai)
#pragma unroll
                for (int m = 0; m < 4; ++m) {
                    const int row = row0 + ai * HALF + m * 16, pos = row & (SEQ - 1);
                    const float dec = base * fast_exp2(lg * (float)(pos & 127));
                    const f32x4 c0 = *(const f32x4*)(cosR + pos * 64 + i0), c1 = *(const f32x4*)(cosR + pos * 64 + i0 + 4);
                    const f32x4 s0 = *(const f32x4*)(sinR + pos * 64 + i0), s1 = *(const f32x4*)(sinR + pos * 64 + i0 + 4);
                    float y1[8], y2[8];
#pragma unroll
                    for (int n = 0; n < 2; ++n)
#pragma unroll
                        for (int e = 0; e < 4; ++e) {
                            const float x1 = acc[ai][0][m][n][e], x2 = acc[ai][1][m][n][e];
                            const float c = n ? c1[e] : c0[e], s = n ? s1[e] : s0[e];
                            y1[4 * n + e] = (x1 * c - x2 * s) * dec; y2[4 * n + e] = (x1 * s + x2 * c) * dec;
                        }
                    bf16_t* rp = dst + (size_t)row * 512 + cb + i0;
                    *(u32x4*)rp = pack8(y1); *(u32x4*)(rp + 64) = pack8(y2);
                }
        }
    }
};

__device__ __forceinline__ float row_rstd(const float* sumsq, int row) {
    const f32x4* p = (const f32x4*)(sumsq + (size_t)row * 16);
    const f32x4 a = p[0], b = p[1], c = p[2], d = p[3];
    const float s = (((a[0] + a[1]) + (a[2] + a[3])) + ((b[0] + b[1]) + (b[2] + b[3]))) + (((c[0] + c[1]) + (c[2] + c[3])) + ((d[0] + d[1]) + (d[2] + d[3])));
    return 1.0f / sqrtf(s * (1.0f / DM) + EPS);
}
struct Epi2 {
    static constexpr bool PERM = false, AFTER_DRAIN = false;
    const float* x; float* x1; bf16_t* a3; const float* mod; const float* gffn; float* sumsq;
    __device__ __forceinline__ void operator()(const f32x4 (&acc)[2][2][4][2], const Unit& u, int wr, int wc, int fr, int fq) const {
        const int row0 = u.pm * BM + wr * 64 + fr, col0 = u.pn * BM + wc * 32 + 4 * fq;
#pragma unroll
        for (int ai = 0; ai < 2; ++ai)
#pragma unroll
            for (int m = 0; m < 4; ++m) {
                const int row = row0 + ai * HALF + m * 16, b = row >> 12;
                const float* mb = mod + b * 6144;
                float ss = 0.f;
#pragma unroll
                for (int bj = 0; bj < 2; ++bj)
#pragma unroll
                    for (int n = 0; n < 2; ++n) {
                        const int c = col0 + bj * HALF + n * 16;
                        const f32x4 xv = *(const f32x4*)(x + (size_t)row * DM + c), gt = *(const f32x4*)(mb + 2048 + c);
#ifdef DBG_NOMIX
                        const f32x4 v = xv;
#else
                        const f32x4 v = xv + gt * acc[ai][bj][m][n];
#endif
                        *(f32x4*)(x1 + (size_t)row * DM + c) = v;
                        ss += (v[0] * v[0] + v[1] * v[1]) + (v[2] * v[2] + v[3] * v[3]);
                        const f32x4 gs = *(const f32x4*)(gffn + c) * (*(const f32x4*)(mb + 4096 + c) + 1.0f);
                        const f32x4 a = v * gs;
                        u32x2 w; w.x = cvt_pk_bf16(a[0], a[1]); w.y = cvt_pk_bf16(a[2], a[3]);
                        *(u32x2*)(a3 + (size_t)row * DM + c) = w;
                    }
                ss += __shfl_xor(ss, 16); ss += __shfl_xor(ss, 32);
                if (fq == 0) sumsq[(size_t)row * 16 + u.pn * 4 + wc] = ss;
            }
    }
};

struct Epi3 {
    static constexpr bool PERM = true, AFTER_DRAIN = false;
    const float* sumsq; const float* biasf; bf16_t* sc;
    __device__ __forceinline__ void operator()(const f32x4 (&acc)[2][2][4][2], const Unit& u, int wr, int wc, int fr, int fq) const {
        const int row0 = u.pm * BM + wr * 64 + fr, col0 = u.pn * BM + wc * 32 + 8 * fq;
#pragma unroll
        for (int ai = 0; ai < 2; ++ai)
#pragma unroll
            for (int m = 0; m < 4; ++m) {
                const int row = row0 + ai * HALF + m * 16, b = row >> 12;
                const float rstd = row_rstd(sumsq, row);
#pragma unroll
                for (int bj = 0; bj < 2; ++bj) {
                    const int c = col0 + bj * HALF;
                    const f32x4 b0 = *(const f32x4*)(biasf + b * 2048 + c), b1 = *(const f32x4*)(biasf + b * 2048 + c + 4);
                    const f32x4 v0 = acc[ai][bj][m][0] * rstd + b0, v1 = acc[ai][bj][m][1] * rstd + b1;
                    u32x4 w; w.x = cvt_pk_bf16(v0[0], v0[1]); w.y = cvt_pk_bf16(v0[2], v0[3]); w.z = cvt_pk_bf16(v1[0], v1[1]); w.w = cvt_pk_bf16(v1[2], v1[3]);
                    *(u32x4*)(sc + (size_t)row * 2048 + c) = w;
                }
            }
    }
};

template <class Epi, class Sched, bool ALIGN_EPI = false, bool SP2 = false>
__device__ __forceinline__ void gemm_phase(PG8_LAS unsigned char* lds, const Gemm g, const Sched& S, const Epi& E) {
    const int tid = threadIdx.x, wid = __builtin_amdgcn_readfirstlane(tid >> 6), lane = tid & 63, wr = wid >> 2, wc = wid & 3, fr = lane & 15, fq = lane >> 4;
    const int K = g.K, nt = K / BK;
    unsigned voffA[2], voffB[2];
#pragma unroll
    for (int i = 0; i < 2; ++i) { int R, C; stage_rc(tid * 16 + i * 8192, R, C); const int Rb = Epi::PERM ? ((R & ~31) + perm32(R & 31)) : R;
        voffA[i] = (unsigned)(R * K + C) * 2u; voffB[i] = (unsigned)(Rb * K + C) * 2u; }
    const size_t kstep = (size_t)(BK * 2);
    const size_t hstep = (size_t)HALF * K * 2;
    const size_t tstep = 2 * hstep;
    const unsigned ldsw = (unsigned)wid * 1024u;
    const int aoff = lds_byte(wr * 64 + fr, fq * 8), boff = lds_byte(wc * 32 + fr, fq * 8);
#define PG8_SA(b, h) (((b) * 2 + (h)) * HTB)
#define PG8_SB(b, h) ((4 + (b) * 2 + (h)) * HTB)
#define PG8_STAGE(bufoff, gbase, voff) do { _Pragma("unroll") for (int _i = 0; _i < 2; ++_i) \
        __builtin_amdgcn_global_load_lds((const unsigned*)((const char*)(gbase) + (voff)[_i]), (PG8_LAS unsigned*)(lds + (bufoff) + ldsw + _i * 8192), 16, 0, 0); } while (0)
#define PG8_LDA(dst, b, h) do { _Pragma("unroll") for (int m = 0; m < 4; ++m) _Pragma("unroll") for (int k = 0; k < 2; ++k) dst[m][k] = *(const PG8_LAS bf16x8*)(lds + PG8_SA(b, h) + aoff + m * 2048 + k * 1024); } while (0)
#define PG8_LDB(dst, b, h) do { _Pragma("unroll") for (int n = 0; n < 2; ++n) _Pragma("unroll") for (int k = 0; k < 2; ++k) dst[n][k] = *(const PG8_LAS bf16x8*)(lds + PG8_SB(b, h) + boff + n * 2048 + k * 1024); } while (0)
#define PG8_MMA(ai, bj, At, Bt) do { __builtin_amdgcn_s_setprio(1); _Pragma("unroll") for (int m = 0; m < 4; ++m) _Pragma("unroll") for (int n = 0; n < 2; ++n) _Pragma("unroll") for (int k = 0; k < 2; ++k) \
        acc[ai][bj][m][n] = __builtin_amdgcn_mfma_f32_16x16x32_bf16(Bt[n][k], At[m][k], acc[ai][bj][m][n], 0, 0, 0); __builtin_amdgcn_s_setprio(0); } while (0)
#define PG8_WAIT_V(n) asm volatile("s_waitcnt vmcnt(" #n ")" ::: "memory")
#define PG8_WAIT_L(n) asm volatile("s_waitcnt lgkmcnt(" #n ")" ::: "memory")
#define PG8_BAR __builtin_amdgcn_s_barrier()
#define PG8_SCHED __builtin_amdgcn_sched_barrier(0)
    Unit cur, nxt; int ui = 0;
    if (!S.next(0, cur)) return;
    f32x4 acc[2][2][4][2];
#pragma unroll
    for (int a = 0; a < 2; ++a)
#pragma unroll
        for (int b = 0; b < 2; ++b)
#pragma unroll
            for (int m = 0; m < 4; ++m)
#pragma unroll
                for (int n = 0; n < 2; ++n) acc[a][b][m][n] = (f32x4){0.f, 0.f, 0.f, 0.f};
    bf16x8 At[4][2], B0[2][2], B1[2][2];
    const char* cA = (const char*)g.A + (size_t)cur.pm * tstep; const char* cB = (const char*)g.Bt + (size_t)cur.pn * tstep;
    S.a_ready(cur);
    if constexpr (SP2) {
        PG8_STAGE(PG8_SB(0, 0), cB, voffB); PG8_STAGE(PG8_SB(0, 1), cB + hstep, voffB); PG8_STAGE(PG8_SA(0, 0), cA, voffA); PG8_STAGE(PG8_SA(0, 1), cA + hstep, voffA);
        if (wr == 1) PG8_BAR;
        PG8_WAIT_V(2); PG8_BAR;
        PG8_STAGE(PG8_SB(1, 0), cB + kstep, voffB); PG8_STAGE(PG8_SA(1, 0), cA + kstep, voffA); PG8_STAGE(PG8_SB(1, 1), cB + hstep + kstep, voffB);
        PG8_WAIT_V(6); PG8_BAR;
    } else {
        PG8_STAGE(PG8_SB(0, 0), cB, voffB); PG8_STAGE(PG8_SA(0, 0), cA, voffA); PG8_STAGE(PG8_SB(0, 1), cB + hstep, voffB); PG8_STAGE(PG8_SA(0, 1), cA + hstep, voffA);
        if (wr == 1) PG8_BAR;
        PG8_WAIT_V(4); PG8_BAR;
        PG8_STAGE(PG8_SB(1, 0), cB + kstep, voffB); PG8_STAGE(PG8_SA(1, 0), cA + kstep, voffA); PG8_STAGE(PG8_SB(1, 1), cB + hstep + kstep, voffB);
        PG8_WAIT_V(6); PG8_BAR;
    }
    for (;;) {
        const bool has_next = S.next(ui + 1, nxt);
        const char* nA = has_next ? (const char*)g.A + (size_t)nxt.pm * tstep : cA; const char* nB = has_next ? (const char*)g.Bt + (size_t)nxt.pn * tstep : cB;
        for (int t = 0; t < nt; t += 2) {
            const bool last = (t == nt - 2);
            const char* a1 = cA + (size_t)(t + 1) * kstep;
            const char* a2 = last ? nA : cA + (size_t)(t + 2) * kstep; const char* b2 = last ? nB : cB + (size_t)(t + 2) * kstep;
            const char* a3 = a2 + kstep; const char* b3 = b2 + kstep;
            if (last && has_next) S.a_ready(nxt);
            if constexpr (SP2) {
            PG8_LDB(B0, 0, 0); PG8_LDB(B1, 0, 1); PG8_SCHED; PG8_LDA(At, 0, 0); PG8_STAGE(PG8_SA(1, 1), a1 + hstep, voffA);
            PG8_WAIT_V(8); PG8_WAIT_L(0); PG8_BAR; PG8_MMA(0, 0, At, B0); PG8_MMA(0, 1, At, B1); PG8_BAR; PG8_SCHED;
            PG8_LDA(At, 0, 1); PG8_STAGE(PG8_SB(0, 0), b2, voffB); PG8_STAGE(PG8_SB(0, 1), b2 + hstep, voffB); PG8_STAGE(PG8_SA(0, 0), a2, voffA);
            PG8_WAIT_V(8); PG8_WAIT_L(0); PG8_BAR; PG8_MMA(1, 0, At, B0); PG8_MMA(1, 1, At, B1); PG8_BAR; PG8_SCHED;
            PG8_LDB(B0, 1, 0); PG8_LDB(B1, 1, 1); PG8_SCHED; PG8_LDA(At, 1, 0); PG8_STAGE(PG8_SA(0, 1), a2 + hstep, voffA);
            PG8_WAIT_V(8); PG8_WAIT_L(0); PG8_BAR; PG8_MMA(0, 0, At, B0); PG8_MMA(0, 1, At, B1); PG8_BAR; PG8_SCHED;
            PG8_LDA(At, 1, 1); PG8_STAGE(PG8_SB(1, 0), b3, voffB); PG8_STAGE(PG8_SB(1, 1), b3 + hstep, voffB); PG8_STAGE(PG8_SA(1, 0), a3, voffA);
            PG8_WAIT_V(8); PG8_WAIT_L(0); PG8_BAR; PG8_MMA(1, 0, At, B0); PG8_MMA(1, 1, At, B1); PG8_BAR; PG8_SCHED;
            } else {
            PG8_LDB(B0, 0, 0); PG8_SCHED; PG8_LDA(At, 0, 0); PG8_STAGE(PG8_SA(1, 1), a1 + hstep, voffA);
            PG8_WAIT_L(8); PG8_BAR; PG8_WAIT_L(0); PG8_MMA(0, 0, At, B0); PG8_BAR; PG8_SCHED;
            PG8_LDB(B1, 0, 1); PG8_STAGE(PG8_SB(0, 0), b2, voffB);
            PG8_BAR; PG8_WAIT_L(0); PG8_MMA(0, 1, At, B1); PG8_BAR;
            PG8_LDA(At, 0, 1); PG8_STAGE(PG8_SA(0, 0), a2, voffA);
            PG8_BAR; PG8_WAIT_L(0); PG8_MMA(1, 0, At, B0); PG8_BAR; PG8_SCHED;
            PG8_STAGE(PG8_SB(0, 1), b2 + hstep, voffB);
            PG8_WAIT_V(6); PG8_BAR; PG8_MMA(1, 1, At, B1); PG8_BAR;
            PG8_LDB(B0, 1, 0); PG8_SCHED; PG8_LDA(At, 1, 0); PG8_STAGE(PG8_SA(0, 1), a2 + hstep, voffA);
            PG8_WAIT_L(8); PG8_BAR; PG8_WAIT_L(0); PG8_MMA(0, 0, At, B0); PG8_BAR; PG8_SCHED;
            PG8_LDB(B1, 1, 1); PG8_STAGE(PG8_SB(1, 0), b3, voffB);
            PG8_BAR; PG8_WAIT_L(0); PG8_MMA(0, 1, At, B1); PG8_BAR;
            PG8_LDA(At, 1, 1); PG8_STAGE(PG8_SA(1, 0), a3, voffA);
            PG8_BAR; PG8_WAIT_L(0); PG8_MMA(1, 0, At, B0); PG8_BAR; PG8_SCHED;
            PG8_STAGE(PG8_SB(1, 1), b3 + hstep, voffB);
            PG8_WAIT_V(6); PG8_BAR; PG8_MMA(1, 1, At, B1); PG8_BAR;
            }
        }
        if constexpr (ALIGN_EPI) { if (wr == 0) PG8_BAR; }
        if constexpr (!Epi::AFTER_DRAIN) { E(acc, cur, wr, wc, fr, fq); S.done(cur); }
        if (!has_next) break;
#pragma unroll
        for (int a = 0; a < 2; ++a)
#pragma unroll
            for (int b = 0; b < 2; ++b)
#pragma unroll
                for (int m = 0; m < 4; ++m)
#pragma unroll
                    for (int n = 0; n < 2; ++n) acc[a][b][m][n] = (f32x4){0.f, 0.f, 0.f, 0.f};
        cur = nxt; cA = nA; cB = nB; ++ui;
        if constexpr (ALIGN_EPI) { if (wr == 1) PG8_BAR; }
    }
    PG8_WAIT_V(0);
    if constexpr (!ALIGN_EPI) { if (wr == 0) PG8_BAR; }
    PG8_BAR;
    if constexpr (Epi::AFTER_DRAIN) { E.fused(acc, cur, wr, wc, fr, fq, lds, wid, lane); S.done(cur); }
#undef PG8_SA
#undef PG8_SB
#undef PG8_STAGE
#undef PG8_LDA
#undef PG8_LDB
#undef PG8_MMA
#undef PG8_WAIT_V
#undef PG8_WAIT_L
#undef PG8_BAR
#undef PG8_SCHED
}
}
struct Args { const float* in[13]; float* out; unsigned char* ws; int ph_lo, ph_hi; };

#ifndef TPROBE_I
#define TPROBE_I 3
#endif
#ifndef TPROBE_B
#define TPROBE_B 0
#endif
#ifdef TIME_PH
#ifndef TIME_AMP
#define TIME_AMP 4
#endif
#define TSTAMP(k, slot) do { if ((k) == TIME_PH && bid == TPROBE_B && tid == 0) { const unsigned long long t_ = __builtin_amdgcn_s_memrealtime(); MISC[slot] = (unsigned)t_; MISC[(slot) + 1] = (unsigned)(t_ >> 32); } } while (0)
#else
#define TSTAMP(k, slot) do { } while (0)
#endif
template <bool PERMUTE>
__device__ __forceinline__ void p0_transpose_item(const float* W, int K, int N, int NPOS, bf16_t* WT, LAS float* scr, int item, int lane) {
    const int nblk = NPOS / 32, kb = item / nblk, nb = item % nblk, k0 = 64 * kb, n0 = 32 * nb;
    const int pos = n0 + 4 * (lane & 7);
    const int col = PERMUTE ? win_src_col(pos) : pos;
    f32x4 v[8];
#pragma unroll
    for (int i = 0; i < 8; ++i) { const int kk = 8 * i + (lane >> 3); v[i] = (col >= 0) ? *(const f32x4*)(W + (size_t)(k0 + kk) * N + col) : (f32x4){0.f, 0.f, 0.f, 0.f}; }
#pragma unroll
    for (int i = 0; i < 8; ++i) { const int kk = 8 * i + (lane >> 3); LAS float* q = scr + kk * 33 + 4 * (lane & 7); q[0] = v[i][0]; q[1] = v[i][1]; q[2] = v[i][2]; q[3] = v[i][3]; }
    asm volatile("s_waitcnt lgkmcnt(0)" ::: "memory");
    const int c = lane & 7;
#pragma unroll
    for (int j = 0; j < 4; ++j) { const int n = (lane >> 3) + 8 * j; const LAS float* s = scr + (8 * c) * 33 + n;
        u32x4 o; o.x = pk2(s[0 * 33], s[1 * 33]); o.y = pk2(s[2 * 33], s[3 * 33]); o.z = pk2(s[4 * 33], s[5 * 33]); o.w = pk2(s[6 * 33], s[7 * 33]);
        *(u32x4*)(WT + (size_t)(n0 + n) * K + k0 + 8 * c) = o; }
    asm volatile("s_waitcnt lgkmcnt(0)" ::: "memory");
}
__device__ __forceinline__ void row_to_bf16(const float* src, bf16_t* dst, int lane) {
    const f32x4* s = (const f32x4*)src + lane; u32x2* d = (u32x2*)dst + lane;
    f32x4 v[4];
#pragma unroll
    for (int j = 0; j < 4; ++j) v[j] = s[64 * j];
#pragma unroll
    for (int j = 0; j < 4; ++j) { u32x2 w; w.x = pk2(v[j][0], v[j][1]); w.y = pk2(v[j][2], v[j][3]); d[64 * j] = w; }
}
typedef float f32x2 __attribute__((ext_vector_type(2)));
template <int NB>
__device__ __forceinline__ void rows_to_fp8(const float* src, unsigned char* dst, float* scale_out, int lane) {
    f32x4 v[NB][4];
#pragma unroll
    for (int i = 0; i < NB; ++i) { const f32x4* s = (const f32x4*)(src + (size_t)i * 1024) + 4 * lane;
#pragma unroll
        for (int j = 0; j < 4; ++j) v[i][j] = __builtin_nontemporal_load(s + j); }
#pragma unroll
    for (int i = 0; i < NB; ++i) {
        float am = 0.f;
#pragma unroll
        for (int j = 0; j < 4; ++j) am = fmaxf(am, fmaxf(fmaxf(fabsf(v[i][j][0]), fabsf(v[i][j][1])), fmaxf(fabsf(v[i][j][2]), fabsf(v[i][j][3]))));
#pragma unroll
        for (int o = 1; o < 64; o <<= 1) am = fmaxf(am, __shfl_xor(am, o));
        const float sc = am > 0.f ? am * (1.0f / 440.0f) : 1.0f, inv = 1.0f / sc;
        u32x4 w;
#pragma unroll
        for (int j = 0; j < 4; ++j) { unsigned t = 0u; t = __builtin_amdgcn_cvt_pk_fp8_f32(v[i][j][0] * inv, v[i][j][1] * inv, t, false); t = __builtin_amdgcn_cvt_pk_fp8_f32(v[i][j][2] * inv, v[i][j][3] * inv, t, true); w[j] = t; }
        *((u32x4*)(dst + (size_t)i * 1024) + lane) = w;
        if (lane == 0) scale_out[i] = sc;
    }
}
__device__ __forceinline__ void sincos_tab(double x, float& s, float& c) {
    const double k = rint(x * 0.15915494309189535);
    double r = fma(-k, 6.283185307179586, x); r = fma(-k, 2.4492935982947064e-16, r);
    const double r2 = r * r;
    double ps = 1.0, pc = 1.0;
#pragma unroll
    for (int n = 29; n >= 3; n -= 2) ps = 1.0 - ps * r2 * (1.0 / (double)((n - 1) * n));
#pragma unroll
    for (int n = 28; n >= 2; n -= 2) pc = 1.0 - pc * r2 * (1.0 / (double)((n - 1) * n));
    s = (float)(r * ps); c = (float)pc;
}

__device__ __forceinline__ void phase0(const Args& a, unsigned char* lds, int tid, int wave, int lane, int bid, int G) {
    unsigned char* ws = a.ws;
    volatile LAS unsigned* MISC = (volatile LAS unsigned*)((LAS unsigned char*)lds + MISC_OFF);
    TSTAMP(90, 0);
    if (bid & 1) { const int gw0 = bid * 8 + wave, NGW0 = G * 8;
        for (int it = gw0; it < 4096; it += NGW0) { const int r = 4 * it;
            rows_to_fp8<4>(a.in[10] + (size_t)r * 1024, ws + WS_U8 + (size_t)r * 1024, (float*)(ws + WS_USC) + r, lane); }
        __syncthreads(); }
    for (int it = bid; it < 192; it += G) {
        float* s_c = (float*)lds; float* red = (float*)(lds + 16384);
        for (int i = tid; i < 4096; i += NTHREADS) { const float v = a.in[1][i]; s_c[i] = v / (1.0f + expf(-v)); }
        __syncthreads();
        const int g = tid & 7, ks = tid >> 3, n0 = 32 * it;
        f32x4 acc[4];
#pragma unroll
        for (int b = 0; b < 4; ++b) acc[b] = (f32x4){0.f, 0.f, 0.f, 0.f};
#pragma unroll 4
        for (int i = 0; i < 16; ++i) { const int k = ks + 64 * i; const f32x4 w = *(const f32x4*)(a.in[2] + (size_t)k * 6144 + n0 + 4 * g);
#pragma unroll
            for (int b = 0; b < 4; ++b) acc[b] += w * s_c[b * 1024 + k]; }
#pragma unroll
        for (int b = 0; b < 4; ++b) *(f32x4*)(red + (ks * 8 + g) * 16 + 4 * b) = acc[b];
        __syncthreads();
        if (tid < 128) { const int b = tid >> 5, col = tid & 31, gg = col >> 2, e = col & 3; float s = 0.f;
            for (int k2 = 0; k2 < 64; ++k2) s += red[(k2 * 8 + gg) * 16 + 4 * b + e];
            ((float*)(ws + WS_MOD))[b * 6144 + n0 + col] = s + a.in[3][n0 + col]; }
        __syncthreads();
    }
    TSTAMP(90, 2); TSTAMP(91, 0);
    for (int it = bid; it < 256; it += G) {
        const int hp = it >> 4, k0 = 64 * (it & 15);
        constexpr int WP = 132;
        float* skl = (float*)lds; float* wql = skl + 128 * WP;
        for (int i = tid; i < 4096; i += NTHREADS) { const int n = i >> 5, d4 = i & 31; *(f32x4*)(skl + n * WP + 4 * d4) = *(const f32x4*)(a.in[9] + (size_t)hp * 16384 + n * 128 + 4 * d4); }
        for (int i = tid; i < 2048; i += NTHREADS) { const int k = i >> 5, d4 = i & 31; *(f32x4*)(wql + k * WP + 4 * d4) = *(const f32x4*)(a.in[8] + (size_t)(k0 + k) * 2048 + hp * 128 + 4 * d4); }
        __syncthreads();
        const int kg = tid & 15, ng = tid >> 4;
        float acc[4][4];
#pragma unroll
        for (int i = 0; i < 4; ++i)
#pragma unroll
            for (int j = 0; j < 4; ++j) acc[i][j] = 0.f;
#pragma unroll 2
        for (int d4 = 0; d4 < 32; ++d4) {
            f32x4 wv[4], sv[4];
#pragma unroll
            for (int i = 0; i < 4; ++i) { wv[i] = *(const f32x4*)(wql + (kg + 16 * i) * WP + 4 * d4); sv[i] = *(const f32x4*)(skl + (ng + 32 * i) * WP + 4 * d4); }
#pragma unroll
            for (int i = 0; i < 4; ++i)
#pragma unroll
                for (int j = 0; j < 4; ++j) acc[i][j] += (wv[i][0] * sv[j][0] + wv[i][1] * sv[j][1]) + (wv[i][2] * sv[j][2] + wv[i][3] * sv[j][3]);
        }
        bf16_t* wt = (bf16_t*)(ws + WS_WPQ);
#pragma unroll
        for (int j = 0; j < 4; ++j)
#pragma unroll
            for (int i = 0; i < 4; ++i) wt[(size_t)(hp * 128 + ng + 32 * j) * 1024 + k0 + kg + 16 * i] = (bf16_t)f2bf(acc[i][j]);
        __syncthreads();
    }
    TSTAMP(91, 2); TSTAMP(92, 0);
    const int gw = bid * 8 + wave, NGW = G * 8;
    {
        LAS float* scr = (LAS float*)(lds + wave * 16384);
        constexpr int I_IN = 16 * (N1 / 32), I_OUT = 16 * 32;
        for (int it = gw; it < I_IN + I_OUT; it += NGW) {
            if (it < I_IN) p0_transpose_item<true>(a.in[5], 1024, 4168, N1, (bf16_t*)(ws + WS_WIN), scr, it, lane);
            else p0_transpose_item<false>(a.in[6], 1024, 1024, 1024, (bf16_t*)(ws + WS_WOUT), scr, it - I_IN, lane);
        }
    }
    if (!(bid & 1)) {
        for (int it = gw; it < 4096; it += NGW) { const int r = 4 * it;
            rows_to_fp8<4>(a.in[10] + (size_t)r * 1024, ws + WS_U8 + (size_t)r * 1024, (float*)(ws + WS_USC) + r, lane); }
    }
    for (int i = bid * NTHREADS + tid; i < 4096 * 96; i += G * NTHREADS) {
        int pos, f; double r; float* ct; float* st; int idx;
        if (i < 4096 * 32) { pos = i >> 5; f = i & 31; r = 0.74989420933245582730; ct = (float*)(ws + WS_COSA); st = (float*)(ws + WS_SINA); idx = i; }
        else { const int j = i - 4096 * 32; pos = j >> 6; f = j & 63; r = 0.86398844948396852897; ct = (float*)(ws + WS_COSR); st = (float*)(ws + WS_SINR); idx = j; }
        double v = 1.0; for (int t = 0; t < f; ++t) v *= r;
        const float invf = (float)v; const float ang = (float)pos * invf;
        float s, c; sincos_tab((double)ang, s, c);
        ct[idx] = c; st[idx] = s;
    }
}

__device__ __forceinline__ void phase1(const Args& a, int wave, int lane, int bid, int G) {
    unsigned char* ws = a.ws;
    const float* mod = (const float*)(ws + WS_MOD);
    const int gw = bid * 8 + wave, NGW = G * 8;
    for (int r0 = gw; r0 < MTOK; r0 += 2 * NGW) {
        const int r1 = r0 + NGW; const bool has1 = r1 < MTOK;
        const f32x4* xa = (const f32x4*)(a.in[0] + (size_t)r0 * DM) + lane; const f32x4* xb = (const f32x4*)(a.in[0] + (size_t)(has1 ? r1 : r0) * DM) + lane;
        f32x4 va[4], vb[4]; float sa = 0.f, sb = 0.f;
#pragma unroll
        for (int j = 0; j < 4; ++j) { va[j] = xa[64 * j]; vb[j] = xb[64 * j]; }
#pragma unroll
        for (int j = 0; j < 4; ++j) { sa += (va[j][0] * va[j][0] + va[j][1] * va[j][1]) + (va[j][2] * va[j][2] + va[j][3] * va[j][3]); sb += (vb[j][0] * vb[j][0] + vb[j][1] * vb[j][1]) + (vb[j][2] * vb[j][2] + vb[j][3] * vb[j][3]); }
#pragma unroll
        for (int o = 1; o < 64; o <<= 1) { sa += __shfl_xor(sa, o); sb += __shfl_xor(sb, o); }
        const float ra = 1.0f / sqrtf(sa * (1.0f / DM) + EPS), rb = 1.0f / sqrtf(sb * (1.0f / DM) + EPS);
        const int ba = r0 >> 12, bb = (has1 ? r1 : r0) >> 12;
        u32x2* oa = (u32x2*)((bf16_t*)(ws + WS_BUFA) + (size_t)r0 * DM) + lane; u32x2* ob = (u32x2*)((bf16_t*)(ws + WS_BUFA) + (size_t)(has1 ? r1 : r0) * DM) + lane;
#pragma unroll
        for (int j = 0; j < 4; ++j) { const int c = 256 * j + 4 * lane;
            const f32x4 g = *(const f32x4*)(a.in[4] + c);
            { const f32x4 sc = *(const f32x4*)(mod + ba * 6144 + 1024 + c), sh = *(const f32x4*)(mod + ba * 6144 + c);
              const f32x4 h = va[j] * ra * g * (sc + 1.0f) + sh; u32x2 w; w.x = pk2(h[0], h[1]); w.y = pk2(h[2], h[3]); oa[64 * j] = w; }
            if (has1) { const f32x4 sc = *(const f32x4*)(mod + bb * 6144 + 1024 + c), sh = *(const f32x4*)(mod + bb * 6144 + c);
              const f32x4 h = vb[j] * rb * g * (sc + 1.0f) + sh; u32x2 w; w.x = pk2(h[0], h[1]); w.y = pk2(h[2], h[3]); ob[64 * j] = w; }
        }
    }
    for (int n = gw; n < 2048; n += NGW) {
        const u32x4* wr = (const u32x4*)((const bf16_t*)(ws + WS_WPQ) + (size_t)n * 1024);
        const u32x4 w0 = wr[lane], w1 = wr[64 + lane];
        float wf[16];
#pragma unroll
        for (int i = 0; i < 4; ++i) { wf[2 * i] = bf_lo(w0[i]); wf[2 * i + 1] = bf_hi(w0[i]); wf[8 + 2 * i] = bf_lo(w1[i]); wf[8 + 2 * i + 1] = bf_hi(w1[i]); }
#pragma unroll
        for (int b = 0; b < 4; ++b) { const float* sh = mod + b * 6144 + 3072; float s = 0.f;
#pragma unroll
            for (int i = 0; i < 8; ++i) s += wf[i] * sh[8 * lane + i] + wf[8 + i] * sh[512 + 8 * lane + i];
            s = wave_sum(s);
            if (lane == 0) ((float*)(ws + WS_BIASF))[b * 2048 + n] = s; }
    }
}

constexpr int SCP = 8200;
__device__ __forceinline__ int wave_total(int v) {
    v += __builtin_amdgcn_update_dpp(0, v, 0xB1, 0xF, 0xF, true);
    v += __builtin_amdgcn_update_dpp(0, v, 0x4E, 0xF, 0xF, true);
    v += __builtin_amdgcn_update_dpp(0, v, 0x141, 0xF, 0xF, true);
    v += __builtin_amdgcn_update_dpp(0, v, 0x140, 0xF, 0xF, true);
    return __builtin_amdgcn_readlane(v, 0) + __builtin_amdgcn_readlane(v, 16) + __builtin_amdgcn_readlane(v, 32) + __builtin_amdgcn_readlane(v, 48);
}
__device__ __forceinline__ int wave_suffix_sum(int v, int lane) {
#pragma unroll
    for (int d = 1; d < 64; d <<= 1) { const int o = __shfl_down(v, d); if (lane + d < 64) v += o; }
    return v;
}
__device__ __forceinline__ void hist_find(const unsigned* hist, int want, int lane, int& bin, int& above, int& inbin) {
    const u32x4 h = *(const u32x4*)(hist + 4 * lane);
    const int s = (int)(h.x + h.y) + (int)(h.z + h.w);
    const int incl = wave_suffix_sum(s, lane), excl = incl - s;
    const bool mine = excl < want && want <= incl;
    int c = excl, bsel = 4 * lane + 3, cin = (int)h.w;
    if (c + (int)h.w < want) { c += (int)h.w; bsel = 4 * lane + 2; cin = (int)h.z;
        if (c + (int)h.z < want) { c += (int)h.z; bsel = 4 * lane + 1; cin = (int)h.y;
            if (c + (int)h.y < want) { c += (int)h.y; bsel = 4 * lane; cin = (int)h.x; } } }
    const int src = (int)__builtin_ctzll(__ballot(mine));
    bin = __builtin_amdgcn_readlane(bsel, src); above = __builtin_amdgcn_readlane(c, src); inbin = __builtin_amdgcn_readlane(cin, src);
}
template <int NR>
__device__ __forceinline__ void select_row_t(int b, int t, unsigned char* ldsrow, unsigned* hist, unsigned long long* MASK, int lane) {
    {
        unsigned* row32 = (unsigned*)ldsrow;
        for (int i = 8 * ((t >> 4) + 1) + lane; i < 32 * NR; i += 64) row32[i] = 0u;
    }
    unsigned key[NR];
#pragma unroll
    for (int j = 0; j < NR; ++j) key[j] = *(const unsigned short*)(ldsrow + 2 * lane + 128 * j);
    unsigned mw_lo = 0u, mw_hi = 0u;
    if (t < 256) {
#pragma unroll
        for (int j = 0; j < 4; ++j) { const unsigned long long w = __ballot(key[j] != 0u);
            asm volatile("s_nop 1\n\tv_writelane_b32 %0, %2, %4\n\tv_writelane_b32 %1, %3, %4\n\ts_nop 0" : "+v"(mw_lo), "+v"(mw_hi) : "s"((unsigned)w), "s"((unsigned)(w >> 32)), "n"(j)); }
    } else {
        *(u32x4*)(hist + 4 * lane) = (u32x4){0u, 0u, 0u, 0u};
#pragma unroll
        for (int j = 0; j < NR; ++j) __hip_atomic_fetch_add(hist + (key[j] >> 8), 1u, __ATOMIC_RELAXED, __HIP_MEMORY_SCOPE_WORKGROUP);
        int B, above, inB;
        hist_find(hist, 256, lane, B, above, inB);
        *(u32x4*)(hist + 4 * lane) = (u32x4){0u, 0u, 0u, 0u};
#pragma unroll
        for (int j = 0; j < NR; ++j) if ((int)(key[j] >> 8) == B) __hip_atomic_fetch_add(hist + (key[j] & 255u), 1u, __ATOMIC_RELAXED, __HIP_MEMORY_SCOPE_WORKGROUP);
        int b2, above2, ties;
        hist_find(hist, 256 - above, lane, b2, above2, ties);
        const unsigned T = ((unsigned)B << 8) | (unsigned)b2;
        int need = 256 - above - above2;
        if (ties == need) {
#pragma unroll
            for (int j = 0; j < NR; ++j) { const unsigned long long w = __ballot(key[j] >= T);
                asm volatile("s_nop 1\n\tv_writelane_b32 %0, %2, %4\n\tv_writelane_b32 %1, %3, %4\n\ts_nop 0" : "+v"(mw_lo), "+v"(mw_hi) : "s"((unsigned)w), "s"((unsigned)(w >> 32)), "n"(j));
                if ((j & 3) == 3) __builtin_amdgcn_sched_barrier(0); }
        } else {
#pragma unroll
            for (int j = 0; j < NR; ++j) {
                const bool gt = key[j] > T, eq = key[j] == T;
                const unsigned long long em = __ballot(eq);
                const int cc = __popcll(em), take = cc < need ? cc : need;
                const int rank = (int)__builtin_amdgcn_mbcnt_hi((unsigned)(em >> 32), __builtin_amdgcn_mbcnt_lo((unsigned)em, 0u));
                const unsigned long long w = __ballot(gt || (eq && rank < take));
                need -= take;
                asm volatile("s_nop 1\n\tv_writelane_b32 %0, %2, %4\n\tv_writelane_b32 %1, %3, %4\n\ts_nop 0" : "+v"(mw_lo), "+v"(mw_hi) : "s"((unsigned)w), "s"((unsigned)(w >> 32)), "n"(j));
                if ((j & 1) == 1) __builtin_amdgcn_sched_barrier(0);
            }
        }
    }
    MASK[((size_t)b * SEQ + t) * 64 + lane] = ((unsigned long long)mw_hi << 32) | mw_lo;
}
__device__ __forceinline__ void select_row(int b, int t, unsigned char* ldsrow, unsigned* hist, unsigned long long* MASK, int lane) {
    switch (t >> 10) {
        case 0: select_row_t<16>(b, t, ldsrow, hist, MASK, lane); break;
        case 1: select_row_t<32>(b, t, ldsrow, hist, MASK, lane); break;
        case 2: select_row_t<48>(b, t, ldsrow, hist, MASK, lane); break;
        default: select_row_t<64>(b, t, ldsrow, hist, MASK, lane); break;
    }
}
__device__ __forceinline__ void idx_unit(int b, int qt, const bf16_t* QI, const bf16_t* KI, const float* WI, unsigned long long* MASK, unsigned char* lds, int wave, int lane, bool tprobe) {
    volatile LAS unsigned* MISC = (volatile LAS unsigned*)((LAS unsigned char*)lds + MISC_OFF); const int bid = tprobe ? TPROBE_B : -1; const int tid = (int)threadIdx.x;
    TSTAMP(32, 0);
    const int t0 = 16 * qt, qn = lane & 15, g = lane >> 4;
    const size_t rowq = (size_t)b * SEQ + t0 + qn;
    bf16x8 qf[8][2]; float wi[8];
#pragma unroll
    for (int h = 0; h < 8; ++h)
#pragma unroll
        for (int ks = 0; ks < 2; ++ks) qf[h][ks] = *(const bf16x8*)(QI + rowq * 512 + h * 64 + ks * 32 + 8 * g);
    { const f32x4 w0 = *(const f32x4*)(WI + rowq * 8), w1 = *(const f32x4*)(WI + rowq * 8 + 4);
#pragma unroll
      for (int e = 0; e < 4; ++e) { wi[e] = w0[e]; wi[4 + e] = w1[e]; } }
    const bf16_t* kbase = KI + ((size_t)b * SEQ + qn) * 64 + 8 * g;
    bf16x8 ra0[8], ra1[8];
#pragma unroll
    for (int i = 0; i < 8; ++i) if (wave + 8 * i <= qt) { const bf16_t* kr = kbase + (size_t)(wave + 8 * i) * 1024; ra0[i] = *(const bf16x8*)kr; ra1[i] = *(const bf16x8*)(kr + 32); }
#pragma unroll 1
    for (int base = wave; base <= qt; base += 64) {
#pragma unroll
        for (int i = 0; i < 8; ++i) {
            const int kt = base + 8 * i;
            if (kt <= qt) {
                const bf16x8 a0 = ra0[i], a1 = ra1[i];
                if (kt + 64 <= qt) { const bf16_t* kr = kbase + (size_t)(kt + 64) * 1024; ra0[i] = *(const bf16x8*)kr; ra1[i] = *(const bf16x8*)(kr + 32); }
                const int s0 = 16 * kt;
                f32x4 sc = (f32x4){0.f, 0.f, 0.f, 0.f};
#pragma unroll
                for (int h = 0; h < 8; ++h) {
                    f32x4 d = mfma16(a0, qf[h][0], (f32x4){0.f, 0.f, 0.f, 0.f}); d = mfma16(a1, qf[h][1], d);
#pragma unroll
                    for (int r = 0; r < 4; ++r) { const int di = (int)__float_as_uint(d[r]); sc[r] += wi[h] * __uint_as_float((unsigned)(di > 0 ? di : 0)); }
                }
                unsigned k[4];
#pragma unroll
                for (int r = 0; r < 4; ++r) { const unsigned kk = sortable16(sc[r]); k[r] = (s0 + 4 * g + r <= t0 + qn) ? kk : 0u; }
                u32x2 pk; pk.x = k[0] | (k[1] << 16); pk.y = k[2] | (k[3] << 16);
                *(u32x2*)(lds + qn * SCP + 2 * (s0 + 4 * g)) = pk;
            }
        }
    }
    __syncthreads();
    TSTAMP(32, 2); TSTAMP(33, 0);
#ifndef NO_SEL
#pragma unroll 1
    for (int qq = 2 * wave; qq < 2 * wave + 2; ++qq) select_row(b, t0 + qq, lds + qq * SCP, (unsigned*)(lds + 16 * SCP) + 256 * wave, MASK, lane);
#endif
    __syncthreads();
    TSTAMP(33, 2);
}

__device__ __forceinline__ void ret_state_unit(int b, int h, int vb, int dh, const bf16_t* KR, const bf16_t* VR, bf16_t* STATE, unsigned char* lds, int tid, int wave, int lane) {
    constexpr int PT = 272, KT_BYTES = 64 * PT, BUF = KT_BYTES + 16 * PT;
    const int j = tid & 127, dq = tid >> 7, g = lane >> 4, ln = lane & 15;
    const float g128 = ret_g128(h), g127 = ret_g127(h), gam = ret_gamma(h);
    f32x4 st = (f32x4){0.f, 0.f, 0.f, 0.f};
    u32x4 kA[2], kB[2], vA = (u32x4){0u, 0u, 0u, 0u}, vB = (u32x4){0u, 0u, 0u, 0u};
#define RS_LOAD(K_, V_, n) do { const size_t row = (size_t)b * SEQ + (n) * 128 + j; const u32x4* p = (const u32x4*)(KR + row * 512 + h * 128 + 64 * dh + 16 * dq); \
        K_[0] = p[0]; K_[1] = p[1]; if (tid < 256) V_ = *(const u32x4*)(VR + row * 512 + h * 128 + 16 * vb + 8 * dq); } while (0)
#define RS_WRITE(K_, V_, buf) do { _Pragma("unroll") for (int i = 0; i < 2; ++i) _Pragma("unroll") for (int e = 0; e < 4; ++e) { const unsigned w = K_[i][e]; const int d = 16 * dq + 8 * i + 2 * e; \
            *(unsigned short*)((buf) + d * PT + 2 * j) = (unsigned short)(w & 0xffffu); *(unsigned short*)((buf) + (d + 1) * PT + 2 * j) = (unsigned short)(w >> 16); } \
        if (tid < 256) { _Pragma("unroll") for (int e = 0; e < 4; ++e) { const unsigned w = V_[e]; const int v = 8 * dq + 2 * e; \
            *(unsigned short*)((buf) + KT_BYTES + v * PT + 2 * j) = (unsigned short)(w & 0xffffu); *(unsigned short*)((buf) + KT_BYTES + (v + 1) * PT + 2 * j) = (unsigned short)(w >> 16); } } } while (0)
#define RS_COMP(buf, n) do { if (wave < 4) { \
        bf16_t* sp = STATE + ((((size_t)b * 4 + h) * 32 + (n)) * 128 + 16 * vb + 4 * g) * 128 + 64 * dh + 16 * wave + ln; \
        _Pragma("unroll") for (int r = 0; r < 4; ++r) sp[r * 128] = (bf16_t)f2bf(gam * st[r]); \
        f32x4 c = (f32x4){0.f, 0.f, 0.f, 0.f}; \
        _Pragma("unroll") for (int ks = 0; ks < 4; ++ks) { \
            const bf16x8 af = *(const bf16x8*)((buf) + KT_BYTES + ln * PT + 2 * (32 * ks + 8 * g)); \
            const bf16x8 bf = *(const bf16x8*)((buf) + (16 * wave + ln) * PT + 2 * (32 * ks + 8 * g)); \
            c = mfma16(af, bf, c); } \
        st = st * g128 + c * g127; } } while (0)
    RS_LOAD(kA, vA, 0); RS_LOAD(kB, vB, 1);
#pragma unroll 1
    for (int n = 0; n < 32; n += 2) {
        RS_WRITE(kA, vA, lds);
        if (n + 2 < 32) RS_LOAD(kA, vA, n + 2);
        __syncthreads();
        RS_COMP(lds, n);
        RS_WRITE(kB, vB, lds + BUF);
        if (n + 3 < 32) RS_LOAD(kB, vB, n + 3);
        __syncthreads();
        RS_COMP(lds + BUF, n + 1);
    }
#undef RS_LOAD
#undef RS_WRITE
#undef RS_COMP
    __syncthreads();
}

__device__ __forceinline__ float amax3(float a, float b, float c) { float r; asm("v_max3_f32 %0, %1, %2, %3" : "=v"(r) : "v"(a), "v"(b), "v"(c)); return r; }
__device__ __forceinline__ void attn_unit(int b, int h, int qb, const bf16_t* QA, const bf16_t* KA, const bf16_t* VA, const unsigned long long* MASK, bf16_t* AR,
                                          unsigned char* lds, int tid, int wave, int lane) {
    constexpr int KP = 144, KS_BYTES = 64 * KP, BUF = 2 * KS_BYTES;
    const int q0 = 256 * qb, r32 = lane & 31, hi = lane >> 5;
    const int t = q0 + 32 * wave + r32;
    const size_t qrow = (size_t)b * SEQ + t;
    bf16x8 qf[4];
#pragma unroll
    for (int d0 = 0; d0 < 4; ++d0) qf[d0] = *(const bf16x8*)(QA + qrow * 512 + h * 64 + 16 * d0 + 8 * hi);
    const int NT = (q0 + 256) / 64;
    const int key_l = tid >> 3, c8 = tid & 7;
    f32x16 o0, o1;
#pragma unroll
    for (int r = 0; r < 16; ++r) { o0[r] = 0.f; o1[r] = 0.f; }
    float m_run = NEG_INF, l_run = 0.f;
    u32x4 kreg[4], vreg[4]; unsigned long long mw[4];
#define AT_LOAD(i, kt) do { const size_t kr = (size_t)b * SEQ + 64 * (kt) + key_l; kreg[i] = *(const u32x4*)(KA + kr * 512 + h * 64 + 8 * c8); vreg[i] = *(const u32x4*)(VA + kr * 512 + h * 64 + 8 * c8); \
        mw[i] = MASK[qrow * 64 + (kt)]; } while (0)
#pragma unroll
    for (int i = 0; i < 4; ++i) AT_LOAD(i, i);
#pragma unroll 1
    for (int kt4 = 0; kt4 < NT; kt4 += 4) {
#pragma unroll
      for (int i = 0; i < 4; ++i) {
        const int kt = kt4 + i;
        unsigned char* buf = lds + (i & 1) * BUF;
        *(u32x4*)(buf + key_l * KP + 16 * c8) = kreg[i];
#pragma unroll
        for (int e = 0; e < 4; ++e) { const unsigned w = vreg[i][e]; const int d = 8 * c8 + 2 * e;
            *(unsigned short*)(buf + KS_BYTES + d * KP + 2 * key_l) = (unsigned short)(w & 0xffffu); *(unsigned short*)(buf + KS_BYTES + (d + 1) * KP + 2 * key_l) = (unsigned short)(w >> 16); }
        const unsigned long long mcur = mw[i];
        if (kt + 4 < NT) AT_LOAD(i, kt + 4);
        __syncthreads();
        if (64 * kt <= q0 + 32 * wave + 31) {
            f32x16 p0, p1;
#pragma unroll
            for (int r = 0; r < 16; ++r) { p0[r] = 0.f; p1[r] = 0.f; }
#pragma unroll
            for (int d0 = 0; d0 < 4; ++d0) {
                const bf16x8 a0 = *(const bf16x8*)(buf + r32 * KP + 32 * d0 + 16 * hi);
                const bf16x8 a1 = *(const bf16x8*)(buf + (32 + r32) * KP + 32 * d0 + 16 * hi);
                p0 = mfma32(a0, qf[d0], p0); p1 = mfma32(a1, qf[d0], p1);
            }
            const unsigned wl = (unsigned)mcur >> (4 * hi), wh = (unsigned)(mcur >> 32) >> (4 * hi);
#pragma unroll
            for (int r = 0; r < 16; ++r) { const int bp = (r & 3) + 8 * (r >> 2);
                const unsigned m0 = (unsigned)((int)(wl << (31 - bp)) >> 31), m1 = (unsigned)((int)(wh << (31 - bp)) >> 31);
                p0[r] = __uint_as_float((__float_as_uint(p0[r]) & m0) | (0xff800000u & ~m0)); p1[r] = __uint_as_float((__float_as_uint(p1[r]) & m1) | (0xff800000u & ~m1)); }
            float mx;
            { float a = amax3(p0[0], p0[1], p1[0]), bq = amax3(p0[2], p0[3], p1[1]); a = amax3(a, p1[2], p1[3]);
#pragma unroll
              for (int r = 4; r < 16; r += 4) { a = amax3(a, p0[r], p0[r + 1]); bq = amax3(bq, p0[r + 2], p0[r + 3]); a = amax3(a, p1[r], p1[r + 1]); bq = amax3(bq, p1[r + 2], p1[r + 3]); }
              mx = amax3(a, bq, bq); }
            mx = amax3(mx, __shfl_xor(mx, 32), mx);
            const float m_new = amax3(m_run, mx, mx);
            const float m_use = (m_new == NEG_INF) ? 0.f : m_new;
            const float alpha = fast_exp2(m_run - m_use);
            m_run = m_new;
            float ps = 0.f;
#pragma unroll
            for (int r = 0; r < 16; ++r) { p0[r] = fast_exp2(p0[r] - m_use); p1[r] = fast_exp2(p1[r] - m_use); ps += p0[r] + p1[r]; }
            l_run = l_run * alpha + ps;
            if (__any(alpha != 1.0f)) {
#pragma unroll
                for (int r = 0; r < 16; ++r) { o0[r] *= alpha; o1[r] *= alpha; }
            }
#pragma unroll
            for (int s4 = 0; s4 < 4; ++s4) {
                const int rb = 8 * (s4 & 1);
                u32x4 pw;
                if (s4 < 2) { pw.x = pk2(p0[rb], p0[rb + 1]); pw.y = pk2(p0[rb + 2], p0[rb + 3]); pw.z = pk2(p0[rb + 4], p0[rb + 5]); pw.w = pk2(p0[rb + 6], p0[rb + 7]); }
                else        { pw.x = pk2(p1[rb], p1[rb + 1]); pw.y = pk2(p1[rb + 2], p1[rb + 3]); pw.z = pk2(p1[rb + 4], p1[rb + 5]); pw.w = pk2(p1[rb + 6], p1[rb + 7]); }
                const bf16x8 bfr = __builtin_bit_cast(bf16x8, pw);
                { const unsigned char* vp = buf + KS_BYTES + r32 * KP + 2 * (16 * s4 + 4 * hi);
                  const u32x2 lo = *(const u32x2*)vp, h2 = *(const u32x2*)(vp + 16); const u32x4 av = (u32x4){lo.x, lo.y, h2.x, h2.y};
                  o0 = mfma32(__builtin_bit_cast(bf16x8, av), bfr, o0); }
                { const unsigned char* vp = buf + KS_BYTES + (32 + r32) * KP + 2 * (16 * s4 + 4 * hi);
                  const u32x2 lo = *(const u32x2*)vp, h2 = *(const u32x2*)(vp + 16); const u32x4 av = (u32x4){lo.x, lo.y, h2.x, h2.y};
                  o1 = mfma32(__builtin_bit_cast(bf16x8, av), bfr, o1); }
            }
        }
      }
    }
#undef AT_LOAD
    l_run += __shfl_xor(l_run, 32);
#ifdef DBG_NOATT
    const float inv = 0.f;
#else
    const float inv = 1.0f / l_run;
#endif
    bf16_t* op = AR + qrow * 1024 + h * 64 + 4 * hi;
#pragma unroll
    for (int c = 0; c < 4; ++c) {
        u32x2 w; w.x = pk2(o0[4 * c] * inv, o0[4 * c + 1] * inv); w.y = pk2(o0[4 * c + 2] * inv, o0[4 * c + 3] * inv); *(u32x2*)(op + 8 * c) = w;
        u32x2 v; v.x = pk2(o1[4 * c] * inv, o1[4 * c + 1] * inv); v.y = pk2(o1[4 * c + 2] * inv, o1[4 * c + 3] * inv); *(u32x2*)(op + 32 + 8 * c) = v;
    }
    __syncthreads();
}

__device__ __forceinline__ void ret_out_unit(int b, int h, int n, const bf16_t* QR, const bf16_t* KR, const bf16_t* VR, const bf16_t* GR, const bf16_t* STATE, bf16_t* AR,
                                             unsigned char* lds, int tid, int wave, int lane) {
    constexpr int PT = 272;
    const size_t c0 = (size_t)b * SEQ + 128 * n; const int hc = 128 * h;
    const int ln = lane & 15, g = lane >> 4;
    const size_t qrow = c0 + 16 * wave + ln;
    u32x4 rr[4];
    { const int j = tid & 127, vq = tid >> 7; const u32x4* p = (const u32x4*)(VR + (c0 + j) * 512 + hc + 32 * vq); rr[0] = p[0]; rr[1] = p[1]; rr[2] = p[2]; rr[3] = p[3]; }
    bf16x8 qf[4];
#pragma unroll
    for (int ks = 0; ks < 4; ++ks) qf[ks] = *(const bf16x8*)(QR + qrow * 512 + hc + 32 * ks + 8 * g);
    bf16x8 kf[8][4];
#pragma unroll
    for (int jt = 0; jt < 8; ++jt) if (jt <= wave) { const bf16_t* kp = KR + (c0 + 16 * jt + ln) * 512 + hc + 8 * g;
#pragma unroll
        for (int ks = 0; ks < 4; ++ks) kf[jt][ks] = *(const bf16x8*)(kp + 32 * ks); }
    u32x2 gw[8];
#pragma unroll
    for (int vt = 0; vt < 8; ++vt) gw[vt] = *(const u32x2*)(GR + qrow * 512 + hc + 16 * vt + 4 * g);
    { const int j = tid & 127, vq = tid >> 7;
#pragma unroll
      for (int i = 0; i < 4; ++i)
#pragma unroll
          for (int e = 0; e < 4; ++e) { const unsigned w = rr[i][e]; const int v = 32 * vq + 8 * i + 2 * e;
              *(unsigned short*)(lds + v * PT + 2 * j) = (unsigned short)(w & 0xffffu); *(unsigned short*)(lds + (v + 1) * PT + 2 * j) = (unsigned short)(w >> 16); } }
    __syncthreads();
    f32x4 sT[8];
#pragma unroll
    for (int jt = 0; jt < 8; ++jt) {
        f32x4 d = (f32x4){0.f, 0.f, 0.f, 0.f};
        if (jt <= wave) {
#pragma unroll
            for (int ks = 0; ks < 4; ++ks) d = mfma16(kf[jt][ks], qf[ks], d);
            if (jt == wave) {
#pragma unroll
                for (int r = 0; r < 4; ++r) if (4 * g + r > ln) d[r] = 0.f;
            }
        }
        sT[jt] = d;
    }
    f32x4 oT[8];
    const bf16_t* stp = STATE + (((size_t)b * 4 + h) * 32 + n) * 16384;
#pragma unroll
    for (int vt = 0; vt < 8; ++vt) {
        f32x4 d = (f32x4){0.f, 0.f, 0.f, 0.f};
#pragma unroll
        for (int ks = 0; ks < 4; ++ks) d = mfma16(*(const bf16x8*)(stp + (16 * vt + ln) * 128 + 32 * ks + 8 * g), qf[ks], d);
        oT[vt] = d;
    }
#pragma unroll
    for (int pr = 0; pr < 4; ++pr) if (2 * pr <= wave) {
        u32x4 pw; pw.x = pk2(sT[2 * pr][0], sT[2 * pr][1]); pw.y = pk2(sT[2 * pr][2], sT[2 * pr][3]); pw.z = pk2(sT[2 * pr + 1][0], sT[2 * pr + 1][1]); pw.w = pk2(sT[2 * pr + 1][2], sT[2 * pr + 1][3]);
        const bf16x8 bfr = __builtin_bit_cast(bf16x8, pw);
#pragma unroll
        for (int vt = 0; vt < 8; ++vt) {
            const unsigned char* vp = lds + (16 * vt + ln) * PT + 2 * (32 * pr + 4 * g);
            const u32x2 lo = *(const u32x2*)vp, h2 = *(const u32x2*)(vp + 32); const u32x4 av = (u32x4){lo.x, lo.y, h2.x, h2.y};
            oT[vt] = mfma16(__builtin_bit_cast(bf16x8, av), bfr, oT[vt]);
        }
    }
    float s = 0.f;
#pragma unroll
    for (int vt = 0; vt < 8; ++vt) s += (oT[vt][0] + oT[vt][1]) + (oT[vt][2] + oT[vt][3]);
    s += __shfl_xor(s, 16); s += __shfl_xor(s, 32);
    const float mean = s * (1.0f / 128.0f);
    float q = 0.f;
#pragma unroll
    for (int vt = 0; vt < 8; ++vt)
#pragma unroll
        for (int r = 0; r < 4; ++r) { const float d = oT[vt][r] - mean; q += d * d; }
    q += __shfl_xor(q, 16); q += __shfl_xor(q, 32);
    const float rstd = 1.0f / sqrtf(q * (1.0f / 128.0f) + EPS);
#pragma unroll
    for (int vt = 0; vt < 8; ++vt) {
        const float y0 = (oT[vt][0] - mean) * rstd * bf_lo(gw[vt].x), y1 = (oT[vt][1] - mean) * rstd * bf_hi(gw[vt].x);
        const float y2 = (oT[vt][2] - mean) * rstd * bf_lo(gw[vt].y), y3 = (oT[vt][3] - mean) * rstd * bf_hi(gw[vt].y);
        u32x2 w; w.x = pk2(y0, y1); w.y = pk2(y2, y3);
        *(u32x2*)(AR + qrow * 1024 + 512 + hc + 16 * vt + 4 * g) = w;
    }
    __syncthreads();
}

template <int N> __device__ __forceinline__ void bitonic_sort_desc(unsigned (&a)[N]) {
#pragma unroll
    for (int k = 2; k <= N; k <<= 1)
#pragma unroll
        for (int j = k >> 1; j > 0; j >>= 1)
#pragma unroll
            for (int i = 0; i < N; ++i) { const int l = i ^ j;
                if (l > i) { const unsigned x = a[i], y = a[l]; const unsigned mx = x > y ? x : y, mn = x > y ? y : x;
                    if ((i & k) == 0) { a[i] = mx; a[l] = mn; } else { a[i] = mn; a[l] = mx; } } }
}
template <int N> __device__ __forceinline__ void bitonic_merge_desc(unsigned (&a)[N]) {
#pragma unroll
    for (int j = N >> 1; j > 0; j >>= 1)
#pragma unroll
        for (int i = 0; i < N; ++i) { const int l = i ^ j;
            if (l > i) { const unsigned x = a[i], y = a[l]; a[i] = x > y ? x : y; a[l] = x > y ? y : x; } }
}
__device__ __forceinline__ void top16_merge(unsigned (&best)[16], const unsigned (&grp)[16]) {
#pragma unroll
    for (int i = 0; i < 16; ++i) { const unsigned x = best[i], y = grp[15 - i]; best[i] = x > y ? x : y; }
    bitonic_merge_desc<16>(best);
}
struct CandTab { int a[64], b[64], n; constexpr CandTab() : a{}, b{}, n(0) { for (int x = 0; x < 16; ++x) for (int y = 0; y < 16; ++y) if ((x + 1) * (y + 1) <= 16) { a[n] = x; b[n] = y; ++n; } } };
constexpr CandTab kCand{};
static_assert(kCand.n == 50, "staircase candidates");

constexpr int PL_EID = 0, PL_GATE = 16384, PL_IDX = 32768;
__device__ __forceinline__ void peer_unit(int unit, unsigned char* ws, float* outp, const float* gffn, const float* gfin, unsigned char* lds, int tid, int wave, int lane) {
    volatile LAS unsigned* MISC = (volatile LAS unsigned*)((LAS unsigned char*)lds + MISC_OFF); const int bid = unit;
    TSTAMP(70, 0);
    const bf16_t* SC = (const bf16_t*)(ws + WS_SC);
    const float* mod = (const float*)(ws + WS_MOD);
#ifndef DBG_NOPEER
    {
        const int tl = tid >> 4, h = (tid >> 1) & 7, p = tid & 1;
        const size_t row = (size_t)32 * unit + tl;
        const u32x4* sp = (const u32x4*)(SC + row * 2048 + h * 256 + p * 128);
        unsigned best[16];
#pragma unroll
        for (int grp = 0; grp < 8; ++grp) {
            unsigned k[16];
#pragma unroll
            for (int q4 = 0; q4 < 2; ++q4) { const u32x4 v = sp[2 * grp + q4];
#pragma unroll
                for (int e = 0; e < 4; ++e) { const int n0 = 16 * grp + 8 * q4 + 2 * e;
                    k[8 * q4 + 2 * e] = (sortable32(bf_lo(v[e])) & ~127u) | (unsigned)(127 - n0);
                    k[8 * q4 + 2 * e + 1] = (sortable32(bf_hi(v[e])) & ~127u) | (unsigned)(127 - (n0 + 1)); } }
            bitonic_sort_desc<16>(k);
            if (grp == 0) {
#pragma unroll
                for (int i = 0; i < 16; ++i) best[i] = k[i];
            } else top16_merge(best, k);
        }
        unsigned char* il = lds + PL_IDX + (tl * 8 + h) * 32;
#pragma unroll
        for (int i = 0; i < 4; ++i) { unsigned w = 0;
#pragma unroll
            for (int e = 0; e < 4; ++e) w |= (127u - (best[4 * i + e] & 127u)) << (8 * e);
            *(unsigned*)(il + p * 16 + 4 * i) = w; }
        float v1[16], v2[16];
#pragma unroll
        for (int i = 0; i < 16; ++i) { const unsigned o = __shfl_xor(best[i], 1); const float mine = unsortable32(best[i] & ~127u), oth = unsortable32(o & ~127u);
            v1[i] = p ? oth : mine; v2[i] = p ? mine : oth; }
        unsigned top[16];
#pragma unroll
        for (int grp = 0; grp < 4; ++grp) {
            unsigned k[16];
#pragma unroll
            for (int i = 0; i < 16; ++i) { const int c = 16 * grp + i;
                k[i] = (c < kCand.n) ? ((sortable32(v1[kCand.a[c < kCand.n ? c : 0]] + v2[kCand.b[c < kCand.n ? c : 0]]) & ~255u) | (unsigned)(255 - (16 * kCand.a[c < kCand.n ? c : 0] + kCand.b[c < kCand.n ? c : 0]))) : 0u; }
            bitonic_sort_desc<16>(k);
            if (grp == 0) {
#pragma unroll
                for (int i = 0; i < 16; ++i) top[i] = k[i];
            } else top16_merge(top, k);
        }
        float ts[16], es[16], sum = 0.f;
#pragma unroll
        for (int i = 0; i < 16; ++i) ts[i] = unsortable32(top[i] & ~255u);
#pragma unroll
        for (int i = 0; i < 16; ++i) { es[i] = __expf(ts[i] - ts[0]); sum += es[i]; }
        const float rs = 1.0f / sum;
        __builtin_amdgcn_wave_barrier(); asm volatile("s_waitcnt lgkmcnt(0)" ::: "memory");
        unsigned* eo = (unsigned*)(lds + PL_EID) + tl * 128 + h * 16;
        float* go = (float*)(lds + PL_GATE) + tl * 128 + h * 16;
#pragma unroll
        for (int i = 0; i < 16; ++i) {
            const unsigned flat = 255u - (top[i] & 255u);
            const unsigned i1 = il[flat >> 4], i2 = il[16 + (flat & 15u)];
            eo[i] = i1 * 128u + i2; go[i] = es[i] * rs;
        }
    }
#endif
    __syncthreads();
    TSTAMP(70, 2); TSTAMP(71, 0);
    const unsigned char* U8 = ws + WS_U8; const unsigned char* V8 = ws + WS_V8;
    const float* USC = (const float*)(ws + WS_USC); const float* VSC = (const float*)(ws + WS_VSC);
    const int me = ((lane >> 5) & 1) * 4 + ((lane >> 4) & 1) * 2 + ((lane >> 3) & 1);
#pragma unroll 1
    for (int ti = 0; ti < 4; ++ti) {
        const int tl = wave + 8 * ti; const size_t row = (size_t)32 * unit + tl; const int b = (int)(row >> 12);
        const float* mb = mod + b * 6144;
        float x1v[16]; f32x2 hv2[8], acc2[8];
        const float rstd = pg8::row_rstd((const float*)(ws + WS_SUMSQ), (int)row);
#pragma unroll
        for (int q4 = 0; q4 < 4; ++q4) { const int c = 16 * lane + 4 * q4;
            const f32x4 xv = *(const f32x4*)(outp + row * DM + c), g = *(const f32x4*)(gffn + c), sc = *(const f32x4*)(mb + 4096 + c), sh = *(const f32x4*)(mb + 3072 + c);
            float hq[4];
#pragma unroll
            for (int e = 0; e < 4; ++e) { x1v[4 * q4 + e] = xv[e]; hq[e] = xv[e] * rstd * g[e] * (1.0f + sc[e]) + sh[e]; }
            hv2[2 * q4] = (f32x2){hq[0], hq[1]}; hv2[2 * q4 + 1] = (f32x2){hq[2], hq[3]}; acc2[2 * q4] = (f32x2){0.f, 0.f}; acc2[2 * q4 + 1] = (f32x2){0.f, 0.f}; }
        const unsigned* el = (const unsigned*)(lds + PL_EID) + tl * 128; const float* gl = (const float*)(lds + PL_GATE) + tl * 128;
        u32x4 uA[8], vA[8]; float guA, gvA;
#define PEER_LOAD(U_, V_, GU_, GV_, e0_) do { _Pragma("unroll") for (int k = 0; k < 8; ++k) { const unsigned eid = el[(e0_) + k]; \
            U_[k] = *((const u32x4*)(U8 + (size_t)eid * 1024) + lane); V_[k] = *((const u32x4*)(V8 + (size_t)eid * 1024) + lane); } \
        { const unsigned em = el[(e0_) + me]; GU_ = USC[em]; GV_ = VSC[em] * gl[(e0_) + me]; } } while (0)
#define PEER_COMP(U_, V_, GU_, GV_) do { float pd[8]; \
        _Pragma("unroll") for (int k = 0; k < 8; ++k) { f32x2 d2 = (f32x2){0.f, 0.f}; \
            _Pragma("unroll") for (int i = 0; i < 4; ++i) { const f32x2 lo = __builtin_amdgcn_cvt_pk_f32_fp8(U_[k][i], false), hi2 = __builtin_amdgcn_cvt_pk_f32_fp8(U_[k][i], true); \
                d2 = __builtin_elementwise_fma(hv2[2 * i], lo, d2); d2 = __builtin_elementwise_fma(hv2[2 * i + 1], hi2, d2); } \
            pd[k] = d2.x + d2.y; } \
        float q4_[4], r2_[2], s_; \
        _Pragma("unroll") for (int k = 0; k < 4; ++k) { const float keep = (lane & 32) ? pd[k + 4] : pd[k], send = (lane & 32) ? pd[k] : pd[k + 4]; q4_[k] = keep + __shfl_xor(send, 32); } \
        _Pragma("unroll") for (int k = 0; k < 2; ++k) { const float keep = (lane & 16) ? q4_[k + 2] : q4_[k], send = (lane & 16) ? q4_[k] : q4_[k + 2]; r2_[k] = keep + __shfl_xor(send, 16); } \
        { const float keep = (lane & 8) ? r2_[1] : r2_[0], send = (lane & 8) ? r2_[0] : r2_[1]; s_ = keep + __shfl_xor(send, 8); } \
        s_ += __shfl_xor(s_, 4); s_ += __shfl_xor(s_, 2); s_ += __shfl_xor(s_, 1); \
        const float cf_ = GV_ * gelu_exact(s_ * GU_); \
        _Pragma("unroll") for (int k = 0; k < 8; ++k) { const float c = __uint_as_float((unsigned)__builtin_amdgcn_readlane((int)__float_as_uint(cf_), 32 * (k >> 2) + 16 * ((k >> 1) & 1) + 8 * (k & 1))); \
            const f32x2 c2 = (f32x2){c, c}; \
            _Pragma("unroll") for (int i = 0; i < 4; ++i) { const f32x2 lo = __builtin_amdgcn_cvt_pk_f32_fp8(V_[k][i], false), hi2 = __builtin_amdgcn_cvt_pk_f32_fp8(V_[k][i], true); \
                acc2[2 * i] = __builtin_elementwise_fma(c2, lo, acc2[2 * i]); acc2[2 * i + 1] = __builtin_elementwise_fma(c2, hi2, acc2[2 * i + 1]); } } } while (0)
#pragma unroll 1
        for (int e0 = 0; e0 < 128; e0 += 8) {
            PEER_LOAD(uA, vA, guA, gvA, e0);
            PEER_COMP(uA, vA, guA, gvA);
        }
#undef PEER_LOAD
#undef PEER_COMP
        float ss = 0.f;
#pragma unroll
        for (int q4 = 0; q4 < 4; ++q4) { const int c = 16 * lane + 4 * q4; const f32x4 gf = *(const f32x4*)(mb + 5120 + c);
#pragma unroll
            for (int e = 0; e < 4; ++e) { const int i = 4 * q4 + e; const float av = (e < 2) ? acc2[2 * q4][e] : acc2[2 * q4 + 1][e - 2]; x1v[i] = x1v[i] + gf[e] * av; ss += x1v[i] * x1v[i]; } }
        const float r2 = 1.0f / sqrtf(wave_sum(ss) * (1.0f / DM) + EPS);
#pragma unroll
        for (int q4 = 0; q4 < 4; ++q4) { const int c = 16 * lane + 4 * q4; const f32x4 gn = *(const f32x4*)(gfin + c);
            f32x4 o;
#pragma unroll
            for (int e = 0; e < 4; ++e) o[e] = x1v[4 * q4 + e] * r2 * gn[e];
            *(f32x4*)(outp + row * DM + c) = o; }
    }
    __syncthreads();
    TSTAMP(71, 2);
}

#define XB_TMO      128
#define XB_XCNT(j)  (256  + 64 * (j))
#define XB_XSUB(j)  (1280 + 64 * (j))
#define XB_XGEN(j)  (2304 + 64 * (j))
#define XB_TOP      3328
#define XB_TOPGEN   3392
#define XCD_BAR_WORDS 3456
#define XB_SPIN_CAP (1u << 18)

__device__ __forceinline__ unsigned xb_ld(unsigned* p)              { return __hip_atomic_load(p, __ATOMIC_RELAXED, __HIP_MEMORY_SCOPE_AGENT); }
__device__ __forceinline__ unsigned xb_add(unsigned* p, unsigned v) { return __hip_atomic_fetch_add(p, v, __ATOMIC_RELAXED, __HIP_MEMORY_SCOPE_AGENT); }
__device__ __forceinline__ unsigned xb_xcc_id() { return (unsigned)__builtin_amdgcn_s_getreg((3 << 11) | 20) & 0xFu; }
#define XB_SPIN(cond, bar) do { unsigned _sp = 0; while (cond) { __builtin_amdgcn_s_sleep(1); \
    if ((++_sp & 255u) == 0u) { if (xb_ld(&(bar)[XB_TMO])) break; if (_sp > XB_SPIN_CAP) { atomicAdd(&(bar)[XB_TMO], 1u); break; } } } } while (0)

struct XcdBarrier {
    unsigned* bar; unsigned x;
    volatile LAS unsigned* st;
};

__device__ __forceinline__ XcdBarrier xcd_barrier_post(unsigned* bar, volatile LAS unsigned* st) {
    XcdBarrier b; b.bar = bar; b.x = xb_xcc_id(); b.st = st;
    if (threadIdx.x == 0) (void)xb_add(&bar[XB_XCNT(b.x)], 1u);
    return b;
}
__device__ __forceinline__ void xcd_barrier_complete(unsigned* bar, unsigned x, unsigned& nloc, unsigned& nx) {
    const unsigned G = gridDim.x * gridDim.y * gridDim.z;
    unsigned sum, cnt, mine, sp = 0u;
    for (;;) {
        sum = 0u; cnt = 0u; mine = 0u;
#pragma unroll
        for (unsigned j = 0; j < 16; ++j) { const unsigned c = xb_ld(&bar[XB_XCNT(j)]); sum += c; cnt += (c > 0u) ? 1u : 0u; mine = (j == x) ? c : mine; }
        if (sum == G) break;
        __builtin_amdgcn_s_sleep(1);
        if ((++sp & 255u) == 0u) { if (xb_ld(&bar[XB_TMO])) break; if (sp > XB_SPIN_CAP) { atomicAdd(&bar[XB_TMO], 1u); break; } }
    }
    nloc = mine > 0u ? mine : 1u; nx = cnt > 0u ? cnt : 1u;
}

__device__ __forceinline__ void xcd_barrier(const XcdBarrier& b) {
    asm volatile("s_waitcnt vmcnt(0)" ::: "memory");
    __syncthreads();
    if (threadIdx.x == 0) {
        unsigned* bar = b.bar;
        __builtin_amdgcn_s_waitcnt(0);
        unsigned nloc = b.st[0], nx = b.st[1];
        if (nloc == 0u) { xcd_barrier_complete(bar, b.x, nloc, nx); b.st[0] = nloc; b.st[1] = nx; }
        const unsigned old = xb_add(&bar[XB_XSUB(b.x)], 1u);
        const unsigned gen = old / nloc;
        if (old + 1u == (gen + 1u) * nloc) {
            __builtin_amdgcn_fence(__ATOMIC_RELEASE, "agent");
            asm volatile("s_waitcnt vmcnt(0)" ::: "memory");
            const unsigned og = xb_add(&bar[XB_TOP], 1u);
            const unsigned tg = og / nx;
            if (og + 1u == (tg + 1u) * nx) xb_add(&bar[XB_TOPGEN], 1u);
            else XB_SPIN(xb_ld(&bar[XB_TOPGEN]) == tg, bar);
            __builtin_amdgcn_fence(__ATOMIC_ACQUIRE, "agent");
            xb_add(&bar[XB_XGEN(b.x)], 1u);
            asm volatile("s_waitcnt vmcnt(0)" ::: "memory");
        } else {
            XB_SPIN(xb_ld(&bar[XB_XGEN(b.x)]) == gen, bar);
            __builtin_amdgcn_fence(__ATOMIC_ACQUIRE, "agent");
            asm volatile("s_waitcnt vmcnt(0)" ::: "memory");
        }
    }
    __syncthreads();
}

constexpr int N_PHASES = 8;
__global__ void __launch_bounds__(NTHREADS, 2) mega(Args a) {
    extern __shared__ __attribute__((aligned(16))) unsigned char lds[];
    const int tid = threadIdx.x, lane = tid & 63, wave = __builtin_amdgcn_readfirstlane(tid >> 6);
    const int bid = blockIdx.x, G = gridDim.x;
    unsigned char* ws = a.ws;
    const int lo = a.ph_lo, hi = a.ph_hi;
    volatile LAS unsigned* MISC = (volatile LAS unsigned*)((LAS unsigned char*)lds + MISC_OFF);
    if (tid < 16) MISC[tid] = 0u;
    __syncthreads();
    XcdBarrier bar; bar.bar = (unsigned*)(ws + WS_CTL) + CW_BAR; bar.x = 0; bar.st = nullptr;
    if (hi - lo > 1) bar = xcd_barrier_post((unsigned*)(ws + WS_CTL) + CW_BAR, MISC + 8);
#ifndef PH_MASK
#define PH_MASK 0xFF
#endif
#define IN(k) (((PH_MASK >> (k)) & 1) && lo <= (k) && (k) < hi)
#define SEAM(k) do { if (IN(k) && IN((k) + 1)) { xcd_barrier(bar); } } while (0)
#ifdef REP_PH
#ifndef REP_N
#define REP_N 1
#endif
#define REPS(k) for (int rep_ = 0; rep_ < ((k) == REP_PH ? 1 + REP_N : 1); ++rep_, ((k) == REP_PH && rep_ <= REP_N ? (xcd_barrier(bar), 0) : 0))
#else
#define REPS(k)
#endif

    TSTAMP(100, 0);
    TSTAMP(0, 0);
    REPS(0) if (IN(0)) phase0(a, lds, tid, wave, lane, bid, G);
    SEAM(0);
    TSTAMP(0, 2);
    TSTAMP(1, 0);
    REPS(1) if (IN(1)) phase1(a, wave, lane, bid, G);
    SEAM(1);
    TSTAMP(1, 2);
    TSTAMP(2, 0);
    REPS(2) if (IN(2)) {
        pg8::Gemm g{(const bf16_t*)(ws + WS_BUFA), (const bf16_t*)(ws + WS_WIN), MTOK, N1, DM}; pg8::StaticOrder S; S.init(MTOK, N1, G, bid);
        pg8::Epi1 E{ws};
        pg8::gemm_phase<pg8::Epi1, pg8::StaticOrder, true, true>((LAS unsigned char*)lds, g, S, E);
        const int nfull = (MTOK / 256) * (N1 / 256) - 4 * G;
        { const bool tail = nfull > 0 && nfull < G; const int cw = tail ? (bid - nfull) * 8 + wave : bid * 8 + wave, NCW = tail ? (G - nfull) * 8 : G * 8;
          if (!tail || bid >= nfull)
              for (int it = cw; it < 4096; it += NCW) { const int r = 4 * it;
                  rows_to_fp8<4>(a.in[11] + (size_t)r * 1024, ws + WS_V8 + (size_t)r * 1024, (float*)(ws + WS_VSC) + r, lane); } }
    }
    SEAM(2);
    TSTAMP(2, 2);
    TSTAMP(3, 0);
    REPS(3) if (IN(3)) {
        TSTAMP(30, 0);
        for (int u = bid; u < 256; u += G)
            ret_state_unit(u >> 6, (u >> 4) & 3, (u >> 1) & 7, u & 1, (const bf16_t*)(ws + WS_KR), (const bf16_t*)(ws + WS_VR), (bf16_t*)(ws + WS_STATE), lds, tid, wave, lane);
        TSTAMP(30, 2); TSTAMP(31, 0);
        for (int k = bid; k < 256; k += G)
#pragma unroll 1
            for (int i = 0; i < 4; ++i) {
                const int b = i, qt = (i < 2) ? k : 255 - k;
                idx_unit(b, qt, (const bf16_t*)(ws + WS_QI), (const bf16_t*)(ws + WS_KI), (const float*)(ws + WS_WI), (unsigned long long*)(ws + WS_MASK), lds, wave, lane, bid == TPROBE_B && i == TPROBE_I);
            }
        TSTAMP(31, 2);
    }
    SEAM(3);
    TSTAMP(3, 2);
    TSTAMP(4, 0);
    REPS(4) if (IN(4)) {
        TSTAMP(40, 0);
        for (int k = bid; k < 256; k += G) {
            const int bh = k >> 3, s = k & 7;
#pragma unroll 1
            for (int i = 0; i < 2; ++i)
                attn_unit(bh >> 3, bh & 7, i ? 15 - s : s, (const bf16_t*)(ws + WS_QA), (const bf16_t*)(ws + WS_KA), (const bf16_t*)(ws + WS_VA), (const unsigned long long*)(ws + WS_MASK),
                          (bf16_t*)(ws + WS_BUFB), lds, tid, wave, lane);
        }
        TSTAMP(40, 2); TSTAMP(41, 0);
        for (int u = bid; u < 512; u += G)
            ret_out_unit(u >> 7, (u >> 5) & 3, u & 31, (const bf16_t*)(ws + WS_QR), (const bf16_t*)(ws + WS_KR), (const bf16_t*)(ws + WS_VR), (const bf16_t*)(ws + WS_GR),
                         (const bf16_t*)(ws + WS_STATE), (bf16_t*)(ws + WS_BUFB), lds, tid, wave, lane);
        TSTAMP(41, 2);
    }
    SEAM(4);
    TSTAMP(4, 2);
    TSTAMP(5, 0);
    REPS(5) if (IN(5)) {
        pg8::Gemm g{(const bf16_t*)(ws + WS_BUFB), (const bf16_t*)(ws + WS_WOUT), MTOK, DM, DM}; pg8::StaticOrder S; S.init(MTOK, DM, G, bid);
        pg8::Epi2 E{a.in[0], a.out, (bf16_t*)(ws + WS_BUFA), (const float*)(ws + WS_MOD), a.in[7], (float*)(ws + WS_SUMSQ)};
        pg8::gemm_phase<pg8::Epi2, pg8::StaticOrder, true, true>((LAS unsigned char*)lds, g, S, E);
    }
    SEAM(5);
    TSTAMP(5, 2);
    TSTAMP(6, 0);
    REPS(6) if (IN(6)) {
        pg8::Gemm g{(const bf16_t*)(ws + WS_BUFA), (const bf16_t*)(ws + WS_WPQ), MTOK, 2048, DM}; pg8::StaticOrder S; S.init(MTOK, 2048, G, bid);
        pg8::Epi3 E{(const float*)(ws + WS_SUMSQ), (const float*)(ws + WS_BIASF), (bf16_t*)(ws + WS_SC)};
        pg8::gemm_phase<pg8::Epi3, pg8::StaticOrder, true, true>((LAS unsigned char*)lds, g, S, E);
    }
    SEAM(6);
    TSTAMP(6, 2);
    TSTAMP(7, 0);
    if (IN(7)) {
        for (int u = bid; u < 512; u += G) peer_unit(u, ws, a.out, a.in[7], a.in[12], lds, tid, wave, lane);
    }
    TSTAMP(7, 2);
    TSTAMP(100, 2);
#ifdef TIME_PH
    if (bid == TPROBE_B && tid == 0) {
        const unsigned long long t0_ = ((unsigned long long)MISC[1] << 32) | MISC[0], t1_ = ((unsigned long long)MISC[3] << 32) | MISC[2];
        const unsigned long long until_ = __builtin_amdgcn_s_memrealtime() + (unsigned long long)TIME_AMP * (t1_ - t0_);
        while (__builtin_amdgcn_s_memrealtime() < until_) __builtin_amdgcn_s_sleep(8);
    }
#endif
#undef IN
#undef SEAM
}

extern "C" void kernel_launch(void* const* d_in, const int* in_sizes, int n_in, void* d_out, int out_size, void* d_ws, size_t ws_size, hipStream_t stream) {
    static int grid = 0;
    if (grid == 0) {
        if (n_in != 13 || out_size != MTOK * DM || ws_size < WS_END) { fprintf(stderr, "kernel_launch: unexpected shapes (n_in %d, out %d, ws %zu); nothing launched\n", n_in, out_size, ws_size); grid = -1; return; }
        int dev = 0, cus = 0, per_cu = 0;
        if (hipGetDevice(&dev) != hipSuccess || hipDeviceGetAttribute(&cus, hipDeviceAttributeMultiprocessorCount, dev) != hipSuccess) { grid = -1; return; }
        if (hipFuncSetAttribute((const void*)mega, hipFuncAttributeMaxDynamicSharedMemorySize, LDS_BYTES) != hipSuccess) { fprintf(stderr, "kernel_launch: hipFuncSetAttribute failed\n"); grid = -1; return; }
        if (hipOccupancyMaxActiveBlocksPerMultiprocessor(&per_cu, (const void*)mega, NTHREADS, LDS_BYTES) != hipSuccess || per_cu < 1) { fprintf(stderr, "kernel_launch: occupancy query gave %d\n", per_cu); per_cu = 1; }
        (void)hipGetLastError();
        grid = cus;
    }
    if (grid < 0) return;
    if (hipMemsetAsync((char*)d_ws + WS_CTL + (size_t)CW_BAR * 4, 0, (size_t)XCD_BAR_WORDS * 4, stream) != hipSuccess) { fprintf(stderr, "kernel_launch: memset failed\n"); return; }
    Args a{};
    for (int i = 0; i < 13; ++i) a.in[i] = (const float*)d_in[i];
    a.out = (float*)d_out; a.ws = (unsigned char*)d_ws;
#if MK_MULTI
    for (int p = 0; p < N_PHASES; ++p) { a.ph_lo = p; a.ph_hi = p + 1; hipLaunchKernelGGL(mega, dim3(grid), dim3(NTHREADS), LDS_BYTES, stream, a); }
#else
    a.ph_lo = 0; a.ph_hi = N_PHASES;
    hipLaunchKernelGGL(mega, dim3(grid), dim3(NTHREADS), LDS_BYTES, stream, a);
#endif
}
```

```cpp
#include <hip/hip_runtime.h>
#include <cstdio>
#include <cstdint>

#ifndef MK_MULTI
#define MK_MULTI 0
#endif

#define GAS __attribute__((address_space(1)))
#define LAS __attribute__((address_space(3)))
typedef unsigned short bf16_t;
typedef short bf16x8 __attribute__((ext_vector_type(8)));
typedef float f32x4 __attribute__((ext_vector_type(4)));
typedef float f32x16 __attribute__((ext_vector_type(16)));
typedef unsigned u32x4 __attribute__((ext_vector_type(4)));
typedef unsigned u32x2 __attribute__((ext_vector_type(2)));

constexpr int BATCH = 4, SEQ = 4096, DM = 1024, MTOK = BATCH * SEQ;
constexpr int N1 = 4352;
constexpr int NTHREADS = 512;
constexpr float EPS = 1e-6f;
constexpr float C_QK = 0.18033688011112042f;
constexpr float NEG_INF = -__builtin_huge_valf();

__device__ __forceinline__ float ret_log2g(int h) { return h == 0 ? -0.045803689613124791f : h == 1 ? -0.022720076500083530f : h == 2 ? -0.011315313227834147f : -0.0056465631411420624f; }
__device__ __forceinline__ float ret_gamma(int h) { return h == 0 ? 0.96875f : h == 1 ? 0.984375f : h == 2 ? 0.9921875f : 0.99609375f; }
__device__ __forceinline__ float ret_g128(int h) { return h == 0 ? 0.017183023570817902f : h == 1 ? 0.13321516287964842f : h == 2 ? 0.36643771592203725f : 0.60593708822908032f; }
__device__ __forceinline__ float ret_g127(int h) { return h == 0 ? 0.017737314653747512f : h == 1 ? 0.13532968927456347f : h == 2 ? 0.36932305226788007f : 0.60831331210448848f; }

constexpr size_t MiB = 1u << 20;
constexpr size_t WS_CTL = 0, CTL_BYTES = 1 * MiB;
constexpr size_t WS_SUMSQ = 5 * MiB;
constexpr size_t WS_MOD = 1 * MiB;
constexpr size_t WS_BIASF = 1 * MiB + 128 * 1024;
constexpr size_t WS_COSA = 2 * MiB, WS_SINA = 2 * MiB + 512 * 1024;
constexpr size_t WS_COSR = 3 * MiB, WS_SINR = 4 * MiB;
constexpr size_t WS_WIN = 6 * MiB;
constexpr size_t WS_WOUT = 15 * MiB;
constexpr size_t WS_WPQ = 17 * MiB;
constexpr size_t WS_BUFA = 22 * MiB;
constexpr size_t WS_MASK = WS_BUFA, WS_STATE = WS_BUFA + 8 * MiB;
constexpr size_t WS_BUFB = 54 * MiB;
constexpr size_t WS_G1 = 86 * MiB;
constexpr size_t WS_QA = WS_G1, WS_KA = WS_G1 + 16 * MiB, WS_VA = WS_G1 + 32 * MiB, WS_QI = WS_G1 + 48 * MiB, WS_QR = WS_G1 + 64 * MiB,
                 WS_KR = WS_G1 + 80 * MiB, WS_VR = WS_G1 + 96 * MiB, WS_GR = WS_G1 + 112 * MiB, WS_KI = WS_G1 + 128 * MiB, WS_WI = WS_G1 + 130 * MiB;
constexpr size_t WS_SC = WS_G1;
constexpr size_t WS_U8 = 217 * MiB, WS_V8 = 233 * MiB;
constexpr size_t WS_USC = 249 * MiB, WS_VSC = 249 * MiB + 65536;
constexpr size_t WS_END = 256 * MiB;
static_assert(WS_WI + (size_t)MTOK * 8 * 4 <= WS_U8 && WS_SC + (size_t)MTOK * 2048 * 4 <= WS_U8 && WS_VSC + 65536 <= WS_END, "ws map");
constexpr int LDS_BYTES = 147456;
constexpr int MISC_OFF = LDS_BYTES - 64;
constexpr int CW_BAR = 4096;

__device__ __forceinline__ unsigned f2bf(float f) { unsigned u = __float_as_uint(f); return (u + 0x7fffu + ((u >> 16) & 1u)) >> 16; }
typedef float f32x2_t __attribute__((ext_vector_type(2))); typedef __bf16 bf16x2_t __attribute__((ext_vector_type(2)));
__device__ __forceinline__ unsigned pk2(float lo, float hi) { const f32x2_t v = {lo, hi}; const bf16x2_t b = __builtin_convertvector(v, bf16x2_t); return __builtin_bit_cast(unsigned, b); }
__device__ __forceinline__ float bf_lo(unsigned w) { return __uint_as_float(w << 16); }
__device__ __forceinline__ float bf_hi(unsigned w) { return __uint_as_float(w & 0xffff0000u); }
__device__ __forceinline__ float wave_sum(float v) {
#pragma unroll
    for (int o = 1; o < 64; o <<= 1) v += __shfl_xor(v, o);
    return v;
}
__device__ __forceinline__ float fast_exp2(float x) { return __builtin_amdgcn_exp2f(x); }
__device__ __forceinline__ float gelu_exact(float v) {
    const float av = fabsf(v), t = __builtin_amdgcn_rcpf(av * 0.2316418882f + 1.0f);
    float q = t * 0.5307027145f + (-0.7265760135f); q = q * t + 0.7107068705f; q = q * t + (-0.142248368f); q = q * t + 0.127414796f; q = q * t;
    const float e = fast_exp2(v * v * (-0.72134752044f));
    const float m = v * (q * e);
    return v < 0.f ? m : v - m;
}
__device__ __forceinline__ float silu_f(float v) { return v / (1.0f + __expf(-v)); }
__device__ __forceinline__ unsigned sortable32(float f) { const unsigned u = __float_as_uint(f); return (u & 0x80000000u) ? ~u : (u | 0x80000000u); }
__device__ __forceinline__ float unsortable32(unsigned s) { return __uint_as_float((s & 0x80000000u) ? (s ^ 0x80000000u) : ~s); }
__device__ __forceinline__ unsigned sortable16(float x) {
    const _Float16 h = (_Float16)x; const unsigned b = (unsigned)__builtin_bit_cast(unsigned short, h);
    return (b & 0x8000u) ? (~b & 0xFFFFu) : (b | 0x8000u);
}
__device__ __forceinline__ f32x4 mfma16(bf16x8 a, bf16x8 b, f32x4 c) { return __builtin_amdgcn_mfma_f32_16x16x32_bf16(a, b, c, 0, 0, 0); }
__device__ __forceinline__ f32x16 mfma32(bf16x8 a, bf16x8 b, f32x16 c) { return __builtin_amdgcn_mfma_f32_32x32x16_bf16(a, b, c, 0, 0, 0); }

__host__ __device__ __forceinline__ int win_src_col(int p) {
    const int tile = p >> 8, bj = (p >> 7) & 1, q = p & 127;
    if (tile < 4) return 256 * tile + (q >> 5) * 64 + bj * 32 + (q & 31);
    if (tile < 6) return p;
    if (tile < 8) return 256 * tile + (q >> 5) * 64 + bj * 32 + (q & 31);
    if (tile == 8) { if (q < 32) return 2048 + bj * 32 + q; if (bj == 0 && q < 40) return 2112 + (q - 32); return -1; }
    if (tile < 13) { const int base = (tile < 11) ? 2120 + 256 * (tile - 9) : 2632 + 256 * (tile - 11); return base + (q >> 6) * 128 + bj * 64 + (q & 63); }
    if (tile < 15) return 3144 + (p - 13 * 256);
    return 3656 + (p - 15 * 256);
}
namespace pg8 {
#define PG8_LAS __attribute__((address_space(3)))
typedef unsigned short bf16_t;
typedef short bf16x8 __attribute__((ext_vector_type(8)));
typedef float f32x4 __attribute__((ext_vector_type(4)));
typedef unsigned u32x4 __attribute__((ext_vector_type(4)));
constexpr int BM = 256, BK = 64, HALF = 128, HTB = HALF * BK * 2  , STAGE_BYTES = 8 * HTB, NXCD = 8, WGM = 8;

__host__ __device__ __forceinline__ int lds_byte(int r, int c) { const int st = (r >> 4) * 2 + (c >> 5), rr = r & 15, cc = c & 31, ob = rr * 64 + cc * 2; return st * 1024 + (ob ^ (((ob >> 9) & 1) << 5)); }
__host__ __device__ __forceinline__ void stage_rc(int b, int& R, int& C) { const int st = b / 1024, sb = b % 1024, swz = sb ^ (((sb >> 9) & 1) << 5); R = (st >> 1) * 16 + swz / 64; C = (st & 1) * 32 + (swz % 64) / 2; }
__host__ __device__ __forceinline__ int perm32(int rho) { const int n = rho >> 4, i = rho & 15; return 8 * (i >> 2) + 4 * n + (i & 3); }

struct Unit { int pm, pn; };
struct Gemm { const bf16_t* A; const bf16_t* Bt; int M, N, K; };

struct StaticOrder {
    int nM, nN, nwg, G, c;
    __host__ __device__ void init(int M, int N, int G_, int c_) { nM = M / BM; nN = N / BM; nwg = nM * nN; G = G_; c = c_; }
    __host__ __device__ bool next(int i, Unit& u) const {
        const long L = (long)i * G + c; if (L >= nwg) return false;
        int wgid = (int)L; { const int q = nwg / NXCD, r = nwg % NXCD, xcd = wgid % NXCD, off = wgid / NXCD; wgid = (xcd < r ? xcd * (q + 1) : r * (q + 1) + (xcd - r) * q) + off; }
        const int nig = WGM * nN, gid = wgid / nig, fm = gid * WGM, gsz = (nM - fm) < WGM ? (nM - fm) : WGM;
        u.pm = fm + ((wgid % nig) % gsz); u.pn = (wgid % nig) / gsz; return true;
    }
    __device__ __forceinline__ void a_ready(const Unit&) const {}
    __device__ __forceinline__ void done(const Unit&) const {}
};

__device__ __forceinline__ unsigned cvt_pk_bf16(float lo, float hi) { unsigned r; asm volatile("v_cvt_pk_bf16_f32 %0, %1, %2" : "=v"(r) : "v"(lo), "v"(hi)); return r; }
__device__ __forceinline__ u32x4 pack8(const float (&v)[8]) { u32x4 w; w.x = cvt_pk_bf16(v[0], v[1]); w.y = cvt_pk_bf16(v[2], v[3]); w.z = cvt_pk_bf16(v[4], v[5]); w.w = cvt_pk_bf16(v[6], v[7]); return w; }

struct Epi1 {
    static constexpr bool PERM = true, AFTER_DRAIN = false;
    unsigned char* ws;
    __device__ __forceinline__ void operator()(const f32x4 (&acc)[2][2][4][2], const Unit& u, int wr, int wc, int fr, int fq) const {
        const int tile = u.pn;
        const int row0 = u.pm * BM + wr * 64 + fr;
        const float* cosA = (const float*)(ws + WS_COSA); const float* sinA = (const float*)(ws + WS_SINA);
        const float* cosR = (const float*)(ws + WS_COSR); const float* sinR = (const float*)(ws + WS_SINR);
        if (tile < 4 || tile == 6 || tile == 7) {
            bf16_t* dst = (bf16_t*)(ws + (tile < 2 ? WS_QA : tile < 4 ? WS_KA : WS_QI));
            const int tl = tile < 2 ? tile : tile < 4 ? tile - 2 : tile - 6;
            const float scale = tile < 2 ? C_QK : 1.0f;
            const int cb = 256 * tl + 64 * wc, i0 = 8 * fq;
#pragma unroll
            for (int ai = 0; ai < 2; ++ai)
#pragma unroll
                for (int m = 0; m < 4; ++m) {
                    const int row = row0 + ai * HALF + m * 16, pos = row & (SEQ - 1);
                    const f32x4 c0 = *(const f32x4*)(cosA + pos * 32 + i0), c1 = *(const f32x4*)(cosA + pos * 32 + i0 + 4);
                    const f32x4 s0 = *(const f32x4*)(sinA + pos * 32 + i0), s1 = *(const f32x4*)(sinA + pos * 32 + i0 + 4);
                    float y1[8], y2[8];
#pragma unroll
                    for (int n = 0; n < 2; ++n)
#pragma unroll
                        for (int e = 0; e < 4; ++e) {
                            const float x1 = acc[ai][0][m][n][e], x2 = acc[ai][1][m][n][e];
                            const float c = n ? c1[e] : c0[e], s = n ? s1[e] : s0[e];
                            y1[4 * n + e] = (x1 * c - x2 * s) * scale; y2[4 * n + e] = (x1 * s + x2 * c) * scale;
                        }
                    bf16_t* rp = dst + (size_t)row * 512 + cb + i0;
                    *(u32x4*)rp = pack8(y1); *(u32x4*)(rp + 32) = pack8(y2);
                }
        } else if (tile == 4 || tile == 5 || tile >= 13) {
            bf16_t* dst = (bf16_t*)(ws + (tile < 6 ? WS_VA : tile < 15 ? WS_VR : WS_GR));
            const int tl = tile < 6 ? tile - 4 : tile < 15 ? tile - 13 : tile - 15;
            const bool act = tile >= 15;
#pragma unroll
            for (int ai = 0; ai < 2; ++ai)
#pragma unroll
                for (int m = 0; m < 4; ++m) {
                    const int row = row0 + ai * HALF + m * 16;
#pragma unroll
                    for (int bj = 0; bj < 2; ++bj) {
                        float y[8];
#pragma unroll
                        for (int n = 0; n < 2; ++n)
#pragma unroll
                            for (int e = 0; e < 4; ++e) { const float v = acc[ai][bj][m][n][e]; y[4 * n + e] = act ? silu_f(v) : v; }
                        *(u32x4*)(dst + (size_t)row * 512 + 256 * tl + 128 * bj + 32 * wc + 8 * fq) = pack8(y);
                    }
                }
        } else if (tile == 8) {
#pragma unroll
            for (int ai = 0; ai < 2; ++ai)
#pragma unroll
                for (int m = 0; m < 4; ++m) {
                    const int row = row0 + ai * HALF + m * 16, pos = row & (SEQ - 1);
                    if (wc == 0) {
                        const int i0 = 8 * fq;
                        const f32x4 c0 = *(const f32x4*)(cosA + pos * 32 + i0), c1 = *(const f32x4*)(cosA + pos * 32 + i0 + 4);
                        const f32x4 s0 = *(const f32x4*)(sinA + pos * 32 + i0), s1 = *(const f32x4*)(sinA + pos * 32 + i0 + 4);
                        float y1[8], y2[8];
#pragma unroll
                        for (int n = 0; n < 2; ++n)
#pragma unroll
                            for (int e = 0; e < 4; ++e) {
                                const float x1 = acc[ai][0][m][n][e], x2 = acc[ai][1][m][n][e];
                                const float c = n ? c1[e] : c0[e], s = n ? s1[e] : s0[e];
                                y1[4 * n + e] = x1 * c - x2 * s; y2[4 * n + e] = x1 * s + x2 * c;
                            }
                        bf16_t* rp = (bf16_t*)(ws + WS_KI) + (size_t)row * 64 + i0;
                        *(u32x4*)rp = pack8(y1); *(u32x4*)(rp + 32) = pack8(y2);
                    } else if (wc == 1 && fq == 0) {
                        const float sw = 0.35355339059327379f;
                        float* WI = (float*)(ws + WS_WI);
                        *(f32x4*)(WI + (size_t)row * 8) = acc[ai][0][m][0] * sw;
                        *(f32x4*)(WI + (size_t)row * 8 + 4) = acc[ai][0][m][1] * sw;
                    }
                }
        } else {
            const bool isk = tile >= 11;
            bf16_t* dst = (bf16_t*)(ws + (isk ? WS_KR : WS_QR));
            const int tl = isk ? tile - 11 : tile - 9, hl = wc >> 1, h = 2 * tl + hl;
            const int i0 = 32 * (wc & 1) + 8 * fq, cb = 256 * tl + 128 * hl;
            const float lg = isk ? -ret_log2g(h) : ret_log2g(h);
            const float base = isk ? 0.08838834764831845f : 1.0f;
#pragma unroll
            for (int ai = 0; ai < 2; ++ai)
#pragma unroll
                for (int m = 0; m < 4; ++m) {
                    const int row = row0 + ai * HALF + m * 16, pos = row & (SEQ - 1);
                    const float dec = base * fast_exp2(lg * (float)(pos & 127));
                    const f32x4 c0 = *(const f32x4*)(cosR + pos * 64 + i0), c1 = *(const f32x4*)(cosR + pos * 64 + i0 + 4);
                    const f32x4 s0 = *(const f32x4*)(sinR + pos * 64 + i0), s1 = *(const f32x4*)(sinR + pos * 64 + i0 + 4);
                    float y1[8], y2[8];
#pragma unroll
                    for (int n = 0; n < 2; ++n)
#pragma unroll
                        for (int e = 0; e < 4; ++e) {
                            const float x1 = acc[ai][0][m][n][e], x2 = acc[ai][1][m][n][e];
                            const float c = n ? c1[e] : c0[e], s = n ? s1[e] : s0[e];
                            y1[4 * n + e] = (x1 * c - x2 * s) * dec; y2[4 * n + e] = (x1 * s + x2 * c) * dec;
                        }
                    bf16_t* rp = dst + (size_t)row * 512 + cb + i0;
                    *(u32x4*)rp = pack8(y1); *(u32x4*)(rp + 64) = pack8(y2);
                }
        }
    }
};

__device__ __forceinline__ float row_rstd(const float* sumsq, int row) {
    const f32x4* p = (const f32x4*)(sumsq + (size_t)row * 16);
    const f32x4 a = p[0], b = p[1], c = p[2], d = p[3];
    const float s = (((a[0] + a[1]) + (a[2] + a[3])) + ((b[0] + b[1]) + (b[2] + b[3]))) + (((c[0] + c[1]) + (c[2] + c[3])) + ((d[0] + d[1]) + (d[2] + d[3])));
    return 1.0f / sqrtf(s * (1.0f / DM) + EPS);
}
struct Epi2 {
    static constexpr bool PERM = false, AFTER_DRAIN = false;
    const float* x; float* x1; bf16_t* a3; const float* mod; const float* gffn; float* sumsq;
    __device__ __forceinline__ void operator()(const f32x4 (&acc)[2][2][4][2], const Unit& u, int wr, int wc, int fr, int fq) const {
        const int row0 = u.pm * BM + wr * 64 + fr, col0 = u.pn * BM + wc * 32 + 4 * fq;
#pragma unroll
        for (int ai = 0; ai < 2; ++ai)
#pragma unroll
            for (int m = 0; m < 4; ++m) {
                const int row = row0 + ai * HALF + m * 16, b = row >> 12;
                const float* mb = mod + b * 6144;
                float ss = 0.f;
#pragma unroll
                for (int bj = 0; bj < 2; ++bj)
#pragma unroll
                    for (int n = 0; n < 2; ++n) {
                        const int c = col0 + bj * HALF + n * 16;
                        const f32x4 xv = *(const f32x4*)(x + (size_t)row * DM + c), gt = *(const f32x4*)(mb + 2048 + c);
#ifdef DBG_NOMIX
                        const f32x4 v = xv;
#else
                        const f32x4 v = xv + gt * acc[ai][bj][m][n];
#endif
                        *(f32x4*)(x1 + (size_t)row * DM + c) = v;
                        ss += (v[0] * v[0] + v[1] * v[1]) + (v[2] * v[2] + v[3] * v[3]);
                        const f32x4 gs = *(const f32x4*)(gffn + c) * (*(const f32x4*)(mb + 4096 + c) + 1.0f);
                        const f32x4 a = v * gs;
                        u32x2 w; w.x = cvt_pk_bf16(a[0], a[1]); w.y = cvt_pk_bf16(a[2], a[3]);
                        *(u32x2*)(a3 + (size_t)row * DM + c) = w;
                    }
                ss += __shfl_xor(ss, 16); ss += __shfl_xor(ss, 32);
                if (fq == 0) sumsq[(size_t)row * 16 + u.pn * 4 + wc] = ss;
            }
    }
};

struct Epi3 {
    static constexpr bool PERM = true, AFTER_DRAIN = false;
    const float* sumsq; const float* biasf; bf16_t* sc;
    __device__ __forceinline__ void operator()(const f32x4 (&acc)[2][2][4][2], const Unit& u, int wr, int wc, int fr, int fq) const {
        const int row0 = u.pm * BM + wr * 64 + fr, col0 = u.pn * BM + wc * 32 + 8 * fq;
#pragma unroll
        for (int ai = 0; ai < 2; ++ai)
#pragma unroll
            for (int m = 0; m < 4; ++m) {
                const int row = row0 + ai * HALF + m * 16, b = row >> 12;
                const float rstd = row_rstd(sumsq, row);
#pragma unroll
                for (int bj = 0; bj < 2; ++bj) {
                    const int c = col0 + bj * HALF;
                    const f32x4 b0 = *(const f32x4*)(biasf + b * 2048 + c), b1 = *(const f32x4*)(biasf + b * 2048 + c + 4);
                    const f32x4 v0 = acc[ai][bj][m][0] * rstd + b0, v1 = acc[ai][bj][m][1] * rstd + b1;
                    u32x4 w; w.x = cvt_pk_bf16(v0[0], v0[1]); w.y = cvt_pk_bf16(v0[2], v0[3]); w.z = cvt_pk_bf16(v1[0], v1[1]); w.w = cvt_pk_bf16(v1[2], v1[3]);
                    *(u32x4*)(sc + (size_t)row * 2048 + c) = w;
                }
            }
    }
};

template <class Epi, class Sched, bool ALIGN_EPI = false, bool SP2 = false>
__device__ __forceinline__ void gemm_phase(PG8_LAS unsigned char* lds, const Gemm g, const Sched& S, const Epi& E) {
    const int tid = threadIdx.x, wid = __builtin_amdgcn_readfirstlane(tid >> 6), lane = tid & 63, wr = wid >> 2, wc = wid & 3, fr = lane & 15, fq = lane >> 4;
    const int K = g.K, nt = K / BK;
    unsigned voffA[2], voffB[2];
#pragma unroll
    for (int i = 0; i < 2; ++i) { int R, C; stage_rc(tid * 16 + i * 8192, R, C); const int Rb = Epi::PERM ? ((R & ~31) + perm32(R & 31)) : R;
        voffA[i] = (unsigned)(R * K + C) * 2u; voffB[i] = (unsigned)(Rb * K + C) * 2u; }
    const size_t kstep = (size_t)(BK * 2);
    const size_t hstep = (size_t)HALF * K * 2;
    const size_t tstep = 2 * hstep;
    const unsigned ldsw = (unsigned)wid * 1024u;
    const int aoff = lds_byte(wr * 64 + fr, fq * 8), boff = lds_byte(wc * 32 + fr, fq * 8);
#define PG8_SA(b, h) (((b) * 2 + (h)) * HTB)
#define PG8_SB(b, h) ((4 + (b) * 2 + (h)) * HTB)
#define PG8_STAGE(bufoff, gbase, voff) do { _Pragma("unroll") for (int _i = 0; _i < 2; ++_i) \
        __builtin_amdgcn_global_load_lds((const unsigned*)((const char*)(gbase) + (voff)[_i]), (PG8_LAS unsigned*)(lds + (bufoff) + ldsw + _i * 8192), 16, 0, 0); } while (0)
#define PG8_LDA(dst, b, h) do { _Pragma("unroll") for (int m = 0; m < 4; ++m) _Pragma("unroll") for (int k = 0; k < 2; ++k) dst[m][k] = *(const PG8_LAS bf16x8*)(lds + PG8_SA(b, h) + aoff + m * 2048 + k * 1024); } while (0)
#define PG8_LDB(dst, b, h) do { _Pragma("unroll") for (int n = 0; n < 2; ++n) _Pragma("unroll") for (int k = 0; k < 2; ++k) dst[n][k] = *(const PG8_LAS bf16x8*)(lds + PG8_SB(b, h) + boff + n * 2048 + k * 1024); } while (0)
#define PG8_MMA(ai, bj, At, Bt) do { __builtin_amdgcn_s_setprio(1); _Pragma("unroll") for (int m = 0; m < 4; ++m) _Pragma("unroll") for (int n = 0; n < 2; ++n) _Pragma("unroll") for (int k = 0; k < 2; ++k) \
        acc[ai][bj][m][n] = __builtin_amdgcn_mfma_f32_16x16x32_bf16(Bt[n][k], At[m][k], acc[ai][bj][m][n], 0, 0, 0); __builtin_amdgcn_s_setprio(0); } while (0)
#define PG8_WAIT_V(n) asm volatile("s_waitcnt vmcnt(" #n ")" ::: "memory")
#define PG8_WAIT_L(n) asm volatile("s_waitcnt lgkmcnt(" #n ")" ::: "memory")
#define PG8_BAR __builtin_amdgcn_s_barrier()
#define PG8_SCHED __builtin_amdgcn_sched_barrier(0)
    Unit cur, nxt; int ui = 0;
    if (!S.next(0, cur)) return;
    f32x4 acc[2][2][4][2];
#pragma unroll
    for (int a = 0; a < 2; ++a)
#pragma unroll
        for (int b = 0; b < 2; ++b)
#pragma unroll
            for (int m = 0; m < 4; ++m)
#pragma unroll
                for (int n = 0; n < 2; ++n) acc[a][b][m][n] = (f32x4){0.f, 0.f, 0.f, 0.f};
    bf16x8 At[4][2], B0[2][2], B1[2][2];
    const char* cA = (const char*)g.A + (size_t)cur.pm * tstep; const char* cB = (const char*)g.Bt + (size_t)cur.pn * tstep;
    S.a_ready(cur);
    if constexpr (SP2) {
        PG8_STAGE(PG8_SB(0, 0), cB, voffB); PG8_STAGE(PG8_SB(0, 1), cB + hstep, voffB); PG8_STAGE(PG8_SA(0, 0), cA, voffA); PG8_STAGE(PG8_SA(0, 1), cA + hstep, voffA);
        if (wr == 1) PG8_BAR;
        PG8_WAIT_V(2); PG8_BAR;
        PG8_STAGE(PG8_SB(1, 0), cB + kstep, voffB); PG8_STAGE(PG8_SA(1, 0), cA + kstep, voffA); PG8_STAGE(PG8_SB(1, 1), cB + hstep + kstep, voffB);
        PG8_WAIT_V(6); PG8_BAR;
    } else {
        PG8_STAGE(PG8_SB(0, 0), cB, voffB); PG8_STAGE(PG8_SA(0, 0), cA, voffA); PG8_STAGE(PG8_SB(0, 1), cB + hstep, voffB); PG8_STAGE(PG8_SA(0, 1), cA + hstep, voffA);
        if (wr == 1) PG8_BAR;
        PG8_WAIT_V(4); PG8_BAR;
        PG8_STAGE(PG8_SB(1, 0), cB + kstep, voffB); PG8_STAGE(PG8_SA(1, 0), cA + kstep, voffA); PG8_STAGE(PG8_SB(1, 1), cB + hstep + kstep, voffB);
        PG8_WAIT_V(6); PG8_BAR;
    }
    for (;;) {
        const bool has_next = S.next(ui + 1, nxt);
        const char* nA = has_next ? (const char*)g.A + (size_t)nxt.pm * tstep : cA; const char* nB = has_next ? (const char*)g.Bt + (size_t)nxt.pn * tstep : cB;
        for (int t = 0; t < nt; t += 2) {
            const bool last = (t == nt - 2);
            const char* a1 = cA + (size_t)(t + 1) * kstep;
            const char* a2 = last ? nA : cA + (size_t)(t + 2) * kstep; const char* b2 = last ? nB : cB + (size_t)(t + 2) * kstep;
            const char* a3 = a2 + kstep; const char* b3 = b2 + kstep;
            if (last && has_next) S.a_ready(nxt);
            if constexpr (SP2) {
            PG8_LDB(B0, 0, 0); PG8_LDB(B1, 0, 1); PG8_SCHED; PG8_LDA(At, 0, 0); PG8_STAGE(PG8_SA(1, 1), a1 + hstep, voffA);
            PG8_WAIT_V(8); PG8_WAIT_L(0); PG8_BAR; PG8_MMA(0, 0, At, B0); PG8_MMA(0, 1, At, B1); PG8_BAR; PG8_SCHED;
            PG8_LDA(At, 0, 1); PG8_STAGE(PG8_SB(0, 0), b2, voffB); PG8_STAGE(PG8_SB(0, 1), b2 + hstep, voffB); PG8_STAGE(PG8_SA(0, 0), a2, voffA);
            PG8_WAIT_V(8); PG8_WAIT_L(0); PG8_BAR; PG8_MMA(1, 0, At, B0); PG8_MMA(1, 1, At, B1); PG8_BAR; PG8_SCHED;
            PG8_LDB(B0, 1, 0); PG8_LDB(B1, 1, 1); PG8_SCHED; PG8_LDA(At, 1, 0); PG8_STAGE(PG8_SA(0, 1), a2 + hstep, voffA);
            PG8_WAIT_V(8); PG8_WAIT_L(0); PG8_BAR; PG8_MMA(0, 0, At, B0); PG8_MMA(0, 1, At, B1); PG8_BAR; PG8_SCHED;
            PG8_LDA(At, 1, 1); PG8_STAGE(PG8_SB(1, 0), b3, voffB); PG8_STAGE(PG8_SB(1, 1), b3 + hstep, voffB); PG8_STAGE(PG8_SA(1, 0), a3, voffA);
            PG8_WAIT_V(8); PG8_WAIT_L(0); PG8_BAR; PG8_MMA(1, 0, At, B0); PG8_MMA(1, 1, At, B1); PG8_BAR; PG8_SCHED;
            } else {
            PG8_LDB(B0, 0, 0); PG8_SCHED; PG8_LDA(At, 0, 0); PG8_STAGE(PG8_SA(1, 1), a1 + hstep, voffA);
            PG8_WAIT_L(8); PG8_BAR; PG8_WAIT_L(0); PG8_MMA(0, 0, At, B0); PG8_BAR; PG8_SCHED;
            PG8_LDB(B1, 0, 1); PG8_STAGE(PG8_SB(0, 0), b2, voffB);
            PG8_BAR; PG8_WAIT_L(0); PG8_MMA(0, 1, At, B1); PG8_BAR;
            PG8_LDA(At, 0, 1); PG8_STAGE(PG8_SA(0, 0), a2, voffA);
            PG8_BAR; PG8_WAIT_L(0); PG8_MMA(1, 0, At, B0); PG8_BAR; PG8_SCHED;
            PG8_STAGE(PG8_SB(0, 1), b2 + hstep, voffB);
            PG8_WAIT_V(6); PG8_BAR; PG8_MMA(1, 1, At, B1); PG8_BAR;
            PG8_LDB(B0, 1, 0); PG8_SCHED; PG8_LDA(At, 1, 0); PG8_STAGE(PG8_SA(0, 1), a2 + hstep, voffA);
            PG8_WAIT_L(8); PG8_BAR; PG8_WAIT_L(0); PG8_MMA(0, 0, At, B0); PG8_BAR; PG8_SCHED;
            PG8_LDB(B1, 1, 1); PG8_STAGE(PG8_SB(1, 0), b3, voffB);
            PG8_BAR; PG8_WAIT_L(0); PG8_MMA(0, 1, At, B1); PG8_BAR;
            PG8_LDA(At, 1, 1); PG8_STAGE(PG8_SA(1, 0), a3, voffA);
            PG8_BAR; PG8_WAIT_L(0); PG8_MMA(1, 0, At, B0); PG8_BAR; PG8_SCHED;
            PG8_STAGE(PG8_SB(1, 1), b3 + hstep, voffB);
            PG8_WAIT_V(6); PG8_BAR; PG8_MMA(1, 1, At, B1); PG8_BAR;
            }
        }
        if constexpr (ALIGN_EPI) { if (wr == 0) PG8_BAR; }
        if constexpr (!Epi::AFTER_DRAIN) { E(acc, cur, wr, wc, fr, fq); S.done(cur); }
        if (!has_next) break;
#pragma unroll
        for (int a = 0; a < 2; ++a)
#pragma unroll
            for (int b = 0; b < 2; ++b)
#pragma unroll
                for (int m = 0; m < 4; ++m)
#pragma unroll
                    for (int n = 0; n < 2; ++n) acc[a][b][m][n] = (f32x4){0.f, 0.f, 0.f, 0.f};
        cur = nxt; cA = nA; cB = nB; ++ui;
        if constexpr (ALIGN_EPI) { if (wr == 1) PG8_BAR; }
    }
    PG8_WAIT_V(0);
    if constexpr (!ALIGN_EPI) { if (wr == 0) PG8_BAR; }
    PG8_BAR;
    if constexpr (Epi::AFTER_DRAIN) { E.fused(acc, cur, wr, wc, fr, fq, lds, wid, lane); S.done(cur); }
#undef PG8_SA
#undef PG8_SB
#undef PG8_STAGE
#undef PG8_LDA
#undef PG8_LDB
#undef PG8_MMA
#undef PG8_WAIT_V
#undef PG8_WAIT_L
#undef PG8_BAR
#undef PG8_SCHED
}
}
struct Args { const float* in[13]; float* out; unsigned char* ws; int ph_lo, ph_hi; };

#ifndef TPROBE_I
#define TPROBE_I 3
#endif
#ifndef TPROBE_B
#define TPROBE_B 0
#endif
#ifdef TIME_PH
#ifndef TIME_AMP
#define TIME_AMP 4
#endif
#define TSTAMP(k, slot) do { if ((k) == TIME_PH && bid == TPROBE_B && tid == 0) { const unsigned long long t_ = __builtin_amdgcn_s_memrealtime(); MISC[slot] = (unsigned)t_; MISC[(slot) + 1] = (unsigned)(t_ >> 32); } } while (0)
#else
#define TSTAMP(k, slot) do { } while (0)
#endif
template <bool PERMUTE>
__device__ __forceinline__ void p0_transpose_item(const float* W, int K, int N, int NPOS, bf16_t* WT, LAS float* scr, int item, int lane) {
    const int nblk = NPOS / 32, kb = item / nblk, nb = item % nblk, k0 = 64 * kb, n0 = 32 * nb;
    const int pos = n0 + 4 * (lane & 7);
    const int col = PERMUTE ? win_src_col(pos) : pos;
    f32x4 v[8];
#pragma unroll
    for (int i = 0; i < 8; ++i) { const int kk = 8 * i + (lane >> 3); v[i] = (col >= 0) ? *(const f32x4*)(W + (size_t)(k0 + kk) * N + col) : (f32x4){0.f, 0.f, 0.f, 0.f}; }
#pragma unroll
    for (int i = 0; i < 8; ++i) { const int kk = 8 * i + (lane >> 3); LAS float* q = scr + kk * 33 + 4 * (lane & 7); q[0] = v[i][0]; q[1] = v[i][1]; q[2] = v[i][2]; q[3] = v[i][3]; }
    asm volatile("s_waitcnt lgkmcnt(0)" ::: "memory");
    const int c = lane & 7;
#pragma unroll
    for (int j = 0; j < 4; ++j) { const int n = (lane >> 3) + 8 * j; const LAS float* s = scr + (8 * c) * 33 + n;
        u32x4 o; o.x = pk2(s[0 * 33], s[1 * 33]); o.y = pk2(s[2 * 33], s[3 * 33]); o.z = pk2(s[4 * 33], s[5 * 33]); o.w = pk2(s[6 * 33], s[7 * 33]);
        *(u32x4*)(WT + (size_t)(n0 + n) * K + k0 + 8 * c) = o; }
    asm volatile("s_waitcnt lgkmcnt(0)" ::: "memory");
}
__device__ __forceinline__ void row_to_bf16(const float* src, bf16_t* dst, int lane) {
    const f32x4* s = (const f32x4*)src + lane; u32x2* d = (u32x2*)dst + lane;
    f32x4 v[4];
#pragma unroll
    for (int j = 0; j < 4; ++j) v[j] = s[64 * j];
#pragma unroll
    for (int j = 0; j < 4; ++j) { u32x2 w; w.x = pk2(v[j][0], v[j][1]); w.y = pk2(v[j][2], v[j][3]); d[64 * j] = w; }
}
typedef float f32x2 __attribute__((ext_vector_type(2)));
template <int NB>
__device__ __forceinline__ void rows_to_fp8(const float* src, unsigned char* dst, float* scale_out, int lane) {
    f32x4 v[NB][4];
#pragma unroll
    for (int i = 0; i < NB; ++i) { const f32x4* s = (const f32x4*)(src + (size_t)i * 1024) + 4 * lane;
#pragma unroll
        for (int j = 0; j < 4; ++j) v[i][j] = __builtin_nontemporal_load(s + j); }
#pragma unroll
    for (int i = 0; i < NB; ++i) {
        float am = 0.f;
#pragma unroll
        for (int j = 0; j < 4; ++j) am = fmaxf(am, fmaxf(fmaxf(fabsf(v[i][j][0]), fabsf(v[i][j][1])), fmaxf(fabsf(v[i][j][2]), fabsf(v[i][j][3]))));
#pragma unroll
        for (int o = 1; o < 64; o <<= 1) am = fmaxf(am, __shfl_xor(am, o));
        const float sc = am > 0.f ? am * (1.0f / 440.0f) : 1.0f, inv = 1.0f / sc;
        u32x4 w;
#pragma unroll
        for (int j = 0; j < 4; ++j) { unsigned t = 0u; t = __builtin_amdgcn_cvt_pk_fp8_f32(v[i][j][0] * inv, v[i][j][1] * inv, t, false); t = __builtin_amdgcn_cvt_pk_fp8_f32(v[i][j][2] * inv, v[i][j][3] * inv, t, true); w[j] = t; }
        *((u32x4*)(dst + (size_t)i * 1024) + lane) = w;
        if (lane == 0) scale_out[i] = sc;
    }
}
__device__ __forceinline__ void sincos_tab(double x, float& s, float& c) {
    const double k = rint(x * 0.15915494309189535);
    double r = fma(-k, 6.283185307179586, x); r = fma(-k, 2.4492935982947064e-16, r);
    const double r2 = r * r;
    double ps = 1.0, pc = 1.0;
#pragma unroll
    for (int n = 29; n >= 3; n -= 2) ps = 1.0 - ps * r2 * (1.0 / (double)((n - 1) * n));
#pragma unroll
    for (int n = 28; n >= 2; n -= 2) pc = 1.0 - pc * r2 * (1.0 / (double)((n - 1) * n));
    s = (float)(r * ps); c = (float)pc;
}

__device__ __forceinline__ void phase0(const Args& a, unsigned char* lds, int tid, int wave, int lane, int bid, int G) {
    unsigned char* ws = a.ws;
    volatile LAS unsigned* MISC = (volatile LAS unsigned*)((LAS unsigned char*)lds + MISC_OFF);
    TSTAMP(90, 0);
    if (bid & 1) { const int gw0 = bid * 8 + wave, NGW0 = G * 8;
        for (int it = gw0; it < 4096; it += NGW0) { const int r = 4 * it;
            rows_to_fp8<4>(a.in[10] + (size_t)r * 1024, ws + WS_U8 + (size_t)r * 1024, (float*)(ws + WS_USC) + r, lane); }
        __syncthreads(); }
    for (int it = bid; it < 192; it += G) {
        float* s_c = (float*)lds; float* red = (float*)(lds + 16384);
        for (int i = tid; i < 4096; i += NTHREADS) { const float v = a.in[1][i]; s_c[i] = v / (1.0f + expf(-v)); }
        __syncthreads();
        const int g = tid & 7, ks = tid >> 3, n0 = 32 * it;
        f32x4 acc[4];
#pragma unroll
        for (int b = 0; b < 4; ++b) acc[b] = (f32x4){0.f, 0.f, 0.f, 0.f};
#pragma unroll 4
        for (int i = 0; i < 16; ++i) { const int k = ks + 64 * i; const f32x4 w = *(const f32x4*)(a.in[2] + (size_t)k * 6144 + n0 + 4 * g);
#pragma unroll
            for (int b = 0; b < 4; ++b) acc[b] += w * s_c[b * 1024 + k]; }
#pragma unroll
        for (int b = 0; b < 4; ++b) *(f32x4*)(red + (ks * 8 + g) * 16 + 4 * b) = acc[b];
        __syncthreads();
        if (tid < 128) { const int b = tid >> 5, col = tid & 31, gg = col >> 2, e = col & 3; float s = 0.f;
            for (int k2 = 0; k2 < 64; ++k2) s += red[(k2 * 8 + gg) * 16 + 4 * b + e];
            ((float*)(ws + WS_MOD))[b * 6144 + n0 + col] = s + a.in[3][n0 + col]; }
        __syncthreads();
    }
    TSTAMP(90, 2); TSTAMP(91, 0);
    for (int it = bid; it < 256; it += G) {
        const int hp = it >> 4, k0 = 64 * (it & 15);
        constexpr int WP = 132;
        float* skl = (float*)lds; float* wql = skl + 128 * WP;
        for (int i = tid; i < 4096; i += NTHREADS) { const int n = i >> 5, d4 = i & 31; *(f32x4*)(skl + n * WP + 4 * d4) = *(const f32x4*)(a.in[9] + (size_t)hp * 16384 + n * 128 + 4 * d4); }
        for (int i = tid; i < 2048; i += NTHREADS) { const int k = i >> 5, d4 = i & 31; *(f32x4*)(wql + k * WP + 4 * d4) = *(const f32x4*)(a.in[8] + (size_t)(k0 + k) * 2048 + hp * 128 + 4 * d4); }
        __syncthreads();
        const int kg = tid & 15, ng = tid >> 4;
        float acc[4][4];
#pragma unroll
        for (int i = 0; i < 4; ++i)
#pragma unroll
            for (int j = 0; j < 4; ++j) acc[i][j] = 0.f;
#pragma unroll 2
        for (int d4 = 0; d4 < 32; ++d4) {
            f32x4 wv[4], sv[4];
#pragma unroll
            for (int i = 0; i < 4; ++i) { wv[i] = *(const f32x4*)(wql + (kg + 16 * i) * WP + 4 * d4); sv[i] = *(const f32x4*)(skl + (ng + 32 * i) * WP + 4 * d4); }
#pragma unroll
            for (int i = 0; i < 4; ++i)
#pragma unroll
                for (int j = 0; j < 4; ++j) acc[i][j] += (wv[i][0] * sv[j][0] + wv[i][1] * sv[j][1]) + (wv[i][2] * sv[j][2] + wv[i][3] * sv[j][3]);
        }
        bf16_t* wt = (bf16_t*)(ws + WS_WPQ);
#pragma unroll
        for (int j = 0; j < 4; ++j)
#pragma unroll
            for (int i = 0; i < 4; ++i) wt[(size_t)(hp * 128 + ng + 32 * j) * 1024 + k0 + kg + 16 * i] = (bf16_t)f2bf(acc[i][j]);
        __syncthreads();
    }
    TSTAMP(91, 2); TSTAMP(92, 0);
    const int gw = bid * 8 + wave, NGW = G * 8;
    {
        LAS float* scr = (LAS float*)(lds + wave * 16384);
        constexpr int I_IN = 16 * (N1 / 32), I_OUT = 16 * 32;
        for (int it = gw; it < I_IN + I_OUT; it += NGW) {
            if (it < I_IN) p0_transpose_item<true>(a.in[5], 1024, 4168, N1, (bf16_t*)(ws + WS_WIN), scr, it, lane);
            else p0_transpose_item<false>(a.in[6], 1024, 1024, 1024, (bf16_t*)(ws + WS_WOUT), scr, it - I_IN, lane);
        }
    }
    if (!(bid & 1)) {
        for (int it = gw; it < 4096; it += NGW) { const int r = 4 * it;
            rows_to_fp8<4>(a.in[10] + (size_t)r * 1024, ws + WS_U8 + (size_t)r * 1024, (float*)(ws + WS_USC) + r, lane); }
    }
    for (int i = bid * NTHREADS + tid; i < 4096 * 96; i += G * NTHREADS) {
        int pos, f; double r; float* ct; float* st; int idx;
        if (i < 4096 * 32) { pos = i >> 5; f = i & 31; r = 0.74989420933245582730; ct = (float*)(ws + WS_COSA); st = (float*)(ws + WS_SINA); idx = i; }
        else { const int j = i - 4096 * 32; pos = j >> 6; f = j & 63; r = 0.86398844948396852897; ct = (float*)(ws + WS_COSR); st = (float*)(ws + WS_SINR); idx = j; }
        double v = 1.0; for (int t = 0; t < f; ++t) v *= r;
        const float invf = (float)v; const float ang = (float)pos * invf;
        float s, c; sincos_tab((double)ang, s, c);
        ct[idx] = c; st[idx] = s;
    }
}

__device__ __forceinline__ void phase1(const Args& a, int wave, int lane, int bid, int G) {
    unsigned char* ws = a.ws;
    const float* mod = (const float*)(ws + WS_MOD);
    const int gw = bid * 8 + wave, NGW = G * 8;
    for (int r0 = gw; r0 < MTOK; r0 += 2 * NGW) {
        const int r1 = r0 + NGW; const bool has1 = r1 < MTOK;
        const f32x4* xa = (const f32x4*)(a.in[0] + (size_t)r0 * DM) + lane; const f32x4* xb = (const f32x4*)(a.in[0] + (size_t)(has1 ? r1 : r0) * DM) + lane;
        f32x4 va[4], vb[4]; float sa = 0.f, sb = 0.f;
#pragma unroll
        for (int j = 0; j < 4; ++j) { va[j] = xa[64 * j]; vb[j] = xb[64 * j]; }
#pragma unroll
        for (int j = 0; j < 4; ++j) { sa += (va[j][0] * va[j][0] + va[j][1] * va[j][1]) + (va[j][2] * va[j][2] + va[j][3] * va[j][3]); sb += (vb[j][0] * vb[j][0] + vb[j][1] * vb[j][1]) + (vb[j][2] * vb[j][2] + vb[j][3] * vb[j][3]); }
#pragma unroll
        for (int o = 1; o < 64; o <<= 1) { sa += __shfl_xor(sa, o); sb += __shfl_xor(sb, o); }
        const float ra = 1.0f / sqrtf(sa * (1.0f / DM) + EPS), rb = 1.0f / sqrtf(sb * (1.0f / DM) + EPS);
        const int ba = r0 >> 12, bb = (has1 ? r1 : r0) >> 12;
        u32x2* oa = (u32x2*)((bf16_t*)(ws + WS_BUFA) + (size_t)r0 * DM) + lane; u32x2* ob = (u32x2*)((bf16_t*)(ws + WS_BUFA) + (size_t)(has1 ? r1 : r0) * DM) + lane;
#pragma unroll
        for (int j = 0; j < 4; ++j) { const int c = 256 * j + 4 * lane;
            const f32x4 g = *(const f32x4*)(a.in[4] + c);
            { const f32x4 sc = *(const f32x4*)(mod + ba * 6144 + 1024 + c), sh = *(const f32x4*)(mod + ba * 6144 + c);
              const f32x4 h = va[j] * ra * g * (sc + 1.0f) + sh; u32x2 w; w.x = pk2(h[0], h[1]); w.y = pk2(h[2], h[3]); oa[64 * j] = w; }
            if (has1) { const f32x4 sc = *(const f32x4*)(mod + bb * 6144 + 1024 + c), sh = *(const f32x4*)(mod + bb * 6144 + c);
              const f32x4 h = vb[j] * rb * g * (sc + 1.0f) + sh; u32x2 w; w.x = pk2(h[0], h[1]); w.y = pk2(h[2], h[3]); ob[64 * j] = w; }
        }
    }
    for (int n = gw; n < 2048; n += NGW) {
        const u32x4* wr = (const u32x4*)((const bf16_t*)(ws + WS_WPQ) + (size_t)n * 1024);
        const u32x4 w0 = wr[lane], w1 = wr[64 + lane];
        float wf[16];
#pragma unroll
        for (int i = 0; i < 4; ++i) { wf[2 * i] = bf_lo(w0[i]); wf[2 * i + 1] = bf_hi(w0[i]); wf[8 + 2 * i] = bf_lo(w1[i]); wf[8 + 2 * i + 1] = bf_hi(w1[i]); }
#pragma unroll
        for (int b = 0; b < 4; ++b) { const float* sh = mod + b * 6144 + 3072; float s = 0.f;
#pragma unroll
            for (int i = 0; i < 8; ++i) s += wf[i] * sh[8 * lane + i] + wf[8 + i] * sh[512 + 8 * lane + i];
            s = wave_sum(s);
            if (lane == 0) ((float*)(ws + WS_BIASF))[b * 2048 + n] = s; }
    }
}

constexpr int SCP = 8200;
__device__ __forceinline__ int wave_total(int v) {
    v += __builtin_amdgcn_update_dpp(0, v, 0xB1, 0xF, 0xF, true);
    v += __builtin_amdgcn_update_dpp(0, v, 0x4E, 0xF, 0xF, true);
    v += __builtin_amdgcn_update_dpp(0, v, 0x141, 0xF, 0xF, true);
    v += __builtin_amdgcn_update_dpp(0, v, 0x140, 0xF, 0xF, true);
    return __builtin_amdgcn_readlane(v, 0) + __builtin_amdgcn_readlane(v, 16) + __builtin_amdgcn_readlane(v, 32) + __builtin_amdgcn_readlane(v, 48);
}
__device__ __forceinline__ int wave_suffix_sum(int v, int lane) {
#pragma unroll
    for (int d = 1; d < 64; d <<= 1) { const int o = __shfl_down(v, d); if (lane + d < 64) v += o; }
    return v;
}
__device__ __forceinline__ void hist_find(const unsigned* hist, int want, int lane, int& bin, int& above, int& inbin) {
    const u32x4 h = *(const u32x4*)(hist + 4 * lane);
    const int s = (int)(h.x + h.y) + (int)(h.z + h.w);
    const int incl = wave_suffix_sum(s, lane), excl = incl - s;
    const bool mine = excl < want && want <= incl;
    int c = excl, bsel = 4 * lane + 3, cin = (int)h.w;
    if (c + (int)h.w < want) { c += (int)h.w; bsel = 4 * lane + 2; cin = (int)h.z;
        if (c + (int)h.z < want) { c += (int)h.z; bsel = 4 * lane + 1; cin = (int)h.y;
            if (c + (int)h.y < want) { c += (int)h.y; bsel = 4 * lane; cin = (int)h.x; } } }
    const int src = (int)__builtin_ctzll(__ballot(mine));
    bin = __builtin_amdgcn_readlane(bsel, src); above = __builtin_amdgcn_readlane(c, src); inbin = __builtin_amdgcn_readlane(cin, src);
}
template <int NR>
__device__ __forceinline__ void select_row_t(int b, int t, unsigned char* ldsrow, unsigned* hist, unsigned long long* MASK, int lane) {
    {
        unsigned* row32 = (unsigned*)ldsrow;
        for (int i = 8 * ((t >> 4) + 1) + lane; i < 32 * NR; i += 64) row32[i] = 0u;
    }
    unsigned key[NR];
#pragma unroll
    for (int j = 0; j < NR; ++j) key[j] = *(const unsigned short*)(ldsrow + 2 * lane + 128 * j);
    unsigned mw_lo = 0u, mw_hi = 0u;
    if (t < 256) {
#pragma unroll
        for (int j = 0; j < 4; ++j) { const unsigned long long w = __ballot(key[j] != 0u);
            asm volatile("s_nop 1\n\tv_writelane_b32 %0, %2, %4\n\tv_writelane_b32 %1, %3, %4\n\ts_nop 0" : "+v"(mw_lo), "+v"(mw_hi) : "s"((unsigned)w), "s"((unsigned)(w >> 32)), "n"(j)); }
    } else {
        *(u32x4*)(hist + 4 * lane) = (u32x4){0u, 0u, 0u, 0u};
#pragma unroll
        for (int j = 0; j < NR; ++j) __hip_atomic_fetch_add(hist + (key[j] >> 8), 1u, __ATOMIC_RELAXED, __HIP_MEMORY_SCOPE_WORKGROUP);
        int B, above, inB;
        hist_find(hist, 256, lane, B, above, inB);
        *(u32x4*)(hist + 4 * lane) = (u32x4){0u, 0u, 0u, 0u};
#pragma unroll
        for (int j = 0; j < NR; ++j) if ((int)(key[j] >> 8) == B) __hip_atomic_fetch_add(hist + (key[j] & 255u), 1u, __ATOMIC_RELAXED, __HIP_MEMORY_SCOPE_WORKGROUP);
        int b2, above2, ties;
        hist_find(hist, 256 - above, lane, b2, above2, ties);
        const unsigned T = ((unsigned)B << 8) | (unsigned)b2;
        int need = 256 - above - above2;
        if (ties == need) {
#pragma unroll
            for (int j = 0; j < NR; ++j) { const unsigned long long w = __ballot(key[j] >= T);
                asm volatile("s_nop 1\n\tv_writelane_b32 %0, %2, %4\n\tv_writelane_b32 %1, %3, %4\n\ts_nop 0" : "+v"(mw_lo), "+v"(mw_hi) : "s"((unsigned)w), "s"((unsigned)(w >> 32)), "n"(j));
                if ((j & 3) == 3) __builtin_amdgcn_sched_barrier(0); }
        } else {
#pragma unroll
            for (int j = 0; j < NR; ++j) {
                const bool gt = key[j] > T, eq = key[j] == T;
                const unsigned long long em = __ballot(eq);
                const int cc = __popcll(em), take = cc < need ? cc : need;
                const int rank = (int)__builtin_amdgcn_mbcnt_hi((unsigned)(em >> 32), __builtin_amdgcn_mbcnt_lo((unsigned)em, 0u));
                const unsigned long long w = __ballot(gt || (eq && rank < take));
                need -= take;
                asm volatile("s_nop 1\n\tv_writelane_b32 %0, %2, %4\n\tv_writelane_b32 %1, %3, %4\n\ts_nop 0" : "+v"(mw_lo), "+v"(mw_hi) : "s"((unsigned)w), "s"((unsigned)(w >> 32)), "n"(j));
                if ((j & 1) == 1) __builtin_amdgcn_sched_barrier(0);
            }
        }
    }
    MASK[((size_t)b * SEQ + t) * 64 + lane] = ((unsigned long long)mw_hi << 32) | mw_lo;
}
__device__ __forceinline__ void select_row(int b, int t, unsigned char* ldsrow, unsigned* hist, unsigned long long* MASK, int lane) {
    switch (t >> 10) {
        case 0: select_row_t<16>(b, t, ldsrow, hist, MASK, lane); break;
        case 1: select_row_t<32>(b, t, ldsrow, hist, MASK, lane); break;
        case 2: select_row_t<48>(b, t, ldsrow, hist, MASK, lane); break;
        default: select_row_t<64>(b, t, ldsrow, hist, MASK, lane); break;
    }
}
__device__ __forceinline__ void idx_unit(int b, int qt, const bf16_t* QI, const bf16_t* KI, const float* WI, unsigned long long* MASK, unsigned char* lds, int wave, int lane, bool tprobe) {
    volatile LAS unsigned* MISC = (volatile LAS unsigned*)((LAS unsigned char*)lds + MISC_OFF); const int bid = tprobe ? TPROBE_B : -1; const int tid = (int)threadIdx.x;
    TSTAMP(32, 0);
    const int t0 = 16 * qt, qn = lane & 15, g = lane >> 4;
    const size_t rowq = (size_t)b * SEQ + t0 + qn;
    bf16x8 qf[8][2]; float wi[8];
#pragma unroll
    for (int h = 0; h < 8; ++h)
#pragma unroll
        for (int ks = 0; ks < 2; ++ks) qf[h][ks] = *(const bf16x8*)(QI + rowq * 512 + h * 64 + ks * 32 + 8 * g);
    { const f32x4 w0 = *(const f32x4*)(WI + rowq * 8), w1 = *(const f32x4*)(WI + rowq * 8 + 4);
#pragma unroll
      for (int e = 0; e < 4; ++e) { wi[e] = w0[e]; wi[4 + e] = w1[e]; } }
    const bf16_t* kbase = KI + ((size_t)b * SEQ + qn) * 64 + 8 * g;
    bf16x8 ra0[8], ra1[8];
#pragma unroll
    for (int i = 0; i < 8; ++i) if (wave + 8 * i <= qt) { const bf16_t* kr = kbase + (size_t)(wave + 8 * i) * 1024; ra0[i] = *(const bf16x8*)kr; ra1[i] = *(const bf16x8*)(kr + 32); }
#pragma unroll 1
    for (int base = wave; base <= qt; base += 64) {
#pragma unroll
        for (int i = 0; i < 8; ++i) {
            const int kt = base + 8 * i;
            if (kt <= qt) {
                const bf16x8 a0 = ra0[i], a1 = ra1[i];
                if (kt + 64 <= qt) { const bf16_t* kr = kbase + (size_t)(kt + 64) * 1024; ra0[i] = *(const bf16x8*)kr; ra1[i] = *(const bf16x8*)(kr + 32); }
                const int s0 = 16 * kt;
                f32x4 sc = (f32x4){0.f, 0.f, 0.f, 0.f};
#pragma unroll
                for (int h = 0; h < 8; ++h) {
                    f32x4 d = mfma16(a0, qf[h][0], (f32x4){0.f, 0.f, 0.f, 0.f}); d = mfma16(a1, qf[h][1], d);
#pragma unroll
                    for (int r = 0; r < 4; ++r) { const int di = (int)__float_as_uint(d[r]); sc[r] += wi[h] * __uint_as_float((unsigned)(di > 0 ? di : 0)); }
                }
                unsigned k[4];
#pragma unroll
                for (int r = 0; r < 4; ++r) { const unsigned kk = sortable16(sc[r]); k[r] = (s0 + 4 * g + r <= t0 + qn) ? kk : 0u; }
                u32x2 pk; pk.x = k[0] | (k[1] << 16); pk.y = k[2] | (k[3] << 16);
                *(u32x2*)(lds + qn * SCP + 2 * (s0 + 4 * g)) = pk;
            }
        }
    }
    __syncthreads();
    TSTAMP(32, 2); TSTAMP(33, 0);
#ifndef NO_SEL
#pragma unroll 1
    for (int qq = 2 * wave; qq < 2 * wave + 2; ++qq) select_row(b, t0 + qq, lds + qq * SCP, (unsigned*)(lds + 16 * SCP) + 256 * wave, MASK, lane);
#endif
    __syncthreads();
    TSTAMP(33, 2);
}

__device__ __forceinline__ void ret_state_unit(int b, int h, int vb, int dh, const bf16_t* KR, const bf16_t* VR, bf16_t* STATE, unsigned char* lds, int tid, int wave, int lane) {
    constexpr int PT = 272, KT_BYTES = 64 * PT, BUF = KT_BYTES + 16 * PT;
    const int j = tid & 127, dq = tid >> 7, g = lane >> 4, ln = lane & 15;
    const float g128 = ret_g128(h), g127 = ret_g127(h), gam = ret_gamma(h);
    f32x4 st = (f32x4){0.f, 0.f, 0.f, 0.f};
    u32x4 kA[2], kB[2], vA = (u32x4){0u, 0u, 0u, 0u}, vB = (u32x4){0u, 0u, 0u, 0u};
#define RS_LOAD(K_, V_, n) do { const size_t row = (size_t)b * SEQ + (n) * 128 + j; const u32x4* p = (const u32x4*)(KR + row * 512 + h * 128 + 64 * dh + 16 * dq); \
        K_[0] = p[0]; K_[1] = p[1]; if (tid < 256) V_ = *(const u32x4*)(VR + row * 512 + h * 128 + 16 * vb + 8 * dq); } while (0)
#define RS_WRITE(K_, V_, buf) do { _Pragma("unroll") for (int i = 0; i < 2; ++i) _Pragma("unroll") for (int e = 0; e < 4; ++e) { const unsigned w = K_[i][e]; const int d = 16 * dq + 8 * i + 2 * e; \
            *(unsigned short*)((buf) + d * PT + 2 * j) = (unsigned short)(w & 0xffffu); *(unsigned short*)((buf) + (d + 1) * PT + 2 * j) = (unsigned short)(w >> 16); } \
        if (tid < 256) { _Pragma("unroll") for (int e = 0; e < 4; ++e) { const unsigned w = V_[e]; const int v = 8 * dq + 2 * e; \
            *(unsigned short*)((buf) + KT_BYTES + v * PT + 2 * j) = (unsigned short)(w & 0xffffu); *(unsigned short*)((buf) + KT_BYTES + (v + 1) * PT + 2 * j) = (unsigned short)(w >> 16); } } } while (0)
#define RS_COMP(buf, n) do { if (wave < 4) { \
        bf16_t* sp = STATE + ((((size_t)b * 4 + h) * 32 + (n)) * 128 + 16 * vb + 4 * g) * 128 + 64 * dh + 16 * wave + ln; \
        _Pragma("unroll") for (int r = 0; r < 4; ++r) sp[r * 128] = (bf16_t)f2bf(gam * st[r]); \
        f32x4 c = (f32x4){0.f, 0.f, 0.f, 0.f}; \
        _Pragma("unroll") for (int ks = 0; ks < 4; ++ks) { \
            const bf16x8 af = *(const bf16x8*)((buf) + KT_BYTES + ln * PT + 2 * (32 * ks + 8 * g)); \
            const bf16x8 bf = *(const bf16x8*)((buf) + (16 * wave + ln) * PT + 2 * (32 * ks + 8 * g)); \
            c = mfma16(af, bf, c); } \
        st = st * g128 + c * g127; } } while (0)
    RS_LOAD(kA, vA, 0); RS_LOAD(kB, vB, 1);
#pragma unroll 1
    for (int n = 0; n < 32; n += 2) {
        RS_WRITE(kA, vA, lds);
        if (n + 2 < 32) RS_LOAD(kA, vA, n + 2);
        __syncthreads();
        RS_COMP(lds, n);
        RS_WRITE(kB, vB, lds + BUF);
        if (n + 3 < 32) RS_LOAD(kB, vB, n + 3);
        __syncthreads();
        RS_COMP(lds + BUF, n + 1);
    }
#undef RS_LOAD
#undef RS_WRITE
#undef RS_COMP
    __syncthreads();
}

__device__ __forceinline__ float amax3(float a, float b, float c) { float r; asm("v_max3_f32 %0, %1, %2, %3" : "=v"(r) : "v"(a), "v"(b), "v"(c)); return r; }
__device__ __forceinline__ void attn_unit(int b, int h, int qb, const bf16_t* QA, const bf16_t* KA, const bf16_t* VA, const unsigned long long* MASK, bf16_t* AR,
                                          unsigned char* lds, int tid, int wave, int lane) {
    constexpr int KP = 144, KS_BYTES = 64 * KP, BUF = 2 * KS_BYTES;
    const int q0 = 256 * qb, r32 = lane & 31, hi = lane >> 5;
    const int t = q0 + 32 * wave + r32;
    const size_t qrow = (size_t)b * SEQ + t;
    bf16x8 qf[4];
#pragma unroll
    for (int d0 = 0; d0 < 4; ++d0) qf[d0] = *(const bf16x8*)(QA + qrow * 512 + h * 64 + 16 * d0 + 8 * hi);
    const int NT = (q0 + 256) / 64;
    const int key_l = tid >> 3, c8 = tid & 7;
    f32x16 o0, o1;
#pragma unroll
    for (int r = 0; r < 16; ++r) { o0[r] = 0.f; o1[r] = 0.f; }
    float m_run = NEG_INF, l_run = 0.f;
    u32x4 kreg[4], vreg[4]; unsigned long long mw[4];
#define AT_LOAD(i, kt) do { const size_t kr = (size_t)b * SEQ + 64 * (kt) + key_l; kreg[i] = *(const u32x4*)(KA + kr * 512 + h * 64 + 8 * c8); vreg[i] = *(const u32x4*)(VA + kr * 512 + h * 64 + 8 * c8); \
        mw[i] = MASK[qrow * 64 + (kt)]; } while (0)
#pragma unroll
    for (int i = 0; i < 4; ++i) AT_LOAD(i, i);
#pragma unroll 1
    for (int kt4 = 0; kt4 < NT; kt4 += 4) {
#pragma unroll
      for (int i = 0; i < 4; ++i) {
        const int kt = kt4 + i;
        unsigned char* buf = lds + (i & 1) * BUF;
        *(u32x4*)(buf + key_l * KP + 16 * c8) = kreg[i];
#pragma unroll
        for (int e = 0; e < 4; ++e) { const unsigned w = vreg[i][e]; const int d = 8 * c8 + 2 * e;
            *(unsigned short*)(buf + KS_BYTES + d * KP + 2 * key_l) = (unsigned short)(w & 0xffffu); *(unsigned short*)(buf + KS_BYTES + (d + 1) * KP + 2 * key_l) = (unsigned short)(w >> 16); }
        const unsigned long long mcur = mw[i];
        if (kt + 4 < NT) AT_LOAD(i, kt + 4);
        __syncthreads();
        if (64 * kt <= q0 + 32 * wave + 31) {
            f32x16 p0, p1;
#pragma unroll
            for (int r = 0; r < 16; ++r) { p0[r] = 0.f; p1[r] = 0.f; }
#pragma unroll
            for (int d0 = 0; d0 < 4; ++d0) {
                const bf16x8 a0 = *(const bf16x8*)(buf + r32 * KP + 32 * d0 + 16 * hi);
                const bf16x8 a1 = *(const bf16x8*)(buf + (32 + r32) * KP + 32 * d0 + 16 * hi);
                p0 = mfma32(a0, qf[d0], p0); p1 = mfma32(a1, qf[d0], p1);
            }
            const unsigned wl = (unsigned)mcur >> (4 * hi), wh = (unsigned)(mcur >> 32) >> (4 * hi);
#pragma unroll
            for (int r = 0; r < 16; ++r) { const int bp = (r & 3) + 8 * (r >> 2);
                const unsigned m0 = (unsigned)((int)(wl << (31 - bp)) >> 31), m1 = (unsigned)((int)(wh << (31 - bp)) >> 31);
                p0[r] = __uint_as_float((__float_as_uint(p0[r]) & m0) | (0xff800000u & ~m0)); p1[r] = __uint_as_float((__float_as_uint(p1[r]) & m1) | (0xff800000u & ~m1)); }
            float mx;
            { float a = amax3(p0[0], p0[1], p1[0]), bq = amax3(p0[2], p0[3], p1[1]); a = amax3(a, p1[2], p1[3]);
#pragma unroll
              for (int r = 4; r < 16; r += 4) { a = amax3(a, p0[r], p0[r + 1]); bq = amax3(bq, p0[r + 2], p0[r + 3]); a = amax3(a, p1[r], p1[r + 1]); bq = amax3(bq, p1[r + 2], p1[r + 3]); }
              mx = amax3(a, bq, bq); }
            mx = amax3(mx, __shfl_xor(mx, 32), mx);
            const float m_new = amax3(m_run, mx, mx);
            const float m_use = (m_new == NEG_INF) ? 0.f : m_new;
            const float alpha = fast_exp2(m_run - m_use);
            m_run = m_new;
            float ps = 0.f;
#pragma unroll
            for (int r = 0; r < 16; ++r) { p0[r] = fast_exp2(p0[r] - m_use); p1[r] = fast_exp2(p1[r] - m_use); ps += p0[r] + p1[r]; }
            l_run = l_run * alpha + ps;
            if (__any(alpha != 1.0f)) {
#pragma unroll
                for (int r = 0; r < 16; ++r) { o0[r] *= alpha; o1[r] *= alpha; }
            }
#pragma unroll
            for (int s4 = 0; s4 < 4; ++s4) {
                const int rb = 8 * (s4 & 1);
                u32x4 pw;
                if (s4 < 2) { pw.x = pk2(p0[rb], p0[rb + 1]); pw.y = pk2(p0[rb + 2], p0[rb + 3]); pw.z = pk2(p0[rb + 4], p0[rb + 5]); pw.w = pk2(p0[rb + 6], p0[rb + 7]); }
                else        { pw.x = pk2(p1[rb], p1[rb + 1]); pw.y = pk2(p1[rb + 2], p1[rb + 3]); pw.z = pk2(p1[rb + 4], p1[rb + 5]); pw.w = pk2(p1[rb + 6], p1[rb + 7]); }
                const bf16x8 bfr = __builtin_bit_cast(bf16x8, pw);
                { const unsigned char* vp = buf + KS_BYTES + r32 * KP + 2 * (16 * s4 + 4 * hi);
                  const u32x2 lo = *(const u32x2*)vp, h2 = *(const u32x2*)(vp + 16); const u32x4 av = (u32x4){lo.x, lo.y, h2.x, h2.y};
                  o0 = mfma32(__builtin_bit_cast(bf16x8, av), bfr, o0); }
                { const unsigned char* vp = buf + KS_BYTES + (32 + r32) * KP + 2 * (16 * s4 + 4 * hi);
                  const u32x2 lo = *(const u32x2*)vp, h2 = *(const u32x2*)(vp + 16); const u32x4 av = (u32x4){lo.x, lo.y, h2.x, h2.y};
                  o1 = mfma32(__builtin_bit_cast(bf16x8, av), bfr, o1); }
            }
        }
      }
    }
#undef AT_LOAD
    l_run += __shfl_xor(l_run, 32);
#ifdef DBG_NOATT
    const float inv = 0.f;
#else
    const float inv = 1.0f / l_run;
#endif
    bf16_t* op = AR + qrow * 1024 + h * 64 + 4 * hi;
#pragma unroll
    for (int c = 0; c < 4; ++c) {
        u32x2 w; w.x = pk2(o0[4 * c] * inv, o0[4 * c + 1] * inv); w.y = pk2(o0[4 * c + 2] * inv, o0[4 * c + 3] * inv); *(u32x2*)(op + 8 * c) = w;
        u32x2 v; v.x = pk2(o1[4 * c] * inv, o1[4 * c + 1] * inv); v.y = pk2(o1[4 * c + 2] * inv, o1[4 * c + 3] * inv); *(u32x2*)(op + 32 + 8 * c) = v;
    }
    __syncthreads();
}

__device__ __forceinline__ void ret_out_unit(int b, int h, int n, const bf16_t* QR, const bf16_t* KR, const bf16_t* VR, const bf16_t* GR, const bf16_t* STATE, bf16_t* AR,
                                             unsigned char* lds, int tid, int wave, int lane) {
    constexpr int PT = 272;
    const size_t c0 = (size_t)b * SEQ + 128 * n; const int hc = 128 * h;
    const int ln = lane & 15, g = lane >> 4;
    const size_t qrow = c0 + 16 * wave + ln;
    u32x4 rr[4];
    { const int j = tid & 127, vq = tid >> 7; const u32x4* p = (const u32x4*)(VR + (c0 + j) * 512 + hc + 32 * vq); rr[0] = p[0]; rr[1] = p[1]; rr[2] = p[2]; rr[3] = p[3]; }
    bf16x8 qf[4];
#pragma unroll
    for (int ks = 0; ks < 4; ++ks) qf[ks] = *(const bf16x8*)(QR + qrow * 512 + hc + 32 * ks + 8 * g);
    bf16x8 kf[8][4];
#pragma unroll
    for (int jt = 0; jt < 8; ++jt) if (jt <= wave) { const bf16_t* kp = KR + (c0 + 16 * jt + ln) * 512 + hc + 8 * g;
#pragma unroll
        for (int ks = 0; ks < 4; ++ks) kf[jt][ks] = *(const bf16x8*)(kp + 32 * ks); }
    u32x2 gw[8];
#pragma unroll
    for (int vt = 0; vt < 8; ++vt) gw[vt] = *(const u32x2*)(GR + qrow * 512 + hc + 16 * vt + 4 * g);
    { const int j = tid & 127, vq = tid >> 7;
#pragma unroll
      for (int i = 0; i < 4; ++i)
#pragma unroll
          for (int e = 0; e < 4; ++e) { const unsigned w = rr[i][e]; const int v = 32 * vq + 8 * i + 2 * e;
              *(unsigned short*)(lds + v * PT + 2 * j) = (unsigned short)(w & 0xffffu); *(unsigned short*)(lds + (v + 1) * PT + 2 * j) = (unsigned short)(w >> 16); } }
    __syncthreads();
    f32x4 sT[8];
#pragma unroll
    for (int jt = 0; jt < 8; ++jt) {
        f32x4 d = (f32x4){0.f, 0.f, 0.f, 0.f};
        if (jt <= wave) {
#pragma unroll
            for (int ks = 0; ks < 4; ++ks) d = mfma16(kf[jt][ks], qf[ks], d);
            if (jt == wave) {
#pragma unroll
                for (int r = 0; r < 4; ++r) if (4 * g + r > ln) d[r] = 0.f;
            }
        }
        sT[jt] = d;
    }
    f32x4 oT[8];
    const bf16_t* stp = STATE + (((size_t)b * 4 + h) * 32 + n) * 16384;
#pragma unroll
    for (int vt = 0; vt < 8; ++vt) {
        f32x4 d = (f32x4){0.f, 0.f, 0.f, 0.f};
#pragma unroll
        for (int ks = 0; ks < 4; ++ks) d = mfma16(*(const bf16x8*)(stp + (16 * vt + ln) * 128 + 32 * ks + 8 * g), qf[ks], d);
        oT[vt] = d;
    }
#pragma unroll
    for (int pr = 0; pr < 4; ++pr) if (2 * pr <= wave) {
        u32x4 pw; pw.x = pk2(sT[2 * pr][0], sT[2 * pr][1]); pw.y = pk2(sT[2 * pr][2], sT[2 * pr][3]); pw.z = pk2(sT[2 * pr + 1][0], sT[2 * pr + 1][1]); pw.w = pk2(sT[2 * pr + 1][2], sT[2 * pr + 1][3]);
        const bf16x8 bfr = __builtin_bit_cast(bf16x8, pw);
#pragma unroll
        for (int vt = 0; vt < 8; ++vt) {
            const unsigned char* vp = lds + (16 * vt + ln) * PT + 2 * (32 * pr + 4 * g);
            const u32x2 lo = *(const u32x2*)vp, h2 = *(const u32x2*)(vp + 32); const u32x4 av = (u32x4){lo.x, lo.y, h2.x, h2.y};
            oT[vt] = mfma16(__builtin_bit_cast(bf16x8, av), bfr, oT[vt]);
        }
    }
    float s = 0.f;
#pragma unroll
    for (int vt = 0; vt < 8; ++vt) s += (oT[vt][0] + oT[vt][1]) + (oT[vt][2] + oT[vt][3]);
    s += __shfl_xor(s, 16); s += __shfl_xor(s, 32);
    const float mean = s * (1.0f / 128.0f);
    float q = 0.f;
#pragma unroll
    for (int vt = 0; vt < 8; ++vt)
#pragma unroll
        for (int r = 0; r < 4; ++r) { const float d = oT[vt][r] - mean; q += d * d; }
    q += __shfl_xor(q, 16); q += __shfl_xor(q, 32);
    const float rstd = 1.0f / sqrtf(q * (1.0f / 128.0f) + EPS);
#pragma unroll
    for (int vt = 0; vt < 8; ++vt) {
        const float y0 = (oT[vt][0] - mean) * rstd * bf_lo(gw[vt].x), y1 = (oT[vt][1] - mean) * rstd * bf_hi(gw[vt].x);
        const float y2 = (oT[vt][2] - mean) * rstd * bf_lo(gw[vt].y), y3 = (oT[vt][3] - mean) * rstd * bf_hi(gw[vt].y);
        u32x2 w; w.x = pk2(y0, y1); w.y = pk2(y2, y3);
        *(u32x2*)(AR + qrow * 1024 + 512 + hc + 16 * vt + 4 * g) = w;
    }
    __syncthreads();
}

template <int N> __device__ __forceinline__ void bitonic_sort_desc(unsigned (&a)[N]) {
#pragma unroll
    for (int k = 2; k <= N; k <<= 1)
#pragma unroll
        for (int j = k >> 1; j > 0; j >>= 1)
#pragma unroll
            for (int i = 0; i < N; ++i) { const int l = i ^ j;
                if (l > i) { const unsigned x = a[i], y = a[l]; const unsigned mx = x > y ? x : y, mn = x > y ? y : x;
                    if ((i & k) == 0) { a[i] = mx; a[l] = mn; } else { a[i] = mn; a[l] = mx; } } }
}
template <int N> __device__ __forceinline__ void bitonic_merge_desc(unsigned (&a)[N]) {
#pragma unroll
    for (int j = N >> 1; j > 0; j >>= 1)
#pragma unroll
        for (int i = 0; i < N; ++i) { const int l = i ^ j;
            if (l > i) { const unsigned x = a[i], y = a[l]; a[i] = x > y ? x : y; a[l] = x > y ? y : x; } }
}
__device__ __forceinline__ void top16_merge(unsigned (&best)[16], const unsigned (&grp)[16]) {
#pragma unroll
    for (int i = 0; i < 16; ++i) { const unsigned x = best[i], y = grp[15 - i]; best[i] = x > y ? x : y; }
    bitonic_merge_desc<16>(best);
}
struct CandTab { int a[64], b[64], n; constexpr CandTab() : a{}, b{}, n(0) { for (int x = 0; x < 16; ++x) for (int y = 0; y < 16; ++y) if ((x + 1) * (y + 1) <= 16) { a[n] = x; b[n] = y; ++n; } } };
constexpr CandTab kCand{};
static_assert(kCand.n == 50, "staircase candidates");

constexpr int PL_EID = 0, PL_GATE = 16384, PL_IDX = 32768;
__device__ __forceinline__ void peer_unit(int unit, unsigned char* ws, float* outp, const float* gffn, const float* gfin, unsigned char* lds, int tid, int wave, int lane) {
    volatile LAS unsigned* MISC = (volatile LAS unsigned*)((LAS unsigned char*)lds + MISC_OFF); const int bid = unit;
    TSTAMP(70, 0);
    const bf16_t* SC = (const bf16_t*)(ws + WS_SC);
    const float* mod = (const float*)(ws + WS_MOD);
#ifndef DBG_NOPEER
    {
        const int tl = tid >> 4, h = (tid >> 1) & 7, p = tid & 1;
        const size_t row = (size_t)32 * unit + tl;
        const u32x4* sp = (const u32x4*)(SC + row * 2048 + h * 256 + p * 128);
        unsigned best[16];
#pragma unroll
        for (int grp = 0; grp < 8; ++grp) {
            unsigned k[16];
#pragma unroll
            for (int q4 = 0; q4 < 2; ++q4) { const u32x4 v = sp[2 * grp + q4];
#pragma unroll
                for (int e = 0; e < 4; ++e) { const int n0 = 16 * grp + 8 * q4 + 2 * e;
                    k[8 * q4 + 2 * e] = (sortable32(bf_lo(v[e])) & ~127u) | (unsigned)(127 - n0);
                    k[8 * q4 + 2 * e + 1] = (sortable32(bf_hi(v[e])) & ~127u) | (unsigned)(127 - (n0 + 1)); } }
            bitonic_sort_desc<16>(k);
            if (grp == 0) {
#pragma unroll
                for (int i = 0; i < 16; ++i) best[i] = k[i];
            } else top16_merge(best, k);
        }
        unsigned char* il = lds + PL_IDX + (tl * 8 + h) * 32;
#pragma unroll
        for (int i = 0; i < 4; ++i) { unsigned w = 0;
#pragma unroll
            for (int e = 0; e < 4; ++e) w |= (127u - (best[4 * i + e] & 127u)) << (8 * e);
            *(unsigned*)(il + p * 16 + 4 * i) = w; }
        float v1[16], v2[16];
#pragma unroll
        for (int i = 0; i < 16; ++i) { const unsigned o = __shfl_xor(best[i], 1); const float mine = unsortable32(best[i] & ~127u), oth = unsortable32(o & ~127u);
            v1[i] = p ? oth : mine; v2[i] = p ? mine : oth; }
        unsigned top[16];
#pragma unroll
        for (int grp = 0; grp < 4; ++grp) {
            unsigned k[16];
#pragma unroll
            for (int i = 0; i < 16; ++i) { const int c = 16 * grp + i;
                k[i] = (c < kCand.n) ? ((sortable32(v1[kCand.a[c < kCand.n ? c : 0]] + v2[kCand.b[c < kCand.n ? c : 0]]) & ~255u) | (unsigned)(255 - (16 * kCand.a[c < kCand.n ? c : 0] + kCand.b[c < kCand.n ? c : 0]))) : 0u; }
            bitonic_sort_desc<16>(k);
            if (grp == 0) {
#pragma unroll
                for (int i = 0; i < 16; ++i) top[i] = k[i];
            } else top16_merge(top, k);
        }
        float ts[16], es[16], sum = 0.f;
#pragma unroll
        for (int i = 0; i < 16; ++i) ts[i] = unsortable32(top[i] & ~255u);
#pragma unroll
        for (int i = 0; i < 16; ++i) { es[i] = __expf(ts[i] - ts[0]); sum += es[i]; }
        const float rs = 1.0f / sum;
        __builtin_amdgcn_wave_barrier(); asm volatile("s_waitcnt lgkmcnt(0)" ::: "memory");
        unsigned* eo = (unsigned*)(lds + PL_EID) + tl * 128 + h * 16;
        float* go = (float*)(lds + PL_GATE) + tl * 128 + h * 16;
#pragma unroll
        for (int i = 0; i < 16; ++i) {
            const unsigned flat = 255u - (top[i] & 255u);
            const unsigned i1 = il[flat >> 4], i2 = il[16 + (flat & 15u)];
            eo[i] = i1 * 128u + i2; go[i] = es[i] * rs;
        }
    }
#endif
    __syncthreads();
    TSTAMP(70, 2); TSTAMP(71, 0);
    const unsigned char* U8 = ws + WS_U8; const unsigned char* V8 = ws + WS_V8;
    const float* USC = (const float*)(ws + WS_USC); const float* VSC = (const float*)(ws + WS_VSC);
    const int me = ((lane >> 5) & 1) * 4 + ((lane >> 4) & 1) * 2 + ((lane >> 3) & 1);
#pragma unroll 1
    for (int ti = 0; ti < 4; ++ti) {
        const int tl = wave + 8 * ti; const size_t row = (size_t)32 * unit + tl; const int b = (int)(row >> 12);
        const float* mb = mod + b * 6144;
        float x1v[16]; f32x2 hv2[8], acc2[8];
        const float rstd = pg8::row_rstd((const float*)(ws + WS_SUMSQ), (int)row);
#pragma unroll
        for (int q4 = 0; q4 < 4; ++q4) { const int c = 16 * lane + 4 * q4;
            const f32x4 xv = *(const f32x4*)(outp + row * DM + c), g = *(const f32x4*)(gffn + c), sc = *(const f32x4*)(mb + 4096 + c), sh = *(const f32x4*)(mb + 3072 + c);
            float hq[4];
#pragma unroll
            for (int e = 0; e < 4; ++e) { x1v[4 * q4 + e] = xv[e]; hq[e] = xv[e] * rstd * g[e] * (1.0f + sc[e]) + sh[e]; }
            hv2[2 * q4] = (f32x2){hq[0], hq[1]}; hv2[2 * q4 + 1] = (f32x2){hq[2], hq[3]}; acc2[2 * q4] = (f32x2){0.f, 0.f}; acc2[2 * q4 + 1] = (f32x2){0.f, 0.f}; }
        const unsigned* el = (const unsigned*)(lds + PL_EID) + tl * 128; const float* gl = (const float*)(lds + PL_GATE) + tl * 128;
        u32x4 uA[8], vA[8]; float guA, gvA;
#define PEER_LOAD(U_, V_, GU_, GV_, e0_) do { _Pragma("unroll") for (int k = 0; k < 8; ++k) { const unsigned eid = el[(e0_) + k]; \
            U_[k] = *((const u32x4*)(U8 + (size_t)eid * 1024) + lane); V_[k] = *((const u32x4*)(V8 + (size_t)eid * 1024) + lane); } \
        { const unsigned em = el[(e0_) + me]; GU_ = USC[em]; GV_ = VSC[em] * gl[(e0_) + me]; } } while (0)
#define PEER_COMP(U_, V_, GU_, GV_) do { float pd[8]; \
        _Pragma("unroll") for (int k = 0; k < 8; ++k) { f32x2 d2 = (f32x2){0.f, 0.f}; \
            _Pragma("unroll") for (int i = 0; i < 4; ++i) { const f32x2 lo = __builtin_amdgcn_cvt_pk_f32_fp8(U_[k][i], false), hi2 = __builtin_amdgcn_cvt_pk_f32_fp8(U_[k][i], true); \
                d2 = __builtin_elementwise_fma(hv2[2 * i], lo, d2); d2 = __builtin_elementwise_fma(hv2[2 * i + 1], hi2, d2); } \
            pd[k] = d2.x + d2.y; } \
        float q4_[4], r2_[2], s_; \
        _Pragma("unroll") for (int k = 0; k < 4; ++k) { const float keep = (lane & 32) ? pd[k + 4] : pd[k], send = (lane & 32) ? pd[k] : pd[k + 4]; q4_[k] = keep + __shfl_xor(send, 32); } \
        _Pragma("unroll") for (int k = 0; k < 2; ++k) { const float keep = (lane & 16) ? q4_[k + 2] : q4_[k], send = (lane & 16) ? q4_[k] : q4_[k + 2]; r2_[k] = keep + __shfl_xor(send, 16); } \
        { const float keep = (lane & 8) ? r2_[1] : r2_[0], send = (lane & 8) ? r2_[0] : r2_[1]; s_ = keep + __shfl_xor(send, 8); } \
        s_ += __shfl_xor(s_, 4); s_ += __shfl_xor(s_, 2); s_ += __shfl_xor(s_, 1); \
        const float cf_ = GV_ * gelu_exact(s_ * GU_); \
        _Pragma("unroll") for (int k = 0; k < 8; ++k) { const float c = __uint_as_float((unsigned)__builtin_amdgcn_readlane((int)__float_as_uint(cf_), 32 * (k >> 2) + 16 * ((k >> 1) & 1) + 8 * (k & 1))); \
            const f32x2 c2 = (f32x2){c, c}; \
            _Pragma("unroll") for (int i = 0; i < 4; ++i) { const f32x2 lo = __builtin_amdgcn_cvt_pk_f32_fp8(V_[k][i], false), hi2 = __builtin_amdgcn_cvt_pk_f32_fp8(V_[k][i], true); \
                acc2[2 * i] = __builtin_elementwise_fma(c2, lo, acc2[2 * i]); acc2[2 * i + 1] = __builtin_elementwise_fma(c2, hi2, acc2[2 * i + 1]); } } } while (0)
#pragma unroll 1
        for (int e0 = 0; e0 < 128; e0 += 8) {
            PEER_LOAD(uA, vA, guA, gvA, e0);
            PEER_COMP(uA, vA, guA, gvA);
        }
#undef PEER_LOAD
#undef PEER_COMP
        float ss = 0.f;
#pragma unroll
        for (int q4 = 0; q4 < 4; ++q4) { const int c = 16 * lane + 4 * q4; const f32x4 gf = *(const f32x4*)(mb + 5120 + c);
#pragma unroll
            for (int e = 0; e < 4; ++e) { const int i = 4 * q4 + e; const float av = (e < 2) ? acc2[2 * q4][e] : acc2[2 * q4 + 1][e - 2]; x1v[i] = x1v[i] + gf[e] * av; ss += x1v[i] * x1v[i]; } }
        const float r2 = 1.0f / sqrtf(wave_sum(ss) * (1.0f / DM) + EPS);
#pragma unroll
        for (int q4 = 0; q4 < 4; ++q4) { const int c = 16 * lane + 4 * q4; const f32x4 gn = *(const f32x4*)(gfin + c);
            f32x4 o;
#pragma unroll
            for (int e = 0; e < 4; ++e) o[e] = x1v[4 * q4 + e] * r2 * gn[e];
            *(f32x4*)(outp + row * DM + c) = o; }
    }
    __syncthreads();
    TSTAMP(71, 2);
}

#define XB_TMO      128
#define XB_XCNT(j)  (256  + 64 * (j))
#define XB_XSUB(j)  (1280 + 64 * (j))
#define XB_XGEN(j)  (2304 + 64 * (j))
#define XB_TOP      3328
#define XB_TOPGEN   3392
#define XCD_BAR_WORDS 3456
#define XB_SPIN_CAP (1u << 18)

__device__ __forceinline__ unsigned xb_ld(unsigned* p)              { return __hip_atomic_load(p, __ATOMIC_RELAXED, __HIP_MEMORY_SCOPE_AGENT); }
__device__ __forceinline__ unsigned xb_add(unsigned* p, unsigned v) { return __hip_atomic_fetch_add(p, v, __ATOMIC_RELAXED, __HIP_MEMORY_SCOPE_AGENT); }
__device__ __forceinline__ unsigned xb_xcc_id() { return (unsigned)__builtin_amdgcn_s_getreg((3 << 11) | 20) & 0xFu; }
#define XB_SPIN(cond, bar) do { unsigned _sp = 0; while (cond) { __builtin_amdgcn_s_sleep(1); \
    if ((++_sp & 255u) == 0u) { if (xb_ld(&(bar)[XB_TMO])) break; if (_sp > XB_SPIN_CAP) { atomicAdd(&(bar)[XB_TMO], 1u); break; } } } } while (0)

struct XcdBarrier {
    unsigned* bar; unsigned x;
    volatile LAS unsigned* st;
};

__device__ __forceinline__ XcdBarrier xcd_barrier_post(unsigned* bar, volatile LAS unsigned* st) {
    XcdBarrier b; b.bar = bar; b.x = xb_xcc_id(); b.st = st;
    if (threadIdx.x == 0) (void)xb_add(&bar[XB_XCNT(b.x)], 1u);
    return b;
}
__device__ __forceinline__ void xcd_barrier_complete(unsigned* bar, unsigned x, unsigned& nloc, unsigned& nx) {
    const unsigned G = gridDim.x * gridDim.y * gridDim.z;
    unsigned sum, cnt, mine, sp = 0u;
    for (;;) {
        sum = 0u; cnt = 0u; mine = 0u;
#pragma unroll
        for (unsigned j = 0; j < 16; ++j) { const unsigned c = xb_ld(&bar[XB_XCNT(j)]); sum += c; cnt += (c > 0u) ? 1u : 0u; mine = (j == x) ? c : mine; }
        if (sum == G) break;
        __builtin_amdgcn_s_sleep(1);
        if ((++sp & 255u) == 0u) { if (xb_ld(&bar[XB_TMO])) break; if (sp > XB_SPIN_CAP) { atomicAdd(&bar[XB_TMO], 1u); break; } }
    }
    nloc = mine > 0u ? mine : 1u; nx = cnt > 0u ? cnt : 1u;
}

__device__ __forceinline__ void xcd_barrier(const XcdBarrier& b) {
    asm volatile("s_waitcnt vmcnt(0)" ::: "memory");
    __syncthreads();
    if (threadIdx.x == 0) {
        unsigned* bar = b.bar;
        __builtin_amdgcn_s_waitcnt(0);
        unsigned nloc = b.st[0], nx = b.st[1];
        if (nloc == 0u) { xcd_barrier_complete(bar, b.x, nloc, nx); b.st[0] = nloc; b.st[1] = nx; }
        const unsigned old = xb_add(&bar[XB_XSUB(b.x)], 1u);
        const unsigned gen = old / nloc;
        if (old + 1u == (gen + 1u) * nloc) {
            __builtin_amdgcn_fence(__ATOMIC_RELEASE, "agent");
            asm volatile("s_waitcnt vmcnt(0)" ::: "memory");
            const unsigned og = xb_add(&bar[XB_TOP], 1u);
            const unsigned tg = og / nx;
            if (og + 1u == (tg + 1u) * nx) xb_add(&bar[XB_TOPGEN], 1u);
            else XB_SPIN(xb_ld(&bar[XB_TOPGEN]) == tg, bar);
            __builtin_amdgcn_fence(__ATOMIC_ACQUIRE, "agent");
            xb_add(&bar[XB_XGEN(b.x)], 1u);
            asm volatile("s_waitcnt vmcnt(0)" ::: "memory");
        } else {
            XB_SPIN(xb_ld(&bar[XB_XGEN(b.x)]) == gen, bar);
            __builtin_amdgcn_fence(__ATOMIC_ACQUIRE, "agent");
            asm volatile("s_waitcnt vmcnt(0)" ::: "memory");
        }
    }
    __syncthreads();
}

constexpr int N_PHASES = 8;
__global__ void __launch_bounds__(NTHREADS, 2) mega(Args a) {
    extern __shared__ __attribute__((aligned(16))) unsigned char lds[];
    const int tid = threadIdx.x, lane = tid & 63, wave = __builtin_amdgcn_readfirstlane(tid >> 6);
    const int bid = blockIdx.x, G = gridDim.x;
    unsigned char* ws = a.ws;
    const int lo = a.ph_lo, hi = a.ph_hi;
    volatile LAS unsigned* MISC = (volatile LAS unsigned*)((LAS unsigned char*)lds + MISC_OFF);
    if (tid < 16) MISC[tid] = 0u;
    __syncthreads();
    XcdBarrier bar; bar.bar = (unsigned*)(ws + WS_CTL) + CW_BAR; bar.x = 0; bar.st = nullptr;
    if (hi - lo > 1) bar = xcd_barrier_post((unsigned*)(ws + WS_CTL) + CW_BAR, MISC + 8);
#ifndef PH_MASK
#define PH_MASK 0xFF
#endif
#define IN(k) (((PH_MASK >> (k)) & 1) && lo <= (k) && (k) < hi)
#define SEAM(k) do { if (IN(k) && IN((k) + 1)) { xcd_barrier(bar); } } while (0)
#ifdef REP_PH
#ifndef REP_N
#define REP_N 1
#endif
#define REPS(k) for (int rep_ = 0; rep_ < ((k) == REP_PH ? 1 + REP_N : 1); ++rep_, ((k) == REP_PH && rep_ <= REP_N ? (xcd_barrier(bar), 0) : 0))
#else
#define REPS(k)
#endif

    TSTAMP(100, 0);
    TSTAMP(0, 0);
    REPS(0) if (IN(0)) phase0(a, lds, tid, wave, lane, bid, G);
    SEAM(0);
    TSTAMP(0, 2);
    TSTAMP(1, 0);
    REPS(1) if (IN(1)) phase1(a, wave, lane, bid, G);
    SEAM(1);
    TSTAMP(1, 2);
    TSTAMP(2, 0);
    REPS(2) if (IN(2)) {
        pg8::Gemm g{(const bf16_t*)(ws + WS_BUFA), (const bf16_t*)(ws + WS_WIN), MTOK, N1, DM}; pg8::StaticOrder S; S.init(MTOK, N1, G, bid);
        pg8::Epi1 E{ws};
        pg8::gemm_phase<pg8::Epi1, pg8::StaticOrder, true, true>((LAS unsigned char*)lds, g, S, E);
        const int nfull = (MTOK / 256) * (N1 / 256) - 4 * G;
        { const bool tail = nfull > 0 && nfull < G; const int cw = tail ? (bid - nfull) * 8 + wave : bid * 8 + wave, NCW = tail ? (G - nfull) * 8 : G * 8;
          if (!tail || bid >= nfull)
              for (int it = cw; it < 4096; it += NCW) { const int r = 4 * it;
                  rows_to_fp8<4>(a.in[11] + (size_t)r * 1024, ws + WS_V8 + (size_t)r * 1024, (float*)(ws + WS_VSC) + r, lane); } }
    }
    SEAM(2);
    TSTAMP(2, 2);
    TSTAMP(3, 0);
    REPS(3) if (IN(3)) {
        TSTAMP(30, 0);
        for (int u = bid; u < 256; u += G)
            ret_state_unit(u >> 6, (u >> 4) & 3, (u >> 1) & 7, u & 1, (const bf16_t*)(ws + WS_KR), (const bf16_t*)(ws + WS_VR), (bf16_t*)(ws + WS_STATE), lds, tid, wave, lane);
        TSTAMP(30, 2); TSTAMP(31, 0);
        for (int k = bid; k < 256; k += G)
#pragma unroll 1
            for (int i = 0; i < 4; ++i) {
                const int b = i, qt = (i < 2) ? k : 255 - k;
                idx_unit(b, qt, (const bf16_t*)(ws + WS_QI), (const bf16_t*)(ws + WS_KI), (const float*)(ws + WS_WI), (unsigned long long*)(ws + WS_MASK), lds, wave, lane, bid == TPROBE_B && i == TPROBE_I);
            }
        TSTAMP(31, 2);
    }
    SEAM(3);
    TSTAMP(3, 2);
    TSTAMP(4, 0);
    REPS(4) if (IN(4)) {
        TSTAMP(40, 0);
        const int vcu = (G % 8 == 0) ? (bid % 8) * (G / 8) + bid / 8 : bid;
        for (int k = vcu; k < 256; k += G) {
            const int bh = k >> 3, s = k & 7;
#pragma unroll 1
            for (int i = 0; i < 2; ++i)
                attn_unit(bh >> 3, bh & 7, i ? 15 - s : s, (const bf16_t*)(ws + WS_QA), (const bf16_t*)(ws + WS_KA), (const bf16_t*)(ws + WS_VA), (const unsigned long long*)(ws + WS_MASK),
                          (bf16_t*)(ws + WS_BUFB), lds, tid, wave, lane);
        }
        TSTAMP(40, 2); TSTAMP(41, 0);
        for (int u = bid; u < 512; u += G)
            ret_out_unit(u >> 7, (u >> 5) & 3, u & 31, (const bf16_t*)(ws + WS_QR), (const bf16_t*)(ws + WS_KR), (const bf16_t*)(ws + WS_VR), (const bf16_t*)(ws + WS_GR),
                         (const bf16_t*)(ws + WS_STATE), (bf16_t*)(ws + WS_BUFB), lds, tid, wave, lane);
        TSTAMP(41, 2);
    }
    SEAM(4);
    TSTAMP(4, 2);
    TSTAMP(5, 0);
    REPS(5) if (IN(5)) {
        pg8::Gemm g{(const bf16_t*)(ws + WS_BUFB), (const bf16_t*)(ws + WS_WOUT), MTOK, DM, DM}; pg8::StaticOrder S; S.init(MTOK, DM, G, bid);
        pg8::Epi2 E{a.in[0], a.out, (bf16_t*)(ws + WS_BUFA), (const float*)(ws + WS_MOD), a.in[7], (float*)(ws + WS_SUMSQ)};
        pg8::gemm_phase<pg8::Epi2, pg8::StaticOrder, true, true>((LAS unsigned char*)lds, g, S, E);
    }
    SEAM(5);
    TSTAMP(5, 2);
    TSTAMP(6, 0);
    REPS(6) if (IN(6)) {
        pg8::Gemm g{(const bf16_t*)(ws + WS_BUFA), (const bf16_t*)(ws + WS_WPQ), MTOK, 2048, DM}; pg8::StaticOrder S; S.init(MTOK, 2048, G, bid);
        pg8::Epi3 E{(const float*)(ws + WS_SUMSQ), (const float*)(ws + WS_BIASF), (bf16_t*)(ws + WS_SC)};
        pg8::gemm_phase<pg8::Epi3, pg8::StaticOrder, true, true>((LAS unsigned char*)lds, g, S, E);
    }
    SEAM(6);
    TSTAMP(6, 2);
    TSTAMP(7, 0);
    if (IN(7)) {
        for (int u = bid; u < 512; u += G) peer_unit(u, ws, a.out, a.in[7], a.in[12], lds, tid, wave, lane);
    }
    TSTAMP(7, 2);
    TSTAMP(100, 2);
#ifdef TIME_PH
    if (bid == TPROBE_B && tid == 0) {
        const unsigned long long t0_ = ((unsigned long long)MISC[1] << 32) | MISC[0], t1_ = ((unsigned long long)MISC[3] << 32) | MISC[2];
        const unsigned long long until_ = __builtin_amdgcn_s_memrealtime() + (unsigned long long)TIME_AMP * (t1_ - t0_);
        while (__builtin_amdgcn_s_memrealtime() < until_) __builtin_amdgcn_s_sleep(8);
    }
#endif
#undef IN
#undef SEAM
}

extern "C" void kernel_launch(void* const* d_in, const int* in_sizes, int n_in, void* d_out, int out_size, void* d_ws, size_t ws_size, hipStream_t stream) {
    static int grid = 0;
    if (grid == 0) {
        if (n_in != 13 || out_size != MTOK * DM || ws_size < WS_END) { fprintf(stderr, "kernel_launch: unexpected shapes (n_in %d, out %d, ws %zu); nothing launched\n", n_in, out_size, ws_size); grid = -1; return; }
        int dev = 0, cus = 0, per_cu = 0;
        if (hipGetDevice(&dev) != hipSuccess || hipDeviceGetAttribute(&cus, hipDeviceAttributeMultiprocessorCount, dev) != hipSuccess) { grid = -1; return; }
        if (hipFuncSetAttribute((const void*)mega, hipFuncAttributeMaxDynamicSharedMemorySize, LDS_BYTES) != hipSuccess) { fprintf(stderr, "kernel_launch: hipFuncSetAttribute failed\n"); grid = -1; return; }
        if (hipOccupancyMaxActiveBlocksPerMultiprocessor(&per_cu, (const void*)mega, NTHREADS, LDS_BYTES) != hipSuccess || per_cu < 1) { fprintf(stderr, "kernel_launch: occupancy query gave %d\n", per_cu); per_cu = 1; }
        (void)hipGetLastError();
        grid = cus;
    }
    if (grid < 0) return;
    if (hipMemsetAsync((char*)d_ws + WS_CTL + (size_t)CW_BAR * 4, 0, (size_t)XCD_BAR_WORDS * 4, stream) != hipSuccess) { fprintf(stderr, "kernel_launch: memset failed\n"); return; }
    Args a{};
    for (int i = 0; i < 13; ++i) a.in[i] = (const float*)d_in[i];
    a.out = (float*)d_out; a.ws = (unsigned char*)d_ws;
#if MK_MULTI
    for (int p = 0; p < N_PHASES; ++p) { a.ph_lo = p; a.ph_hi = p + 1; hipLaunchKernelGGL(mega, dim3(grid), dim3(NTHREADS), LDS_BYTES, stream, a); }
#else
    a.ph_lo = 0; a.ph_hi = N_PHASES;
    hipLaunchKernelGGL(mega, dim3(grid), dim3(NTHREADS), LDS_BYTES, stream, a);
#endif
}
```

```cpp
#include <hip/hip_runtime.h>
#include <cstdio>
#include <cstdint>

#ifndef MK_MULTI
#define MK_MULTI 0
#endif

#define GAS __attribute__((address_space(1)))
#define LAS __attribute__((address_space(3)))
typedef unsigned short bf16_t;
typedef short bf16x8 __attribute__((ext_vector_type(8)));
typedef float f32x4 __attribute__((ext_vector_type(4)));
typedef float f32x16 __attribute__((ext_vector_type(16)));
typedef unsigned u32x4 __attribute__((ext_vector_type(4)));
typedef unsigned u32x2 __attribute__((ext_vector_type(2)));

constexpr int BATCH = 4, SEQ = 4096, DM = 1024, MTOK = BATCH * SEQ;
constexpr int N1 = 4352;
constexpr int NTHREADS = 512;
constexpr float EPS = 1e-6f;
constexpr float C_QK = 0.18033688011112042f;
constexpr float NEG_INF = -__builtin_huge_valf();

__device__ __forceinline__ float ret_log2g(int h) { return h == 0 ? -0.045803689613124791f : h == 1 ? -0.022720076500083530f : h == 2 ? -0.011315313227834147f : -0.0056465631411420624f; }
__device__ __forceinline__ float ret_gamma(int h) { return h == 0 ? 0.96875f : h == 1 ? 0.984375f : h == 2 ? 0.9921875f : 0.99609375f; }
__device__ __forceinline__ float ret_g128(int h) { return h == 0 ? 0.017183023570817902f : h == 1 ? 0.13321516287964842f : h == 2 ? 0.36643771592203725f : 0.60593708822908032f; }
__device__ __forceinline__ float ret_g127(int h) { return h == 0 ? 0.017737314653747512f : h == 1 ? 0.13532968927456347f : h == 2 ? 0.36932305226788007f : 0.60831331210448848f; }

constexpr size_t MiB = 1u << 20;
constexpr size_t WS_CTL = 0, CTL_BYTES = 1 * MiB;
constexpr size_t WS_SUMSQ = 5 * MiB;
constexpr size_t WS_MOD = 1 * MiB;
constexpr size_t WS_BIASF = 1 * MiB + 128 * 1024;
constexpr size_t WS_COSA = 2 * MiB, WS_SINA = 2 * MiB + 512 * 1024;
constexpr size_t WS_COSR = 3 * MiB, WS_SINR = 4 * MiB;
constexpr size_t WS_WIN = 6 * MiB;
constexpr size_t WS_WOUT = 15 * MiB;
constexpr size_t WS_WPQ = 17 * MiB;
constexpr size_t WS_BUFA = 22 * MiB;
constexpr size_t WS_MASK = WS_BUFA, WS_STATE = WS_BUFA + 8 * MiB;
constexpr size_t WS_BUFB = 54 * MiB;
constexpr size_t WS_G1 = 86 * MiB;
constexpr size_t WS_QA = WS_G1, WS_KA = WS_G1 + 16 * MiB, WS_VA = WS_G1 + 32 * MiB, WS_QI = WS_G1 + 48 * MiB, WS_QR = WS_G1 + 64 * MiB,
                 WS_KR = WS_G1 + 80 * MiB, WS_VR = WS_G1 + 96 * MiB, WS_GR = WS_G1 + 112 * MiB, WS_KI = WS_G1 + 128 * MiB, WS_WI = WS_G1 + 130 * MiB;
constexpr size_t WS_SC = WS_G1;
constexpr size_t WS_U8 = 217 * MiB, WS_V8 = 233 * MiB;
constexpr size_t WS_USC = 249 * MiB, WS_VSC = 249 * MiB + 65536;
constexpr size_t WS_END = 256 * MiB;
static_assert(WS_WI + (size_t)MTOK * 8 * 4 <= WS_U8 && WS_SC + (size_t)MTOK * 2048 * 4 <= WS_U8 && WS_VSC + 65536 <= WS_END, "ws map");
constexpr int LDS_BYTES = 147456;
constexpr int MISC_OFF = LDS_BYTES - 64;
constexpr int CW_BAR = 4096;

__device__ __forceinline__ unsigned f2bf(float f) { unsigned u = __float_as_uint(f); return (u + 0x7fffu + ((u >> 16) & 1u)) >> 16; }
typedef float f32x2_t __attribute__((ext_vector_type(2))); typedef __bf16 bf16x2_t __attribute__((ext_vector_type(2)));
__device__ __forceinline__ unsigned pk2(float lo, float hi) { const f32x2_t v = {lo, hi}; const bf16x2_t b = __builtin_convertvector(v, bf16x2_t); return __builtin_bit_cast(unsigned, b); }
__device__ __forceinline__ float bf_lo(unsigned w) { return __uint_as_float(w << 16); }
__device__ __forceinline__ float bf_hi(unsigned w) { return __uint_as_float(w & 0xffff0000u); }
__device__ __forceinline__ float wave_sum(float v) {
#pragma unroll
    for (int o = 1; o < 64; o <<= 1) v += __shfl_xor(v, o);
    return v;
}
__device__ __forceinline__ float fast_exp2(float x) { return __builtin_amdgcn_exp2f(x); }
__device__ __forceinline__ float gelu_exact(float v) {
    const float av = fabsf(v), t = __builtin_amdgcn_rcpf(av * 0.2316418882f + 1.0f);
    float q = t * 0.5307027145f + (-0.7265760135f); q = q * t + 0.7107068705f; q = q * t + (-0.142248368f); q = q * t + 0.127414796f; q = q * t;
    const float e = fast_exp2(v * v * (-0.72134752044f));
    const float m = v * (q * e);
    return v < 0.f ? m : v - m;
}
__device__ __forceinline__ float silu_f(float v) { return v / (1.0f + __expf(-v)); }
__device__ __forceinline__ unsigned sortable32(float f) { const unsigned u = __float_as_uint(f); return (u & 0x80000000u) ? ~u : (u | 0x80000000u); }
__device__ __forceinline__ float unsortable32(unsigned s) { return __uint_as_float((s & 0x80000000u) ? (s ^ 0x80000000u) : ~s); }
__device__ __forceinline__ unsigned sortable16(float x) {
    const _Float16 h = (_Float16)x; const unsigned b = (unsigned)__builtin_bit_cast(unsigned short, h);
    return (b & 0x8000u) ? (~b & 0xFFFFu) : (b | 0x8000u);
}
__device__ __forceinline__ f32x4 mfma16(bf16x8 a, bf16x8 b, f32x4 c) { return __builtin_amdgcn_mfma_f32_16x16x32_bf16(a, b, c, 0, 0, 0); }
__device__ __forceinline__ f32x16 mfma32(bf16x8 a, bf16x8 b, f32x16 c) { return __builtin_amdgcn_mfma_f32_32x32x16_bf16(a, b, c, 0, 0, 0); }

__host__ __device__ __forceinline__ int win_src_col(int p) {
    const int tile = p >> 8, bj = (p >> 7) & 1, q = p & 127;
    if (tile < 4) return 256 * tile + (q >> 5) * 64 + bj * 32 + (q & 31);
    if (tile < 6) return p;
    if (tile < 8) return 256 * tile + (q >> 5) * 64 + bj * 32 + (q & 31);
    if (tile == 8) { if (q < 32) return 2048 + bj * 32 + q; if (bj == 0 && q < 40) return 2112 + (q - 32); return -1; }
    if (tile < 13) { const int base = (tile < 11) ? 2120 + 256 * (tile - 9) : 2632 + 256 * (tile - 11); return base + (q >> 6) * 128 + bj * 64 + (q & 63); }
    if (tile < 15) return 3144 + (p - 13 * 256);
    return 3656 + (p - 15 * 256);
}
namespace pg8 {
#define PG8_LAS __attribute__((address_space(3)))
typedef unsigned short bf16_t;
typedef short bf16x8 __attribute__((ext_vector_type(8)));
typedef float f32x4 __attribute__((ext_vector_type(4)));
typedef unsigned u32x4 __attribute__((ext_vector_type(4)));
constexpr int BM = 256, BK = 64, HALF = 128, HTB = HALF * BK * 2  , STAGE_BYTES = 8 * HTB, NXCD = 8, WGM = 8;

__host__ __device__ __forceinline__ int lds_byte(int r, int c) { const int st = (r >> 4) * 2 + (c >> 5), rr = r & 15, cc = c & 31, ob = rr * 64 + cc * 2; return st * 1024 + (ob ^ (((ob >> 9) & 1) << 5)); }
__host__ __device__ __forceinline__ void stage_rc(int b, int& R, int& C) { const int st = b / 1024, sb = b % 1024, swz = sb ^ (((sb >> 9) & 1) << 5); R = (st >> 1) * 16 + swz / 64; C = (st & 1) * 32 + (swz % 64) / 2; }
__host__ __device__ __forceinline__ int perm32(int rho) { const int n = rho >> 4, i = rho & 15; return 8 * (i >> 2) + 4 * n + (i & 3); }

struct Unit { int pm, pn; };
struct Gemm { const bf16_t* A; const bf16_t* Bt; int M, N, K; };

struct StaticOrder {
    int nM, nN, nwg, G, c;
    __host__ __device__ void init(int M, int N, int G_, int c_) { nM = M / BM; nN = N / BM; nwg = nM * nN; G = G_; c = c_; }
    __host__ __device__ bool next(int i, Unit& u) const {
        const long L = (long)i * G + c; if (L >= nwg) return false;
        int wgid = (int)L; { const int q = nwg / NXCD, r = nwg % NXCD, xcd = wgid % NXCD, off = wgid / NXCD; wgid = (xcd < r ? xcd * (q + 1) : r * (q + 1) + (xcd - r) * q) + off; }
        const int nig = WGM * nN, gid = wgid / nig, fm = gid * WGM, gsz = (nM - fm) < WGM ? (nM - fm) : WGM;
        u.pm = fm + ((wgid % nig) % gsz); u.pn = (wgid % nig) / gsz; return true;
    }
    __device__ __forceinline__ void a_ready(const Unit&) const {}
    __device__ __forceinline__ void done(const Unit&) const {}
};

__device__ __forceinline__ unsigned cvt_pk_bf16(float lo, float hi) { unsigned r; asm volatile("v_cvt_pk_bf16_f32 %0, %1, %2" : "=v"(r) : "v"(lo), "v"(hi)); return r; }
__device__ __forceinline__ u32x4 pack8(const float (&v)[8]) { u32x4 w; w.x = cvt_pk_bf16(v[0], v[1]); w.y = cvt_pk_bf16(v[2], v[3]); w.z = cvt_pk_bf16(v[4], v[5]); w.w = cvt_pk_bf16(v[6], v[7]); return w; }

struct Epi1 {
    static constexpr bool PERM = true, AFTER_DRAIN = false;
    unsigned char* ws;
    __device__ __forceinline__ void operator()(const f32x4 (&acc)[2][2][4][2], const Unit& u, int wr, int wc, int fr, int fq) const {
        const int tile = u.pn;
        const int row0 = u.pm * BM + wr * 64 + fr;
        const float* cosA = (const float*)(ws + WS_COSA); const float* sinA = (const float*)(ws + WS_SINA);
        const float* cosR = (const float*)(ws + WS_COSR); const float* sinR = (const float*)(ws + WS_SINR);
        if (tile < 4 || tile == 6 || tile == 7) {
            bf16_t* dst = (bf16_t*)(ws + (tile < 2 ? WS_QA : tile < 4 ? WS_KA : WS_QI));
            const int tl = tile < 2 ? tile : tile < 4 ? tile - 2 : tile - 6;
            const float scale = tile < 2 ? C_QK : 1.0f;
            const int cb = 256 * tl + 64 * wc, i0 = 8 * fq;
#pragma unroll
            for (int ai = 0; ai < 2; ++ai)
#pragma unroll
                for (int m = 0; m < 4; ++m) {
                    const int row = row0 + ai * HALF + m * 16, pos = row & (SEQ - 1);
                    const f32x4 c0 = *(const f32x4*)(cosA + pos * 32 + i0), c1 = *(const f32x4*)(cosA + pos * 32 + i0 + 4);
                    const f32x4 s0 = *(const f32x4*)(sinA + pos * 32 + i0), s1 = *(const f32x4*)(sinA + pos * 32 + i0 + 4);
                    float y1[8], y2[8];
#pragma unroll
                    for (int n = 0; n < 2; ++n)
#pragma unroll
                        for (int e = 0; e < 4; ++e) {
                            const float x1 = acc[ai][0][m][n][e], x2 = acc[ai][1][m][n][e];
                            const float c = n ? c1[e] : c0[e], s = n ? s1[e] : s0[e];
                            y1[4 * n + e] = (x1 * c - x2 * s) * scale; y2[4 * n + e] = (x1 * s + x2 * c) * scale;
                        }
                    bf16_t* rp = dst + (size_t)row * 512 + cb + i0;
                    *(u32x4*)rp = pack8(y1); *(u32x4*)(rp + 32) = pack8(y2);
                }
        } else if (tile == 4 || tile == 5 || tile >= 13) {
            bf16_t* dst = (bf16_t*)(ws + (tile < 6 ? WS_VA : tile < 15 ? WS_VR : WS_GR));
            const int tl = tile < 6 ? tile - 4 : tile < 15 ? tile - 13 : tile - 15;
            const bool act = tile >= 15;
#pragma unroll
            for (int ai = 0; ai < 2; ++ai)
#pragma unroll
                for (int m = 0; m < 4; ++m) {
                    const int row = row0 + ai * HALF + m * 16;
#pragma unroll
                    for (int bj = 0; bj < 2; ++bj) {
                        float y[8];
#pragma unroll
                        for (int n = 0; n < 2; ++n)
#pragma unroll
                            for (int e = 0; e < 4; ++e) { const float v = acc[ai][bj][m][n][e]; y[4 * n + e] = act ? silu_f(v) : v; }
                        *(u32x4*)(dst + (size_t)row * 512 + 256 * tl + 128 * bj + 32 * wc + 8 * fq) = pack8(y);
                    }
                }
        } else if (tile == 8) {
#pragma unroll
            for (int ai = 0; ai < 2; ++ai)
#pragma unroll
                for (int m = 0; m < 4; ++m) {
                    const int row = row0 + ai * HALF + m * 16, pos = row & (SEQ - 1);
                    if (wc == 0) {
                        const int i0 = 8 * fq;
                        const f32x4 c0 = *(const f32x4*)(cosA + pos * 32 + i0), c1 = *(const f32x4*)(cosA + pos * 32 + i0 + 4);
                        const f32x4 s0 = *(const f32x4*)(sinA + pos * 32 + i0), s1 = *(const f32x4*)(sinA + pos * 32 + i0 + 4);
                        float y1[8], y2[8];
#pragma unroll
                        for (int n = 0; n < 2; ++n)
#pragma unroll
                            for (int e = 0; e < 4; ++e) {
                                const float x1 = acc[ai][0][m][n][e], x2 = acc[ai][1][m][n][e];
                                const float c = n ? c1[e] : c0[e], s = n ? s1[e] : s0[e];
                                y1[4 * n + e] = x1 * c - x2 * s; y2[4 * n + e] = x1 * s + x2 * c;
                            }
                        bf16_t* rp = (bf16_t*)(ws + WS_KI) + (size_t)row * 64 + i0;
                        *(u32x4*)rp = pack8(y1); *(u32x4*)(rp + 32) = pack8(y2);
                    } else if (wc == 1 && fq == 0) {
                        const float sw = 0.35355339059327379f;
                        float* WI = (float*)(ws + WS_WI);
                        *(f32x4*)(WI + (size_t)row * 8) = acc[ai][0][m][0] * sw;
                        *(f32x4*)(WI + (size_t)row * 8 + 4) = acc[ai][0][m][1] * sw;
                    }
                }
        } else {
            const bool isk = tile >= 11;
            bf16_t* dst = (bf16_t*)(ws + (isk ? WS_KR : WS_QR));
            const int tl = isk ? tile - 11 : tile - 9, hl = wc >> 1, h = 2 * tl + hl;
            const int i0 = 32 * (wc & 1) + 8 * fq, cb = 256 * tl + 128 * hl;
            const float lg = isk ? -ret_log2g(h) : ret_log2g(h);
            const float base = isk ? 0.08838834764831845f : 1.0f;
#pragma unroll
            for (int ai = 0; ai < 2; ++ai)
#pragma unroll
                for (int m = 0; m < 4; ++m) {
                    const int row = row0 + ai * HALF + m * 16, pos = row & (SEQ - 1);
                    const float dec = base * fast_exp2(lg * (float)(pos & 127));
                    const f32x4 c0 = *(const f32x4*)(cosR + pos * 64 + i0), c1 = *(const f32x4*)(cosR + pos * 64 + i0 + 4);
                    const f32x4 s0 = *(const f32x4*)(sinR + pos * 64 + i0), s1 = *(const f32x4*)(sinR + pos * 64 + i0 + 4);
                    float y1[8], y2[8];
#pragma unroll
                    for (int n = 0; n < 2; ++n)
#pragma unroll
                        for (int e = 0; e < 4; ++e) {
                            const float x1 = acc[ai][0][m][n][e], x2 = acc[ai][1][m][n][e];
                            const float c = n ? c1[e] : c0[e], s = n ? s1[e] : s0[e];
                            y1[4 * n + e] = (x1 * c - x2 * s) * dec; y2[4 * n + e] = (x1 * s + x2 * c) * dec;
                        }
                    bf16_t* rp = dst + (size_t)row * 512 + cb + i0;
                    *(u32x4*)rp = pack8(y1); *(u32x4*)(rp + 64) = pack8(y2);
                }
        }
    }
};

__device__ __forceinline__ float row_rstd(const float* sumsq, int row) {
    const f32x4* p = (const f32x4*)(sumsq + (size_t)row * 16);
    const f32x4 a = p[0], b = p[1], c = p[2], d = p[3];
    const float s = (((a[0] + a[1]) + (a[2] + a[3])) + ((b[0] + b[1]) + (b[2] + b[3]))) + (((c[0] + c[1]) + (c[2] + c[3])) + ((d[0] + d[1]) + (d[2] + d[3])));
    return 1.0f / sqrtf(s * (1.0f / DM) + EPS);
}
struct Epi2 {
    static constexpr bool PERM = false, AFTER_DRAIN = false;
    const float* x; float* x1; bf16_t* a3; const float* mod; const float* gffn; float* sumsq;
    __device__ __forceinline__ void operator()(const f32x4 (&acc)[2][2][4][2], const Unit& u, int wr, int wc, int fr, int fq) const {
        const int row0 = u.pm * BM + wr * 64 + fr, col0 = u.pn * BM + wc * 32 + 4 * fq;
#pragma unroll
        for (int ai = 0; ai < 2; ++ai)
#pragma unroll
            for (int m = 0; m < 4; ++m) {
                const int row = row0 + ai * HALF + m * 16, b = row >> 12;
                const float* mb = mod + b * 6144;
                float ss = 0.f;
#pragma unroll
                for (int bj = 0; bj < 2; ++bj)
#pragma unroll
                    for (int n = 0; n < 2; ++n) {
                        const int c = col0 + bj * HALF + n * 16;
                        const f32x4 xv = *(const f32x4*)(x + (size_t)row * DM + c), gt = *(const f32x4*)(mb + 2048 + c);
#ifdef DBG_NOMIX
                        const f32x4 v = xv;
#else
                        const f32x4 v = xv + gt * acc[ai][bj][m][n];
#endif
                        *(f32x4*)(x1 + (size_t)row * DM + c) = v;
                        ss += (v[0] * v[0] + v[1] * v[1]) + (v[2] * v[2] + v[3] * v[3]);
                        const f32x4 gs = *(const f32x4*)(gffn + c) * (*(const f32x4*)(mb + 4096 + c) + 1.0f);
                        const f32x4 a = v * gs;
                        u32x2 w; w.x = cvt_pk_bf16(a[0], a[1]); w.y = cvt_pk_bf16(a[2], a[3]);
                        *(u32x2*)(a3 + (size_t)row * DM + c) = w;
                    }
                ss += __shfl_xor(ss, 16); ss += __shfl_xor(ss, 32);
                if (fq == 0) sumsq[(size_t)row * 16 + u.pn * 4 + wc] = ss;
            }
    }
};

struct Epi3 {
    static constexpr bool PERM = true, AFTER_DRAIN = false;
    const float* sumsq; const float* biasf; bf16_t* sc;
    __device__ __forceinline__ void operator()(const f32x4 (&acc)[2][2][4][2], const Unit& u, int wr, int wc, int fr, int fq) const {
        const int row0 = u.pm * BM + wr * 64 + fr, col0 = u.pn * BM + wc * 32 + 8 * fq;
#pragma unroll
        for (int ai = 0; ai < 2; ++ai)
#pragma unroll
            for (int m = 0; m < 4; ++m) {
                const int row = row0 + ai * HALF + m * 16, b = row >> 12;
                const float rstd = row_rstd(sumsq, row);
#pragma unroll
                for (int bj = 0; bj < 2; ++bj) {
                    const int c = col0 + bj * HALF;
                    const f32x4 b0 = *(const f32x4*)(biasf + b * 2048 + c), b1 = *(const f32x4*)(biasf + b * 2048 + c + 4);
                    const f32x4 v0 = acc[ai][bj][m][0] * rstd + b0, v1 = acc[ai][bj][m][1] * rstd + b1;
                    u32x4 w; w.x = cvt_pk_bf16(v0[0], v0[1]); w.y = cvt_pk_bf16(v0[2], v0[3]); w.z = cvt_pk_bf16(v1[0], v1[1]); w.w = cvt_pk_bf16(v1[2], v1[3]);
                    *(u32x4*)(sc + (size_t)row * 2048 + c) = w;
                }
            }
    }
};

template <class Epi, class Sched, bool ALIGN_EPI = false, bool SP2 = false>
__device__ __forceinline__ void gemm_phase(PG8_LAS unsigned char* lds, const Gemm g, const Sched& S, const Epi& E) {
    const int tid = threadIdx.x, wid = __builtin_amdgcn_readfirstlane(tid >> 6), lane = tid & 63, wr = wid >> 2, wc = wid & 3, fr = lane & 15, fq = lane >> 4;
    const int K = g.K, nt = K / BK;
    unsigned voffA[2], voffB[2];
#pragma unroll
    for (int i = 0; i < 2; ++i) { int R, C; stage_rc(tid * 16 + i * 8192, R, C); const int Rb = Epi::PERM ? ((R & ~31) + perm32(R & 31)) : R;
        voffA[i] = (unsigned)(R * K + C) * 2u; voffB[i] = (unsigned)(Rb * K + C) * 2u; }
    const size_t kstep = (size_t)(BK * 2);
    const size_t hstep = (size_t)HALF * K * 2;
    const size_t tstep = 2 * hstep;
    const unsigned ldsw = (unsigned)wid * 1024u;
    const int aoff = lds_byte(wr * 64 + fr, fq * 8), boff = lds_byte(wc * 32 + fr, fq * 8);
#define PG8_SA(b, h) (((b) * 2 + (h)) * HTB)
#define PG8_SB(b, h) ((4 + (b) * 2 + (h)) * HTB)
#define PG8_STAGE(bufoff, gbase, voff) do { _Pragma("unroll") for (int _i = 0; _i < 2; ++_i) \
        __builtin_amdgcn_global_load_lds((const unsigned*)((const char*)(gbase) + (voff)[_i]), (PG8_LAS unsigned*)(lds + (bufoff) + ldsw + _i * 8192), 16, 0, 0); } while (0)
#define PG8_LDA(dst, b, h) do { _Pragma("unroll") for (int m = 0; m < 4; ++m) _Pragma("unroll") for (int k = 0; k < 2; ++k) dst[m][k] = *(const PG8_LAS bf16x8*)(lds + PG8_SA(b, h) + aoff + m * 2048 + k * 1024); } while (0)
#define PG8_LDB(dst, b, h) do { _Pragma("unroll") for (int n = 0; n < 2; ++n) _Pragma("unroll") for (int k = 0; k < 2; ++k) dst[n][k] = *(const PG8_LAS bf16x8*)(lds + PG8_SB(b, h) + boff + n * 2048 + k * 1024); } while (0)
#define PG8_MMA(ai, bj, At, Bt) do { __builtin_amdgcn_s_setprio(1); _Pragma("unroll") for (int m = 0; m < 4; ++m) _Pragma("unroll") for (int n = 0; n < 2; ++n) _Pragma("unroll") for (int k = 0; k < 2; ++k) \
        acc[ai][bj][m][n] = __builtin_amdgcn_mfma_f32_16x16x32_bf16(Bt[n][k], At[m][k], acc[ai][bj][m][n], 0, 0, 0); __builtin_amdgcn_s_setprio(0); } while (0)
#define PG8_WAIT_V(n) asm volatile("s_waitcnt vmcnt(" #n ")" ::: "memory")
#define PG8_WAIT_L(n) asm volatile("s_waitcnt lgkmcnt(" #n ")" ::: "memory")
#define PG8_BAR __builtin_amdgcn_s_barrier()
#define PG8_SCHED __builtin_amdgcn_sched_barrier(0)
    Unit cur, nxt; int ui = 0;
    if (!S.next(0, cur)) return;
    f32x4 acc[2][2][4][2];
#pragma unroll
    for (int a = 0; a < 2; ++a)
#pragma unroll
        for (int b = 0; b < 2; ++b)
#pragma unroll
            for (int m = 0; m < 4; ++m)
#pragma unroll
                for (int n = 0; n < 2; ++n) acc[a][b][m][n] = (f32x4){0.f, 0.f, 0.f, 0.f};
    bf16x8 At[4][2], B0[2][2], B1[2][2];
    const char* cA = (const char*)g.A + (size_t)cur.pm * tstep; const char* cB = (const char*)g.Bt + (size_t)cur.pn * tstep;
    S.a_ready(cur);
    if constexpr (SP2) {
        PG8_STAGE(PG8_SB(0, 0), cB, voffB); PG8_STAGE(PG8_SB(0, 1), cB + hstep, voffB); PG8_STAGE(PG8_SA(0, 0), cA, voffA); PG8_STAGE(PG8_SA(0, 1), cA + hstep, voffA);
        if (wr == 1) PG8_BAR;
        PG8_WAIT_V(2); PG8_BAR;
        PG8_STAGE(PG8_SB(1, 0), cB + kstep, voffB); PG8_STAGE(PG8_SA(1, 0), cA + kstep, voffA); PG8_STAGE(PG8_SB(1, 1), cB + hstep + kstep, voffB);
        PG8_WAIT_V(6); PG8_BAR;
    } else {
        PG8_STAGE(PG8_SB(0, 0), cB, voffB); PG8_STAGE(PG8_SA(0, 0), cA, voffA); PG8_STAGE(PG8_SB(0, 1), cB + hstep, voffB); PG8_STAGE(PG8_SA(0, 1), cA + hstep, voffA);
        if (wr == 1) PG8_BAR;
        PG8_WAIT_V(4); PG8_BAR;
        PG8_STAGE(PG8_SB(1, 0), cB + kstep, voffB); PG8_STAGE(PG8_SA(1, 0), cA + kstep, voffA); PG8_STAGE(PG8_SB(1, 1), cB + hstep + kstep, voffB);
        PG8_WAIT_V(6); PG8_BAR;
    }
    for (;;) {
        const bool has_next = S.next(ui + 1, nxt);
        const char* nA = has_next ? (const char*)g.A + (size_t)nxt.pm * tstep : cA; const char* nB = has_next ? (const char*)g.Bt + (size_t)nxt.pn * tstep : cB;
        for (int t = 0; t < nt; t += 2) {
            const bool last = (t == nt - 2);
            const char* a1 = cA + (size_t)(t + 1) * kstep;
            const char* a2 = last ? nA : cA + (size_t)(t + 2) * kstep; const char* b2 = last ? nB : cB + (size_t)(t + 2) * kstep;
            const char* a3 = a2 + kstep; const char* b3 = b2 + kstep;
            if (last && has_next) S.a_ready(nxt);
            if constexpr (SP2) {
            PG8_LDB(B0, 0, 0); PG8_LDB(B1, 0, 1); PG8_SCHED; PG8_LDA(At, 0, 0); PG8_STAGE(PG8_SA(1, 1), a1 + hstep, voffA);
            PG8_WAIT_V(8); PG8_WAIT_L(0); PG8_BAR; PG8_MMA(0, 0, At, B0); PG8_MMA(0, 1, At, B1); PG8_BAR; PG8_SCHED;
            PG8_LDA(At, 0, 1); PG8_STAGE(PG8_SB(0, 0), b2, voffB); PG8_STAGE(PG8_SB(0, 1), b2 + hstep, voffB); PG8_STAGE(PG8_SA(0, 0), a2, voffA);
            PG8_WAIT_V(8); PG8_WAIT_L(0); PG8_BAR; PG8_MMA(1, 0, At, B0); PG8_MMA(1, 1, At, B1); PG8_BAR; PG8_SCHED;
            PG8_LDB(B0, 1, 0); PG8_LDB(B1, 1, 1); PG8_SCHED; PG8_LDA(At, 1, 0); PG8_STAGE(PG8_SA(0, 1), a2 + hstep, voffA);
            PG8_WAIT_V(8); PG8_WAIT_L(0); PG8_BAR; PG8_MMA(0, 0, At, B0); PG8_MMA(0, 1, At, B1); PG8_BAR; PG8_SCHED;
            PG8_LDA(At, 1, 1); PG8_STAGE(PG8_SB(1, 0), b3, voffB); PG8_STAGE(PG8_SB(1, 1), b3 + hstep, voffB); PG8_STAGE(PG8_SA(1, 0), a3, voffA);
            PG8_WAIT_V(8); PG8_WAIT_L(0); PG8_BAR; PG8_MMA(1, 0, At, B0); PG8_MMA(1, 1, At, B1); PG8_BAR; PG8_SCHED;
            } else {
            PG8_LDB(B0, 0, 0); PG8_SCHED; PG8_LDA(At, 0, 0); PG8_STAGE(PG8_SA(1, 1), a1 + hstep, voffA);
            PG8_WAIT_L(8); PG8_BAR; PG8_WAIT_L(0); PG8_MMA(0, 0, At, B0); PG8_BAR; PG8_SCHED;
            PG8_LDB(B1, 0, 1); PG8_STAGE(PG8_SB(0, 0), b2, voffB);
            PG8_BAR; PG8_WAIT_L(0); PG8_MMA(0, 1, At, B1); PG8_BAR;
            PG8_LDA(At, 0, 1); PG8_STAGE(PG8_SA(0, 0), a2, voffA);
            PG8_BAR; PG8_WAIT_L(0); PG8_MMA(1, 0, At, B0); PG8_BAR; PG8_SCHED;
            PG8_STAGE(PG8_SB(0, 1), b2 + hstep, voffB);
            PG8_WAIT_V(6); PG8_BAR; PG8_MMA(1, 1, At, B1); PG8_BAR;
            PG8_LDB(B0, 1, 0); PG8_SCHED; PG8_LDA(At, 1, 0); PG8_STAGE(PG8_SA(0, 1), a2 + hstep, voffA);
            PG8_WAIT_L(8); PG8_BAR; PG8_WAIT_L(0); PG8_MMA(0, 0, At, B0); PG8_BAR; PG8_SCHED;
            PG8_LDB(B1, 1, 1); PG8_STAGE(PG8_SB(1, 0), b3, voffB);
            PG8_BAR; PG8_WAIT_L(0); PG8_MMA(0, 1, At, B1); PG8_BAR;
            PG8_LDA(At, 1, 1); PG8_STAGE(PG8_SA(1, 0), a3, voffA);
            PG8_BAR; PG8_WAIT_L(0); PG8_MMA(1, 0, At, B0); PG8_BAR; PG8_SCHED;
            PG8_STAGE(PG8_SB(1, 1), b3 + hstep, voffB);
            PG8_WAIT_V(6); PG8_BAR; PG8_MMA(1, 1, At, B1); PG8_BAR;
            }
        }
        if constexpr (ALIGN_EPI) { if (wr == 0) PG8_BAR; }
        if constexpr (!Epi::AFTER_DRAIN) { E(acc, cur, wr, wc, fr, fq); S.done(cur); }
        if (!has_next) break;
#pragma unroll
        for (int a = 0; a < 2; ++a)
#pragma unroll
            for (int b = 0; b < 2; ++b)
#pragma unroll
                for (int m = 0; m < 4; ++m)
#pragma unroll
                    for (int n = 0; n < 2; ++n) acc[a][b][m][n] = (f32x4){0.f, 0.f, 0.f, 0.f};
        cur = nxt; cA = nA; cB = nB; ++ui;
        if constexpr (ALIGN_EPI) { if (wr == 1) PG8_BAR; }
    }
    PG8_WAIT_V(0);
    if constexpr (!ALIGN_EPI) { if (wr == 0) PG8_BAR; }
    PG8_BAR;
    if constexpr (Epi::AFTER_DRAIN) { E.fused(acc, cur, wr, wc, fr, fq, lds, wid, lane); S.done(cur); }
#undef PG8_SA
#undef PG8_SB
#undef PG8_STAGE
#undef PG8_LDA
#undef PG8_LDB
#undef PG8_MMA
#undef PG8_WAIT_V
#undef PG8_WAIT_L
#undef PG8_BAR
#undef PG8_SCHED
}
}
struct Args { const float* in[13]; float* out; unsigned char* ws; int ph_lo, ph_hi; };

#ifndef TPROBE_I
#define TPROBE_I 3
#endif
#ifndef TPROBE_B
#define TPROBE_B 0
#endif
#ifdef TIME_PH
#ifndef TIME_AMP
#define TIME_AMP 4
#endif
#define TSTAMP(k, slot) do { if ((k) == TIME_PH && bid == TPROBE_B && tid == 0) { const unsigned long long t_ = __builtin_amdgcn_s_memrealtime(); MISC[slot] = (unsigned)t_; MISC[(slot) + 1] = (unsigned)(t_ >> 32); } } while (0)
#else
#define TSTAMP(k, slot) do { } while (0)
#endif
template <bool PERMUTE>
__device__ __forceinline__ void p0_transpose_item(const float* W, int K, int N, int NPOS, bf16_t* WT, LAS float* scr, int item, int lane) {
    const int nblk = NPOS / 32, kb = item / nblk, nb = item % nblk, k0 = 64 * kb, n0 = 32 * nb;
    const int pos = n0 + 4 * (lane & 7);
    const int col = PERMUTE ? win_src_col(pos) : pos;
    f32x4 v[8];
#pragma unroll
    for (int i = 0; i < 8; ++i) { const int kk = 8 * i + (lane >> 3); v[i] = (col >= 0) ? *(const f32x4*)(W + (size_t)(k0 + kk) * N + col) : (f32x4){0.f, 0.f, 0.f, 0.f}; }
#pragma unroll
    for (int i = 0; i < 8; ++i) { const int kk = 8 * i + (lane >> 3); LAS float* q = scr + kk * 33 + 4 * (lane & 7); q[0] = v[i][0]; q[1] = v[i][1]; q[2] = v[i][2]; q[3] = v[i][3]; }
    asm volatile("s_waitcnt lgkmcnt(0)" ::: "memory");
    const int c = lane & 7;
#pragma unroll
    for (int j = 0; j < 4; ++j) { const int n = (lane >> 3) + 8 * j; const LAS float* s = scr + (8 * c) * 33 + n;
        u32x4 o; o.x = pk2(s[0 * 33], s[1 * 33]); o.y = pk2(s[2 * 33], s[3 * 33]); o.z = pk2(s[4 * 33], s[5 * 33]); o.w = pk2(s[6 * 33], s[7 * 33]);
        *(u32x4*)(WT + (size_t)(n0 + n) * K + k0 + 8 * c) = o; }
    asm volatile("s_waitcnt lgkmcnt(0)" ::: "memory");
}
__device__ __forceinline__ void row_to_bf16(const float* src, bf16_t* dst, int lane) {
    const f32x4* s = (const f32x4*)src + lane; u32x2* d = (u32x2*)dst + lane;
    f32x4 v[4];
#pragma unroll
    for (int j = 0; j < 4; ++j) v[j] = s[64 * j];
#pragma unroll
    for (int j = 0; j < 4; ++j) { u32x2 w; w.x = pk2(v[j][0], v[j][1]); w.y = pk2(v[j][2], v[j][3]); d[64 * j] = w; }
}
typedef float f32x2 __attribute__((ext_vector_type(2)));
template <int NB>
__device__ __forceinline__ void rows_to_fp8(const float* src, unsigned char* dst, float* scale_out, int lane) {
    f32x4 v[NB][4];
#pragma unroll
    for (int i = 0; i < NB; ++i) { const f32x4* s = (const f32x4*)(src + (size_t)i * 1024) + 4 * lane;
#pragma unroll
        for (int j = 0; j < 4; ++j) v[i][j] = __builtin_nontemporal_load(s + j); }
#pragma unroll
    for (int i = 0; i < NB; ++i) {
        float am = 0.f;
#pragma unroll
        for (int j = 0; j < 4; ++j) am = fmaxf(am, fmaxf(fmaxf(fabsf(v[i][j][0]), fabsf(v[i][j][1])), fmaxf(fabsf(v[i][j][2]), fabsf(v[i][j][3]))));
#pragma unroll
        for (int o = 1; o < 64; o <<= 1) am = fmaxf(am, __shfl_xor(am, o));
        const float sc = am > 0.f ? am * (1.0f / 440.0f) : 1.0f, inv = 1.0f / sc;
        u32x4 w;
#pragma unroll
        for (int j = 0; j < 4; ++j) { unsigned t = 0u; t = __builtin_amdgcn_cvt_pk_fp8_f32(v[i][j][0] * inv, v[i][j][1] * inv, t, false); t = __builtin_amdgcn_cvt_pk_fp8_f32(v[i][j][2] * inv, v[i][j][3] * inv, t, true); w[j] = t; }
        *((u32x4*)(dst + (size_t)i * 1024) + lane) = w;
        if (lane == 0) scale_out[i] = sc;
    }
}
__device__ __forceinline__ void sincos_tab(double x, float& s, float& c) {
    const double k = rint(x * 0.15915494309189535);
    double r = fma(-k, 6.283185307179586, x); r = fma(-k, 2.4492935982947064e-16, r);
    const double r2 = r * r;
    double ps = 1.0, pc = 1.0;
#pragma unroll
    for (int n = 29; n >= 3; n -= 2) ps = 1.0 - ps * r2 * (1.0 / (double)((n - 1) * n));
#pragma unroll
    for (int n = 28; n >= 2; n -= 2) pc = 1.0 - pc * r2 * (1.0 / (double)((n - 1) * n));
    s = (float)(r * ps); c = (float)pc;
}

__device__ __forceinline__ void phase0(const Args& a, unsigned char* lds, int tid, int wave, int lane, int bid, int G) {
    unsigned char* ws = a.ws;
    volatile LAS unsigned* MISC = (volatile LAS unsigned*)((LAS unsigned char*)lds + MISC_OFF);
    TSTAMP(90, 0);
    if (bid & 1) { const int gw0 = bid * 8 + wave, NGW0 = G * 8;
        for (int it = gw0; it < 4096; it += NGW0) { const int r = 4 * it;
            rows_to_fp8<4>(a.in[10] + (size_t)r * 1024, ws + WS_U8 + (size_t)r * 1024, (float*)(ws + WS_USC) + r, lane); }
        __syncthreads(); }
    for (int it = bid; it < 192; it += G) {
        float* s_c = (float*)lds; float* red = (float*)(lds + 16384);
        for (int i = tid; i < 4096; i += NTHREADS) { const float v = a.in[1][i]; s_c[i] = v / (1.0f + expf(-v)); }
        __syncthreads();
        const int g = tid & 7, ks = tid >> 3, n0 = 32 * it;
        f32x4 acc[4];
#pragma unroll
        for (int b = 0; b < 4; ++b) acc[b] = (f32x4){0.f, 0.f, 0.f, 0.f};
#pragma unroll 4
        for (int i = 0; i < 16; ++i) { const int k = ks + 64 * i; const f32x4 w = *(const f32x4*)(a.in[2] + (size_t)k * 6144 + n0 + 4 * g);
#pragma unroll
            for (int b = 0; b < 4; ++b) acc[b] += w * s_c[b * 1024 + k]; }
#pragma unroll
        for (int b = 0; b < 4; ++b) *(f32x4*)(red + (ks * 8 + g) * 16 + 4 * b) = acc[b];
        __syncthreads();
        if (tid < 128) { const int b = tid >> 5, col = tid & 31, gg = col >> 2, e = col & 3; float s = 0.f;
            for (int k2 = 0; k2 < 64; ++k2) s += red[(k2 * 8 + gg) * 16 + 4 * b + e];
            ((float*)(ws + WS_MOD))[b * 6144 + n0 + col] = s + a.in[3][n0 + col]; }
        __syncthreads();
    }
    TSTAMP(90, 2); TSTAMP(91, 0);
    for (int it = bid; it < 256; it += G) {
        const int hp = it >> 4, k0 = 64 * (it & 15);
        constexpr int WP = 132;
        float* skl = (float*)lds; float* wql = skl + 128 * WP;
        for (int i = tid; i < 4096; i += NTHREADS) { const int n = i >> 5, d4 = i & 31; *(f32x4*)(skl + n * WP + 4 * d4) = *(const f32x4*)(a.in[9] + (size_t)hp * 16384 + n * 128 + 4 * d4); }
        for (int i = tid; i < 2048; i += NTHREADS) { const int k = i >> 5, d4 = i & 31; *(f32x4*)(wql + k * WP + 4 * d4) = *(const f32x4*)(a.in[8] + (size_t)(k0 + k) * 2048 + hp * 128 + 4 * d4); }
        __syncthreads();
        const int kg = tid & 15, ng = tid >> 4;
        float acc[4][4];
#pragma unroll
        for (int i = 0; i < 4; ++i)
#pragma unroll
            for (int j = 0; j < 4; ++j) acc[i][j] = 0.f;
#pragma unroll 2
        for (int d4 = 0; d4 < 32; ++d4) {
            f32x4 wv[4], sv[4];
#pragma unroll
            for (int i = 0; i < 4; ++i) { wv[i] = *(const f32x4*)(wql + (kg + 16 * i) * WP + 4 * d4); sv[i] = *(const f32x4*)(skl + (ng + 32 * i) * WP + 4 * d4); }
#pragma unroll
            for (int i = 0; i < 4; ++i)
#pragma unroll
                for (int j = 0; j < 4; ++j) acc[i][j] += (wv[i][0] * sv[j][0] + wv[i][1] * sv[j][1]) + (wv[i][2] * sv[j][2] + wv[i][3] * sv[j][3]);
        }
        bf16_t* wt = (bf16_t*)(ws + WS_WPQ);
#pragma unroll
        for (int j = 0; j < 4; ++j)
#pragma unroll
            for (int i = 0; i < 4; ++i) wt[(size_t)(hp * 128 + ng + 32 * j) * 1024 + k0 + kg + 16 * i] = (bf16_t)f2bf(acc[i][j]);
        __syncthreads();
    }
    TSTAMP(91, 2); TSTAMP(92, 0);
    const int gw = bid * 8 + wave, NGW = G * 8;
    {
        LAS float* scr = (LAS float*)(lds + wave * 16384);
        constexpr int I_IN = 16 * (N1 / 32), I_OUT = 16 * 32;
        for (int it = gw; it < I_IN + I_OUT; it += NGW) {
            if (it < I_IN) p0_transpose_item<true>(a.in[5], 1024, 4168, N1, (bf16_t*)(ws + WS_WIN), scr, it, lane);
            else p0_transpose_item<false>(a.in[6], 1024, 1024, 1024, (bf16_t*)(ws + WS_WOUT), scr, it - I_IN, lane);
        }
    }
    if (!(bid & 1)) {
        for (int it = gw; it < 4096; it += NGW) { const int r = 4 * it;
            rows_to_fp8<4>(a.in[10] + (size_t)r * 1024, ws + WS_U8 + (size_t)r * 1024, (float*)(ws + WS_USC) + r, lane); }
    }
    for (int i = bid * NTHREADS + tid; i < 4096 * 96; i += G * NTHREADS) {
        int pos, f; double r; float* ct; float* st; int idx;
        if (i < 4096 * 32) { pos = i >> 5; f = i & 31; r = 0.74989420933245582730; ct = (float*)(ws + WS_COSA); st = (float*)(ws + WS_SINA); idx = i; }
        else { const int j = i - 4096 * 32; pos = j >> 6; f = j & 63; r = 0.86398844948396852897; ct = (float*)(ws + WS_COSR); st = (float*)(ws + WS_SINR); idx = j; }
        double v = 1.0; for (int t = 0; t < f; ++t) v *= r;
        const float invf = (float)v; const float ang = (float)pos * invf;
        float s, c; sincos_tab((double)ang, s, c);
        ct[idx] = c; st[idx] = s;
    }
}

__device__ __forceinline__ void phase1(const Args& a, int wave, int lane, int bid, int G) {
    unsigned char* ws = a.ws;
    const float* mod = (const float*)(ws + WS_MOD);
    const int gw = bid * 8 + wave, NGW = G * 8;
    for (int r0 = gw; r0 < MTOK; r0 += 2 * NGW) {
        const int r1 = r0 + NGW; const bool has1 = r1 < MTOK;
        const f32x4* xa = (const f32x4*)(a.in[0] + (size_t)r0 * DM) + lane; const f32x4* xb = (const f32x4*)(a.in[0] + (size_t)(has1 ? r1 : r0) * DM) + lane;
        f32x4 va[4], vb[4]; float sa = 0.f, sb = 0.f;
#pragma unroll
        for (int j = 0; j < 4; ++j) { va[j] = xa[64 * j]; vb[j] = xb[64 * j]; }
#pragma unroll
        for (int j = 0; j < 4; ++j) { sa += (va[j][0] * va[j][0] + va[j][1] * va[j][1]) + (va[j][2] * va[j][2] + va[j][3] * va[j][3]); sb += (vb[j][0] * vb[j][0] + vb[j][1] * vb[j][1]) + (vb[j][2] * vb[j][2] + vb[j][3] * vb[j][3]); }
#pragma unroll
        for (int o = 1; o < 64; o <<= 1) { sa += __shfl_xor(sa, o); sb += __shfl_xor(sb, o); }
        const float ra = 1.0f / sqrtf(sa * (1.0f / DM) + EPS), rb = 1.0f / sqrtf(sb * (1.0f / DM) + EPS);
        const int ba = r0 >> 12, bb = (has1 ? r1 : r0) >> 12;
        u32x2* oa = (u32x2*)((bf16_t*)(ws + WS_BUFA) + (size_t)r0 * DM) + lane; u32x2* ob = (u32x2*)((bf16_t*)(ws + WS_BUFA) + (size_t)(has1 ? r1 : r0) * DM) + lane;
#pragma unroll
        for (int j = 0; j < 4; ++j) { const int c = 256 * j + 4 * lane;
            const f32x4 g = *(const f32x4*)(a.in[4] + c);
            { const f32x4 sc = *(const f32x4*)(mod + ba * 6144 + 1024 + c), sh = *(const f32x4*)(mod + ba * 6144 + c);
              const f32x4 h = va[j] * ra * g * (sc + 1.0f) + sh; u32x2 w; w.x = pk2(h[0], h[1]); w.y = pk2(h[2], h[3]); oa[64 * j] = w; }
            if (has1) { const f32x4 sc = *(const f32x4*)(mod + bb * 6144 + 1024 + c), sh = *(const f32x4*)(mod + bb * 6144 + c);
              const f32x4 h = vb[j] * rb * g * (sc + 1.0f) + sh; u32x2 w; w.x = pk2(h[0], h[1]); w.y = pk2(h[2], h[3]); ob[64 * j] = w; }
        }
    }
    for (int n = gw; n < 2048; n += NGW) {
        const u32x4* wr = (const u32x4*)((const bf16_t*)(ws + WS_WPQ) + (size_t)n * 1024);
        const u32x4 w0 = wr[lane], w1 = wr[64 + lane];
        float wf[16];
#pragma unroll
        for (int i = 0; i < 4; ++i) { wf[2 * i] = bf_lo(w0[i]); wf[2 * i + 1] = bf_hi(w0[i]); wf[8 + 2 * i] = bf_lo(w1[i]); wf[8 + 2 * i + 1] = bf_hi(w1[i]); }
#pragma unroll
        for (int b = 0; b < 4; ++b) { const float* sh = mod + b * 6144 + 3072; float s = 0.f;
#pragma unroll
            for (int i = 0; i < 8; ++i) s += wf[i] * sh[8 * lane + i] + wf[8 + i] * sh[512 + 8 * lane + i];
            s = wave_sum(s);
            if (lane == 0) ((float*)(ws + WS_BIASF))[b * 2048 + n] = s; }
    }
}

constexpr int SCP = 8200;
__device__ __forceinline__ int wave_total(int v) {
    v += __builtin_amdgcn_update_dpp(0, v, 0xB1, 0xF, 0xF, true);
    v += __builtin_amdgcn_update_dpp(0, v, 0x4E, 0xF, 0xF, true);
    v += __builtin_amdgcn_update_dpp(0, v, 0x141, 0xF, 0xF, true);
    v += __builtin_amdgcn_update_dpp(0, v, 0x140, 0xF, 0xF, true);
    return __builtin_amdgcn_readlane(v, 0) + __builtin_amdgcn_readlane(v, 16) + __builtin_amdgcn_readlane(v, 32) + __builtin_amdgcn_readlane(v, 48);
}
__device__ __forceinline__ int wave_suffix_sum(int v, int lane) {
#pragma unroll
    for (int d = 1; d < 64; d <<= 1) { const int o = __shfl_down(v, d); if (lane + d < 64) v += o; }
    return v;
}
__device__ __forceinline__ void hist_find(const unsigned* hist, int want, int lane, int& bin, int& above, int& inbin) {
    const u32x4 h = *(const u32x4*)(hist + 4 * lane);
    const int s = (int)(h.x + h.y) + (int)(h.z + h.w);
    const int incl = wave_suffix_sum(s, lane), excl = incl - s;
    const bool mine = excl < want && want <= incl;
    int c = excl, bsel = 4 * lane + 3, cin = (int)h.w;
    if (c + (int)h.w < want) { c += (int)h.w; bsel = 4 * lane + 2; cin = (int)h.z;
        if (c + (int)h.z < want) { c += (int)h.z; bsel = 4 * lane + 1; cin = (int)h.y;
            if (c + (int)h.y < want) { c += (int)h.y; bsel = 4 * lane; cin = (int)h.x; } } }
    const int src = (int)__builtin_ctzll(__ballot(mine));
    bin = __builtin_amdgcn_readlane(bsel, src); above = __builtin_amdgcn_readlane(c, src); inbin = __builtin_amdgcn_readlane(cin, src);
}
template <int NR>
__device__ __forceinline__ void select_row_t(int b, int t, unsigned char* ldsrow, unsigned* hist, unsigned long long* MASK, int lane) {
    {
        unsigned* row32 = (unsigned*)ldsrow;
        for (int i = 8 * ((t >> 4) + 1) + lane; i < 32 * NR; i += 64) row32[i] = 0u;
    }
    unsigned key[NR];
#pragma unroll
    for (int j = 0; j < NR; ++j) key[j] = *(const unsigned short*)(ldsrow + 2 * lane + 128 * j);
    unsigned mw_lo = 0u, mw_hi = 0u;
    if (t < 256) {
#pragma unroll
        for (int j = 0; j < 4; ++j) { const unsigned long long w = __ballot(key[j] != 0u);
            asm volatile("s_nop 1\n\tv_writelane_b32 %0, %2, %4\n\tv_writelane_b32 %1, %3, %4\n\ts_nop 0" : "+v"(mw_lo), "+v"(mw_hi) : "s"((unsigned)w), "s"((unsigned)(w >> 32)), "n"(j)); }
    } else {
        *(u32x4*)(hist + 4 * lane) = (u32x4){0u, 0u, 0u, 0u};
#pragma unroll
        for (int j = 0; j < NR; ++j) __hip_atomic_fetch_add(hist + (key[j] >> 8), 1u, __ATOMIC_RELAXED, __HIP_MEMORY_SCOPE_WORKGROUP);
        int B, above, inB;
        hist_find(hist, 256, lane, B, above, inB);
        *(u32x4*)(hist + 4 * lane) = (u32x4){0u, 0u, 0u, 0u};
#pragma unroll
        for (int j = 0; j < NR; ++j) if ((int)(key[j] >> 8) == B) __hip_atomic_fetch_add(hist + (key[j] & 255u), 1u, __ATOMIC_RELAXED, __HIP_MEMORY_SCOPE_WORKGROUP);
        int b2, above2, ties;
        hist_find(hist, 256 - above, lane, b2, above2, ties);
        const unsigned T = ((unsigned)B << 8) | (unsigned)b2;
        int need = 256 - above - above2;
        if (ties == need) {
#pragma unroll
            for (int j = 0; j < NR; ++j) { const unsigned long long w = __ballot(key[j] >= T);
                asm volatile("s_nop 1\n\tv_writelane_b32 %0, %2, %4\n\tv_writelane_b32 %1, %3, %4\n\ts_nop 0" : "+v"(mw_lo), "+v"(mw_hi) : "s"((unsigned)w), "s"((unsigned)(w >> 32)), "n"(j));
                if ((j & 3) == 3) __builtin_amdgcn_sched_barrier(0); }
        } else {
#pragma unroll
            for (int j = 0; j < NR; ++j) {
                const bool gt = key[j] > T, eq = key[j] == T;
                const unsigned long long em = __ballot(eq);
                const int cc = __popcll(em), take = cc < need ? cc : need;
                const int rank = (int)__builtin_amdgcn_mbcnt_hi((unsigned)(em >> 32), __builtin_amdgcn_mbcnt_lo((unsigned)em, 0u));
                const unsigned long long w = __ballot(gt || (eq && rank < take));
                need -= take;
                asm volatile("s_nop 1\n\tv_writelane_b32 %0, %2, %4\n\tv_writelane_b32 %1, %3, %4\n\ts_nop 0" : "+v"(mw_lo), "+v"(mw_hi) : "s"((unsigned)w), "s"((unsigned)(w >> 32)), "n"(j));
                if ((j & 1) == 1) __builtin_amdgcn_sched_barrier(0);
            }
        }
    }
    MASK[((size_t)b * SEQ + t) * 64 + lane] = ((unsigned long long)mw_hi << 32) | mw_lo;
}
__device__ __forceinline__ void select_row(int b, int t, unsigned char* ldsrow, unsigned* hist, unsigned long long* MASK, int lane) {
    switch (t >> 10) {
        case 0: select_row_t<16>(b, t, ldsrow, hist, MASK, lane); break;
        case 1: select_row_t<32>(b, t, ldsrow, hist, MASK, lane); break;
        case 2: select_row_t<48>(b, t, ldsrow, hist, MASK, lane); break;
        default: select_row_t<64>(b, t, ldsrow, hist, MASK, lane); break;
    }
}
__device__ __forceinline__ void idx_unit(int b, int qt, const bf16_t* QI, const bf16_t* KI, const float* WI, unsigned long long* MASK, unsigned char* lds, int wave, int lane, bool tprobe) {
    volatile LAS unsigned* MISC = (volatile LAS unsigned*)((LAS unsigned char*)lds + MISC_OFF); const int bid = tprobe ? TPROBE_B : -1; const int tid = (int)threadIdx.x;
    TSTAMP(32, 0);
    const int t0 = 16 * qt, qn = lane & 15, g = lane >> 4;
    const size_t rowq = (size_t)b * SEQ + t0 + qn;
    bf16x8 qf[8][2]; float wi[8];
#pragma unroll
    for (int h = 0; h < 8; ++h)
#pragma unroll
        for (int ks = 0; ks < 2; ++ks) qf[h][ks] = *(const bf16x8*)(QI + rowq * 512 + h * 64 + ks * 32 + 8 * g);
    { const f32x4 w0 = *(const f32x4*)(WI + rowq * 8), w1 = *(const f32x4*)(WI + rowq * 8 + 4);
#pragma unroll
      for (int e = 0; e < 4; ++e) { wi[e] = w0[e]; wi[4 + e] = w1[e]; } }
    const bf16_t* kbase = KI + ((size_t)b * SEQ + qn) * 64 + 8 * g;
    bf16x8 ra0[8], ra1[8];
#pragma unroll
    for (int i = 0; i < 8; ++i) if (wave + 8 * i <= qt) { const bf16_t* kr = kbase + (size_t)(wave + 8 * i) * 1024; ra0[i] = *(const bf16x8*)kr; ra1[i] = *(const bf16x8*)(kr + 32); }
#pragma unroll 1
    for (int base = wave; base <= qt; base += 64) {
#pragma unroll
        for (int i = 0; i < 8; ++i) {
            const int kt = base + 8 * i;
            if (kt <= qt) {
                const bf16x8 a0 = ra0[i], a1 = ra1[i];
                if (kt + 64 <= qt) { const bf16_t* kr = kbase + (size_t)(kt + 64) * 1024; ra0[i] = *(const bf16x8*)kr; ra1[i] = *(const bf16x8*)(kr + 32); }
                const int s0 = 16 * kt;
                f32x4 sc = (f32x4){0.f, 0.f, 0.f, 0.f};
#pragma unroll
                for (int h = 0; h < 8; ++h) {
                    f32x4 d = mfma16(a0, qf[h][0], (f32x4){0.f, 0.f, 0.f, 0.f}); d = mfma16(a1, qf[h][1], d);
#pragma unroll
                    for (int r = 0; r < 4; ++r) { const int di = (int)__float_as_uint(d[r]); sc[r] += wi[h] * __uint_as_float((unsigned)(di > 0 ? di : 0)); }
                }
                unsigned k[4];
#pragma unroll
                for (int r = 0; r < 4; ++r) { const unsigned kk = sortable16(sc[r]); k[r] = (s0 + 4 * g + r <= t0 + qn) ? kk : 0u; }
                u32x2 pk; pk.x = k[0] | (k[1] << 16); pk.y = k[2] | (k[3] << 16);
                *(u32x2*)(lds + qn * SCP + 2 * (s0 + 4 * g)) = pk;
            }
        }
    }
    __syncthreads();
    TSTAMP(32, 2); TSTAMP(33, 0);
#ifndef NO_SEL
#pragma unroll 1
    for (int qq = 2 * wave; qq < 2 * wave + 2; ++qq) select_row(b, t0 + qq, lds + qq * SCP, (unsigned*)(lds + 16 * SCP) + 256 * wave, MASK, lane);
#endif
    __syncthreads();
    TSTAMP(33, 2);
}

typedef short s16x4_t __attribute__((ext_vector_type(4)));
__device__ __forceinline__ s16x4_t lds_tr16(const unsigned char* p) {
    return __builtin_bit_cast(s16x4_t, __builtin_amdgcn_ds_read_tr16_b64_v4i16((LAS s16x4_t*)(LAS unsigned char*)p));
}
__device__ __forceinline__ void ret_state_unit(int b, int h, int vb, int dh, const bf16_t* KR, const bf16_t* VR, bf16_t* STATE, unsigned char* lds, int tid, int wave, int lane) {
    constexpr int KPT = 144, VPT = 48, K_BYTES = 128 * KPT, BUF = K_BYTES + 128 * VPT;
    const int j = tid & 127, dq = tid >> 7, g = lane >> 4, ln = lane & 15;
    const float g128 = ret_g128(h), g127 = ret_g127(h), gam = ret_gamma(h);
    f32x4 st = (f32x4){0.f, 0.f, 0.f, 0.f};
    u32x4 kA[2], kB[2], vA = (u32x4){0u, 0u, 0u, 0u}, vB = (u32x4){0u, 0u, 0u, 0u};
#define RS_LOAD(K_, V_, n) do { const size_t row = (size_t)b * SEQ + (n) * 128 + j; const u32x4* p = (const u32x4*)(KR + row * 512 + h * 128 + 64 * dh + 16 * dq); \
        K_[0] = p[0]; K_[1] = p[1]; if (tid < 256) V_ = *(const u32x4*)(VR + row * 512 + h * 128 + 16 * vb + 8 * dq); } while (0)
#define RS_WRITE(K_, V_, buf) do { *(u32x4*)((buf) + j * KPT + 32 * dq) = K_[0]; *(u32x4*)((buf) + j * KPT + 32 * dq + 16) = K_[1]; \
        if (tid < 256) *(u32x4*)((buf) + K_BYTES + j * VPT + 16 * dq) = V_; } while (0)
#define RS_COMP(buf, n) do { \
        f32x4 c = (f32x4){0.f, 0.f, 0.f, 0.f}; \
        _Pragma("unroll") for (int ks = 0; ks < 4; ++ks) { const int j0 = 32 * ks + 8 * g + (ln >> 2); \
            const unsigned char* ap = (buf) + K_BYTES + j0 * VPT + 8 * (ln & 3); const unsigned char* bp = (buf) + j0 * KPT + 32 * (wave & 3) + 8 * (ln & 3); \
            const s16x4_t a0 = lds_tr16(ap), a1 = lds_tr16(ap + 4 * VPT), b0 = lds_tr16(bp), b1 = lds_tr16(bp + 4 * KPT); \
            const bf16x8 af = (bf16x8){a0[0], a0[1], a0[2], a0[3], a1[0], a1[1], a1[2], a1[3]}, bf = (bf16x8){b0[0], b0[1], b0[2], b0[3], b1[0], b1[1], b1[2], b1[3]}; \
            c = mfma16(af, bf, c); } \
        if (wave < 4) { \
            bf16_t* sp = STATE + ((((size_t)b * 4 + h) * 32 + (n)) * 128 + 16 * vb + 4 * g) * 128 + 64 * dh + 16 * wave + ln; \
            _Pragma("unroll") for (int r = 0; r < 4; ++r) sp[r * 128] = (bf16_t)f2bf(gam * st[r]); \
            st = st * g128 + c * g127; } } while (0)
    u32x4 kC[2], kD[2], vC = (u32x4){0u, 0u, 0u, 0u}, vD = (u32x4){0u, 0u, 0u, 0u};
    RS_LOAD(kA, vA, 0); RS_LOAD(kB, vB, 1); RS_LOAD(kC, vC, 2); RS_LOAD(kD, vD, 3);
#pragma unroll 1
    for (int n = 0; n < 32; n += 4) {
        RS_WRITE(kA, vA, lds);        if (n + 4 < 32) RS_LOAD(kA, vA, n + 4); __syncthreads(); RS_COMP(lds, n);
        RS_WRITE(kB, vB, lds + BUF);  if (n + 5 < 32) RS_LOAD(kB, vB, n + 5); __syncthreads(); RS_COMP(lds + BUF, n + 1);
        RS_WRITE(kC, vC, lds);        if (n + 6 < 32) RS_LOAD(kC, vC, n + 6); __syncthreads(); RS_COMP(lds, n + 2);
        RS_WRITE(kD, vD, lds + BUF);  if (n + 7 < 32) RS_LOAD(kD, vD, n + 7); __syncthreads(); RS_COMP(lds + BUF, n + 3);
    }
#undef RS_LOAD
#undef RS_WRITE
#undef RS_COMP
    __syncthreads();
}

__device__ __forceinline__ float amax3(float a, float b, float c) { float r; asm("v_max3_f32 %0, %1, %2, %3" : "=v"(r) : "v"(a), "v"(b), "v"(c)); return r; }
__device__ __forceinline__ void attn_unit(int b, int h, int qb, const bf16_t* QA, const bf16_t* KA, const bf16_t* VA, const unsigned long long* MASK, bf16_t* AR,
                                          unsigned char* lds, int tid, int wave, int lane) {
    constexpr int KP = 144, KS_BYTES = 64 * KP, BUF = 2 * KS_BYTES;
    const int q0 = 256 * qb, r32 = lane & 31, hi = lane >> 5;
    const int t = q0 + 32 * wave + r32;
    const size_t qrow = (size_t)b * SEQ + t;
    bf16x8 qf[4];
#pragma unroll
    for (int d0 = 0; d0 < 4; ++d0) qf[d0] = *(const bf16x8*)(QA + qrow * 512 + h * 64 + 16 * d0 + 8 * hi);
    const int NT = (q0 + 256) / 64;
    const int key_l = tid >> 3, c8 = tid & 7;
    f32x16 o0, o1;
#pragma unroll
    for (int r = 0; r < 16; ++r) { o0[r] = 0.f; o1[r] = 0.f; }
    float m_run = NEG_INF, l_run = 0.f;
    u32x4 kreg[4], vreg[4]; unsigned long long mw[4];
#define AT_LOAD(i, kt) do { const size_t kr = (size_t)b * SEQ + 64 * (kt) + key_l; kreg[i] = *(const u32x4*)(KA + kr * 512 + h * 64 + 8 * c8); vreg[i] = *(const u32x4*)(VA + kr * 512 + h * 64 + 8 * c8); \
        mw[i] = MASK[qrow * 64 + (kt)]; } while (0)
#pragma unroll
    for (int i = 0; i < 4; ++i) AT_LOAD(i, i);
#pragma unroll 1
    for (int kt4 = 0; kt4 < NT; kt4 += 4) {
#pragma unroll
      for (int i = 0; i < 4; ++i) {
        const int kt = kt4 + i;
        unsigned char* buf = lds + (i & 1) * BUF;
        *(u32x4*)(buf + key_l * KP + 16 * c8) = kreg[i];
#pragma unroll
        for (int e = 0; e < 4; ++e) { const unsigned w = vreg[i][e]; const int d = 8 * c8 + 2 * e;
            *(unsigned short*)(buf + KS_BYTES + d * KP + 2 * key_l) = (unsigned short)(w & 0xffffu); *(unsigned short*)(buf + KS_BYTES + (d + 1) * KP + 2 * key_l) = (unsigned short)(w >> 16); }
        const unsigned long long mcur = mw[i];
        if (kt + 4 < NT) AT_LOAD(i, kt + 4);
        __syncthreads();
        if (64 * kt <= q0 + 32 * wave + 31) {
            f32x16 p0, p1;
#pragma unroll
            for (int r = 0; r < 16; ++r) { p0[r] = 0.f; p1[r] = 0.f; }
#pragma unroll
            for (int d0 = 0; d0 < 4; ++d0) {
                const bf16x8 a0 = *(const bf16x8*)(buf + r32 * KP + 32 * d0 + 16 * hi);
                const bf16x8 a1 = *(const bf16x8*)(buf + (32 + r32) * KP + 32 * d0 + 16 * hi);
                p0 = mfma32(a0, qf[d0], p0); p1 = mfma32(a1, qf[d0], p1);
            }
            const unsigned wl = (unsigned)mcur >> (4 * hi), wh = (unsigned)(mcur >> 32) >> (4 * hi);
#pragma unroll
            for (int r = 0; r < 16; ++r) { const int bp = (r & 3) + 8 * (r >> 2);
                const unsigned m0 = (unsigned)((int)(wl << (31 - bp)) >> 31), m1 = (unsigned)((int)(wh << (31 - bp)) >> 31);
                p0[r] = __uint_as_float((__float_as_uint(p0[r]) & m0) | (0xff800000u & ~m0)); p1[r] = __uint_as_float((__float_as_uint(p1[r]) & m1) | (0xff800000u & ~m1)); }
            float mx;
            { float a = amax3(p0[0], p0[1], p1[0]), bq = amax3(p0[2], p0[3], p1[1]); a = amax3(a, p1[2], p1[3]);
#pragma unroll
              for (int r = 4; r < 16; r += 4) { a = amax3(a, p0[r], p0[r + 1]); bq = amax3(bq, p0[r + 2], p0[r + 3]); a = amax3(a, p1[r], p1[r + 1]); bq = amax3(bq, p1[r + 2], p1[r + 3]); }
              mx = amax3(a, bq, bq); }
            mx = amax3(mx, __shfl_xor(mx, 32), mx);
            const float m_new = amax3(m_run, mx, mx);
            const float m_use = (m_new == NEG_INF) ? 0.f : m_new;
            const float alpha = fast_exp2(m_run - m_use);
            m_run = m_new;
            float ps = 0.f;
#pragma unroll
            for (int r = 0; r < 16; ++r) { p0[r] = fast_exp2(p0[r] - m_use); p1[r] = fast_exp2(p1[r] - m_use); ps += p0[r] + p1[r]; }
            l_run = l_run * alpha + ps;
            if (__any(alpha != 1.0f)) {
#pragma unroll
                for (int r = 0; r < 16; ++r) { o0[r] *= alpha; o1[r] *= alpha; }
            }
#pragma unroll
            for (int s4 = 0; s4 < 4; ++s4) {
                const int rb = 8 * (s4 & 1);
                u32x4 pw;
                if (s4 < 2) { pw.x = pk2(p0[rb], p0[rb + 1]); pw.y = pk2(p0[rb + 2], p0[rb + 3]); pw.z = pk2(p0[rb + 4], p0[rb + 5]); pw.w = pk2(p0[rb + 6], p0[rb + 7]); }
                else        { pw.x = pk2(p1[rb], p1[rb + 1]); pw.y = pk2(p1[rb + 2], p1[rb + 3]); pw.z = pk2(p1[rb + 4], p1[rb + 5]); pw.w = pk2(p1[rb + 6], p1[rb + 7]); }
                const bf16x8 bfr = __builtin_bit_cast(bf16x8, pw);
                { const unsigned char* vp = buf + KS_BYTES + r32 * KP + 2 * (16 * s4 + 4 * hi);
                  const u32x2 lo = *(const u32x2*)vp, h2 = *(const u32x2*)(vp + 16); const u32x4 av = (u32x4){lo.x, lo.y, h2.x, h2.y};
                  o0 = mfma32(__builtin_bit_cast(bf16x8, av), bfr, o0); }
                { const unsigned char* vp = buf + KS_BYTES + (32 + r32) * KP + 2 * (16 * s4 + 4 * hi);
                  const u32x2 lo = *(const u32x2*)vp, h2 = *(const u32x2*)(vp + 16); const u32x4 av = (u32x4){lo.x, lo.y, h2.x, h2.y};
                  o1 = mfma32(__builtin_bit_cast(bf16x8, av), bfr, o1); }
            }
        }
      }
    }
#undef AT_LOAD
    l_run += __shfl_xor(l_run, 32);
#ifdef DBG_NOATT
    const float inv = 0.f;
#else
    const float inv = 1.0f / l_run;
#endif
    bf16_t* op = AR + qrow * 1024 + h * 64 + 4 * hi;
#pragma unroll
    for (int c = 0; c < 4; ++c) {
        u32x2 w; w.x = pk2(o0[4 * c] * inv, o0[4 * c + 1] * inv); w.y = pk2(o0[4 * c + 2] * inv, o0[4 * c + 3] * inv); *(u32x2*)(op + 8 * c) = w;
        u32x2 v; v.x = pk2(o1[4 * c] * inv, o1[4 * c + 1] * inv); v.y = pk2(o1[4 * c + 2] * inv, o1[4 * c + 3] * inv); *(u32x2*)(op + 32 + 8 * c) = v;
    }
    __syncthreads();
}

__device__ __forceinline__ void ret_out_unit(int b, int h, int n, const bf16_t* QR, const bf16_t* KR, const bf16_t* VR, const bf16_t* GR, const bf16_t* STATE, bf16_t* AR,
                                             unsigned char* lds, int tid, int wave, int lane) {
    constexpr int PT = 272;
    const size_t c0 = (size_t)b * SEQ + 128 * n; const int hc = 128 * h;
    const int ln = lane & 15, g = lane >> 4;
    const size_t qrow = c0 + 16 * wave + ln;
    u32x4 rr[4];
    { const int j = tid & 127, vq = tid >> 7; const u32x4* p = (const u32x4*)(VR + (c0 + j) * 512 + hc + 32 * vq); rr[0] = p[0]; rr[1] = p[1]; rr[2] = p[2]; rr[3] = p[3]; }
    bf16x8 qf[4];
#pragma unroll
    for (int ks = 0; ks < 4; ++ks) qf[ks] = *(const bf16x8*)(QR + qrow * 512 + hc + 32 * ks + 8 * g);
    bf16x8 kf[8][4];
#pragma unroll
    for (int jt = 0; jt < 8; ++jt) if (jt <= wave) { const bf16_t* kp = KR + (c0 + 16 * jt + ln) * 512 + hc + 8 * g;
#pragma unroll
        for (int ks = 0; ks < 4; ++ks) kf[jt][ks] = *(const bf16x8*)(kp + 32 * ks); }
    u32x2 gw[8];
#pragma unroll
    for (int vt = 0; vt < 8; ++vt) gw[vt] = *(const u32x2*)(GR + qrow * 512 + hc + 16 * vt + 4 * g);
    { const int j = tid & 127, vq = tid >> 7;
#pragma unroll
      for (int i = 0; i < 4; ++i)
#pragma unroll
          for (int e = 0; e < 4; ++e) { const unsigned w = rr[i][e]; const int v = 32 * vq + 8 * i + 2 * e;
              *(unsigned short*)(lds + v * PT + 2 * j) = (unsigned short)(w & 0xffffu); *(unsigned short*)(lds + (v + 1) * PT + 2 * j) = (unsigned short)(w >> 16); } }
    __syncthreads();
    f32x4 sT[8];
#pragma unroll
    for (int jt = 0; jt < 8; ++jt) {
        f32x4 d = (f32x4){0.f, 0.f, 0.f, 0.f};
        if (jt <= wave) {
#pragma unroll
            for (int ks = 0; ks < 4; ++ks) d = mfma16(kf[jt][ks], qf[ks], d);
            if (jt == wave) {
#pragma unroll
                for (int r = 0; r < 4; ++r) if (4 * g + r > ln) d[r] = 0.f;
            }
        }
        sT[jt] = d;
    }
    f32x4 oT[8];
    const bf16_t* stp = STATE + (((size_t)b * 4 + h) * 32 + n) * 16384;
#pragma unroll
    for (int vt = 0; vt < 8; ++vt) {
        f32x4 d = (f32x4){0.f, 0.f, 0.f, 0.f};
#pragma unroll
        for (int ks = 0; ks < 4; ++ks) d = mfma16(*(const bf16x8*)(stp + (16 * vt + ln) * 128 + 32 * ks + 8 * g), qf[ks], d);
        oT[vt] = d;
    }
#pragma unroll
    for (int pr = 0; pr < 4; ++pr) if (2 * pr <= wave) {
        u32x4 pw; pw.x = pk2(sT[2 * pr][0], sT[2 * pr][1]); pw.y = pk2(sT[2 * pr][2], sT[2 * pr][3]); pw.z = pk2(sT[2 * pr + 1][0], sT[2 * pr + 1][1]); pw.w = pk2(sT[2 * pr + 1][2], sT[2 * pr + 1][3]);
        const bf16x8 bfr = __builtin_bit_cast(bf16x8, pw);
#pragma unroll
        for (int vt = 0; vt < 8; ++vt) {
            const unsigned char* vp = lds + (16 * vt + ln) * PT + 2 * (32 * pr + 4 * g);
            const u32x2 lo = *(const u32x2*)vp, h2 = *(const u32x2*)(vp + 32); const u32x4 av = (u32x4){lo.x, lo.y, h2.x, h2.y};
            oT[vt] = mfma16(__builtin_bit_cast(bf16x8, av), bfr, oT[vt]);
        }
    }
    float s = 0.f;
#pragma unroll
    for (int vt = 0; vt < 8; ++vt) s += (oT[vt][0] + oT[vt][1]) + (oT[vt][2] + oT[vt][3]);
    s += __shfl_xor(s, 16); s += __shfl_xor(s, 32);
    const float mean = s * (1.0f / 128.0f);
    float q = 0.f;
#pragma unroll
    for (int vt = 0; vt < 8; ++vt)
#pragma unroll
        for (int r = 0; r < 4; ++r) { const float d = oT[vt][r] - mean; q += d * d; }
    q += __shfl_xor(q, 16); q += __shfl_xor(q, 32);
    const float rstd = 1.0f / sqrtf(q * (1.0f / 128.0f) + EPS);
#pragma unroll
    for (int vt = 0; vt < 8; ++vt) {
        const float y0 = (oT[vt][0] - mean) * rstd * bf_lo(gw[vt].x), y1 = (oT[vt][1] - mean) * rstd * bf_hi(gw[vt].x);
        const float y2 = (oT[vt][2] - mean) * rstd * bf_lo(gw[vt].y), y3 = (oT[vt][3] - mean) * rstd * bf_hi(gw[vt].y);
        u32x2 w; w.x = pk2(y0, y1); w.y = pk2(y2, y3);
        *(u32x2*)(AR + qrow * 1024 + 512 + hc + 16 * vt + 4 * g) = w;
    }
    __syncthreads();
}

template <int N> __device__ __forceinline__ void bitonic_sort_desc(unsigned (&a)[N]) {
#pragma unroll
    for (int k = 2; k <= N; k <<= 1)
#pragma unroll
        for (int j = k >> 1; j > 0; j >>= 1)
#pragma unroll
            for (int i = 0; i < N; ++i) { const int l = i ^ j;
                if (l > i) { const unsigned x = a[i], y = a[l]; const unsigned mx = x > y ? x : y, mn = x > y ? y : x;
                    if ((i & k) == 0) { a[i] = mx; a[l] = mn; } else { a[i] = mn; a[l] = mx; } } }
}
template <int N> __device__ __forceinline__ void bitonic_merge_desc(unsigned (&a)[N]) {
#pragma unroll
    for (int j = N >> 1; j > 0; j >>= 1)
#pragma unroll
        for (int i = 0; i < N; ++i) { const int l = i ^ j;
            if (l > i) { const unsigned x = a[i], y = a[l]; a[i] = x > y ? x : y; a[l] = x > y ? y : x; } }
}
__device__ __forceinline__ void top16_merge(unsigned (&best)[16], const unsigned (&grp)[16]) {
#pragma unroll
    for (int i = 0; i < 16; ++i) { const unsigned x = best[i], y = grp[15 - i]; best[i] = x > y ? x : y; }
    bitonic_merge_desc<16>(best);
}
struct CandTab { int a[64], b[64], n; constexpr CandTab() : a{}, b{}, n(0) { for (int x = 0; x < 16; ++x) for (int y = 0; y < 16; ++y) if ((x + 1) * (y + 1) <= 16) { a[n] = x; b[n] = y; ++n; } } };
constexpr CandTab kCand{};
static_assert(kCand.n == 50, "staircase candidates");

constexpr int PL_EID = 0, PL_GATE = 16384, PL_IDX = 32768;
__device__ __forceinline__ void peer_unit(int unit, unsigned char* ws, float* outp, const float* gffn, const float* gfin, unsigned char* lds, int tid, int wave, int lane) {
    volatile LAS unsigned* MISC = (volatile LAS unsigned*)((LAS unsigned char*)lds + MISC_OFF); const int bid = unit;
    TSTAMP(70, 0);
    const bf16_t* SC = (const bf16_t*)(ws + WS_SC);
    const float* mod = (const float*)(ws + WS_MOD);
#ifndef DBG_NOPEER
    {
        const int tl = tid >> 4, h = (tid >> 1) & 7, p = tid & 1;
        const size_t row = (size_t)32 * unit + tl;
        const u32x4* sp = (const u32x4*)(SC + row * 2048 + h * 256 + p * 128);
        unsigned best[16];
#pragma unroll
        for (int grp = 0; grp < 8; ++grp) {
            unsigned k[16];
#pragma unroll
            for (int q4 = 0; q4 < 2; ++q4) { const u32x4 v = sp[2 * grp + q4];
#pragma unroll
                for (int e = 0; e < 4; ++e) { const int n0 = 16 * grp + 8 * q4 + 2 * e;
                    k[8 * q4 + 2 * e] = (sortable32(bf_lo(v[e])) & ~127u) | (unsigned)(127 - n0);
                    k[8 * q4 + 2 * e + 1] = (sortable32(bf_hi(v[e])) & ~127u) | (unsigned)(127 - (n0 + 1)); } }
            bitonic_sort_desc<16>(k);
            if (grp == 0) {
#pragma unroll
                for (int i = 0; i < 16; ++i) best[i] = k[i];
            } else top16_merge(best, k);
        }
        unsigned char* il = lds + PL_IDX + (tl * 8 + h) * 32;
#pragma unroll
        for (int i = 0; i < 4; ++i) { unsigned w = 0;
#pragma unroll
            for (int e = 0; e < 4; ++e) w |= (127u - (best[4 * i + e] & 127u)) << (8 * e);
            *(unsigned*)(il + p * 16 + 4 * i) = w; }
        float v1[16], v2[16];
#pragma unroll
        for (int i = 0; i < 16; ++i) { const unsigned o = __shfl_xor(best[i], 1); const float mine = unsortable32(best[i] & ~127u), oth = unsortable32(o & ~127u);
            v1[i] = p ? oth : mine; v2[i] = p ? mine : oth; }
        unsigned top[16];
#pragma unroll
        for (int grp = 0; grp < 4; ++grp) {
            unsigned k[16];
#pragma unroll
            for (int i = 0; i < 16; ++i) { const int c = 16 * grp + i;
                k[i] = (c < kCand.n) ? ((sortable32(v1[kCand.a[c < kCand.n ? c : 0]] + v2[kCand.b[c < kCand.n ? c : 0]]) & ~255u) | (unsigned)(255 - (16 * kCand.a[c < kCand.n ? c : 0] + kCand.b[c < kCand.n ? c : 0]))) : 0u; }
            bitonic_sort_desc<16>(k);
            if (grp == 0) {
#pragma unroll
                for (int i = 0; i < 16; ++i) top[i] = k[i];
            } else top16_merge(top, k);
        }
        float ts[16], es[16], sum = 0.f;
#pragma unroll
        for (int i = 0; i < 16; ++i) ts[i] = unsortable32(top[i] & ~255u);
#pragma unroll
        for (int i = 0; i < 16; ++i) { es[i] = __expf(ts[i] - ts[0]); sum += es[i]; }
        const float rs = 1.0f / sum;
        __builtin_amdgcn_wave_barrier(); asm volatile("s_waitcnt lgkmcnt(0)" ::: "memory");
        unsigned* eo = (unsigned*)(lds + PL_EID) + tl * 128 + h * 16;
        float* go = (float*)(lds + PL_GATE) + tl * 128 + h * 16;
#pragma unroll
        for (int i = 0; i < 16; ++i) {
            const unsigned flat = 255u - (top[i] & 255u);
            const unsigned i1 = il[flat >> 4], i2 = il[16 + (flat & 15u)];
            eo[i] = i1 * 128u + i2; go[i] = es[i] * rs;
        }
    }
#endif
    __syncthreads();
    TSTAMP(70, 2); TSTAMP(71, 0);
    const unsigned char* U8 = ws + WS_U8; const unsigned char* V8 = ws + WS_V8;
    const float* USC = (const float*)(ws + WS_USC); const float* VSC = (const float*)(ws + WS_VSC);
    const int me = ((lane >> 5) & 1) * 4 + ((lane >> 4) & 1) * 2 + ((lane >> 3) & 1);
#pragma unroll 1
    for (int ti = 0; ti < 4; ++ti) {
        const int tl = wave + 8 * ti; const size_t row = (size_t)32 * unit + tl; const int b = (int)(row >> 12);
        const float* mb = mod + b * 6144;
        float x1v[16]; f32x2 hv2[8], acc2[8];
        const float rstd = pg8::row_rstd((const float*)(ws + WS_SUMSQ), (int)row);
#pragma unroll
        for (int q4 = 0; q4 < 4; ++q4) { const int c = 16 * lane + 4 * q4;
            const f32x4 xv = *(const f32x4*)(outp + row * DM + c), g = *(const f32x4*)(gffn + c), sc = *(const f32x4*)(mb + 4096 + c), sh = *(const f32x4*)(mb + 3072 + c);
            float hq[4];
#pragma unroll
            for (int e = 0; e < 4; ++e) { x1v[4 * q4 + e] = xv[e]; hq[e] = xv[e] * rstd * g[e] * (1.0f + sc[e]) + sh[e]; }
            hv2[2 * q4] = (f32x2){hq[0], hq[1]}; hv2[2 * q4 + 1] = (f32x2){hq[2], hq[3]}; acc2[2 * q4] = (f32x2){0.f, 0.f}; acc2[2 * q4 + 1] = (f32x2){0.f, 0.f}; }
        const unsigned* el = (const unsigned*)(lds + PL_EID) + tl * 128; const float* gl = (const float*)(lds + PL_GATE) + tl * 128;
        u32x4 uA[8], vA[8]; float guA, gvA;
#define PEER_LOAD(U_, V_, GU_, GV_, e0_) do { _Pragma("unroll") for (int k = 0; k < 8; ++k) { const unsigned eid = el[(e0_) + k]; \
            U_[k] = *((const u32x4*)(U8 + (size_t)eid * 1024) + lane); V_[k] = *((const u32x4*)(V8 + (size_t)eid * 1024) + lane); } \
        { const unsigned em = el[(e0_) + me]; GU_ = USC[em]; GV_ = VSC[em] * gl[(e0_) + me]; } } while (0)
#define PEER_COMP(U_, V_, GU_, GV_) do { float pd[8]; \
        _Pragma("unroll") for (int k = 0; k < 8; ++k) { f32x2 d2 = (f32x2){0.f, 0.f}; \
            _Pragma("unroll") for (int i = 0; i < 4; ++i) { const f32x2 lo = __builtin_amdgcn_cvt_pk_f32_fp8(U_[k][i], false), hi2 = __builtin_amdgcn_cvt_pk_f32_fp8(U_[k][i], true); \
                d2 = __builtin_elementwise_fma(hv2[2 * i], lo, d2); d2 = __builtin_elementwise_fma(hv2[2 * i + 1], hi2, d2); } \
            pd[k] = d2.x + d2.y; } \
        float q4_[4], r2_[2], s_; \
        _Pragma("unroll") for (int k = 0; k < 4; ++k) { const float keep = (lane & 32) ? pd[k + 4] : pd[k], send = (lane & 32) ? pd[k] : pd[k + 4]; q4_[k] = keep + __shfl_xor(send, 32); } \
        _Pragma("unroll") for (int k = 0; k < 2; ++k) { const float keep = (lane & 16) ? q4_[k + 2] : q4_[k], send = (lane & 16) ? q4_[k] : q4_[k + 2]; r2_[k] = keep + __shfl_xor(send, 16); } \
        { const float keep = (lane & 8) ? r2_[1] : r2_[0], send = (lane & 8) ? r2_[0] : r2_[1]; s_ = keep + __shfl_xor(send, 8); } \
        s_ += __shfl_xor(s_, 4); s_ += __shfl_xor(s_, 2); s_ += __shfl_xor(s_, 1); \
        const float cf_ = GV_ * gelu_exact(s_ * GU_); \
        _Pragma("unroll") for (int k = 0; k < 8; ++k) { const float c = __uint_as_float((unsigned)__builtin_amdgcn_readlane((int)__float_as_uint(cf_), 32 * (k >> 2) + 16 * ((k >> 1) & 1) + 8 * (k & 1))); \
            const f32x2 c2 = (f32x2){c, c}; \
            _Pragma("unroll") for (int i = 0; i < 4; ++i) { const f32x2 lo = __builtin_amdgcn_cvt_pk_f32_fp8(V_[k][i], false), hi2 = __builtin_amdgcn_cvt_pk_f32_fp8(V_[k][i], true); \
                acc2[2 * i] = __builtin_elementwise_fma(c2, lo, acc2[2 * i]); acc2[2 * i + 1] = __builtin_elementwise_fma(c2, hi2, acc2[2 * i + 1]); } } } while (0)
#pragma unroll 1
        for (int e0 = 0; e0 < 128; e0 += 8) {
            PEER_LOAD(uA, vA, guA, gvA, e0);
            PEER_COMP(uA, vA, guA, gvA);
        }
#undef PEER_LOAD
#undef PEER_COMP
        float ss = 0.f;
#pragma unroll
        for (int q4 = 0; q4 < 4; ++q4) { const int c = 16 * lane + 4 * q4; const f32x4 gf = *(const f32x4*)(mb + 5120 + c);
#pragma unroll
            for (int e = 0; e < 4; ++e) { const int i = 4 * q4 + e; const float av = (e < 2) ? acc2[2 * q4][e] : acc2[2 * q4 + 1][e - 2]; x1v[i] = x1v[i] + gf[e] * av; ss += x1v[i] * x1v[i]; } }
        const float r2 = 1.0f / sqrtf(wave_sum(ss) * (1.0f / DM) + EPS);
#pragma unroll
        for (int q4 = 0; q4 < 4; ++q4) { const int c = 16 * lane + 4 * q4; const f32x4 gn = *(const f32x4*)(gfin + c);
            f32x4 o;
#pragma unroll
            for (int e = 0; e < 4; ++e) o[e] = x1v[4 * q4 + e] * r2 * gn[e];
            *(f32x4*)(outp + row * DM + c) = o; }
    }
    __syncthreads();
    TSTAMP(71, 2);
}

#define XB_TMO      128
#define XB_XCNT(j)  (256  + 64 * (j))
#define XB_XSUB(j)  (1280 + 64 * (j))
#define XB_XGEN(j)  (2304 + 64 * (j))
#define XB_TOP      3328
#define XB_TOPGEN   3392
#define XCD_BAR_WORDS 3456
#define XB_SPIN_CAP (1u << 18)

__device__ __forceinline__ unsigned xb_ld(unsigned* p)              { return __hip_atomic_load(p, __ATOMIC_RELAXED, __HIP_MEMORY_SCOPE_AGENT); }
__device__ __forceinline__ unsigned xb_add(unsigned* p, unsigned v) { return __hip_atomic_fetch_add(p, v, __ATOMIC_RELAXED, __HIP_MEMORY_SCOPE_AGENT); }
__device__ __forceinline__ unsigned xb_xcc_id() { return (unsigned)__builtin_amdgcn_s_getreg((3 << 11) | 20) & 0xFu; }
#define XB_SPIN(cond, bar) do { unsigned _sp = 0; while (cond) { __builtin_amdgcn_s_sleep(1); \
    if ((++_sp & 255u) == 0u) { if (xb_ld(&(bar)[XB_TMO])) break; if (_sp > XB_SPIN_CAP) { atomicAdd(&(bar)[XB_TMO], 1u); break; } } } } while (0)

struct XcdBarrier {
    unsigned* bar; unsigned x;
    volatile LAS unsigned* st;
};

__device__ __forceinline__ XcdBarrier xcd_barrier_post(unsigned* bar, volatile LAS unsigned* st) {
    XcdBarrier b; b.bar = bar; b.x = xb_xcc_id(); b.st = st;
    if (threadIdx.x == 0) (void)xb_add(&bar[XB_XCNT(b.x)], 1u);
    return b;
}
__device__ __forceinline__ void xcd_barrier_complete(unsigned* bar, unsigned x, unsigned& nloc, unsigned& nx) {
    const unsigned G = gridDim.x * gridDim.y * gridDim.z;
    unsigned sum, cnt, mine, sp = 0u;
    for (;;) {
        sum = 0u; cnt = 0u; mine = 0u;
#pragma unroll
        for (unsigned j = 0; j < 16; ++j) { const unsigned c = xb_ld(&bar[XB_XCNT(j)]); sum += c; cnt += (c > 0u) ? 1u : 0u; mine = (j == x) ? c : mine; }
        if (sum == G) break;
        __builtin_amdgcn_s_sleep(1);
        if ((++sp & 255u) == 0u) { if (xb_ld(&bar[XB_TMO])) break; if (sp > XB_SPIN_CAP) { atomicAdd(&bar[XB_TMO], 1u); break; } }
    }
    nloc = mine > 0u ? mine : 1u; nx = cnt > 0u ? cnt : 1u;
}

__device__ __forceinline__ void xcd_barrier(const XcdBarrier& b) {
    asm volatile("s_waitcnt vmcnt(0)" ::: "memory");
    __syncthreads();
    if (threadIdx.x == 0) {
        unsigned* bar = b.bar;
        __builtin_amdgcn_s_waitcnt(0);
        unsigned nloc = b.st[0], nx = b.st[1];
        if (nloc == 0u) { xcd_barrier_complete(bar, b.x, nloc, nx); b.st[0] = nloc; b.st[1] = nx; }
        const unsigned old = xb_add(&bar[XB_XSUB(b.x)], 1u);
        const unsigned gen = old / nloc;
        if (old + 1u == (gen + 1u) * nloc) {
            __builtin_amdgcn_fence(__ATOMIC_RELEASE, "agent");
            asm volatile("s_waitcnt vmcnt(0)" ::: "memory");
            const unsigned og = xb_add(&bar[XB_TOP], 1u);
            const unsigned tg = og / nx;
            if (og + 1u == (tg + 1u) * nx) xb_add(&bar[XB_TOPGEN], 1u);
            else XB_SPIN(xb_ld(&bar[XB_TOPGEN]) == tg, bar);
            __builtin_amdgcn_fence(__ATOMIC_ACQUIRE, "agent");
            xb_add(&bar[XB_XGEN(b.x)], 1u);
            asm volatile("s_waitcnt vmcnt(0)" ::: "memory");
        } else {
            XB_SPIN(xb_ld(&bar[XB_XGEN(b.x)]) == gen, bar);
            __builtin_amdgcn_fence(__ATOMIC_ACQUIRE, "agent");
            asm volatile("s_waitcnt vmcnt(0)" ::: "memory");
        }
    }
    __syncthreads();
}

constexpr int N_PHASES = 8;
__global__ void __launch_bounds__(NTHREADS, 2) mega(Args a) {
    extern __shared__ __attribute__((aligned(16))) unsigned char lds[];
    const int tid = threadIdx.x, lane = tid & 63, wave = __builtin_amdgcn_readfirstlane(tid >> 6);
    const int bid = blockIdx.x, G = gridDim.x;
    unsigned char* ws = a.ws;
    const int lo = a.ph_lo, hi = a.ph_hi;
    volatile LAS unsigned* MISC = (volatile LAS unsigned*)((LAS unsigned char*)lds + MISC_OFF);
    if (tid < 16) MISC[tid] = 0u;
    __syncthreads();
    XcdBarrier bar; bar.bar = (unsigned*)(ws + WS_CTL) + CW_BAR; bar.x = 0; bar.st = nullptr;
    if (hi - lo > 1) bar = xcd_barrier_post((unsigned*)(ws + WS_CTL) + CW_BAR, MISC + 8);
#ifndef PH_MASK
#define PH_MASK 0xFF
#endif
#define IN(k) (((PH_MASK >> (k)) & 1) && lo <= (k) && (k) < hi)
#define SEAM(k) do { if (IN(k) && IN((k) + 1)) { xcd_barrier(bar); } } while (0)
#ifdef REP_PH
#ifndef REP_N
#define REP_N 1
#endif
#define REPS(k) for (int rep_ = 0; rep_ < ((k) == REP_PH ? 1 + REP_N : 1); ++rep_, ((k) == REP_PH && rep_ <= REP_N ? (xcd_barrier(bar), 0) : 0))
#else
#define REPS(k)
#endif

    TSTAMP(100, 0);
    TSTAMP(0, 0);
    REPS(0) if (IN(0)) phase0(a, lds, tid, wave, lane, bid, G);
    SEAM(0);
    TSTAMP(0, 2);
    TSTAMP(1, 0);
    REPS(1) if (IN(1)) phase1(a, wave, lane, bid, G);
    SEAM(1);
    TSTAMP(1, 2);
    TSTAMP(2, 0);
    REPS(2) if (IN(2)) {
        pg8::Gemm g{(const bf16_t*)(ws + WS_BUFA), (const bf16_t*)(ws + WS_WIN), MTOK, N1, DM}; pg8::StaticOrder S; S.init(MTOK, N1, G, bid);
        pg8::Epi1 E{ws};
        pg8::gemm_phase<pg8::Epi1, pg8::StaticOrder, true, true>((LAS unsigned char*)lds, g, S, E);
        const int nfull = (MTOK / 256) * (N1 / 256) - 4 * G;
        { const bool tail = nfull > 0 && nfull < G; const int cw = tail ? (bid - nfull) * 8 + wave : bid * 8 + wave, NCW = tail ? (G - nfull) * 8 : G * 8;
          if (!tail || bid >= nfull)
              for (int it = cw; it < 4096; it += NCW) { const int r = 4 * it;
                  rows_to_fp8<4>(a.in[11] + (size_t)r * 1024, ws + WS_V8 + (size_t)r * 1024, (float*)(ws + WS_VSC) + r, lane); } }
    }
    SEAM(2);
    TSTAMP(2, 2);
    TSTAMP(3, 0);
    REPS(3) if (IN(3)) {
        TSTAMP(30, 0);
        const int vcu3 = (G % 8 == 0) ? (bid % 8) * (G / 8) + bid / 8 : bid;
        for (int u = vcu3; u < 256; u += G)
            ret_state_unit(u >> 6, (u >> 4) & 3, (u >> 1) & 7, u & 1, (const bf16_t*)(ws + WS_KR), (const bf16_t*)(ws + WS_VR), (bf16_t*)(ws + WS_STATE), lds, tid, wave, lane);
        TSTAMP(30, 2); TSTAMP(31, 0);
        for (int k = vcu3; k < 256; k += G) {
            const int b = k >> 6, j = k & 63;
#pragma unroll 1
            for (int i = 0; i < 4; ++i) {
                const int qt = (i == 0) ? j : (i == 1) ? 127 - j : (i == 2) ? 128 + j : 255 - j;
                idx_unit(b, qt, (const bf16_t*)(ws + WS_QI), (const bf16_t*)(ws + WS_KI), (const float*)(ws + WS_WI), (unsigned long long*)(ws + WS_MASK), lds, wave, lane, bid == TPROBE_B && i == TPROBE_I);
            }
        }
        TSTAMP(31, 2);
    }
    SEAM(3);
    TSTAMP(3, 2);
    TSTAMP(4, 0);
    REPS(4) if (IN(4)) {
        TSTAMP(40, 0);
        const int vcu = (G % 8 == 0) ? (bid % 8) * (G / 8) + bid / 8 : bid;
        for (int k = vcu; k < 256; k += G) {
            const int bh = k >> 3, s = k & 7;
#pragma unroll 1
            for (int i = 0; i < 2; ++i)
                attn_unit(bh >> 3, bh & 7, i ? 15 - s : s, (const bf16_t*)(ws + WS_QA), (const bf16_t*)(ws + WS_KA), (const bf16_t*)(ws + WS_VA), (const unsigned long long*)(ws + WS_MASK),
                          (bf16_t*)(ws + WS_BUFB), lds, tid, wave, lane);
        }
        TSTAMP(40, 2); TSTAMP(41, 0);
        for (int u = vcu; u < 256; u += G) {
            const int xg = u >> 5, ci = u & 31;
#pragma unroll 1
            for (int jj = 0; jj < 2; ++jj) { const int bh2 = 2 * xg + jj;
                ret_out_unit(bh2 >> 2, bh2 & 3, ci, (const bf16_t*)(ws + WS_QR), (const bf16_t*)(ws + WS_KR), (const bf16_t*)(ws + WS_VR), (const bf16_t*)(ws + WS_GR),
                             (const bf16_t*)(ws + WS_STATE), (bf16_t*)(ws + WS_BUFB), lds, tid, wave, lane); }
        }
        TSTAMP(41, 2);
    }
    SEAM(4);
    TSTAMP(4, 2);
    TSTAMP(5, 0);
    REPS(5) if (IN(5)) {
        pg8::Gemm g{(const bf16_t*)(ws + WS_BUFB), (const bf16_t*)(ws + WS_WOUT), MTOK, DM, DM}; pg8::StaticOrder S; S.init(MTOK, DM, G, bid);
        pg8::Epi2 E{a.in[0], a.out, (bf16_t*)(ws + WS_BUFA), (const float*)(ws + WS_MOD), a.in[7], (float*)(ws + WS_SUMSQ)};
        pg8::gemm_phase<pg8::Epi2, pg8::StaticOrder, true, true>((LAS unsigned char*)lds, g, S, E);
    }
    SEAM(5);
    TSTAMP(5, 2);
    TSTAMP(6, 0);
    REPS(6) if (IN(6)) {
        pg8::Gemm g{(const bf16_t*)(ws + WS_BUFA), (const bf16_t*)(ws + WS_WPQ), MTOK, 2048, DM}; pg8::StaticOrder S; S.init(MTOK, 2048, G, bid);
        pg8::Epi3 E{(const float*)(ws + WS_SUMSQ), (const float*)(ws + WS_BIASF), (bf16_t*)(ws + WS_SC)};
        pg8::gemm_phase<pg8::Epi3, pg8::StaticOrder, true, true>((LAS unsigned char*)lds, g, S, E);
    }
    SEAM(6);
    TSTAMP(6, 2);
    TSTAMP(7, 0);
    if (IN(7)) {
        for (int u = bid; u < 512; u += G) peer_unit(u, ws, a.out, a.in[7], a.in[12], lds, tid, wave, lane);
    }
    TSTAMP(7, 2);
    TSTAMP(100, 2);
#ifdef TIME_PH
    if (bid == TPROBE_B && tid == 0) {
        const unsigned long long t0_ = ((unsigned long long)MISC[1] << 32) | MISC[0], t1_ = ((unsigned long long)MISC[3] << 32) | MISC[2];
        const unsigned long long until_ = __builtin_amdgcn_s_memrealtime() + (unsigned long long)TIME_AMP * (t1_ - t0_);
        while (__builtin_amdgcn_s_memrealtime() < until_) __builtin_amdgcn_s_sleep(8);
    }
#endif
#undef IN
#undef SEAM
}

extern "C" void kernel_launch(void* const* d_in, const int* in_sizes, int n_in, void* d_out, int out_size, void* d_ws, size_t ws_size, hipStream_t stream) {
    static int grid = 0;
    if (grid == 0) {
        if (n_in != 13 || out_size != MTOK * DM || ws_size < WS_END) { fprintf(stderr, "kernel_launch: unexpected shapes (n_in %d, out %d, ws %zu); nothing launched\n", n_in, out_size, ws_size); grid = -1; return; }
        int dev = 0, cus = 0, per_cu = 0;
        if (hipGetDevice(&dev) != hipSuccess || hipDeviceGetAttribute(&cus, hipDeviceAttributeMultiprocessorCount, dev) != hipSuccess) { grid = -1; return; }
        if (hipFuncSetAttribute((const void*)mega, hipFuncAttributeMaxDynamicSharedMemorySize, LDS_BYTES) != hipSuccess) { fprintf(stderr, "kernel_launch: hipFuncSetAttribute failed\n"); grid = -1; return; }
        if (hipOccupancyMaxActiveBlocksPerMultiprocessor(&per_cu, (const void*)mega, NTHREADS, LDS_BYTES) != hipSuccess || per_cu < 1) { fprintf(stderr, "kernel_launch: occupancy query gave %d\n", per_cu); per_cu = 1; }
        (void)hipGetLastError();
        grid = cus;
    }
    if (grid < 0) return;
    if (hipMemsetAsync((char*)d_ws + WS_CTL + (size_t)CW_BAR * 4, 0, (size_t)XCD_BAR_WORDS * 4, stream) != hipSuccess) { fprintf(stderr, "kernel_launch: memset failed\n"); return; }
    Args a{};
    for (int i = 0; i < 13; ++i) a.in[i] = (const float*)d_in[i];
    a.out = (float*)d_out; a.ws = (unsigned char*)d_ws;
#if MK_MULTI
    for (int p = 0; p < N_PHASES; ++p) { a.ph_lo = p; a.ph_hi = p + 1; hipLaunchKernelGGL(mega, dim3(grid), dim3(NTHREADS), LDS_BYTES, stream, a); }
#else
    a.ph_lo = 0; a.ph_hi = N_PHASES;
    hipLaunchKernelGGL(mega, dim3(grid), dim3(NTHREADS), LDS_BYTES, stream, a);
#endif
}
```

```cpp
#include <hip/hip_runtime.h>
#include <cstdio>
#include <cstdint>

#ifndef MK_MULTI
#define MK_MULTI 0
#endif

#define GAS __attribute__((address_space(1)))
#define LAS __attribute__((address_space(3)))
typedef unsigned short bf16_t;
typedef short bf16x8 __attribute__((ext_vector_type(8)));
typedef float f32x4 __attribute__((ext_vector_type(4)));
typedef float f32x16 __attribute__((ext_vector_type(16)));
typedef unsigned u32x4 __attribute__((ext_vector_type(4)));
typedef unsigned u32x2 __attribute__((ext_vector_type(2)));

constexpr int BATCH = 4, SEQ = 4096, DM = 1024, MTOK = BATCH * SEQ;
constexpr int N1 = 4352;
constexpr int NTHREADS = 512;
constexpr float EPS = 1e-6f;
constexpr float C_QK = 0.18033688011112042f;
constexpr float NEG_INF = -__builtin_huge_valf();

__device__ __forceinline__ float ret_log2g(int h) { return h == 0 ? -0.045803689613124791f : h == 1 ? -0.022720076500083530f : h == 2 ? -0.011315313227834147f : -0.0056465631411420624f; }
__device__ __forceinline__ float ret_gamma(int h) { return h == 0 ? 0.96875f : h == 1 ? 0.984375f : h == 2 ? 0.9921875f : 0.99609375f; }
__device__ __forceinline__ float ret_g128(int h) { return h == 0 ? 0.017183023570817902f : h == 1 ? 0.13321516287964842f : h == 2 ? 0.36643771592203725f : 0.60593708822908032f; }
__device__ __forceinline__ float ret_g127(int h) { return h == 0 ? 0.017737314653747512f : h == 1 ? 0.13532968927456347f : h == 2 ? 0.36932305226788007f : 0.60831331210448848f; }

constexpr size_t MiB = 1u << 20;
constexpr size_t WS_CTL = 0, CTL_BYTES = 1 * MiB;
constexpr size_t WS_SUMSQ = 5 * MiB;
constexpr size_t WS_MOD = 1 * MiB;
constexpr size_t WS_BIASF = 1 * MiB + 128 * 1024;
constexpr size_t WS_COSA = 2 * MiB, WS_SINA = 2 * MiB + 512 * 1024;
constexpr size_t WS_COSR = 3 * MiB, WS_SINR = 4 * MiB;
constexpr size_t WS_WIN = 6 * MiB;
constexpr size_t WS_WOUT = 15 * MiB;
constexpr size_t WS_WPQ = 17 * MiB;
constexpr size_t WS_BUFA = 22 * MiB;
constexpr size_t WS_MASK = WS_BUFA, WS_STATE = WS_BUFA + 8 * MiB;
constexpr size_t WS_BUFB = 54 * MiB;
constexpr size_t WS_G1 = 86 * MiB;
constexpr size_t WS_QA = WS_G1, WS_KA = WS_G1 + 16 * MiB, WS_VA = WS_G1 + 32 * MiB, WS_QI = WS_G1 + 48 * MiB, WS_QR = WS_G1 + 64 * MiB,
                 WS_KR = WS_G1 + 80 * MiB, WS_VR = WS_G1 + 96 * MiB, WS_GR = WS_G1 + 112 * MiB, WS_KI = WS_G1 + 128 * MiB, WS_WI = WS_G1 + 130 * MiB;
constexpr size_t WS_SC = WS_G1;
constexpr size_t WS_U8 = 217 * MiB, WS_V8 = 233 * MiB;
constexpr size_t WS_USC = 249 * MiB, WS_VSC = 249 * MiB + 65536;
constexpr size_t WS_END = 256 * MiB;
static_assert(WS_WI + (size_t)MTOK * 8 * 4 <= WS_U8 && WS_SC + (size_t)MTOK * 2048 * 4 <= WS_U8 && WS_VSC + 65536 <= WS_END, "ws map");
constexpr int LDS_BYTES = 147456;
constexpr int MISC_OFF = LDS_BYTES - 64;
constexpr int CW_BAR = 4096;

__device__ __forceinline__ unsigned f2bf(float f) { unsigned u = __float_as_uint(f); return (u + 0x7fffu + ((u >> 16) & 1u)) >> 16; }
typedef float f32x2_t __attribute__((ext_vector_type(2))); typedef __bf16 bf16x2_t __attribute__((ext_vector_type(2)));
__device__ __forceinline__ unsigned pk2(float lo, float hi) { const f32x2_t v = {lo, hi}; const bf16x2_t b = __builtin_convertvector(v, bf16x2_t); return __builtin_bit_cast(unsigned, b); }
__device__ __forceinline__ float bf_lo(unsigned w) { return __uint_as_float(w << 16); }
__device__ __forceinline__ float bf_hi(unsigned w) { return __uint_as_float(w & 0xffff0000u); }
__device__ __forceinline__ float wave_sum(float v) {
#pragma unroll
    for (int o = 1; o < 64; o <<= 1) v += __shfl_xor(v, o);
    return v;
}
__device__ __forceinline__ float fast_exp2(float x) { return __builtin_amdgcn_exp2f(x); }
__device__ __forceinline__ float gelu_exact(float v) {
    const float av = fabsf(v), t = __builtin_amdgcn_rcpf(av * 0.2316418882f + 1.0f);
    float q = t * 0.5307027145f + (-0.7265760135f); q = q * t + 0.7107068705f; q = q * t + (-0.142248368f); q = q * t + 0.127414796f; q = q * t;
    const float e = fast_exp2(v * v * (-0.72134752044f));
    const float m = v * (q * e);
    return v < 0.f ? m : v - m;
}
__device__ __forceinline__ float silu_f(float v) { return v / (1.0f + __expf(-v)); }
__device__ __forceinline__ unsigned sortable32(float f) { const unsigned u = __float_as_uint(f); return (u & 0x80000000u) ? ~u : (u | 0x80000000u); }
__device__ __forceinline__ float unsortable32(unsigned s) { return __uint_as_float((s & 0x80000000u) ? (s ^ 0x80000000u) : ~s); }
__device__ __forceinline__ unsigned sortable16(float x) {
    const _Float16 h = (_Float16)x; const unsigned b = (unsigned)__builtin_bit_cast(unsigned short, h);
    return (b & 0x8000u) ? (~b & 0xFFFFu) : (b | 0x8000u);
}
__device__ __forceinline__ f32x4 mfma16(bf16x8 a, bf16x8 b, f32x4 c) { return __builtin_amdgcn_mfma_f32_16x16x32_bf16(a, b, c, 0, 0, 0); }
__device__ __forceinline__ f32x16 mfma32(bf16x8 a, bf16x8 b, f32x16 c) { return __builtin_amdgcn_mfma_f32_32x32x16_bf16(a, b, c, 0, 0, 0); }

__host__ __device__ __forceinline__ int win_src_col(int p) {
    const int tile = p >> 8, bj = (p >> 7) & 1, q = p & 127;
    if (tile < 4) return 256 * tile + (q >> 5) * 64 + bj * 32 + (q & 31);
    if (tile < 6) return p;
    if (tile < 8) return 256 * tile + (q >> 5) * 64 + bj * 32 + (q & 31);
    if (tile == 8) { if (q < 32) return 2048 + bj * 32 + q; if (bj == 0 && q < 40) return 2112 + (q - 32); return -1; }
    if (tile < 13) { const int base = (tile < 11) ? 2120 + 256 * (tile - 9) : 2632 + 256 * (tile - 11); return base + (q >> 6) * 128 + bj * 64 + (q & 63); }
    if (tile < 15) return 3144 + (p - 13 * 256);
    return 3656 + (p - 15 * 256);
}
namespace pg8 {
#define PG8_LAS __attribute__((address_space(3)))
typedef unsigned short bf16_t;
typedef short bf16x8 __attribute__((ext_vector_type(8)));
typedef float f32x4 __attribute__((ext_vector_type(4)));
typedef unsigned u32x4 __attribute__((ext_vector_type(4)));
constexpr int BM = 256, BK = 64, HALF = 128, HTB = HALF * BK * 2  , STAGE_BYTES = 8 * HTB, NXCD = 8, WGM = 8;

__host__ __device__ __forceinline__ int lds_byte(int r, int c) { const int st = (r >> 4) * 2 + (c >> 5), rr = r & 15, cc = c & 31, ob = rr * 64 + cc * 2; return st * 1024 + (ob ^ (((ob >> 9) & 1) << 5)); }
__host__ __device__ __forceinline__ void stage_rc(int b, int& R, int& C) { const int st = b / 1024, sb = b % 1024, swz = sb ^ (((sb >> 9) & 1) << 5); R = (st >> 1) * 16 + swz / 64; C = (st & 1) * 32 + (swz % 64) / 2; }
__host__ __device__ __forceinline__ int perm32(int rho) { const int n = rho >> 4, i = rho & 15; return 8 * (i >> 2) + 4 * n + (i & 3); }

struct Unit { int pm, pn; };
struct Gemm { const bf16_t* A; const bf16_t* Bt; int M, N, K; };

struct StaticOrder {
    int nM, nN, nwg, G, c;
    __host__ __device__ void init(int M, int N, int G_, int c_) { nM = M / BM; nN = N / BM; nwg = nM * nN; G = G_; c = c_; }
    __host__ __device__ bool next(int i, Unit& u) const {
        const long L = (long)i * G + c; if (L >= nwg) return false;
        int wgid = (int)L; { const int q = nwg / NXCD, r = nwg % NXCD, xcd = wgid % NXCD, off = wgid / NXCD; wgid = (xcd < r ? xcd * (q + 1) : r * (q + 1) + (xcd - r) * q) + off; }
        const int nig = WGM * nN, gid = wgid / nig, fm = gid * WGM, gsz = (nM - fm) < WGM ? (nM - fm) : WGM;
        u.pm = fm + ((wgid % nig) % gsz); u.pn = (wgid % nig) / gsz; return true;
    }
    __device__ __forceinline__ void a_ready(const Unit&) const {}
    __device__ __forceinline__ void done(const Unit&) const {}
};

__device__ __forceinline__ unsigned cvt_pk_bf16(float lo, float hi) { unsigned r; asm volatile("v_cvt_pk_bf16_f32 %0, %1, %2" : "=v"(r) : "v"(lo), "v"(hi)); return r; }
__device__ __forceinline__ u32x4 pack8(const float (&v)[8]) { u32x4 w; w.x = cvt_pk_bf16(v[0], v[1]); w.y = cvt_pk_bf16(v[2], v[3]); w.z = cvt_pk_bf16(v[4], v[5]); w.w = cvt_pk_bf16(v[6], v[7]); return w; }

struct Epi1 {
    static constexpr bool PERM = true, AFTER_DRAIN = false;
    unsigned char* ws;
    __device__ __forceinline__ void operator()(const f32x4 (&acc)[2][2][4][2], const Unit& u, int wr, int wc, int fr, int fq) const {
        const int tile = u.pn;
        const int row0 = u.pm * BM + wr * 64 + fr;
        const float* cosA = (const float*)(ws + WS_COSA); const float* sinA = (const float*)(ws + WS_SINA);
        const float* cosR = (const float*)(ws + WS_COSR); const float* sinR = (const float*)(ws + WS_SINR);
        if (tile < 4 || tile == 6 || tile == 7) {
            bf16_t* dst = (bf16_t*)(ws + (tile < 2 ? WS_QA : tile < 4 ? WS_KA : WS_QI));
            const int tl = tile < 2 ? tile : tile < 4 ? tile - 2 : tile - 6;
            const float scale = tile < 2 ? C_QK : 1.0f;
            const int cb = 256 * tl + 64 * wc, i0 = 8 * fq;
#pragma unroll
            for (int ai = 0; ai < 2; ++ai)
#pragma unroll
                for (int m = 0; m < 4; ++m) {
                    const int row = row0 + ai * HALF + m * 16, pos = row & (SEQ - 1);
                    const f32x4 c0 = *(const f32x4*)(cosA + pos * 32 + i0), c1 = *(const f32x4*)(cosA + pos * 32 + i0 + 4);
                    const f32x4 s0 = *(const f32x4*)(sinA + pos * 32 + i0), s1 = *(const f32x4*)(sinA + pos * 32 + i0 + 4);
                    float y1[8], y2[8];
#pragma unroll
                    for (int n = 0; n < 2; ++n)
#pragma unroll
                        for (int e = 0; e < 4; ++e) {
                            const float x1 = acc[ai][0][m][n][e], x2 = acc[ai][1][m][n][e];
                            const float c = n ? c1[e] : c0[e], s = n ? s1[e] : s0[e];
                            y1[4 * n + e] = (x1 * c - x2 * s) * scale; y2[4 * n + e] = (x1 * s + x2 * c) * scale;
                        }
                    bf16_t* rp = dst + (size_t)row * 512 + cb + i0;
                    *(u32x4*)rp = pack8(y1); *(u32x4*)(rp + 32) = pack8(y2);
                }
        } else if (tile == 4 || tile == 5 || tile >= 13) {
            bf16_t* dst = (bf16_t*)(ws + (tile < 6 ? WS_VA : tile < 15 ? WS_VR : WS_GR));
            const int tl = tile < 6 ? tile - 4 : tile < 15 ? tile - 13 : tile - 15;
            const bool act = tile >= 15;
#pragma unroll
            for (int ai = 0; ai < 2; ++ai)
#pragma unroll
                for (int m = 0; m < 4; ++m) {
                    const int row = row0 + ai * HALF + m * 16;
#pragma unroll
                    for (int bj = 0; bj < 2; ++bj) {
                        float y[8];
#pragma unroll
                        for (int n = 0; n < 2; ++n)
#pragma unroll
                            for (int e = 0; e < 4; ++e) { const float v = acc[ai][bj][m][n][e]; y[4 * n + e] = act ? silu_f(v) : v; }
                        *(u32x4*)(dst + (size_t)row * 512 + 256 * tl + 128 * bj + 32 * wc + 8 * fq) = pack8(y);
                    }
                }
        } else if (tile == 8) {
#pragma unroll
            for (int ai = 0; ai < 2; ++ai)
#pragma unroll
                for (int m = 0; m < 4; ++m) {
                    const int row = row0 + ai * HALF + m * 16, pos = row & (SEQ - 1);
                    if (wc == 0) {
                        const int i0 = 8 * fq;
                        const f32x4 c0 = *(const f32x4*)(cosA + pos * 32 + i0), c1 = *(const f32x4*)(cosA + pos * 32 + i0 + 4);
                        const f32x4 s0 = *(const f32x4*)(sinA + pos * 32 + i0), s1 = *(const f32x4*)(sinA + pos * 32 + i0 + 4);
                        float y1[8], y2[8];
#pragma unroll
                        for (int n = 0; n < 2; ++n)
#pragma unroll
                            for (int e = 0; e < 4; ++e) {
                                const float x1 = acc[ai][0][m][n][e], x2 = acc[ai][1][m][n][e];
                                const float c = n ? c1[e] : c0[e], s = n ? s1[e] : s0[e];
                                y1[4 * n + e] = x1 * c - x2 * s; y2[4 * n + e] = x1 * s + x2 * c;
                            }
                        bf16_t* rp = (bf16_t*)(ws + WS_KI) + (size_t)row * 64 + i0;
                        *(u32x4*)rp = pack8(y1); *(u32x4*)(rp + 32) = pack8(y2);
                    } else if (wc == 1 && fq == 0) {
                        const float sw = 0.35355339059327379f;
                        float* WI = (float*)(ws + WS_WI);
                        *(f32x4*)(WI + (size_t)row * 8) = acc[ai][0][m][0] * sw;
                        *(f32x4*)(WI + (size_t)row * 8 + 4) = acc[ai][0][m][1] * sw;
                    }
                }
        } else {
            const bool isk = tile >= 11;
            bf16_t* dst = (bf16_t*)(ws + (isk ? WS_KR : WS_QR));
            const int tl = isk ? tile - 11 : tile - 9, hl = wc >> 1, h = 2 * tl + hl;
            const int i0 = 32 * (wc & 1) + 8 * fq, cb = 256 * tl + 128 * hl;
            const float lg = isk ? -ret_log2g(h) : ret_log2g(h);
            const float base = isk ? 0.08838834764831845f : 1.0f;
#pragma unroll
            for (int ai = 0; ai < 2; ++ai)
#pragma unroll
                for (int m = 0; m < 4; ++m) {
                    const int row = row0 + ai * HALF + m * 16, pos = row & (SEQ - 1);
                    const float dec = base * fast_exp2(lg * (float)(pos & 127));
                    const f32x4 c0 = *(const f32x4*)(cosR + pos * 64 + i0), c1 = *(const f32x4*)(cosR + pos * 64 + i0 + 4);
                    const f32x4 s0 = *(const f32x4*)(sinR + pos * 64 + i0), s1 = *(const f32x4*)(sinR + pos * 64 + i0 + 4);
                    float y1[8], y2[8];
#pragma unroll
                    for (int n = 0; n < 2; ++n)
#pragma unroll
                        for (int e = 0; e < 4; ++e) {
                            const float x1 = acc[ai][0][m][n][e], x2 = acc[ai][1][m][n][e];
                            const float c = n ? c1[e] : c0[e], s = n ? s1[e] : s0[e];
                            y1[4 * n + e] = (x1 * c - x2 * s) * dec; y2[4 * n + e] = (x1 * s + x2 * c) * dec;
                        }
                    bf16_t* rp = dst + (size_t)row * 512 + cb + i0;
                    *(u32x4*)rp = pack8(y1); *(u32x4*)(rp + 64) = pack8(y2);
                }
        }
    }
};

__device__ __forceinline__ float row_rstd(const float* sumsq, int row) {
    const f32x4* p = (const f32x4*)(sumsq + (size_t)row * 16);
    const f32x4 a = p[0], b = p[1], c = p[2], d = p[3];
    const float s = (((a[0] + a[1]) + (a[2] + a[3])) + ((b[0] + b[1]) + (b[2] + b[3]))) + (((c[0] + c[1]) + (c[2] + c[3])) + ((d[0] + d[1]) + (d[2] + d[3])));
    return 1.0f / sqrtf(s * (1.0f / DM) + EPS);
}
struct Epi2 {
    static constexpr bool PERM = false, AFTER_DRAIN = false;
    const float* x; float* x1; bf16_t* a3; const float* mod; const float* gffn; float* sumsq;
    __device__ __forceinline__ void operator()(const f32x4 (&acc)[2][2][4][2], const Unit& u, int wr, int wc, int fr, int fq) const {
        const int row0 = u.pm * BM + wr * 64 + fr, col0 = u.pn * BM + wc * 32 + 4 * fq;
#pragma unroll
        for (int ai = 0; ai < 2; ++ai)
#pragma unroll
            for (int m = 0; m < 4; ++m) {
                const int row = row0 + ai * HALF + m * 16, b = row >> 12;
                const float* mb = mod + b * 6144;
                float ss = 0.f;
#pragma unroll
                for (int bj = 0; bj < 2; ++bj)
#pragma unroll
                    for (int n = 0; n < 2; ++n) {
                        const int c = col0 + bj * HALF + n * 16;
                        const f32x4 xv = *(const f32x4*)(x + (size_t)row * DM + c), gt = *(const f32x4*)(mb + 2048 + c);
#ifdef DBG_NOMIX
                        const f32x4 v = xv;
#else
                        const f32x4 v = xv + gt * acc[ai][bj][m][n];
#endif
                        *(f32x4*)(x1 + (size_t)row * DM + c) = v;
                        ss += (v[0] * v[0] + v[1] * v[1]) + (v[2] * v[2] + v[3] * v[3]);
                        const f32x4 gs = *(const f32x4*)(gffn + c) * (*(const f32x4*)(mb + 4096 + c) + 1.0f);
                        const f32x4 a = v * gs;
                        u32x2 w; w.x = cvt_pk_bf16(a[0], a[1]); w.y = cvt_pk_bf16(a[2], a[3]);
                        *(u32x2*)(a3 + (size_t)row * DM + c) = w;
                    }
                ss += __shfl_xor(ss, 16); ss += __shfl_xor(ss, 32);
                if (fq == 0) sumsq[(size_t)row * 16 + u.pn * 4 + wc] = ss;
            }
    }
};

struct Epi3 {
    static constexpr bool PERM = true, AFTER_DRAIN = false;
    const float* sumsq; const float* biasf; bf16_t* sc;
    __device__ __forceinline__ void operator()(const f32x4 (&acc)[2][2][4][2], const Unit& u, int wr, int wc, int fr, int fq) const {
        const int row0 = u.pm * BM + wr * 64 + fr, col0 = u.pn * BM + wc * 32 + 8 * fq;
#pragma unroll
        for (int ai = 0; ai < 2; ++ai)
#pragma unroll
            for (int m = 0; m < 4; ++m) {
                const int row = row0 + ai * HALF + m * 16, b = row >> 12;
                const float rstd = row_rstd(sumsq, row);
#pragma unroll
                for (int bj = 0; bj < 2; ++bj) {
                    const int c = col0 + bj * HALF;
                    const f32x4 b0 = *(const f32x4*)(biasf + b * 2048 + c), b1 = *(const f32x4*)(biasf + b * 2048 + c + 4);
                    const f32x4 v0 = acc[ai][bj][m][0] * rstd + b0, v1 = acc[ai][bj][m][1] * rstd + b1;
                    u32x4 w; w.x = cvt_pk_bf16(v0[0], v0[1]); w.y = cvt_pk_bf16(v0[2], v0[3]); w.z = cvt_pk_bf16(v1[0], v1[1]); w.w = cvt_pk_bf16(v1[2], v1[3]);
                    *(u32x4*)(sc + (size_t)row * 2048 + c) = w;
                }
            }
    }
};

template <class Epi, class Sched, bool ALIGN_EPI = false, bool SP2 = false>
__device__ __forceinline__ void gemm_phase(PG8_LAS unsigned char* lds, const Gemm g, const Sched& S, const Epi& E) {
    const int tid = threadIdx.x, wid = __builtin_amdgcn_readfirstlane(tid >> 6), lane = tid & 63, wr = wid >> 2, wc = wid & 3, fr = lane & 15, fq = lane >> 4;
    const int K = g.K, nt = K / BK;
    unsigned voffA[2], voffB[2];
#pragma unroll
    for (int i = 0; i < 2; ++i) { int R, C; stage_rc(tid * 16 + i * 8192, R, C); const int Rb = Epi::PERM ? ((R & ~31) + perm32(R & 31)) : R;
        voffA[i] = (unsigned)(R * K + C) * 2u; voffB[i] = (unsigned)(Rb * K + C) * 2u; }
    const size_t kstep = (size_t)(BK * 2);
    const size_t hstep = (size_t)HALF * K * 2;
    const size_t tstep = 2 * hstep;
    const unsigned ldsw = (unsigned)wid * 1024u;
    const int aoff = lds_byte(wr * 64 + fr, fq * 8), boff = lds_byte(wc * 32 + fr, fq * 8);
#define PG8_SA(b, h) (((b) * 2 + (h)) * HTB)
#define PG8_SB(b, h) ((4 + (b) * 2 + (h)) * HTB)
#define PG8_STAGE(bufoff, gbase, voff) do { _Pragma("unroll") for (int _i = 0; _i < 2; ++_i) \
        __builtin_amdgcn_global_load_lds((const unsigned*)((const char*)(gbase) + (voff)[_i]), (PG8_LAS unsigned*)(lds + (bufoff) + ldsw + _i * 8192), 16, 0, 0); } while (0)
#define PG8_LDA(dst, b, h) do { _Pragma("unroll") for (int m = 0; m < 4; ++m) _Pragma("unroll") for (int k = 0; k < 2; ++k) dst[m][k] = *(const PG8_LAS bf16x8*)(lds + PG8_SA(b, h) + aoff + m * 2048 + k * 1024); } while (0)
#define PG8_LDB(dst, b, h) do { _Pragma("unroll") for (int n = 0; n < 2; ++n) _Pragma("unroll") for (int k = 0; k < 2; ++k) dst[n][k] = *(const PG8_LAS bf16x8*)(lds + PG8_SB(b, h) + boff + n * 2048 + k * 1024); } while (0)
#define PG8_MMA(ai, bj, At, Bt) do { __builtin_amdgcn_s_setprio(1); _Pragma("unroll") for (int m = 0; m < 4; ++m) _Pragma("unroll") for (int n = 0; n < 2; ++n) _Pragma("unroll") for (int k = 0; k < 2; ++k) \
        acc[ai][bj][m][n] = __builtin_amdgcn_mfma_f32_16x16x32_bf16(Bt[n][k], At[m][k], acc[ai][bj][m][n], 0, 0, 0); __builtin_amdgcn_s_setprio(0); } while (0)
#define PG8_WAIT_V(n) asm volatile("s_waitcnt vmcnt(" #n ")" ::: "memory")
#define PG8_WAIT_L(n) asm volatile("s_waitcnt lgkmcnt(" #n ")" ::: "memory")
#define PG8_BAR __builtin_amdgcn_s_barrier()
#define PG8_SCHED __builtin_amdgcn_sched_barrier(0)
    Unit cur, nxt; int ui = 0;
    if (!S.next(0, cur)) return;
    f32x4 acc[2][2][4][2];
#pragma unroll
    for (int a = 0; a < 2; ++a)
#pragma unroll
        for (int b = 0; b < 2; ++b)
#pragma unroll
            for (int m = 0; m < 4; ++m)
#pragma unroll
                for (int n = 0; n < 2; ++n) acc[a][b][m][n] = (f32x4){0.f, 0.f, 0.f, 0.f};
    bf16x8 At[4][2], B0[2][2], B1[2][2];
    const char* cA = (const char*)g.A + (size_t)cur.pm * tstep; const char* cB = (const char*)g.Bt + (size_t)cur.pn * tstep;
    S.a_ready(cur);
    if constexpr (SP2) {
        PG8_STAGE(PG8_SB(0, 0), cB, voffB); PG8_STAGE(PG8_SB(0, 1), cB + hstep, voffB); PG8_STAGE(PG8_SA(0, 0), cA, voffA); PG8_STAGE(PG8_SA(0, 1), cA + hstep, voffA);
        if (wr == 1) PG8_BAR;
        PG8_WAIT_V(2); PG8_BAR;
        PG8_STAGE(PG8_SB(1, 0), cB + kstep, voffB); PG8_STAGE(PG8_SA(1, 0), cA + kstep, voffA); PG8_STAGE(PG8_SB(1, 1), cB + hstep + kstep, voffB);
        PG8_WAIT_V(6); PG8_BAR;
    } else {
        PG8_STAGE(PG8_SB(0, 0), cB, voffB); PG8_STAGE(PG8_SA(0, 0), cA, voffA); PG8_STAGE(PG8_SB(0, 1), cB + hstep, voffB); PG8_STAGE(PG8_SA(0, 1), cA + hstep, voffA);
        if (wr == 1) PG8_BAR;
        PG8_WAIT_V(4); PG8_BAR;
        PG8_STAGE(PG8_SB(1, 0), cB + kstep, voffB); PG8_STAGE(PG8_SA(1, 0), cA + kstep, voffA); PG8_STAGE(PG8_SB(1, 1), cB + hstep + kstep, voffB);
        PG8_WAIT_V(6); PG8_BAR;
    }
    for (;;) {
        const bool has_next = S.next(ui + 1, nxt);
        const char* nA = has_next ? (const char*)g.A + (size_t)nxt.pm * tstep : cA; const char* nB = has_next ? (const char*)g.Bt + (size_t)nxt.pn * tstep : cB;
        for (int t = 0; t < nt; t += 2) {
            const bool last = (t == nt - 2);
            const char* a1 = cA + (size_t)(t + 1) * kstep;
            const char* a2 = last ? nA : cA + (size_t)(t + 2) * kstep; const char* b2 = last ? nB : cB + (size_t)(t + 2) * kstep;
            const char* a3 = a2 + kstep; const char* b3 = b2 + kstep;
            if (last && has_next) S.a_ready(nxt);
            if constexpr (SP2) {
            PG8_LDB(B0, 0, 0); PG8_LDB(B1, 0, 1); PG8_SCHED; PG8_LDA(At, 0, 0); PG8_STAGE(PG8_SA(1, 1), a1 + hstep, voffA);
            PG8_WAIT_V(8); PG8_WAIT_L(0); PG8_BAR; PG8_MMA(0, 0, At, B0); PG8_MMA(0, 1, At, B1); PG8_BAR; PG8_SCHED;
            PG8_LDA(At, 0, 1); PG8_STAGE(PG8_SB(0, 0), b2, voffB); PG8_STAGE(PG8_SB(0, 1), b2 + hstep, voffB); PG8_STAGE(PG8_SA(0, 0), a2, voffA);
            PG8_WAIT_V(8); PG8_WAIT_L(0); PG8_BAR; PG8_MMA(1, 0, At, B0); PG8_MMA(1, 1, At, B1); PG8_BAR; PG8_SCHED;
            PG8_LDB(B0, 1, 0); PG8_LDB(B1, 1, 1); PG8_SCHED; PG8_LDA(At, 1, 0); PG8_STAGE(PG8_SA(0, 1), a2 + hstep, voffA);
            PG8_WAIT_V(8); PG8_WAIT_L(0); PG8_BAR; PG8_MMA(0, 0, At, B0); PG8_MMA(0, 1, At, B1); PG8_BAR; PG8_SCHED;
            PG8_LDA(At, 1, 1); PG8_STAGE(PG8_SB(1, 0), b3, voffB); PG8_STAGE(PG8_SB(1, 1), b3 + hstep, voffB); PG8_STAGE(PG8_SA(1, 0), a3, voffA);
            PG8_WAIT_V(8); PG8_WAIT_L(0); PG8_BAR; PG8_MMA(1, 0, At, B0); PG8_MMA(1, 1, At, B1); PG8_BAR; PG8_SCHED;
            } else {
            PG8_LDB(B0, 0, 0); PG8_SCHED; PG8_LDA(At, 0, 0); PG8_STAGE(PG8_SA(1, 1), a1 + hstep, voffA);
            PG8_WAIT_L(8); PG8_BAR; PG8_WAIT_L(0); PG8_MMA(0, 0, At, B0); PG8_BAR; PG8_SCHED;
            PG8_LDB(B1, 0, 1); PG8_STAGE(PG8_SB(0, 0), b2, voffB);
            PG8_BAR; PG8_WAIT_L(0); PG8_MMA(0, 1, At, B1); PG8_BAR;
            PG8_LDA(At, 0, 1); PG8_STAGE(PG8_SA(0, 0), a2, voffA);
            PG8_BAR; PG8_WAIT_L(0); PG8_MMA(1, 0, At, B0); PG8_BAR; PG8_SCHED;
            PG8_STAGE(PG8_SB(0, 1), b2 + hstep, voffB);
            PG8_WAIT_V(6); PG8_BAR; PG8_MMA(1, 1, At, B1); PG8_BAR;
            PG8_LDB(B0, 1, 0); PG8_SCHED; PG8_LDA(At, 1, 0); PG8_STAGE(PG8_SA(0, 1), a2 + hstep, voffA);
            PG8_WAIT_L(8); PG8_BAR; PG8_WAIT_L(0); PG8_MMA(0, 0, At, B0); PG8_BAR; PG8_SCHED;
            PG8_LDB(B1, 1, 1); PG8_STAGE(PG8_SB(1, 0), b3, voffB);
            PG8_BAR; PG8_WAIT_L(0); PG8_MMA(0, 1, At, B1); PG8_BAR;
            PG8_LDA(At, 1, 1); PG8_STAGE(PG8_SA(1, 0), a3, voffA);
            PG8_BAR; PG8_WAIT_L(0); PG8_MMA(1, 0, At, B0); PG8_BAR; PG8_SCHED;
            PG8_STAGE(PG8_SB(1, 1), b3 + hstep, voffB);
            PG8_WAIT_V(6); PG8_BAR; PG8_MMA(1, 1, At, B1); PG8_BAR;
            }
        }
        if constexpr (ALIGN_EPI) { if (wr == 0) PG8_BAR; }
        if constexpr (!Epi::AFTER_DRAIN) { E(acc, cur, wr, wc, fr, fq); S.done(cur); }
        if (!has_next) break;
#pragma unroll
        for (int a = 0; a < 2; ++a)
#pragma unroll
            for (int b = 0; b < 2; ++b)
#pragma unroll
                for (int m = 0; m < 4; ++m)
#pragma unroll
                    for (int n = 0; n < 2; ++n) acc[a][b][m][n] = (f32x4){0.f, 0.f, 0.f, 0.f};
        cur = nxt; cA = nA; cB = nB; ++ui;
        if constexpr (ALIGN_EPI) { if (wr == 1) PG8_BAR; }
    }
    PG8_WAIT_V(0);
    if constexpr (!ALIGN_EPI) { if (wr == 0) PG8_BAR; }
    PG8_BAR;
    if constexpr (Epi::AFTER_DRAIN) { E.fused(acc, cur, wr, wc, fr, fq, lds, wid, lane); S.done(cur); }
#undef PG8_SA
#undef PG8_SB
#undef PG8_STAGE
#undef PG8_LDA
#undef PG8_LDB
#undef PG8_MMA
#undef PG8_WAIT_V
#undef PG8_WAIT_L
#undef PG8_BAR
#undef PG8_SCHED
}
}
struct Args { const float* in[13]; float* out; unsigned char* ws; int ph_lo, ph_hi; };

#ifndef TPROBE_I
#define TPROBE_I 3
#endif
#ifndef TPROBE_B
#define TPROBE_B 0
#endif
#ifdef TIME_PH
#ifndef TIME_AMP
#define TIME_AMP 4
#endif
#define TSTAMP(k, slot) do { if ((k) == TIME_PH && bid == TPROBE_B && tid == 0) { const unsigned long long t_ = __builtin_amdgcn_s_memrealtime(); MISC[slot] = (unsigned)t_; MISC[(slot) + 1] = (unsigned)(t_ >> 32); } } while (0)
#else
#define TSTAMP(k, slot) do { } while (0)
#endif
template <bool PERMUTE>
__device__ __forceinline__ void p0_transpose_item(const float* W, int K, int N, int NPOS, bf16_t* WT, LAS float* scr, int item, int lane) {
    const int nblk = NPOS / 32, kb = item / nblk, nb = item % nblk, k0 = 64 * kb, n0 = 32 * nb;
    const int pos = n0 + 4 * (lane & 7);
    const int col = PERMUTE ? win_src_col(pos) : pos;
    f32x4 v[8];
#pragma unroll
    for (int i = 0; i < 8; ++i) { const int kk = 8 * i + (lane >> 3); v[i] = (col >= 0) ? *(const f32x4*)(W + (size_t)(k0 + kk) * N + col) : (f32x4){0.f, 0.f, 0.f, 0.f}; }
#pragma unroll
    for (int i = 0; i < 8; ++i) { const int kk = 8 * i + (lane >> 3); LAS float* q = scr + kk * 33 + 4 * (lane & 7); q[0] = v[i][0]; q[1] = v[i][1]; q[2] = v[i][2]; q[3] = v[i][3]; }
    asm volatile("s_waitcnt lgkmcnt(0)" ::: "memory");
    const int c = lane & 7;
#pragma unroll
    for (int j = 0; j < 4; ++j) { const int n = (lane >> 3) + 8 * j; const LAS float* s = scr + (8 * c) * 33 + n;
        u32x4 o; o.x = pk2(s[0 * 33], s[1 * 33]); o.y = pk2(s[2 * 33], s[3 * 33]); o.z = pk2(s[4 * 33], s[5 * 33]); o.w = pk2(s[6 * 33], s[7 * 33]);
        *(u32x4*)(WT + (size_t)(n0 + n) * K + k0 + 8 * c) = o; }
    asm volatile("s_waitcnt lgkmcnt(0)" ::: "memory");
}
__device__ __forceinline__ void row_to_bf16(const float* src, bf16_t* dst, int lane) {
    const f32x4* s = (const f32x4*)src + lane; u32x2* d = (u32x2*)dst + lane;
    f32x4 v[4];
#pragma unroll
    for (int j = 0; j < 4; ++j) v[j] = s[64 * j];
#pragma unroll
    for (int j = 0; j < 4; ++j) { u32x2 w; w.x = pk2(v[j][0], v[j][1]); w.y = pk2(v[j][2], v[j][3]); d[64 * j] = w; }
}
typedef float f32x2 __attribute__((ext_vector_type(2)));
template <int NB>
__device__ __forceinline__ void rows_to_fp8(const float* src, unsigned char* dst, float* scale_out, int lane) {
    f32x4 v[NB][4];
#pragma unroll
    for (int i = 0; i < NB; ++i) { const f32x4* s = (const f32x4*)(src + (size_t)i * 1024) + 4 * lane;
#pragma unroll
        for (int j = 0; j < 4; ++j) v[i][j] = __builtin_nontemporal_load(s + j); }
#pragma unroll
    for (int i = 0; i < NB; ++i) {
        float am = 0.f;
#pragma unroll
        for (int j = 0; j < 4; ++j) am = fmaxf(am, fmaxf(fmaxf(fabsf(v[i][j][0]), fabsf(v[i][j][1])), fmaxf(fabsf(v[i][j][2]), fabsf(v[i][j][3]))));
#pragma unroll
        for (int o = 1; o < 64; o <<= 1) am = fmaxf(am, __shfl_xor(am, o));
        const float sc = am > 0.f ? am * (1.0f / 440.0f) : 1.0f, inv = 1.0f / sc;
        u32x4 w;
#pragma unroll
        for (int j = 0; j < 4; ++j) { unsigned t = 0u; t = __builtin_amdgcn_cvt_pk_fp8_f32(v[i][j][0] * inv, v[i][j][1] * inv, t, false); t = __builtin_amdgcn_cvt_pk_fp8_f32(v[i][j][2] * inv, v[i][j][3] * inv, t, true); w[j] = t; }
        *((u32x4*)(dst + (size_t)i * 1024) + lane) = w;
        if (lane == 0) scale_out[i] = sc;
    }
}
__device__ __forceinline__ void sincos_tab(double x, float& s, float& c) {
    const double k = rint(x * 0.15915494309189535);
    double r = fma(-k, 6.283185307179586, x); r = fma(-k, 2.4492935982947064e-16, r);
    const double r2 = r * r;
    double ps = 1.0, pc = 1.0;
#pragma unroll
    for (int n = 29; n >= 3; n -= 2) ps = 1.0 - ps * r2 * (1.0 / (double)((n - 1) * n));
#pragma unroll
    for (int n = 28; n >= 2; n -= 2) pc = 1.0 - pc * r2 * (1.0 / (double)((n - 1) * n));
    s = (float)(r * ps); c = (float)pc;
}

__device__ __forceinline__ void phase0(const Args& a, unsigned char* lds, int tid, int wave, int lane, int bid, int G) {
    unsigned char* ws = a.ws;
    volatile LAS unsigned* MISC = (volatile LAS unsigned*)((LAS unsigned char*)lds + MISC_OFF);
    TSTAMP(90, 0);
    if (bid & 1) { const int gw0 = bid * 8 + wave, NGW0 = G * 8;
        for (int it = gw0; it < 4096; it += NGW0) { const int r = 4 * it;
            rows_to_fp8<4>(a.in[10] + (size_t)r * 1024, ws + WS_U8 + (size_t)r * 1024, (float*)(ws + WS_USC) + r, lane); }
        __syncthreads(); }
    for (int it = bid; it < 192; it += G) {
        float* s_c = (float*)lds; float* red = (float*)(lds + 16384);
        for (int i = tid; i < 4096; i += NTHREADS) { const float v = a.in[1][i]; s_c[i] = v / (1.0f + expf(-v)); }
        __syncthreads();
        const int g = tid & 7, ks = tid >> 3, n0 = 32 * it;
        f32x4 acc[4];
#pragma unroll
        for (int b = 0; b < 4; ++b) acc[b] = (f32x4){0.f, 0.f, 0.f, 0.f};
#pragma unroll 4
        for (int i = 0; i < 16; ++i) { const int k = ks + 64 * i; const f32x4 w = *(const f32x4*)(a.in[2] + (size_t)k * 6144 + n0 + 4 * g);
#pragma unroll
            for (int b = 0; b < 4; ++b) acc[b] += w * s_c[b * 1024 + k]; }
#pragma unroll
        for (int b = 0; b < 4; ++b) *(f32x4*)(red + (ks * 8 + g) * 16 + 4 * b) = acc[b];
        __syncthreads();
        if (tid < 128) { const int b = tid >> 5, col = tid & 31, gg = col >> 2, e = col & 3; float s = 0.f;
            for (int k2 = 0; k2 < 64; ++k2) s += red[(k2 * 8 + gg) * 16 + 4 * b + e];
            ((float*)(ws + WS_MOD))[b * 6144 + n0 + col] = s + a.in[3][n0 + col]; }
        __syncthreads();
    }
    TSTAMP(90, 2); TSTAMP(91, 0);
    for (int it = bid; it < 256; it += G) {
        const int hp = it >> 4, k0 = 64 * (it & 15);
        constexpr int WP = 132;
        float* skl = (float*)lds; float* wql = skl + 128 * WP;
        for (int i = tid; i < 4096; i += NTHREADS) { const int n = i >> 5, d4 = i & 31; *(f32x4*)(skl + n * WP + 4 * d4) = *(const f32x4*)(a.in[9] + (size_t)hp * 16384 + n * 128 + 4 * d4); }
        for (int i = tid; i < 2048; i += NTHREADS) { const int k = i >> 5, d4 = i & 31; *(f32x4*)(wql + k * WP + 4 * d4) = *(const f32x4*)(a.in[8] + (size_t)(k0 + k) * 2048 + hp * 128 + 4 * d4); }
        __syncthreads();
        const int kg = tid & 15, ng = tid >> 4;
        float acc[4][4];
#pragma unroll
        for (int i = 0; i < 4; ++i)
#pragma unroll
            for (int j = 0; j < 4; ++j) acc[i][j] = 0.f;
#pragma unroll 2
        for (int d4 = 0; d4 < 32; ++d4) {
            f32x4 wv[4], sv[4];
#pragma unroll
            for (int i = 0; i < 4; ++i) { wv[i] = *(const f32x4*)(wql + (kg + 16 * i) * WP + 4 * d4); sv[i] = *(const f32x4*)(skl + (ng + 32 * i) * WP + 4 * d4); }
#pragma unroll
            for (int i = 0; i < 4; ++i)
#pragma unroll
                for (int j = 0; j < 4; ++j) acc[i][j] += (wv[i][0] * sv[j][0] + wv[i][1] * sv[j][1]) + (wv[i][2] * sv[j][2] + wv[i][3] * sv[j][3]);
        }
        bf16_t* wt = (bf16_t*)(ws + WS_WPQ);
#pragma unroll
        for (int j = 0; j < 4; ++j)
#pragma unroll
            for (int i = 0; i < 4; ++i) wt[(size_t)(hp * 128 + ng + 32 * j) * 1024 + k0 + kg + 16 * i] = (bf16_t)f2bf(acc[i][j]);
        __syncthreads();
    }
    TSTAMP(91, 2); TSTAMP(92, 0);
    const int gw = bid * 8 + wave, NGW = G * 8;
    {
        LAS float* scr = (LAS float*)(lds + wave * 16384);
        constexpr int I_IN = 16 * (N1 / 32), I_OUT = 16 * 32;
        for (int it = gw; it < I_IN + I_OUT; it += NGW) {
            if (it < I_IN) p0_transpose_item<true>(a.in[5], 1024, 4168, N1, (bf16_t*)(ws + WS_WIN), scr, it, lane);
            else p0_transpose_item<false>(a.in[6], 1024, 1024, 1024, (bf16_t*)(ws + WS_WOUT), scr, it - I_IN, lane);
        }
    }
    if (!(bid & 1)) {
        for (int it = gw; it < 4096; it += NGW) { const int r = 4 * it;
            rows_to_fp8<4>(a.in[10] + (size_t)r * 1024, ws + WS_U8 + (size_t)r * 1024, (float*)(ws + WS_USC) + r, lane); }
    }
    for (int i = bid * NTHREADS + tid; i < 4096 * 96; i += G * NTHREADS) {
        int pos, f; double r; float* ct; float* st; int idx;
        if (i < 4096 * 32) { pos = i >> 5; f = i & 31; r = 0.74989420933245582730; ct = (float*)(ws + WS_COSA); st = (float*)(ws + WS_SINA); idx = i; }
        else { const int j = i - 4096 * 32; pos = j >> 6; f = j & 63; r = 0.86398844948396852897; ct = (float*)(ws + WS_COSR); st = (float*)(ws + WS_SINR); idx = j; }
        double v = 1.0; for (int t = 0; t < f; ++t) v *= r;
        const float invf = (float)v; const float ang = (float)pos * invf;
        float s, c; sincos_tab((double)ang, s, c);
        ct[idx] = c; st[idx] = s;
    }
}

__device__ __forceinline__ void phase1(const Args& a, int wave, int lane, int bid, int G) {
    unsigned char* ws = a.ws;
    const float* mod = (const float*)(ws + WS_MOD);
    const int gw = bid * 8 + wave, NGW = G * 8;
    for (int r0 = gw; r0 < MTOK; r0 += 2 * NGW) {
        const int r1 = r0 + NGW; const bool has1 = r1 < MTOK;
        const f32x4* xa = (const f32x4*)(a.in[0] + (size_t)r0 * DM) + lane; const f32x4* xb = (const f32x4*)(a.in[0] + (size_t)(has1 ? r1 : r0) * DM) + lane;
        f32x4 va[4], vb[4]; float sa = 0.f, sb = 0.f;
#pragma unroll
        for (int j = 0; j < 4; ++j) { va[j] = xa[64 * j]; vb[j] = xb[64 * j]; }
#pragma unroll
        for (int j = 0; j < 4; ++j) { sa += (va[j][0] * va[j][0] + va[j][1] * va[j][1]) + (va[j][2] * va[j][2] + va[j][3] * va[j][3]); sb += (vb[j][0] * vb[j][0] + vb[j][1] * vb[j][1]) + (vb[j][2] * vb[j][2] + vb[j][3] * vb[j][3]); }
#pragma unroll
        for (int o = 1; o < 64; o <<= 1) { sa += __shfl_xor(sa, o); sb += __shfl_xor(sb, o); }
        const float ra = 1.0f / sqrtf(sa * (1.0f / DM) + EPS), rb = 1.0f / sqrtf(sb * (1.0f / DM) + EPS);
        const int ba = r0 >> 12, bb = (has1 ? r1 : r0) >> 12;
        u32x2* oa = (u32x2*)((bf16_t*)(ws + WS_BUFA) + (size_t)r0 * DM) + lane; u32x2* ob = (u32x2*)((bf16_t*)(ws + WS_BUFA) + (size_t)(has1 ? r1 : r0) * DM) + lane;
#pragma unroll
        for (int j = 0; j < 4; ++j) { const int c = 256 * j + 4 * lane;
            const f32x4 g = *(const f32x4*)(a.in[4] + c);
            { const f32x4 sc = *(const f32x4*)(mod + ba * 6144 + 1024 + c), sh = *(const f32x4*)(mod + ba * 6144 + c);
              const f32x4 h = va[j] * ra * g * (sc + 1.0f) + sh; u32x2 w; w.x = pk2(h[0], h[1]); w.y = pk2(h[2], h[3]); oa[64 * j] = w; }
            if (has1) { const f32x4 sc = *(const f32x4*)(mod + bb * 6144 + 1024 + c), sh = *(const f32x4*)(mod + bb * 6144 + c);
              const f32x4 h = vb[j] * rb * g * (sc + 1.0f) + sh; u32x2 w; w.x = pk2(h[0], h[1]); w.y = pk2(h[2], h[3]); ob[64 * j] = w; }
        }
    }
    for (int n = gw; n < 2048; n += NGW) {
        const u32x4* wr = (const u32x4*)((const bf16_t*)(ws + WS_WPQ) + (size_t)n * 1024);
        const u32x4 w0 = wr[lane], w1 = wr[64 + lane];
        float wf[16];
#pragma unroll
        for (int i = 0; i < 4; ++i) { wf[2 * i] = bf_lo(w0[i]); wf[2 * i + 1] = bf_hi(w0[i]); wf[8 + 2 * i] = bf_lo(w1[i]); wf[8 + 2 * i + 1] = bf_hi(w1[i]); }
#pragma unroll
        for (int b = 0; b < 4; ++b) { const float* sh = mod + b * 6144 + 3072; float s = 0.f;
#pragma unroll
            for (int i = 0; i < 8; ++i) s += wf[i] * sh[8 * lane + i] + wf[8 + i] * sh[512 + 8 * lane + i];
            s = wave_sum(s);
            if (lane == 0) ((float*)(ws + WS_BIASF))[b * 2048 + n] = s; }
    }
}

constexpr int SCP = 8200;
__device__ __forceinline__ int wave_total(int v) {
    v += __builtin_amdgcn_update_dpp(0, v, 0xB1, 0xF, 0xF, true);
    v += __builtin_amdgcn_update_dpp(0, v, 0x4E, 0xF, 0xF, true);
    v += __builtin_amdgcn_update_dpp(0, v, 0x141, 0xF, 0xF, true);
    v += __builtin_amdgcn_update_dpp(0, v, 0x140, 0xF, 0xF, true);
    return __builtin_amdgcn_readlane(v, 0) + __builtin_amdgcn_readlane(v, 16) + __builtin_amdgcn_readlane(v, 32) + __builtin_amdgcn_readlane(v, 48);
}
__device__ __forceinline__ int wave_suffix_sum(int v, int lane) {
#pragma unroll
    for (int d = 1; d < 64; d <<= 1) { const int o = __shfl_down(v, d); if (lane + d < 64) v += o; }
    return v;
}
__device__ __forceinline__ void hist_find(const unsigned* hist, int want, int lane, int& bin, int& above, int& inbin) {
    const u32x4 h = *(const u32x4*)(hist + 4 * lane);
    const int s = (int)(h.x + h.y) + (int)(h.z + h.w);
    const int incl = wave_suffix_sum(s, lane), excl = incl - s;
    const bool mine = excl < want && want <= incl;
    int c = excl, bsel = 4 * lane + 3, cin = (int)h.w;
    if (c + (int)h.w < want) { c += (int)h.w; bsel = 4 * lane + 2; cin = (int)h.z;
        if (c + (int)h.z < want) { c += (int)h.z; bsel = 4 * lane + 1; cin = (int)h.y;
            if (c + (int)h.y < want) { c += (int)h.y; bsel = 4 * lane; cin = (int)h.x; } } }
    const int src = (int)__builtin_ctzll(__ballot(mine));
    bin = __builtin_amdgcn_readlane(bsel, src); above = __builtin_amdgcn_readlane(c, src); inbin = __builtin_amdgcn_readlane(cin, src);
}
template <int NR>
__device__ __forceinline__ void select_row_t(int b, int t, unsigned char* ldsrow, unsigned* hist, unsigned long long* MASK, int lane) {
    {
        unsigned* row32 = (unsigned*)ldsrow;
        for (int i = 8 * ((t >> 4) + 1) + lane; i < 32 * NR; i += 64) row32[i] = 0u;
    }
    unsigned key[NR];
#pragma unroll
    for (int j = 0; j < NR; ++j) key[j] = *(const unsigned short*)(ldsrow + 2 * lane + 128 * j);
    unsigned mw_lo = 0u, mw_hi = 0u;
    if (t < 256) {
#pragma unroll
        for (int j = 0; j < 4; ++j) { const unsigned long long w = __ballot(key[j] != 0u);
            asm volatile("s_nop 1\n\tv_writelane_b32 %0, %2, %4\n\tv_writelane_b32 %1, %3, %4\n\ts_nop 0" : "+v"(mw_lo), "+v"(mw_hi) : "s"((unsigned)w), "s"((unsigned)(w >> 32)), "n"(j)); }
    } else {
        *(u32x4*)(hist + 4 * lane) = (u32x4){0u, 0u, 0u, 0u};
#pragma unroll
        for (int j = 0; j < NR; ++j) __hip_atomic_fetch_add(hist + (key[j] >> 8), 1u, __ATOMIC_RELAXED, __HIP_MEMORY_SCOPE_WORKGROUP);
        int B, above, inB;
        hist_find(hist, 256, lane, B, above, inB);
        *(u32x4*)(hist + 4 * lane) = (u32x4){0u, 0u, 0u, 0u};
#pragma unroll
        for (int j = 0; j < NR; ++j) if ((int)(key[j] >> 8) == B) __hip_atomic_fetch_add(hist + (key[j] & 255u), 1u, __ATOMIC_RELAXED, __HIP_MEMORY_SCOPE_WORKGROUP);
        int b2, above2, ties;
        hist_find(hist, 256 - above, lane, b2, above2, ties);
        const unsigned T = ((unsigned)B << 8) | (unsigned)b2;
        int need = 256 - above - above2;
        if (ties == need) {
#pragma unroll
            for (int j = 0; j < NR; ++j) { const unsigned long long w = __ballot(key[j] >= T);
                asm volatile("s_nop 1\n\tv_writelane_b32 %0, %2, %4\n\tv_writelane_b32 %1, %3, %4\n\ts_nop 0" : "+v"(mw_lo), "+v"(mw_hi) : "s"((unsigned)w), "s"((unsigned)(w >> 32)), "n"(j));
                if ((j & 3) == 3) __builtin_amdgcn_sched_barrier(0); }
        } else {
#pragma unroll
            for (int j = 0; j < NR; ++j) {
                const bool gt = key[j] > T, eq = key[j] == T;
                const unsigned long long em = __ballot(eq);
                const int cc = __popcll(em), take = cc < need ? cc : need;
                const int rank = (int)__builtin_amdgcn_mbcnt_hi((unsigned)(em >> 32), __builtin_amdgcn_mbcnt_lo((unsigned)em, 0u));
                const unsigned long long w = __ballot(gt || (eq && rank < take));
                need -= take;
                asm volatile("s_nop 1\n\tv_writelane_b32 %0, %2, %4\n\tv_writelane_b32 %1, %3, %4\n\ts_nop 0" : "+v"(mw_lo), "+v"(mw_hi) : "s"((unsigned)w), "s"((unsigned)(w >> 32)), "n"(j));
                if ((j & 1) == 1) __builtin_amdgcn_sched_barrier(0);
            }
        }
    }
    MASK[((size_t)b * SEQ + t) * 64 + lane] = ((unsigned long long)mw_hi << 32) | mw_lo;
}
__device__ __forceinline__ void select_row(int b, int t, unsigned char* ldsrow, unsigned* hist, unsigned long long* MASK, int lane) {
    switch (t >> 10) {
        case 0: select_row_t<16>(b, t, ldsrow, hist, MASK, lane); break;
        case 1: select_row_t<32>(b, t, ldsrow, hist, MASK, lane); break;
        case 2: select_row_t<48>(b, t, ldsrow, hist, MASK, lane); break;
        default: select_row_t<64>(b, t, ldsrow, hist, MASK, lane); break;
    }
}
__device__ __forceinline__ void idx_unit(int b, int qt, const bf16_t* QI, const bf16_t* KI, const float* WI, unsigned long long* MASK, unsigned char* lds, int wave, int lane, bool tprobe) {
    volatile LAS unsigned* MISC = (volatile LAS unsigned*)((LAS unsigned char*)lds + MISC_OFF); const int bid = tprobe ? TPROBE_B : -1; const int tid = (int)threadIdx.x;
    TSTAMP(32, 0);
    const int t0 = 16 * qt, qn = lane & 15, g = lane >> 4;
    const size_t rowq = (size_t)b * SEQ + t0 + qn;
    bf16x8 qf[8][2]; float wi[8];
#pragma unroll
    for (int h = 0; h < 8; ++h)
#pragma unroll
        for (int ks = 0; ks < 2; ++ks) qf[h][ks] = *(const bf16x8*)(QI + rowq * 512 + h * 64 + ks * 32 + 8 * g);
    { const f32x4 w0 = *(const f32x4*)(WI + rowq * 8), w1 = *(const f32x4*)(WI + rowq * 8 + 4);
#pragma unroll
      for (int e = 0; e < 4; ++e) { wi[e] = w0[e]; wi[4 + e] = w1[e]; } }
    const bf16_t* kbase = KI + ((size_t)b * SEQ + qn) * 64 + 8 * g;
    bf16x8 ra0[8], ra1[8];
#pragma unroll
    for (int i = 0; i < 8; ++i) if (wave + 8 * i <= qt) { const bf16_t* kr = kbase + (size_t)(wave + 8 * i) * 1024; ra0[i] = *(const bf16x8*)kr; ra1[i] = *(const bf16x8*)(kr + 32); }
#pragma unroll 1
    for (int base = wave; base <= qt; base += 64) {
#pragma unroll
        for (int i = 0; i < 8; ++i) {
            const int kt = base + 8 * i;
            if (kt <= qt) {
                const bf16x8 a0 = ra0[i], a1 = ra1[i];
                if (kt + 64 <= qt) { const bf16_t* kr = kbase + (size_t)(kt + 64) * 1024; ra0[i] = *(const bf16x8*)kr; ra1[i] = *(const bf16x8*)(kr + 32); }
                const int s0 = 16 * kt;
                f32x4 sc = (f32x4){0.f, 0.f, 0.f, 0.f};
#pragma unroll
                for (int h = 0; h < 8; ++h) {
                    f32x4 d = mfma16(a0, qf[h][0], (f32x4){0.f, 0.f, 0.f, 0.f}); d = mfma16(a1, qf[h][1], d);
#pragma unroll
                    for (int r = 0; r < 4; ++r) { const int di = (int)__float_as_uint(d[r]); sc[r] += wi[h] * __uint_as_float((unsigned)(di > 0 ? di : 0)); }
                }
                unsigned k[4];
#pragma unroll
                for (int r = 0; r < 4; ++r) { const unsigned kk = sortable16(sc[r]); k[r] = (s0 + 4 * g + r <= t0 + qn) ? kk : 0u; }
                u32x2 pk; pk.x = k[0] | (k[1] << 16); pk.y = k[2] | (k[3] << 16);
                *(u32x2*)(lds + qn * SCP + 2 * (s0 + 4 * g)) = pk;
            }
        }
    }
    __syncthreads();
    TSTAMP(32, 2); TSTAMP(33, 0);
#ifndef NO_SEL
#pragma unroll 1
    for (int qq = 2 * wave; qq < 2 * wave + 2; ++qq) select_row(b, t0 + qq, lds + qq * SCP, (unsigned*)(lds + 16 * SCP) + 256 * wave, MASK, lane);
#endif
    __syncthreads();
    TSTAMP(33, 2);
}

typedef short s16x4_t __attribute__((ext_vector_type(4)));
__device__ __forceinline__ s16x4_t lds_tr16(const unsigned char* p) {
    return __builtin_bit_cast(s16x4_t, __builtin_amdgcn_ds_read_tr16_b64_v4i16((LAS s16x4_t*)(LAS unsigned char*)p));
}
__device__ __forceinline__ void ret_state_unit(int b, int h, int vb, int dh, const bf16_t* KR, const bf16_t* VR, bf16_t* STATE, unsigned char* lds, int tid, int wave, int lane) {
    constexpr int KPT = 144, VPT = 48, K_BYTES = 128 * KPT, BUF = K_BYTES + 128 * VPT;
    const int j = tid & 127, dq = tid >> 7, g = lane >> 4, ln = lane & 15;
    const float g128 = ret_g128(h), g127 = ret_g127(h), gam = ret_gamma(h);
    f32x4 st = (f32x4){0.f, 0.f, 0.f, 0.f};
    u32x4 kA[2], kB[2], vA = (u32x4){0u, 0u, 0u, 0u}, vB = (u32x4){0u, 0u, 0u, 0u};
#define RS_LOAD(K_, V_, n) do { const size_t row = (size_t)b * SEQ + (n) * 128 + j; const u32x4* p = (const u32x4*)(KR + row * 512 + h * 128 + 64 * dh + 16 * dq); \
        K_[0] = p[0]; K_[1] = p[1]; if (tid < 256) V_ = *(const u32x4*)(VR + row * 512 + h * 128 + 16 * vb + 8 * dq); } while (0)
#define RS_WRITE(K_, V_, buf) do { *(u32x4*)((buf) + j * KPT + 32 * dq) = K_[0]; *(u32x4*)((buf) + j * KPT + 32 * dq + 16) = K_[1]; \
        if (tid < 256) *(u32x4*)((buf) + K_BYTES + j * VPT + 16 * dq) = V_; } while (0)
#define RS_COMP(buf, n) do { \
        f32x4 c = (f32x4){0.f, 0.f, 0.f, 0.f}; \
        _Pragma("unroll") for (int ks = 0; ks < 4; ++ks) { const int j0 = 32 * ks + 8 * g + (ln >> 2); \
            const unsigned char* ap = (buf) + K_BYTES + j0 * VPT + 8 * (ln & 3); const unsigned char* bp = (buf) + j0 * KPT + 32 * (wave & 3) + 8 * (ln & 3); \
            const s16x4_t a0 = lds_tr16(ap), a1 = lds_tr16(ap + 4 * VPT), b0 = lds_tr16(bp), b1 = lds_tr16(bp + 4 * KPT); \
            const bf16x8 af = (bf16x8){a0[0], a0[1], a0[2], a0[3], a1[0], a1[1], a1[2], a1[3]}, bf = (bf16x8){b0[0], b0[1], b0[2], b0[3], b1[0], b1[1], b1[2], b1[3]}; \
            c = mfma16(af, bf, c); } \
        if (wave < 4) { \
            bf16_t* sp = STATE + ((((size_t)b * 4 + h) * 32 + (n)) * 128 + 16 * vb + 4 * g) * 128 + 64 * dh + 16 * wave + ln; \
            _Pragma("unroll") for (int r = 0; r < 4; ++r) sp[r * 128] = (bf16_t)f2bf(gam * st[r]); \
            st = st * g128 + c * g127; } } while (0)
    u32x4 kC[2], kD[2], vC = (u32x4){0u, 0u, 0u, 0u}, vD = (u32x4){0u, 0u, 0u, 0u};
    RS_LOAD(kA, vA, 0); RS_LOAD(kB, vB, 1); RS_LOAD(kC, vC, 2); RS_LOAD(kD, vD, 3);
#pragma unroll 1
    for (int n = 0; n < 32; n += 4) {
        RS_WRITE(kA, vA, lds);        if (n + 4 < 32) RS_LOAD(kA, vA, n + 4); __syncthreads(); RS_COMP(lds, n);
        RS_WRITE(kB, vB, lds + BUF);  if (n + 5 < 32) RS_LOAD(kB, vB, n + 5); __syncthreads(); RS_COMP(lds + BUF, n + 1);
        RS_WRITE(kC, vC, lds);        if (n + 6 < 32) RS_LOAD(kC, vC, n + 6); __syncthreads(); RS_COMP(lds, n + 2);
        RS_WRITE(kD, vD, lds + BUF);  if (n + 7 < 32) RS_LOAD(kD, vD, n + 7); __syncthreads(); RS_COMP(lds + BUF, n + 3);
    }
#undef RS_LOAD
#undef RS_WRITE
#undef RS_COMP
    __syncthreads();
}

__device__ __forceinline__ float amax3(float a, float b, float c) { float r; asm("v_max3_f32 %0, %1, %2, %3" : "=v"(r) : "v"(a), "v"(b), "v"(c)); return r; }
__device__ __forceinline__ void attn_unit(int b, int h, int qb, const bf16_t* QA, const bf16_t* KA, const bf16_t* VA, const unsigned long long* MASK, bf16_t* AR,
                                          unsigned char* lds, int tid, int wave, int lane) {
    constexpr int KP = 144, KS_BYTES = 64 * KP, BUF = 2 * KS_BYTES;
    const int q0 = 256 * qb, r32 = lane & 31, hi = lane >> 5;
    const int t = q0 + 32 * wave + r32;
    const size_t qrow = (size_t)b * SEQ + t;
    bf16x8 qf[4];
#pragma unroll
    for (int d0 = 0; d0 < 4; ++d0) qf[d0] = *(const bf16x8*)(QA + qrow * 512 + h * 64 + 16 * d0 + 8 * hi);
    const int NT = (q0 + 256) / 64;
    const int key_l = tid >> 3, c8 = tid & 7;
    f32x16 o0, o1;
#pragma unroll
    for (int r = 0; r < 16; ++r) { o0[r] = 0.f; o1[r] = 0.f; }
    float m_run = NEG_INF, l_run = 0.f;
    u32x4 kreg[4], vreg[4]; unsigned long long mw[4];
#define AT_LOAD(i, kt) do { const size_t kr = (size_t)b * SEQ + 64 * (kt) + key_l; kreg[i] = *(const u32x4*)(KA + kr * 512 + h * 64 + 8 * c8); vreg[i] = *(const u32x4*)(VA + kr * 512 + h * 64 + 8 * c8); \
        mw[i] = MASK[qrow * 64 + (kt)]; } while (0)
#pragma unroll
    for (int i = 0; i < 4; ++i) AT_LOAD(i, i);
#pragma unroll 1
    for (int kt4 = 0; kt4 < NT; kt4 += 4) {
#pragma unroll
      for (int i = 0; i < 4; ++i) {
        const int kt = kt4 + i;
        unsigned char* buf = lds + (i & 1) * BUF;
        *(u32x4*)(buf + key_l * KP + 16 * c8) = kreg[i];
#pragma unroll
        for (int e = 0; e < 4; ++e) { const unsigned w = vreg[i][e]; const int d = 8 * c8 + 2 * e;
            *(unsigned short*)(buf + KS_BYTES + d * KP + 2 * key_l) = (unsigned short)(w & 0xffffu); *(unsigned short*)(buf + KS_BYTES + (d + 1) * KP + 2 * key_l) = (unsigned short)(w >> 16); }
        const unsigned long long mcur = mw[i];
        if (kt + 4 < NT) AT_LOAD(i, kt + 4);
        __syncthreads();
        if (64 * kt <= q0 + 32 * wave + 31) {
            f32x16 p0, p1;
#pragma unroll
            for (int r = 0; r < 16; ++r) { p0[r] = 0.f; p1[r] = 0.f; }
#pragma unroll
            for (int d0 = 0; d0 < 4; ++d0) {
                const bf16x8 a0 = *(const bf16x8*)(buf + r32 * KP + 32 * d0 + 16 * hi);
                const bf16x8 a1 = *(const bf16x8*)(buf + (32 + r32) * KP + 32 * d0 + 16 * hi);
                p0 = mfma32(a0, qf[d0], p0); p1 = mfma32(a1, qf[d0], p1);
            }
            const unsigned wl = (unsigned)mcur >> (4 * hi), wh = (unsigned)(mcur >> 32) >> (4 * hi);
#pragma unroll
            for (int r = 0; r < 16; ++r) { const int bp = (r & 3) + 8 * (r >> 2);
                const unsigned m0 = (unsigned)((int)(wl << (31 - bp)) >> 31), m1 = (unsigned)((int)(wh << (31 - bp)) >> 31);
                p0[r] = __uint_as_float((__float_as_uint(p0[r]) & m0) | (0xff800000u & ~m0)); p1[r] = __uint_as_float((__float_as_uint(p1[r]) & m1) | (0xff800000u & ~m1)); }
            float mx;
            { float a = amax3(p0[0], p0[1], p1[0]), bq = amax3(p0[2], p0[3], p1[1]); a = amax3(a, p1[2], p1[3]);
#pragma unroll
              for (int r = 4; r < 16; r += 4) { a = amax3(a, p0[r], p0[r + 1]); bq = amax3(bq, p0[r + 2], p0[r + 3]); a = amax3(a, p1[r], p1[r + 1]); bq = amax3(bq, p1[r + 2], p1[r + 3]); }
              mx = amax3(a, bq, bq); }
            mx = amax3(mx, __shfl_xor(mx, 32), mx);
            const float m_new = amax3(m_run, mx, mx);
            const float m_use = (m_new == NEG_INF) ? 0.f : m_new;
            const float alpha = fast_exp2(m_run - m_use);
            m_run = m_new;
            float ps = 0.f;
#pragma unroll
            for (int r = 0; r < 16; ++r) { p0[r] = fast_exp2(p0[r] - m_use); p1[r] = fast_exp2(p1[r] - m_use); ps += p0[r] + p1[r]; }
            l_run = l_run * alpha + ps;
            if (__any(alpha != 1.0f)) {
#pragma unroll
                for (int r = 0; r < 16; ++r) { o0[r] *= alpha; o1[r] *= alpha; }
            }
#pragma unroll
            for (int s4 = 0; s4 < 4; ++s4) {
                const int rb = 8 * (s4 & 1);
                u32x4 pw;
                if (s4 < 2) { pw.x = pk2(p0[rb], p0[rb + 1]); pw.y = pk2(p0[rb + 2], p0[rb + 3]); pw.z = pk2(p0[rb + 4], p0[rb + 5]); pw.w = pk2(p0[rb + 6], p0[rb + 7]); }
                else        { pw.x = pk2(p1[rb], p1[rb + 1]); pw.y = pk2(p1[rb + 2], p1[rb + 3]); pw.z = pk2(p1[rb + 4], p1[rb + 5]); pw.w = pk2(p1[rb + 6], p1[rb + 7]); }
                const bf16x8 bfr = __builtin_bit_cast(bf16x8, pw);
                { const unsigned char* vp = buf + KS_BYTES + r32 * KP + 2 * (16 * s4 + 4 * hi);
                  const u32x2 lo = *(const u32x2*)vp, h2 = *(const u32x2*)(vp + 16); const u32x4 av = (u32x4){lo.x, lo.y, h2.x, h2.y};
                  o0 = mfma32(__builtin_bit_cast(bf16x8, av), bfr, o0); }
                { const unsigned char* vp = buf + KS_BYTES + (32 + r32) * KP + 2 * (16 * s4 + 4 * hi);
                  const u32x2 lo = *(const u32x2*)vp, h2 = *(const u32x2*)(vp + 16); const u32x4 av = (u32x4){lo.x, lo.y, h2.x, h2.y};
                  o1 = mfma32(__builtin_bit_cast(bf16x8, av), bfr, o1); }
            }
        }
      }
    }
#undef AT_LOAD
    l_run += __shfl_xor(l_run, 32);
#ifdef DBG_NOATT
    const float inv = 0.f;
#else
    const float inv = 1.0f / l_run;
#endif
    bf16_t* op = AR + qrow * 1024 + h * 64 + 4 * hi;
#pragma unroll
    for (int c = 0; c < 4; ++c) {
        u32x2 w; w.x = pk2(o0[4 * c] * inv, o0[4 * c + 1] * inv); w.y = pk2(o0[4 * c + 2] * inv, o0[4 * c + 3] * inv); *(u32x2*)(op + 8 * c) = w;
        u32x2 v; v.x = pk2(o1[4 * c] * inv, o1[4 * c + 1] * inv); v.y = pk2(o1[4 * c + 2] * inv, o1[4 * c + 3] * inv); *(u32x2*)(op + 32 + 8 * c) = v;
    }
    __syncthreads();
}

__device__ __forceinline__ void ret_out_unit(int b, int h, int n, const bf16_t* QR, const bf16_t* KR, const bf16_t* VR, const bf16_t* GR, const bf16_t* STATE, bf16_t* AR,
                                             unsigned char* lds, int tid, int wave, int lane) {
    constexpr int PT = 272;
    const size_t c0 = (size_t)b * SEQ + 128 * n; const int hc = 128 * h;
    const int ln = lane & 15, g = lane >> 4;
    const size_t qrow = c0 + 16 * wave + ln;
    u32x4 rr[4];
    { const int j = tid & 127, vq = tid >> 7; const u32x4* p = (const u32x4*)(VR + (c0 + j) * 512 + hc + 32 * vq); rr[0] = p[0]; rr[1] = p[1]; rr[2] = p[2]; rr[3] = p[3]; }
    bf16x8 qf[4];
#pragma unroll
    for (int ks = 0; ks < 4; ++ks) qf[ks] = *(const bf16x8*)(QR + qrow * 512 + hc + 32 * ks + 8 * g);
    bf16x8 kf[8][4];
#pragma unroll
    for (int jt = 0; jt < 8; ++jt) if (jt <= wave) { const bf16_t* kp = KR + (c0 + 16 * jt + ln) * 512 + hc + 8 * g;
#pragma unroll
        for (int ks = 0; ks < 4; ++ks) kf[jt][ks] = *(const bf16x8*)(kp + 32 * ks); }
    u32x2 gw[8];
#pragma unroll
    for (int vt = 0; vt < 8; ++vt) gw[vt] = *(const u32x2*)(GR + qrow * 512 + hc + 16 * vt + 4 * g);
    { const int j = tid & 127, vq = tid >> 7;
#pragma unroll
      for (int i = 0; i < 4; ++i)
#pragma unroll
          for (int e = 0; e < 4; ++e) { const unsigned w = rr[i][e]; const int v = 32 * vq + 8 * i + 2 * e;
              *(unsigned short*)(lds + v * PT + 2 * j) = (unsigned short)(w & 0xffffu); *(unsigned short*)(lds + (v + 1) * PT + 2 * j) = (unsigned short)(w >> 16); } }
    __syncthreads();
    f32x4 sT[8];
#pragma unroll
    for (int jt = 0; jt < 8; ++jt) {
        f32x4 d = (f32x4){0.f, 0.f, 0.f, 0.f};
        if (jt <= wave) {
#pragma unroll
            for (int ks = 0; ks < 4; ++ks) d = mfma16(kf[jt][ks], qf[ks], d);
            if (jt == wave) {
#pragma unroll
                for (int r = 0; r < 4; ++r) if (4 * g + r > ln) d[r] = 0.f;
            }
        }
        sT[jt] = d;
    }
    f32x4 oT[8];
    const bf16_t* stp = STATE + (((size_t)b * 4 + h) * 32 + n) * 16384;
#pragma unroll
    for (int vt = 0; vt < 8; ++vt) {
        f32x4 d = (f32x4){0.f, 0.f, 0.f, 0.f};
#pragma unroll
        for (int ks = 0; ks < 4; ++ks) d = mfma16(*(const bf16x8*)(stp + (16 * vt + ln) * 128 + 32 * ks + 8 * g), qf[ks], d);
        oT[vt] = d;
    }
#pragma unroll
    for (int pr = 0; pr < 4; ++pr) if (2 * pr <= wave) {
        u32x4 pw; pw.x = pk2(sT[2 * pr][0], sT[2 * pr][1]); pw.y = pk2(sT[2 * pr][2], sT[2 * pr][3]); pw.z = pk2(sT[2 * pr + 1][0], sT[2 * pr + 1][1]); pw.w = pk2(sT[2 * pr + 1][2], sT[2 * pr + 1][3]);
        const bf16x8 bfr = __builtin_bit_cast(bf16x8, pw);
#pragma unroll
        for (int vt = 0; vt < 8; ++vt) {
            const unsigned char* vp = lds + (16 * vt + ln) * PT + 2 * (32 * pr + 4 * g);
            const u32x2 lo = *(const u32x2*)vp, h2 = *(const u32x2*)(vp + 32); const u32x4 av = (u32x4){lo.x, lo.y, h2.x, h2.y};
            oT[vt] = mfma16(__builtin_bit_cast(bf16x8, av), bfr, oT[vt]);
        }
    }
    float s = 0.f;
#pragma unroll
    for (int vt = 0; vt < 8; ++vt) s += (oT[vt][0] + oT[vt][1]) + (oT[vt][2] + oT[vt][3]);
    s += __shfl_xor(s, 16); s += __shfl_xor(s, 32);
    const float mean = s * (1.0f / 128.0f);
    float q = 0.f;
#pragma unroll
    for (int vt = 0; vt < 8; ++vt)
#pragma unroll
        for (int r = 0; r < 4; ++r) { const float d = oT[vt][r] - mean; q += d * d; }
    q += __shfl_xor(q, 16); q += __shfl_xor(q, 32);
    const float rstd = 1.0f / sqrtf(q * (1.0f / 128.0f) + EPS);
#pragma unroll
    for (int vt = 0; vt < 8; ++vt) {
        const float y0 = (oT[vt][0] - mean) * rstd * bf_lo(gw[vt].x), y1 = (oT[vt][1] - mean) * rstd * bf_hi(gw[vt].x);
        const float y2 = (oT[vt][2] - mean) * rstd * bf_lo(gw[vt].y), y3 = (oT[vt][3] - mean) * rstd * bf_hi(gw[vt].y);
        u32x2 w; w.x = pk2(y0, y1); w.y = pk2(y2, y3);
        *(u32x2*)(AR + qrow * 1024 + 512 + hc + 16 * vt + 4 * g) = w;
    }
    __syncthreads();
}

template <int N> __device__ __forceinline__ void bitonic_sort_desc(unsigned (&a)[N]) {
#pragma unroll
    for (int k = 2; k <= N; k <<= 1)
#pragma unroll
        for (int j = k >> 1; j > 0; j >>= 1)
#pragma unroll
            for (int i = 0; i < N; ++i) { const int l = i ^ j;
                if (l > i) { const unsigned x = a[i], y = a[l]; const unsigned mx = x > y ? x : y, mn = x > y ? y : x;
                    if ((i & k) == 0) { a[i] = mx; a[l] = mn; } else { a[i] = mn; a[l] = mx; } } }
}
template <int N> __device__ __forceinline__ void bitonic_merge_desc(unsigned (&a)[N]) {
#pragma unroll
    for (int j = N >> 1; j > 0; j >>= 1)
#pragma unroll
        for (int i = 0; i < N; ++i) { const int l = i ^ j;
            if (l > i) { const unsigned x = a[i], y = a[l]; a[i] = x > y ? x : y; a[l] = x > y ? y : x; } }
}
__device__ __forceinline__ void top16_merge(unsigned (&best)[16], const unsigned (&grp)[16]) {
#pragma unroll
    for (int i = 0; i < 16; ++i) { const unsigned x = best[i], y = grp[15 - i]; best[i] = x > y ? x : y; }
    bitonic_merge_desc<16>(best);
}
struct CandTab { int a[64], b[64], n; constexpr CandTab() : a{}, b{}, n(0) { for (int x = 0; x < 16; ++x) for (int y = 0; y < 16; ++y) if ((x + 1) * (y + 1) <= 16) { a[n] = x; b[n] = y; ++n; } } };
constexpr CandTab kCand{};
static_assert(kCand.n == 50, "staircase candidates");

constexpr int PL_EID = 0, PL_GATE = 16384, PL_IDX = 32768;
__device__ __forceinline__ void peer_unit(int unit, unsigned char* ws, float* outp, const float* gffn, const float* gfin, unsigned char* lds, int tid, int wave, int lane) {
    volatile LAS unsigned* MISC = (volatile LAS unsigned*)((LAS unsigned char*)lds + MISC_OFF); const int bid = unit;
    TSTAMP(70, 0);
    const bf16_t* SC = (const bf16_t*)(ws + WS_SC);
    const float* mod = (const float*)(ws + WS_MOD);
#ifndef DBG_NOPEER
    {
        const int tl = tid >> 4, h = (tid >> 1) & 7, p = tid & 1;
        const size_t row = (size_t)32 * unit + tl;
        const u32x4* sp = (const u32x4*)(SC + row * 2048 + h * 256 + p * 128);
        unsigned best[16];
#pragma unroll
        for (int grp = 0; grp < 8; ++grp) {
            unsigned k[16];
#pragma unroll
            for (int q4 = 0; q4 < 2; ++q4) { const u32x4 v = sp[2 * grp + q4];
#pragma unroll
                for (int e = 0; e < 4; ++e) { const int n0 = 16 * grp + 8 * q4 + 2 * e;
                    k[8 * q4 + 2 * e] = (sortable32(bf_lo(v[e])) & ~127u) | (unsigned)(127 - n0);
                    k[8 * q4 + 2 * e + 1] = (sortable32(bf_hi(v[e])) & ~127u) | (unsigned)(127 - (n0 + 1)); } }
            bitonic_sort_desc<16>(k);
            if (grp == 0) {
#pragma unroll
                for (int i = 0; i < 16; ++i) best[i] = k[i];
            } else top16_merge(best, k);
        }
        unsigned char* il = lds + PL_IDX + (tl * 8 + h) * 32;
#pragma unroll
        for (int i = 0; i < 4; ++i) { unsigned w = 0;
#pragma unroll
            for (int e = 0; e < 4; ++e) w |= (127u - (best[4 * i + e] & 127u)) << (8 * e);
            *(unsigned*)(il + p * 16 + 4 * i) = w; }
        float v1[16], v2[16];
#pragma unroll
        for (int i = 0; i < 16; ++i) { const unsigned o = __shfl_xor(best[i], 1); const float mine = unsortable32(best[i] & ~127u), oth = unsortable32(o & ~127u);
            v1[i] = p ? oth : mine; v2[i] = p ? mine : oth; }
        unsigned top[16];
#pragma unroll
        for (int grp = 0; grp < 4; ++grp) {
            unsigned k[16];
#pragma unroll
            for (int i = 0; i < 16; ++i) { const int c = 16 * grp + i;
                k[i] = (c < kCand.n) ? ((sortable32(v1[kCand.a[c < kCand.n ? c : 0]] + v2[kCand.b[c < kCand.n ? c : 0]]) & ~255u) | (unsigned)(255 - (16 * kCand.a[c < kCand.n ? c : 0] + kCand.b[c < kCand.n ? c : 0]))) : 0u; }
            bitonic_sort_desc<16>(k);
            if (grp == 0) {
#pragma unroll
                for (int i = 0; i < 16; ++i) top[i] = k[i];
            } else top16_merge(top, k);
        }
        float ts[16], es[16], sum = 0.f;
#pragma unroll
        for (int i = 0; i < 16; ++i) ts[i] = unsortable32(top[i] & ~255u);
#pragma unroll
        for (int i = 0; i < 16; ++i) { es[i] = __expf(ts[i] - ts[0]); sum += es[i]; }
        const float rs = 1.0f / sum;
        __builtin_amdgcn_wave_barrier(); asm volatile("s_waitcnt lgkmcnt(0)" ::: "memory");
        unsigned* eo = (unsigned*)(lds + PL_EID) + tl * 128 + h * 16;
        float* go = (float*)(lds + PL_GATE) + tl * 128 + h * 16;
#pragma unroll
        for (int i = 0; i < 16; ++i) {
            const unsigned flat = 255u - (top[i] & 255u);
            const unsigned i1 = il[flat >> 4], i2 = il[16 + (flat & 15u)];
            eo[i] = i1 * 128u + i2; go[i] = es[i] * rs;
        }
    }
#endif
    __syncthreads();
    TSTAMP(70, 2); TSTAMP(71, 0);
    const unsigned char* U8 = ws + WS_U8; const unsigned char* V8 = ws + WS_V8;
    const float* USC = (const float*)(ws + WS_USC); const float* VSC = (const float*)(ws + WS_VSC);
    const int me = ((lane >> 5) & 1) * 4 + ((lane >> 4) & 1) * 2 + ((lane >> 3) & 1);
#pragma unroll 1
    for (int ti = 0; ti < 4; ++ti) {
        const int tl = wave + 8 * ti; const size_t row = (size_t)32 * unit + tl; const int b = (int)(row >> 12);
        const float* mb = mod + b * 6144;
        float x1v[16]; f32x2 hv2[8], acc2[8];
        const float rstd = pg8::row_rstd((const float*)(ws + WS_SUMSQ), (int)row);
#pragma unroll
        for (int q4 = 0; q4 < 4; ++q4) { const int c = 16 * lane + 4 * q4;
            const f32x4 xv = *(const f32x4*)(outp + row * DM + c), g = *(const f32x4*)(gffn + c), sc = *(const f32x4*)(mb + 4096 + c), sh = *(const f32x4*)(mb + 3072 + c);
            float hq[4];
#pragma unroll
            for (int e = 0; e < 4; ++e) { x1v[4 * q4 + e] = xv[e]; hq[e] = xv[e] * rstd * g[e] * (1.0f + sc[e]) + sh[e]; }
            hv2[2 * q4] = (f32x2){hq[0], hq[1]}; hv2[2 * q4 + 1] = (f32x2){hq[2], hq[3]}; acc2[2 * q4] = (f32x2){0.f, 0.f}; acc2[2 * q4 + 1] = (f32x2){0.f, 0.f}; }
        const unsigned* el = (const unsigned*)(lds + PL_EID) + tl * 128; const float* gl = (const float*)(lds + PL_GATE) + tl * 128;
        u32x4 uA[8], vA[8]; float guA, gvA;
#define PEER_LOAD(U_, V_, GU_, GV_, e0_) do { _Pragma("unroll") for (int k = 0; k < 8; ++k) { const unsigned eid = el[(e0_) + k]; \
            U_[k] = *((const u32x4*)(U8 + (size_t)eid * 1024) + lane); V_[k] = *((const u32x4*)(V8 + (size_t)eid * 1024) + lane); } \
        { const unsigned em = el[(e0_) + me]; GU_ = USC[em]; GV_ = VSC[em] * gl[(e0_) + me]; } } while (0)
#define PEER_COMP(U_, V_, GU_, GV_) do { float pd[8]; \
        _Pragma("unroll") for (int k = 0; k < 8; ++k) { f32x2 d2 = (f32x2){0.f, 0.f}; \
            _Pragma("unroll") for (int i = 0; i < 4; ++i) { const f32x2 lo = __builtin_amdgcn_cvt_pk_f32_fp8(U_[k][i], false), hi2 = __builtin_amdgcn_cvt_pk_f32_fp8(U_[k][i], true); \
                d2 = __builtin_elementwise_fma(hv2[2 * i], lo, d2); d2 = __builtin_elementwise_fma(hv2[2 * i + 1], hi2, d2); } \
            pd[k] = d2.x + d2.y; } \
        float q4_[4], r2_[2], s_; \
        _Pragma("unroll") for (int k = 0; k < 4; ++k) { const float keep = (lane & 32) ? pd[k + 4] : pd[k], send = (lane & 32) ? pd[k] : pd[k + 4]; q4_[k] = keep + __shfl_xor(send, 32); } \
        _Pragma("unroll") for (int k = 0; k < 2; ++k) { const float keep = (lane & 16) ? q4_[k + 2] : q4_[k], send = (lane & 16) ? q4_[k] : q4_[k + 2]; r2_[k] = keep + __shfl_xor(send, 16); } \
        { const float keep = (lane & 8) ? r2_[1] : r2_[0], send = (lane & 8) ? r2_[0] : r2_[1]; s_ = keep + __shfl_xor(send, 8); } \
        s_ += __shfl_xor(s_, 4); s_ += __shfl_xor(s_, 2); s_ += __shfl_xor(s_, 1); \
        const float cf_ = GV_ * gelu_exact(s_ * GU_); \
        _Pragma("unroll") for (int k = 0; k < 8; ++k) { const float c = __uint_as_float((unsigned)__builtin_amdgcn_readlane((int)__float_as_uint(cf_), 32 * (k >> 2) + 16 * ((k >> 1) & 1) + 8 * (k & 1))); \
            const f32x2 c2 = (f32x2){c, c}; \
            _Pragma("unroll") for (int i = 0; i < 4; ++i) { const f32x2 lo = __builtin_amdgcn_cvt_pk_f32_fp8(V_[k][i], false), hi2 = __builtin_amdgcn_cvt_pk_f32_fp8(V_[k][i], true); \
                acc2[2 * i] = __builtin_elementwise_fma(c2, lo, acc2[2 * i]); acc2[2 * i + 1] = __builtin_elementwise_fma(c2, hi2, acc2[2 * i + 1]); } } } while (0)
#pragma unroll 1
        for (int e0 = 0; e0 < 128; e0 += 8) {
            PEER_LOAD(uA, vA, guA, gvA, e0);
            PEER_COMP(uA, vA, guA, gvA);
        }
#undef PEER_LOAD
#undef PEER_COMP
        float ss = 0.f;
#pragma unroll
        for (int q4 = 0; q4 < 4; ++q4) { const int c = 16 * lane + 4 * q4; const f32x4 gf = *(const f32x4*)(mb + 5120 + c);
#pragma unroll
            for (int e = 0; e < 4; ++e) { const int i = 4 * q4 + e; const float av = (e < 2) ? acc2[2 * q4][e] : acc2[2 * q4 + 1][e - 2]; x1v[i] = x1v[i] + gf[e] * av; ss += x1v[i] * x1v[i]; } }
        const float r2 = 1.0f / sqrtf(wave_sum(ss) * (1.0f / DM) + EPS);
#pragma unroll
        for (int q4 = 0; q4 < 4; ++q4) { const int c = 16 * lane + 4 * q4; const f32x4 gn = *(const f32x4*)(gfin + c);
            f32x4 o;
#pragma unroll
            for (int e = 0; e < 4; ++e) o[e] = x1v[4 * q4 + e] * r2 * gn[e];
            *(f32x4*)(outp + row * DM + c) = o; }
    }
    __syncthreads();
    TSTAMP(71, 2);
}

#define XB_TMO      128
#define XB_XCNT(j)  (256  + 64 * (j))
#define XB_XSUB(j)  (1280 + 64 * (j))
#define XB_XGEN(j)  (2304 + 64 * (j))
#define XB_TOP      3328
#define XB_TOPGEN   3392
#define XCD_BAR_WORDS 3456
#define XB_SPIN_CAP (1u << 18)

__device__ __forceinline__ unsigned xb_ld(unsigned* p)              { return __hip_atomic_load(p, __ATOMIC_RELAXED, __HIP_MEMORY_SCOPE_AGENT); }
__device__ __forceinline__ unsigned xb_add(unsigned* p, unsigned v) { return __hip_atomic_fetch_add(p, v, __ATOMIC_RELAXED, __HIP_MEMORY_SCOPE_AGENT); }
__device__ __forceinline__ unsigned xb_xcc_id() { return (unsigned)__builtin_amdgcn_s_getreg((3 << 11) | 20) & 0xFu; }
#define XB_SPIN(cond, bar) do { unsigned _sp = 0; while (cond) { __builtin_amdgcn_s_sleep(1); \
    if ((++_sp & 255u) == 0u) { if (xb_ld(&(bar)[XB_TMO])) break; if (_sp > XB_SPIN_CAP) { atomicAdd(&(bar)[XB_TMO], 1u); break; } } } } while (0)

struct XcdBarrier {
    unsigned* bar; unsigned x;
    volatile LAS unsigned* st;
};

__device__ __forceinline__ XcdBarrier xcd_barrier_post(unsigned* bar, volatile LAS unsigned* st) {
    XcdBarrier b; b.bar = bar; b.x = xb_xcc_id(); b.st = st;
    if (threadIdx.x == 0) (void)xb_add(&bar[XB_XCNT(b.x)], 1u);
    return b;
}
__device__ __forceinline__ void xcd_barrier_complete(unsigned* bar, unsigned x, unsigned& nloc, unsigned& nx) {
    const unsigned G = gridDim.x * gridDim.y * gridDim.z;
    unsigned sum, cnt, mine, sp = 0u;
    for (;;) {
        sum = 0u; cnt = 0u; mine = 0u;
#pragma unroll
        for (unsigned j = 0; j < 16; ++j) { const unsigned c = xb_ld(&bar[XB_XCNT(j)]); sum += c; cnt += (c > 0u) ? 1u : 0u; mine = (j == x) ? c : mine; }
        if (sum == G) break;
        __builtin_amdgcn_s_sleep(1);
        if ((++sp & 255u) == 0u) { if (xb_ld(&bar[XB_TMO])) break; if (sp > XB_SPIN_CAP) { atomicAdd(&bar[XB_TMO], 1u); break; } }
    }
    nloc = mine > 0u ? mine : 1u; nx = cnt > 0u ? cnt : 1u;
}

__device__ __forceinline__ void xcd_barrier(const XcdBarrier& b) {
    asm volatile("s_waitcnt vmcnt(0)" ::: "memory");
    __syncthreads();
    if (threadIdx.x == 0) {
        unsigned* bar = b.bar;
        __builtin_amdgcn_s_waitcnt(0);
        unsigned nloc = b.st[0], nx = b.st[1];
        if (nloc == 0u) { xcd_barrier_complete(bar, b.x, nloc, nx); b.st[0] = nloc; b.st[1] = nx; }
        const unsigned old = xb_add(&bar[XB_XSUB(b.x)], 1u);
        const unsigned gen = old / nloc;
        if (old + 1u == (gen + 1u) * nloc) {
            __builtin_amdgcn_fence(__ATOMIC_RELEASE, "agent");
            asm volatile("s_waitcnt vmcnt(0)" ::: "memory");
            const unsigned og = xb_add(&bar[XB_TOP], 1u);
            const unsigned tg = og / nx;
            if (og + 1u == (tg + 1u) * nx) xb_add(&bar[XB_TOPGEN], 1u);
            else XB_SPIN(xb_ld(&bar[XB_TOPGEN]) == tg, bar);
            __builtin_amdgcn_fence(__ATOMIC_ACQUIRE, "agent");
            xb_add(&bar[XB_XGEN(b.x)], 1u);
            asm volatile("s_waitcnt vmcnt(0)" ::: "memory");
        } else {
            XB_SPIN(xb_ld(&bar[XB_XGEN(b.x)]) == gen, bar);
            __builtin_amdgcn_fence(__ATOMIC_ACQUIRE, "agent");
            asm volatile("s_waitcnt vmcnt(0)" ::: "memory");
        }
    }
    __syncthreads();
}

constexpr int N_PHASES = 8;
__global__ void __launch_bounds__(NTHREADS, 2) mega(Args a) {
    extern __shared__ __attribute__((aligned(16))) unsigned char lds[];
    const int tid = threadIdx.x, lane = tid & 63, wave = __builtin_amdgcn_readfirstlane(tid >> 6);
    const int bid = blockIdx.x, G = gridDim.x;
    unsigned char* ws = a.ws;
    const int lo = a.ph_lo, hi = a.ph_hi;
    volatile LAS unsigned* MISC = (volatile LAS unsigned*)((LAS unsigned char*)lds + MISC_OFF);
    if (tid < 16) MISC[tid] = 0u;
    __syncthreads();
    XcdBarrier bar; bar.bar = (unsigned*)(ws + WS_CTL) + CW_BAR; bar.x = 0; bar.st = nullptr;
    if (hi - lo > 1) bar = xcd_barrier_post((unsigned*)(ws + WS_CTL) + CW_BAR, MISC + 8);
#ifndef PH_MASK
#define PH_MASK 0xFF
#endif
#define IN(k) (((PH_MASK >> (k)) & 1) && lo <= (k) && (k) < hi)
#define SEAM(k) do { if (IN(k) && IN((k) + 1)) { xcd_barrier(bar); } } while (0)
#ifdef REP_PH
#ifndef REP_N
#define REP_N 1
#endif
#define REPS(k) for (int rep_ = 0; rep_ < ((k) == REP_PH ? 1 + REP_N : 1); ++rep_, ((k) == REP_PH && rep_ <= REP_N ? (xcd_barrier(bar), 0) : 0))
#else
#define REPS(k)
#endif

    TSTAMP(100, 0);
    TSTAMP(0, 0);
    REPS(0) if (IN(0)) phase0(a, lds, tid, wave, lane, bid, G);
    SEAM(0);
    TSTAMP(0, 2);
    TSTAMP(1, 0);
    REPS(1) if (IN(1)) phase1(a, wave, lane, bid, G);
    SEAM(1);
    TSTAMP(1, 2);
    TSTAMP(2, 0);
    REPS(2) if (IN(2)) {
        pg8::Gemm g{(const bf16_t*)(ws + WS_BUFA), (const bf16_t*)(ws + WS_WIN), MTOK, N1, DM}; pg8::StaticOrder S; S.init(MTOK, N1, G, bid);
        pg8::Epi1 E{ws};
        pg8::gemm_phase<pg8::Epi1, pg8::StaticOrder, true, true>((LAS unsigned char*)lds, g, S, E);
        const int nfull = (MTOK / 256) * (N1 / 256) - 4 * G;
        { const bool tail = nfull > 0 && nfull < G; const int cw = tail ? (bid - nfull) * 8 + wave : bid * 8 + wave, NCW = tail ? (G - nfull) * 8 : G * 8;
          if (!tail || bid >= nfull)
              for (int it = cw; it < 4096; it += NCW) { const int r = 4 * it;
                  rows_to_fp8<4>(a.in[11] + (size_t)r * 1024, ws + WS_V8 + (size_t)r * 1024, (float*)(ws + WS_VSC) + r, lane); } }
    }
    SEAM(2);
    TSTAMP(2, 2);
    TSTAMP(3, 0);
    REPS(3) if (IN(3)) {
        TSTAMP(30, 0);
        const int vcu3 = (G % 8 == 0) ? (bid % 8) * (G / 8) + bid / 8 : bid;
        for (int u = vcu3; u < 256; u += G)
            ret_state_unit(u >> 6, (u >> 4) & 3, (u >> 1) & 7, u & 1, (const bf16_t*)(ws + WS_KR), (const bf16_t*)(ws + WS_VR), (bf16_t*)(ws + WS_STATE), lds, tid, wave, lane);
        TSTAMP(30, 2); TSTAMP(31, 0);
        for (int k = vcu3; k < 256; k += G) {
            const int b = k >> 6, j = k & 63;
#pragma unroll 1
            for (int i = 0; i < 4; ++i) {
                const int qt = (i == 0) ? j : (i == 1) ? 127 - j : (i == 2) ? 128 + j : 255 - j;
                idx_unit(b, qt, (const bf16_t*)(ws + WS_QI), (const bf16_t*)(ws + WS_KI), (const float*)(ws + WS_WI), (unsigned long long*)(ws + WS_MASK), lds, wave, lane, bid == TPROBE_B && i == TPROBE_I);
            }
        }
        TSTAMP(31, 2);
    }
    SEAM(3);
    TSTAMP(3, 2);
    TSTAMP(4, 0);
    REPS(4) if (IN(4)) {
        TSTAMP(40, 0);
        const int vcu = (G % 8 == 0) ? (bid % 8) * (G / 8) + bid / 8 : bid;
        for (int k = vcu; k < 256; k += G) {
            const int bh = k >> 3, s = k & 7;
#pragma unroll 1
            for (int i = 0; i < 2; ++i)
                attn_unit(bh >> 3, bh & 7, i ? 15 - s : s, (const bf16_t*)(ws + WS_QA), (const bf16_t*)(ws + WS_KA), (const bf16_t*)(ws + WS_VA), (const unsigned long long*)(ws + WS_MASK),
                          (bf16_t*)(ws + WS_BUFB), lds, tid, wave, lane);
        }
        TSTAMP(40, 2); TSTAMP(41, 0);
        for (int u = vcu; u < 256; u += G) {
            const int xg = u >> 5, ci = u & 31;
#pragma unroll 1
            for (int jj = 0; jj < 2; ++jj) { const int bh2 = 2 * xg + jj;
                ret_out_unit(bh2 >> 2, bh2 & 3, ci, (const bf16_t*)(ws + WS_QR), (const bf16_t*)(ws + WS_KR), (const bf16_t*)(ws + WS_VR), (const bf16_t*)(ws + WS_GR),
                             (const bf16_t*)(ws + WS_STATE), (bf16_t*)(ws + WS_BUFB), lds, tid, wave, lane); }
        }
        TSTAMP(41, 2);
    }
    SEAM(4);
    TSTAMP(4, 2);
    TSTAMP(5, 0);
    REPS(5) if (IN(5)) {
        pg8::Gemm g{(const bf16_t*)(ws + WS_BUFB), (const bf16_t*)(ws + WS_WOUT), MTOK, DM, DM}; pg8::StaticOrder S; S.init(MTOK, DM, G, bid);
        pg8::Epi2 E{a.in[0], a.out, (bf16_t*)(ws + WS_BUFA), (const float*)(ws + WS_MOD), a.in[7], (float*)(ws + WS_SUMSQ)};
        pg8::gemm_phase<pg8::Epi2, pg8::StaticOrder, true, true>((LAS unsigned char*)lds, g, S, E);
    }
    SEAM(5);
    TSTAMP(5, 2);
    TSTAMP(6, 0);
    REPS(6) if (IN(6)) {
        pg8::Gemm g{(const bf16_t*)(ws + WS_BUFA), (const bf16_t*)(ws + WS_WPQ), MTOK, 2048, DM}; pg8::StaticOrder S; S.init(MTOK, 2048, G, bid);
        pg8::Epi3 E{(const float*)(ws + WS_SUMSQ), (const float*)(ws + WS_BIASF), (bf16_t*)(ws + WS_SC)};
        pg8::gemm_phase<pg8::Epi3, pg8::StaticOrder, true, true>((LAS unsigned char*)lds, g, S, E);
    }
    SEAM(6);
    TSTAMP(6, 2);
    TSTAMP(7, 0);
    if (IN(7)) {
        if (G == 256) { const int xg = bid & 7, i = bid >> 3;
            peer_unit(64 * xg + i, ws, a.out, a.in[7], a.in[12], lds, tid, wave, lane); peer_unit(64 * xg + 32 + i, ws, a.out, a.in[7], a.in[12], lds, tid, wave, lane); }
        else for (int u = bid; u < 512; u += G) peer_unit(u, ws, a.out, a.in[7], a.in[12], lds, tid, wave, lane);
    }
    TSTAMP(7, 2);
    TSTAMP(100, 2);
#ifdef TIME_PH
    if (bid == TPROBE_B && tid == 0) {
        const unsigned long long t0_ = ((unsigned long long)MISC[1] << 32) | MISC[0], t1_ = ((unsigned long long)MISC[3] << 32) | MISC[2];
        const unsigned long long until_ = __builtin_amdgcn_s_memrealtime() + (unsigned long long)TIME_AMP * (t1_ - t0_);
        while (__builtin_amdgcn_s_memrealtime() < until_) __builtin_amdgcn_s_sleep(8);
    }
#endif
#undef IN
#undef SEAM
}

extern "C" void kernel_launch(void* const* d_in, const int* in_sizes, int n_in, void* d_out, int out_size, void* d_ws, size_t ws_size, hipStream_t stream) {
    static int grid = 0;
    if (grid == 0) {
        if (n_in != 13 || out_size != MTOK * DM || ws_size < WS_END) { fprintf(stderr, "kernel_launch: unexpected shapes (n_in %d, out %d, ws %zu); nothing launched\n", n_in, out_size, ws_size); grid = -1; return; }
        int dev = 0, cus = 0, per_cu = 0;
        if (hipGetDevice(&dev) != hipSuccess || hipDeviceGetAttribute(&cus, hipDeviceAttributeMultiprocessorCount, dev) != hipSuccess) { grid = -1; return; }
        if (hipFuncSetAttribute((const void*)mega, hipFuncAttributeMaxDynamicSharedMemorySize, LDS_BYTES) != hipSuccess) { fprintf(stderr, "kernel_launch: hipFuncSetAttribute failed\n"); grid = -1; return; }
        if (hipOccupancyMaxActiveBlocksPerMultiprocessor(&per_cu, (const void*)mega, NTHREADS, LDS_BYTES) != hipSuccess || per_cu < 1) { fprintf(stderr, "kernel_launch: occupancy query gave %d\n", per_cu); per_cu = 1; }
        (void)hipGetLastError();
        grid = cus;
    }
    if (grid < 0) return;
    if (hipMemsetAsync((char*)d_ws + WS_CTL + (size_t)CW_BAR * 4, 0, (size_t)XCD_BAR_WORDS * 4, stream) != hipSuccess) { fprintf(stderr, "kernel_launch: memset failed\n"); return; }
    Args a{};
    for (int i = 0; i < 13; ++i) a.in[i] = (const float*)d_in[i];
    a.out = (float*)d_out; a.ws = (unsigned char*)d_ws;
#if MK_MULTI
    for (int p = 0; p < N_PHASES; ++p) { a.ph_lo = p; a.ph_hi = p + 1; hipLaunchKernelGGL(mega, dim3(grid), dim3(NTHREADS), LDS_BYTES, stream, a); }
#else
    a.ph_lo = 0; a.ph_hi = N_PHASES;
    hipLaunchKernelGGL(mega, dim3(grid), dim3(NTHREADS), LDS_BYTES, stream, a);
#endif
}
```

```cpp
#include <hip/hip_runtime.h>
#include <cstdio>
#include <cstdint>

#ifndef MK_MULTI
#define MK_MULTI 0
#endif

#define GAS __attribute__((address_space(1)))
#define LAS __attribute__((address_space(3)))
typedef unsigned short bf16_t;
typedef short bf16x8 __attribute__((ext_vector_type(8)));
typedef float f32x4 __attribute__((ext_vector_type(4)));
typedef float f32x16 __attribute__((ext_vector_type(16)));
typedef unsigned u32x4 __attribute__((ext_vector_type(4)));
typedef unsigned u32x2 __attribute__((ext_vector_type(2)));

constexpr int BATCH = 4, SEQ = 4096, DM = 1024, MTOK = BATCH * SEQ;
constexpr int N1 = 4352;
constexpr int NTHREADS = 512;
constexpr float EPS = 1e-6f;
constexpr float C_QK = 0.18033688011112042f;
constexpr float NEG_INF = -__builtin_huge_valf();

__device__ __forceinline__ float ret_log2g(int h) { return h == 0 ? -0.045803689613124791f : h == 1 ? -0.022720076500083530f : h == 2 ? -0.011315313227834147f : -0.0056465631411420624f; }
__device__ __forceinline__ float ret_gamma(int h) { return h == 0 ? 0.96875f : h == 1 ? 0.984375f : h == 2 ? 0.9921875f : 0.99609375f; }
__device__ __forceinline__ float ret_g128(int h) { return h == 0 ? 0.017183023570817902f : h == 1 ? 0.13321516287964842f : h == 2 ? 0.36643771592203725f : 0.60593708822908032f; }
__device__ __forceinline__ float ret_g127(int h) { return h == 0 ? 0.017737314653747512f : h == 1 ? 0.13532968927456347f : h == 2 ? 0.36932305226788007f : 0.60831331210448848f; }

constexpr size_t MiB = 1u << 20;
constexpr size_t WS_CTL = 0, CTL_BYTES = 1 * MiB;
constexpr size_t WS_SUMSQ = 5 * MiB;
constexpr size_t WS_MOD = 1 * MiB;
constexpr size_t WS_BIASF = 1 * MiB + 128 * 1024;
constexpr size_t WS_COSA = 2 * MiB, WS_SINA = 2 * MiB + 512 * 1024;
constexpr size_t WS_COSR = 3 * MiB, WS_SINR = 4 * MiB;
constexpr size_t WS_WIN = 6 * MiB;
constexpr size_t WS_WOUT = 15 * MiB;
constexpr size_t WS_WPQ = 17 * MiB;
constexpr size_t WS_BUFA = 22 * MiB;
constexpr size_t WS_MASK = WS_BUFA, WS_STATE = WS_BUFA + 8 * MiB;
constexpr size_t WS_BUFB = 54 * MiB;
constexpr size_t WS_G1 = 86 * MiB;
constexpr size_t WS_QA = WS_G1, WS_KA = WS_G1 + 16 * MiB, WS_VA = WS_G1 + 32 * MiB, WS_QI = WS_G1 + 48 * MiB, WS_QR = WS_G1 + 64 * MiB,
                 WS_KR = WS_G1 + 80 * MiB, WS_VR = WS_G1 + 96 * MiB, WS_GR = WS_G1 + 112 * MiB, WS_KI = WS_G1 + 128 * MiB, WS_WI = WS_G1 + 130 * MiB;
constexpr size_t WS_SC = WS_G1;
constexpr size_t WS_U8 = 217 * MiB, WS_V8 = 233 * MiB;
constexpr size_t WS_USC = 249 * MiB, WS_VSC = 249 * MiB + 65536;
constexpr size_t WS_END = 256 * MiB;
static_assert(WS_WI + (size_t)MTOK * 8 * 4 <= WS_U8 && WS_SC + (size_t)MTOK * 2048 * 4 <= WS_U8 && WS_VSC + 65536 <= WS_END, "ws map");
constexpr int LDS_BYTES = 147456;
constexpr int MISC_OFF = LDS_BYTES - 64;
constexpr int CW_BAR = 4096;

__device__ __forceinline__ unsigned f2bf(float f) { unsigned u = __float_as_uint(f); return (u + 0x7fffu + ((u >> 16) & 1u)) >> 16; }
typedef float f32x2_t __attribute__((ext_vector_type(2))); typedef __bf16 bf16x2_t __attribute__((ext_vector_type(2)));
__device__ __forceinline__ unsigned pk2(float lo, float hi) { const f32x2_t v = {lo, hi}; const bf16x2_t b = __builtin_convertvector(v, bf16x2_t); return __builtin_bit_cast(unsigned, b); }
__device__ __forceinline__ float bf_lo(unsigned w) { return __uint_as_float(w << 16); }
__device__ __forceinline__ float bf_hi(unsigned w) { return __uint_as_float(w & 0xffff0000u); }
__device__ __forceinline__ float wave_sum(float v) {
#pragma unroll
    for (int o = 1; o < 64; o <<= 1) v += __shfl_xor(v, o);
    return v;
}
__device__ __forceinline__ float fast_exp2(float x) { return __builtin_amdgcn_exp2f(x); }
__device__ __forceinline__ float gelu_exact(float v) {
    const float av = fabsf(v), t = __builtin_amdgcn_rcpf(av * 0.2316418882f + 1.0f);
    float q = t * 0.5307027145f + (-0.7265760135f); q = q * t + 0.7107068705f; q = q * t + (-0.142248368f); q = q * t + 0.127414796f; q = q * t;
    const float e = fast_exp2(v * v * (-0.72134752044f));
    const float m = v * (q * e);
    return v < 0.f ? m : v - m;
}
__device__ __forceinline__ float silu_f(float v) { return v / (1.0f + __expf(-v)); }
__device__ __forceinline__ unsigned sortable32(float f) { const unsigned u = __float_as_uint(f); return (u & 0x80000000u) ? ~u : (u | 0x80000000u); }
__device__ __forceinline__ float unsortable32(unsigned s) { return __uint_as_float((s & 0x80000000u) ? (s ^ 0x80000000u) : ~s); }
__device__ __forceinline__ unsigned sortable16(float x) {
    const _Float16 h = (_Float16)x; const unsigned b = (unsigned)__builtin_bit_cast(unsigned short, h);
    return (b & 0x8000u) ? (~b & 0xFFFFu) : (b | 0x8000u);
}
__device__ __forceinline__ f32x4 mfma16(bf16x8 a, bf16x8 b, f32x4 c) { return __builtin_amdgcn_mfma_f32_16x16x32_bf16(a, b, c, 0, 0, 0); }
__device__ __forceinline__ f32x16 mfma32(bf16x8 a, bf16x8 b, f32x16 c) { return __builtin_amdgcn_mfma_f32_32x32x16_bf16(a, b, c, 0, 0, 0); }

__host__ __device__ __forceinline__ int win_src_col(int p) {
    const int tile = p >> 8, bj = (p >> 7) & 1, q = p & 127;
    if (tile < 4) return 256 * tile + (q >> 5) * 64 + bj * 32 + (q & 31);
    if (tile < 6) return p;
    if (tile < 8) return 256 * tile + (q >> 5) * 64 + bj * 32 + (q & 31);
    if (tile == 8) { if (q < 32) return 2048 + bj * 32 + q; if (bj == 0 && q < 40) return 2112 + (q - 32); return -1; }
    if (tile < 13) { const int base = (tile < 11) ? 2120 + 256 * (tile - 9) : 2632 + 256 * (tile - 11); return base + (q >> 6) * 128 + bj * 64 + (q & 63); }
    if (tile < 15) return 3144 + (p - 13 * 256);
    return 3656 + (p - 15 * 256);
}
namespace pg8 {
#define PG8_LAS __attribute__((address_space(3)))
typedef unsigned short bf16_t;
typedef short bf16x8 __attribute__((ext_vector_type(8)));
typedef float f32x4 __attribute__((ext_vector_type(4)));
typedef unsigned u32x4 __attribute__((ext_vector_type(4)));
constexpr int BM = 256, BK = 64, HALF = 128, HTB = HALF * BK * 2  , STAGE_BYTES = 8 * HTB, NXCD = 8, WGM = 8;

__host__ __device__ __forceinline__ int lds_byte(int r, int c) { const int st = (r >> 4) * 2 + (c >> 5), rr = r & 15, cc = c & 31, ob = rr * 64 + cc * 2; return st * 1024 + (ob ^ (((ob >> 9) & 1) << 5)); }
__host__ __device__ __forceinline__ void stage_rc(int b, int& R, int& C) { const int st = b / 1024, sb = b % 1024, swz = sb ^ (((sb >> 9) & 1) << 5); R = (st >> 1) * 16 + swz / 64; C = (st & 1) * 32 + (swz % 64) / 2; }
__host__ __device__ __forceinline__ int perm32(int rho) { const int n = rho >> 4, i = rho & 15; return 8 * (i >> 2) + 4 * n + (i & 3); }

struct Unit { int pm, pn; };
struct Gemm { const bf16_t* A; const bf16_t* Bt; int M, N, K; };

struct StaticOrder {
    int nM, nN, nwg, G, c;
    __host__ __device__ void init(int M, int N, int G_, int c_) { nM = M / BM; nN = N / BM; nwg = nM * nN; G = G_; c = c_; }
    __host__ __device__ bool next(int i, Unit& u) const {
        const long L = (long)i * G + c; if (L >= nwg) return false;
        int wgid = (int)L; { const int q = nwg / NXCD, r = nwg % NXCD, xcd = wgid % NXCD, off = wgid / NXCD; wgid = (xcd < r ? xcd * (q + 1) : r * (q + 1) + (xcd - r) * q) + off; }
        const int nig = WGM * nN, gid = wgid / nig, fm = gid * WGM, gsz = (nM - fm) < WGM ? (nM - fm) : WGM;
        u.pm = fm + ((wgid % nig) % gsz); u.pn = (wgid % nig) / gsz; return true;
    }
    __device__ __forceinline__ void a_ready(const Unit&) const {}
    __device__ __forceinline__ void done(const Unit&) const {}
};

__device__ __forceinline__ unsigned cvt_pk_bf16(float lo, float hi) { unsigned r; asm volatile("v_cvt_pk_bf16_f32 %0, %1, %2" : "=v"(r) : "v"(lo), "v"(hi)); return r; }
__device__ __forceinline__ u32x4 pack8(const float (&v)[8]) { u32x4 w; w.x = cvt_pk_bf16(v[0], v[1]); w.y = cvt_pk_bf16(v[2], v[3]); w.z = cvt_pk_bf16(v[4], v[5]); w.w = cvt_pk_bf16(v[6], v[7]); return w; }

struct Epi1 {
    static constexpr bool PERM = true, AFTER_DRAIN = false;
    unsigned char* ws;
    __device__ __forceinline__ void operator()(const f32x4 (&acc)[2][2][4][2], const Unit& u, int wr, int wc, int fr, int fq) const {
        const int tile = u.pn;
        const int row0 = u.pm * BM + wr * 64 + fr;
        const float* cosA = (const float*)(ws + WS_COSA); const float* sinA = (const float*)(ws + WS_SINA);
        const float* cosR = (const float*)(ws + WS_COSR); const float* sinR = (const float*)(ws + WS_SINR);
        if (tile < 4 || tile == 6 || tile == 7) {
            bf16_t* dst = (bf16_t*)(ws + (tile < 2 ? WS_QA : tile < 4 ? WS_KA : WS_QI));
            const int tl = tile < 2 ? tile : tile < 4 ? tile - 2 : tile - 6;
            const float scale = tile < 2 ? C_QK : 1.0f;
            const int cb = 256 * tl + 64 * wc, i0 = 8 * fq;
#pragma unroll
            for (int ai = 0; ai < 2; ++ai)
#pragma unroll
                for (int m = 0; m < 4; ++m) {
                    const int row = row0 + ai * HALF + m * 16, pos = row & (SEQ - 1);
                    const f32x4 c0 = *(const f32x4*)(cosA + pos * 32 + i0), c1 = *(const f32x4*)(cosA + pos * 32 + i0 + 4);
                    const f32x4 s0 = *(const f32x4*)(sinA + pos * 32 + i0), s1 = *(const f32x4*)(sinA + pos * 32 + i0 + 4);
                    float y1[8], y2[8];
#pragma unroll
                    for (int n = 0; n < 2; ++n)
#pragma unroll
                        for (int e = 0; e < 4; ++e) {
                            const float x1 = acc[ai][0][m][n][e], x2 = acc[ai][1][m][n][e];
                            const float c = n ? c1[e] : c0[e], s = n ? s1[e] : s0[e];
                            y1[4 * n + e] = (x1 * c - x2 * s) * scale; y2[4 * n + e] = (x1 * s + x2 * c) * scale;
                        }
                    bf16_t* rp = dst + (size_t)row * 512 + cb + i0;
                    *(u32x4*)rp = pack8(y1); *(u32x4*)(rp + 32) = pack8(y2);
                }
        } else if (tile == 4 || tile == 5 || tile >= 13) {
            bf16_t* dst = (bf16_t*)(ws + (tile < 6 ? WS_VA : tile < 15 ? WS_VR : WS_GR));
            const int tl = tile < 6 ? tile - 4 : tile < 15 ? tile - 13 : tile - 15;
            const bool act = tile >= 15;
#pragma unroll
            for (int ai = 0; ai < 2; ++ai)
#pragma unroll
                for (int m = 0; m < 4; ++m) {
                    const int row = row0 + ai * HALF + m * 16;
#pragma unroll
                    for (int bj = 0; bj < 2; ++bj) {
                        float y[8];
#pragma unroll
                        for (int n = 0; n < 2; ++n)
#pragma unroll
                            for (int e = 0; e < 4; ++e) { const float v = acc[ai][bj][m][n][e]; y[4 * n + e] = act ? silu_f(v) : v; }
                        *(u32x4*)(dst + (size_t)row * 512 + 256 * tl + 128 * bj + 32 * wc + 8 * fq) = pack8(y);
                    }
                }
        } else if (tile == 8) {
#pragma unroll
            for (int ai = 0; ai < 2; ++ai)
#pragma unroll
                for (int m = 0; m < 4; ++m) {
                    const int row = row0 + ai * HALF + m * 16, pos = row & (SEQ - 1);
                    if (wc == 0) {
                        const int i0 = 8 * fq;
                        const f32x4 c0 = *(const f32x4*)(cosA + pos * 32 + i0), c1 = *(const f32x4*)(cosA + pos * 32 + i0 + 4);
                        const f32x4 s0 = *(const f32x4*)(sinA + pos * 32 + i0), s1 = *(const f32x4*)(sinA + pos * 32 + i0 + 4);
                        float y1[8], y2[8];
#pragma unroll
                        for (int n = 0; n < 2; ++n)
#pragma unroll
                            for (int e = 0; e < 4; ++e) {
                                const float x1 = acc[ai][0][m][n][e], x2 = acc[ai][1][m][n][e];
                                const float c = n ? c1[e] : c0[e], s = n ? s1[e] : s0[e];
                                y1[4 * n + e] = x1 * c - x2 * s; y2[4 * n + e] = x1 * s + x2 * c;
                            }
                        bf16_t* rp = (bf16_t*)(ws + WS_KI) + (size_t)row * 64 + i0;
                        *(u32x4*)rp = pack8(y1); *(u32x4*)(rp + 32) = pack8(y2);
                    } else if (wc == 1 && fq == 0) {
                        const float sw = 0.35355339059327379f;
                        float* WI = (float*)(ws + WS_WI);
                        *(f32x4*)(WI + (size_t)row * 8) = acc[ai][0][m][0] * sw;
                        *(f32x4*)(WI + (size_t)row * 8 + 4) = acc[ai][0][m][1] * sw;
                    }
                }
        } else {
            const bool isk = tile >= 11;
            bf16_t* dst = (bf16_t*)(ws + (isk ? WS_KR : WS_QR));
            const int tl = isk ? tile - 11 : tile - 9, hl = wc >> 1, h = 2 * tl + hl;
            const int i0 = 32 * (wc & 1) + 8 * fq, cb = 256 * tl + 128 * hl;
            const float lg = isk ? -ret_log2g(h) : ret_log2g(h);
            const float base = isk ? 0.08838834764831845f : 1.0f;
#pragma unroll
            for (int ai = 0; ai < 2; ++ai)
#pragma unroll
                for (int m = 0; m < 4; ++m) {
                    const int row = row0 + ai * HALF + m * 16, pos = row & (SEQ - 1);
                    const float dec = base * fast_exp2(lg * (float)(pos & 127));
                    const f32x4 c0 = *(const f32x4*)(cosR + pos * 64 + i0), c1 = *(const f32x4*)(cosR + pos * 64 + i0 + 4);
                    const f32x4 s0 = *(const f32x4*)(sinR + pos * 64 + i0), s1 = *(const f32x4*)(sinR + pos * 64 + i0 + 4);
                    float y1[8], y2[8];
#pragma unroll
                    for (int n = 0; n < 2; ++n)
#pragma unroll
                        for (int e = 0; e < 4; ++e) {
                            const float x1 = acc[ai][0][m][n][e], x2 = acc[ai][1][m][n][e];
                            const float c = n ? c1[e] : c0[e], s = n ? s1[e] : s0[e];
                            y1[4 * n + e] = (x1 * c - x2 * s) * dec; y2[4 * n + e] = (x1 * s + x2 * c) * dec;
                        }
                    bf16_t* rp = dst + (size_t)row * 512 + cb + i0;
                    *(u32x4*)rp = pack8(y1); *(u32x4*)(rp + 64) = pack8(y2);
                }
        }
    }
};

__device__ __forceinline__ float row_rstd(const float* sumsq, int row) {
    const f32x4* p = (const f32x4*)(sumsq + (size_t)row * 16);
    const f32x4 a = p[0], b = p[1], c = p[2], d = p[3];
    const float s = (((a[0] + a[1]) + (a[2] + a[3])) + ((b[0] + b[1]) + (b[2] + b[3]))) + (((c[0] + c[1]) + (c[2] + c[3])) + ((d[0] + d[1]) + (d[2] + d[3])));
    return 1.0f / sqrtf(s * (1.0f / DM) + EPS);
}
struct Epi2 {
    static constexpr bool PERM = false, AFTER_DRAIN = false;
    const float* x; float* x1; bf16_t* a3; const float* mod; const float* gffn; float* sumsq;
    __device__ __forceinline__ void operator()(const f32x4 (&acc)[2][2][4][2], const Unit& u, int wr, int wc, int fr, int fq) const {
        const int row0 = u.pm * BM + wr * 64 + fr, col0 = u.pn * BM + wc * 32 + 4 * fq;
#pragma unroll
        for (int ai = 0; ai < 2; ++ai)
#pragma unroll
            for (int m = 0; m < 4; ++m) {
                const int row = row0 + ai * HALF + m * 16, b = row >> 12;
                const float* mb = mod + b * 6144;
                float ss = 0.f;
#pragma unroll
                for (int bj = 0; bj < 2; ++bj)
#pragma unroll
                    for (int n = 0; n < 2; ++n) {
                        const int c = col0 + bj * HALF + n * 16;
                        const f32x4 xv = *(const f32x4*)(x + (size_t)row * DM + c), gt = *(const f32x4*)(mb + 2048 + c);
#ifdef DBG_NOMIX
                        const f32x4 v = xv;
#else
                        const f32x4 v = xv + gt * acc[ai][bj][m][n];
#endif
                        *(f32x4*)(x1 + (size_t)row * DM + c) = v;
                        ss += (v[0] * v[0] + v[1] * v[1]) + (v[2] * v[2] + v[3] * v[3]);
                        const f32x4 gs = *(const f32x4*)(gffn + c) * (*(const f32x4*)(mb + 4096 + c) + 1.0f);
                        const f32x4 a = v * gs;
                        u32x2 w; w.x = cvt_pk_bf16(a[0], a[1]); w.y = cvt_pk_bf16(a[2], a[3]);
                        *(u32x2*)(a3 + (size_t)row * DM + c) = w;
                    }
                ss += __shfl_xor(ss, 16); ss += __shfl_xor(ss, 32);
                if (fq == 0) sumsq[(size_t)row * 16 + u.pn * 4 + wc] = ss;
            }
    }
};

struct Epi3 {
    static constexpr bool PERM = true, AFTER_DRAIN = false;
    const float* sumsq; const float* biasf; bf16_t* sc;
    __device__ __forceinline__ void operator()(const f32x4 (&acc)[2][2][4][2], const Unit& u, int wr, int wc, int fr, int fq) const {
        const int row0 = u.pm * BM + wr * 64 + fr, col0 = u.pn * BM + wc * 32 + 8 * fq;
#pragma unroll
        for (int ai = 0; ai < 2; ++ai)
#pragma unroll
            for (int m = 0; m < 4; ++m) {
                const int row = row0 + ai * HALF + m * 16, b = row >> 12;
                const float rstd = row_rstd(sumsq, row);
#pragma unroll
                for (int bj = 0; bj < 2; ++bj) {
                    const int c = col0 + bj * HALF;
                    const f32x4 b0 = *(const f32x4*)(biasf + b * 2048 + c), b1 = *(const f32x4*)(biasf + b * 2048 + c + 4);
                    const f32x4 v0 = acc[ai][bj][m][0] * rstd + b0, v1 = acc[ai][bj][m][1] * rstd + b1;
                    u32x4 w; w.x = cvt_pk_bf16(v0[0], v0[1]); w.y = cvt_pk_bf16(v0[2], v0[3]); w.z = cvt_pk_bf16(v1[0], v1[1]); w.w = cvt_pk_bf16(v1[2], v1[3]);
                    *(u32x4*)(sc + (size_t)row * 2048 + c) = w;
                }
            }
    }
};

template <class Epi, class Sched, bool ALIGN_EPI = false, bool SP2 = false>
__device__ __forceinline__ void gemm_phase(PG8_LAS unsigned char* lds, const Gemm g, const Sched& S, const Epi& E) {
    const int tid = threadIdx.x, wid = __builtin_amdgcn_readfirstlane(tid >> 6), lane = tid & 63, wr = wid >> 2, wc = wid & 3, fr = lane & 15, fq = lane >> 4;
    const int K = g.K, nt = K / BK;
    unsigned voffA[2], voffB[2];
#pragma unroll
    for (int i = 0; i < 2; ++i) { int R, C; stage_rc(tid * 16 + i * 8192, R, C); const int Rb = Epi::PERM ? ((R & ~31) + perm32(R & 31)) : R;
        voffA[i] = (unsigned)(R * K + C) * 2u; voffB[i] = (unsigned)(Rb * K + C) * 2u; }
    const size_t kstep = (size_t)(BK * 2);
    const size_t hstep = (size_t)HALF * K * 2;
    const size_t tstep = 2 * hstep;
    const unsigned ldsw = (unsigned)wid * 1024u;
    const int aoff = lds_byte(wr * 64 + fr, fq * 8), boff = lds_byte(wc * 32 + fr, fq * 8);
#define PG8_SA(b, h) (((b) * 2 + (h)) * HTB)
#define PG8_SB(b, h) ((4 + (b) * 2 + (h)) * HTB)
#define PG8_STAGE(bufoff, gbase, voff) do { _Pragma("unroll") for (int _i = 0; _i < 2; ++_i) \
        __builtin_amdgcn_global_load_lds((const unsigned*)((const char*)(gbase) + (voff)[_i]), (PG8_LAS unsigned*)(lds + (bufoff) + ldsw + _i * 8192), 16, 0, 0); } while (0)
#define PG8_LDA(dst, b, h) do { _Pragma("unroll") for (int m = 0; m < 4; ++m) _Pragma("unroll") for (int k = 0; k < 2; ++k) dst[m][k] = *(const PG8_LAS bf16x8*)(lds + PG8_SA(b, h) + aoff + m * 2048 + k * 1024); } while (0)
#define PG8_LDB(dst, b, h) do { _Pragma("unroll") for (int n = 0; n < 2; ++n) _Pragma("unroll") for (int k = 0; k < 2; ++k) dst[n][k] = *(const PG8_LAS bf16x8*)(lds + PG8_SB(b, h) + boff + n * 2048 + k * 1024); } while (0)
#define PG8_MMA(ai, bj, At, Bt) do { __builtin_amdgcn_s_setprio(1); _Pragma("unroll") for (int m = 0; m < 4; ++m) _Pragma("unroll") for (int n = 0; n < 2; ++n) _Pragma("unroll") for (int k = 0; k < 2; ++k) \
        acc[ai][bj][m][n] = __builtin_amdgcn_mfma_f32_16x16x32_bf16(Bt[n][k], At[m][k], acc[ai][bj][m][n], 0, 0, 0); __builtin_amdgcn_s_setprio(0); } while (0)
#define PG8_WAIT_V(n) asm volatile("s_waitcnt vmcnt(" #n ")" ::: "memory")
#define PG8_WAIT_L(n) asm volatile("s_waitcnt lgkmcnt(" #n ")" ::: "memory")
#define PG8_BAR __builtin_amdgcn_s_barrier()
#define PG8_SCHED __builtin_amdgcn_sched_barrier(0)
    Unit cur, nxt; int ui = 0;
    if (!S.next(0, cur)) return;
    f32x4 acc[2][2][4][2];
#pragma unroll
    for (int a = 0; a < 2; ++a)
#pragma unroll
        for (int b = 0; b < 2; ++b)
#pragma unroll
            for (int m = 0; m < 4; ++m)
#pragma unroll
                for (int n = 0; n < 2; ++n) acc[a][b][m][n] = (f32x4){0.f, 0.f, 0.f, 0.f};
    bf16x8 At[4][2], B0[2][2], B1[2][2];
    const char* cA = (const char*)g.A + (size_t)cur.pm * tstep; const char* cB = (const char*)g.Bt + (size_t)cur.pn * tstep;
    S.a_ready(cur);
    if constexpr (SP2) {
        PG8_STAGE(PG8_SB(0, 0), cB, voffB); PG8_STAGE(PG8_SB(0, 1), cB + hstep, voffB); PG8_STAGE(PG8_SA(0, 0), cA, voffA); PG8_STAGE(PG8_SA(0, 1), cA + hstep, voffA);
        if (wr == 1) PG8_BAR;
        PG8_WAIT_V(2); PG8_BAR;
        PG8_STAGE(PG8_SB(1, 0), cB + kstep, voffB); PG8_STAGE(PG8_SA(1, 0), cA + kstep, voffA); PG8_STAGE(PG8_SB(1, 1), cB + hstep + kstep, voffB);
        PG8_WAIT_V(6); PG8_BAR;
    } else {
        PG8_STAGE(PG8_SB(0, 0), cB, voffB); PG8_STAGE(PG8_SA(0, 0), cA, voffA); PG8_STAGE(PG8_SB(0, 1), cB + hstep, voffB); PG8_STAGE(PG8_SA(0, 1), cA + hstep, voffA);
        if (wr == 1) PG8_BAR;
        PG8_WAIT_V(4); PG8_BAR;
        PG8_STAGE(PG8_SB(1, 0), cB + kstep, voffB); PG8_STAGE(PG8_SA(1, 0), cA + kstep, voffA); PG8_STAGE(PG8_SB(1, 1), cB + hstep + kstep, voffB);
        PG8_WAIT_V(6); PG8_BAR;
    }
    for (;;) {
        const bool has_next = S.next(ui + 1, nxt);
        const char* nA = has_next ? (const char*)g.A + (size_t)nxt.pm * tstep : cA; const char* nB = has_next ? (const char*)g.Bt + (size_t)nxt.pn * tstep : cB;
        for (int t = 0; t < nt; t += 2) {
            const bool last = (t == nt - 2);
            const char* a1 = cA + (size_t)(t + 1) * kstep;
            const char* a2 = last ? nA : cA + (size_t)(t + 2) * kstep; const char* b2 = last ? nB : cB + (size_t)(t + 2) * kstep;
            const char* a3 = a2 + kstep; const char* b3 = b2 + kstep;
            if (last && has_next) S.a_ready(nxt);
            if constexpr (SP2) {
            PG8_LDB(B0, 0, 0); PG8_LDB(B1, 0, 1); PG8_SCHED; PG8_LDA(At, 0, 0); PG8_STAGE(PG8_SA(1, 1), a1 + hstep, voffA);
            PG8_WAIT_V(8); PG8_WAIT_L(0); PG8_BAR; PG8_MMA(0, 0, At, B0); PG8_MMA(0, 1, At, B1); PG8_BAR; PG8_SCHED;
            PG8_LDA(At, 0, 1); PG8_STAGE(PG8_SB(0, 0), b2, voffB); PG8_STAGE(PG8_SB(0, 1), b2 + hstep, voffB); PG8_STAGE(PG8_SA(0, 0), a2, voffA);
            PG8_WAIT_V(8); PG8_WAIT_L(0); PG8_BAR; PG8_MMA(1, 0, At, B0); PG8_MMA(1, 1, At, B1); PG8_BAR; PG8_SCHED;
            PG8_LDB(B0, 1, 0); PG8_LDB(B1, 1, 1); PG8_SCHED; PG8_LDA(At, 1, 0); PG8_STAGE(PG8_SA(0, 1), a2 + hstep, voffA);
            PG8_WAIT_V(8); PG8_WAIT_L(0); PG8_BAR; PG8_MMA(0, 0, At, B0); PG8_MMA(0, 1, At, B1); PG8_BAR; PG8_SCHED;
            PG8_LDA(At, 1, 1); PG8_STAGE(PG8_SB(1, 0), b3, voffB); PG8_STAGE(PG8_SB(1, 1), b3 + hstep, voffB); PG8_STAGE(PG8_SA(1, 0), a3, voffA);
            PG8_WAIT_V(8); PG8_WAIT_L(0); PG8_BAR; PG8_MMA(1, 0, At, B0); PG8_MMA(1, 1, At, B1); PG8_BAR; PG8_SCHED;
            } else {
            PG8_LDB(B0, 0, 0); PG8_SCHED; PG8_LDA(At, 0, 0); PG8_STAGE(PG8_SA(1, 1), a1 + hstep, voffA);
            PG8_WAIT_L(8); PG8_BAR; PG8_WAIT_L(0); PG8_MMA(0, 0, At, B0); PG8_BAR; PG8_SCHED;
            PG8_LDB(B1, 0, 1); PG8_STAGE(PG8_SB(0, 0), b2, voffB);
            PG8_BAR; PG8_WAIT_L(0); PG8_MMA(0, 1, At, B1); PG8_BAR;
            PG8_LDA(At, 0, 1); PG8_STAGE(PG8_SA(0, 0), a2, voffA);
            PG8_BAR; PG8_WAIT_L(0); PG8_MMA(1, 0, At, B0); PG8_BAR; PG8_SCHED;
            PG8_STAGE(PG8_SB(0, 1), b2 + hstep, voffB);
            PG8_WAIT_V(6); PG8_BAR; PG8_MMA(1, 1, At, B1); PG8_BAR;
            PG8_LDB(B0, 1, 0); PG8_SCHED; PG8_LDA(At, 1, 0); PG8_STAGE(PG8_SA(0, 1), a2 + hstep, voffA);
            PG8_WAIT_L(8); PG8_BAR; PG8_WAIT_L(0); PG8_MMA(0, 0, At, B0); PG8_BAR; PG8_SCHED;
            PG8_LDB(B1, 1, 1); PG8_STAGE(PG8_SB(1, 0), b3, voffB);
            PG8_BAR; PG8_WAIT_L(0); PG8_MMA(0, 1, At, B1); PG8_BAR;
            PG8_LDA(At, 1, 1); PG8_STAGE(PG8_SA(1, 0), a3, voffA);
            PG8_BAR; PG8_WAIT_L(0); PG8_MMA(1, 0, At, B0); PG8_BAR; PG8_SCHED;
            PG8_STAGE(PG8_SB(1, 1), b3 + hstep, voffB);
            PG8_WAIT_V(6); PG8_BAR; PG8_MMA(1, 1, At, B1); PG8_BAR;
            }
        }
        if constexpr (ALIGN_EPI) { if (wr == 0) PG8_BAR; }
        if constexpr (!Epi::AFTER_DRAIN) { E(acc, cur, wr, wc, fr, fq); S.done(cur); }
        if (!has_next) break;
#pragma unroll
        for (int a = 0; a < 2; ++a)
#pragma unroll
            for (int b = 0; b < 2; ++b)
#pragma unroll
                for (int m = 0; m < 4; ++m)
#pragma unroll
                    for (int n = 0; n < 2; ++n) acc[a][b][m][n] = (f32x4){0.f, 0.f, 0.f, 0.f};
        cur = nxt; cA = nA; cB = nB; ++ui;
        if constexpr (ALIGN_EPI) { if (wr == 1) PG8_BAR; }
    }
    PG8_WAIT_V(0);
    if constexpr (!ALIGN_EPI) { if (wr == 0) PG8_BAR; }
    PG8_BAR;
    if constexpr (Epi::AFTER_DRAIN) { E.fused(acc, cur, wr, wc, fr, fq, lds, wid, lane); S.done(cur); }
#undef PG8_SA
#undef PG8_SB
#undef PG8_STAGE
#undef PG8_LDA
#undef PG8_LDB
#undef PG8_MMA
#undef PG8_WAIT_V
#undef PG8_WAIT_L
#undef PG8_BAR
#undef PG8_SCHED
}
}
struct Args { const float* in[13]; float* out; unsigned char* ws; int ph_lo, ph_hi; };

#ifndef TPROBE_I
#define TPROBE_I 3
#endif
#ifndef TPROBE_B
#define TPROBE_B 0
#endif
#ifdef TIME_PH
#ifndef TIME_AMP
#define TIME_AMP 4
#endif
#define TSTAMP(k, slot) do { if ((k) == TIME_PH && bid == TPROBE_B && tid == 0) { const unsigned long long t_ = __builtin_amdgcn_s_memrealtime(); MISC[slot] = (unsigned)t_; MISC[(slot) + 1] = (unsigned)(t_ >> 32); } } while (0)
#else
#define TSTAMP(k, slot) do { } while (0)
#endif
template <bool PERMUTE>
__device__ __forceinline__ void p0_transpose_item(const float* W, int K, int N, int NPOS, bf16_t* WT, LAS float* scr, int item, int lane) {
    const int nblk = NPOS / 32, kb = item / nblk, nb = item % nblk, k0 = 64 * kb, n0 = 32 * nb;
    const int pos = n0 + 4 * (lane & 7);
    const int col = PERMUTE ? win_src_col(pos) : pos;
    f32x4 v[8];
#pragma unroll
    for (int i = 0; i < 8; ++i) { const int kk = 8 * i + (lane >> 3); v[i] = (col >= 0) ? *(const f32x4*)(W + (size_t)(k0 + kk) * N + col) : (f32x4){0.f, 0.f, 0.f, 0.f}; }
#pragma unroll
    for (int i = 0; i < 8; ++i) { const int kk = 8 * i + (lane >> 3); LAS float* q = scr + kk * 33 + 4 * (lane & 7); q[0] = v[i][0]; q[1] = v[i][1]; q[2] = v[i][2]; q[3] = v[i][3]; }
    asm volatile("s_waitcnt lgkmcnt(0)" ::: "memory");
    const int c = lane & 7;
#pragma unroll
    for (int j = 0; j < 4; ++j) { const int n = (lane >> 3) + 8 * j; const LAS float* s = scr + (8 * c) * 33 + n;
        u32x4 o; o.x = pk2(s[0 * 33], s[1 * 33]); o.y = pk2(s[2 * 33], s[3 * 33]); o.z = pk2(s[4 * 33], s[5 * 33]); o.w = pk2(s[6 * 33], s[7 * 33]);
        *(u32x4*)(WT + (size_t)(n0 + n) * K + k0 + 8 * c) = o; }
    asm volatile("s_waitcnt lgkmcnt(0)" ::: "memory");
}
__device__ __forceinline__ void row_to_bf16(const float* src, bf16_t* dst, int lane) {
    const f32x4* s = (const f32x4*)src + lane; u32x2* d = (u32x2*)dst + lane;
    f32x4 v[4];
#pragma unroll
    for (int j = 0; j < 4; ++j) v[j] = s[64 * j];
#pragma unroll
    for (int j = 0; j < 4; ++j) { u32x2 w; w.x = pk2(v[j][0], v[j][1]); w.y = pk2(v[j][2], v[j][3]); d[64 * j] = w; }
}
typedef float f32x2 __attribute__((ext_vector_type(2)));
template <int NB>
__device__ __forceinline__ void rows_to_fp8(const float* src, unsigned char* dst, float* scale_out, int lane) {
    f32x4 v[NB][4];
#pragma unroll
    for (int i = 0; i < NB; ++i) { const f32x4* s = (const f32x4*)(src + (size_t)i * 1024) + 4 * lane;
#pragma unroll
        for (int j = 0; j < 4; ++j) v[i][j] = __builtin_nontemporal_load(s + j); }
#pragma unroll
    for (int i = 0; i < NB; ++i) {
        float am = 0.f;
#pragma unroll
        for (int j = 0; j < 4; ++j) am = fmaxf(am, fmaxf(fmaxf(fabsf(v[i][j][0]), fabsf(v[i][j][1])), fmaxf(fabsf(v[i][j][2]), fabsf(v[i][j][3]))));
#pragma unroll
        for (int o = 1; o < 64; o <<= 1) am = fmaxf(am, __shfl_xor(am, o));
        const float sc = am > 0.f ? am * (1.0f / 440.0f) : 1.0f, inv = 1.0f / sc;
        u32x4 w;
#pragma unroll
        for (int j = 0; j < 4; ++j) { unsigned t = 0u; t = __builtin_amdgcn_cvt_pk_fp8_f32(v[i][j][0] * inv, v[i][j][1] * inv, t, false); t = __builtin_amdgcn_cvt_pk_fp8_f32(v[i][j][2] * inv, v[i][j][3] * inv, t, true); w[j] = t; }
        *((u32x4*)(dst + (size_t)i * 1024) + lane) = w;
        if (lane == 0) scale_out[i] = sc;
    }
}
__device__ __forceinline__ void sincos_tab(double x, float& s, float& c) {
    const double k = rint(x * 0.15915494309189535);
    double r = fma(-k, 6.283185307179586, x); r = fma(-k, 2.4492935982947064e-16, r);
    const double r2 = r * r;
    double ps = 1.0, pc = 1.0;
#pragma unroll
    for (int n = 29; n >= 3; n -= 2) ps = 1.0 - ps * r2 * (1.0 / (double)((n - 1) * n));
#pragma unroll
    for (int n = 28; n >= 2; n -= 2) pc = 1.0 - pc * r2 * (1.0 / (double)((n - 1) * n));
    s = (float)(r * ps); c = (float)pc;
}

__device__ __forceinline__ void phase0(const Args& a, unsigned char* lds, int tid, int wave, int lane, int bid, int G) {
    unsigned char* ws = a.ws;
    volatile LAS unsigned* MISC = (volatile LAS unsigned*)((LAS unsigned char*)lds + MISC_OFF);
    TSTAMP(90, 0);
    if (bid & 1) { const int gw0 = bid * 8 + wave, NGW0 = G * 8;
        for (int it = gw0; it < 4096; it += NGW0) { const int r = 4 * it;
            rows_to_fp8<4>(a.in[10] + (size_t)r * 1024, ws + WS_U8 + (size_t)r * 1024, (float*)(ws + WS_USC) + r, lane); }
        __syncthreads(); }
    for (int it = bid; it < 192; it += G) {
        float* s_c = (float*)lds; float* red = (float*)(lds + 16384);
        for (int i = tid; i < 4096; i += NTHREADS) { const float v = a.in[1][i]; s_c[i] = v / (1.0f + expf(-v)); }
        __syncthreads();
        const int g = tid & 7, ks = tid >> 3, n0 = 32 * it;
        f32x4 acc[4];
#pragma unroll
        for (int b = 0; b < 4; ++b) acc[b] = (f32x4){0.f, 0.f, 0.f, 0.f};
#pragma unroll 4
        for (int i = 0; i < 16; ++i) { const int k = ks + 64 * i; const f32x4 w = *(const f32x4*)(a.in[2] + (size_t)k * 6144 + n0 + 4 * g);
#pragma unroll
            for (int b = 0; b < 4; ++b) acc[b] += w * s_c[b * 1024 + k]; }
#pragma unroll
        for (int b = 0; b < 4; ++b) *(f32x4*)(red + (ks * 8 + g) * 16 + 4 * b) = acc[b];
        __syncthreads();
        if (tid < 128) { const int b = tid >> 5, col = tid & 31, gg = col >> 2, e = col & 3; float s = 0.f;
            for (int k2 = 0; k2 < 64; ++k2) s += red[(k2 * 8 + gg) * 16 + 4 * b + e];
            ((float*)(ws + WS_MOD))[b * 6144 + n0 + col] = s + a.in[3][n0 + col]; }
        __syncthreads();
    }
    TSTAMP(90, 2); TSTAMP(91, 0);
    for (int it = bid; it < 256; it += G) {
        const int hp = it >> 4, k0 = 64 * (it & 15);
        constexpr int WP = 132;
        float* skl = (float*)lds; float* wql = skl + 128 * WP;
        for (int i = tid; i < 4096; i += NTHREADS) { const int n = i >> 5, d4 = i & 31; *(f32x4*)(skl + n * WP + 4 * d4) = *(const f32x4*)(a.in[9] + (size_t)hp * 16384 + n * 128 + 4 * d4); }
        for (int i = tid; i < 2048; i += NTHREADS) { const int k = i >> 5, d4 = i & 31; *(f32x4*)(wql + k * WP + 4 * d4) = *(const f32x4*)(a.in[8] + (size_t)(k0 + k) * 2048 + hp * 128 + 4 * d4); }
        __syncthreads();
        const int kg = tid & 15, ng = tid >> 4;
        float acc[4][4];
#pragma unroll
        for (int i = 0; i < 4; ++i)
#pragma unroll
            for (int j = 0; j < 4; ++j) acc[i][j] = 0.f;
#pragma unroll 2
        for (int d4 = 0; d4 < 32; ++d4) {
            f32x4 wv[4], sv[4];
#pragma unroll
            for (int i = 0; i < 4; ++i) { wv[i] = *(const f32x4*)(wql + (kg + 16 * i) * WP + 4 * d4); sv[i] = *(const f32x4*)(skl + (ng + 32 * i) * WP + 4 * d4); }
#pragma unroll
            for (int i = 0; i < 4; ++i)
#pragma unroll
                for (int j = 0; j < 4; ++j) acc[i][j] += (wv[i][0] * sv[j][0] + wv[i][1] * sv[j][1]) + (wv[i][2] * sv[j][2] + wv[i][3] * sv[j][3]);
        }
        bf16_t* wt = (bf16_t*)(ws + WS_WPQ);
#pragma unroll
        for (int j = 0; j < 4; ++j)
#pragma unroll
            for (int i = 0; i < 4; ++i) wt[(size_t)(hp * 128 + ng + 32 * j) * 1024 + k0 + kg + 16 * i] = (bf16_t)f2bf(acc[i][j]);
        __syncthreads();
    }
    TSTAMP(91, 2); TSTAMP(92, 0);
    const int gw = bid * 8 + wave, NGW = G * 8;
    {
        LAS float* scr = (LAS float*)(lds + wave * 16384);
        constexpr int I_IN = 16 * (N1 / 32), I_OUT = 16 * 32;
        for (int it = gw; it < I_IN + I_OUT; it += NGW) {
            if (it < I_IN) p0_transpose_item<true>(a.in[5], 1024, 4168, N1, (bf16_t*)(ws + WS_WIN), scr, it, lane);
            else p0_transpose_item<false>(a.in[6], 1024, 1024, 1024, (bf16_t*)(ws + WS_WOUT), scr, it - I_IN, lane);
        }
    }
    if (!(bid & 1)) {
        for (int it = gw; it < 4096; it += NGW) { const int r = 4 * it;
            rows_to_fp8<4>(a.in[10] + (size_t)r * 1024, ws + WS_U8 + (size_t)r * 1024, (float*)(ws + WS_USC) + r, lane); }
    }
    for (int i = bid * NTHREADS + tid; i < 4096 * 96; i += G * NTHREADS) {
        int pos, f; double r; float* ct; float* st; int idx;
        if (i < 4096 * 32) { pos = i >> 5; f = i & 31; r = 0.74989420933245582730; ct = (float*)(ws + WS_COSA); st = (float*)(ws + WS_SINA); idx = i; }
        else { const int j = i - 4096 * 32; pos = j >> 6; f = j & 63; r = 0.86398844948396852897; ct = (float*)(ws + WS_COSR); st = (float*)(ws + WS_SINR); idx = j; }
        double v = 1.0; for (int t = 0; t < f; ++t) v *= r;
        const float invf = (float)v; const float ang = (float)pos * invf;
        float s, c; sincos_tab((double)ang, s, c);
        ct[idx] = c; st[idx] = s;
    }
}

__device__ __forceinline__ void phase1(const Args& a, int wave, int lane, int bid, int G) {
    unsigned char* ws = a.ws;
    const float* mod = (const float*)(ws + WS_MOD);
    const int gw = bid * 8 + wave, NGW = G * 8;
    for (int r0 = gw; r0 < MTOK; r0 += 2 * NGW) {
        const int r1 = r0 + NGW; const bool has1 = r1 < MTOK;
        const f32x4* xa = (const f32x4*)(a.in[0] + (size_t)r0 * DM) + lane; const f32x4* xb = (const f32x4*)(a.in[0] + (size_t)(has1 ? r1 : r0) * DM) + lane;
        f32x4 va[4], vb[4]; float sa = 0.f, sb = 0.f;
#pragma unroll
        for (int j = 0; j < 4; ++j) { va[j] = xa[64 * j]; vb[j] = xb[64 * j]; }
#pragma unroll
        for (int j = 0; j < 4; ++j) { sa += (va[j][0] * va[j][0] + va[j][1] * va[j][1]) + (va[j][2] * va[j][2] + va[j][3] * va[j][3]); sb += (vb[j][0] * vb[j][0] + vb[j][1] * vb[j][1]) + (vb[j][2] * vb[j][2] + vb[j][3] * vb[j][3]); }
#pragma unroll
        for (int o = 1; o < 64; o <<= 1) { sa += __shfl_xor(sa, o); sb += __shfl_xor(sb, o); }
        const float ra = 1.0f / sqrtf(sa * (1.0f / DM) + EPS), rb = 1.0f / sqrtf(sb * (1.0f / DM) + EPS);
        const int ba = r0 >> 12, bb = (has1 ? r1 : r0) >> 12;
        u32x2* oa = (u32x2*)((bf16_t*)(ws + WS_BUFA) + (size_t)r0 * DM) + lane; u32x2* ob = (u32x2*)((bf16_t*)(ws + WS_BUFA) + (size_t)(has1 ? r1 : r0) * DM) + lane;
#pragma unroll
        for (int j = 0; j < 4; ++j) { const int c = 256 * j + 4 * lane;
            const f32x4 g = *(const f32x4*)(a.in[4] + c);
            { const f32x4 sc = *(const f32x4*)(mod + ba * 6144 + 1024 + c), sh = *(const f32x4*)(mod + ba * 6144 + c);
              const f32x4 h = va[j] * ra * g * (sc + 1.0f) + sh; u32x2 w; w.x = pk2(h[0], h[1]); w.y = pk2(h[2], h[3]); oa[64 * j] = w; }
            if (has1) { const f32x4 sc = *(const f32x4*)(mod + bb * 6144 + 1024 + c), sh = *(const f32x4*)(mod + bb * 6144 + c);
              const f32x4 h = vb[j] * rb * g * (sc + 1.0f) + sh; u32x2 w; w.x = pk2(h[0], h[1]); w.y = pk2(h[2], h[3]); ob[64 * j] = w; }
        }
    }
    for (int n = gw; n < 2048; n += NGW) {
        const u32x4* wr = (const u32x4*)((const bf16_t*)(ws + WS_WPQ) + (size_t)n * 1024);
        const u32x4 w0 = wr[lane], w1 = wr[64 + lane];
        float wf[16];
#pragma unroll
        for (int i = 0; i < 4; ++i) { wf[2 * i] = bf_lo(w0[i]); wf[2 * i + 1] = bf_hi(w0[i]); wf[8 + 2 * i] = bf_lo(w1[i]); wf[8 + 2 * i + 1] = bf_hi(w1[i]); }
#pragma unroll
        for (int b = 0; b < 4; ++b) { const float* sh = mod + b * 6144 + 3072; float s = 0.f;
#pragma unroll
            for (int i = 0; i < 8; ++i) s += wf[i] * sh[8 * lane + i] + wf[8 + i] * sh[512 + 8 * lane + i];
            s = wave_sum(s);
            if (lane == 0) ((float*)(ws + WS_BIASF))[b * 2048 + n] = s; }
    }
}

constexpr int SCP = 8200;
__device__ __forceinline__ int wave_total(int v) {
    v += __builtin_amdgcn_update_dpp(0, v, 0xB1, 0xF, 0xF, true);
    v += __builtin_amdgcn_update_dpp(0, v, 0x4E, 0xF, 0xF, true);
    v += __builtin_amdgcn_update_dpp(0, v, 0x141, 0xF, 0xF, true);
    v += __builtin_amdgcn_update_dpp(0, v, 0x140, 0xF, 0xF, true);
    return __builtin_amdgcn_readlane(v, 0) + __builtin_amdgcn_readlane(v, 16) + __builtin_amdgcn_readlane(v, 32) + __builtin_amdgcn_readlane(v, 48);
}
__device__ __forceinline__ int wave_suffix_sum(int v, int lane) {
#pragma unroll
    for (int d = 1; d < 64; d <<= 1) { const int o = __shfl_down(v, d); if (lane + d < 64) v += o; }
    return v;
}
__device__ __forceinline__ void hist_find(const unsigned* hist, int want, int lane, int& bin, int& above, int& inbin) {
    const u32x4 h = *(const u32x4*)(hist + 4 * lane);
    const int s = (int)(h.x + h.y) + (int)(h.z + h.w);
    const int incl = wave_suffix_sum(s, lane), excl = incl - s;
    const bool mine = excl < want && want <= incl;
    int c = excl, bsel = 4 * lane + 3, cin = (int)h.w;
    if (c + (int)h.w < want) { c += (int)h.w; bsel = 4 * lane + 2; cin = (int)h.z;
        if (c + (int)h.z < want) { c += (int)h.z; bsel = 4 * lane + 1; cin = (int)h.y;
            if (c + (int)h.y < want) { c += (int)h.y; bsel = 4 * lane; cin = (int)h.x; } } }
    const int src = (int)__builtin_ctzll(__ballot(mine));
    bin = __builtin_amdgcn_readlane(bsel, src); above = __builtin_amdgcn_readlane(c, src); inbin = __builtin_amdgcn_readlane(cin, src);
}
template <int NR>
__device__ __forceinline__ void select_row_t(int b, int t, unsigned char* ldsrow, unsigned* hist, unsigned long long* MASK, int lane) {
    {
        unsigned* row32 = (unsigned*)ldsrow;
        for (int i = 8 * ((t >> 4) + 1) + lane; i < 32 * NR; i += 64) row32[i] = 0u;
    }
    unsigned key[NR];
#pragma unroll
    for (int j = 0; j < NR; ++j) key[j] = *(const unsigned short*)(ldsrow + 2 * lane + 128 * j);
    unsigned mw_lo = 0u, mw_hi = 0u;
    if (t < 256) {
#pragma unroll
        for (int j = 0; j < 4; ++j) { const unsigned long long w = __ballot(key[j] != 0u);
            asm volatile("s_nop 1\n\tv_writelane_b32 %0, %2, %4\n\tv_writelane_b32 %1, %3, %4\n\ts_nop 0" : "+v"(mw_lo), "+v"(mw_hi) : "s"((unsigned)w), "s"((unsigned)(w >> 32)), "n"(j)); }
    } else {
        *(u32x4*)(hist + 4 * lane) = (u32x4){0u, 0u, 0u, 0u};
#pragma unroll
        for (int j = 0; j < NR; ++j) __hip_atomic_fetch_add(hist + (key[j] >> 8), 1u, __ATOMIC_RELAXED, __HIP_MEMORY_SCOPE_WORKGROUP);
        int B, above, inB;
        hist_find(hist, 256, lane, B, above, inB);
        *(u32x4*)(hist + 4 * lane) = (u32x4){0u, 0u, 0u, 0u};
#pragma unroll
        for (int j = 0; j < NR; ++j) if ((int)(key[j] >> 8) == B) __hip_atomic_fetch_add(hist + (key[j] & 255u), 1u, __ATOMIC_RELAXED, __HIP_MEMORY_SCOPE_WORKGROUP);
        int b2, above2, ties;
        hist_find(hist, 256 - above, lane, b2, above2, ties);
        const unsigned T = ((unsigned)B << 8) | (unsigned)b2;
        int need = 256 - above - above2;
        if (ties == need) {
#pragma unroll
            for (int j = 0; j < NR; ++j) { const unsigned long long w = __ballot(key[j] >= T);
                asm volatile("s_nop 1\n\tv_writelane_b32 %0, %2, %4\n\tv_writelane_b32 %1, %3, %4\n\ts_nop 0" : "+v"(mw_lo), "+v"(mw_hi) : "s"((unsigned)w), "s"((unsigned)(w >> 32)), "n"(j));
                if ((j & 3) == 3) __builtin_amdgcn_sched_barrier(0); }
        } else {
#pragma unroll
            for (int j = 0; j < NR; ++j) {
                const bool gt = key[j] > T, eq = key[j] == T;
                const unsigned long long em = __ballot(eq);
                const int cc = __popcll(em), take = cc < need ? cc : need;
                const int rank = (int)__builtin_amdgcn_mbcnt_hi((unsigned)(em >> 32), __builtin_amdgcn_mbcnt_lo((unsigned)em, 0u));
                const unsigned long long w = __ballot(gt || (eq && rank < take));
                need -= take;
                asm volatile("s_nop 1\n\tv_writelane_b32 %0, %2, %4\n\tv_writelane_b32 %1, %3, %4\n\ts_nop 0" : "+v"(mw_lo), "+v"(mw_hi) : "s"((unsigned)w), "s"((unsigned)(w >> 32)), "n"(j));
                if ((j & 1) == 1) __builtin_amdgcn_sched_barrier(0);
            }
        }
    }
    MASK[((size_t)b * SEQ + t) * 64 + lane] = ((unsigned long long)mw_hi << 32) | mw_lo;
}
__device__ __forceinline__ void select_row(int b, int t, unsigned char* ldsrow, unsigned* hist, unsigned long long* MASK, int lane) {
    switch (t >> 10) {
        case 0: select_row_t<16>(b, t, ldsrow, hist, MASK, lane); break;
        case 1: select_row_t<32>(b, t, ldsrow, hist, MASK, lane); break;
        case 2: select_row_t<48>(b, t, ldsrow, hist, MASK, lane); break;
        default: select_row_t<64>(b, t, ldsrow, hist, MASK, lane); break;
    }
}
__device__ __forceinline__ void idx_unit(int b, int qt, const bf16_t* QI, const bf16_t* KI, const float* WI, unsigned long long* MASK, unsigned char* lds, int wave, int lane, bool tprobe) {
    volatile LAS unsigned* MISC = (volatile LAS unsigned*)((LAS unsigned char*)lds + MISC_OFF); const int bid = tprobe ? TPROBE_B : -1; const int tid = (int)threadIdx.x;
    TSTAMP(32, 0);
    const int t0 = 16 * qt, qn = lane & 15, g = lane >> 4;
    const size_t rowq = (size_t)b * SEQ + t0 + qn;
    bf16x8 qf[8][2]; float wi[8];
#pragma unroll
    for (int h = 0; h < 8; ++h)
#pragma unroll
        for (int ks = 0; ks < 2; ++ks) qf[h][ks] = *(const bf16x8*)(QI + rowq * 512 + h * 64 + ks * 32 + 8 * g);
    { const f32x4 w0 = *(const f32x4*)(WI + rowq * 8), w1 = *(const f32x4*)(WI + rowq * 8 + 4);
#pragma unroll
      for (int e = 0; e < 4; ++e) { wi[e] = w0[e]; wi[4 + e] = w1[e]; } }
    const bf16_t* kbase = KI + ((size_t)b * SEQ + qn) * 64 + 8 * g;
    bf16x8 ra0[8], ra1[8];
#pragma unroll
    for (int i = 0; i < 8; ++i) if (wave + 8 * i <= qt) { const bf16_t* kr = kbase + (size_t)(wave + 8 * i) * 1024; ra0[i] = *(const bf16x8*)kr; ra1[i] = *(const bf16x8*)(kr + 32); }
#pragma unroll 1
    for (int base = wave; base <= qt; base += 64) {
#pragma unroll
        for (int i = 0; i < 8; ++i) {
            const int kt = base + 8 * i;
            if (kt <= qt) {
                const bf16x8 a0 = ra0[i], a1 = ra1[i];
                if (kt + 64 <= qt) { const bf16_t* kr = kbase + (size_t)(kt + 64) * 1024; ra0[i] = *(const bf16x8*)kr; ra1[i] = *(const bf16x8*)(kr + 32); }
                const int s0 = 16 * kt;
                f32x4 sc = (f32x4){0.f, 0.f, 0.f, 0.f};
#pragma unroll
                for (int h = 0; h < 8; ++h) {
                    f32x4 d = mfma16(a0, qf[h][0], (f32x4){0.f, 0.f, 0.f, 0.f}); d = mfma16(a1, qf[h][1], d);
#pragma unroll
                    for (int r = 0; r < 4; ++r) { const int di = (int)__float_as_uint(d[r]); sc[r] += wi[h] * __uint_as_float((unsigned)(di > 0 ? di : 0)); }
                }
                unsigned k[4];
#pragma unroll
                for (int r = 0; r < 4; ++r) { const unsigned kk = sortable16(sc[r]); k[r] = (s0 + 4 * g + r <= t0 + qn) ? kk : 0u; }
                u32x2 pk; pk.x = k[0] | (k[1] << 16); pk.y = k[2] | (k[3] << 16);
                *(u32x2*)(lds + qn * SCP + 2 * (s0 + 4 * g)) = pk;
            }
        }
    }
    __syncthreads();
    TSTAMP(32, 2); TSTAMP(33, 0);
#ifndef NO_SEL
#pragma unroll 1
    for (int qq = 2 * wave; qq < 2 * wave + 2; ++qq) select_row(b, t0 + qq, lds + qq * SCP, (unsigned*)(lds + 16 * SCP) + 256 * wave, MASK, lane);
#endif
    __syncthreads();
    TSTAMP(33, 2);
}

typedef short s16x4_t __attribute__((ext_vector_type(4)));
__device__ __forceinline__ s16x4_t lds_tr16(const unsigned char* p) {
    return __builtin_bit_cast(s16x4_t, __builtin_amdgcn_ds_read_tr16_b64_v4i16((LAS s16x4_t*)(LAS unsigned char*)p));
}
__device__ __forceinline__ void ret_state_unit(int b, int h, int vb, int dh, const bf16_t* KR, const bf16_t* VR, bf16_t* STATE, unsigned char* lds, int tid, int wave, int lane) {
    constexpr int KPT = 144, VPT = 48, K_BYTES = 128 * KPT, BUF = K_BYTES + 128 * VPT;
    const int j = tid & 127, dq = tid >> 7, g = lane >> 4, ln = lane & 15;
    const float g128 = ret_g128(h), g127 = ret_g127(h), gam = ret_gamma(h);
    f32x4 st = (f32x4){0.f, 0.f, 0.f, 0.f};
    u32x4 kA[2], kB[2], vA = (u32x4){0u, 0u, 0u, 0u}, vB = (u32x4){0u, 0u, 0u, 0u};
#define RS_LOAD(K_, V_, n) do { const size_t row = (size_t)b * SEQ + (n) * 128 + j; const u32x4* p = (const u32x4*)(KR + row * 512 + h * 128 + 64 * dh + 16 * dq); \
        K_[0] = p[0]; K_[1] = p[1]; if (tid < 256) V_ = *(const u32x4*)(VR + row * 512 + h * 128 + 16 * vb + 8 * dq); } while (0)
#define RS_WRITE(K_, V_, buf) do { *(u32x4*)((buf) + j * KPT + 32 * dq) = K_[0]; *(u32x4*)((buf) + j * KPT + 32 * dq + 16) = K_[1]; \
        if (tid < 256) *(u32x4*)((buf) + K_BYTES + j * VPT + 16 * dq) = V_; } while (0)
#define RS_COMP(buf, n) do { \
        f32x4 c = (f32x4){0.f, 0.f, 0.f, 0.f}; \
        _Pragma("unroll") for (int ks = 0; ks < 4; ++ks) { const int j0 = 32 * ks + 8 * g + (ln >> 2); \
            const unsigned char* ap = (buf) + K_BYTES + j0 * VPT + 8 * (ln & 3); const unsigned char* bp = (buf) + j0 * KPT + 32 * (wave & 3) + 8 * (ln & 3); \
            const s16x4_t a0 = lds_tr16(ap), a1 = lds_tr16(ap + 4 * VPT), b0 = lds_tr16(bp), b1 = lds_tr16(bp + 4 * KPT); \
            const bf16x8 af = (bf16x8){a0[0], a0[1], a0[2], a0[3], a1[0], a1[1], a1[2], a1[3]}, bf = (bf16x8){b0[0], b0[1], b0[2], b0[3], b1[0], b1[1], b1[2], b1[3]}; \
            c = mfma16(af, bf, c); } \
        if (wave < 4) { \
            bf16_t* sp = STATE + ((((size_t)b * 4 + h) * 32 + (n)) * 128 + 16 * vb + 4 * g) * 128 + 64 * dh + 16 * wave + ln; \
            _Pragma("unroll") for (int r = 0; r < 4; ++r) sp[r * 128] = (bf16_t)f2bf(gam * st[r]); \
            st = st * g128 + c * g127; } } while (0)
    u32x4 kC[2], kD[2], vC = (u32x4){0u, 0u, 0u, 0u}, vD = (u32x4){0u, 0u, 0u, 0u};
    RS_LOAD(kA, vA, 0); RS_LOAD(kB, vB, 1); RS_LOAD(kC, vC, 2); RS_LOAD(kD, vD, 3);
#pragma unroll 1
    for (int n = 0; n < 32; n += 4) {
        RS_WRITE(kA, vA, lds);        if (n + 4 < 32) RS_LOAD(kA, vA, n + 4); __syncthreads(); RS_COMP(lds, n);
        RS_WRITE(kB, vB, lds + BUF);  if (n + 5 < 32) RS_LOAD(kB, vB, n + 5); __syncthreads(); RS_COMP(lds + BUF, n + 1);
        RS_WRITE(kC, vC, lds);        if (n + 6 < 32) RS_LOAD(kC, vC, n + 6); __syncthreads(); RS_COMP(lds, n + 2);
        RS_WRITE(kD, vD, lds + BUF);  if (n + 7 < 32) RS_LOAD(kD, vD, n + 7); __syncthreads(); RS_COMP(lds + BUF, n + 3);
    }
#undef RS_LOAD
#undef RS_WRITE
#undef RS_COMP
    __syncthreads();
}

__device__ __forceinline__ float amax3(float a, float b, float c) { float r; asm("v_max3_f32 %0, %1, %2, %3" : "=v"(r) : "v"(a), "v"(b), "v"(c)); return r; }
__device__ __forceinline__ void attn_unit(int b, int h, int qb, const bf16_t* QA, const bf16_t* KA, const bf16_t* VA, const unsigned long long* MASK, bf16_t* AR,
                                          unsigned char* lds, int tid, int wave, int lane) {
    constexpr int KP = 144, KS_BYTES = 64 * KP, BUF = 2 * KS_BYTES;
    const int q0 = 256 * qb, r32 = lane & 31, hi = lane >> 5;
    const int t = q0 + 32 * wave + r32;
    const size_t qrow = (size_t)b * SEQ + t;
    bf16x8 qf[4];
#pragma unroll
    for (int d0 = 0; d0 < 4; ++d0) qf[d0] = *(const bf16x8*)(QA + qrow * 512 + h * 64 + 16 * d0 + 8 * hi);
    const int NT = (q0 + 256) / 64;
    const int key_l = tid >> 3, c8 = tid & 7;
    f32x16 o0, o1;
#pragma unroll
    for (int r = 0; r < 16; ++r) { o0[r] = 0.f; o1[r] = 0.f; }
    float m_run = NEG_INF, l_run = 0.f;
    u32x4 kreg[4], vreg[4]; unsigned long long mw[4];
#define AT_LOAD(i, kt) do { const size_t kr = (size_t)b * SEQ + 64 * (kt) + key_l; kreg[i] = *(const u32x4*)(KA + kr * 512 + h * 64 + 8 * c8); vreg[i] = *(const u32x4*)(VA + kr * 512 + h * 64 + 8 * c8); \
        mw[i] = MASK[qrow * 64 + (kt)]; } while (0)
#pragma unroll
    for (int i = 0; i < 4; ++i) AT_LOAD(i, i);
#pragma unroll 1
    for (int kt4 = 0; kt4 < NT; kt4 += 4) {
#pragma unroll
      for (int i = 0; i < 4; ++i) {
        const int kt = kt4 + i;
        unsigned char* buf = lds + (i & 1) * BUF;
        *(u32x4*)(buf + key_l * KP + 16 * c8) = kreg[i];
#pragma unroll
        for (int e = 0; e < 4; ++e) { const unsigned w = vreg[i][e]; const int d = 8 * c8 + 2 * e;
            *(unsigned short*)(buf + KS_BYTES + d * KP + 2 * key_l) = (unsigned short)(w & 0xffffu); *(unsigned short*)(buf + KS_BYTES + (d + 1) * KP + 2 * key_l) = (unsigned short)(w >> 16); }
        const unsigned long long mcur = mw[i];
        if (kt + 4 < NT) AT_LOAD(i, kt + 4);
        __syncthreads();
        if (64 * kt <= q0 + 32 * wave + 31) {
            f32x16 p0, p1;
#pragma unroll
            for (int r = 0; r < 16; ++r) { p0[r] = 0.f; p1[r] = 0.f; }
#pragma unroll
            for (int d0 = 0; d0 < 4; ++d0) {
                const bf16x8 a0 = *(const bf16x8*)(buf + r32 * KP + 32 * d0 + 16 * hi);
                const bf16x8 a1 = *(const bf16x8*)(buf + (32 + r32) * KP + 32 * d0 + 16 * hi);
                p0 = mfma32(a0, qf[d0], p0); p1 = mfma32(a1, qf[d0], p1);
            }
            const unsigned wl = (unsigned)mcur >> (4 * hi), wh = (unsigned)(mcur >> 32) >> (4 * hi);
#pragma unroll
            for (int r = 0; r < 16; ++r) { const int bp = (r & 3) + 8 * (r >> 2);
                const unsigned m0 = (unsigned)((int)(wl << (31 - bp)) >> 31), m1 = (unsigned)((int)(wh << (31 - bp)) >> 31);
                p0[r] = __uint_as_float((__float_as_uint(p0[r]) & m0) | (0xff800000u & ~m0)); p1[r] = __uint_as_float((__float_as_uint(p1[r]) & m1) | (0xff800000u & ~m1)); }
            float mx;
            { float a = amax3(p0[0], p0[1], p1[0]), bq = amax3(p0[2], p0[3], p1[1]); a = amax3(a, p1[2], p1[3]);
#pragma unroll
              for (int r = 4; r < 16; r += 4) { a = amax3(a, p0[r], p0[r + 1]); bq = amax3(bq, p0[r + 2], p0[r + 3]); a = amax3(a, p1[r], p1[r + 1]); bq = amax3(bq, p1[r + 2], p1[r + 3]); }
              mx = amax3(a, bq, bq); }
            mx = amax3(mx, __shfl_xor(mx, 32), mx);
            const float m_new = amax3(m_run, mx, mx);
            const float m_use = (m_new == NEG_INF) ? 0.f : m_new;
            const float alpha = fast_exp2(m_run - m_use);
            m_run = m_new;
            float ps = 0.f;
#pragma unroll
            for (int r = 0; r < 16; ++r) { p0[r] = fast_exp2(p0[r] - m_use); p1[r] = fast_exp2(p1[r] - m_use); ps += p0[r] + p1[r]; }
            l_run = l_run * alpha + ps;
            if (__any(alpha != 1.0f)) {
#pragma unroll
                for (int r = 0; r < 16; ++r) { o0[r] *= alpha; o1[r] *= alpha; }
            }
#pragma unroll
            for (int s4 = 0; s4 < 4; ++s4) {
                const int rb = 8 * (s4 & 1);
                u32x4 pw;
                if (s4 < 2) { pw.x = pk2(p0[rb], p0[rb + 1]); pw.y = pk2(p0[rb + 2], p0[rb + 3]); pw.z = pk2(p0[rb + 4], p0[rb + 5]); pw.w = pk2(p0[rb + 6], p0[rb + 7]); }
                else        { pw.x = pk2(p1[rb], p1[rb + 1]); pw.y = pk2(p1[rb + 2], p1[rb + 3]); pw.z = pk2(p1[rb + 4], p1[rb + 5]); pw.w = pk2(p1[rb + 6], p1[rb + 7]); }
                const bf16x8 bfr = __builtin_bit_cast(bf16x8, pw);
                { const unsigned char* vp = buf + KS_BYTES + r32 * KP + 2 * (16 * s4 + 4 * hi);
                  const u32x2 lo = *(const u32x2*)vp, h2 = *(const u32x2*)(vp + 16); const u32x4 av = (u32x4){lo.x, lo.y, h2.x, h2.y};
                  o0 = mfma32(__builtin_bit_cast(bf16x8, av), bfr, o0); }
                { const unsigned char* vp = buf + KS_BYTES + (32 + r32) * KP + 2 * (16 * s4 + 4 * hi);
                  const u32x2 lo = *(const u32x2*)vp, h2 = *(const u32x2*)(vp + 16); const u32x4 av = (u32x4){lo.x, lo.y, h2.x, h2.y};
                  o1 = mfma32(__builtin_bit_cast(bf16x8, av), bfr, o1); }
            }
        }
      }
    }
#undef AT_LOAD
    l_run += __shfl_xor(l_run, 32);
#ifdef DBG_NOATT
    const float inv = 0.f;
#else
    const float inv = 1.0f / l_run;
#endif
    bf16_t* op = AR + qrow * 1024 + h * 64 + 4 * hi;
#pragma unroll
    for (int c = 0; c < 4; ++c) {
        u32x2 w; w.x = pk2(o0[4 * c] * inv, o0[4 * c + 1] * inv); w.y = pk2(o0[4 * c + 2] * inv, o0[4 * c + 3] * inv); *(u32x2*)(op + 8 * c) = w;
        u32x2 v; v.x = pk2(o1[4 * c] * inv, o1[4 * c + 1] * inv); v.y = pk2(o1[4 * c + 2] * inv, o1[4 * c + 3] * inv); *(u32x2*)(op + 32 + 8 * c) = v;
    }
    __syncthreads();
}

__device__ __forceinline__ void ret_out_unit(int b, int h, int n, const bf16_t* QR, const bf16_t* KR, const bf16_t* VR, const bf16_t* GR, const bf16_t* STATE, bf16_t* AR,
                                             unsigned char* lds, int tid, int wave, int lane) {
    constexpr int PT = 272;
    const size_t c0 = (size_t)b * SEQ + 128 * n; const int hc = 128 * h;
    const int ln = lane & 15, g = lane >> 4;
    const size_t qrow = c0 + 16 * wave + ln;
    u32x4 rr[4];
    { const int j = tid & 127, vq = tid >> 7; const u32x4* p = (const u32x4*)(VR + (c0 + j) * 512 + hc + 32 * vq); rr[0] = p[0]; rr[1] = p[1]; rr[2] = p[2]; rr[3] = p[3]; }
    bf16x8 qf[4];
#pragma unroll
    for (int ks = 0; ks < 4; ++ks) qf[ks] = *(const bf16x8*)(QR + qrow * 512 + hc + 32 * ks + 8 * g);
    bf16x8 kf[8][4];
#pragma unroll
    for (int jt = 0; jt < 8; ++jt) if (jt <= wave) { const bf16_t* kp = KR + (c0 + 16 * jt + ln) * 512 + hc + 8 * g;
#pragma unroll
        for (int ks = 0; ks < 4; ++ks) kf[jt][ks] = *(const bf16x8*)(kp + 32 * ks); }
    u32x2 gw[8];
#pragma unroll
    for (int vt = 0; vt < 8; ++vt) gw[vt] = *(const u32x2*)(GR + qrow * 512 + hc + 16 * vt + 4 * g);
    { const int j = tid & 127, vq = tid >> 7;
#pragma unroll
      for (int i = 0; i < 4; ++i)
#pragma unroll
          for (int e = 0; e < 4; ++e) { const unsigned w = rr[i][e]; const int v = 32 * vq + 8 * i + 2 * e;
              *(unsigned short*)(lds + v * PT + 2 * j) = (unsigned short)(w & 0xffffu); *(unsigned short*)(lds + (v + 1) * PT + 2 * j) = (unsigned short)(w >> 16); } }
    __syncthreads();
    f32x4 sT[8];
#pragma unroll
    for (int jt = 0; jt < 8; ++jt) {
        f32x4 d = (f32x4){0.f, 0.f, 0.f, 0.f};
        if (jt <= wave) {
#pragma unroll
            for (int ks = 0; ks < 4; ++ks) d = mfma16(kf[jt][ks], qf[ks], d);
            if (jt == wave) {
#pragma unroll
                for (int r = 0; r < 4; ++r) if (4 * g + r > ln) d[r] = 0.f;
            }
        }
        sT[jt] = d;
    }
    f32x4 oT[8];
    const bf16_t* stp = STATE + (((size_t)b * 4 + h) * 32 + n) * 16384;
#pragma unroll
    for (int vt = 0; vt < 8; ++vt) {
        f32x4 d = (f32x4){0.f, 0.f, 0.f, 0.f};
#pragma unroll
        for (int ks = 0; ks < 4; ++ks) d = mfma16(*(const bf16x8*)(stp + (16 * vt + ln) * 128 + 32 * ks + 8 * g), qf[ks], d);
        oT[vt] = d;
    }
#pragma unroll
    for (int pr = 0; pr < 4; ++pr) if (2 * pr <= wave) {
        u32x4 pw; pw.x = pk2(sT[2 * pr][0], sT[2 * pr][1]); pw.y = pk2(sT[2 * pr][2], sT[2 * pr][3]); pw.z = pk2(sT[2 * pr + 1][0], sT[2 * pr + 1][1]); pw.w = pk2(sT[2 * pr + 1][2], sT[2 * pr + 1][3]);
        const bf16x8 bfr = __builtin_bit_cast(bf16x8, pw);
#pragma unroll
        for (int vt = 0; vt < 8; ++vt) {
            const unsigned char* vp = lds + (16 * vt + ln) * PT + 2 * (32 * pr + 4 * g);
            const u32x2 lo = *(const u32x2*)vp, h2 = *(const u32x2*)(vp + 32); const u32x4 av = (u32x4){lo.x, lo.y, h2.x, h2.y};
            oT[vt] = mfma16(__builtin_bit_cast(bf16x8, av), bfr, oT[vt]);
        }
    }
    float s = 0.f;
#pragma unroll
    for (int vt = 0; vt < 8; ++vt) s += (oT[vt][0] + oT[vt][1]) + (oT[vt][2] + oT[vt][3]);
    s += __shfl_xor(s, 16); s += __shfl_xor(s, 32);
    const float mean = s * (1.0f / 128.0f);
    float q = 0.f;
#pragma unroll
    for (int vt = 0; vt < 8; ++vt)
#pragma unroll
        for (int r = 0; r < 4; ++r) { const float d = oT[vt][r] - mean; q += d * d; }
    q += __shfl_xor(q, 16); q += __shfl_xor(q, 32);
    const float rstd = 1.0f / sqrtf(q * (1.0f / 128.0f) + EPS);
#pragma unroll
    for (int vt = 0; vt < 8; ++vt) {
        const float y0 = (oT[vt][0] - mean) * rstd * bf_lo(gw[vt].x), y1 = (oT[vt][1] - mean) * rstd * bf_hi(gw[vt].x);
        const float y2 = (oT[vt][2] - mean) * rstd * bf_lo(gw[vt].y), y3 = (oT[vt][3] - mean) * rstd * bf_hi(gw[vt].y);
        u32x2 w; w.x = pk2(y0, y1); w.y = pk2(y2, y3);
        *(u32x2*)(AR + qrow * 1024 + 512 + hc + 16 * vt + 4 * g) = w;
    }
    __syncthreads();
}

template <int N> __device__ __forceinline__ void bitonic_sort_desc(unsigned (&a)[N]) {
#pragma unroll
    for (int k = 2; k <= N; k <<= 1)
#pragma unroll
        for (int j = k >> 1; j > 0; j >>= 1)
#pragma unroll
            for (int i = 0; i < N; ++i) { const int l = i ^ j;
                if (l > i) { const unsigned x = a[i], y = a[l]; const unsigned mx = x > y ? x : y, mn = x > y ? y : x;
                    if ((i & k) == 0) { a[i] = mx; a[l] = mn; } else { a[i] = mn; a[l] = mx; } } }
}
template <int N> __device__ __forceinline__ void bitonic_merge_desc(unsigned (&a)[N]) {
#pragma unroll
    for (int j = N >> 1; j > 0; j >>= 1)
#pragma unroll
        for (int i = 0; i < N; ++i) { const int l = i ^ j;
            if (l > i) { const unsigned x = a[i], y = a[l]; a[i] = x > y ? x : y; a[l] = x > y ? y : x; } }
}
__device__ __forceinline__ void top16_merge(unsigned (&best)[16], const unsigned (&grp)[16]) {
#pragma unroll
    for (int i = 0; i < 16; ++i) { const unsigned x = best[i], y = grp[15 - i]; best[i] = x > y ? x : y; }
    bitonic_merge_desc<16>(best);
}
struct CandTab { int a[64], b[64], n; constexpr CandTab() : a{}, b{}, n(0) { for (int x = 0; x < 16; ++x) for (int y = 0; y < 16; ++y) if ((x + 1) * (y + 1) <= 16) { a[n] = x; b[n] = y; ++n; } } };
constexpr CandTab kCand{};
static_assert(kCand.n == 50, "staircase candidates");

constexpr int PL_EID = 0, PL_GATE = 16384, PL_IDX = 32768;
__device__ __forceinline__ void peer_unit(int unit, unsigned char* ws, float* outp, const float* gffn, const float* gfin, unsigned char* lds, int tid, int wave, int lane) {
    volatile LAS unsigned* MISC = (volatile LAS unsigned*)((LAS unsigned char*)lds + MISC_OFF); const int bid = unit;
    TSTAMP(70, 0);
    const bf16_t* SC = (const bf16_t*)(ws + WS_SC);
    const float* mod = (const float*)(ws + WS_MOD);
#ifndef DBG_NOPEER
    {
        const int tl = tid >> 4, h = (tid >> 1) & 7, p = tid & 1;
        const size_t row = (size_t)32 * unit + tl;
        const u32x4* sp = (const u32x4*)(SC + row * 2048 + h * 256 + p * 128);
        unsigned best[16];
#pragma unroll
        for (int grp = 0; grp < 8; ++grp) {
            unsigned k[16];
#pragma unroll
            for (int q4 = 0; q4 < 2; ++q4) { const u32x4 v = sp[2 * grp + q4];
#pragma unroll
                for (int e = 0; e < 4; ++e) { const int n0 = 16 * grp + 8 * q4 + 2 * e;
                    k[8 * q4 + 2 * e] = (sortable32(bf_lo(v[e])) & ~127u) | (unsigned)(127 - n0);
                    k[8 * q4 + 2 * e + 1] = (sortable32(bf_hi(v[e])) & ~127u) | (unsigned)(127 - (n0 + 1)); } }
            bitonic_sort_desc<16>(k);
            if (grp == 0) {
#pragma unroll
                for (int i = 0; i < 16; ++i) best[i] = k[i];
            } else top16_merge(best, k);
        }
        unsigned char* il = lds + PL_IDX + (tl * 8 + h) * 32;
#pragma unroll
        for (int i = 0; i < 4; ++i) { unsigned w = 0;
#pragma unroll
            for (int e = 0; e < 4; ++e) w |= (127u - (best[4 * i + e] & 127u)) << (8 * e);
            *(unsigned*)(il + p * 16 + 4 * i) = w; }
        float v1[16], v2[16];
#pragma unroll
        for (int i = 0; i < 16; ++i) { const unsigned o = __shfl_xor(best[i], 1); const float mine = unsortable32(best[i] & ~127u), oth = unsortable32(o & ~127u);
            v1[i] = p ? oth : mine; v2[i] = p ? mine : oth; }
        unsigned top[16];
#pragma unroll
        for (int grp = 0; grp < 4; ++grp) {
            unsigned k[16];
#pragma unroll
            for (int i = 0; i < 16; ++i) { const int c = 16 * grp + i;
                k[i] = (c < kCand.n) ? ((sortable32(v1[kCand.a[c < kCand.n ? c : 0]] + v2[kCand.b[c < kCand.n ? c : 0]]) & ~255u) | (unsigned)(255 - (16 * kCand.a[c < kCand.n ? c : 0] + kCand.b[c < kCand.n ? c : 0]))) : 0u; }
            bitonic_sort_desc<16>(k);
            if (grp == 0) {
#pragma unroll
                for (int i = 0; i < 16; ++i) top[i] = k[i];
            } else top16_merge(top, k);
        }
        float ts[16], es[16], sum = 0.f;
#pragma unroll
        for (int i = 0; i < 16; ++i) ts[i] = unsortable32(top[i] & ~255u);
#pragma unroll
        for (int i = 0; i < 16; ++i) { es[i] = __expf(ts[i] - ts[0]); sum += es[i]; }
        const float rs = 1.0f / sum;
        __builtin_amdgcn_wave_barrier(); asm volatile("s_waitcnt lgkmcnt(0)" ::: "memory");
        unsigned* eo = (unsigned*)(lds + PL_EID) + tl * 128 + h * 16;
        float* go = (float*)(lds + PL_GATE) + tl * 128 + h * 16;
#pragma unroll
        for (int i = 0; i < 16; ++i) {
            const unsigned flat = 255u - (top[i] & 255u);
            const unsigned i1 = il[flat >> 4], i2 = il[16 + (flat & 15u)];
            eo[i] = i1 * 128u + i2; go[i] = es[i] * rs;
        }
    }
#endif
    __syncthreads();
    TSTAMP(70, 2); TSTAMP(71, 0);
    const unsigned char* U8 = ws + WS_U8; const unsigned char* V8 = ws + WS_V8;
    const float* USC = (const float*)(ws + WS_USC); const float* VSC = (const float*)(ws + WS_VSC);
    const int me = ((lane >> 5) & 1) * 4 + ((lane >> 4) & 1) * 2 + ((lane >> 3) & 1);
#pragma unroll 1
    for (int ti = 0; ti < 4; ++ti) {
        const int tl = wave + 8 * ti; const size_t row = (size_t)32 * unit + tl; const int b = (int)(row >> 12);
        const float* mb = mod + b * 6144;
        float x1v[16]; f32x2 hv2[8], acc2[8];
        const float rstd = pg8::row_rstd((const float*)(ws + WS_SUMSQ), (int)row);
#pragma unroll
        for (int q4 = 0; q4 < 4; ++q4) { const int c = 16 * lane + 4 * q4;
            const f32x4 xv = *(const f32x4*)(outp + row * DM + c), g = *(const f32x4*)(gffn + c), sc = *(const f32x4*)(mb + 4096 + c), sh = *(const f32x4*)(mb + 3072 + c);
            float hq[4];
#pragma unroll
            for (int e = 0; e < 4; ++e) { x1v[4 * q4 + e] = xv[e]; hq[e] = xv[e] * rstd * g[e] * (1.0f + sc[e]) + sh[e]; }
            hv2[2 * q4] = (f32x2){hq[0], hq[1]}; hv2[2 * q4 + 1] = (f32x2){hq[2], hq[3]}; acc2[2 * q4] = (f32x2){0.f, 0.f}; acc2[2 * q4 + 1] = (f32x2){0.f, 0.f}; }
        unsigned* el = (unsigned*)(lds + PL_EID) + tl * 128; float* gl = (float*)(lds + PL_GATE) + tl * 128;
        {
            unsigned e0_ = el[lane], e1_ = el[64 + lane]; float g0_ = gl[lane], g1_ = gl[64 + lane];
#pragma unroll
            for (int k = 2; k <= 128; k <<= 1)
#pragma unroll
                for (int j = k >> 1; j > 0; j >>= 1) {
                    if (j == 64) {
                        const bool sw = e0_ > e1_; const unsigned te = sw ? e1_ : e0_; const float tg = sw ? g1_ : g0_;
                        e1_ = sw ? e0_ : e1_; g1_ = sw ? g0_ : g1_; e0_ = te; g0_ = tg;
                    } else {
                        const unsigned pe0 = __shfl_xor(e0_, j), pe1 = __shfl_xor(e1_, j); const float pg0 = __shfl_xor(g0_, j), pg1 = __shfl_xor(g1_, j);
                        const bool lower = (lane & j) == 0;
                        const bool up0 = ((lane & k) == 0), up1 = (((lane + 64) & k) == 0);
                        { const bool takemin = (lower == up0); const bool sw = takemin ? (pe0 < e0_) : (pe0 > e0_); e0_ = sw ? pe0 : e0_; g0_ = sw ? pg0 : g0_; }
                        { const bool takemin = (lower == up1); const bool sw = takemin ? (pe1 < e1_) : (pe1 > e1_); e1_ = sw ? pe1 : e1_; g1_ = sw ? pg1 : g1_; }
                    }
                }
            if (ti & 1) { el[127 - lane] = e0_; el[63 - lane] = e1_; gl[127 - lane] = g0_; gl[63 - lane] = g1_; }
            else { el[lane] = e0_; el[64 + lane] = e1_; gl[lane] = g0_; gl[64 + lane] = g1_; }
            asm volatile("s_waitcnt lgkmcnt(0)" ::: "memory");
        }
        u32x4 uA[8], vA[8]; float guA, gvA;
#define PEER_LOAD(U_, V_, GU_, GV_, e0_) do { _Pragma("unroll") for (int k = 0; k < 8; ++k) { const unsigned eid = el[(e0_) + k]; \
            U_[k] = *((const u32x4*)(U8 + (size_t)eid * 1024) + lane); V_[k] = *((const u32x4*)(V8 + (size_t)eid * 1024) + lane); } \
        { const unsigned em = el[(e0_) + me]; GU_ = USC[em]; GV_ = VSC[em] * gl[(e0_) + me]; } } while (0)
#define PEER_COMP(U_, V_, GU_, GV_) do { float pd[8]; \
        _Pragma("unroll") for (int k = 0; k < 8; ++k) { f32x2 d2 = (f32x2){0.f, 0.f}; \
            _Pragma("unroll") for (int i = 0; i < 4; ++i) { const f32x2 lo = __builtin_amdgcn_cvt_pk_f32_fp8(U_[k][i], false), hi2 = __builtin_amdgcn_cvt_pk_f32_fp8(U_[k][i], true); \
                d2 = __builtin_elementwise_fma(hv2[2 * i], lo, d2); d2 = __builtin_elementwise_fma(hv2[2 * i + 1], hi2, d2); } \
            pd[k] = d2.x + d2.y; } \
        float q4_[4], r2_[2], s_; \
        _Pragma("unroll") for (int k = 0; k < 4; ++k) { const float keep = (lane & 32) ? pd[k + 4] : pd[k], send = (lane & 32) ? pd[k] : pd[k + 4]; q4_[k] = keep + __shfl_xor(send, 32); } \
        _Pragma("unroll") for (int k = 0; k < 2; ++k) { const float keep = (lane & 16) ? q4_[k + 2] : q4_[k], send = (lane & 16) ? q4_[k] : q4_[k + 2]; r2_[k] = keep + __shfl_xor(send, 16); } \
        { const float keep = (lane & 8) ? r2_[1] : r2_[0], send = (lane & 8) ? r2_[0] : r2_[1]; s_ = keep + __shfl_xor(send, 8); } \
        s_ += __shfl_xor(s_, 4); s_ += __shfl_xor(s_, 2); s_ += __shfl_xor(s_, 1); \
        const float cf_ = GV_ * gelu_exact(s_ * GU_); \
        _Pragma("unroll") for (int k = 0; k < 8; ++k) { const float c = __uint_as_float((unsigned)__builtin_amdgcn_readlane((int)__float_as_uint(cf_), 32 * (k >> 2) + 16 * ((k >> 1) & 1) + 8 * (k & 1))); \
            const f32x2 c2 = (f32x2){c, c}; \
            _Pragma("unroll") for (int i = 0; i < 4; ++i) { const f32x2 lo = __builtin_amdgcn_cvt_pk_f32_fp8(V_[k][i], false), hi2 = __builtin_amdgcn_cvt_pk_f32_fp8(V_[k][i], true); \
                acc2[2 * i] = __builtin_elementwise_fma(c2, lo, acc2[2 * i]); acc2[2 * i + 1] = __builtin_elementwise_fma(c2, hi2, acc2[2 * i + 1]); } } } while (0)
#pragma unroll 1
        for (int e0 = 0; e0 < 128; e0 += 8) {
            if ((e0 & 31) == 0) __syncthreads();
            PEER_LOAD(uA, vA, guA, gvA, e0);
            PEER_COMP(uA, vA, guA, gvA);
        }
#undef PEER_LOAD
#undef PEER_COMP
        float ss = 0.f;
#pragma unroll
        for (int q4 = 0; q4 < 4; ++q4) { const int c = 16 * lane + 4 * q4; const f32x4 gf = *(const f32x4*)(mb + 5120 + c);
#pragma unroll
            for (int e = 0; e < 4; ++e) { const int i = 4 * q4 + e; const float av = (e < 2) ? acc2[2 * q4][e] : acc2[2 * q4 + 1][e - 2]; x1v[i] = x1v[i] + gf[e] * av; ss += x1v[i] * x1v[i]; } }
        const float r2 = 1.0f / sqrtf(wave_sum(ss) * (1.0f / DM) + EPS);
#pragma unroll
        for (int q4 = 0; q4 < 4; ++q4) { const int c = 16 * lane + 4 * q4; const f32x4 gn = *(const f32x4*)(gfin + c);
            f32x4 o;
#pragma unroll
            for (int e = 0; e < 4; ++e) o[e] = x1v[4 * q4 + e] * r2 * gn[e];
            *(f32x4*)(outp + row * DM + c) = o; }
    }
    __syncthreads();
    TSTAMP(71, 2);
}

#define XB_TMO      128
#define XB_XCNT(j)  (256  + 64 * (j))
#define XB_XSUB(j)  (1280 + 64 * (j))
#define XB_XGEN(j)  (2304 + 64 * (j))
#define XB_TOP      3328
#define XB_TOPGEN   3392
#define XCD_BAR_WORDS 3456
#define XB_SPIN_CAP (1u << 18)

__device__ __forceinline__ unsigned xb_ld(unsigned* p)              { return __hip_atomic_load(p, __ATOMIC_RELAXED, __HIP_MEMORY_SCOPE_AGENT); }
__device__ __forceinline__ unsigned xb_add(unsigned* p, unsigned v) { return __hip_atomic_fetch_add(p, v, __ATOMIC_RELAXED, __HIP_MEMORY_SCOPE_AGENT); }
__device__ __forceinline__ unsigned xb_xcc_id() { return (unsigned)__builtin_amdgcn_s_getreg((3 << 11) | 20) & 0xFu; }
#define XB_SPIN(cond, bar) do { unsigned _sp = 0; while (cond) { __builtin_amdgcn_s_sleep(1); \
    if ((++_sp & 255u) == 0u) { if (xb_ld(&(bar)[XB_TMO])) break; if (_sp > XB_SPIN_CAP) { atomicAdd(&(bar)[XB_TMO], 1u); break; } } } } while (0)

struct XcdBarrier {
    unsigned* bar; unsigned x;
    volatile LAS unsigned* st;
};

__device__ __forceinline__ XcdBarrier xcd_barrier_post(unsigned* bar, volatile LAS unsigned* st) {
    XcdBarrier b; b.bar = bar; b.x = xb_xcc_id(); b.st = st;
    if (threadIdx.x == 0) (void)xb_add(&bar[XB_XCNT(b.x)], 1u);
    return b;
}
__device__ __forceinline__ void xcd_barrier_complete(unsigned* bar, unsigned x, unsigned& nloc, unsigned& nx) {
    const unsigned G = gridDim.x * gridDim.y * gridDim.z;
    unsigned sum, cnt, mine, sp = 0u;
    for (;;) {
        sum = 0u; cnt = 0u; mine = 0u;
#pragma unroll
        for (unsigned j = 0; j < 16; ++j) { const unsigned c = xb_ld(&bar[XB_XCNT(j)]); sum += c; cnt += (c > 0u) ? 1u : 0u; mine = (j == x) ? c : mine; }
        if (sum == G) break;
        __builtin_amdgcn_s_sleep(1);
        if ((++sp & 255u) == 0u) { if (xb_ld(&bar[XB_TMO])) break; if (sp > XB_SPIN_CAP) { atomicAdd(&bar[XB_TMO], 1u); break; } }
    }
    nloc = mine > 0u ? mine : 1u; nx = cnt > 0u ? cnt : 1u;
}

__device__ __forceinline__ void xcd_barrier(const XcdBarrier& b) {
    asm volatile("s_waitcnt vmcnt(0)" ::: "memory");
    __syncthreads();
    if (threadIdx.x == 0) {
        unsigned* bar = b.bar;
        __builtin_amdgcn_s_waitcnt(0);
        unsigned nloc = b.st[0], nx = b.st[1];
        if (nloc == 0u) { xcd_barrier_complete(bar, b.x, nloc, nx); b.st[0] = nloc; b.st[1] = nx; }
        const unsigned old = xb_add(&bar[XB_XSUB(b.x)], 1u);
        const unsigned gen = old / nloc;
        if (old + 1u == (gen + 1u) * nloc) {
            __builtin_amdgcn_fence(__ATOMIC_RELEASE, "agent");
            asm volatile("s_waitcnt vmcnt(0)" ::: "memory");
            const unsigned og = xb_add(&bar[XB_TOP], 1u);
            const unsigned tg = og / nx;
            if (og + 1u == (tg + 1u) * nx) xb_add(&bar[XB_TOPGEN], 1u);
            else XB_SPIN(xb_ld(&bar[XB_TOPGEN]) == tg, bar);
            __builtin_amdgcn_fence(__ATOMIC_ACQUIRE, "agent");
            xb_add(&bar[XB_XGEN(b.x)], 1u);
            asm volatile("s_waitcnt vmcnt(0)" ::: "memory");
        } else {
            XB_SPIN(xb_ld(&bar[XB_XGEN(b.x)]) == gen, bar);
            __builtin_amdgcn_fence(__ATOMIC_ACQUIRE, "agent");
            asm volatile("s_waitcnt vmcnt(0)" ::: "memory");
        }
    }
    __syncthreads();
}

constexpr int N_PHASES = 8;
__global__ void __launch_bounds__(NTHREADS, 2) mega(Args a) {
    extern __shared__ __attribute__((aligned(16))) unsigned char lds[];
    const int tid = threadIdx.x, lane = tid & 63, wave = __builtin_amdgcn_readfirstlane(tid >> 6);
    const int bid = blockIdx.x, G = gridDim.x;
    unsigned char* ws = a.ws;
    const int lo = a.ph_lo, hi = a.ph_hi;
    volatile LAS unsigned* MISC = (volatile LAS unsigned*)((LAS unsigned char*)lds + MISC_OFF);
    if (tid < 16) MISC[tid] = 0u;
    __syncthreads();
    XcdBarrier bar; bar.bar = (unsigned*)(ws + WS_CTL) + CW_BAR; bar.x = 0; bar.st = nullptr;
    if (hi - lo > 1) bar = xcd_barrier_post((unsigned*)(ws + WS_CTL) + CW_BAR, MISC + 8);
#ifndef PH_MASK
#define PH_MASK 0xFF
#endif
#define IN(k) (((PH_MASK >> (k)) & 1) && lo <= (k) && (k) < hi)
#define SEAM(k) do { if (IN(k) && IN((k) + 1)) { xcd_barrier(bar); } } while (0)
#ifdef REP_PH
#ifndef REP_N
#define REP_N 1
#endif
#define REPS(k) for (int rep_ = 0; rep_ < ((k) == REP_PH ? 1 + REP_N : 1); ++rep_, ((k) == REP_PH && rep_ <= REP_N ? (xcd_barrier(bar), 0) : 0))
#else
#define REPS(k)
#endif

    TSTAMP(100, 0);
    TSTAMP(0, 0);
    REPS(0) if (IN(0)) phase0(a, lds, tid, wave, lane, bid, G);
    SEAM(0);
    TSTAMP(0, 2);
    TSTAMP(1, 0);
    REPS(1) if (IN(1)) phase1(a, wave, lane, bid, G);
    SEAM(1);
    TSTAMP(1, 2);
    TSTAMP(2, 0);
    REPS(2) if (IN(2)) {
        pg8::Gemm g{(const bf16_t*)(ws + WS_BUFA), (const bf16_t*)(ws + WS_WIN), MTOK, N1, DM}; pg8::StaticOrder S; S.init(MTOK, N1, G, bid);
        pg8::Epi1 E{ws};
        pg8::gemm_phase<pg8::Epi1, pg8::StaticOrder, true, true>((LAS unsigned char*)lds, g, S, E);
        const int nfull = (MTOK / 256) * (N1 / 256) - 4 * G;
        { const bool tail = nfull > 0 && nfull < G; const int cw = tail ? (bid - nfull) * 8 + wave : bid * 8 + wave, NCW = tail ? (G - nfull) * 8 : G * 8;
          if (!tail || bid >= nfull)
              for (int it = cw; it < 4096; it += NCW) { const int r = 4 * it;
                  rows_to_fp8<4>(a.in[11] + (size_t)r * 1024, ws + WS_V8 + (size_t)r * 1024, (float*)(ws + WS_VSC) + r, lane); } }
    }
    SEAM(2);
    TSTAMP(2, 2);
    TSTAMP(3, 0);
    REPS(3) if (IN(3)) {
        TSTAMP(30, 0);
        const int vcu3 = (G % 8 == 0) ? (bid % 8) * (G / 8) + bid / 8 : bid;
        for (int u = vcu3; u < 256; u += G)
            ret_state_unit(u >> 6, (u >> 4) & 3, (u >> 1) & 7, u & 1, (const bf16_t*)(ws + WS_KR), (const bf16_t*)(ws + WS_VR), (bf16_t*)(ws + WS_STATE), lds, tid, wave, lane);
        TSTAMP(30, 2); TSTAMP(31, 0);
        for (int k = vcu3; k < 256; k += G) {
            const int b = k >> 6, j = k & 63;
#pragma unroll 1
            for (int i = 0; i < 4; ++i) {
                const int qt = (i == 0) ? j : (i == 1) ? 127 - j : (i == 2) ? 128 + j : 255 - j;
                idx_unit(b, qt, (const bf16_t*)(ws + WS_QI), (const bf16_t*)(ws + WS_KI), (const float*)(ws + WS_WI), (unsigned long long*)(ws + WS_MASK), lds, wave, lane, bid == TPROBE_B && i == TPROBE_I);
            }
        }
        TSTAMP(31, 2);
    }
    SEAM(3);
    TSTAMP(3, 2);
    TSTAMP(4, 0);
    REPS(4) if (IN(4)) {
        TSTAMP(40, 0);
        const int vcu = (G % 8 == 0) ? (bid % 8) * (G / 8) + bid / 8 : bid;
        for (int k = vcu; k < 256; k += G) {
            const int bh = k >> 3, s = k & 7;
#pragma unroll 1
            for (int i = 0; i < 2; ++i)
                attn_unit(bh >> 3, bh & 7, i ? 15 - s : s, (const bf16_t*)(ws + WS_QA), (const bf16_t*)(ws + WS_KA), (const bf16_t*)(ws + WS_VA), (const unsigned long long*)(ws + WS_MASK),
                          (bf16_t*)(ws + WS_BUFB), lds, tid, wave, lane);
        }
        TSTAMP(40, 2); TSTAMP(41, 0);
        for (int u = vcu; u < 256; u += G) {
            const int xg = u >> 5, ci = u & 31;
#pragma unroll 1
            for (int jj = 0; jj < 2; ++jj) { const int bh2 = 2 * xg + jj;
                ret_out_unit(bh2 >> 2, bh2 & 3, ci, (const bf16_t*)(ws + WS_QR), (const bf16_t*)(ws + WS_KR), (const bf16_t*)(ws + WS_VR), (const bf16_t*)(ws + WS_GR),
                             (const bf16_t*)(ws + WS_STATE), (bf16_t*)(ws + WS_BUFB), lds, tid, wave, lane); }
        }
        TSTAMP(41, 2);
    }
    SEAM(4);
    TSTAMP(4, 2);
    TSTAMP(5, 0);
    REPS(5) if (IN(5)) {
        pg8::Gemm g{(const bf16_t*)(ws + WS_BUFB), (const bf16_t*)(ws + WS_WOUT), MTOK, DM, DM}; pg8::StaticOrder S; S.init(MTOK, DM, G, bid);
        pg8::Epi2 E{a.in[0], a.out, (bf16_t*)(ws + WS_BUFA), (const float*)(ws + WS_MOD), a.in[7], (float*)(ws + WS_SUMSQ)};
        pg8::gemm_phase<pg8::Epi2, pg8::StaticOrder, true, true>((LAS unsigned char*)lds, g, S, E);
    }
    SEAM(5);
    TSTAMP(5, 2);
    TSTAMP(6, 0);
    REPS(6) if (IN(6)) {
        pg8::Gemm g{(const bf16_t*)(ws + WS_BUFA), (const bf16_t*)(ws + WS_WPQ), MTOK, 2048, DM}; pg8::StaticOrder S; S.init(MTOK, 2048, G, bid);
        pg8::Epi3 E{(const float*)(ws + WS_SUMSQ), (const float*)(ws + WS_BIASF), (bf16_t*)(ws + WS_SC)};
        pg8::gemm_phase<pg8::Epi3, pg8::StaticOrder, true, true>((LAS unsigned char*)lds, g, S, E);
    }
    SEAM(6);
    TSTAMP(6, 2);
    TSTAMP(7, 0);
    if (IN(7)) {
        if (G == 256) { const int xg = bid & 7, i = bid >> 3;
            peer_unit(64 * xg + i, ws, a.out, a.in[7], a.in[12], lds, tid, wave, lane); peer_unit(64 * xg + 32 + i, ws, a.out, a.in[7], a.in[12], lds, tid, wave, lane); }
        else for (int u = bid; u < 512; u += G) peer_unit(u, ws, a.out, a.in[7], a.in[12], lds, tid, wave, lane);
    }
    TSTAMP(7, 2);
    TSTAMP(100, 2);
#ifdef TIME_PH
    if (bid == TPROBE_B && tid == 0) {
        const unsigned long long t0_ = ((unsigned long long)MISC[1] << 32) | MISC[0], t1_ = ((unsigned long long)MISC[3] << 32) | MISC[2];
        const unsigned long long until_ = __builtin_amdgcn_s_memrealtime() + (unsigned long long)TIME_AMP * (t1_ - t0_);
        while (__builtin_amdgcn_s_memrealtime() < until_) __builtin_amdgcn_s_sleep(8);
    }
#endif
#undef IN
#undef SEAM
}

extern "C" void kernel_launch(void* const* d_in, const int* in_sizes, int n_in, void* d_out, int out_size, void* d_ws, size_t ws_size, hipStream_t stream) {
    static int grid = 0;
    if (grid == 0) {
        if (n_in != 13 || out_size != MTOK * DM || ws_size < WS_END) { fprintf(stderr, "kernel_launch: unexpected shapes (n_in %d, out %d, ws %zu); nothing launched\n", n_in, out_size, ws_size); grid = -1; return; }
        int dev = 0, cus = 0, per_cu = 0;
        if (hipGetDevice(&dev) != hipSuccess || hipDeviceGetAttribute(&cus, hipDeviceAttributeMultiprocessorCount, dev) != hipSuccess) { grid = -1; return; }
        if (hipFuncSetAttribute((const void*)mega, hipFuncAttributeMaxDynamicSharedMemorySize, LDS_BYTES) != hipSuccess) { fprintf(stderr, "kernel_launch: hipFuncSetAttribute failed\n"); grid = -1; return; }
        if (hipOccupancyMaxActiveBlocksPerMultiprocessor(&per_cu, (const void*)mega, NTHREADS, LDS_BYTES) != hipSuccess || per_cu < 1) { fprintf(stderr, "kernel_launch: occupancy query gave %d\n", per_cu); per_cu = 1; }
        (void)hipGetLastError();
        grid = cus;
    }
    if (grid < 0) return;
    if (hipMemsetAsync((char*)d_ws + WS_CTL + (size_t)CW_BAR * 4, 0, (size_t)XCD_BAR_WORDS * 4, stream) != hipSuccess) { fprintf(stderr, "kernel_launch: memset failed\n"); return; }
    Args a{};
    for (int i = 0; i < 13; ++i) a.in[i] = (const float*)d_in[i];
    a.out = (float*)d_out; a.ws = (unsigned char*)d_ws;
#if MK_MULTI
    for (int p = 0; p < N_PHASES; ++p) { a.ph_lo = p; a.ph_hi = p + 1; hipLaunchKernelGGL(mega, dim3(grid), dim3(NTHREADS), LDS_BYTES, stream, a); }
#else
    a.ph_lo = 0; a.ph_hi = N_PHASES;
    hipLaunchKernelGGL(mega, dim3(grid), dim3(NTHREADS), LDS_BYTES, stream, a);
#endif
}
```
